# Optimizing an MI355X kernel written in HIP

```python
import jax
import jax.numpy as jnp
from jax import lax
import numpy as np

D_MODEL = 2048
BATCH = 2
SEQ = 8192
DEPTH = 2

CTX_LEN = 256
GRID_W = 64

A_HEADS = 8
A_DV = D_MODEL // A_HEADS
A_DK = A_DV // 2
A_CHUNK = 64
F_BIAS = 3.0
B_WIDTH = D_MODEL
CONV_W = 3
C_HEADS = 16
C_DH = D_MODEL // C_HEADS
WIN_ROWS = 8
WIN_COLS = 16
PEER_HEADS = 8
PEER_NKEYS = 128
PEER_N = PEER_NKEYS * PEER_NKEYS
PEER_QDIM = 256
PEER_HALF = PEER_QDIM // 2
PEER_TOPK = 16
PEER_BLOCK = 128
N_BRANCH = 3
ROPE_BASE = 10000.0
EPS = 1e-6

PROJ_LAYOUT = (
    ('a_k', A_HEADS * A_DK),
    ('a_v', A_HEADS * A_DV),
    ('a_gates', 4 * A_HEADS),
    ('c_k', C_HEADS * C_DH),
    ('c_v', C_HEADS * C_DH),
    ('a_q', A_HEADS * A_DK),
    ('a_o', A_HEADS * A_DV),
    ('b_b', B_WIDTH),
    ('b_c', B_WIDTH),
    ('b_x', B_WIDTH),
    ('c_q', C_HEADS * C_DH),
    ('gate', N_BRANCH * D_MODEL),
)
KV_WIDTH = A_HEADS * A_DK + A_HEADS * A_DV + 4 * A_HEADS + 2 * C_HEADS * C_DH
PROJ_WIDTH = KV_WIDTH + A_HEADS * A_DK + A_HEADS * A_DV + 3 * B_WIDTH + C_HEADS * C_DH + N_BRANCH * D_MODEL

kernel_name = 'hybrid_mlstm_shortconv_natten_peer'


def split_cols(p):
    out, off = {}, 0
    for name, w in PROJ_LAYOUT:
        if off + w > p.shape[-1]:
            break
        out[name] = p[..., off:off + w]
        off += w
    return out


def rms_norm(t, g):
    tf = t.astype(jnp.float32)
    y = tf * lax.rsqrt(jnp.mean(tf * tf, axis=-1, keepdims=True) + EPS)
    return (y * g.astype(jnp.float32)).astype(t.dtype)


def modulate(t, shift, scale):
    return t * (1 + scale) + shift


def to_heads(t, n):
    b, s, _ = t.shape
    return t.reshape(b, s, n, -1).transpose(0, 2, 1, 3)


def to_c_heads(t):
    return t.reshape(t.shape[0], t.shape[1], C_HEADS, C_DH)


def flip_seq(t):
    return jnp.flip(t, axis=2)


def rope2d(t):
    s = t.shape[2]
    half = t.shape[-1] // 2
    nf = half // 2
    inv = ROPE_BASE ** (-jnp.arange(nf, dtype=jnp.float32) / nf)
    pos = jnp.arange(s)

    def rot(u, p):
        ang = p.astype(jnp.float32)[:, None] * inv
        cos, sin = jnp.cos(ang), jnp.sin(ang)
        u1, u2 = u[..., :nf], u[..., nf:]
        return jnp.concatenate([u1 * cos - u2 * sin, u2 * cos + u1 * sin], axis=-1)

    tf = t.astype(jnp.float32)
    out = jnp.concatenate([rot(tf[..., :half], pos // GRID_W), rot(tf[..., half:], pos % GRID_W)], axis=-1)
    return out.astype(t.dtype)


def mlstm_gates(gp, bias):
    b, s, _ = gp.shape
    g = gp.astype(jnp.float32).reshape(b, s, 4, A_HEADS) + bias.astype(jnp.float32)
    g = g.transpose(2, 0, 3, 1)
    return (g[0], jax.nn.log_sigmoid(g[1]), g[2], jax.nn.log_sigmoid(g[3]))


def mlstm_final_state(k, v, li, lf):
    kf, vf = k.astype(jnp.float32), v.astype(jnp.float32)
    cs = jnp.cumsum(lf, axis=-1)
    w = cs[..., -1:] - cs + li
    m = jnp.max(w, axis=-1)
    ke = kf * jnp.exp(w - m[..., None])[..., None]
    big_c = jnp.einsum('bhsd,bhse->bhde', ke, vf)
    n = jnp.sum(ke, axis=2)
    return (big_c, n, m)


def zero_state(bsz):
    return (jnp.zeros((bsz, A_HEADS, A_DK, A_DV), jnp.float32),
            jnp.zeros((bsz, A_HEADS, A_DK), jnp.float32),
            jnp.zeros((bsz, A_HEADS), jnp.float32))


def mlstm_chunkwise(q, k, v, li, lf, state):
    b, h, s, _ = q.shape
    nc = s // A_CHUNK

    def chunks(t):
        t = t.reshape(b, h, nc, A_CHUNK, *t.shape[3:])
        return jnp.moveaxis(t, 2, 0)

    tril = jnp.tril(jnp.ones((A_CHUNK, A_CHUNK), dtype=bool))

    def step(carry, xs):
        big_c, n, m = carry
        qc, kc, vc, lic, lfc = xs
        bc = jnp.cumsum(lfc, axis=-1)
        dlog = jnp.where(tril, bc[..., :, None] - bc[..., None, :] + lic[..., None, :], -jnp.inf)
        inter = bc + m[..., None]
        m_row = jnp.maximum(inter, jnp.max(dlog, axis=-1))
        w_inter = jnp.exp(inter - m_row)
        sc = jnp.einsum('bhtd,bhsd->bhts', qc, kc) * jnp.exp(dlog - m_row[..., None])
        num = w_inter[..., None] * jnp.einsum('bhtd,bhde->bhte', qc, big_c) + jnp.einsum('bhts,bhse->bhte', sc, vc)
        den = w_inter * jnp.einsum('bhtd,bhd->bht', qc, n) + jnp.sum(sc, axis=-1)
        hc = num / jnp.maximum(jnp.abs(den), jnp.exp(-m_row))[..., None]
        b_last = bc[..., -1]
        w_s = b_last[..., None] - bc + lic
        m_new = jnp.maximum(b_last + m, jnp.max(w_s, axis=-1))
        decay = jnp.exp(b_last + m - m_new)
        ke = kc * jnp.exp(w_s - m_new[..., None])[..., None]
        c_new = decay[..., None, None] * big_c + jnp.einsum('bhsd,bhse->bhde', ke, vc)
        n_new = decay[..., None] * n + jnp.sum(ke, axis=2)
        return (c_new, n_new, m_new), hc

    state, hs = lax.scan(step, state, (chunks(q), chunks(k), chunks(v), chunks(li), chunks(lf)))
    return jnp.moveaxis(hs, 0, 2).reshape(b, h, s, -1), state


def mlstm_mixer(q, k, v, o, gates, state_f, state_b, hnorm_g):
    q = q.astype(jnp.float32) * (A_DK ** -0.5)
    k = k.astype(jnp.float32)
    v = v.astype(jnp.float32)
    li_f, lf_f, li_b, lf_b = gates
    h_f, _ = mlstm_chunkwise(q, k, v, li_f, lf_f, state_f)
    h_b, _ = mlstm_chunkwise(flip_seq(q), flip_seq(k), flip_seq(v), flip_seq(li_b), flip_seq(lf_b), state_b)
    hs = h_f + flip_seq(h_b)
    hs = hs * lax.rsqrt(jnp.mean(hs * hs, axis=-1, keepdims=True) + EPS) * hnorm_g.astype(jnp.float32).reshape(A_HEADS, 1, A_DV)
    bsz, _, s, _ = hs.shape
    hs = hs.transpose(0, 2, 1, 3).reshape(bsz, s, A_HEADS * A_DV)
    return (jax.nn.sigmoid(o.astype(jnp.float32)) * hs).astype(o.dtype)


def short_conv_mixer(bg, cg, xin, w):
    u = cg * xin
    s = u.shape[1]
    pad = CONV_W // 2
    up = jnp.pad(u, ((0, 0), (pad, pad), (0, 0)))
    y = up[:, 0:s] * w[0]
    for j in range(1, CONV_W):
        y = y + up[:, j:j + s] * w[j]
    return bg * y


def neighbourhood_attention(q, k, v, k_ctx, v_ctx, rpb):
    bsz, s, nh, dh = q.shape
    rows = s // GRID_W
    wr = min(WIN_ROWS, rows)
    nloc = wr * WIN_COLS
    qg = (q.reshape(bsz, rows, GRID_W, nh, dh) * (dh ** -0.5)).transpose(1, 0, 2, 3, 4)
    kg = k.reshape(bsz, rows, GRID_W, nh, dh)
    vg = v.reshape(bsz, rows, GRID_W, nh, dh)
    col = np.arange(GRID_W)
    col0 = np.clip(col - WIN_COLS // 2, 0, GRID_W - WIN_COLS)
    col_idx = col0[:, None] + np.arange(WIN_COLS)
    dc_idx = col_idx - col[:, None] + (WIN_COLS - 1)

    def row_step(args):
        r, q_row = args
        r0 = jnp.clip(r - wr // 2, 0, rows - wr)
        k_win = lax.dynamic_slice_in_dim(kg, r0, wr, axis=1)[:, :, col_idx]
        v_win = lax.dynamic_slice_in_dim(vg, r0, wr, axis=1)[:, :, col_idx]
        dr_idx = r0 + jnp.arange(wr) - r + (WIN_ROWS - 1)
        bias = rpb[:, dr_idx[None, :, None], dc_idx[:, None, :]]
        s_loc = jnp.einsum('bqhd,brqwhd->bhqrw', q_row, k_win).astype(jnp.float32) + bias.astype(jnp.float32)
        s_ctx = jnp.einsum('bqhd,bchd->bhqc', q_row, k_ctx).astype(jnp.float32)
        sc = jnp.concatenate([s_loc.reshape(bsz, nh, GRID_W, nloc), s_ctx], axis=-1)
        p = jax.nn.softmax(sc, axis=-1).astype(v.dtype)
        p_loc = p[..., :nloc].reshape(bsz, nh, GRID_W, wr, WIN_COLS)
        p_ctx = p[..., nloc:]
        return jnp.einsum('bhqrw,brqwhd->bqhd', p_loc, v_win) + jnp.einsum('bhqc,bchd->bqhd', p_ctx, v_ctx)

    out = lax.map(row_step, (jnp.arange(rows), qg))
    return out.transpose(1, 0, 2, 3, 4).reshape(bsz, s, nh * dh)


def context_attention(q, k, v):
    sc = jnp.einsum('bqhd,bkhd->bhqk', q, k).astype(jnp.float32) * (q.shape[-1] ** -0.5)
    p = jax.nn.softmax(sc, axis=-1).astype(v.dtype)
    return jnp.einsum('bhqk,bkhd->bqhd', p, v).reshape(q.shape[0], q.shape[1], -1)


def merge_branches(gate_pre, ya, yb, yc, w_a, w_b, w_c, w_o):
    b, s, _ = gate_pre.shape
    g = jax.nn.sigmoid(gate_pre.astype(jnp.float32)).astype(ya.dtype).reshape(b, s, N_BRANCH, D_MODEL)
    y = g[:, :, 0] * (ya @ w_a) + g[:, :, 1] * (yb @ w_b) + g[:, :, 2] * (yc @ w_c)
    return y @ w_o


def peer_ffn(xn, wq, sub_keys, u, v):
    b, t, d = xn.shape
    xb = xn.reshape(-1, PEER_BLOCK, d)

    def block(xt):
        q = (xt @ wq).reshape(PEER_BLOCK, PEER_HEADS, 2, PEER_HALF)
        s = jnp.einsum('thpd,hpkd->thpk', q, sub_keys).astype(jnp.float32)
        s_top, i_top = lax.top_k(s, PEER_TOPK)
        cand = (s_top[:, :, 0, :, None] + s_top[:, :, 1, None, :]).reshape(PEER_BLOCK, PEER_HEADS, -1)
        cand_idx = (i_top[:, :, 0, :, None] * PEER_NKEYS + i_top[:, :, 1, None, :]).reshape(PEER_BLOCK, PEER_HEADS, -1)
        best, pos = lax.top_k(cand, PEER_TOPK)
        idx = jnp.take_along_axis(cand_idx, pos, axis=-1)
        g = jax.nn.softmax(best, axis=-1)
        act = jax.nn.gelu(jnp.einsum('td,thkd->thk', xt, u[idx]).astype(jnp.float32), approximate=False)
        return jnp.einsum('thk,thkd->td', (g * act).astype(xt.dtype), v[idx])

    return lax.map(block, xb).reshape(b, t, d)


def setup_inputs(seed: int = 0) -> dict:
    key = jax.random.key(seed)
    ks = jax.random.split(key, 21)
    nl, d = DEPTH, D_MODEL

    def nrm(k, shape, scale):
        return scale * jax.random.normal(k, shape, jnp.float32)

    gate_off = jnp.array([0.0, F_BIAS, 0.0, F_BIAS], jnp.float32)[None, :, None]
    return {
        'x': nrm(ks[0], (BATCH, SEQ, d), 1.0),
        'c': nrm(ks[1], (BATCH, d), 1.0),
        'ctx': nrm(ks[2], (BATCH, CTX_LEN, d), 1.0),
        'c_ctx': nrm(ks[3], (d,), 1.0),
        'w_ada': nrm(ks[4], (nl, d, 6 * d), 0.5 * d ** -0.5),
        'b_ada': nrm(ks[5], (nl, 6 * d), 0.02),
        'norm_g': 1.0 + nrm(ks[6], (nl, 2, d), 0.05),
        'w_in': nrm(ks[7], (nl, d, PROJ_WIDTH), d ** -0.5),
        'a_gate_b': gate_off + nrm(ks[8], (nl, 4, A_HEADS), 0.1),
        'a_hnorm_g': 1.0 + nrm(ks[9], (nl, A_HEADS * A_DV), 0.05),
        'b_conv': nrm(ks[10], (nl, CONV_W, B_WIDTH), CONV_W ** -0.5),
        'c_qk_g': 1.0 + nrm(ks[11], (nl, 2, C_DH), 0.05),
        'c_rpb': nrm(ks[12], (nl, C_HEADS, 2 * WIN_ROWS - 1, 2 * WIN_COLS - 1), 0.1),
        'w_a_out': nrm(ks[13], (nl, A_HEADS * A_DV, d), (A_HEADS * A_DV) ** -0.5),
        'w_b_out': nrm(ks[14], (nl, B_WIDTH, d), B_WIDTH ** -0.5),
        'w_c_out': nrm(ks[15], (nl, C_HEADS * C_DH, d), (C_HEADS * C_DH) ** -0.5),
        'w_out': nrm(ks[16], (nl, d, d), d ** -0.5),
        'peer_wq': nrm(ks[17], (nl, d, PEER_HEADS * PEER_QDIM), d ** -0.5),
        'peer_keys': nrm(ks[18], (nl, PEER_HEADS, 2, PEER_NKEYS, PEER_HALF), PEER_HALF ** -0.5),
        'peer_u': nrm(ks[19], (nl, PEER_N, d), d ** -0.5),
        'peer_v': nrm(ks[20], (nl, PEER_N, d), PEER_HEADS ** -0.5),
    }


def reference(x, c, ctx, c_ctx, w_ada, b_ada, norm_g, w_in, a_gate_b, a_hnorm_g, b_conv, c_qk_g, c_rpb,
              w_a_out, w_b_out, w_c_out, w_out, peer_wq, peer_keys, peer_u, peer_v):
    bsz = x.shape[0]
    h_ctx = ctx
    for l in range(DEPTH):
        last = l == DEPTH - 1
        mod_x = jnp.split((jax.nn.silu(c) @ w_ada[l] + b_ada[l])[:, None, :], 6, axis=-1)
        mod_c = jnp.split(jax.nn.silu(c_ctx) @ w_ada[l] + b_ada[l], 6, axis=-1)

        cn = modulate(rms_norm(h_ctx, norm_g[l, 0]), mod_c[0], mod_c[1])
        pc = split_cols(cn @ (w_in[l, :, :KV_WIDTH] if last else w_in[l]))
        ka_c = to_heads(pc['a_k'], A_HEADS)
        va_c = to_heads(pc['a_v'], A_HEADS)
        gates_c = mlstm_gates(pc['a_gates'], a_gate_b[l])
        state_f = mlstm_final_state(ka_c, va_c, gates_c[0], gates_c[1])
        state_b = mlstm_final_state(flip_seq(ka_c), flip_seq(va_c), flip_seq(gates_c[2]), flip_seq(gates_c[3]))
        kc_c = rms_norm(to_c_heads(pc['c_k']), c_qk_g[l, 1])
        vc_c = to_c_heads(pc['c_v'])

        xn = modulate(rms_norm(x, norm_g[l, 0]), mod_x[0], mod_x[1])
        p = split_cols(xn @ w_in[l])
        ya = mlstm_mixer(rope2d(to_heads(p['a_q'], A_HEADS)), rope2d(to_heads(p['a_k'], A_HEADS)),
                         to_heads(p['a_v'], A_HEADS), p['a_o'], mlstm_gates(p['a_gates'], a_gate_b[l]),
                         state_f, state_b, a_hnorm_g[l])
        yb = short_conv_mixer(p['b_b'], p['b_c'], p['b_x'], b_conv[l])
        yc = neighbourhood_attention(rms_norm(to_c_heads(p['c_q']), c_qk_g[l, 0]),
                                     rms_norm(to_c_heads(p['c_k']), c_qk_g[l, 1]),
                                     to_c_heads(p['c_v']), kc_c, vc_c, c_rpb[l])
        mix = merge_branches(p['gate'], ya, yb, yc, w_a_out[l], w_b_out[l], w_c_out[l], w_out[l])
        x_new = x + mod_x[2] * mix
        xn2 = modulate(rms_norm(x_new, norm_g[l, 1]), mod_x[3], mod_x[4])
        x_new = x_new + mod_x[5] * peer_ffn(xn2, peer_wq[l], peer_keys[l], peer_u[l], peer_v[l])

        if not last:
            ya_c = mlstm_mixer(to_heads(pc['a_q'], A_HEADS), ka_c, va_c, pc['a_o'], gates_c,
                               zero_state(bsz), zero_state(bsz), a_hnorm_g[l])
            yb_c = short_conv_mixer(pc['b_b'], pc['b_c'], pc['b_x'], b_conv[l])
            yc_c = context_attention(rms_norm(to_c_heads(pc['c_q']), c_qk_g[l, 0]), kc_c, vc_c)
            mix_c = merge_branches(pc['gate'], ya_c, yb_c, yc_c, w_a_out[l], w_b_out[l], w_c_out[l], w_out[l])
            hc = h_ctx + mod_c[2] * mix_c
            hcn = modulate(rms_norm(hc, norm_g[l, 1]), mod_c[3], mod_c[4])
            h_ctx = hc + mod_c[5] * peer_ffn(hcn, peer_wq[l], peer_keys[l], peer_u[l], peer_v[l])
        x = x_new
    return x
```

```cpp
#include <hip/hip_runtime.h>
#include <stdint.h>
#include <stdio.h>

#ifndef ABL
#define ABL 0
#endif
#ifndef MK_SINGLE
#define MK_SINGLE 1
#endif

#define LAS __attribute__((address_space(3)))
typedef unsigned short bf16_t;
typedef short bf16x8 __attribute__((ext_vector_type(8)));
typedef float f32x4 __attribute__((ext_vector_type(4)));
typedef float f32x2 __attribute__((ext_vector_type(2)));
typedef unsigned u32x4 __attribute__((ext_vector_type(4)));
typedef unsigned u32x2 __attribute__((ext_vector_type(2)));
typedef __bf16 bf2_t __attribute__((ext_vector_type(2)));

constexpr int DM = 2048, NBATCH = 2, SEQ = 8192, CTXL = 256;
constexpr int NLAT = NBATCH * SEQ;
constexpr int NCTX = NBATCH * CTXL;
constexpr int MR = NLAT + NCTX;
constexpr int PROJ_W = 24608;
constexpr int NPROJ = 24576;
constexpr int NTHREADS = 512;
constexpr int LDS_BYTES = 163840;
constexpr int NPH = 11;
constexpr float EPSF = 1e-6f;

constexpr size_t SZ_A = (size_t)MR * 2048 * 2;
constexpr size_t WS_BAR = 0;
constexpr size_t WS_MOD = 16384;
constexpr size_t CTL_BYTES = 16384 + 2 * 3 * 12288 * 4;
constexpr size_t WS_TAB = 311296;
constexpr size_t WS_X = WS_TAB + 32768;
constexpr size_t WS_XN = WS_X + (size_t)MR * 2048 * 4;
constexpr size_t WS_Y = WS_XN + SZ_A;
constexpr size_t WS_PQ = WS_Y + SZ_A;
constexpr size_t WS_PK = WS_PQ + SZ_A / 2;
constexpr size_t WS_T8 = WS_PK + SZ_A / 2;
constexpr size_t WS_PV = WS_T8 + 0 * SZ_A;
constexpr size_t WS_PO = WS_T8 + 1 * SZ_A;
constexpr size_t WS_CQ = WS_T8 + 2 * SZ_A;
constexpr size_t WS_CK = WS_T8 + 3 * SZ_A;
constexpr size_t WS_CV = WS_T8 + 4 * SZ_A;
constexpr size_t WS_BB = WS_T8 + 5 * SZ_A;
constexpr size_t WS_BC = WS_T8 + 6 * SZ_A;
constexpr size_t WS_BX = WS_T8 + 7 * SZ_A;
constexpr size_t WS_GT = WS_T8 + 8 * SZ_A;
constexpr size_t WS_GATES = WS_GT + 3 * SZ_A;
constexpr size_t WS_WIN = WS_GATES + (size_t)MR * 32 * 4;
constexpr size_t WS_WG = WS_WIN + (size_t)NPROJ * 2048 * 2;
constexpr size_t SZ_W = (size_t)2048 * 2048 * 2;
constexpr size_t WS_WA = WS_WG + 32 * 2048 * 2;
constexpr size_t WS_WB = WS_WA + SZ_W;
constexpr size_t WS_WC = WS_WB + SZ_W;
constexpr size_t WS_WO = WS_WC + SZ_W;
constexpr size_t WS_WQ = WS_WO + SZ_W;
constexpr size_t WS_KEYS = WS_WQ + SZ_W;
constexpr size_t WS_PU = WS_KEYS + 16 * 128 * 128 * 2;
constexpr size_t WS_PVW = WS_PU + (size_t)16384 * 2048 * 2;
constexpr size_t WS_END = WS_PVW + (size_t)16384 * 2048 * 2;

struct Params {
    const float *x, *c, *ctx, *c_ctx, *w_ada, *b_ada, *norm_g, *w_in, *a_gate_b, *a_hnorm_g, *b_conv, *c_qk_g, *c_rpb,
        *w_a_out, *w_b_out, *w_c_out, *w_out, *peer_wq, *peer_keys, *peer_u, *peer_v;
    float* out; unsigned char* ws; int ph_lo, ph_hi;
};
#define CAS __attribute__((address_space(4)))
typedef const CAS Params* KP;
__device__ __forceinline__ KP launder_p(KP q) { asm volatile("" : "+s"(q)); return q; }

__device__ __forceinline__ unsigned char* launder(unsigned char* q) { size_t z = 0; asm volatile("" : "+s"(z)); return q + z; }
__device__ __forceinline__ int tid_fresh() { int t = threadIdx.x; asm volatile("" : "+v"(t)); return t; }

__device__ __forceinline__ float bf2f(unsigned b) { return __uint_as_float(b << 16); }
__device__ __forceinline__ float bflo(unsigned w) { return __uint_as_float(w << 16); }
__device__ __forceinline__ float bfhi(unsigned w) { return __uint_as_float(w & 0xffff0000u); }
__device__ __forceinline__ unsigned pk2(float lo, float hi) { f32x2 v = {lo, hi}; bf2_t b = __builtin_convertvector(v, bf2_t); return __builtin_bit_cast(unsigned, b); }
__device__ __forceinline__ bf16_t f2bf(float f) { return (bf16_t)(pk2(f, 0.f) & 0xffffu); }
__device__ __forceinline__ f32x4 mfma16(bf16x8 a, bf16x8 b, f32x4 c) { return __builtin_amdgcn_mfma_f32_16x16x32_bf16(a, b, c, 0, 0, 0); }
__device__ __forceinline__ float dot2bf(unsigned a, unsigned b, float c) { return __builtin_amdgcn_fdot2_f32_bf16(__builtin_bit_cast(bf2_t, a), __builtin_bit_cast(bf2_t, b), c, false); }
__device__ __forceinline__ float wave_sum(float v) {
#pragma unroll
    for (int o = 32; o >= 1; o >>= 1) v += __shfl_xor(v, o);
    return v;
}
__device__ __forceinline__ float sigmoidf_(float v) { return 1.0f / (1.0f + __expf(-v)); }
__device__ __forceinline__ float logsigmoidf_(float v) { return fminf(v, 0.f) - log1pf(__expf(-fabsf(v))); }

#define XB_TMO      128
#define XB_XCNT(j)  (256  + 64 * (j))
#define XB_XSUB(j)  (1280 + 64 * (j))
#define XB_XGEN(j)  (2304 + 64 * (j))
#define XB_TOP      3328
#define XB_TOPGEN   3392
#define XCD_BAR_WORDS 3456
#define XB_SPIN_CAP (1u << 22)
__device__ __forceinline__ unsigned xb_ld(unsigned* p)              { return __hip_atomic_load(p, __ATOMIC_RELAXED, __HIP_MEMORY_SCOPE_AGENT); }
__device__ __forceinline__ unsigned xb_add(unsigned* p, unsigned v) { return __hip_atomic_fetch_add(p, v, __ATOMIC_RELAXED, __HIP_MEMORY_SCOPE_AGENT); }
__device__ __forceinline__ unsigned xb_xcc_id() { return (unsigned)__builtin_amdgcn_s_getreg((3 << 11) | 20) & 0xFu; }
#define XB_SPIN(cond, bar) do { unsigned _sp = 0; while (cond) { __builtin_amdgcn_s_sleep(1); \
    if ((++_sp & 255u) == 0u) { if (xb_ld(&(bar)[XB_TMO])) break; if (_sp > XB_SPIN_CAP) { atomicAdd(&(bar)[XB_TMO], 1u); break; } } } } while (0)
struct XcdBarrier { unsigned* bar; unsigned x; volatile LAS unsigned* st; };
__device__ __forceinline__ XcdBarrier xcd_barrier_post(unsigned* bar, volatile LAS unsigned* st) {
    XcdBarrier b; b.bar = bar; b.x = xb_xcc_id(); b.st = st;
    if (threadIdx.x == 0) (void)xb_add(&bar[XB_XCNT(b.x)], 1u);
    return b;
}
__device__ __forceinline__ void xcd_barrier_complete(unsigned* bar, unsigned x, unsigned& nloc, unsigned& nx) {
    const unsigned G = gridDim.x * gridDim.y * gridDim.z;
    unsigned sum, cnt, mine, sp = 0u;
    for (;;) {
        sum = 0u; cnt = 0u; mine = 0u;
#pragma unroll
        for (unsigned j = 0; j < 16; ++j) { const unsigned c = xb_ld(&bar[XB_XCNT(j)]); sum += c; cnt += (c > 0u) ? 1u : 0u; mine = (j == x) ? c : mine; }
        if (sum == G) break;
        __builtin_amdgcn_s_sleep(1);
        if ((++sp & 255u) == 0u) { if (xb_ld(&bar[XB_TMO])) break; if (sp > XB_SPIN_CAP) { atomicAdd(&bar[XB_TMO], 1u); break; } }
    }
    nloc = mine > 0u ? mine : 1u; nx = cnt > 0u ? cnt : 1u;
}
__device__ __forceinline__ void xcd_barrier(const XcdBarrier& b) {
    asm volatile("s_waitcnt vmcnt(0)" ::: "memory");
    __syncthreads();
    if (threadIdx.x == 0) {
        unsigned* bar = b.bar;
        __builtin_amdgcn_s_waitcnt(0);
        unsigned nloc = b.st[0], nx = b.st[1];
        if (nloc == 0u) { xcd_barrier_complete(bar, b.x, nloc, nx); b.st[0] = nloc; b.st[1] = nx; }
        const unsigned old = xb_add(&bar[XB_XSUB(b.x)], 1u);
        const unsigned gen = old / nloc;
        if (old + 1u == (gen + 1u) * nloc) {
            __builtin_amdgcn_fence(__ATOMIC_RELEASE, "agent");
            asm volatile("s_waitcnt vmcnt(0)" ::: "memory");
            const unsigned og = xb_add(&bar[XB_TOP], 1u);
            const unsigned tg = og / nx;
            if (og + 1u == (tg + 1u) * nx) xb_add(&bar[XB_TOPGEN], 1u);
            else XB_SPIN(xb_ld(&bar[XB_TOPGEN]) == tg, bar);
            __builtin_amdgcn_fence(__ATOMIC_ACQUIRE, "agent");
            xb_add(&bar[XB_XGEN(b.x)], 1u);
            asm volatile("s_waitcnt vmcnt(0)" ::: "memory");
        } else {
            XB_SPIN(xb_ld(&bar[XB_XGEN(b.x)]) == gen, bar);
            __builtin_amdgcn_fence(__ATOMIC_ACQUIRE, "agent");
            asm volatile("s_waitcnt vmcnt(0)" ::: "memory");
        }
    }
    __syncthreads();
}

namespace pg8 {
constexpr int BM = 256, BK = 64, HALF = 128, HTB = HALF * BK * 2, STAGE_BYTES = 8 * HTB, NXCD = 8, WGM = 8;
__host__ __device__ __forceinline__ int lds_byte(int r, int c) { const int st = (r >> 4) * 2 + (c >> 5), rr = r & 15, cc = c & 31, ob = rr * 64 + cc * 2; return st * 1024 + (ob ^ (((ob >> 9) & 1) << 5)); }
__host__ __device__ __forceinline__ void stage_rc(int b, int& R, int& C) { const int st = b / 1024, sb = b % 1024, swz = sb ^ (((sb >> 9) & 1) << 5); R = (st >> 1) * 16 + swz / 64; C = (st & 1) * 32 + (swz % 64) / 2; }
__host__ __device__ __forceinline__ int perm32(int rho) { const int n = rho >> 4, i = rho & 15; return 8 * (i >> 2) + 4 * n + (i & 3); }

struct Unit { int pm, pn, br; const char* A; const char* B; };

__device__ __forceinline__ bool tile_of(int L, int nM, int nN, int& pm, int& pn) {
    const int nwg = nM * nN; if (L >= nwg) return false;
    int wgid = L; { const int q = nwg / NXCD, r = nwg % NXCD, xcd = wgid % NXCD, off = wgid / NXCD; wgid = (xcd < r ? xcd * (q + 1) : r * (q + 1) + (xcd - r) * q) + off; }
    const int nig = WGM * nN, gid = wgid / nig, fm = gid * WGM, gsz = (nM - fm) < WGM ? (nM - fm) : WGM;
    pm = fm + ((wgid % nig) % gsz); pn = (wgid % nig) / gsz; return true;
}
struct PlainOrder {
    const char* A; const char* Bt; int nM, nN, G, c; size_t tstep;
    __device__ __forceinline__ void init(const void* A_, const void* Bt_, int M, int N, int K, int G_, int c_) { A = (const char*)A_; Bt = (const char*)Bt_; nM = M / BM; nN = N / BM; G = G_; c = c_; tstep = (size_t)BM * K * 2; }
    __device__ __forceinline__ bool next(int i, Unit& u) const {
        int pm, pn; if (!tile_of(i * G + c, nM, nN, pm, pn)) return false;
        u.pm = pm; u.pn = pn; u.br = 0; u.A = A + (size_t)pm * tstep; u.B = Bt + (size_t)pn * tstep; return true;
    }
};
struct BranchOrder {
    const char* T8; const char* WA; int nM, nN, G, c; size_t tstep;
    __device__ __forceinline__ bool next(int i, Unit& u) const {
        const int tl = i / 3, br = i - 3 * tl; int pm, pn; if (!tile_of(tl * G + c, nM, nN, pm, pn)) return false;
        u.pm = pm; u.pn = pn; u.br = br;
        const int ti = 1 + 4 * (br == 1) + (br == 2);
        u.A = T8 + (size_t)ti * SZ_A + (size_t)pm * tstep; u.B = WA + (size_t)br * SZ_W + (size_t)pn * tstep; return true;
    }
};

template <class Epi, class Sched>
__device__ __forceinline__ void gemm_phase(LAS unsigned char* lds, const int K, const Sched& S, const Epi& E) {
    const int tid = tid_fresh(), wid = __builtin_amdgcn_readfirstlane(tid >> 6), lane = tid & 63, wr = wid >> 2, wc = wid & 3, fr = lane & 15, fq = lane >> 4;
    const int nt = K / BK;
    unsigned voffA[2], voffB[2];
#pragma unroll
    for (int i = 0; i < 2; ++i) { int R, C; stage_rc(tid * 16 + i * 8192, R, C); const int Rb = Epi::PERM ? ((R & ~31) + perm32(R & 31)) : R;
        voffA[i] = (unsigned)(R * K + C) * 2u; voffB[i] = (unsigned)(Rb * K + C) * 2u; }
    const size_t kstep = (size_t)(BK * 2);
    const size_t hstep = (size_t)HALF * K * 2;
    const unsigned ldsw = (unsigned)wid * 1024u;
    const int aoff = lds_byte(wr * 64 + fr, fq * 8), boff = lds_byte(wc * 32 + fr, fq * 8);
#define PG8_SA(b, h) (((b) * 2 + (h)) * HTB)
#define PG8_SB(b, h) ((4 + (b) * 2 + (h)) * HTB)
#define PG8_STAGE(bufoff, gbase, voff) do { _Pragma("unroll") for (int _i = 0; _i < 2; ++_i) \
        __builtin_amdgcn_global_load_lds((const unsigned*)((const char*)(gbase) + (voff)[_i]), (LAS unsigned*)(lds + (bufoff) + ldsw + _i * 8192), 16, 0, 0); } while (0)
#define PG8_LDA(dst, b, h) do { _Pragma("unroll") for (int m = 0; m < 4; ++m) _Pragma("unroll") for (int k = 0; k < 2; ++k) dst[m][k] = *(const LAS bf16x8*)(lds + PG8_SA(b, h) + aoff + m * 2048 + k * 1024); } while (0)
#define PG8_LDB(dst, b, h) do { _Pragma("unroll") for (int n = 0; n < 2; ++n) _Pragma("unroll") for (int k = 0; k < 2; ++k) dst[n][k] = *(const LAS bf16x8*)(lds + PG8_SB(b, h) + boff + n * 2048 + k * 1024); } while (0)
#define PG8_MMA(ai, bj, At, Bt) do { __builtin_amdgcn_s_setprio(1); _Pragma("unroll") for (int m = 0; m < 4; ++m) _Pragma("unroll") for (int n = 0; n < 2; ++n) _Pragma("unroll") for (int k = 0; k < 2; ++k) \
        acc[ai][bj][m][n] = __builtin_amdgcn_mfma_f32_16x16x32_bf16(Bt[n][k], At[m][k], acc[ai][bj][m][n], 0, 0, 0); __builtin_amdgcn_s_setprio(0); } while (0)
#define PG8_WAIT_V(n) asm volatile("s_waitcnt vmcnt(" #n ")" ::: "memory")
#define PG8_WAIT_L(n) asm volatile("s_waitcnt lgkmcnt(" #n ")" ::: "memory")
#define PG8_BAR __builtin_amdgcn_s_barrier()
#define PG8_SCHED __builtin_amdgcn_sched_barrier(0)
    Unit cur, nxt; int ui = 0;
    if (!S.next(0, cur)) return;
    f32x4 acc[2][2][4][2];
#pragma unroll
    for (int a = 0; a < 2; ++a)
#pragma unroll
        for (int b = 0; b < 2; ++b)
#pragma unroll
            for (int m = 0; m < 4; ++m)
#pragma unroll
                for (int n = 0; n < 2; ++n) acc[a][b][m][n] = (f32x4){0.f, 0.f, 0.f, 0.f};
    bf16x8 At[4][2], B0[2][2], B1[2][2];
    const char* cA = cur.A; const char* cB = cur.B;
    PG8_STAGE(PG8_SB(0, 0), cB, voffB); PG8_STAGE(PG8_SA(0, 0), cA, voffA); PG8_STAGE(PG8_SB(0, 1), cB + hstep, voffB); PG8_STAGE(PG8_SA(0, 1), cA + hstep, voffA);
    if (wr == 1) PG8_BAR;
    PG8_WAIT_V(4); PG8_BAR;
    PG8_STAGE(PG8_SB(1, 0), cB + kstep, voffB); PG8_STAGE(PG8_SA(1, 0), cA + kstep, voffA); PG8_STAGE(PG8_SB(1, 1), cB + hstep + kstep, voffB);
    PG8_WAIT_V(6); PG8_BAR;
    for (;;) {
        const bool has_next = S.next(ui + 1, nxt);
        const char* nA = has_next ? nxt.A : cA; const char* nB = has_next ? nxt.B : cB;
        for (int t = 0; t < nt; t += 2) {
            const bool last = (t == nt - 2);
            const char* a1 = cA + (size_t)(t + 1) * kstep;
            const char* a2 = last ? nA : cA + (size_t)(t + 2) * kstep; const char* b2 = last ? nB : cB + (size_t)(t + 2) * kstep;
            const char* a3 = a2 + kstep; const char* b3 = b2 + kstep;
            PG8_LDB(B0, 0, 0); PG8_SCHED; PG8_LDA(At, 0, 0); PG8_STAGE(PG8_SA(1, 1), a1 + hstep, voffA);
            PG8_WAIT_L(8); PG8_BAR; PG8_WAIT_L(0); PG8_MMA(0, 0, At, B0); PG8_BAR; PG8_SCHED;
            PG8_LDB(B1, 0, 1); PG8_STAGE(PG8_SB(0, 0), b2, voffB);
            PG8_BAR; PG8_WAIT_L(0); PG8_MMA(0, 1, At, B1); PG8_BAR;
            PG8_LDA(At, 0, 1); PG8_STAGE(PG8_SA(0, 0), a2, voffA);
            PG8_BAR; PG8_WAIT_L(0); PG8_MMA(1, 0, At, B0); PG8_BAR; PG8_SCHED;
            PG8_STAGE(PG8_SB(0, 1), b2 + hstep, voffB);
            PG8_WAIT_V(6); PG8_BAR; PG8_MMA(1, 1, At, B1); PG8_BAR;
            PG8_LDB(B0, 1, 0); PG8_SCHED; PG8_LDA(At, 1, 0); PG8_STAGE(PG8_SA(0, 1), a2 + hstep, voffA);
            PG8_WAIT_L(8); PG8_BAR; PG8_WAIT_L(0); PG8_MMA(0, 0, At, B0); PG8_BAR; PG8_SCHED;
            PG8_LDB(B1, 1, 1); PG8_STAGE(PG8_SB(1, 0), b3, voffB);
            PG8_BAR; PG8_WAIT_L(0); PG8_MMA(0, 1, At, B1); PG8_BAR;
            PG8_LDA(At, 1, 1); PG8_STAGE(PG8_SA(1, 0), a3, voffA);
            PG8_BAR; PG8_WAIT_L(0); PG8_MMA(1, 0, At, B0); PG8_BAR; PG8_SCHED;
            PG8_STAGE(PG8_SB(1, 1), b3 + hstep, voffB);
            PG8_WAIT_V(6); PG8_BAR; PG8_MMA(1, 1, At, B1); PG8_BAR;
        }
        E(acc, cur, wr, wc, fr, fq);
        if (!has_next) break;
#pragma unroll
        for (int a = 0; a < 2; ++a)
#pragma unroll
            for (int b = 0; b < 2; ++b)
#pragma unroll
                for (int m = 0; m < 4; ++m)
#pragma unroll
                    for (int n = 0; n < 2; ++n) acc[a][b][m][n] = (f32x4){0.f, 0.f, 0.f, 0.f};
        cur = nxt; cA = nA; cB = nB; ++ui;
    }
    PG8_WAIT_V(0);
    if (wr == 0) PG8_BAR;
    PG8_BAR;
#undef PG8_SA
#undef PG8_SB
#undef PG8_STAGE
#undef PG8_LDA
#undef PG8_LDB
#undef PG8_MMA
#undef PG8_WAIT_V
#undef PG8_WAIT_L
#undef PG8_BAR
#undef PG8_SCHED
}

template <int LD>
__device__ __forceinline__ void store_tile_bf16(const f32x4 (&acc)[2][2][4][2], bf16_t* base  , int wr, int wc, int fr, int fq) {
    bf16_t* lp = base + (size_t)(wr * 64 + fr) * LD + wc * 32 + 8 * fq;
#pragma unroll
    for (int ai = 0; ai < 2; ++ai)
#pragma unroll
        for (int m = 0; m < 4; ++m) { bf16_t* rowp = lp + (size_t)(ai * HALF + m * 16) * LD;
#pragma unroll
            for (int bj = 0; bj < 2; ++bj) { const f32x4 v0 = acc[ai][bj][m][0], v1 = acc[ai][bj][m][1];
                u32x4 w; w.x = pk2(v0[0], v0[1]); w.y = pk2(v0[2], v0[3]); w.z = pk2(v1[0], v1[1]); w.w = pk2(v1[2], v1[3]);
                *(u32x4*)(rowp + bj * HALF) = w; } }
}
struct EpiProj {
    static constexpr bool PERM = true;
    unsigned char* ws;
    __device__ __forceinline__ void operator()(const f32x4 (&acc)[2][2][4][2], const Unit& u, int wr, int wc, int fr, int fq) const {
        const int pn = u.pn;
        if (pn < 8) { bf16_t* base = (bf16_t*)(ws + (pn < 4 ? WS_PQ : WS_PK)) + (size_t)(u.pm * BM) * 1024 + (pn & 3) * 256; store_tile_bf16<1024>(acc, base, wr, wc, fr, fq); }
        else if (pn < 72) { const int t = (pn - 8) >> 3; bf16_t* base = (bf16_t*)(ws + WS_T8 + (size_t)t * SZ_A) + (size_t)(u.pm * BM) * 2048 + ((pn - 8) & 7) * 256; store_tile_bf16<2048>(acc, base, wr, wc, fr, fq); }
        else { bf16_t* base = (bf16_t*)(ws + WS_GT) + (size_t)(u.pm * BM) * 6144 + (pn - 72) * 256; store_tile_bf16<6144>(acc, base, wr, wc, fr, fq); }
    }
};
struct EpiBf {
    static constexpr bool PERM = true;
    bf16_t* O; int ld;
    __device__ __forceinline__ void operator()(const f32x4 (&acc)[2][2][4][2], const Unit& u, int wr, int wc, int fr, int fq) const {
        const int row0 = u.pm * BM + wr * 64 + fr, col0 = u.pn * BM + wc * 32 + 8 * fq;
#pragma unroll
        for (int ai = 0; ai < 2; ++ai)
#pragma unroll
            for (int m = 0; m < 4; ++m) { bf16_t* rowp = O + (size_t)(row0 + ai * HALF + m * 16) * ld + col0;
#pragma unroll
                for (int bj = 0; bj < 2; ++bj) { const f32x4 v0 = acc[ai][bj][m][0], v1 = acc[ai][bj][m][1];
                    u32x4 w; w.x = pk2(v0[0], v0[1]); w.y = pk2(v0[2], v0[3]); w.z = pk2(v1[0], v1[1]); w.w = pk2(v1[2], v1[3]);
                    *(u32x4*)(rowp + bj * HALF) = w; } }
    }
};
struct EpiMerge {
    static constexpr bool PERM = true;
    bf16_t* Y; const bf16_t* GT;
    __device__ __forceinline__ void operator()(const f32x4 (&acc)[2][2][4][2], const Unit& u, int wr, int wc, int fr, int fq) const {
        const int row0 = u.pm * BM + wr * 64 + fr, col0 = u.pn * BM + wc * 32 + 8 * fq;
#pragma unroll
        for (int ai = 0; ai < 2; ++ai)
#pragma unroll
            for (int m = 0; m < 4; ++m) { const size_t r = (size_t)(row0 + ai * HALF + m * 16);
                bf16_t* rowp = Y + r * 2048 + col0; const bf16_t* gp = GT + r * 6144 + (size_t)u.br * 2048 + col0;
#pragma unroll
                for (int bj = 0; bj < 2; ++bj) { const f32x4 v0 = acc[ai][bj][m][0], v1 = acc[ai][bj][m][1];
                    const u32x4 g = *(const u32x4*)(gp + bj * HALF);
                    const float ab = ((ABL >> u.br) & 1) ? 0.f : 1.f;
                    float o[8];
                    o[0] = ab * sigmoidf_(bflo(g.x)) * v0[0]; o[1] = ab * sigmoidf_(bfhi(g.x)) * v0[1]; o[2] = ab * sigmoidf_(bflo(g.y)) * v0[2]; o[3] = ab * sigmoidf_(bfhi(g.y)) * v0[3];
                    o[4] = ab * sigmoidf_(bflo(g.z)) * v1[0]; o[5] = ab * sigmoidf_(bfhi(g.z)) * v1[1]; o[6] = ab * sigmoidf_(bflo(g.w)) * v1[2]; o[7] = ab * sigmoidf_(bfhi(g.w)) * v1[3];
                    if (u.br != 0) { const u32x4 y = *(const u32x4*)(rowp + bj * HALF);
                        o[0] += bflo(y.x); o[1] += bfhi(y.x); o[2] += bflo(y.y); o[3] += bfhi(y.y); o[4] += bflo(y.z); o[5] += bfhi(y.z); o[6] += bflo(y.w); o[7] += bfhi(y.w); }
                    u32x4 w; w.x = pk2(o[0], o[1]); w.y = pk2(o[2], o[3]); w.z = pk2(o[4], o[5]); w.w = pk2(o[6], o[7]);
                    *(u32x4*)(rowp + bj * HALF) = w; } }
    }
};
struct EpiRes {
    static constexpr bool PERM = false;
    float* X; const float* mod;
    __device__ __forceinline__ void operator()(const f32x4 (&acc)[2][2][4][2], const Unit& u, int wr, int wc, int fr, int fq) const {
        const int row0 = u.pm * BM + wr * 64 + fr, col0 = u.pn * BM + wc * 32 + 4 * fq;
        const int which = (u.pm < 32) ? 0 : (u.pm < 64 ? 1 : 2);
        const float* mg = mod + (size_t)which * 12288 + 2 * 2048 + col0;
        f32x4 gv[2][2];
#pragma unroll
        for (int bj = 0; bj < 2; ++bj)
#pragma unroll
            for (int n = 0; n < 2; ++n) gv[bj][n] = *(const f32x4*)(mg + bj * HALF + n * 16);
#pragma unroll
        for (int ai = 0; ai < 2; ++ai)
#pragma unroll
            for (int m = 0; m < 4; ++m) { float* rowp = X + (size_t)(row0 + ai * HALF + m * 16) * 2048 + col0;
#pragma unroll
                for (int bj = 0; bj < 2; ++bj)
#pragma unroll
                    for (int n = 0; n < 2; ++n) { f32x4* q = (f32x4*)(rowp + bj * HALF + n * 16); *q = *q + gv[bj][n] * acc[ai][bj][m][n]; } }
    }
};
}

__device__ __forceinline__ int proj_src_col(int n) {
    if (n < 1024) return 7200 + n;
    if (n < 2048) return n - 1024;
    if (n < 4096) return 1024 + (n - 2048);
    if (n < 6144) return 8224 + (n - 4096);
    if (n < 8192) return 16416 + (n - 6144);
    if (n < 10240) return 3104 + (n - 8192);
    if (n < 12288) return 5152 + (n - 10240);
    if (n < 14336) return 10272 + (n - 12288);
    if (n < 16384) return 12320 + (n - 14336);
    if (n < 18432) return 14368 + (n - 16384);
    return 18464 + (n - 18432);
}
__device__ void phase_w(KP p, int l, LAS unsigned char* lds) {
    const int tid = tid_fresh(), G = gridDim.x, bid = blockIdx.x;
    unsigned char* ws = launder(p->ws);
    {
        LAS float* tile = (LAS float*)lds;
        const int NT_IN = NPROJ / 64;
        const int total = (NT_IN + 5 * 32) * 32;
        for (int t = bid; t < total; t += G) {
            const int ntile = t >> 5, kt = t & 31, k0 = kt * 64;
            const float* src; int ld; bf16_t* dst; float scale = 1.0f; int n0;
            if (ntile < NT_IN) { n0 = ntile * 64; src = p->w_in + (size_t)l * 2048 * PROJ_W + proj_src_col(n0); ld = PROJ_W; dst = (bf16_t*)(ws + WS_WIN) + (size_t)n0 * 2048; if (n0 < 1024) scale = 0.08838834764831845f; }
            else { const int mi = (ntile - NT_IN) >> 5; n0 = ((ntile - NT_IN) & 31) * 64;
                const float* m5 = mi == 0 ? p->w_a_out : mi == 1 ? p->w_b_out : mi == 2 ? p->w_c_out : mi == 3 ? p->w_out : p->peer_wq;
                src = m5 + (size_t)l * 2048 * 2048 + n0; ld = 2048; dst = (bf16_t*)(ws + WS_WA + (size_t)mi * SZ_W) + (size_t)n0 * 2048; }
            { const int kk = tid >> 4, n4 = (tid & 15) * 4;
#pragma unroll
              for (int h = 0; h < 2; ++h) { const f32x4 v = *(const f32x4*)(src + (size_t)(k0 + kk + 32 * h) * ld + n4);
                  LAS float* tp = tile + (kk + 32 * h) * 65 + n4; tp[0] = v[0]; tp[1] = v[1]; tp[2] = v[2]; tp[3] = v[3]; } }
            __syncthreads();
            { const int n = tid >> 3, k8 = (tid & 7) * 8; float v[8];
#pragma unroll
              for (int j = 0; j < 8; ++j) v[j] = tile[(k8 + j) * 65 + n] * scale;
              u32x4 w; w.x = pk2(v[0], v[1]); w.y = pk2(v[2], v[3]); w.z = pk2(v[4], v[5]); w.w = pk2(v[6], v[7]);
              *(u32x4*)(dst + (size_t)n * 2048 + k0 + k8) = w; }
            __syncthreads();
        }
    }
    const size_t gtid = (size_t)bid * NTHREADS + tid, gthreads = (size_t)G * NTHREADS;
    for (size_t i = gtid; i < 32 * 2048; i += gthreads) { const int n = (int)(i >> 11), k = (int)(i & 2047);
        ((bf16_t*)(ws + WS_WG))[i] = f2bf(p->w_in[(size_t)l * 2048 * PROJ_W + (size_t)k * PROJ_W + 3072 + n]); }
    {
        const float* su = p->peer_u + (size_t)l * 16384 * 2048; const float* sv = p->peer_v + (size_t)l * 16384 * 2048;
        bf16_t* du = (bf16_t*)(ws + WS_PU); bf16_t* dv = (bf16_t*)(ws + WS_PVW);
        const size_t n8 = (size_t)16384 * 2048 / 8;
        for (size_t i = gtid; i < n8; i += gthreads) {
            const f32x4 a = *(const f32x4*)(su + i * 8), b = *(const f32x4*)(su + i * 8 + 4);
            u32x4 w; w.x = pk2(a[0], a[1]); w.y = pk2(a[2], a[3]); w.z = pk2(b[0], b[1]); w.w = pk2(b[2], b[3]); *(u32x4*)(du + i * 8) = w;
            const f32x4 c = *(const f32x4*)(sv + i * 8), d = *(const f32x4*)(sv + i * 8 + 4);
            u32x4 z; z.x = pk2(c[0], c[1]); z.y = pk2(c[2], c[3]); z.z = pk2(d[0], d[1]); z.w = pk2(d[2], d[3]); *(u32x4*)(dv + i * 8) = z;
        }
        const float* sk = p->peer_keys + (size_t)l * 16 * 128 * 128; bf16_t* dk = (bf16_t*)(ws + WS_KEYS);
        for (size_t i = gtid; i < (size_t)16 * 128 * 128; i += gthreads) dk[i] = f2bf(sk[i]);
    }
    {
        float* mod = (float*)(ws + WS_MOD) + (size_t)l * 3 * 12288;
        const float* wa = p->w_ada + (size_t)l * 2048 * 12288; const float* ba = p->b_ada + (size_t)l * 12288;
        LAS float* part = (LAS float*)(lds + 32768);
        const int col = tid & 63, ks = tid >> 6;
        for (int t = bid; t < 256; t += G) {
            const int n = t * 48 + col;
            float a0 = 0.f, a1 = 0.f, a2 = 0.f;
            if (col < 48) {
                for (int k = ks * 256; k < ks * 256 + 256; ++k) {
                    const float w = wa[(size_t)k * 12288 + n];
                    const float c0 = p->c[k], c1 = p->c[2048 + k], c2 = p->c_ctx[k];
                    a0 += c0 * sigmoidf_(c0) * w; a1 += c1 * sigmoidf_(c1) * w; a2 += c2 * sigmoidf_(c2) * w;
                }
                part[(ks * 3 + 0) * 48 + col] = a0; part[(ks * 3 + 1) * 48 + col] = a1; part[(ks * 3 + 2) * 48 + col] = a2;
            }
            __syncthreads();
            if (tid < 144) { const int which = tid / 48, cc = tid - which * 48; float sacc = ba[t * 48 + cc];
#pragma unroll
                for (int q = 0; q < 8; ++q) sacc += part[(q * 3 + which) * 48 + cc];
                mod[(size_t)which * 12288 + t * 48 + cc] = sacc; }
            __syncthreads();
        }
    }
    if (l == 0) {
        float* X = (float*)(ws + WS_X);
        const size_t nl4 = (size_t)NLAT * 2048 / 4, nc4 = (size_t)NCTX * 2048 / 4;
        for (size_t i = gtid; i < nl4; i += gthreads) ((f32x4*)X)[i] = ((const f32x4*)p->x)[i];
        for (size_t i = gtid; i < nc4; i += gthreads) ((f32x4*)X)[nl4 + i] = ((const f32x4*)p->ctx)[i];
        float* tab = (float*)(ws + WS_TAB);
        for (size_t i = gtid; i < 4096; i += gthreads) { const int pos = (int)(i >> 5), j = (int)(i & 31);
            const float inv = powf(10000.0f, -(float)j / 32.0f); const float ang = (float)pos * inv;
            tab[i] = cosf(ang); tab[4096 + i] = sinf(ang); }
    }
}

__device__ void phase_norm(KP p, int l, int which_norm, int nrows) {
    const int tid = tid_fresh(); const int lane = tid & 63, gw = blockIdx.x * 8 + (tid >> 6), nw = gridDim.x * 8;
    unsigned char* ws = launder(p->ws);
    const float* X = (const float*)(ws + WS_X); bf16_t* XN = (bf16_t*)(ws + WS_XN);
    const float* mod = (const float*)(ws + WS_MOD) + (size_t)l * 3 * 12288;
    const float* g = p->norm_g + (size_t)(l * 2 + which_norm) * 2048;
    const int shift_c = which_norm ? 3 : 0, scale_c = which_norm ? 4 : 1;
    for (int row = gw; row < nrows; row += nw) {
        const int which = row < NLAT ? (row >> 13) : 2;
        const float* xr = X + (size_t)row * 2048; const float* mb = mod + (size_t)which * 12288;
        f32x4 v[8]; float ss = 0.f;
#pragma unroll
        for (int i = 0; i < 8; ++i) { v[i] = *(const f32x4*)(xr + i * 256 + lane * 4); ss += v[i][0] * v[i][0] + v[i][1] * v[i][1] + v[i][2] * v[i][2] + v[i][3] * v[i][3]; }
        ss = wave_sum(ss);
        const float rstd = rsqrtf(ss * (1.0f / 2048.0f) + EPSF);
#pragma unroll
        for (int i = 0; i < 8; ++i) { const int c = i * 256 + lane * 4;
            const f32x4 gg = *(const f32x4*)(g + c), sh = *(const f32x4*)(mb + shift_c * 2048 + c), sc = *(const f32x4*)(mb + scale_c * 2048 + c);
            float o[4];
#pragma unroll
            for (int j = 0; j < 4; ++j) o[j] = v[i][j] * rstd * gg[j] * (1.0f + sc[j]) + sh[j];
            u32x2 w; w.x = pk2(o[0], o[1]); w.y = pk2(o[2], o[3]); *(u32x2*)(XN + (size_t)row * 2048 + c) = w; }
    }
}

__device__ void phase_gates_gemm(KP p, int l) {
    const int tid = tid_fresh(); const int lane = tid & 63, gw = blockIdx.x * 8 + (tid >> 6), nw = gridDim.x * 8;
    unsigned char* ws = launder(p->ws);
    const bf16_t* XN = (const bf16_t*)(ws + WS_XN); const bf16_t* WG = (const bf16_t*)(ws + WS_WG); float* GA = (float*)(ws + WS_GATES);
    const int q4 = lane >> 4, c = lane & 15;
    const float gb0 = p->a_gate_b[l * 32 + c], gb1 = p->a_gate_b[l * 32 + 16 + c];
    for (int task = gw; task < MR / 16; task += nw) {
        const int r0 = task * 16;
        f32x4 acc0 = {0.f, 0.f, 0.f, 0.f}, acc1 = {0.f, 0.f, 0.f, 0.f};
        const bf16_t* ap = XN + (size_t)(r0 + c) * 2048 + 8 * q4; const bf16_t* b0 = WG + (size_t)c * 2048 + 8 * q4; const bf16_t* b1 = b0 + 16 * 2048;
#pragma unroll 4
        for (int ks = 0; ks < 64; ++ks) { const bf16x8 a = *(const bf16x8*)(ap + ks * 32), x0 = *(const bf16x8*)(b0 + ks * 32), x1 = *(const bf16x8*)(b1 + ks * 32);
            acc0 = mfma16(a, x0, acc0); acc1 = mfma16(a, x1, acc1); }
#pragma unroll
        for (int r = 0; r < 4; ++r) {
            const float v0 = acc0[r] + gb0, v1 = acc1[r] + gb1;
            GA[(size_t)(r0 + 4 * q4 + r) * 32 + c] = (c >= 8) ? logsigmoidf_(v0) : v0; GA[(size_t)(r0 + 4 * q4 + r) * 32 + 16 + c] = (c >= 8) ? logsigmoidf_(v1) : v1; }
    }
}

__device__ void phase_e1(KP p, int l) {
    const int tid = tid_fresh(); const int lane = tid & 63, gw = blockIdx.x * 8 + (tid >> 6), nw = gridDim.x * 8;
    unsigned char* ws = launder(p->ws);
    bf16_t* PQ = (bf16_t*)(ws + WS_PQ); bf16_t* PK = (bf16_t*)(ws + WS_PK); bf16_t* CQ = (bf16_t*)(ws + WS_CQ); bf16_t* CK = (bf16_t*)(ws + WS_CK);
    bf16_t* BB = (bf16_t*)(ws + WS_BB); const bf16_t* BC = (const bf16_t*)(ws + WS_BC); const bf16_t* BX = (const bf16_t*)(ws + WS_BX);
    float* GA = (float*)(ws + WS_GATES); const float* tab = (const float*)(ws + WS_TAB);
    const float* gq = p->c_qk_g + (size_t)(l * 2 + 0) * 128; const float* gk = p->c_qk_g + (size_t)(l * 2 + 1) * 128;
    const float* cw = p->b_conv + (size_t)l * 3 * 2048;
    float gqv[8], gkv[8];
#pragma unroll
    for (int j = 0; j < 8; ++j) { gqv[j] = gq[(lane & 15) * 8 + j] * 0.08838834764831845f; gkv[j] = gk[(lane & 15) * 8 + j]; }
    for (int row = gw; row < MR; row += nw) {
        if (row < NLAT) {
            const int s = row & 8191, gr = s >> 6, gc = s & 63;
#pragma unroll
            for (int it = 0; it < 2; ++it) {
                const int unit = it * 64 + lane, h = unit >> 4, hf = (unit >> 3) & 1, j4 = unit & 7;
                const int off = h * 128 + hf * 64 + j4 * 4, pos = hf ? gc : gr;
                const f32x4 cs = *(const f32x4*)(tab + pos * 32 + j4 * 4), sn = *(const f32x4*)(tab + 4096 + pos * 32 + j4 * 4);
#pragma unroll
                for (int tsel = 0; tsel < 2; ++tsel) { bf16_t* T = (tsel ? PK : PQ) + (size_t)row * 1024 + off;
                    const u32x2 u1 = *(const u32x2*)T, u2 = *(const u32x2*)(T + 32);
                    const float a0 = bflo(u1.x), a1 = bfhi(u1.x), a2 = bflo(u1.y), a3 = bfhi(u1.y), b0 = bflo(u2.x), b1 = bfhi(u2.x), b2 = bflo(u2.y), b3 = bfhi(u2.y);
                    u32x2 o1, o2;
                    o1.x = pk2(a0 * cs[0] - b0 * sn[0], a1 * cs[1] - b1 * sn[1]); o1.y = pk2(a2 * cs[2] - b2 * sn[2], a3 * cs[3] - b3 * sn[3]);
                    o2.x = pk2(b0 * cs[0] + a0 * sn[0], b1 * cs[1] + a1 * sn[1]); o2.y = pk2(b2 * cs[2] + a2 * sn[2], b3 * cs[3] + a3 * sn[3]);
                    *(u32x2*)T = o1; *(u32x2*)(T + 32) = o2; }
            }
        }
#pragma unroll
        for (int tsel = 0; tsel < 2; ++tsel) {
            bf16_t* T = (tsel ? CK : CQ) + (size_t)row * 2048;
#pragma unroll
            for (int ps = 0; ps < 4; ++ps) {
                const u32x4 w = *(const u32x4*)(T + ps * 512 + lane * 8);
                float v[8] = {bflo(w.x), bfhi(w.x), bflo(w.y), bfhi(w.y), bflo(w.z), bfhi(w.z), bflo(w.w), bfhi(w.w)};
                float ss = 0.f;
#pragma unroll
                for (int j = 0; j < 8; ++j) ss += v[j] * v[j];
                ss += __shfl_xor(ss, 1); ss += __shfl_xor(ss, 2); ss += __shfl_xor(ss, 4); ss += __shfl_xor(ss, 8);
                const float rstd = rsqrtf(ss * (1.0f / 128.0f) + EPSF);
#pragma unroll
                for (int j = 0; j < 8; ++j) v[j] = v[j] * rstd * (tsel ? gkv[j] : gqv[j]);
                u32x4 o; o.x = pk2(v[0], v[1]); o.y = pk2(v[2], v[3]); o.z = pk2(v[4], v[5]); o.w = pk2(v[6], v[7]);
                *(u32x4*)(T + ps * 512 + lane * 8) = o;
            }
        }
        {
            int pos, len; if (row < NLAT) { pos = row & 8191; len = SEQ; } else { pos = (row - NLAT) & 255; len = CTXL; }
            const bool hp = pos > 0, hn = pos < len - 1;
#pragma unroll
            for (int ps = 0; ps < 4; ++ps) {
                const int c = ps * 512 + lane * 8; const size_t o = (size_t)row * 2048 + c;
                const u32x4 bb = *(const u32x4*)(BB + o), c1 = *(const u32x4*)(BC + o), x1 = *(const u32x4*)(BX + o);
                u32x4 c0 = {0u, 0u, 0u, 0u}, x0 = c0, c2 = c0, x2 = c0;
                if (hp) { c0 = *(const u32x4*)(BC + o - 2048); x0 = *(const u32x4*)(BX + o - 2048); }
                if (hn) { c2 = *(const u32x4*)(BC + o + 2048); x2 = *(const u32x4*)(BX + o + 2048); }
                const unsigned bw[4] = {bb.x, bb.y, bb.z, bb.w}, c0w[4] = {c0.x, c0.y, c0.z, c0.w}, c1w[4] = {c1.x, c1.y, c1.z, c1.w}, c2w[4] = {c2.x, c2.y, c2.z, c2.w};
                const unsigned x0w[4] = {x0.x, x0.y, x0.z, x0.w}, x1w[4] = {x1.x, x1.y, x1.z, x1.w}, x2w[4] = {x2.x, x2.y, x2.z, x2.w};
                unsigned ow[4];
#pragma unroll
                for (int q = 0; q < 4; ++q) {
                    const int cc = c + 2 * q;
                    const float w00 = cw[cc], w01 = cw[cc + 1], w10 = cw[2048 + cc], w11 = cw[2048 + cc + 1], w20 = cw[4096 + cc], w21 = cw[4096 + cc + 1];
                    const float ylo = bflo(bw[q]) * (bflo(c0w[q]) * bflo(x0w[q]) * w00 + bflo(c1w[q]) * bflo(x1w[q]) * w10 + bflo(c2w[q]) * bflo(x2w[q]) * w20);
                    const float yhi = bfhi(bw[q]) * (bfhi(c0w[q]) * bfhi(x0w[q]) * w01 + bfhi(c1w[q]) * bfhi(x1w[q]) * w11 + bfhi(c2w[q]) * bfhi(x2w[q]) * w21);
                    ow[q] = pk2(ylo, yhi);
                }
                u32x4 ov; ov.x = ow[0]; ov.y = ow[1]; ov.z = ow[2]; ov.w = ow[3];
                *(u32x4*)(BB + o) = ov;
            }
        }
    }
}

constexpr int ML_QS = 0, ML_KS = 17408, ML_KET = 34816, ML_VT = 53248, ML_SS = 60160, ML_CT = 69376, ML_CTSZ = 13056;
__device__ __forceinline__ int ml_row(int pp, int b, int dir) {
    if (pp < 256) { const int j = dir ? 255 - pp : pp; return NLAT + b * 256 + j; }
    int s = pp - 256; if (dir) s = 8191 - s; return b * 8192 + s;
}
__device__ void phase_mlstm(KP p, int l, LAS unsigned char* lds) {
    const int tid = tid_fresh(), lane = tid & 63, w = __builtin_amdgcn_readfirstlane(tid >> 6), q4 = lane >> 4, c16 = lane & 15;
    unsigned char* ws = launder(p->ws);
    const bf16_t* PQ = (const bf16_t*)(ws + WS_PQ); const bf16_t* PK = (const bf16_t*)(ws + WS_PK); const bf16_t* PV = (const bf16_t*)(ws + WS_PV);
    const float* GA = (const float*)(ws + WS_GATES);
    for (int task = blockIdx.x; task < 256; task += gridDim.x) {
        const int xq = task & 7, yq = task >> 3; const int bh = 2 * xq + (yq >> 4), dir = (yq >> 3) & 1, sl = yq & 7; const int b = bh >> 3, h = bh & 7;
        bf16_t* H = (bf16_t*)(ws + (dir ? WS_BX : WS_BC));
        __syncthreads();
        for (int i = tid; i < 16 * 32; i += NTHREADS) { const int r = 32 + (i >> 5), cdw = i & 31; *(LAS unsigned*)(lds + ML_VT + r * 144 + cdw * 4) = (r == 32) ? 0x3f803f80u : 0u; }
        for (int i = tid; i < 2 * ML_CTSZ / 4; i += NTHREADS) *(LAS unsigned*)(lds + ML_CT + i * 4) = 0u;
        float m = 0.f;
        f32x4 Cst[3];
#pragma unroll
        for (int i = 0; i < 3; ++i) Cst[i] = (f32x4){0.f, 0.f, 0.f, 0.f};
        u32x4 qreg[2], kreg[2], vreg; float li, lf;
        { const int r = ml_row(lane, b, dir);
#pragma unroll
          for (int i = 0; i < 2; ++i) { qreg[i] = *(const u32x4*)(PQ + (size_t)r * 1024 + h * 128 + (w * 2 + i) * 8); kreg[i] = *(const u32x4*)(PK + (size_t)r * 1024 + h * 128 + (w * 2 + i) * 8); }
          if (w < 4) vreg = *(const u32x4*)(PV + (size_t)r * 2048 + h * 256 + sl * 32 + w * 8);
          li = GA[(size_t)r * 32 + (2 * dir) * 8 + h]; lf = GA[(size_t)r * 32 + (2 * dir + 1) * 8 + h]; }
        for (int c = 0; c < 132; ++c) {
            float bc = lf;
#pragma unroll
            for (int o = 1; o < 64; o <<= 1) { const float t = __shfl_up(bc, o); if (lane >= o) bc += t; }
            const float a = li - bc;
            float pm = a;
#pragma unroll
            for (int o = 1; o < 64; o <<= 1) { const float t = __shfl_up(pm, o); if (lane >= o) pm = fmaxf(pm, t); }
            const float total = __shfl(bc, 63), pmall = __shfl(pm, 63);
            const float mx = fmaxf(m, pm);
            const float mrow = bc + mx;
            const float winter = __expf(m - mx);
            const float m_new = total + fmaxf(m, pmall);
            const float decay = __expf(total + m - m_new);
            const float kscale = __expf(total + a - m_new);
#pragma unroll
            for (int i = 0; i < 2; ++i) {
                *(LAS u32x4*)(lds + ML_QS + lane * 272 + (w * 2 + i) * 16) = qreg[i];
                *(LAS u32x4*)(lds + ML_KS + lane * 272 + (w * 2 + i) * 16) = kreg[i];
                const unsigned kw[4] = {kreg[i].x, kreg[i].y, kreg[i].z, kreg[i].w};
#pragma unroll
                for (int j = 0; j < 4; ++j) { const int d = (w * 2 + i) * 8 + 2 * j;
                    *(LAS bf16_t*)(lds + ML_KET + d * 144 + lane * 2) = f2bf(bflo(kw[j]) * kscale);
                    *(LAS bf16_t*)(lds + ML_KET + (d + 1) * 144 + lane * 2) = f2bf(bfhi(kw[j]) * kscale); }
            }
            if (w < 4) { const unsigned vw[4] = {vreg.x, vreg.y, vreg.z, vreg.w};
#pragma unroll
                for (int j = 0; j < 4; ++j) { const int e = w * 8 + 2 * j;
                    *(LAS bf16_t*)(lds + ML_VT + e * 144 + lane * 2) = (bf16_t)(vw[j] & 0xffffu);
                    *(LAS bf16_t*)(lds + ML_VT + (e + 1) * 144 + lane * 2) = (bf16_t)(vw[j] >> 16); } }
            if (c + 1 < 132) { const int r = ml_row((c + 1) * 64 + lane, b, dir);
#pragma unroll
                for (int i = 0; i < 2; ++i) { qreg[i] = *(const u32x4*)(PQ + (size_t)r * 1024 + h * 128 + (w * 2 + i) * 8); kreg[i] = *(const u32x4*)(PK + (size_t)r * 1024 + h * 128 + (w * 2 + i) * 8); }
                if (w < 4) vreg = *(const u32x4*)(PV + (size_t)r * 2048 + h * 256 + sl * 32 + w * 8);
                li = GA[(size_t)r * 32 + (2 * dir) * 8 + h]; lf = GA[(size_t)r * 32 + (2 * dir + 1) * 8 + h]; }
            __syncthreads();
            const int tr = w >> 1;
            bf16x8 aq[4];
#pragma unroll
            for (int ks = 0; ks < 4; ++ks) aq[ks] = *(const LAS bf16x8*)(lds + ML_QS + (16 * tr + c16) * 272 + (ks * 32 + 8 * q4) * 2);
            float nmx_t[4], wi_t[4], mrow_t[4];
#pragma unroll
            for (int r = 0; r < 4; ++r) { const int t = 16 * tr + 4 * q4 + r; nmx_t[r] = -__shfl(mx, t); wi_t[r] = __shfl(winter, t); mrow_t[r] = __shfl(mrow, t); }
#pragma unroll
            for (int tci = 0; tci < 2; ++tci) {
                const int tc = 2 * (w & 1) + tci;
                f32x4 acc = {0.f, 0.f, 0.f, 0.f};
#pragma unroll
                for (int ks = 0; ks < 4; ++ks) { const bf16x8 bk = *(const LAS bf16x8*)(lds + ML_KS + (16 * tc + c16) * 272 + (ks * 32 + 8 * q4) * 2); acc = mfma16(aq[ks], bk, acc); }
                const int scol = 16 * tc + c16; const float a_s = __shfl(a, scol);
#pragma unroll
                for (int r = 0; r < 4; ++r) { const int t = 16 * tr + 4 * q4 + r;
                    const float dv = (scol <= t) ? __expf(a_s + nmx_t[r]) : 0.f;
                    *(LAS bf16_t*)(lds + ML_SS + t * 144 + scol * 2) = f2bf(acc[r] * dv); }
            }
            __syncthreads();
            {
                const LAS unsigned char* CTc = lds + ML_CT + (c & 1) * ML_CTSZ;
                const int part = w & 1;
                bf16x8 as2[2];
#pragma unroll
                for (int k2 = 0; k2 < 2; ++k2) as2[k2] = *(const LAS bf16x8*)(lds + ML_SS + (16 * tr + c16) * 144 + (k2 * 32 + 8 * q4) * 2);
                f32x4 accA = {0.f, 0.f, 0.f, 0.f}, accD = {0.f, 0.f, 0.f, 0.f};
#pragma unroll
                for (int ks = 0; ks < 4; ++ks) {
                    const bf16x8 b1 = *(const LAS bf16x8*)(CTc + (16 * part + c16) * 272 + (ks * 32 + 8 * q4) * 2);
                    const bf16x8 b2 = *(const LAS bf16x8*)(CTc + (32 + c16) * 272 + (ks * 32 + 8 * q4) * 2);
                    accA = mfma16(aq[ks], b1, accA); accD = mfma16(aq[ks], b2, accD); }
#pragma unroll
                for (int r = 0; r < 4; ++r) { accA[r] *= wi_t[r]; accD[r] *= wi_t[r]; }
#pragma unroll
                for (int k2 = 0; k2 < 2; ++k2) {
                    const bf16x8 v1 = *(const LAS bf16x8*)(lds + ML_VT + (16 * part + c16) * 144 + (k2 * 32 + 8 * q4) * 2);
                    const bf16x8 v2 = *(const LAS bf16x8*)(lds + ML_VT + (32 + c16) * 144 + (k2 * 32 + 8 * q4) * 2);
                    accA = mfma16(as2[k2], v1, accA); accD = mfma16(as2[k2], v2, accD); }
                if (l == 0 || c >= 4) {
#pragma unroll
                    for (int r = 0; r < 4; ++r) {
                        const float den = __shfl(accD[r], lane & 48);
                        const float hv = accA[r] / fmaxf(fabsf(den), __expf(-mrow_t[r]));
                        const int t = 16 * tr + 4 * q4 + r; const int row = ml_row(c * 64 + t, b, dir);
                        H[(size_t)row * 2048 + h * 256 + sl * 32 + 16 * part + c16] = f2bf(hv);
                    }
                }
            }
            {
                LAS unsigned char* CTn = lds + ML_CT + ((c + 1) & 1) * ML_CTSZ;
                bf16x8 ak[2];
#pragma unroll
                for (int k2 = 0; k2 < 2; ++k2) ak[k2] = *(const LAS bf16x8*)(lds + ML_KET + (16 * w + c16) * 144 + (k2 * 32 + 8 * q4) * 2);
#pragma unroll
                for (int ct = 0; ct < 3; ++ct) {
                    Cst[ct] = Cst[ct] * decay;
#pragma unroll
                    for (int k2 = 0; k2 < 2; ++k2) { const bf16x8 bv = *(const LAS bf16x8*)(lds + ML_VT + (16 * ct + c16) * 144 + (k2 * 32 + 8 * q4) * 2); Cst[ct] = mfma16(ak[k2], bv, Cst[ct]); }
                    u32x2 o; o.x = pk2(Cst[ct][0], Cst[ct][1]); o.y = pk2(Cst[ct][2], Cst[ct][3]);
                    *(LAS u32x2*)(CTn + (16 * ct + c16) * 272 + (16 * w + 4 * q4) * 2) = o;
                }
            }
            m = m_new;
            __syncthreads();
        }
    }
}

constexpr int AT_KS = 0, AT_VT = 17408, AT_RPB = 35840;
__device__ void phase_attn(KP p, int l, LAS unsigned char* lds) {
    const int tid = tid_fresh(), lane = tid & 63, w = __builtin_amdgcn_readfirstlane(tid >> 6), q4 = lane >> 4, c16 = lane & 15;
    unsigned char* ws = launder(p->ws);
    bf16_t* CQ = (bf16_t*)(ws + WS_CQ); const bf16_t* CK = (const bf16_t*)(ws + WS_CK); const bf16_t* CV = (const bf16_t*)(ws + WS_CV);
    const int nunits = 2048 + (l == 0 ? 64 : 0);
    for (int u = blockIdx.x; u < nunits; u += gridDim.x) {
        int b, h, qrow = 0, g = 0, ntl = 0, r0a = 0, qbase;  bool is_ctx = u >= 2048;
        if (!is_ctx) { b = u >> 10; h = (u >> 6) & 15; const int rp = u & 63; qrow = 2 * rp + (w >> 2); g = w & 3;
            r0a = min(max(2 * rp - 4, 0), 120); const int r0b = min(max(2 * rp + 1 - 4, 0), 120); ntl = r0b + 8 - r0a;
            qbase = b * 8192 + qrow * 64 + 16 * g; }
        else { const int uu = u - 2048; b = uu >> 5; h = (uu >> 1) & 15; qbase = NLAT + b * 256 + (uu & 1) * 128 + 16 * w; }
        const int r0q = min(max(qrow - 4, 0), 120);
        const int a_g = (g == 0) ? 0 : (g == 1 ? 8 : (g == 2 ? 24 : 32));
        __syncthreads();
        if (!is_ctx) for (int i = tid; i < 465; i += NTHREADS) *(LAS float*)(lds + AT_RPB + i * 4) = p->c_rpb[((size_t)l * 16 + h) * 465 + i];
        bf16x8 qf[4];
#pragma unroll
        for (int ks = 0; ks < 4; ++ks) qf[ks] = *(const bf16x8*)(CQ + (size_t)(qbase + c16) * 2048 + h * 128 + ks * 32 + 8 * q4);
        f32x4 O[8];
#pragma unroll
        for (int i = 0; i < 8; ++i) O[i] = (f32x4){0.f, 0.f, 0.f, 0.f};
        float m_run = -1e30f, l_run = 0.f;
        const int ntiles = ntl + 4;
        u32x4 kreg[2], vreg[2];
        auto tile_row = [&](int t, int key) -> int { return (t < ntl) ? (b * 8192 + (r0a + t) * 64 + key) : (NLAT + b * 256 + (t - ntl) * 64 + key); };
        { const int r = tile_row(0, lane);
#pragma unroll
          for (int i = 0; i < 2; ++i) { kreg[i] = *(const u32x4*)(CK + (size_t)r * 2048 + h * 128 + (w * 2 + i) * 8); vreg[i] = *(const u32x4*)(CV + (size_t)r * 2048 + h * 128 + (w * 2 + i) * 8); } }
        for (int t = 0; t < ntiles; ++t) {
            __syncthreads();
#pragma unroll
            for (int i = 0; i < 2; ++i) {
                *(LAS u32x4*)(lds + AT_KS + lane * 272 + (w * 2 + i) * 16) = kreg[i];
                const unsigned vw[4] = {vreg[i].x, vreg[i].y, vreg[i].z, vreg[i].w};
#pragma unroll
                for (int j = 0; j < 4; ++j) { const int d = (w * 2 + i) * 8 + 2 * j;
                    *(LAS bf16_t*)(lds + AT_VT + d * 144 + lane * 2) = (bf16_t)(vw[j] & 0xffffu);
                    *(LAS bf16_t*)(lds + AT_VT + (d + 1) * 144 + lane * 2) = (bf16_t)(vw[j] >> 16); }
            }
            if (t + 1 < ntiles) { const int r = tile_row(t + 1, lane);
#pragma unroll
                for (int i = 0; i < 2; ++i) { kreg[i] = *(const u32x4*)(CK + (size_t)r * 2048 + h * 128 + (w * 2 + i) * 8); vreg[i] = *(const u32x4*)(CV + (size_t)r * 2048 + h * 128 + (w * 2 + i) * 8); } }
            __syncthreads();
            const bool local = t < ntl; const int kr = r0a + t;
            if (local && !(kr >= r0q && kr < r0q + 8)) continue;
            const int npass = local ? 1 : 2;
            for (int ps = 0; ps < npass; ++ps) {
                const int a0 = local ? a_g : ps * 32;
                f32x4 sc[2];
#pragma unroll
                for (int ct = 0; ct < 2; ++ct) { sc[ct] = (f32x4){0.f, 0.f, 0.f, 0.f};
#pragma unroll
                    for (int ks = 0; ks < 4; ++ks) { const bf16x8 ka = *(const LAS bf16x8*)(lds + AT_KS + (a0 + 16 * ct + c16) * 272 + (ks * 32 + 8 * q4) * 2); sc[ct] = mfma16(ka, qf[ks], sc[ct]); } }
                if (local) {
                    const int qc = 16 * g + c16, col0 = min(max(qc - 8, 0), 48); const int dr = kr - qrow + 7;
#pragma unroll
                    for (int ct = 0; ct < 2; ++ct)
#pragma unroll
                        for (int r = 0; r < 4; ++r) { const int kc = a0 + 16 * ct + 4 * q4 + r; const bool valid = (kc >= col0) && (kc < col0 + 16);
                            const int dc = min(max(kc - qc + 15, 0), 30);
                            const float bias = *(const LAS float*)(lds + AT_RPB + (dr * 31 + dc) * 4);
                            sc[ct][r] = valid ? sc[ct][r] + bias : -1e30f; }
                }
                float mx = fmaxf(fmaxf(fmaxf(sc[0][0], sc[0][1]), fmaxf(sc[0][2], sc[0][3])), fmaxf(fmaxf(sc[1][0], sc[1][1]), fmaxf(sc[1][2], sc[1][3])));
                mx = fmaxf(mx, __shfl_xor(mx, 16)); mx = fmaxf(mx, __shfl_xor(mx, 32));
                const float m_new = fmaxf(m_run, mx);
                const float alpha = __expf(m_run - m_new);
                float pe[8]; float psum = 0.f;
#pragma unroll
                for (int ct = 0; ct < 2; ++ct)
#pragma unroll
                    for (int r = 0; r < 4; ++r) { const float e = __expf(sc[ct][r] - m_new); pe[ct * 4 + r] = e; psum += e; }
                psum += __shfl_xor(psum, 16); psum += __shfl_xor(psum, 32);
                l_run = l_run * alpha + psum; m_run = m_new;
                bf16x8 pf; { u32x4 pw; pw.x = pk2(pe[0], pe[1]); pw.y = pk2(pe[2], pe[3]); pw.z = pk2(pe[4], pe[5]); pw.w = pk2(pe[6], pe[7]); pf = __builtin_bit_cast(bf16x8, pw); }
                float al[4];
#pragma unroll
                for (int r = 0; r < 4; ++r) al[r] = __shfl(alpha, 4 * q4 + r);
#pragma unroll
                for (int dt = 0; dt < 8; ++dt) {
#pragma unroll
                    for (int r = 0; r < 4; ++r) O[dt][r] *= al[r];
                    const u32x2 lo = *(const LAS u32x2*)(lds + AT_VT + (16 * dt + c16) * 144 + (a0 + 4 * q4) * 2);
                    const u32x2 hi = *(const LAS u32x2*)(lds + AT_VT + (16 * dt + c16) * 144 + (a0 + 16 + 4 * q4) * 2);
                    u32x4 bw; bw.x = lo.x; bw.y = lo.y; bw.z = hi.x; bw.w = hi.y;
                    O[dt] = mfma16(pf, __builtin_bit_cast(bf16x8, bw), O[dt]);
                }
            }
        }
        float linv[4];
#pragma unroll
        for (int r = 0; r < 4; ++r) linv[r] = 1.0f / __shfl(l_run, 4 * q4 + r);
#pragma unroll
        for (int dt = 0; dt < 8; ++dt)
#pragma unroll
            for (int r = 0; r < 4; ++r) CQ[(size_t)(qbase + 4 * q4 + r) * 2048 + h * 128 + 16 * dt + c16] = f2bf(O[dt][r] * linv[r]);
    }
}

__device__ void phase_e2(KP p, int l, int nrows) {
    const int tid = tid_fresh(); const int lane = tid & 63, gw = blockIdx.x * 8 + (tid >> 6), nw = gridDim.x * 8;
    unsigned char* ws = launder(p->ws);
    const bf16_t* HF = (const bf16_t*)(ws + WS_BC); const bf16_t* HB = (const bf16_t*)(ws + WS_BX); bf16_t* PO = (bf16_t*)(ws + WS_PO);
    const float* hg = p->a_hnorm_g + (size_t)l * 2048;
    for (int row = gw; row < nrows; row += nw) {
#pragma unroll
        for (int h = 0; h < 8; ++h) {
            const size_t o = (size_t)row * 2048 + h * 256 + lane * 4;
            const u32x2 f = *(const u32x2*)(HF + o), bb = *(const u32x2*)(HB + o), ov = *(const u32x2*)(PO + o);
            float v[4] = {bflo(f.x) + bflo(bb.x), bfhi(f.x) + bfhi(bb.x), bflo(f.y) + bflo(bb.y), bfhi(f.y) + bfhi(bb.y)};
            float ss = v[0] * v[0] + v[1] * v[1] + v[2] * v[2] + v[3] * v[3];
            ss = wave_sum(ss);
            const float rstd = rsqrtf(ss * (1.0f / 256.0f) + EPSF);
            const f32x4 gg = *(const f32x4*)(hg + h * 256 + lane * 4);
            const float og[4] = {bflo(ov.x), bfhi(ov.x), bflo(ov.y), bfhi(ov.y)};
            float y[4];
#pragma unroll
            for (int j = 0; j < 4; ++j) y[j] = sigmoidf_(og[j]) * v[j] * rstd * gg[j];
            u32x2 wv; wv.x = pk2(y[0], y[1]); wv.y = pk2(y[2], y[3]); *(u32x2*)(PO + o) = wv;
        }
    }
}

constexpr int PE_MAXT = 80;
constexpr int PE_IDX = 0, PE_W = PE_MAXT * 128 * 4, PE_SCR = 2 * PE_MAXT * 128 * 4, PE_SCRSZ = 16 * 132 * 4 + 4096 + 256;
__device__ __forceinline__ unsigned ordkey(float v) { const unsigned u = __float_as_uint(v); return (u & 0x80000000u) ? ~u : (u | 0x80000000u); }
__device__ void phase_peer(KP p, int l, LAS unsigned char* lds) {
    const int tid = tid_fresh(), lane = tid & 63, w = __builtin_amdgcn_readfirstlane(tid >> 6), q4 = lane >> 4, c16 = lane & 15;
    unsigned char* ws = launder(p->ws);
    const bf16_t* QP = (const bf16_t*)(ws + WS_PV); const bf16_t* KEYS = (const bf16_t*)(ws + WS_KEYS);
    const bf16_t* PU = (const bf16_t*)(ws + WS_PU); const bf16_t* PVW = (const bf16_t*)(ws + WS_PVW); const bf16_t* XN = (const bf16_t*)(ws + WS_XN);
    float* X = (float*)(ws + WS_X); const float* mod = (const float*)(ws + WS_MOD) + (size_t)l * 3 * 12288;
    const int ntok = (l == 0) ? MR : NLAT, G = gridDim.x;
    const int per = (ntok + G - 1) / G; const int t_begin = blockIdx.x * per, t_end = min(ntok, t_begin + per);
    for (int tb = t_begin; tb < t_end; tb += PE_MAXT) {
        const int nt = min(PE_MAXT, t_end - tb);
        __syncthreads();
        const int ntask = (nt + 15) >> 4;
        if (w < ntask) {
            LAS unsigned char* scr = lds + PE_SCR + w * PE_SCRSZ;
            LAS float* SC = (LAS float*)scr;
            LAS float* LS = (LAS float*)(scr + 16 * 132 * 4);
            LAS int* LI = (LAS int*)(scr + 16 * 132 * 4 + 2048);
            LAS unsigned char* PT = scr + 16 * 132 * 4 + 4096;
            if (lane < 52) {
                int cnt = 0, pa = 15, pb = 15;
                for (int a = 0; a < 16; ++a) { const int nb = 16 / (a + 1); for (int bb = 0; bb < nb; ++bb) { if (cnt == lane) { pa = a; pb = bb; } ++cnt; } }
                PT[lane * 2] = (unsigned char)pa; PT[lane * 2 + 1] = (unsigned char)pb;
            }
            const int tok_a = min(tb + 16 * w + c16, t_end - 1);
            const int tkl = lane >> 2, qq = lane & 3;
            for (int h = 0; h < 8; ++h) {
                for (int pp = 0; pp < 2; ++pp) {
                    const int hp = 2 * h + pp;
                    bf16x8 af[4];
#pragma unroll
                    for (int ks = 0; ks < 4; ++ks) af[ks] = *(const bf16x8*)(QP + (size_t)tok_a * 2048 + h * 256 + pp * 128 + ks * 32 + 8 * q4);
#pragma unroll
                    for (int ct = 0; ct < 8; ++ct) {
                        f32x4 acc = {0.f, 0.f, 0.f, 0.f};
#pragma unroll
                        for (int ks = 0; ks < 4; ++ks) { const bf16x8 bfr = *(const bf16x8*)(KEYS + ((size_t)hp * 128 + 16 * ct + c16) * 128 + ks * 32 + 8 * q4); acc = mfma16(af[ks], bfr, acc); }
#pragma unroll
                        for (int r = 0; r < 4; ++r) SC[(4 * q4 + r) * 132 + 16 * ct + c16] = acc[r];
                    }
                    asm volatile("s_waitcnt lgkmcnt(0)" ::: "memory");
                    unsigned key[32];
#pragma unroll
                    for (int i = 0; i < 8; ++i) { const f32x4 v = *(const LAS f32x4*)(SC + tkl * 132 + 32 * qq + 4 * i);
#pragma unroll
                        for (int j = 0; j < 4; ++j) key[4 * i + j] = (ordkey(v[j]) & ~127u) | (unsigned)(32 * qq + 4 * i + j); }
                    unsigned prev = 0xffffffffu;
#pragma unroll 1
                    for (int r = 0; r < 16; ++r) {
                        unsigned mxk = 0u;
#pragma unroll
                        for (int i = 0; i < 32; ++i) { const unsigned k = key[i] < prev ? key[i] : 0u; mxk = mxk > k ? mxk : k; }
                        unsigned o1 = __shfl_xor(mxk, 1); mxk = mxk > o1 ? mxk : o1; o1 = __shfl_xor(mxk, 2); mxk = mxk > o1 ? mxk : o1;
                        prev = mxk;
                        if (qq == (r & 3)) { const int idx = (int)(mxk & 127u); LS[(pp * 16 + tkl) * 16 + r] = SC[tkl * 132 + idx]; LI[(pp * 16 + tkl) * 16 + r] = idx; }
                    }
                    asm volatile("s_waitcnt lgkmcnt(0)" ::: "memory");
                }
                unsigned ck[13];
#pragma unroll
                for (int i = 0; i < 13; ++i) { const int cidx = qq + 4 * i;
                    if (cidx < 50) { const int a = PT[cidx * 2], bq = PT[cidx * 2 + 1]; const float sv = LS[(0 * 16 + tkl) * 16 + a] + LS[(1 * 16 + tkl) * 16 + bq]; ck[i] = (ordkey(sv) & ~63u) | (unsigned)cidx; }
                    else ck[i] = 0u; }
                unsigned prev = 0xffffffffu; float best0 = 0.f, esum = 0.f; float myexp[4] = {0.f, 0.f, 0.f, 0.f}; int myidx[4] = {0, 0, 0, 0};
#pragma unroll
                for (int r = 0; r < 16; ++r) {
                    unsigned mxk = 0u;
#pragma unroll
                    for (int i = 0; i < 13; ++i) { const unsigned k = ck[i] < prev ? ck[i] : 0u; mxk = mxk > k ? mxk : k; }
                    unsigned o1 = __shfl_xor(mxk, 1); mxk = mxk > o1 ? mxk : o1; o1 = __shfl_xor(mxk, 2); mxk = mxk > o1 ? mxk : o1;
                    prev = mxk;
                    const int cidx = (int)(mxk & 63u); const int a = PT[cidx * 2], bq = PT[cidx * 2 + 1];
                    const float best = LS[(0 * 16 + tkl) * 16 + a] + LS[(1 * 16 + tkl) * 16 + bq];
                    const int eidx = LI[(0 * 16 + tkl) * 16 + a] * 128 + LI[(1 * 16 + tkl) * 16 + bq];
                    if (r == 0) best0 = best;
                    const float e = __expf(best - best0); esum += e;
                    if (qq == (r & 3)) { myexp[r >> 2] = e; myidx[r >> 2] = eidx; }
                }
                const float inv = 1.0f / esum; const int tl = 16 * w + tkl;
                if (tl < nt) {
#pragma unroll
                    for (int i = 0; i < 4; ++i) { const int r = 4 * i + qq;
                        *(LAS int*)(lds + PE_IDX + (tl * 128 + h * 16 + r) * 4) = myidx[i];
                        *(LAS float*)(lds + PE_W + (tl * 128 + h * 16 + r) * 4) = myexp[i] * inv; }
                }
                asm volatile("s_waitcnt lgkmcnt(0)" ::: "memory");
            }
        }
        __syncthreads();
#ifdef PE_DEBUG
        for (int tl = w; tl < nt; tl += 8) { const int row = tb + tl; float* xrow = X + (size_t)row * 2048;
            xrow[lane] = (float)*(const LAS int*)(lds + PE_IDX + (tl * 128 + lane) * 4); xrow[64 + lane] = (float)*(const LAS int*)(lds + PE_IDX + (tl * 128 + 64 + lane) * 4);
            xrow[128 + lane] = *(const LAS float*)(lds + PE_W + (tl * 128 + lane) * 4); xrow[192 + lane] = *(const LAS float*)(lds + PE_W + (tl * 128 + 64 + lane) * 4); }
        if (true) continue;
#endif
        for (int tl = w; tl < nt; tl += 8) {
            const int row = tb + tl;
            u32x4 xr[4];
#pragma unroll
            for (int i = 0; i < 4; ++i) xr[i] = *(const u32x4*)(XN + (size_t)row * 2048 + i * 512 + lane * 8);
            float act_lo = 0.f, act_hi = 0.f;
#pragma unroll 2
            for (int e = 0; e < 128; ++e) {
                const int idx = *(const LAS int*)(lds + PE_IDX + (tl * 128 + e) * 4);
                const bf16_t* ur = PU + (size_t)idx * 2048 + lane * 8;
                float d = 0.f;
#pragma unroll
                for (int i = 0; i < 4; ++i) { const u32x4 uv = *(const u32x4*)(ur + i * 512);
                    d = dot2bf(uv.x, xr[i].x, d); d = dot2bf(uv.y, xr[i].y, d); d = dot2bf(uv.z, xr[i].z, d); d = dot2bf(uv.w, xr[i].w, d); }
                d = wave_sum(d);
                if (e < 64) { if (lane == e) act_lo = d; } else { if (lane == e - 64) act_hi = d; }
            }
            const float g_lo = *(const LAS float*)(lds + PE_W + (tl * 128 + lane) * 4), g_hi = *(const LAS float*)(lds + PE_W + (tl * 128 + 64 + lane) * 4);
            const float w_lo = g_lo * 0.5f * act_lo * (1.0f + erff(act_lo * 0.70710678118654752f));
            const float w_hi = g_hi * 0.5f * act_hi * (1.0f + erff(act_hi * 0.70710678118654752f));
            float out[32];
#pragma unroll
            for (int i = 0; i < 32; ++i) out[i] = 0.f;
#pragma unroll 2
            for (int e = 0; e < 128; ++e) {
                const int idx = *(const LAS int*)(lds + PE_IDX + (tl * 128 + e) * 4);
                const float wv = __shfl(e < 64 ? w_lo : w_hi, e & 63);
                const bf16_t* vr = PVW + (size_t)idx * 2048 + lane * 8;
#pragma unroll
                for (int i = 0; i < 4; ++i) { const u32x4 vv = *(const u32x4*)(vr + i * 512);
                    out[i * 8 + 0] += wv * bflo(vv.x); out[i * 8 + 1] += wv * bfhi(vv.x); out[i * 8 + 2] += wv * bflo(vv.y); out[i * 8 + 3] += wv * bfhi(vv.y);
                    out[i * 8 + 4] += wv * bflo(vv.z); out[i * 8 + 5] += wv * bfhi(vv.z); out[i * 8 + 6] += wv * bflo(vv.w); out[i * 8 + 7] += wv * bfhi(vv.w); }
            }
            if (ABL & 8) {
#pragma unroll
                for (int i = 0; i < 32; ++i) out[i] = 0.f; }
            if (((ABL & 64) && l == 0) || ((ABL & 128) && l == 1)) {
#pragma unroll
                for (int i = 0; i < 32; ++i) out[i] = 0.f; }
            if (ABL & 16) {
#pragma unroll
                for (int i = 0; i < 32; ++i) out[i] = -out[i]; }
            if (ABL & 32) {
#pragma unroll
                for (int i = 0; i < 32; ++i) out[i] = 0.25f * out[i]; }
            const int which = row < NLAT ? (row >> 13) : 2;
            const float* mg = mod + (size_t)which * 12288 + 5 * 2048;
            float* xrow = X + (size_t)row * 2048; float* orow = (l == 1) ? (p->out + (size_t)row * 2048) : xrow;
#pragma unroll
            for (int i = 0; i < 4; ++i)
#pragma unroll
                for (int hh = 0; hh < 2; ++hh) { const int c = i * 512 + lane * 8 + hh * 4;
                    const f32x4 xv = *(const f32x4*)(xrow + c), gv = *(const f32x4*)(mg + c);
                    f32x4 ov; ov[0] = xv[0] + gv[0] * out[i * 8 + hh * 4 + 0]; ov[1] = xv[1] + gv[1] * out[i * 8 + hh * 4 + 1]; ov[2] = xv[2] + gv[2] * out[i * 8 + hh * 4 + 2]; ov[3] = xv[3] + gv[3] * out[i * 8 + hh * 4 + 3];
                    *(f32x4*)(orow + c) = ov; }
        }
    }
}

__global__ void __launch_bounds__(NTHREADS, 2) fwd_kernel(Params p) {
    extern __shared__ __attribute__((aligned(16))) unsigned char lds_raw[];
    LAS unsigned char* lds = (LAS unsigned char*)lds_raw;
    const int tid = threadIdx.x, G = gridDim.x;
    KP kp = (KP)__builtin_amdgcn_kernarg_segment_ptr();
    unsigned char* ws0 = kp->ws;
    volatile LAS unsigned* bst = (volatile LAS unsigned*)(lds + LDS_BYTES - 16);
    if (tid == 0) { bst[0] = 0u; bst[1] = 0u; bst[2] = 0u; bst[3] = 0u; }
    __syncthreads();
    XcdBarrier bar; bar.bar = (unsigned*)(ws0 + WS_BAR); bar.x = 0; bar.st = bst;
    if (MK_SINGLE) bar = xcd_barrier_post((unsigned*)(ws0 + WS_BAR), bst);
    const int lo = kp->ph_lo, hi = kp->ph_hi;
#ifndef PHM
#define PHM 0x7ff
#endif
#define IN(k) (((PHM >> (((k) % NPH))) & 1) && lo <= (k) && (k) < hi)
#define SEAM(k) do { if (IN(k) && IN((k) + 1)) xcd_barrier(bar); } while (0)
    for (int l = 0; l < 2; ++l) {
        const int pb = l * NPH;
        const int M2 = (l == 0) ? MR : NLAT;
        if (IN(pb + 0)) { phase_w(launder_p(kp), l, lds); } SEAM(pb + 0);
        if (IN(pb + 1)) { phase_norm(launder_p(kp), l, 0, MR); } SEAM(pb + 1);
        if (IN(pb + 2)) { unsigned char* ws = launder(ws0);
            pg8::PlainOrder S; S.init(ws + WS_XN, ws + WS_WIN, MR, NPROJ, 2048, G, (int)blockIdx.x);
            pg8::EpiProj E{ws};
            pg8::gemm_phase<pg8::EpiProj, pg8::PlainOrder>(lds, 2048, S, E);
        } SEAM(pb + 2);
        if (IN(pb + 3)) { phase_gates_gemm(launder_p(kp), l); phase_e1(launder_p(kp), l); } SEAM(pb + 3);
        if (IN(pb + 4)) { phase_mlstm(launder_p(kp), l, lds); phase_attn(launder_p(kp), l, lds); } SEAM(pb + 4);
        if (IN(pb + 5)) { phase_e2(launder_p(kp), l, M2); } SEAM(pb + 5);
        if (IN(pb + 6)) { unsigned char* ws = launder(ws0);
            pg8::BranchOrder S; S.T8 = (const char*)(ws + WS_T8); S.WA = (const char*)(ws + WS_WA);
            S.nM = M2 / 256; S.nN = 8; S.G = G; S.c = (int)blockIdx.x; S.tstep = (size_t)256 * 2048 * 2;
            pg8::EpiMerge E{(bf16_t*)(ws + WS_Y), (const bf16_t*)(ws + WS_GT)};
            pg8::gemm_phase<pg8::EpiMerge, pg8::BranchOrder>(lds, 2048, S, E);
        } SEAM(pb + 6);
        if (IN(pb + 7)) { unsigned char* ws = launder(ws0);
            pg8::PlainOrder S; S.init(ws + WS_Y, ws + WS_WO, M2, 2048, 2048, G, (int)blockIdx.x);
            pg8::EpiRes E{(float*)(ws + WS_X), (const float*)(ws + WS_MOD) + (size_t)l * 3 * 12288};
            pg8::gemm_phase<pg8::EpiRes, pg8::PlainOrder>(lds, 2048, S, E);
        } SEAM(pb + 7);
        if (IN(pb + 8)) { phase_norm(launder_p(kp), l, 1, M2); } SEAM(pb + 8);
        if (IN(pb + 9)) { unsigned char* ws = launder(ws0);
            pg8::PlainOrder S; S.init(ws + WS_XN, ws + WS_WQ, M2, 2048, 2048, G, (int)blockIdx.x);
            pg8::EpiBf E{(bf16_t*)(ws + WS_PV), 2048};
            pg8::gemm_phase<pg8::EpiBf, pg8::PlainOrder>(lds, 2048, S, E);
        } SEAM(pb + 9);
        if (IN(pb + 10)) { phase_peer(launder_p(kp), l, lds); } SEAM(pb + 10);
    }
#undef IN
#undef SEAM
}

#ifdef CUT
#ifndef DUMP_OFF
#define DUMP_OFF WS_PV
#endif
#ifndef DUMP_F32
#define DUMP_F32 0
#endif
#ifndef DUMP_N
#define DUMP_N ((size_t)NLAT * DM)
#endif
__global__ void dump_kernel(const unsigned char* ws, float* out, size_t n) {
    for (size_t i = (size_t)blockIdx.x * blockDim.x + threadIdx.x; i < n; i += (size_t)gridDim.x * blockDim.x)
        out[i] = (i >= (size_t)DUMP_N) ? 0.f : (DUMP_F32 ? ((const float*)(ws + DUMP_OFF))[i] : bf2f(((const bf16_t*)(ws + DUMP_OFF))[i]));
}
#endif
extern "C" void kernel_launch(void* const* d_in, const int* in_sizes, int n_in, void* d_out, int out_size, void* d_ws, size_t ws_size, hipStream_t stream) {
    static int grid = 0;
    if (grid == 0) {
        if (n_in != 21 || in_sizes[0] != NLAT * DM || out_size != NLAT * DM || ws_size < WS_END) {
            fprintf(stderr, "kernel_launch: unexpected shapes (n_in %d, in0 %d, out %d, ws %zu need %zu); nothing launched\n", n_in, n_in > 0 ? in_sizes[0] : -1, out_size, ws_size, (size_t)WS_END); grid = -1; return; }
        int dev = 0, cus = 0, per_cu = 0;
        if (hipGetDevice(&dev) != hipSuccess || hipDeviceGetAttribute(&cus, hipDeviceAttributeMultiprocessorCount, dev) != hipSuccess) { grid = -1; return; }
        if (hipFuncSetAttribute((const void*)fwd_kernel, hipFuncAttributeMaxDynamicSharedMemorySize, LDS_BYTES) != hipSuccess) { fprintf(stderr, "kernel_launch: hipFuncSetAttribute failed\n"); grid = -1; return; }
        if (hipOccupancyMaxActiveBlocksPerMultiprocessor(&per_cu, (const void*)fwd_kernel, NTHREADS, LDS_BYTES) != hipSuccess || per_cu < 1) { fprintf(stderr, "kernel_launch: occupancy query says %d\n", per_cu); }
        (void)hipGetLastError();
        grid = cus;
    }
    if (grid < 0) return;
    (void)hipMemsetAsync((char*)d_ws, 0, CTL_BYTES, stream);
    Params p{};
    const float** pp = (const float**)&p;
    for (int i = 0; i < 21; ++i) pp[i] = (const float*)d_in[i];
    p.out = (float*)d_out; p.ws = (unsigned char*)d_ws;
#if MK_SINGLE
    p.ph_lo = 0; p.ph_hi = 2 * NPH;
    hipLaunchKernelGGL(fwd_kernel, dim3(grid), dim3(NTHREADS), LDS_BYTES, stream, p);
#else
#ifdef CUT
    for (int k = 0; k <= CUT; ++k) { p.ph_lo = k; p.ph_hi = k + 1; hipLaunchKernelGGL(fwd_kernel, dim3(grid), dim3(NTHREADS), LDS_BYTES, stream, p); }
    hipLaunchKernelGGL(dump_kernel, dim3(1024), dim3(256), 0, stream, (const unsigned char*)d_ws, (float*)d_out, (size_t)NLAT * DM);
#else
    for (int k = 0; k < 2 * NPH; ++k) { p.ph_lo = k; p.ph_hi = k + 1; hipLaunchKernelGGL(fwd_kernel, dim3(grid), dim3(NTHREADS), LDS_BYTES, stream, p); }
#endif
#endif
}
```

```cpp
#include <hip/hip_runtime.h>
#include <stdint.h>
#include <stdio.h>

#ifndef ABL
#define ABL 0
#endif
#ifndef MK_SINGLE
#define MK_SINGLE 1
#endif

#define LAS __attribute__((address_space(3)))
typedef unsigned short bf16_t;
typedef short bf16x8 __attribute__((ext_vector_type(8)));
typedef float f32x4 __attribute__((ext_vector_type(4)));
typedef float f32x2 __attribute__((ext_vector_type(2)));
typedef unsigned u32x4 __attribute__((ext_vector_type(4)));
typedef unsigned u32x2 __attribute__((ext_vector_type(2)));
typedef __bf16 bf2_t __attribute__((ext_vector_type(2)));

constexpr int DM = 2048, NBATCH = 2, SEQ = 8192, CTXL = 256;
constexpr int NLAT = NBATCH * SEQ;
constexpr int NCTX = NBATCH * CTXL;
constexpr int MR = NLAT + NCTX;
constexpr int PROJ_W = 24608;
constexpr int NPROJ = 24576;
constexpr int NTHREADS = 512;
constexpr int LDS_BYTES = 163840;
constexpr int NPH = 11;
constexpr float EPSF = 1e-6f;

constexpr size_t SZ_A = (size_t)MR * 2048 * 2;
constexpr size_t WS_BAR = 0;
constexpr size_t WS_MOD = 16384;
constexpr size_t CTL_BYTES = 16384 + 2 * 3 * 12288 * 4;
constexpr size_t WS_TAB = 311296;
constexpr size_t WS_X = WS_TAB + 32768;
constexpr size_t WS_XN = WS_X + (size_t)MR * 2048 * 4;
constexpr size_t WS_Y = WS_XN + SZ_A;
constexpr size_t WS_PQ = WS_Y + SZ_A;
constexpr size_t WS_PK = WS_PQ + SZ_A / 2;
constexpr size_t WS_T8 = WS_PK + SZ_A / 2;
constexpr size_t WS_PV = WS_T8 + 0 * SZ_A;
constexpr size_t WS_PO = WS_T8 + 1 * SZ_A;
constexpr size_t WS_CQ = WS_T8 + 2 * SZ_A;
constexpr size_t WS_CK = WS_T8 + 3 * SZ_A;
constexpr size_t WS_CV = WS_T8 + 4 * SZ_A;
constexpr size_t WS_BB = WS_T8 + 5 * SZ_A;
constexpr size_t WS_BC = WS_T8 + 6 * SZ_A;
constexpr size_t WS_BX = WS_T8 + 7 * SZ_A;
constexpr size_t WS_GT = WS_T8 + 8 * SZ_A;
constexpr size_t WS_GATES = WS_GT + 3 * SZ_A;
constexpr size_t WS_WIN = WS_GATES + (size_t)MR * 32 * 4;
constexpr size_t WS_WG = WS_WIN + (size_t)NPROJ * 2048 * 2;
constexpr size_t SZ_W = (size_t)2048 * 2048 * 2;
constexpr size_t WS_WA = WS_WG + 32 * 2048 * 2;
constexpr size_t WS_WB = WS_WA + SZ_W;
constexpr size_t WS_WC = WS_WB + SZ_W;
constexpr size_t WS_WO = WS_WC + SZ_W;
constexpr size_t WS_WQ = WS_WO + SZ_W;
constexpr size_t WS_KEYS = WS_WQ + SZ_W;
constexpr size_t WS_PU = WS_KEYS + 16 * 128 * 128 * 2;
constexpr size_t WS_PVW = WS_PU + (size_t)16384 * 2048 * 2;
constexpr size_t WS_END = WS_PVW + (size_t)16384 * 2048 * 2;

struct Params {
    const float *x, *c, *ctx, *c_ctx, *w_ada, *b_ada, *norm_g, *w_in, *a_gate_b, *a_hnorm_g, *b_conv, *c_qk_g, *c_rpb,
        *w_a_out, *w_b_out, *w_c_out, *w_out, *peer_wq, *peer_keys, *peer_u, *peer_v;
    float* out; unsigned char* ws; int ph_lo, ph_hi;
};
#define CAS __attribute__((address_space(4)))
typedef const CAS Params* KP;
__device__ __forceinline__ KP launder_p(KP q) { asm volatile("" : "+s"(q)); return q; }

__device__ __forceinline__ unsigned char* launder(unsigned char* q) { size_t z = 0; asm volatile("" : "+s"(z)); return q + z; }
__device__ __forceinline__ int tid_fresh() { int t = threadIdx.x; asm volatile("" : "+v"(t)); return t; }

__device__ __forceinline__ float bf2f(unsigned b) { return __uint_as_float(b << 16); }
__device__ __forceinline__ float bflo(unsigned w) { return __uint_as_float(w << 16); }
__device__ __forceinline__ float bfhi(unsigned w) { return __uint_as_float(w & 0xffff0000u); }
__device__ __forceinline__ unsigned pk2(float lo, float hi) { f32x2 v = {lo, hi}; bf2_t b = __builtin_convertvector(v, bf2_t); return __builtin_bit_cast(unsigned, b); }
__device__ __forceinline__ bf16_t f2bf(float f) { return (bf16_t)(pk2(f, 0.f) & 0xffffu); }
__device__ __forceinline__ f32x4 mfma16(bf16x8 a, bf16x8 b, f32x4 c) { return __builtin_amdgcn_mfma_f32_16x16x32_bf16(a, b, c, 0, 0, 0); }
__device__ __forceinline__ float dot2bf(unsigned a, unsigned b, float c) { return __builtin_amdgcn_fdot2_f32_bf16(__builtin_bit_cast(bf2_t, a), __builtin_bit_cast(bf2_t, b), c, false); }
__device__ __forceinline__ float wave_sum(float v) {
#pragma unroll
    for (int o = 32; o >= 1; o >>= 1) v += __shfl_xor(v, o);
    return v;
}
__device__ __forceinline__ float sigmoidf_(float v) { return 1.0f / (1.0f + __expf(-v)); }
__device__ __forceinline__ float logsigmoidf_(float v) { return fminf(v, 0.f) - log1pf(__expf(-fabsf(v))); }

#define XB_TMO      128
#define XB_XCNT(j)  (256  + 64 * (j))
#define XB_XSUB(j)  (1280 + 64 * (j))
#define XB_XGEN(j)  (2304 + 64 * (j))
#define XB_TOP      3328
#define XB_TOPGEN   3392
#define XCD_BAR_WORDS 3456
#define XB_SPIN_CAP (1u << 22)
__device__ __forceinline__ unsigned xb_ld(unsigned* p)              { return __hip_atomic_load(p, __ATOMIC_RELAXED, __HIP_MEMORY_SCOPE_AGENT); }
__device__ __forceinline__ unsigned xb_add(unsigned* p, unsigned v) { return __hip_atomic_fetch_add(p, v, __ATOMIC_RELAXED, __HIP_MEMORY_SCOPE_AGENT); }
__device__ __forceinline__ unsigned xb_xcc_id() { return (unsigned)__builtin_amdgcn_s_getreg((3 << 11) | 20) & 0xFu; }
#define XB_SPIN(cond, bar) do { unsigned _sp = 0; while (cond) { __builtin_amdgcn_s_sleep(1); \
    if ((++_sp & 255u) == 0u) { if (xb_ld(&(bar)[XB_TMO])) break; if (_sp > XB_SPIN_CAP) { atomicAdd(&(bar)[XB_TMO], 1u); break; } } } } while (0)
struct XcdBarrier { unsigned* bar; unsigned x; volatile LAS unsigned* st; };
__device__ __forceinline__ XcdBarrier xcd_barrier_post(unsigned* bar, volatile LAS unsigned* st) {
    XcdBarrier b; b.bar = bar; b.x = xb_xcc_id(); b.st = st;
    if (threadIdx.x == 0) (void)xb_add(&bar[XB_XCNT(b.x)], 1u);
    return b;
}
__device__ __forceinline__ void xcd_barrier_complete(unsigned* bar, unsigned x, unsigned& nloc, unsigned& nx) {
    const unsigned G = gridDim.x * gridDim.y * gridDim.z;
    unsigned sum, cnt, mine, sp = 0u;
    for (;;) {
        sum = 0u; cnt = 0u; mine = 0u;
#pragma unroll
        for (unsigned j = 0; j < 16; ++j) { const unsigned c = xb_ld(&bar[XB_XCNT(j)]); sum += c; cnt += (c > 0u) ? 1u : 0u; mine = (j == x) ? c : mine; }
        if (sum == G) break;
        __builtin_amdgcn_s_sleep(1);
        if ((++sp & 255u) == 0u) { if (xb_ld(&bar[XB_TMO])) break; if (sp > XB_SPIN_CAP) { atomicAdd(&bar[XB_TMO], 1u); break; } }
    }
    nloc = mine > 0u ? mine : 1u; nx = cnt > 0u ? cnt : 1u;
}
__device__ __forceinline__ void xcd_barrier(const XcdBarrier& b) {
    asm volatile("s_waitcnt vmcnt(0)" ::: "memory");
    __syncthreads();
    if (threadIdx.x == 0) {
        unsigned* bar = b.bar;
        __builtin_amdgcn_s_waitcnt(0);
        unsigned nloc = b.st[0], nx = b.st[1];
        if (nloc == 0u) { xcd_barrier_complete(bar, b.x, nloc, nx); b.st[0] = nloc; b.st[1] = nx; }
        const unsigned old = xb_add(&bar[XB_XSUB(b.x)], 1u);
        const unsigned gen = old / nloc;
        if (old + 1u == (gen + 1u) * nloc) {
            __builtin_amdgcn_fence(__ATOMIC_RELEASE, "agent");
            asm volatile("s_waitcnt vmcnt(0)" ::: "memory");
            const unsigned og = xb_add(&bar[XB_TOP], 1u);
            const unsigned tg = og / nx;
            if (og + 1u == (tg + 1u) * nx) xb_add(&bar[XB_TOPGEN], 1u);
            else XB_SPIN(xb_ld(&bar[XB_TOPGEN]) == tg, bar);
            __builtin_amdgcn_fence(__ATOMIC_ACQUIRE, "agent");
            xb_add(&bar[XB_XGEN(b.x)], 1u);
            asm volatile("s_waitcnt vmcnt(0)" ::: "memory");
        } else {
            XB_SPIN(xb_ld(&bar[XB_XGEN(b.x)]) == gen, bar);
            __builtin_amdgcn_fence(__ATOMIC_ACQUIRE, "agent");
            asm volatile("s_waitcnt vmcnt(0)" ::: "memory");
        }
    }
    __syncthreads();
}

namespace pg8 {
constexpr int BM = 256, BK = 64, HALF = 128, HTB = HALF * BK * 2, STAGE_BYTES = 8 * HTB, NXCD = 8, WGM = 8;
__host__ __device__ __forceinline__ int lds_byte(int r, int c) { const int st = (r >> 4) * 2 + (c >> 5), rr = r & 15, cc = c & 31, ob = rr * 64 + cc * 2; return st * 1024 + (ob ^ (((ob >> 9) & 1) << 5)); }
__host__ __device__ __forceinline__ void stage_rc(int b, int& R, int& C) { const int st = b / 1024, sb = b % 1024, swz = sb ^ (((sb >> 9) & 1) << 5); R = (st >> 1) * 16 + swz / 64; C = (st & 1) * 32 + (swz % 64) / 2; }
__host__ __device__ __forceinline__ int perm32(int rho) { const int n = rho >> 4, i = rho & 15; return 8 * (i >> 2) + 4 * n + (i & 3); }

struct Unit { int pm, pn, br; const char* A; const char* B; };

__device__ __forceinline__ bool tile_of(int L, int nM, int nN, int& pm, int& pn) {
    const int nwg = nM * nN; if (L >= nwg) return false;
    int wgid = L; { const int q = nwg / NXCD, r = nwg % NXCD, xcd = wgid % NXCD, off = wgid / NXCD; wgid = (xcd < r ? xcd * (q + 1) : r * (q + 1) + (xcd - r) * q) + off; }
    const int nig = WGM * nN, gid = wgid / nig, fm = gid * WGM, gsz = (nM - fm) < WGM ? (nM - fm) : WGM;
    pm = fm + ((wgid % nig) % gsz); pn = (wgid % nig) / gsz; return true;
}
struct PlainOrder {
    const char* A; const char* Bt; int nM, nN, G, c; size_t tstep;
    __device__ __forceinline__ void init(const void* A_, const void* Bt_, int M, int N, int K, int G_, int c_) { A = (const char*)A_; Bt = (const char*)Bt_; nM = M / BM; nN = N / BM; G = G_; c = c_; tstep = (size_t)BM * K * 2; }
    __device__ __forceinline__ bool next(int i, Unit& u) const {
        int pm, pn; if (!tile_of(i * G + c, nM, nN, pm, pn)) return false;
        u.pm = pm; u.pn = pn; u.br = 0; u.A = A + (size_t)pm * tstep; u.B = Bt + (size_t)pn * tstep; return true;
    }
};
struct BranchOrder {
    const char* T8; const char* WA; int nM, nN, G, c; size_t tstep;
    __device__ __forceinline__ bool next(int i, Unit& u) const {
        const int tl = i / 3, br = i - 3 * tl; int pm, pn; if (!tile_of(tl * G + c, nM, nN, pm, pn)) return false;
        u.pm = pm; u.pn = pn; u.br = br;
        const int ti = 1 + 4 * (br == 1) + (br == 2);
        u.A = T8 + (size_t)ti * SZ_A + (size_t)pm * tstep; u.B = WA + (size_t)br * SZ_W + (size_t)pn * tstep; return true;
    }
};

template <class Epi, class Sched>
__device__ __forceinline__ void gemm_phase(LAS unsigned char* lds, const int K, const Sched& S, const Epi& E) {
    const int tid = tid_fresh(), wid = __builtin_amdgcn_readfirstlane(tid >> 6), lane = tid & 63, wr = wid >> 2, wc = wid & 3, fr = lane & 15, fq = lane >> 4;
    const int nt = K / BK;
    unsigned voffA[2], voffB[2];
#pragma unroll
    for (int i = 0; i < 2; ++i) { int R, C; stage_rc(tid * 16 + i * 8192, R, C); const int Rb = Epi::PERM ? ((R & ~31) + perm32(R & 31)) : R;
        voffA[i] = (unsigned)(R * K + C) * 2u; voffB[i] = (unsigned)(Rb * K + C) * 2u; }
    const size_t kstep = (size_t)(BK * 2);
    const size_t hstep = (size_t)HALF * K * 2;
    const unsigned ldsw = (unsigned)wid * 1024u;
    const int aoff = lds_byte(wr * 64 + fr, fq * 8), boff = lds_byte(wc * 32 + fr, fq * 8);
#define PG8_SA(b, h) (((b) * 2 + (h)) * HTB)
#define PG8_SB(b, h) ((4 + (b) * 2 + (h)) * HTB)
#define PG8_STAGE(bufoff, gbase, voff) do { _Pragma("unroll") for (int _i = 0; _i < 2; ++_i) \
        __builtin_amdgcn_global_load_lds((const unsigned*)((const char*)(gbase) + (voff)[_i]), (LAS unsigned*)(lds + (bufoff) + ldsw + _i * 8192), 16, 0, 0); } while (0)
#define PG8_LDA(dst, b, h) do { _Pragma("unroll") for (int m = 0; m < 4; ++m) _Pragma("unroll") for (int k = 0; k < 2; ++k) dst[m][k] = *(const LAS bf16x8*)(lds + PG8_SA(b, h) + aoff + m * 2048 + k * 1024); } while (0)
#define PG8_LDB(dst, b, h) do { _Pragma("unroll") for (int n = 0; n < 2; ++n) _Pragma("unroll") for (int k = 0; k < 2; ++k) dst[n][k] = *(const LAS bf16x8*)(lds + PG8_SB(b, h) + boff + n * 2048 + k * 1024); } while (0)
#define PG8_MMA(ai, bj, At, Bt) do { __builtin_amdgcn_s_setprio(1); _Pragma("unroll") for (int m = 0; m < 4; ++m) _Pragma("unroll") for (int n = 0; n < 2; ++n) _Pragma("unroll") for (int k = 0; k < 2; ++k) \
        acc[ai][bj][m][n] = __builtin_amdgcn_mfma_f32_16x16x32_bf16(Bt[n][k], At[m][k], acc[ai][bj][m][n], 0, 0, 0); __builtin_amdgcn_s_setprio(0); } while (0)
#define PG8_WAIT_V(n) asm volatile("s_waitcnt vmcnt(" #n ")" ::: "memory")
#define PG8_WAIT_L(n) asm volatile("s_waitcnt lgkmcnt(" #n ")" ::: "memory")
#define PG8_BAR __builtin_amdgcn_s_barrier()
#define PG8_SCHED __builtin_amdgcn_sched_barrier(0)
    Unit cur, nxt; int ui = 0;
    if (!S.next(0, cur)) return;
    f32x4 acc[2][2][4][2];
#pragma unroll
    for (int a = 0; a < 2; ++a)
#pragma unroll
        for (int b = 0; b < 2; ++b)
#pragma unroll
            for (int m = 0; m < 4; ++m)
#pragma unroll
                for (int n = 0; n < 2; ++n) acc[a][b][m][n] = (f32x4){0.f, 0.f, 0.f, 0.f};
    bf16x8 At[4][2], B0[2][2], B1[2][2];
    const char* cA = cur.A; const char* cB = cur.B;
    PG8_STAGE(PG8_SB(0, 0), cB, voffB); PG8_STAGE(PG8_SA(0, 0), cA, voffA); PG8_STAGE(PG8_SB(0, 1), cB + hstep, voffB); PG8_STAGE(PG8_SA(0, 1), cA + hstep, voffA);
    if (wr == 1) PG8_BAR;
    PG8_WAIT_V(4); PG8_BAR;
    PG8_STAGE(PG8_SB(1, 0), cB + kstep, voffB); PG8_STAGE(PG8_SA(1, 0), cA + kstep, voffA); PG8_STAGE(PG8_SB(1, 1), cB + hstep + kstep, voffB);
    PG8_WAIT_V(6); PG8_BAR;
    for (;;) {
        const bool has_next = S.next(ui + 1, nxt);
        const char* nA = has_next ? nxt.A : cA; const char* nB = has_next ? nxt.B : cB;
        for (int t = 0; t < nt; t += 2) {
            const bool last = (t == nt - 2);
            const char* a1 = cA + (size_t)(t + 1) * kstep;
            const char* a2 = last ? nA : cA + (size_t)(t + 2) * kstep; const char* b2 = last ? nB : cB + (size_t)(t + 2) * kstep;
            const char* a3 = a2 + kstep; const char* b3 = b2 + kstep;
            PG8_LDB(B0, 0, 0); PG8_SCHED; PG8_LDA(At, 0, 0); PG8_STAGE(PG8_SA(1, 1), a1 + hstep, voffA);
            PG8_WAIT_L(8); PG8_BAR; PG8_WAIT_L(0); PG8_MMA(0, 0, At, B0); PG8_BAR; PG8_SCHED;
            PG8_LDB(B1, 0, 1); PG8_STAGE(PG8_SB(0, 0), b2, voffB);
            PG8_BAR; PG8_WAIT_L(0); PG8_MMA(0, 1, At, B1); PG8_BAR;
            PG8_LDA(At, 0, 1); PG8_STAGE(PG8_SA(0, 0), a2, voffA);
            PG8_BAR; PG8_WAIT_L(0); PG8_MMA(1, 0, At, B0); PG8_BAR; PG8_SCHED;
            PG8_STAGE(PG8_SB(0, 1), b2 + hstep, voffB);
            PG8_WAIT_V(6); PG8_BAR; PG8_MMA(1, 1, At, B1); PG8_BAR;
            PG8_LDB(B0, 1, 0); PG8_SCHED; PG8_LDA(At, 1, 0); PG8_STAGE(PG8_SA(0, 1), a2 + hstep, voffA);
            PG8_WAIT_L(8); PG8_BAR; PG8_WAIT_L(0); PG8_MMA(0, 0, At, B0); PG8_BAR; PG8_SCHED;
            PG8_LDB(B1, 1, 1); PG8_STAGE(PG8_SB(1, 0), b3, voffB);
            PG8_BAR; PG8_WAIT_L(0); PG8_MMA(0, 1, At, B1); PG8_BAR;
            PG8_LDA(At, 1, 1); PG8_STAGE(PG8_SA(1, 0), a3, voffA);
            PG8_BAR; PG8_WAIT_L(0); PG8_MMA(1, 0, At, B0); PG8_BAR; PG8_SCHED;
            PG8_STAGE(PG8_SB(1, 1), b3 + hstep, voffB);
            PG8_WAIT_V(6); PG8_BAR; PG8_MMA(1, 1, At, B1); PG8_BAR;
        }
        E(acc, cur, wr, wc, fr, fq);
        if (!has_next) break;
#pragma unroll
        for (int a = 0; a < 2; ++a)
#pragma unroll
            for (int b = 0; b < 2; ++b)
#pragma unroll
                for (int m = 0; m < 4; ++m)
#pragma unroll
                    for (int n = 0; n < 2; ++n) acc[a][b][m][n] = (f32x4){0.f, 0.f, 0.f, 0.f};
        cur = nxt; cA = nA; cB = nB; ++ui;
    }
    PG8_WAIT_V(0);
    if (wr == 0) PG8_BAR;
    PG8_BAR;
#undef PG8_SA
#undef PG8_SB
#undef PG8_STAGE
#undef PG8_LDA
#undef PG8_LDB
#undef PG8_MMA
#undef PG8_WAIT_V
#undef PG8_WAIT_L
#undef PG8_BAR
#undef PG8_SCHED
}

template <int LD>
__device__ __forceinline__ void store_tile_bf16(const f32x4 (&acc)[2][2][4][2], bf16_t* base  , int wr, int wc, int fr, int fq) {
    bf16_t* lp = base + (size_t)(wr * 64 + fr) * LD + wc * 32 + 8 * fq;
#pragma unroll
    for (int ai = 0; ai < 2; ++ai)
#pragma unroll
        for (int m = 0; m < 4; ++m) { bf16_t* rowp = lp + (size_t)(ai * HALF + m * 16) * LD;
#pragma unroll
            for (int bj = 0; bj < 2; ++bj) { const f32x4 v0 = acc[ai][bj][m][0], v1 = acc[ai][bj][m][1];
                u32x4 w; w.x = pk2(v0[0], v0[1]); w.y = pk2(v0[2], v0[3]); w.z = pk2(v1[0], v1[1]); w.w = pk2(v1[2], v1[3]);
                *(u32x4*)(rowp + bj * HALF) = w; } }
}
struct EpiProj {
    static constexpr bool PERM = true;
    unsigned char* ws;
    __device__ __forceinline__ void operator()(const f32x4 (&acc)[2][2][4][2], const Unit& u, int wr, int wc, int fr, int fq) const {
        const int pn = u.pn;
        if (pn < 8) { bf16_t* base = (bf16_t*)(ws + (pn < 4 ? WS_PQ : WS_PK)) + (size_t)(u.pm * BM) * 1024 + (pn & 3) * 256; store_tile_bf16<1024>(acc, base, wr, wc, fr, fq); }
        else if (pn < 72) { const int t = (pn - 8) >> 3; bf16_t* base = (bf16_t*)(ws + WS_T8 + (size_t)t * SZ_A) + (size_t)(u.pm * BM) * 2048 + ((pn - 8) & 7) * 256; store_tile_bf16<2048>(acc, base, wr, wc, fr, fq); }
        else { bf16_t* base = (bf16_t*)(ws + WS_GT) + (size_t)(u.pm * BM) * 6144 + (pn - 72) * 256; store_tile_bf16<6144>(acc, base, wr, wc, fr, fq); }
    }
};
struct EpiBf {
    static constexpr bool PERM = true;
    bf16_t* O; int ld;
    __device__ __forceinline__ void operator()(const f32x4 (&acc)[2][2][4][2], const Unit& u, int wr, int wc, int fr, int fq) const {
        const int row0 = u.pm * BM + wr * 64 + fr, col0 = u.pn * BM + wc * 32 + 8 * fq;
#pragma unroll
        for (int ai = 0; ai < 2; ++ai)
#pragma unroll
            for (int m = 0; m < 4; ++m) { bf16_t* rowp = O + (size_t)(row0 + ai * HALF + m * 16) * ld + col0;
#pragma unroll
                for (int bj = 0; bj < 2; ++bj) { const f32x4 v0 = acc[ai][bj][m][0], v1 = acc[ai][bj][m][1];
                    u32x4 w; w.x = pk2(v0[0], v0[1]); w.y = pk2(v0[2], v0[3]); w.z = pk2(v1[0], v1[1]); w.w = pk2(v1[2], v1[3]);
                    *(u32x4*)(rowp + bj * HALF) = w; } }
    }
};
struct EpiMerge {
    static constexpr bool PERM = true;
    bf16_t* Y; const bf16_t* GT;
    __device__ __forceinline__ void operator()(const f32x4 (&acc)[2][2][4][2], const Unit& u, int wr, int wc, int fr, int fq) const {
        const int row0 = u.pm * BM + wr * 64 + fr, col0 = u.pn * BM + wc * 32 + 8 * fq;
#pragma unroll
        for (int ai = 0; ai < 2; ++ai)
#pragma unroll
            for (int m = 0; m < 4; ++m) { const size_t r = (size_t)(row0 + ai * HALF + m * 16);
                bf16_t* rowp = Y + r * 2048 + col0; const bf16_t* gp = GT + r * 6144 + (size_t)u.br * 2048 + col0;
#pragma unroll
                for (int bj = 0; bj < 2; ++bj) { const f32x4 v0 = acc[ai][bj][m][0], v1 = acc[ai][bj][m][1];
                    const u32x4 g = *(const u32x4*)(gp + bj * HALF);
                    const float ab = ((ABL >> u.br) & 1) ? 0.f : 1.f;
                    float o[8];
                    o[0] = ab * sigmoidf_(bflo(g.x)) * v0[0]; o[1] = ab * sigmoidf_(bfhi(g.x)) * v0[1]; o[2] = ab * sigmoidf_(bflo(g.y)) * v0[2]; o[3] = ab * sigmoidf_(bfhi(g.y)) * v0[3];
                    o[4] = ab * sigmoidf_(bflo(g.z)) * v1[0]; o[5] = ab * sigmoidf_(bfhi(g.z)) * v1[1]; o[6] = ab * sigmoidf_(bflo(g.w)) * v1[2]; o[7] = ab * sigmoidf_(bfhi(g.w)) * v1[3];
                    if (u.br != 0) { const u32x4 y = *(const u32x4*)(rowp + bj * HALF);
                        o[0] += bflo(y.x); o[1] += bfhi(y.x); o[2] += bflo(y.y); o[3] += bfhi(y.y); o[4] += bflo(y.z); o[5] += bfhi(y.z); o[6] += bflo(y.w); o[7] += bfhi(y.w); }
                    u32x4 w; w.x = pk2(o[0], o[1]); w.y = pk2(o[2], o[3]); w.z = pk2(o[4], o[5]); w.w = pk2(o[6], o[7]);
                    *(u32x4*)(rowp + bj * HALF) = w; } }
    }
};
struct EpiRes {
    static constexpr bool PERM = false;
    float* X; const float* mod;
    __device__ __forceinline__ void operator()(const f32x4 (&acc)[2][2][4][2], const Unit& u, int wr, int wc, int fr, int fq) const {
        const int row0 = u.pm * BM + wr * 64 + fr, col0 = u.pn * BM + wc * 32 + 4 * fq;
        const int which = (u.pm < 32) ? 0 : (u.pm < 64 ? 1 : 2);
        const float* mg = mod + (size_t)which * 12288 + 2 * 2048 + col0;
        f32x4 gv[2][2];
#pragma unroll
        for (int bj = 0; bj < 2; ++bj)
#pragma unroll
            for (int n = 0; n < 2; ++n) gv[bj][n] = *(const f32x4*)(mg + bj * HALF + n * 16);
#pragma unroll
        for (int ai = 0; ai < 2; ++ai)
#pragma unroll
            for (int m = 0; m < 4; ++m) { float* rowp = X + (size_t)(row0 + ai * HALF + m * 16) * 2048 + col0;
#pragma unroll
                for (int bj = 0; bj < 2; ++bj)
#pragma unroll
                    for (int n = 0; n < 2; ++n) { f32x4* q = (f32x4*)(rowp + bj * HALF + n * 16); *q = *q + gv[bj][n] * acc[ai][bj][m][n]; } }
    }
};
}

__device__ __forceinline__ int proj_src_col(int n) {
    if (n < 1024) return 7200 + n;
    if (n < 2048) return n - 1024;
    if (n < 4096) return 1024 + (n - 2048);
    if (n < 6144) return 8224 + (n - 4096);
    if (n < 8192) return 16416 + (n - 6144);
    if (n < 10240) return 3104 + (n - 8192);
    if (n < 12288) return 5152 + (n - 10240);
    if (n < 14336) return 10272 + (n - 12288);
    if (n < 16384) return 12320 + (n - 14336);
    if (n < 18432) return 14368 + (n - 16384);
    return 18464 + (n - 18432);
}
__device__ void phase_w(KP p, int l, LAS unsigned char* lds) {
    const int tid = tid_fresh(), G = gridDim.x, bid = blockIdx.x;
    unsigned char* ws = launder(p->ws);
    {
        LAS float* tile = (LAS float*)lds;
        const int NT_IN = NPROJ / 64;
        const int total = (NT_IN + 5 * 32) * 32;
        for (int t = bid; t < total; t += G) {
            const int ntile = t >> 5, kt = t & 31, k0 = kt * 64;
            const float* src; int ld; bf16_t* dst; float scale = 1.0f; int n0;
            if (ntile < NT_IN) { n0 = ntile * 64; src = p->w_in + (size_t)l * 2048 * PROJ_W + proj_src_col(n0); ld = PROJ_W; dst = (bf16_t*)(ws + WS_WIN) + (size_t)n0 * 2048; if (n0 < 1024) scale = 0.08838834764831845f; }
            else { const int mi = (ntile - NT_IN) >> 5; n0 = ((ntile - NT_IN) & 31) * 64;
                const float* m5 = mi == 0 ? p->w_a_out : mi == 1 ? p->w_b_out : mi == 2 ? p->w_c_out : mi == 3 ? p->w_out : p->peer_wq;
                src = m5 + (size_t)l * 2048 * 2048 + n0; ld = 2048; dst = (bf16_t*)(ws + WS_WA + (size_t)mi * SZ_W) + (size_t)n0 * 2048; }
            { const int kk = tid >> 4, n4 = (tid & 15) * 4;
#pragma unroll
              for (int h = 0; h < 2; ++h) { const f32x4 v = *(const f32x4*)(src + (size_t)(k0 + kk + 32 * h) * ld + n4);
                  LAS float* tp = tile + (kk + 32 * h) * 65 + n4; tp[0] = v[0]; tp[1] = v[1]; tp[2] = v[2]; tp[3] = v[3]; } }
            __syncthreads();
            { const int n = tid >> 3, k8 = (tid & 7) * 8; float v[8];
#pragma unroll
              for (int j = 0; j < 8; ++j) v[j] = tile[(k8 + j) * 65 + n] * scale;
              u32x4 w; w.x = pk2(v[0], v[1]); w.y = pk2(v[2], v[3]); w.z = pk2(v[4], v[5]); w.w = pk2(v[6], v[7]);
              *(u32x4*)(dst + (size_t)n * 2048 + k0 + k8) = w; }
            __syncthreads();
        }
    }
    const size_t gtid = (size_t)bid * NTHREADS + tid, gthreads = (size_t)G * NTHREADS;
    for (size_t i = gtid; i < 32 * 2048; i += gthreads) { const int n = (int)(i >> 11), k = (int)(i & 2047);
        ((bf16_t*)(ws + WS_WG))[i] = f2bf(p->w_in[(size_t)l * 2048 * PROJ_W + (size_t)k * PROJ_W + 3072 + n]); }
    {
        const float* su = p->peer_u + (size_t)l * 16384 * 2048; const float* sv = p->peer_v + (size_t)l * 16384 * 2048;
        unsigned char* du = ws + WS_PU; unsigned char* dv = ws + WS_PVW;
        const size_t n16 = (size_t)16384 * 2048 / 16;
        for (size_t i = gtid; i < n16; i += gthreads) {
#pragma unroll
            for (int t = 0; t < 2; ++t) {
                const float* sp = (t ? sv : su) + i * 16; const float sc = t ? 128.0f : 2048.0f;
                u32x4 wv;
#pragma unroll
                for (int q = 0; q < 4; ++q) { const f32x4 a = *(const f32x4*)(sp + q * 4);
                    const float a0 = fminf(fmaxf(a[0] * sc, -448.f), 448.f), a1 = fminf(fmaxf(a[1] * sc, -448.f), 448.f), a2 = fminf(fmaxf(a[2] * sc, -448.f), 448.f), a3 = fminf(fmaxf(a[3] * sc, -448.f), 448.f);
                    int d = 0; d = __builtin_amdgcn_cvt_pk_fp8_f32(a0, a1, d, false); d = __builtin_amdgcn_cvt_pk_fp8_f32(a2, a3, d, true); wv[q] = (unsigned)d; }
                *(u32x4*)((t ? dv : du) + i * 16) = wv;
            }
        }
        const float* sk = p->peer_keys + (size_t)l * 16 * 128 * 128; bf16_t* dk = (bf16_t*)(ws + WS_KEYS);
        for (size_t i = gtid; i < (size_t)16 * 128 * 128; i += gthreads) dk[i] = f2bf(sk[i]);
    }
    {
        float* mod = (float*)(ws + WS_MOD) + (size_t)l * 3 * 12288;
        const float* wa = p->w_ada + (size_t)l * 2048 * 12288; const float* ba = p->b_ada + (size_t)l * 12288;
        LAS float* part = (LAS float*)(lds + 32768);
        const int col = tid & 63, ks = tid >> 6;
        for (int t = bid; t < 256; t += G) {
            const int n = t * 48 + col;
            float a0 = 0.f, a1 = 0.f, a2 = 0.f;
            if (col < 48) {
                for (int k = ks * 256; k < ks * 256 + 256; ++k) {
                    const float w = wa[(size_t)k * 12288 + n];
                    const float c0 = p->c[k], c1 = p->c[2048 + k], c2 = p->c_ctx[k];
                    a0 += c0 * sigmoidf_(c0) * w; a1 += c1 * sigmoidf_(c1) * w; a2 += c2 * sigmoidf_(c2) * w;
                }
                part[(ks * 3 + 0) * 48 + col] = a0; part[(ks * 3 + 1) * 48 + col] = a1; part[(ks * 3 + 2) * 48 + col] = a2;
            }
            __syncthreads();
            if (tid < 144) { const int which = tid / 48, cc = tid - which * 48; float sacc = ba[t * 48 + cc];
#pragma unroll
                for (int q = 0; q < 8; ++q) sacc += part[(q * 3 + which) * 48 + cc];
                mod[(size_t)which * 12288 + t * 48 + cc] = sacc; }
            __syncthreads();
        }
    }
    if (l == 0) {
        float* X = (float*)(ws + WS_X);
        const size_t nl4 = (size_t)NLAT * 2048 / 4, nc4 = (size_t)NCTX * 2048 / 4;
        for (size_t i = gtid; i < nl4; i += gthreads) ((f32x4*)X)[i] = ((const f32x4*)p->x)[i];
        for (size_t i = gtid; i < nc4; i += gthreads) ((f32x4*)X)[nl4 + i] = ((const f32x4*)p->ctx)[i];
        float* tab = (float*)(ws + WS_TAB);
        for (size_t i = gtid; i < 4096; i += gthreads) { const int pos = (int)(i >> 5), j = (int)(i & 31);
            const float inv = powf(10000.0f, -(float)j / 32.0f); const float ang = (float)pos * inv;
            tab[i] = cosf(ang); tab[4096 + i] = sinf(ang); }
    }
}

__device__ void phase_norm(KP p, int l, int which_norm, int nrows) {
    const int tid = tid_fresh(); const int lane = tid & 63, gw = blockIdx.x * 8 + (tid >> 6), nw = gridDim.x * 8;
    unsigned char* ws = launder(p->ws);
    const float* X = (const float*)(ws + WS_X); bf16_t* XN = (bf16_t*)(ws + WS_XN);
    const float* mod = (const float*)(ws + WS_MOD) + (size_t)l * 3 * 12288;
    const float* g = p->norm_g + (size_t)(l * 2 + which_norm) * 2048;
    const int shift_c = which_norm ? 3 : 0, scale_c = which_norm ? 4 : 1;
    for (int row = gw; row < nrows; row += nw) {
        const int which = row < NLAT ? (row >> 13) : 2;
        const float* xr = X + (size_t)row * 2048; const float* mb = mod + (size_t)which * 12288;
        f32x4 v[8]; float ss = 0.f;
#pragma unroll
        for (int i = 0; i < 8; ++i) { v[i] = *(const f32x4*)(xr + i * 256 + lane * 4); ss += v[i][0] * v[i][0] + v[i][1] * v[i][1] + v[i][2] * v[i][2] + v[i][3] * v[i][3]; }
        ss = wave_sum(ss);
        const float rstd = rsqrtf(ss * (1.0f / 2048.0f) + EPSF);
#pragma unroll
        for (int i = 0; i < 8; ++i) { const int c = i * 256 + lane * 4;
            const f32x4 gg = *(const f32x4*)(g + c), sh = *(const f32x4*)(mb + shift_c * 2048 + c), sc = *(const f32x4*)(mb + scale_c * 2048 + c);
            float o[4];
#pragma unroll
            for (int j = 0; j < 4; ++j) o[j] = v[i][j] * rstd * gg[j] * (1.0f + sc[j]) + sh[j];
            u32x2 w; w.x = pk2(o[0], o[1]); w.y = pk2(o[2], o[3]); *(u32x2*)(XN + (size_t)row * 2048 + c) = w; }
    }
}

__device__ void phase_gates_gemm(KP p, int l) {
    const int tid = tid_fresh(); const int lane = tid & 63, gw = blockIdx.x * 8 + (tid >> 6), nw = gridDim.x * 8;
    unsigned char* ws = launder(p->ws);
    const bf16_t* XN = (const bf16_t*)(ws + WS_XN); const bf16_t* WG = (const bf16_t*)(ws + WS_WG); float* GA = (float*)(ws + WS_GATES);
    const int q4 = lane >> 4, c = lane & 15;
    const float gb0 = p->a_gate_b[l * 32 + c], gb1 = p->a_gate_b[l * 32 + 16 + c];
    for (int task = gw; task < MR / 16; task += nw) {
        const int r0 = task * 16;
        f32x4 acc0 = {0.f, 0.f, 0.f, 0.f}, acc1 = {0.f, 0.f, 0.f, 0.f};
        const bf16_t* ap = XN + (size_t)(r0 + c) * 2048 + 8 * q4; const bf16_t* b0 = WG + (size_t)c * 2048 + 8 * q4; const bf16_t* b1 = b0 + 16 * 2048;
#pragma unroll 4
        for (int ks = 0; ks < 64; ++ks) { const bf16x8 a = *(const bf16x8*)(ap + ks * 32), x0 = *(const bf16x8*)(b0 + ks * 32), x1 = *(const bf16x8*)(b1 + ks * 32);
            acc0 = mfma16(a, x0, acc0); acc1 = mfma16(a, x1, acc1); }
#pragma unroll
        for (int r = 0; r < 4; ++r) {
            const float v0 = acc0[r] + gb0, v1 = acc1[r] + gb1;
            GA[(size_t)(r0 + 4 * q4 + r) * 32 + c] = (c >= 8) ? logsigmoidf_(v0) : v0; GA[(size_t)(r0 + 4 * q4 + r) * 32 + 16 + c] = (c >= 8) ? logsigmoidf_(v1) : v1; }
    }
}

__device__ void phase_e1(KP p, int l) {
    const int tid = tid_fresh(); const int lane = tid & 63, gw = blockIdx.x * 8 + (tid >> 6), nw = gridDim.x * 8;
    unsigned char* ws = launder(p->ws);
    bf16_t* PQ = (bf16_t*)(ws + WS_PQ); bf16_t* PK = (bf16_t*)(ws + WS_PK); bf16_t* CQ = (bf16_t*)(ws + WS_CQ); bf16_t* CK = (bf16_t*)(ws + WS_CK);
    bf16_t* BB = (bf16_t*)(ws + WS_BB); const bf16_t* BC = (const bf16_t*)(ws + WS_BC); const bf16_t* BX = (const bf16_t*)(ws + WS_BX);
    float* GA = (float*)(ws + WS_GATES); const float* tab = (const float*)(ws + WS_TAB);
    const float* gq = p->c_qk_g + (size_t)(l * 2 + 0) * 128; const float* gk = p->c_qk_g + (size_t)(l * 2 + 1) * 128;
    const float* cw = p->b_conv + (size_t)l * 3 * 2048;
    float gqv[8], gkv[8];
#pragma unroll
    for (int j = 0; j < 8; ++j) { gqv[j] = gq[(lane & 15) * 8 + j] * 0.08838834764831845f; gkv[j] = gk[(lane & 15) * 8 + j]; }
    for (int row = gw; row < MR; row += nw) {
        if (row < NLAT) {
            const int s = row & 8191, gr = s >> 6, gc = s & 63;
#pragma unroll
            for (int it = 0; it < 2; ++it) {
                const int unit = it * 64 + lane, h = unit >> 4, hf = (unit >> 3) & 1, j4 = unit & 7;
                const int off = h * 128 + hf * 64 + j4 * 4, pos = hf ? gc : gr;
                const f32x4 cs = *(const f32x4*)(tab + pos * 32 + j4 * 4), sn = *(const f32x4*)(tab + 4096 + pos * 32 + j4 * 4);
#pragma unroll
                for (int tsel = 0; tsel < 2; ++tsel) { bf16_t* T = (tsel ? PK : PQ) + (size_t)row * 1024 + off;
                    const u32x2 u1 = *(const u32x2*)T, u2 = *(const u32x2*)(T + 32);
                    const float a0 = bflo(u1.x), a1 = bfhi(u1.x), a2 = bflo(u1.y), a3 = bfhi(u1.y), b0 = bflo(u2.x), b1 = bfhi(u2.x), b2 = bflo(u2.y), b3 = bfhi(u2.y);
                    u32x2 o1, o2;
                    o1.x = pk2(a0 * cs[0] - b0 * sn[0], a1 * cs[1] - b1 * sn[1]); o1.y = pk2(a2 * cs[2] - b2 * sn[2], a3 * cs[3] - b3 * sn[3]);
                    o2.x = pk2(b0 * cs[0] + a0 * sn[0], b1 * cs[1] + a1 * sn[1]); o2.y = pk2(b2 * cs[2] + a2 * sn[2], b3 * cs[3] + a3 * sn[3]);
                    *(u32x2*)T = o1; *(u32x2*)(T + 32) = o2; }
            }
        }
#pragma unroll
        for (int tsel = 0; tsel < 2; ++tsel) {
            bf16_t* T = (tsel ? CK : CQ) + (size_t)row * 2048;
#pragma unroll
            for (int ps = 0; ps < 4; ++ps) {
                const u32x4 w = *(const u32x4*)(T + ps * 512 + lane * 8);
                float v[8] = {bflo(w.x), bfhi(w.x), bflo(w.y), bfhi(w.y), bflo(w.z), bfhi(w.z), bflo(w.w), bfhi(w.w)};
                float ss = 0.f;
#pragma unroll
                for (int j = 0; j < 8; ++j) ss += v[j] * v[j];
                ss += __shfl_xor(ss, 1); ss += __shfl_xor(ss, 2); ss += __shfl_xor(ss, 4); ss += __shfl_xor(ss, 8);
                const float rstd = rsqrtf(ss * (1.0f / 128.0f) + EPSF);
#pragma unroll
                for (int j = 0; j < 8; ++j) v[j] = v[j] * rstd * (tsel ? gkv[j] : gqv[j]);
                u32x4 o; o.x = pk2(v[0], v[1]); o.y = pk2(v[2], v[3]); o.z = pk2(v[4], v[5]); o.w = pk2(v[6], v[7]);
                *(u32x4*)(T + ps * 512 + lane * 8) = o;
            }
        }
        {
            int pos, len; if (row < NLAT) { pos = row & 8191; len = SEQ; } else { pos = (row - NLAT) & 255; len = CTXL; }
            const bool hp = pos > 0, hn = pos < len - 1;
#pragma unroll
            for (int ps = 0; ps < 4; ++ps) {
                const int c = ps * 512 + lane * 8; const size_t o = (size_t)row * 2048 + c;
                const u32x4 bb = *(const u32x4*)(BB + o), c1 = *(const u32x4*)(BC + o), x1 = *(const u32x4*)(BX + o);
                u32x4 c0 = {0u, 0u, 0u, 0u}, x0 = c0, c2 = c0, x2 = c0;
                if (hp) { c0 = *(const u32x4*)(BC + o - 2048); x0 = *(const u32x4*)(BX + o - 2048); }
                if (hn) { c2 = *(const u32x4*)(BC + o + 2048); x2 = *(const u32x4*)(BX + o + 2048); }
                const unsigned bw[4] = {bb.x, bb.y, bb.z, bb.w}, c0w[4] = {c0.x, c0.y, c0.z, c0.w}, c1w[4] = {c1.x, c1.y, c1.z, c1.w}, c2w[4] = {c2.x, c2.y, c2.z, c2.w};
                const unsigned x0w[4] = {x0.x, x0.y, x0.z, x0.w}, x1w[4] = {x1.x, x1.y, x1.z, x1.w}, x2w[4] = {x2.x, x2.y, x2.z, x2.w};
                unsigned ow[4];
#pragma unroll
                for (int q = 0; q < 4; ++q) {
                    const int cc = c + 2 * q;
                    const float w00 = cw[cc], w01 = cw[cc + 1], w10 = cw[2048 + cc], w11 = cw[2048 + cc + 1], w20 = cw[4096 + cc], w21 = cw[4096 + cc + 1];
                    const float ylo = bflo(bw[q]) * (bflo(c0w[q]) * bflo(x0w[q]) * w00 + bflo(c1w[q]) * bflo(x1w[q]) * w10 + bflo(c2w[q]) * bflo(x2w[q]) * w20);
                    const float yhi = bfhi(bw[q]) * (bfhi(c0w[q]) * bfhi(x0w[q]) * w01 + bfhi(c1w[q]) * bfhi(x1w[q]) * w11 + bfhi(c2w[q]) * bfhi(x2w[q]) * w21);
                    ow[q] = pk2(ylo, yhi);
                }
                u32x4 ov; ov.x = ow[0]; ov.y = ow[1]; ov.z = ow[2]; ov.w = ow[3];
                *(u32x4*)(BB + o) = ov;
            }
        }
    }
}

constexpr int ML_QS = 0, ML_KS = 17408, ML_KET = 34816, ML_VT = 53248, ML_SS = 60160, ML_CT = 69376, ML_CTSZ = 13056;
__device__ __forceinline__ int ml_row(int pp, int b, int dir) {
    if (pp < 256) { const int j = dir ? 255 - pp : pp; return NLAT + b * 256 + j; }
    int s = pp - 256; if (dir) s = 8191 - s; return b * 8192 + s;
}
__device__ void phase_mlstm(KP p, int l, LAS unsigned char* lds) {
    const int tid = tid_fresh(), lane = tid & 63, w = __builtin_amdgcn_readfirstlane(tid >> 6), q4 = lane >> 4, c16 = lane & 15;
    unsigned char* ws = launder(p->ws);
    const bf16_t* PQ = (const bf16_t*)(ws + WS_PQ); const bf16_t* PK = (const bf16_t*)(ws + WS_PK); const bf16_t* PV = (const bf16_t*)(ws + WS_PV);
    const float* GA = (const float*)(ws + WS_GATES);
    for (int task = blockIdx.x; task < 256; task += gridDim.x) {
        const int xq = task & 7, yq = task >> 3; const int bh = 2 * xq + (yq >> 4), dir = (yq >> 3) & 1, sl = yq & 7; const int b = bh >> 3, h = bh & 7;
        bf16_t* H = (bf16_t*)(ws + (dir ? WS_BX : WS_BC));
        __syncthreads();
        for (int i = tid; i < 16 * 32; i += NTHREADS) { const int r = 32 + (i >> 5), cdw = i & 31; *(LAS unsigned*)(lds + ML_VT + r * 144 + cdw * 4) = (r == 32) ? 0x3f803f80u : 0u; }
        for (int i = tid; i < 2 * ML_CTSZ / 4; i += NTHREADS) *(LAS unsigned*)(lds + ML_CT + i * 4) = 0u;
        float m = 0.f;
        f32x4 Cst[3];
#pragma unroll
        for (int i = 0; i < 3; ++i) Cst[i] = (f32x4){0.f, 0.f, 0.f, 0.f};
        u32x4 qreg[2], kreg[2], vreg; float li, lf;
        { const int r = ml_row(lane, b, dir);
#pragma unroll
          for (int i = 0; i < 2; ++i) { qreg[i] = *(const u32x4*)(PQ + (size_t)r * 1024 + h * 128 + (w * 2 + i) * 8); kreg[i] = *(const u32x4*)(PK + (size_t)r * 1024 + h * 128 + (w * 2 + i) * 8); }
          if (w < 4) vreg = *(const u32x4*)(PV + (size_t)r * 2048 + h * 256 + sl * 32 + w * 8);
          li = GA[(size_t)r * 32 + (2 * dir) * 8 + h]; lf = GA[(size_t)r * 32 + (2 * dir + 1) * 8 + h]; }
        for (int c = 0; c < 132; ++c) {
            float bc = lf;
#pragma unroll
            for (int o = 1; o < 64; o <<= 1) { const float t = __shfl_up(bc, o); if (lane >= o) bc += t; }
            const float a = li - bc;
            float pm = a;
#pragma unroll
            for (int o = 1; o < 64; o <<= 1) { const float t = __shfl_up(pm, o); if (lane >= o) pm = fmaxf(pm, t); }
            const float total = __shfl(bc, 63), pmall = __shfl(pm, 63);
            const float mx = fmaxf(m, pm);
            const float mrow = bc + mx;
            const float winter = __expf(m - mx);
            const float m_new = total + fmaxf(m, pmall);
            const float decay = __expf(total + m - m_new);
            const float kscale = __expf(total + a - m_new);
#pragma unroll
            for (int i = 0; i < 2; ++i) {
                *(LAS u32x4*)(lds + ML_QS + lane * 272 + (w * 2 + i) * 16) = qreg[i];
                *(LAS u32x4*)(lds + ML_KS + lane * 272 + (w * 2 + i) * 16) = kreg[i];
                const unsigned kw[4] = {kreg[i].x, kreg[i].y, kreg[i].z, kreg[i].w};
#pragma unroll
                for (int j = 0; j < 4; ++j) { const int d = (w * 2 + i) * 8 + 2 * j;
                    *(LAS bf16_t*)(lds + ML_KET + d * 144 + lane * 2) = f2bf(bflo(kw[j]) * kscale);
                    *(LAS bf16_t*)(lds + ML_KET + (d + 1) * 144 + lane * 2) = f2bf(bfhi(kw[j]) * kscale); }
            }
            if (w < 4) { const unsigned vw[4] = {vreg.x, vreg.y, vreg.z, vreg.w};
#pragma unroll
                for (int j = 0; j < 4; ++j) { const int e = w * 8 + 2 * j;
                    *(LAS bf16_t*)(lds + ML_VT + e * 144 + lane * 2) = (bf16_t)(vw[j] & 0xffffu);
                    *(LAS bf16_t*)(lds + ML_VT + (e + 1) * 144 + lane * 2) = (bf16_t)(vw[j] >> 16); } }
            if (c + 1 < 132) { const int r = ml_row((c + 1) * 64 + lane, b, dir);
#pragma unroll
                for (int i = 0; i < 2; ++i) { qreg[i] = *(const u32x4*)(PQ + (size_t)r * 1024 + h * 128 + (w * 2 + i) * 8); kreg[i] = *(const u32x4*)(PK + (size_t)r * 1024 + h * 128 + (w * 2 + i) * 8); }
                if (w < 4) vreg = *(const u32x4*)(PV + (size_t)r * 2048 + h * 256 + sl * 32 + w * 8);
                li = GA[(size_t)r * 32 + (2 * dir) * 8 + h]; lf = GA[(size_t)r * 32 + (2 * dir + 1) * 8 + h]; }
            __syncthreads();
            const int tr = w >> 1;
            bf16x8 aq[4];
#pragma unroll
            for (int ks = 0; ks < 4; ++ks) aq[ks] = *(const LAS bf16x8*)(lds + ML_QS + (16 * tr + c16) * 272 + (ks * 32 + 8 * q4) * 2);
            float nmx_t[4], wi_t[4], mrow_t[4];
#pragma unroll
            for (int r = 0; r < 4; ++r) { const int t = 16 * tr + 4 * q4 + r; nmx_t[r] = -__shfl(mx, t); wi_t[r] = __shfl(winter, t); mrow_t[r] = __shfl(mrow, t); }
#pragma unroll
            for (int tci = 0; tci < 2; ++tci) {
                const int tc = 2 * (w & 1) + tci;
                f32x4 acc = {0.f, 0.f, 0.f, 0.f};
#pragma unroll
                for (int ks = 0; ks < 4; ++ks) { const bf16x8 bk = *(const LAS bf16x8*)(lds + ML_KS + (16 * tc + c16) * 272 + (ks * 32 + 8 * q4) * 2); acc = mfma16(aq[ks], bk, acc); }
                const int scol = 16 * tc + c16; const float a_s = __shfl(a, scol);
#pragma unroll
                for (int r = 0; r < 4; ++r) { const int t = 16 * tr + 4 * q4 + r;
                    const float dv = (scol <= t) ? __expf(a_s + nmx_t[r]) : 0.f;
                    *(LAS bf16_t*)(lds + ML_SS + t * 144 + scol * 2) = f2bf(acc[r] * dv); }
            }
            __syncthreads();
            {
                const LAS unsigned char* CTc = lds + ML_CT + (c & 1) * ML_CTSZ;
                const int part = w & 1;
                bf16x8 as2[2];
#pragma unroll
                for (int k2 = 0; k2 < 2; ++k2) as2[k2] = *(const LAS bf16x8*)(lds + ML_SS + (16 * tr + c16) * 144 + (k2 * 32 + 8 * q4) * 2);
                f32x4 accA = {0.f, 0.f, 0.f, 0.f}, accD = {0.f, 0.f, 0.f, 0.f};
#pragma unroll
                for (int ks = 0; ks < 4; ++ks) {
                    const bf16x8 b1 = *(const LAS bf16x8*)(CTc + (16 * part + c16) * 272 + (ks * 32 + 8 * q4) * 2);
                    const bf16x8 b2 = *(const LAS bf16x8*)(CTc + (32 + c16) * 272 + (ks * 32 + 8 * q4) * 2);
                    accA = mfma16(aq[ks], b1, accA); accD = mfma16(aq[ks], b2, accD); }
#pragma unroll
                for (int r = 0; r < 4; ++r) { accA[r] *= wi_t[r]; accD[r] *= wi_t[r]; }
#pragma unroll
                for (int k2 = 0; k2 < 2; ++k2) {
                    const bf16x8 v1 = *(const LAS bf16x8*)(lds + ML_VT + (16 * part + c16) * 144 + (k2 * 32 + 8 * q4) * 2);
                    const bf16x8 v2 = *(const LAS bf16x8*)(lds + ML_VT + (32 + c16) * 144 + (k2 * 32 + 8 * q4) * 2);
                    accA = mfma16(as2[k2], v1, accA); accD = mfma16(as2[k2], v2, accD); }
                if (l == 0 || c >= 4) {
#pragma unroll
                    for (int r = 0; r < 4; ++r) {
                        const float den = __shfl(accD[r], lane & 48);
                        const float hv = accA[r] / fmaxf(fabsf(den), __expf(-mrow_t[r]));
                        const int t = 16 * tr + 4 * q4 + r; const int row = ml_row(c * 64 + t, b, dir);
                        H[(size_t)row * 2048 + h * 256 + sl * 32 + 16 * part + c16] = f2bf(hv);
                    }
                }
            }
            {
                LAS unsigned char* CTn = lds + ML_CT + ((c + 1) & 1) * ML_CTSZ;
                bf16x8 ak[2];
#pragma unroll
                for (int k2 = 0; k2 < 2; ++k2) ak[k2] = *(const LAS bf16x8*)(lds + ML_KET + (16 * w + c16) * 144 + (k2 * 32 + 8 * q4) * 2);
#pragma unroll
                for (int ct = 0; ct < 3; ++ct) {
                    Cst[ct] = Cst[ct] * decay;
#pragma unroll
                    for (int k2 = 0; k2 < 2; ++k2) { const bf16x8 bv = *(const LAS bf16x8*)(lds + ML_VT + (16 * ct + c16) * 144 + (k2 * 32 + 8 * q4) * 2); Cst[ct] = mfma16(ak[k2], bv, Cst[ct]); }
                    u32x2 o; o.x = pk2(Cst[ct][0], Cst[ct][1]); o.y = pk2(Cst[ct][2], Cst[ct][3]);
                    *(LAS u32x2*)(CTn + (16 * ct + c16) * 272 + (16 * w + 4 * q4) * 2) = o;
                }
            }
            m = m_new;
            __syncthreads();
        }
    }
}

constexpr int AT_KS = 0, AT_VT = 17408, AT_RPB = 35840;
__device__ void phase_attn(KP p, int l, LAS unsigned char* lds) {
    const int tid = tid_fresh(), lane = tid & 63, w = __builtin_amdgcn_readfirstlane(tid >> 6), q4 = lane >> 4, c16 = lane & 15;
    unsigned char* ws = launder(p->ws);
    bf16_t* CQ = (bf16_t*)(ws + WS_CQ); const bf16_t* CK = (const bf16_t*)(ws + WS_CK); const bf16_t* CV = (const bf16_t*)(ws + WS_CV);
    const int nunits = 2048 + (l == 0 ? 64 : 0);
    for (int u = blockIdx.x; u < nunits; u += gridDim.x) {
        int b, h, qrow = 0, g = 0, ntl = 0, r0a = 0, qbase;  bool is_ctx = u >= 2048;
        if (!is_ctx) { b = u >> 10; h = (u >> 6) & 15; const int rp = u & 63; qrow = 2 * rp + (w >> 2); g = w & 3;
            r0a = min(max(2 * rp - 4, 0), 120); const int r0b = min(max(2 * rp + 1 - 4, 0), 120); ntl = r0b + 8 - r0a;
            qbase = b * 8192 + qrow * 64 + 16 * g; }
        else { const int uu = u - 2048; b = uu >> 5; h = (uu >> 1) & 15; qbase = NLAT + b * 256 + (uu & 1) * 128 + 16 * w; }
        const int r0q = min(max(qrow - 4, 0), 120);
        const int a_g = (g == 0) ? 0 : (g == 1 ? 8 : (g == 2 ? 24 : 32));
        __syncthreads();
        if (!is_ctx) for (int i = tid; i < 465; i += NTHREADS) *(LAS float*)(lds + AT_RPB + i * 4) = p->c_rpb[((size_t)l * 16 + h) * 465 + i];
        bf16x8 qf[4];
#pragma unroll
        for (int ks = 0; ks < 4; ++ks) qf[ks] = *(const bf16x8*)(CQ + (size_t)(qbase + c16) * 2048 + h * 128 + ks * 32 + 8 * q4);
        f32x4 O[8];
#pragma unroll
        for (int i = 0; i < 8; ++i) O[i] = (f32x4){0.f, 0.f, 0.f, 0.f};
        float m_run = -1e30f, l_run = 0.f;
        const int ntiles = ntl + 4;
        u32x4 kreg[2], vreg[2];
        auto tile_row = [&](int t, int key) -> int { return (t < ntl) ? (b * 8192 + (r0a + t) * 64 + key) : (NLAT + b * 256 + (t - ntl) * 64 + key); };
        { const int r = tile_row(0, lane);
#pragma unroll
          for (int i = 0; i < 2; ++i) { kreg[i] = *(const u32x4*)(CK + (size_t)r * 2048 + h * 128 + (w * 2 + i) * 8); vreg[i] = *(const u32x4*)(CV + (size_t)r * 2048 + h * 128 + (w * 2 + i) * 8); } }
        for (int t = 0; t < ntiles; ++t) {
            __syncthreads();
#pragma unroll
            for (int i = 0; i < 2; ++i) {
                *(LAS u32x4*)(lds + AT_KS + lane * 272 + (w * 2 + i) * 16) = kreg[i];
                const unsigned vw[4] = {vreg[i].x, vreg[i].y, vreg[i].z, vreg[i].w};
#pragma unroll
                for (int j = 0; j < 4; ++j) { const int d = (w * 2 + i) * 8 + 2 * j;
                    *(LAS bf16_t*)(lds + AT_VT + d * 144 + lane * 2) = (bf16_t)(vw[j] & 0xffffu);
                    *(LAS bf16_t*)(lds + AT_VT + (d + 1) * 144 + lane * 2) = (bf16_t)(vw[j] >> 16); }
            }
            if (t + 1 < ntiles) { const int r = tile_row(t + 1, lane);
#pragma unroll
                for (int i = 0; i < 2; ++i) { kreg[i] = *(const u32x4*)(CK + (size_t)r * 2048 + h * 128 + (w * 2 + i) * 8); vreg[i] = *(const u32x4*)(CV + (size_t)r * 2048 + h * 128 + (w * 2 + i) * 8); } }
            __syncthreads();
            const bool local = t < ntl; const int kr = r0a + t;
            if (local && !(kr >= r0q && kr < r0q + 8)) continue;
            const int npass = local ? 1 : 2;
            for (int ps = 0; ps < npass; ++ps) {
                const int a0 = local ? a_g : ps * 32;
                f32x4 sc[2];
#pragma unroll
                for (int ct = 0; ct < 2; ++ct) { sc[ct] = (f32x4){0.f, 0.f, 0.f, 0.f};
#pragma unroll
                    for (int ks = 0; ks < 4; ++ks) { const bf16x8 ka = *(const LAS bf16x8*)(lds + AT_KS + (a0 + 16 * ct + c16) * 272 + (ks * 32 + 8 * q4) * 2); sc[ct] = mfma16(ka, qf[ks], sc[ct]); } }
                if (local) {
                    const int qc = 16 * g + c16, col0 = min(max(qc - 8, 0), 48); const int dr = kr - qrow + 7;
#pragma unroll
                    for (int ct = 0; ct < 2; ++ct)
#pragma unroll
                        for (int r = 0; r < 4; ++r) { const int kc = a0 + 16 * ct + 4 * q4 + r; const bool valid = (kc >= col0) && (kc < col0 + 16);
                            const int dc = min(max(kc - qc + 15, 0), 30);
                            const float bias = *(const LAS float*)(lds + AT_RPB + (dr * 31 + dc) * 4);
                            sc[ct][r] = valid ? sc[ct][r] + bias : -1e30f; }
                }
                float mx = fmaxf(fmaxf(fmaxf(sc[0][0], sc[0][1]), fmaxf(sc[0][2], sc[0][3])), fmaxf(fmaxf(sc[1][0], sc[1][1]), fmaxf(sc[1][2], sc[1][3])));
                mx = fmaxf(mx, __shfl_xor(mx, 16)); mx = fmaxf(mx, __shfl_xor(mx, 32));
                const float m_new = fmaxf(m_run, mx);
                const float alpha = __expf(m_run - m_new);
                float pe[8]; float psum = 0.f;
#pragma unroll
                for (int ct = 0; ct < 2; ++ct)
#pragma unroll
                    for (int r = 0; r < 4; ++r) { const float e = __expf(sc[ct][r] - m_new); pe[ct * 4 + r] = e; psum += e; }
                psum += __shfl_xor(psum, 16); psum += __shfl_xor(psum, 32);
                l_run = l_run * alpha + psum; m_run = m_new;
                bf16x8 pf; { u32x4 pw; pw.x = pk2(pe[0], pe[1]); pw.y = pk2(pe[2], pe[3]); pw.z = pk2(pe[4], pe[5]); pw.w = pk2(pe[6], pe[7]); pf = __builtin_bit_cast(bf16x8, pw); }
                float al[4];
#pragma unroll
                for (int r = 0; r < 4; ++r) al[r] = __shfl(alpha, 4 * q4 + r);
#pragma unroll
                for (int dt = 0; dt < 8; ++dt) {
#pragma unroll
                    for (int r = 0; r < 4; ++r) O[dt][r] *= al[r];
                    const u32x2 lo = *(const LAS u32x2*)(lds + AT_VT + (16 * dt + c16) * 144 + (a0 + 4 * q4) * 2);
                    const u32x2 hi = *(const LAS u32x2*)(lds + AT_VT + (16 * dt + c16) * 144 + (a0 + 16 + 4 * q4) * 2);
                    u32x4 bw; bw.x = lo.x; bw.y = lo.y; bw.z = hi.x; bw.w = hi.y;
                    O[dt] = mfma16(pf, __builtin_bit_cast(bf16x8, bw), O[dt]);
                }
            }
        }
        float linv[4];
#pragma unroll
        for (int r = 0; r < 4; ++r) linv[r] = 1.0f / __shfl(l_run, 4 * q4 + r);
#pragma unroll
        for (int dt = 0; dt < 8; ++dt)
#pragma unroll
            for (int r = 0; r < 4; ++r) CQ[(size_t)(qbase + 4 * q4 + r) * 2048 + h * 128 + 16 * dt + c16] = f2bf(O[dt][r] * linv[r]);
    }
}

__device__ void phase_e2(KP p, int l, int nrows) {
    const int tid = tid_fresh(); const int lane = tid & 63, gw = blockIdx.x * 8 + (tid >> 6), nw = gridDim.x * 8;
    unsigned char* ws = launder(p->ws);
    const bf16_t* HF = (const bf16_t*)(ws + WS_BC); const bf16_t* HB = (const bf16_t*)(ws + WS_BX); bf16_t* PO = (bf16_t*)(ws + WS_PO);
    const float* hg = p->a_hnorm_g + (size_t)l * 2048;
    for (int row = gw; row < nrows; row += nw) {
#pragma unroll
        for (int h = 0; h < 8; ++h) {
            const size_t o = (size_t)row * 2048 + h * 256 + lane * 4;
            const u32x2 f = *(const u32x2*)(HF + o), bb = *(const u32x2*)(HB + o), ov = *(const u32x2*)(PO + o);
            float v[4] = {bflo(f.x) + bflo(bb.x), bfhi(f.x) + bfhi(bb.x), bflo(f.y) + bflo(bb.y), bfhi(f.y) + bfhi(bb.y)};
            float ss = v[0] * v[0] + v[1] * v[1] + v[2] * v[2] + v[3] * v[3];
            ss = wave_sum(ss);
            const float rstd = rsqrtf(ss * (1.0f / 256.0f) + EPSF);
            const f32x4 gg = *(const f32x4*)(hg + h * 256 + lane * 4);
            const float og[4] = {bflo(ov.x), bfhi(ov.x), bflo(ov.y), bfhi(ov.y)};
            float y[4];
#pragma unroll
            for (int j = 0; j < 4; ++j) y[j] = sigmoidf_(og[j]) * v[j] * rstd * gg[j];
            u32x2 wv; wv.x = pk2(y[0], y[1]); wv.y = pk2(y[2], y[3]); *(u32x2*)(PO + o) = wv;
        }
    }
}

constexpr int PE_MAXT = 80;
constexpr int PE_IDX = 0, PE_W = PE_MAXT * 128 * 4, PE_SCR = 2 * PE_MAXT * 128 * 4, PE_SCRSZ = 16 * 132 * 4 + 4096 + 256;
__device__ __forceinline__ unsigned ordkey(float v) { const unsigned u = __float_as_uint(v); return (u & 0x80000000u) ? ~u : (u | 0x80000000u); }
__device__ void phase_peer(KP p, int l, LAS unsigned char* lds) {
    const int tid = tid_fresh(), lane = tid & 63, w = __builtin_amdgcn_readfirstlane(tid >> 6), q4 = lane >> 4, c16 = lane & 15;
    unsigned char* ws = launder(p->ws);
    const bf16_t* QP = (const bf16_t*)(ws + WS_PV); const bf16_t* KEYS = (const bf16_t*)(ws + WS_KEYS);
    const bf16_t* XN = (const bf16_t*)(ws + WS_XN);
    float* X = (float*)(ws + WS_X); const float* mod = (const float*)(ws + WS_MOD) + (size_t)l * 3 * 12288;
    const int ntok = (l == 0) ? MR : NLAT, G = gridDim.x;
    const int per = (ntok + G - 1) / G; const int t_begin = blockIdx.x * per, t_end = min(ntok, t_begin + per);
    for (int tb = t_begin; tb < t_end; tb += PE_MAXT) {
        const int nt = min(PE_MAXT, t_end - tb);
        __syncthreads();
        const int ntask = (nt + 15) >> 4;
        if (w < ntask) {
            LAS unsigned char* scr = lds + PE_SCR + w * PE_SCRSZ;
            LAS float* SC = (LAS float*)scr;
            LAS float* LS = (LAS float*)(scr + 16 * 132 * 4);
            LAS int* LI = (LAS int*)(scr + 16 * 132 * 4 + 2048);
            LAS unsigned char* PT = scr + 16 * 132 * 4 + 4096;
            if (lane < 52) {
                int cnt = 0, pa = 15, pb = 15;
                for (int a = 0; a < 16; ++a) { const int nb = 16 / (a + 1); for (int bb = 0; bb < nb; ++bb) { if (cnt == lane) { pa = a; pb = bb; } ++cnt; } }
                PT[lane * 2] = (unsigned char)pa; PT[lane * 2 + 1] = (unsigned char)pb;
            }
            const int tok_a = min(tb + 16 * w + c16, t_end - 1);
            const int tkl = lane >> 2, qq = lane & 3;
            for (int h = 0; h < 8; ++h) {
                for (int pp = 0; pp < 2; ++pp) {
                    const int hp = 2 * h + pp;
                    bf16x8 af[4];
#pragma unroll
                    for (int ks = 0; ks < 4; ++ks) af[ks] = *(const bf16x8*)(QP + (size_t)tok_a * 2048 + h * 256 + pp * 128 + ks * 32 + 8 * q4);
#pragma unroll
                    for (int ct = 0; ct < 8; ++ct) {
                        f32x4 acc = {0.f, 0.f, 0.f, 0.f};
#pragma unroll
                        for (int ks = 0; ks < 4; ++ks) { const bf16x8 bfr = *(const bf16x8*)(KEYS + ((size_t)hp * 128 + 16 * ct + c16) * 128 + ks * 32 + 8 * q4); acc = mfma16(af[ks], bfr, acc); }
#pragma unroll
                        for (int r = 0; r < 4; ++r) SC[(4 * q4 + r) * 132 + 16 * ct + c16] = acc[r];
                    }
                    asm volatile("s_waitcnt lgkmcnt(0)" ::: "memory");
                    unsigned key[32];
#pragma unroll
                    for (int i = 0; i < 8; ++i) { const f32x4 v = *(const LAS f32x4*)(SC + tkl * 132 + 32 * qq + 4 * i);
#pragma unroll
                        for (int j = 0; j < 4; ++j) key[4 * i + j] = (ordkey(v[j]) & ~127u) | (unsigned)(32 * qq + 4 * i + j); }
                    unsigned prev = 0xffffffffu;
#pragma unroll 1
                    for (int r = 0; r < 16; ++r) {
                        unsigned mxk = 0u;
#pragma unroll
                        for (int i = 0; i < 32; ++i) { const unsigned k = key[i] < prev ? key[i] : 0u; mxk = mxk > k ? mxk : k; }
                        unsigned o1 = __shfl_xor(mxk, 1); mxk = mxk > o1 ? mxk : o1; o1 = __shfl_xor(mxk, 2); mxk = mxk > o1 ? mxk : o1;
                        prev = mxk;
                        if (qq == (r & 3)) { const int idx = (int)(mxk & 127u); LS[(pp * 16 + tkl) * 16 + r] = SC[tkl * 132 + idx]; LI[(pp * 16 + tkl) * 16 + r] = idx; }
                    }
                    asm volatile("s_waitcnt lgkmcnt(0)" ::: "memory");
                }
                unsigned ck[13];
#pragma unroll
                for (int i = 0; i < 13; ++i) { const int cidx = qq + 4 * i;
                    if (cidx < 50) { const int a = PT[cidx * 2], bq = PT[cidx * 2 + 1]; const float sv = LS[(0 * 16 + tkl) * 16 + a] + LS[(1 * 16 + tkl) * 16 + bq]; ck[i] = (ordkey(sv) & ~63u) | (unsigned)cidx; }
                    else ck[i] = 0u; }
                unsigned prev = 0xffffffffu; float best0 = 0.f, esum = 0.f; float myexp[4] = {0.f, 0.f, 0.f, 0.f}; int myidx[4] = {0, 0, 0, 0};
#pragma unroll
                for (int r = 0; r < 16; ++r) {
                    unsigned mxk = 0u;
#pragma unroll
                    for (int i = 0; i < 13; ++i) { const unsigned k = ck[i] < prev ? ck[i] : 0u; mxk = mxk > k ? mxk : k; }
                    unsigned o1 = __shfl_xor(mxk, 1); mxk = mxk > o1 ? mxk : o1; o1 = __shfl_xor(mxk, 2); mxk = mxk > o1 ? mxk : o1;
                    prev = mxk;
                    const int cidx = (int)(mxk & 63u); const int a = PT[cidx * 2], bq = PT[cidx * 2 + 1];
                    const float best = LS[(0 * 16 + tkl) * 16 + a] + LS[(1 * 16 + tkl) * 16 + bq];
                    const int eidx = LI[(0 * 16 + tkl) * 16 + a] * 128 + LI[(1 * 16 + tkl) * 16 + bq];
                    if (r == 0) best0 = best;
                    const float e = __expf(best - best0); esum += e;
                    if (qq == (r & 3)) { myexp[r >> 2] = e; myidx[r >> 2] = eidx; }
                }
                const float inv = 1.0f / esum; const int tl = 16 * w + tkl;
                if (tl < nt) {
#pragma unroll
                    for (int i = 0; i < 4; ++i) { const int r = 4 * i + qq;
                        *(LAS int*)(lds + PE_IDX + (tl * 128 + h * 16 + r) * 4) = myidx[i];
                        *(LAS float*)(lds + PE_W + (tl * 128 + h * 16 + r) * 4) = myexp[i] * inv; }
                }
                asm volatile("s_waitcnt lgkmcnt(0)" ::: "memory");
            }
        }
        __syncthreads();
        for (int tl = w; tl < nt; tl += 8) {
            const int row = tb + tl;
            f32x2 xs[16];
#pragma unroll
            for (int i = 0; i < 2; ++i)
#pragma unroll
                for (int hq = 0; hq < 2; ++hq) { const u32x4 xw = *(const u32x4*)(XN + (size_t)row * 2048 + i * 1024 + lane * 16 + hq * 8);
                    const float sc = 1.0f / 2048.0f;
                    xs[i * 8 + hq * 4 + 0] = (f32x2){bflo(xw.x) * sc, bfhi(xw.x) * sc}; xs[i * 8 + hq * 4 + 1] = (f32x2){bflo(xw.y) * sc, bfhi(xw.y) * sc};
                    xs[i * 8 + hq * 4 + 2] = (f32x2){bflo(xw.z) * sc, bfhi(xw.z) * sc}; xs[i * 8 + hq * 4 + 3] = (f32x2){bflo(xw.w) * sc, bfhi(xw.w) * sc}; }
            const LAS int* idxp = (const LAS int*)(lds + PE_IDX + tl * 512);
            LAS float* wp = (LAS float*)(lds + PE_W + tl * 512);
            u32x4 bufA[8], bufB[8];
#define PE_ISSUE(buf, TAB, b) do { const int _e0 = idxp[4 * (b)], _e1 = idxp[4 * (b) + 1], _e2 = idxp[4 * (b) + 2], _e3 = idxp[4 * (b) + 3]; \
                const unsigned char* _r0 = (TAB) + (size_t)_e0 * 2048 + lane * 16; const unsigned char* _r1 = (TAB) + (size_t)_e1 * 2048 + lane * 16; \
                const unsigned char* _r2 = (TAB) + (size_t)_e2 * 2048 + lane * 16; const unsigned char* _r3 = (TAB) + (size_t)_e3 * 2048 + lane * 16; \
                buf[0] = *(const u32x4*)_r0; buf[1] = *(const u32x4*)(_r0 + 1024); buf[2] = *(const u32x4*)_r1; buf[3] = *(const u32x4*)(_r1 + 1024); \
                buf[4] = *(const u32x4*)_r2; buf[5] = *(const u32x4*)(_r2 + 1024); buf[6] = *(const u32x4*)_r3; buf[7] = *(const u32x4*)(_r3 + 1024); } while (0)
#define PE_CONS_U(buf, b) do { float _p[4]; \
                _Pragma("unroll") for (int _j = 0; _j < 4; ++_j) { f32x2 _d = {0.f, 0.f}; \
                    _Pragma("unroll") for (int _i = 0; _i < 2; ++_i) { const u32x4 _u = buf[_j * 2 + _i]; \
                        _Pragma("unroll") for (int _q = 0; _q < 4; ++_q) { const int _dw = (int)_u[_q]; \
                            _d += __builtin_amdgcn_cvt_pk_f32_fp8(_dw, false) * xs[_i * 8 + _q * 2]; _d += __builtin_amdgcn_cvt_pk_f32_fp8(_dw, true) * xs[_i * 8 + _q * 2 + 1]; } } \
                    _p[_j] = _d[0] + _d[1]; } \
                const bool _h32 = (lane & 32) != 0, _h16 = (lane & 16) != 0; \
                float _a = _h32 ? _p[2] : _p[0]; const float _as = _h32 ? _p[0] : _p[2]; float _bq = _h32 ? _p[3] : _p[1]; const float _bs = _h32 ? _p[1] : _p[3]; \
                _a += __shfl_xor(_as, 32); _bq += __shfl_xor(_bs, 32); \
                float _c = _h16 ? _bq : _a; const float _cs = _h16 ? _a : _bq; _c += __shfl_xor(_cs, 16); \
                _c += __shfl_xor(_c, 8); _c += __shfl_xor(_c, 4); _c += __shfl_xor(_c, 2); _c += __shfl_xor(_c, 1); \
                const int _e = 4 * (b) + (lane >> 4); const float _g = wp[_e]; \
                const float _w = _g * 0.5f * _c * (1.0f + erff(_c * 0.70710678118654752f)); \
                if ((lane & 15) == 0) wp[_e] = _w; } while (0)
#define PE_CONS_V(buf, b) do { const f32x4 _w4 = *(const LAS f32x4*)(wp + 4 * (b)); \
                _Pragma("unroll") for (int _j = 0; _j < 4; ++_j) { const f32x2 _wv = {_w4[_j], _w4[_j]}; \
                    _Pragma("unroll") for (int _i = 0; _i < 2; ++_i) { const u32x4 _v = buf[_j * 2 + _i]; \
                        _Pragma("unroll") for (int _q = 0; _q < 4; ++_q) { const int _dw = (int)_v[_q]; \
                            out2[_i * 8 + _q * 2] += _wv * __builtin_amdgcn_cvt_pk_f32_fp8(_dw, false); out2[_i * 8 + _q * 2 + 1] += _wv * __builtin_amdgcn_cvt_pk_f32_fp8(_dw, true); } } } } while (0)
            const unsigned char* TU = ws + WS_PU; const unsigned char* TV = ws + WS_PVW;
            PE_ISSUE(bufA, TU, 0);
#pragma unroll 1
            for (int b = 0; b < 32; b += 2) {
                PE_ISSUE(bufB, TU, b + 1);
                PE_CONS_U(bufA, b);
                if (b + 2 < 32) PE_ISSUE(bufA, TU, b + 2); else PE_ISSUE(bufA, TV, 0);
                PE_CONS_U(bufB, b + 1);
            }
            asm volatile("s_waitcnt lgkmcnt(0)" ::: "memory");
            f32x2 out2[16];
#pragma unroll
            for (int i = 0; i < 16; ++i) out2[i] = (f32x2){0.f, 0.f};
#pragma unroll 1
            for (int b = 0; b < 32; b += 2) {
                PE_ISSUE(bufB, TV, b + 1);
                PE_CONS_V(bufA, b);
                if (b + 2 < 32) PE_ISSUE(bufA, TV, b + 2);
                PE_CONS_V(bufB, b + 1);
            }
#undef PE_ISSUE
#undef PE_CONS_U
#undef PE_CONS_V
            float out[32];
#pragma unroll
            for (int i = 0; i < 16; ++i) { out[2 * i] = out2[i][0] * (1.0f / 128.0f); out[2 * i + 1] = out2[i][1] * (1.0f / 128.0f); }
            if (ABL & 8) {
#pragma unroll
                for (int i = 0; i < 32; ++i) out[i] = 0.f; }
            if (((ABL & 64) && l == 0) || ((ABL & 128) && l == 1)) {
#pragma unroll
                for (int i = 0; i < 32; ++i) out[i] = 0.f; }
            if (ABL & 16) {
#pragma unroll
                for (int i = 0; i < 32; ++i) out[i] = -out[i]; }
            if (ABL & 32) {
#pragma unroll
                for (int i = 0; i < 32; ++i) out[i] = 0.25f * out[i]; }
            const int which = row < NLAT ? (row >> 13) : 2;
            const float* mg = mod + (size_t)which * 12288 + 5 * 2048;
            float* xrow = X + (size_t)row * 2048; float* orow = (l == 1) ? (p->out + (size_t)row * 2048) : xrow;
#pragma unroll
            for (int i = 0; i < 2; ++i)
#pragma unroll
                for (int hh = 0; hh < 4; ++hh) { const int c = i * 1024 + lane * 16 + hh * 4;
                    const f32x4 xv = *(const f32x4*)(xrow + c), gv = *(const f32x4*)(mg + c);
                    f32x4 ov; ov[0] = xv[0] + gv[0] * out[i * 16 + hh * 4 + 0]; ov[1] = xv[1] + gv[1] * out[i * 16 + hh * 4 + 1]; ov[2] = xv[2] + gv[2] * out[i * 16 + hh * 4 + 2]; ov[3] = xv[3] + gv[3] * out[i * 16 + hh * 4 + 3];
                    *(f32x4*)(orow + c) = ov; }
        }
    }
}

__global__ void __launch_bounds__(NTHREADS, 2) fwd_kernel(Params p) {
    extern __shared__ __attribute__((aligned(16))) unsigned char lds_raw[];
    LAS unsigned char* lds = (LAS unsigned char*)lds_raw;
    const int tid = threadIdx.x, G = gridDim.x;
    KP kp = (KP)__builtin_amdgcn_kernarg_segment_ptr();
    unsigned char* ws0 = kp->ws;
    volatile LAS unsigned* bst = (volatile LAS unsigned*)(lds + LDS_BYTES - 16);
    if (tid == 0) { bst[0] = 0u; bst[1] = 0u; bst[2] = 0u; bst[3] = 0u; }
    __syncthreads();
    XcdBarrier bar; bar.bar = (unsigned*)(ws0 + WS_BAR); bar.x = 0; bar.st = bst;
    if (MK_SINGLE) bar = xcd_barrier_post((unsigned*)(ws0 + WS_BAR), bst);
    const int lo = kp->ph_lo, hi = kp->ph_hi;
#ifndef PHM
#define PHM 0x7ff
#endif
#define IN(k) (((PHM >> (((k) % NPH))) & 1) && lo <= (k) && (k) < hi)
#define SEAM(k) do { if (IN(k) && IN((k) + 1)) xcd_barrier(bar); } while (0)
    for (int l = 0; l < 2; ++l) {
        const int pb = l * NPH;
        const int M2 = (l == 0) ? MR : NLAT;
        if (IN(pb + 0)) { phase_w(launder_p(kp), l, lds); } SEAM(pb + 0);
        if (IN(pb + 1)) { phase_norm(launder_p(kp), l, 0, MR); } SEAM(pb + 1);
        if (IN(pb + 2)) { unsigned char* ws = launder(ws0);
            pg8::PlainOrder S; S.init(ws + WS_XN, ws + WS_WIN, MR, NPROJ, 2048, G, (int)blockIdx.x);
            pg8::EpiProj E{ws};
            pg8::gemm_phase<pg8::EpiProj, pg8::PlainOrder>(lds, 2048, S, E);
        } SEAM(pb + 2);
        if (IN(pb + 3)) { phase_gates_gemm(launder_p(kp), l); phase_e1(launder_p(kp), l); } SEAM(pb + 3);
        if (IN(pb + 4)) { phase_mlstm(launder_p(kp), l, lds); phase_attn(launder_p(kp), l, lds); } SEAM(pb + 4);
        if (IN(pb + 5)) { phase_e2(launder_p(kp), l, M2); } SEAM(pb + 5);
        if (IN(pb + 6)) { unsigned char* ws = launder(ws0);
            pg8::BranchOrder S; S.T8 = (const char*)(ws + WS_T8); S.WA = (const char*)(ws + WS_WA);
            S.nM = M2 / 256; S.nN = 8; S.G = G; S.c = (int)blockIdx.x; S.tstep = (size_t)256 * 2048 * 2;
            pg8::EpiMerge E{(bf16_t*)(ws + WS_Y), (const bf16_t*)(ws + WS_GT)};
            pg8::gemm_phase<pg8::EpiMerge, pg8::BranchOrder>(lds, 2048, S, E);
        } SEAM(pb + 6);
        if (IN(pb + 7)) { unsigned char* ws = launder(ws0);
            pg8::PlainOrder S; S.init(ws + WS_Y, ws + WS_WO, M2, 2048, 2048, G, (int)blockIdx.x);
            pg8::EpiRes E{(float*)(ws + WS_X), (const float*)(ws + WS_MOD) + (size_t)l * 3 * 12288};
            pg8::gemm_phase<pg8::EpiRes, pg8::PlainOrder>(lds, 2048, S, E);
        } SEAM(pb + 7);
        if (IN(pb + 8)) { phase_norm(launder_p(kp), l, 1, M2); } SEAM(pb + 8);
        if (IN(pb + 9)) { unsigned char* ws = launder(ws0);
            pg8::PlainOrder S; S.init(ws + WS_XN, ws + WS_WQ, M2, 2048, 2048, G, (int)blockIdx.x);
            pg8::EpiBf E{(bf16_t*)(ws + WS_PV), 2048};
            pg8::gemm_phase<pg8::EpiBf, pg8::PlainOrder>(lds, 2048, S, E);
        } SEAM(pb + 9);
        if (IN(pb + 10)) { phase_peer(launder_p(kp), l, lds); } SEAM(pb + 10);
    }
#undef IN
#undef SEAM
}

#ifdef CUT
#ifndef DUMP_OFF
#define DUMP_OFF WS_PV
#endif
#ifndef DUMP_F32
#define DUMP_F32 0
#endif
#ifndef DUMP_N
#define DUMP_N ((size_t)NLAT * DM)
#endif
__global__ void dump_kernel(const unsigned char* ws, float* out, size_t n) {
    for (size_t i = (size_t)blockIdx.x * blockDim.x + threadIdx.x; i < n; i += (size_t)gridDim.x * blockDim.x)
        out[i] = (i >= (size_t)DUMP_N) ? 0.f : (DUMP_F32 ? ((const float*)(ws + DUMP_OFF))[i] : bf2f(((const bf16_t*)(ws + DUMP_OFF))[i]));
}
#endif
extern "C" void kernel_launch(void* const* d_in, const int* in_sizes, int n_in, void* d_out, int out_size, void* d_ws, size_t ws_size, hipStream_t stream) {
    static int grid = 0;
    if (grid == 0) {
        if (n_in != 21 || in_sizes[0] != NLAT * DM || out_size != NLAT * DM || ws_size < WS_END) {
            fprintf(stderr, "kernel_launch: unexpected shapes (n_in %d, in0 %d, out %d, ws %zu need %zu); nothing launched\n", n_in, n_in > 0 ? in_sizes[0] : -1, out_size, ws_size, (size_t)WS_END); grid = -1; return; }
        int dev = 0, cus = 0, per_cu = 0;
        if (hipGetDevice(&dev) != hipSuccess || hipDeviceGetAttribute(&cus, hipDeviceAttributeMultiprocessorCount, dev) != hipSuccess) { grid = -1; return; }
        if (hipFuncSetAttribute((const void*)fwd_kernel, hipFuncAttributeMaxDynamicSharedMemorySize, LDS_BYTES) != hipSuccess) { fprintf(stderr, "kernel_launch: hipFuncSetAttribute failed\n"); grid = -1; return; }
        if (hipOccupancyMaxActiveBlocksPerMultiprocessor(&per_cu, (const void*)fwd_kernel, NTHREADS, LDS_BYTES) != hipSuccess || per_cu < 1) { fprintf(stderr, "kernel_launch: occupancy query says %d\n", per_cu); }
        (void)hipGetLastError();
        grid = cus;
    }
    if (grid < 0) return;
    (void)hipMemsetAsync((char*)d_ws, 0, CTL_BYTES, stream);
    Params p{};
    const float** pp = (const float**)&p;
    for (int i = 0; i < 21; ++i) pp[i] = (const float*)d_in[i];
    p.out = (float*)d_out; p.ws = (unsigned char*)d_ws;
#if MK_SINGLE
    p.ph_lo = 0; p.ph_hi = 2 * NPH;
    hipLaunchKernelGGL(fwd_kernel, dim3(grid), dim3(NTHREADS), LDS_BYTES, stream, p);
#else
#ifdef CUT
    for (int k = 0; k <= CUT; ++k) { p.ph_lo = k; p.ph_hi = k + 1; hipLaunchKernelGGL(fwd_kernel, dim3(grid), dim3(NTHREADS), LDS_BYTES, stream, p); }
    hipLaunchKernelGGL(dump_kernel, dim3(1024), dim3(256), 0, stream, (const unsigned char*)d_ws, (float*)d_out, (size_t)NLAT * DM);
#else
    for (int k = 0; k < 2 * NPH; ++k) { p.ph_lo = k; p.ph_hi = k + 1; hipLaunchKernelGGL(fwd_kernel, dim3(grid), dim3(NTHREADS), LDS_BYTES, stream, p); }
#endif
#endif
}
```

```cpp
#include <hip/hip_runtime.h>
#include <stdint.h>
#include <stdio.h>
#include <type_traits>

#ifndef ABL
#define ABL 0
#endif
#ifndef MK_SINGLE
#define MK_SINGLE 1
#endif

#define LAS __attribute__((address_space(3)))
typedef unsigned short bf16_t;
typedef short bf16x8 __attribute__((ext_vector_type(8)));
typedef float f32x4 __attribute__((ext_vector_type(4)));
typedef float f32x2 __attribute__((ext_vector_type(2)));
typedef unsigned u32x4 __attribute__((ext_vector_type(4)));
typedef unsigned u32x2 __attribute__((ext_vector_type(2)));
typedef __bf16 bf2_t __attribute__((ext_vector_type(2)));
typedef int i32x4 __attribute__((ext_vector_type(4)));
typedef int i32x8 __attribute__((ext_vector_type(8)));

constexpr int DM = 2048, NBATCH = 2, SEQ = 8192, CTXL = 256;
constexpr int NLAT = NBATCH * SEQ;
constexpr int NCTX = NBATCH * CTXL;
constexpr int MR = NLAT + NCTX;
constexpr int PROJ_W = 24608;
constexpr int NPROJ = 24576;
constexpr int NTHREADS = 512;
constexpr int LDS_BYTES = 163840;
constexpr int NPH = 11;
constexpr float EPSF = 1e-6f;

constexpr size_t SZ_A = (size_t)MR * 2048 * 2;
constexpr size_t WS_BAR = 0;
constexpr size_t WS_MOD = 16384;
constexpr size_t CTL_BYTES = 16384 + 2 * 3 * 12288 * 4;
constexpr size_t WS_TAB = 311296;
constexpr size_t WS_X = WS_TAB + 32768;
constexpr size_t WS_XN = WS_X + (size_t)MR * 2048 * 4;
constexpr size_t WS_Y = WS_XN + SZ_A;
constexpr size_t WS_XN8 = WS_Y;
constexpr size_t WS_PQ = WS_Y + SZ_A;
constexpr size_t WS_PK = WS_PQ + SZ_A / 2;
constexpr size_t WS_T8 = WS_PK + SZ_A / 2;
constexpr size_t WS_PV = WS_T8 + 0 * SZ_A;
constexpr size_t WS_PO = WS_T8 + 1 * SZ_A;
constexpr size_t WS_CQ = WS_T8 + 2 * SZ_A;
constexpr size_t WS_CK = WS_T8 + 3 * SZ_A;
constexpr size_t WS_CV = WS_T8 + 4 * SZ_A;
constexpr size_t WS_BB = WS_T8 + 5 * SZ_A;
constexpr size_t WS_BC = WS_T8 + 6 * SZ_A;
constexpr size_t WS_BX = WS_T8 + 7 * SZ_A;
constexpr size_t WS_GT = WS_T8 + 8 * SZ_A;
constexpr size_t WS_GATES = WS_GT + 3 * SZ_A;
constexpr size_t WS_WIN = WS_GATES + (size_t)MR * 32 * 4;
constexpr size_t WS_WINB = WS_WIN + (size_t)NPROJ * 2048;
constexpr size_t WS_WG = WS_WIN + (size_t)NPROJ * 2048 * 2;
constexpr size_t SZ_W = (size_t)2048 * 2048 * 2;
constexpr size_t WS_WA = WS_WG + 32 * 2048 * 2;
constexpr size_t WS_WB = WS_WA + SZ_W;
constexpr size_t WS_WC = WS_WB + SZ_W;
constexpr size_t WS_WO = WS_WC + SZ_W;
constexpr size_t WS_WQ = WS_WO + SZ_W;
constexpr size_t WS_KEYS = WS_WQ + SZ_W;
constexpr size_t WS_PU = WS_KEYS + 16 * 128 * 128 * 2;
constexpr size_t WS_PVW = WS_PU + (size_t)16384 * 2048 * 2;
constexpr size_t WS_END = WS_PVW + (size_t)16384 * 2048 * 2;

struct Params {
    const float *x, *c, *ctx, *c_ctx, *w_ada, *b_ada, *norm_g, *w_in, *a_gate_b, *a_hnorm_g, *b_conv, *c_qk_g, *c_rpb,
        *w_a_out, *w_b_out, *w_c_out, *w_out, *peer_wq, *peer_keys, *peer_u, *peer_v;
    float* out; unsigned char* ws; int ph_lo, ph_hi;
};
#define CAS __attribute__((address_space(4)))
typedef const CAS Params* KP;
__device__ __forceinline__ KP launder_p(KP q) { asm volatile("" : "+s"(q)); return q; }

__device__ __forceinline__ unsigned char* launder(unsigned char* q) { size_t z = 0; asm volatile("" : "+s"(z)); return q + z; }
__device__ __forceinline__ int tid_fresh(int wid0) { int t = wid0 * 64 + (int)__builtin_amdgcn_mbcnt_hi(~0u, __builtin_amdgcn_mbcnt_lo(~0u, 0u)); asm volatile("" : "+v"(t)); return t; }

__device__ __forceinline__ float bf2f(unsigned b) { return __uint_as_float(b << 16); }
__device__ __forceinline__ float bflo(unsigned w) { return __uint_as_float(w << 16); }
__device__ __forceinline__ float bfhi(unsigned w) { return __uint_as_float(w & 0xffff0000u); }
__device__ __forceinline__ unsigned pk2(float lo, float hi) { f32x2 v = {lo, hi}; bf2_t b = __builtin_convertvector(v, bf2_t); return __builtin_bit_cast(unsigned, b); }
__device__ __forceinline__ bf16_t f2bf(float f) { return (bf16_t)(pk2(f, 0.f) & 0xffffu); }
__device__ __forceinline__ f32x4 mfma16(bf16x8 a, bf16x8 b, f32x4 c) { return __builtin_amdgcn_mfma_f32_16x16x32_bf16(a, b, c, 0, 0, 0); }
__device__ __forceinline__ float dot2bf(unsigned a, unsigned b, float c) { return __builtin_amdgcn_fdot2_f32_bf16(__builtin_bit_cast(bf2_t, a), __builtin_bit_cast(bf2_t, b), c, false); }
__device__ __forceinline__ float wave_sum(float v) {
#pragma unroll
    for (int o = 32; o >= 1; o >>= 1) v += __shfl_xor(v, o);
    return v;
}
__device__ __forceinline__ float sigmoidf_(float v) { return 1.0f / (1.0f + __expf(-v)); }
__device__ __forceinline__ float logsigmoidf_(float v) { return fminf(v, 0.f) - log1pf(__expf(-fabsf(v))); }

#define XB_TMO      128
#define XB_XCNT(j)  (256  + 64 * (j))
#define XB_XSUB(j)  (1280 + 64 * (j))
#define XB_XGEN(j)  (2304 + 64 * (j))
#define XB_TOP      3328
#define XB_TOPGEN   3392
#define XCD_BAR_WORDS 3456
#define XB_SPIN_CAP (1u << 22)
__device__ __forceinline__ unsigned xb_ld(unsigned* p)              { return __hip_atomic_load(p, __ATOMIC_RELAXED, __HIP_MEMORY_SCOPE_AGENT); }
__device__ __forceinline__ unsigned xb_add(unsigned* p, unsigned v) { return __hip_atomic_fetch_add(p, v, __ATOMIC_RELAXED, __HIP_MEMORY_SCOPE_AGENT); }
__device__ __forceinline__ unsigned xb_xcc_id() { return (unsigned)__builtin_amdgcn_s_getreg((3 << 11) | 20) & 0xFu; }
#define XB_SPIN(cond, bar) do { unsigned _sp = 0; while (cond) { __builtin_amdgcn_s_sleep(1); \
    if ((++_sp & 255u) == 0u) { if (xb_ld(&(bar)[XB_TMO])) break; if (_sp > XB_SPIN_CAP) { atomicAdd(&(bar)[XB_TMO], 1u); break; } } } } while (0)
struct XcdBarrier { unsigned* bar; unsigned x; volatile LAS unsigned* st; };
__device__ __forceinline__ XcdBarrier xcd_barrier_post(unsigned* bar, volatile LAS unsigned* st) {
    XcdBarrier b; b.bar = bar; b.x = xb_xcc_id(); b.st = st;
    if (threadIdx.x == 0) (void)xb_add(&bar[XB_XCNT(b.x)], 1u);
    return b;
}
__device__ __forceinline__ void xcd_barrier_complete(unsigned* bar, unsigned x, unsigned& nloc, unsigned& nx) {
    const unsigned G = gridDim.x * gridDim.y * gridDim.z;
    unsigned sum, cnt, mine, sp = 0u;
    for (;;) {
        sum = 0u; cnt = 0u; mine = 0u;
#pragma unroll
        for (unsigned j = 0; j < 16; ++j) { const unsigned c = xb_ld(&bar[XB_XCNT(j)]); sum += c; cnt += (c > 0u) ? 1u : 0u; mine = (j == x) ? c : mine; }
        if (sum == G) break;
        __builtin_amdgcn_s_sleep(1);
        if ((++sp & 255u) == 0u) { if (xb_ld(&bar[XB_TMO])) break; if (sp > XB_SPIN_CAP) { atomicAdd(&bar[XB_TMO], 1u); break; } }
    }
    nloc = mine > 0u ? mine : 1u; nx = cnt > 0u ? cnt : 1u;
}
__device__ __forceinline__ void xcd_barrier(const XcdBarrier& b) {
    asm volatile("s_waitcnt vmcnt(0)" ::: "memory");
    __syncthreads();
    if (threadIdx.x == 0) {
        unsigned* bar = b.bar;
        __builtin_amdgcn_s_waitcnt(0);
        unsigned nloc = b.st[0], nx = b.st[1];
        if (nloc == 0u) { xcd_barrier_complete(bar, b.x, nloc, nx); b.st[0] = nloc; b.st[1] = nx; }
        const unsigned old = xb_add(&bar[XB_XSUB(b.x)], 1u);
        const unsigned gen = old / nloc;
        if (old + 1u == (gen + 1u) * nloc) {
            __builtin_amdgcn_fence(__ATOMIC_RELEASE, "agent");
            asm volatile("s_waitcnt vmcnt(0)" ::: "memory");
            const unsigned og = xb_add(&bar[XB_TOP], 1u);
            const unsigned tg = og / nx;
            if (og + 1u == (tg + 1u) * nx) xb_add(&bar[XB_TOPGEN], 1u);
            else XB_SPIN(xb_ld(&bar[XB_TOPGEN]) == tg, bar);
            __builtin_amdgcn_fence(__ATOMIC_ACQUIRE, "agent");
            xb_add(&bar[XB_XGEN(b.x)], 1u);
            asm volatile("s_waitcnt vmcnt(0)" ::: "memory");
        } else {
            XB_SPIN(xb_ld(&bar[XB_XGEN(b.x)]) == gen, bar);
            __builtin_amdgcn_fence(__ATOMIC_ACQUIRE, "agent");
            asm volatile("s_waitcnt vmcnt(0)" ::: "memory");
        }
    }
    __syncthreads();
}

namespace pg8 {
constexpr int BM = 256, BK = 64, HALF = 128, HTB = HALF * BK * 2, STAGE_BYTES = 8 * HTB, NXCD = 8, WGM = 8;
__host__ __device__ __forceinline__ int lds_byte(int r, int c) { const int st = (r >> 4) * 2 + (c >> 5), rr = r & 15, cc = c & 31, ob = rr * 64 + cc * 2; return st * 1024 + (ob ^ (((ob >> 9) & 1) << 5)); }
__host__ __device__ __forceinline__ void stage_rc(int b, int& R, int& C) { const int st = b / 1024, sb = b % 1024, swz = sb ^ (((sb >> 9) & 1) << 5); R = (st >> 1) * 16 + swz / 64; C = (st & 1) * 32 + (swz % 64) / 2; }
__host__ __device__ __forceinline__ int perm32(int rho) { const int n = rho >> 4, i = rho & 15; return 8 * (i >> 2) + 4 * n + (i & 3); }

struct Unit { int pm, pn, br; const char* A; const char* B; };

__device__ __forceinline__ bool tile_of(int L, int nM, int nN, int& pm, int& pn) {
    const int nwg = nM * nN; if (L >= nwg) return false;
    int wgid = L; { const int q = nwg / NXCD, r = nwg % NXCD, xcd = wgid % NXCD, off = wgid / NXCD; wgid = (xcd < r ? xcd * (q + 1) : r * (q + 1) + (xcd - r) * q) + off; }
    const int nig = WGM * nN, gid = wgid / nig, fm = gid * WGM, gsz = (nM - fm) < WGM ? (nM - fm) : WGM;
    pm = fm + ((wgid % nig) % gsz); pn = (wgid % nig) / gsz; return true;
}
struct PlainOrder {
    const char* A; const char* Bt; int nM, nN, G, c; size_t tstep; int pn_base, skip_from, skip_cnt, b_row0;
    __device__ __forceinline__ void init(const void* A_, const void* Bt_, int M, int N, int K, int G_, int c_) { A = (const char*)A_; Bt = (const char*)Bt_; nM = M / BM; nN = N / BM; G = G_; c = c_; tstep = (size_t)BM * K * 2;
        pn_base = 0; skip_from = 1 << 30; skip_cnt = 0; b_row0 = 0; }
    __device__ __forceinline__ bool next(int i, Unit& u) const {
        int pm, pn; if (!tile_of(i * G + c, nM, nN, pm, pn)) return false;
        pn += pn_base; if (pn >= skip_from) pn += skip_cnt;
        u.pm = pm; u.pn = pn; u.br = 0; u.A = A + (size_t)pm * tstep; u.B = Bt + (size_t)(pn - b_row0) * tstep; return true;
    }
};
struct BranchOrder {
    const char* T8; const char* WA; int nM, nN, G, c; size_t tstep;
    __device__ __forceinline__ bool next(int i, Unit& u) const {
        const int tl = i / 3, br = i - 3 * tl; int pm, pn; if (!tile_of(tl * G + c, nM, nN, pm, pn)) return false;
        u.pm = pm; u.pn = pn; u.br = br;
        const int ti = 1 + 4 * (br == 1) + (br == 2);
        u.A = T8 + (size_t)ti * SZ_A + (size_t)pm * tstep; u.B = WA + (size_t)br * SZ_W + (size_t)pn * tstep; return true;
    }
};

template <class Epi, class Sched, bool FP8 = false>
__device__ __forceinline__ void gemm_phase(LAS unsigned char* lds, const int K, const Sched& S, const Epi& E, int wid0) {
    const int tid = tid_fresh(wid0), wid = __builtin_amdgcn_readfirstlane(tid >> 6), lane = tid & 63, wr = wid >> 2, wc = wid & 3, fr = lane & 15, fq = lane >> 4;
    const int nt = K / BK;
    unsigned voffA[2], voffB[2];
#pragma unroll
    for (int i = 0; i < 2; ++i) { int R, C; stage_rc(tid * 16 + i * 8192, R, C); const int Rb = Epi::PERM ? ((R & ~31) + perm32(R & 31)) : R;
        voffA[i] = (unsigned)(R * K + C) * 2u; voffB[i] = (unsigned)(Rb * K + C) * 2u; }
    const size_t kstep = (size_t)(BK * 2);
    const size_t hstep = (size_t)HALF * K * 2;
    const unsigned ldsw = (unsigned)wid * 1024u;
    const int aoff = lds_byte(wr * 64 + fr, fq * 8), boff = lds_byte(wc * 32 + fr, fq * 8);
#define PG8_SA(b, h) (((b) * 2 + (h)) * HTB)
#define PG8_SB(b, h) ((4 + (b) * 2 + (h)) * HTB)
#define PG8_STAGE(bufoff, gbase, voff) do { _Pragma("unroll") for (int _i = 0; _i < 2; ++_i) \
        __builtin_amdgcn_global_load_lds((const unsigned*)((const char*)(gbase) + (voff)[_i]), (LAS unsigned*)(lds + (bufoff) + ldsw + _i * 8192), 16, 0, 0); } while (0)
#define PG8_LD1(dstv, addr) do { if constexpr (FP8) { const i32x4 _lo = *(const LAS i32x4*)(lds + (addr)), _hi = *(const LAS i32x4*)(lds + (addr) + 1024); dstv[0] = __builtin_shufflevector(_lo, _hi, 0, 1, 2, 3, 4, 5, 6, 7); } \
        else { _Pragma("unroll") for (int k = 0; k < 2; ++k) dstv[k] = *(const LAS bf16x8*)(lds + (addr) + k * 1024); } } while (0)
#define PG8_LDA(dst, b, h) do { _Pragma("unroll") for (int m = 0; m < 4; ++m) PG8_LD1(dst[m], PG8_SA(b, h) + aoff + m * 2048); } while (0)
#define PG8_LDB(dst, b, h) do { _Pragma("unroll") for (int n = 0; n < 2; ++n) PG8_LD1(dst[n], PG8_SB(b, h) + boff + n * 2048); } while (0)
#define PG8_MMA(ai, bj, At, Bt) do { __builtin_amdgcn_s_setprio(1); _Pragma("unroll") for (int m = 0; m < 4; ++m) _Pragma("unroll") for (int n = 0; n < 2; ++n) { \
        if constexpr (FP8) asm volatile("v_mfma_scale_f32_16x16x128_f8f6f4 %0, %1, %2, %0, %3, %4 op_sel_hi:[0,0,0]" : "+v"(acc[ai][bj][m][n]) : "v"(Bt[n][0]), "v"(At[m][0]), "v"(sclW), "v"(sclX)); \
        else { _Pragma("unroll") for (int k = 0; k < 2; ++k) acc[ai][bj][m][n] = __builtin_amdgcn_mfma_f32_16x16x32_bf16(Bt[n][k], At[m][k], acc[ai][bj][m][n], 0, 0, 0); } } \
        __builtin_amdgcn_s_setprio(0); } while (0)
#define PG8_WAIT_V(n) asm volatile("s_waitcnt vmcnt(" #n ")" ::: "memory")
#define PG8_WAIT_L(n) asm volatile("s_waitcnt lgkmcnt(" #n ")" ::: "memory")
#define PG8_BAR __builtin_amdgcn_s_barrier()
#define PG8_SCHED __builtin_amdgcn_sched_barrier(0)
    Unit cur, nxt; int ui = 0;
    if (!S.next(0, cur)) return;
    const int sclW = 0x75757575, sclX = 0x7F7F7F7F;
    f32x4 acc[2][2][4][2];
#pragma unroll
    for (int a = 0; a < 2; ++a)
#pragma unroll
        for (int b = 0; b < 2; ++b)
#pragma unroll
            for (int m = 0; m < 4; ++m)
#pragma unroll
                for (int n = 0; n < 2; ++n) acc[a][b][m][n] = (f32x4){0.f, 0.f, 0.f, 0.f};
    typedef typename std::conditional<FP8, i32x8, bf16x8>::type frag_t;
    frag_t At[4][FP8 ? 1 : 2], B0[2][FP8 ? 1 : 2], B1[2][FP8 ? 1 : 2];
    const char* cA = cur.A; const char* cB = cur.B;
    PG8_STAGE(PG8_SB(0, 0), cB, voffB); PG8_STAGE(PG8_SA(0, 0), cA, voffA); PG8_STAGE(PG8_SB(0, 1), cB + hstep, voffB); PG8_STAGE(PG8_SA(0, 1), cA + hstep, voffA);
    if (wr == 1) PG8_BAR;
    PG8_WAIT_V(4); PG8_BAR;
    PG8_STAGE(PG8_SB(1, 0), cB + kstep, voffB); PG8_STAGE(PG8_SA(1, 0), cA + kstep, voffA); PG8_STAGE(PG8_SB(1, 1), cB + hstep + kstep, voffB);
    PG8_WAIT_V(6); PG8_BAR;
    for (;;) {
        const bool has_next = S.next(ui + 1, nxt);
        const char* nA = has_next ? nxt.A : cA; const char* nB = has_next ? nxt.B : cB;
        for (int t = 0; t < nt; t += 2) {
            const bool last = (t == nt - 2);
            const char* a1 = cA + (size_t)(t + 1) * kstep;
            const char* a2 = last ? nA : cA + (size_t)(t + 2) * kstep; const char* b2 = last ? nB : cB + (size_t)(t + 2) * kstep;
            const char* a3 = a2 + kstep; const char* b3 = b2 + kstep;
            PG8_LDB(B0, 0, 0); PG8_SCHED; PG8_LDA(At, 0, 0); PG8_STAGE(PG8_SA(1, 1), a1 + hstep, voffA);
            PG8_WAIT_L(8); PG8_BAR; PG8_WAIT_L(0); PG8_MMA(0, 0, At, B0); PG8_BAR; PG8_SCHED;
            PG8_LDB(B1, 0, 1); PG8_STAGE(PG8_SB(0, 0), b2, voffB);
            PG8_BAR; PG8_WAIT_L(0); PG8_MMA(0, 1, At, B1); PG8_BAR;
            PG8_LDA(At, 0, 1); PG8_STAGE(PG8_SA(0, 0), a2, voffA);
            PG8_BAR; PG8_WAIT_L(0); PG8_MMA(1, 0, At, B0); PG8_BAR; PG8_SCHED;
            PG8_STAGE(PG8_SB(0, 1), b2 + hstep, voffB);
            PG8_WAIT_V(6); PG8_BAR; PG8_MMA(1, 1, At, B1); PG8_BAR;
            PG8_LDB(B0, 1, 0); PG8_SCHED; PG8_LDA(At, 1, 0); PG8_STAGE(PG8_SA(0, 1), a2 + hstep, voffA);
            PG8_WAIT_L(8); PG8_BAR; PG8_WAIT_L(0); PG8_MMA(0, 0, At, B0); PG8_BAR; PG8_SCHED;
            PG8_LDB(B1, 1, 1); PG8_STAGE(PG8_SB(1, 0), b3, voffB);
            PG8_BAR; PG8_WAIT_L(0); PG8_MMA(0, 1, At, B1); PG8_BAR;
            PG8_LDA(At, 1, 1); PG8_STAGE(PG8_SA(1, 0), a3, voffA);
            PG8_BAR; PG8_WAIT_L(0); PG8_MMA(1, 0, At, B0); PG8_BAR; PG8_SCHED;
            PG8_STAGE(PG8_SB(1, 1), b3 + hstep, voffB);
            PG8_WAIT_V(6); PG8_BAR; PG8_MMA(1, 1, At, B1); PG8_BAR;
        }
        if constexpr (FP8) { asm volatile("s_nop 15\n\ts_nop 15\n\ts_nop 15" ::: "memory"); }
        E(acc, cur, wr, wc, fr, fq);
        if (!has_next) break;
#pragma unroll
        for (int a = 0; a < 2; ++a)
#pragma unroll
            for (int b = 0; b < 2; ++b)
#pragma unroll
                for (int m = 0; m < 4; ++m)
#pragma unroll
                    for (int n = 0; n < 2; ++n) acc[a][b][m][n] = (f32x4){0.f, 0.f, 0.f, 0.f};
        cur = nxt; cA = nA; cB = nB; ++ui;
    }
    PG8_WAIT_V(0);
    if (wr == 0) PG8_BAR;
    PG8_BAR;
#undef PG8_SA
#undef PG8_SB
#undef PG8_STAGE
#undef PG8_LD1
#undef PG8_LDA
#undef PG8_LDB
#undef PG8_MMA
#undef PG8_WAIT_V
#undef PG8_WAIT_L
#undef PG8_BAR
#undef PG8_SCHED
}

struct EpiProj {
    static constexpr bool PERM = true;
    unsigned char* ws;
    __device__ __forceinline__ void operator()(const f32x4 (&acc)[2][2][4][2], const Unit& u, int wr, int wc, int fr, int fq) const {
        const int pn = u.pn; size_t off; int ld, c0;
        if (pn < 4) { off = WS_PQ; ld = 1024; c0 = pn * 256; }
        else if (pn < 8) { off = WS_PK; ld = 1024; c0 = (pn - 4) * 256; }
        else if (pn < 72) { const int t = (pn - 8) >> 3; off = WS_T8 + (size_t)t * SZ_A; ld = 2048; c0 = ((pn - 8) & 7) * 256; }
        else { off = WS_GT; ld = 6144; c0 = (pn - 72) * 256; }
        bf16_t* rp = (bf16_t*)(ws + off) + (size_t)(u.pm * BM + wr * 64 + fr) * ld + c0 + wc * 32 + 8 * fq;
        const size_t step = (size_t)16 * ld;
#pragma unroll
        for (int ai = 0; ai < 2; ++ai) {
#pragma unroll
            for (int m = 0; m < 4; ++m) {
                asm volatile("" : "+v"(rp));
#pragma unroll
                for (int bj = 0; bj < 2; ++bj) { const f32x4 v0 = acc[ai][bj][m][0], v1 = acc[ai][bj][m][1];
                    u32x4 w; w.x = pk2(v0[0], v0[1]); w.y = pk2(v0[2], v0[3]); w.z = pk2(v1[0], v1[1]); w.w = pk2(v1[2], v1[3]);
                    *(u32x4*)(rp + bj * HALF) = w; }
                rp += step;
            }
            rp += 4 * step;
        }
    }
};
struct EpiBf {
    static constexpr bool PERM = true;
    bf16_t* O; int ld;
    __device__ __forceinline__ void operator()(const f32x4 (&acc)[2][2][4][2], const Unit& u, int wr, int wc, int fr, int fq) const {
        const int row0 = u.pm * BM + wr * 64 + fr, col0 = u.pn * BM + wc * 32 + 8 * fq;
#pragma unroll
        for (int ai = 0; ai < 2; ++ai)
#pragma unroll
            for (int m = 0; m < 4; ++m) { bf16_t* rowp = O + (size_t)(row0 + ai * HALF + m * 16) * ld + col0;
#pragma unroll
                for (int bj = 0; bj < 2; ++bj) { const f32x4 v0 = acc[ai][bj][m][0], v1 = acc[ai][bj][m][1];
                    u32x4 w; w.x = pk2(v0[0], v0[1]); w.y = pk2(v0[2], v0[3]); w.z = pk2(v1[0], v1[1]); w.w = pk2(v1[2], v1[3]);
                    *(u32x4*)(rowp + bj * HALF) = w; } }
    }
};
struct EpiMerge {
    static constexpr bool PERM = true;
    bf16_t* Y; const bf16_t* GT;
    __device__ __forceinline__ void operator()(const f32x4 (&acc)[2][2][4][2], const Unit& u, int wr, int wc, int fr, int fq) const {
        const int row0 = u.pm * BM + wr * 64 + fr, col0 = u.pn * BM + wc * 32 + 8 * fq;
#pragma unroll
        for (int ai = 0; ai < 2; ++ai)
#pragma unroll
            for (int m = 0; m < 4; ++m) { const size_t r = (size_t)(row0 + ai * HALF + m * 16);
                bf16_t* rowp = Y + r * 2048 + col0; const bf16_t* gp = GT + r * 6144 + (size_t)u.br * 2048 + col0;
#pragma unroll
                for (int bj = 0; bj < 2; ++bj) { const f32x4 v0 = acc[ai][bj][m][0], v1 = acc[ai][bj][m][1];
                    const u32x4 g = *(const u32x4*)(gp + bj * HALF);
                    const float ab = ((ABL >> u.br) & 1) ? 0.f : 1.f;
                    float o[8];
                    o[0] = ab * sigmoidf_(bflo(g.x)) * v0[0]; o[1] = ab * sigmoidf_(bfhi(g.x)) * v0[1]; o[2] = ab * sigmoidf_(bflo(g.y)) * v0[2]; o[3] = ab * sigmoidf_(bfhi(g.y)) * v0[3];
                    o[4] = ab * sigmoidf_(bflo(g.z)) * v1[0]; o[5] = ab * sigmoidf_(bfhi(g.z)) * v1[1]; o[6] = ab * sigmoidf_(bflo(g.w)) * v1[2]; o[7] = ab * sigmoidf_(bfhi(g.w)) * v1[3];
                    if (u.br != 0) { const u32x4 y = *(const u32x4*)(rowp + bj * HALF);
                        o[0] += bflo(y.x); o[1] += bfhi(y.x); o[2] += bflo(y.y); o[3] += bfhi(y.y); o[4] += bflo(y.z); o[5] += bfhi(y.z); o[6] += bflo(y.w); o[7] += bfhi(y.w); }
                    u32x4 w; w.x = pk2(o[0], o[1]); w.y = pk2(o[2], o[3]); w.z = pk2(o[4], o[5]); w.w = pk2(o[6], o[7]);
                    *(u32x4*)(rowp + bj * HALF) = w; } }
    }
};
struct EpiRes {
    static constexpr bool PERM = false;
    float* X; const float* mod;
    __device__ __forceinline__ void operator()(const f32x4 (&acc)[2][2][4][2], const Unit& u, int wr, int wc, int fr, int fq) const {
        const int row0 = u.pm * BM + wr * 64 + fr, col0 = u.pn * BM + wc * 32 + 4 * fq;
        const int which = (u.pm < 32) ? 0 : (u.pm < 64 ? 1 : 2);
        const float* mg = mod + (size_t)which * 12288 + 2 * 2048 + col0;
        f32x4 gv[2][2];
#pragma unroll
        for (int bj = 0; bj < 2; ++bj)
#pragma unroll
            for (int n = 0; n < 2; ++n) gv[bj][n] = *(const f32x4*)(mg + bj * HALF + n * 16);
#pragma unroll
        for (int ai = 0; ai < 2; ++ai)
#pragma unroll
            for (int m = 0; m < 4; ++m) { float* rowp = X + (size_t)(row0 + ai * HALF + m * 16) * 2048 + col0;
#pragma unroll
                for (int bj = 0; bj < 2; ++bj)
#pragma unroll
                    for (int n = 0; n < 2; ++n) { f32x4* q = (f32x4*)(rowp + bj * HALF + n * 16); *q = *q + gv[bj][n] * acc[ai][bj][m][n]; } }
    }
};
}

__device__ __forceinline__ int proj_src_col(int n) {
    if (n < 1024) return 7200 + n;
    if (n < 2048) return n - 1024;
    if (n < 4096) return 1024 + (n - 2048);
    if (n < 6144) return 8224 + (n - 4096);
    if (n < 8192) return 16416 + (n - 6144);
    if (n < 10240) return 3104 + (n - 8192);
    if (n < 12288) return 5152 + (n - 10240);
    if (n < 14336) return 10272 + (n - 12288);
    if (n < 16384) return 12320 + (n - 14336);
    if (n < 18432) return 14368 + (n - 16384);
    return 18464 + (n - 18432);
}
__device__ void phase_w(KP p, int l, LAS unsigned char* lds, int wid0) {
    const int tid = tid_fresh(wid0), G = gridDim.x, bid = blockIdx.x;
    unsigned char* ws = launder(p->ws);
    {
        LAS float* tile = (LAS float*)lds;
        const int NT_IN = NPROJ / 64;
        const int total = (NT_IN + 5 * 32) * 32;
        for (int t = bid; t < total; t += G) {
            const int ntile = t >> 5, kt = t & 31, k0 = kt * 64;
            const float* src; int ld; bf16_t* dst; float scale = 1.0f; int n0;
            bool to8 = false;
            if (ntile < NT_IN) { n0 = ntile * 64; src = p->w_in + (size_t)l * 2048 * PROJ_W + proj_src_col(n0); ld = PROJ_W;
                if (n0 >= 12288 && n0 < 18432) { dst = (bf16_t*)(ws + WS_WINB) + (size_t)(n0 - 12288) * 2048; }
                else { to8 = true; dst = (bf16_t*)(ws + WS_WIN); scale = (n0 < 1024) ? 1024.0f * 0.08838834764831845f : 1024.0f; } }
            else { const int mi = (ntile - NT_IN) >> 5; n0 = ((ntile - NT_IN) & 31) * 64;
                const float* m5 = mi == 0 ? p->w_a_out : mi == 1 ? p->w_b_out : mi == 2 ? p->w_c_out : mi == 3 ? p->w_out : p->peer_wq;
                src = m5 + (size_t)l * 2048 * 2048 + n0; ld = 2048; dst = (bf16_t*)(ws + WS_WA + (size_t)mi * SZ_W) + (size_t)n0 * 2048; }
            { const int kk = tid >> 4, n4 = (tid & 15) * 4;
#pragma unroll
              for (int h = 0; h < 2; ++h) { const f32x4 v = *(const f32x4*)(src + (size_t)(k0 + kk + 32 * h) * ld + n4);
                  LAS float* tp = tile + (kk + 32 * h) * 65 + n4; tp[0] = v[0]; tp[1] = v[1]; tp[2] = v[2]; tp[3] = v[3]; } }
            __syncthreads();
            { const int n = tid >> 3, k8 = (tid & 7) * 8; float v[8];
#pragma unroll
              for (int j = 0; j < 8; ++j) v[j] = tile[(k8 + j) * 65 + n] * scale;
              if (to8) {
#pragma unroll
                  for (int j = 0; j < 8; ++j) v[j] = fminf(fmaxf(v[j], -448.f), 448.f);
                  int d0 = 0, d1 = 0; d0 = __builtin_amdgcn_cvt_pk_fp8_f32(v[0], v[1], d0, false); d0 = __builtin_amdgcn_cvt_pk_fp8_f32(v[2], v[3], d0, true);
                  d1 = __builtin_amdgcn_cvt_pk_fp8_f32(v[4], v[5], d1, false); d1 = __builtin_amdgcn_cvt_pk_fp8_f32(v[6], v[7], d1, true);
                  u32x2 w8; w8.x = (unsigned)d0; w8.y = (unsigned)d1; *(u32x2*)((unsigned char*)dst + (size_t)(n0 + n) * 2048 + k0 + k8) = w8; }
              else { u32x4 w; w.x = pk2(v[0], v[1]); w.y = pk2(v[2], v[3]); w.z = pk2(v[4], v[5]); w.w = pk2(v[6], v[7]);
                  *(u32x4*)(dst + (size_t)n * 2048 + k0 + k8) = w; } }
            __syncthreads();
        }
    }
    const size_t gtid = (size_t)bid * NTHREADS + tid, gthreads = (size_t)G * NTHREADS;
    for (size_t i = gtid; i < 32 * 2048; i += gthreads) { const int n = (int)(i >> 11), k = (int)(i & 2047);
        ((bf16_t*)(ws + WS_WG))[i] = f2bf(p->w_in[(size_t)l * 2048 * PROJ_W + (size_t)k * PROJ_W + 3072 + n]); }
    {
        const float* su = p->peer_u + (size_t)l * 16384 * 2048; const float* sv = p->peer_v + (size_t)l * 16384 * 2048;
        unsigned char* du = ws + WS_PU; unsigned char* dv = ws + WS_PVW;
        const size_t n16 = (size_t)16384 * 2048 / 16;
        for (size_t i = gtid; i < n16; i += gthreads) {
#pragma unroll
            for (int t = 0; t < 2; ++t) {
                const float* sp = (t ? sv : su) + i * 16; const float sc = t ? 128.0f : 2048.0f;
                u32x4 wv;
#pragma unroll
                for (int q = 0; q < 4; ++q) { const f32x4 a = *(const f32x4*)(sp + q * 4);
                    const float a0 = fminf(fmaxf(a[0] * sc, -448.f), 448.f), a1 = fminf(fmaxf(a[1] * sc, -448.f), 448.f), a2 = fminf(fmaxf(a[2] * sc, -448.f), 448.f), a3 = fminf(fmaxf(a[3] * sc, -448.f), 448.f);
                    int d = 0; d = __builtin_amdgcn_cvt_pk_fp8_f32(a0, a1, d, false); d = __builtin_amdgcn_cvt_pk_fp8_f32(a2, a3, d, true); wv[q] = (unsigned)d; }
                *(u32x4*)((t ? dv : du) + i * 16) = wv;
            }
        }
        const float* sk = p->peer_keys + (size_t)l * 16 * 128 * 128; bf16_t* dk = (bf16_t*)(ws + WS_KEYS);
        for (size_t i = gtid; i < (size_t)16 * 128 * 128; i += gthreads) dk[i] = f2bf(sk[i]);
    }
    {
        float* mod = (float*)(ws + WS_MOD) + (size_t)l * 3 * 12288;
        const float* wa = p->w_ada + (size_t)l * 2048 * 12288; const float* ba = p->b_ada + (size_t)l * 12288;
        LAS float* part = (LAS float*)(lds + 32768);
        const int col = tid & 63, ks = tid >> 6;
        for (int t = bid; t < 256; t += G) {
            const int n = t * 48 + col;
            float a0 = 0.f, a1 = 0.f, a2 = 0.f;
            if (col < 48) {
                for (int k = ks * 256; k < ks * 256 + 256; ++k) {
                    const float w = wa[(size_t)k * 12288 + n];
                    const float c0 = p->c[k], c1 = p->c[2048 + k], c2 = p->c_ctx[k];
                    a0 += c0 * sigmoidf_(c0) * w; a1 += c1 * sigmoidf_(c1) * w; a2 += c2 * sigmoidf_(c2) * w;
                }
                part[(ks * 3 + 0) * 48 + col] = a0; part[(ks * 3 + 1) * 48 + col] = a1; part[(ks * 3 + 2) * 48 + col] = a2;
            }
            __syncthreads();
            if (tid < 144) { const int which = tid / 48, cc = tid - which * 48; float sacc = ba[t * 48 + cc];
#pragma unroll
                for (int q = 0; q < 8; ++q) sacc += part[(q * 3 + which) * 48 + cc];
                mod[(size_t)which * 12288 + t * 48 + cc] = sacc; }
            __syncthreads();
        }
    }
    if (l == 0) {
        float* X = (float*)(ws + WS_X);
        const size_t nl4 = (size_t)NLAT * 2048 / 4, nc4 = (size_t)NCTX * 2048 / 4;
        for (size_t i = gtid; i < nl4; i += gthreads) ((f32x4*)X)[i] = ((const f32x4*)p->x)[i];
        for (size_t i = gtid; i < nc4; i += gthreads) ((f32x4*)X)[nl4 + i] = ((const f32x4*)p->ctx)[i];
        float* tab = (float*)(ws + WS_TAB);
        for (size_t i = gtid; i < 4096; i += gthreads) { const int pos = (int)(i >> 5), j = (int)(i & 31);
            const float inv = powf(10000.0f, -(float)j / 32.0f); const float ang = (float)pos * inv;
            tab[i] = cosf(ang); tab[4096 + i] = sinf(ang); }
    }
}

__device__ void phase_norm(KP p, int l, int which_norm, int nrows, int wid0) {
    const int tid = tid_fresh(wid0); const int lane = tid & 63, gw = blockIdx.x * 8 + (tid >> 6), nw = gridDim.x * 8;
    unsigned char* ws = launder(p->ws);
    const float* X = (const float*)(ws + WS_X); bf16_t* XN = (bf16_t*)(ws + WS_XN);
    const float* mod = (const float*)(ws + WS_MOD) + (size_t)l * 3 * 12288;
    const float* g = p->norm_g + (size_t)(l * 2 + which_norm) * 2048;
    const int shift_c = which_norm ? 3 : 0, scale_c = which_norm ? 4 : 1;
    for (int row = gw; row < nrows; row += nw) {
        const int which = row < NLAT ? (row >> 13) : 2;
        const float* xr = X + (size_t)row * 2048; const float* mb = mod + (size_t)which * 12288;
        f32x4 v[8]; float ss = 0.f;
#pragma unroll
        for (int i = 0; i < 8; ++i) { v[i] = *(const f32x4*)(xr + i * 256 + lane * 4); ss += v[i][0] * v[i][0] + v[i][1] * v[i][1] + v[i][2] * v[i][2] + v[i][3] * v[i][3]; }
        ss = wave_sum(ss);
        const float rstd = rsqrtf(ss * (1.0f / 2048.0f) + EPSF);
#pragma unroll
        for (int i = 0; i < 8; ++i) { const int c = i * 256 + lane * 4;
            const f32x4 gg = *(const f32x4*)(g + c), sh = *(const f32x4*)(mb + shift_c * 2048 + c), sc = *(const f32x4*)(mb + scale_c * 2048 + c);
            float o[4];
#pragma unroll
            for (int j = 0; j < 4; ++j) o[j] = v[i][j] * rstd * gg[j] * (1.0f + sc[j]) + sh[j];
            u32x2 w; w.x = pk2(o[0], o[1]); w.y = pk2(o[2], o[3]); *(u32x2*)(XN + (size_t)row * 2048 + c) = w;
            if (which_norm == 0) { int d = 0; d = __builtin_amdgcn_cvt_pk_fp8_f32(fminf(fmaxf(o[0], -448.f), 448.f), fminf(fmaxf(o[1], -448.f), 448.f), d, false);
                d = __builtin_amdgcn_cvt_pk_fp8_f32(fminf(fmaxf(o[2], -448.f), 448.f), fminf(fmaxf(o[3], -448.f), 448.f), d, true); *(unsigned*)(ws + WS_XN8 + (size_t)row * 2048 + c) = (unsigned)d; } }
    }
}

__device__ void phase_gates_gemm(KP p, int l, int wid0) {
    const int tid = tid_fresh(wid0); const int lane = tid & 63, gw = blockIdx.x * 8 + (tid >> 6), nw = gridDim.x * 8;
    unsigned char* ws = launder(p->ws);
    const bf16_t* XN = (const bf16_t*)(ws + WS_XN); const bf16_t* WG = (const bf16_t*)(ws + WS_WG); float* GA = (float*)(ws + WS_GATES);
    const int q4 = lane >> 4, c = lane & 15;
    const float gb0 = p->a_gate_b[l * 32 + c], gb1 = p->a_gate_b[l * 32 + 16 + c];
    for (int task = gw; task < MR / 16; task += nw) {
        const int r0 = task * 16;
        f32x4 acc0 = {0.f, 0.f, 0.f, 0.f}, acc1 = {0.f, 0.f, 0.f, 0.f};
        const bf16_t* ap = XN + (size_t)(r0 + c) * 2048 + 8 * q4; const bf16_t* b0 = WG + (size_t)c * 2048 + 8 * q4; const bf16_t* b1 = b0 + 16 * 2048;
#pragma unroll 4
        for (int ks = 0; ks < 64; ++ks) { const bf16x8 a = *(const bf16x8*)(ap + ks * 32), x0 = *(const bf16x8*)(b0 + ks * 32), x1 = *(const bf16x8*)(b1 + ks * 32);
            acc0 = mfma16(a, x0, acc0); acc1 = mfma16(a, x1, acc1); }
#pragma unroll
        for (int r = 0; r < 4; ++r) {
            const float v0 = acc0[r] + gb0, v1 = acc1[r] + gb1;
            GA[(size_t)(r0 + 4 * q4 + r) * 32 + c] = (c >= 8) ? logsigmoidf_(v0) : v0; GA[(size_t)(r0 + 4 * q4 + r) * 32 + 16 + c] = (c >= 8) ? logsigmoidf_(v1) : v1; }
    }
}

__device__ void phase_e1(KP p, int l, int wid0) {
    const int tid = tid_fresh(wid0); const int lane = tid & 63, gw = blockIdx.x * 8 + (tid >> 6), nw = gridDim.x * 8;
    unsigned char* ws = launder(p->ws);
    bf16_t* PQ = (bf16_t*)(ws + WS_PQ); bf16_t* PK = (bf16_t*)(ws + WS_PK); bf16_t* CQ = (bf16_t*)(ws + WS_CQ); bf16_t* CK = (bf16_t*)(ws + WS_CK);
    bf16_t* BB = (bf16_t*)(ws + WS_BB); const bf16_t* BC = (const bf16_t*)(ws + WS_BC); const bf16_t* BX = (const bf16_t*)(ws + WS_BX);
    float* GA = (float*)(ws + WS_GATES); const float* tab = (const float*)(ws + WS_TAB);
    const float* gq = p->c_qk_g + (size_t)(l * 2 + 0) * 128; const float* gk = p->c_qk_g + (size_t)(l * 2 + 1) * 128;
    const float* cw = p->b_conv + (size_t)l * 3 * 2048;
    float gqv[8], gkv[8];
#pragma unroll
    for (int j = 0; j < 8; ++j) { gqv[j] = gq[(lane & 15) * 8 + j] * 0.08838834764831845f; gkv[j] = gk[(lane & 15) * 8 + j]; }
    for (int row = gw; row < MR; row += nw) {
        if (row < NLAT) {
            const int s = row & 8191, gr = s >> 6, gc = s & 63;
#pragma unroll
            for (int it = 0; it < 2; ++it) {
                const int unit = it * 64 + lane, h = unit >> 4, hf = (unit >> 3) & 1, j4 = unit & 7;
                const int off = h * 128 + hf * 64 + j4 * 4, pos = hf ? gc : gr;
                const f32x4 cs = *(const f32x4*)(tab + pos * 32 + j4 * 4), sn = *(const f32x4*)(tab + 4096 + pos * 32 + j4 * 4);
#pragma unroll
                for (int tsel = 0; tsel < 2; ++tsel) { bf16_t* T = (tsel ? PK : PQ) + (size_t)row * 1024 + off;
                    const u32x2 u1 = *(const u32x2*)T, u2 = *(const u32x2*)(T + 32);
                    const float a0 = bflo(u1.x), a1 = bfhi(u1.x), a2 = bflo(u1.y), a3 = bfhi(u1.y), b0 = bflo(u2.x), b1 = bfhi(u2.x), b2 = bflo(u2.y), b3 = bfhi(u2.y);
                    u32x2 o1, o2;
                    o1.x = pk2(a0 * cs[0] - b0 * sn[0], a1 * cs[1] - b1 * sn[1]); o1.y = pk2(a2 * cs[2] - b2 * sn[2], a3 * cs[3] - b3 * sn[3]);
                    o2.x = pk2(b0 * cs[0] + a0 * sn[0], b1 * cs[1] + a1 * sn[1]); o2.y = pk2(b2 * cs[2] + a2 * sn[2], b3 * cs[3] + a3 * sn[3]);
                    *(u32x2*)T = o1; *(u32x2*)(T + 32) = o2; }
            }
        }
#pragma unroll
        for (int tsel = 0; tsel < 2; ++tsel) {
            bf16_t* T = (tsel ? CK : CQ) + (size_t)row * 2048;
#pragma unroll
            for (int ps = 0; ps < 4; ++ps) {
                const u32x4 w = *(const u32x4*)(T + ps * 512 + lane * 8);
                float v[8] = {bflo(w.x), bfhi(w.x), bflo(w.y), bfhi(w.y), bflo(w.z), bfhi(w.z), bflo(w.w), bfhi(w.w)};
                float ss = 0.f;
#pragma unroll
                for (int j = 0; j < 8; ++j) ss += v[j] * v[j];
                ss += __shfl_xor(ss, 1); ss += __shfl_xor(ss, 2); ss += __shfl_xor(ss, 4); ss += __shfl_xor(ss, 8);
                const float rstd = rsqrtf(ss * (1.0f / 128.0f) + EPSF);
#pragma unroll
                for (int j = 0; j < 8; ++j) v[j] = v[j] * rstd * (tsel ? gkv[j] : gqv[j]);
                u32x4 o; o.x = pk2(v[0], v[1]); o.y = pk2(v[2], v[3]); o.z = pk2(v[4], v[5]); o.w = pk2(v[6], v[7]);
                *(u32x4*)(T + ps * 512 + lane * 8) = o;
            }
        }
        {
            int pos, len; if (row < NLAT) { pos = row & 8191; len = SEQ; } else { pos = (row - NLAT) & 255; len = CTXL; }
            const bool hp = pos > 0, hn = pos < len - 1;
#pragma unroll
            for (int ps = 0; ps < 4; ++ps) {
                const int c = ps * 512 + lane * 8; const size_t o = (size_t)row * 2048 + c;
                const u32x4 bb = *(const u32x4*)(BB + o), c1 = *(const u32x4*)(BC + o), x1 = *(const u32x4*)(BX + o);
                u32x4 c0 = {0u, 0u, 0u, 0u}, x0 = c0, c2 = c0, x2 = c0;
                if (hp) { c0 = *(const u32x4*)(BC + o - 2048); x0 = *(const u32x4*)(BX + o - 2048); }
                if (hn) { c2 = *(const u32x4*)(BC + o + 2048); x2 = *(const u32x4*)(BX + o + 2048); }
                const unsigned bw[4] = {bb.x, bb.y, bb.z, bb.w}, c0w[4] = {c0.x, c0.y, c0.z, c0.w}, c1w[4] = {c1.x, c1.y, c1.z, c1.w}, c2w[4] = {c2.x, c2.y, c2.z, c2.w};
                const unsigned x0w[4] = {x0.x, x0.y, x0.z, x0.w}, x1w[4] = {x1.x, x1.y, x1.z, x1.w}, x2w[4] = {x2.x, x2.y, x2.z, x2.w};
                unsigned ow[4];
#pragma unroll
                for (int q = 0; q < 4; ++q) {
                    const int cc = c + 2 * q;
                    const float w00 = cw[cc], w01 = cw[cc + 1], w10 = cw[2048 + cc], w11 = cw[2048 + cc + 1], w20 = cw[4096 + cc], w21 = cw[4096 + cc + 1];
                    const float ylo = bflo(bw[q]) * (bflo(c0w[q]) * bflo(x0w[q]) * w00 + bflo(c1w[q]) * bflo(x1w[q]) * w10 + bflo(c2w[q]) * bflo(x2w[q]) * w20);
                    const float yhi = bfhi(bw[q]) * (bfhi(c0w[q]) * bfhi(x0w[q]) * w01 + bfhi(c1w[q]) * bfhi(x1w[q]) * w11 + bfhi(c2w[q]) * bfhi(x2w[q]) * w21);
                    ow[q] = pk2(ylo, yhi);
                }
                u32x4 ov; ov.x = ow[0]; ov.y = ow[1]; ov.z = ow[2]; ov.w = ow[3];
                *(u32x4*)(BB + o) = ov;
            }
        }
    }
}

constexpr int ML_QS = 0, ML_KS = 17408, ML_KET = 34816, ML_VT = 53248, ML_SS = 60160, ML_CT = 69376, ML_CTSZ = 13056;
__device__ __forceinline__ int ml_row(int pp, int b, int dir) {
    if (pp < 256) { const int j = dir ? 255 - pp : pp; return NLAT + b * 256 + j; }
    int s = pp - 256; if (dir) s = 8191 - s; return b * 8192 + s;
}
__device__ void phase_mlstm(KP p, int l, LAS unsigned char* lds, int wid0) {
    const int tid = tid_fresh(wid0), lane = tid & 63, w = __builtin_amdgcn_readfirstlane(tid >> 6), q4 = lane >> 4, c16 = lane & 15;
    unsigned char* ws = launder(p->ws);
    const bf16_t* PQ = (const bf16_t*)(ws + WS_PQ); const bf16_t* PK = (const bf16_t*)(ws + WS_PK); const bf16_t* PV = (const bf16_t*)(ws + WS_PV);
    const float* GA = (const float*)(ws + WS_GATES);
    for (int task = blockIdx.x; task < 256; task += gridDim.x) {
        const int xq = task & 7, yq = task >> 3; const int bh = 2 * xq + (yq >> 4), dir = (yq >> 3) & 1, sl = yq & 7; const int b = bh >> 3, h = bh & 7;
        bf16_t* H = (bf16_t*)(ws + (dir ? WS_BX : WS_BC));
        __syncthreads();
        for (int i = tid; i < 16 * 32; i += NTHREADS) { const int r = 32 + (i >> 5), cdw = i & 31; *(LAS unsigned*)(lds + ML_VT + r * 144 + cdw * 4) = (r == 32) ? 0x3f803f80u : 0u; }
        for (int i = tid; i < 2 * ML_CTSZ / 4; i += NTHREADS) *(LAS unsigned*)(lds + ML_CT + i * 4) = 0u;
        float m = 0.f;
        f32x4 Cst[3];
#pragma unroll
        for (int i = 0; i < 3; ++i) Cst[i] = (f32x4){0.f, 0.f, 0.f, 0.f};
        u32x4 qreg[2], kreg[2], vreg; float li, lf;
        { const int r = ml_row(lane, b, dir);
#pragma unroll
          for (int i = 0; i < 2; ++i) { qreg[i] = *(const u32x4*)(PQ + (size_t)r * 1024 + h * 128 + (w * 2 + i) * 8); kreg[i] = *(const u32x4*)(PK + (size_t)r * 1024 + h * 128 + (w * 2 + i) * 8); }
          if (w < 4) vreg = *(const u32x4*)(PV + (size_t)r * 2048 + h * 256 + sl * 32 + w * 8);
          li = GA[(size_t)r * 32 + (2 * dir) * 8 + h]; lf = GA[(size_t)r * 32 + (2 * dir + 1) * 8 + h]; }
        for (int c = 0; c < 132; ++c) {
            float bc = lf;
#pragma unroll
            for (int o = 1; o < 64; o <<= 1) { const float t = __shfl_up(bc, o); if (lane >= o) bc += t; }
            const float a = li - bc;
            float pm = a;
#pragma unroll
            for (int o = 1; o < 64; o <<= 1) { const float t = __shfl_up(pm, o); if (lane >= o) pm = fmaxf(pm, t); }
            const float total = __shfl(bc, 63), pmall = __shfl(pm, 63);
            const float mx = fmaxf(m, pm);
            const float mrow = bc + mx;
            const float winter = __expf(m - mx);
            const float m_new = total + fmaxf(m, pmall);
            const float decay = __expf(total + m - m_new);
            const float kscale = __expf(total + a - m_new);
#pragma unroll
            for (int i = 0; i < 2; ++i) {
                *(LAS u32x4*)(lds + ML_QS + lane * 272 + (w * 2 + i) * 16) = qreg[i];
                *(LAS u32x4*)(lds + ML_KS + lane * 272 + (w * 2 + i) * 16) = kreg[i];
                const unsigned kw[4] = {kreg[i].x, kreg[i].y, kreg[i].z, kreg[i].w};
#pragma unroll
                for (int j = 0; j < 4; ++j) { const int d = (w * 2 + i) * 8 + 2 * j;
                    *(LAS bf16_t*)(lds + ML_KET + d * 144 + lane * 2) = f2bf(bflo(kw[j]) * kscale);
                    *(LAS bf16_t*)(lds + ML_KET + (d + 1) * 144 + lane * 2) = f2bf(bfhi(kw[j]) * kscale); }
            }
            if (w < 4) { const unsigned vw[4] = {vreg.x, vreg.y, vreg.z, vreg.w};
#pragma unroll
                for (int j = 0; j < 4; ++j) { const int e = w * 8 + 2 * j;
                    *(LAS bf16_t*)(lds + ML_VT + e * 144 + lane * 2) = (bf16_t)(vw[j] & 0xffffu);
                    *(LAS bf16_t*)(lds + ML_VT + (e + 1) * 144 + lane * 2) = (bf16_t)(vw[j] >> 16); } }
            if (c + 1 < 132) { const int r = ml_row((c + 1) * 64 + lane, b, dir);
#pragma unroll
                for (int i = 0; i < 2; ++i) { qreg[i] = *(const u32x4*)(PQ + (size_t)r * 1024 + h * 128 + (w * 2 + i) * 8); kreg[i] = *(const u32x4*)(PK + (size_t)r * 1024 + h * 128 + (w * 2 + i) * 8); }
                if (w < 4) vreg = *(const u32x4*)(PV + (size_t)r * 2048 + h * 256 + sl * 32 + w * 8);
                li = GA[(size_t)r * 32 + (2 * dir) * 8 + h]; lf = GA[(size_t)r * 32 + (2 * dir + 1) * 8 + h]; }
            __syncthreads();
            const int tr = w >> 1;
            bf16x8 aq[4];
#pragma unroll
            for (int ks = 0; ks < 4; ++ks) aq[ks] = *(const LAS bf16x8*)(lds + ML_QS + (16 * tr + c16) * 272 + (ks * 32 + 8 * q4) * 2);
            float nmx_t[4], wi_t[4], mrow_t[4];
#pragma unroll
            for (int r = 0; r < 4; ++r) { const int t = 16 * tr + 4 * q4 + r; nmx_t[r] = -__shfl(mx, t); wi_t[r] = __shfl(winter, t); mrow_t[r] = __shfl(mrow, t); }
#pragma unroll
            for (int tci = 0; tci < 2; ++tci) {
                const int tc = 2 * (w & 1) + tci;
                f32x4 acc = {0.f, 0.f, 0.f, 0.f};
#pragma unroll
                for (int ks = 0; ks < 4; ++ks) { const bf16x8 bk = *(const LAS bf16x8*)(lds + ML_KS + (16 * tc + c16) * 272 + (ks * 32 + 8 * q4) * 2); acc = mfma16(aq[ks], bk, acc); }
                const int scol = 16 * tc + c16; const float a_s = __shfl(a, scol);
#pragma unroll
                for (int r = 0; r < 4; ++r) { const int t = 16 * tr + 4 * q4 + r;
                    const float dv = (scol <= t) ? __expf(a_s + nmx_t[r]) : 0.f;
                    *(LAS bf16_t*)(lds + ML_SS + t * 144 + scol * 2) = f2bf(acc[r] * dv); }
            }
            __syncthreads();
            {
                const LAS unsigned char* CTc = lds + ML_CT + (c & 1) * ML_CTSZ;
                const int part = w & 1;
                bf16x8 as2[2];
#pragma unroll
                for (int k2 = 0; k2 < 2; ++k2) as2[k2] = *(const LAS bf16x8*)(lds + ML_SS + (16 * tr + c16) * 144 + (k2 * 32 + 8 * q4) * 2);
                f32x4 accA = {0.f, 0.f, 0.f, 0.f}, accD = {0.f, 0.f, 0.f, 0.f};
#pragma unroll
                for (int ks = 0; ks < 4; ++ks) {
                    const bf16x8 b1 = *(const LAS bf16x8*)(CTc + (16 * part + c16) * 272 + (ks * 32 + 8 * q4) * 2);
                    const bf16x8 b2 = *(const LAS bf16x8*)(CTc + (32 + c16) * 272 + (ks * 32 + 8 * q4) * 2);
                    accA = mfma16(aq[ks], b1, accA); accD = mfma16(aq[ks], b2, accD); }
#pragma unroll
                for (int r = 0; r < 4; ++r) { accA[r] *= wi_t[r]; accD[r] *= wi_t[r]; }
#pragma unroll
                for (int k2 = 0; k2 < 2; ++k2) {
                    const bf16x8 v1 = *(const LAS bf16x8*)(lds + ML_VT + (16 * part + c16) * 144 + (k2 * 32 + 8 * q4) * 2);
                    const bf16x8 v2 = *(const LAS bf16x8*)(lds + ML_VT + (32 + c16) * 144 + (k2 * 32 + 8 * q4) * 2);
                    accA = mfma16(as2[k2], v1, accA); accD = mfma16(as2[k2], v2, accD); }
                if (l == 0 || c >= 4) {
#pragma unroll
                    for (int r = 0; r < 4; ++r) {
                        const float den = __shfl(accD[r], lane & 48);
                        const float hv = accA[r] / fmaxf(fabsf(den), __expf(-mrow_t[r]));
                        const int t = 16 * tr + 4 * q4 + r; const int row = ml_row(c * 64 + t, b, dir);
                        H[(size_t)row * 2048 + h * 256 + sl * 32 + 16 * part + c16] = f2bf(hv);
                    }
                }
            }
            {
                LAS unsigned char* CTn = lds + ML_CT + ((c + 1) & 1) * ML_CTSZ;
                bf16x8 ak[2];
#pragma unroll
                for (int k2 = 0; k2 < 2; ++k2) ak[k2] = *(const LAS bf16x8*)(lds + ML_KET + (16 * w + c16) * 144 + (k2 * 32 + 8 * q4) * 2);
#pragma unroll
                for (int ct = 0; ct < 3; ++ct) {
                    Cst[ct] = Cst[ct] * decay;
#pragma unroll
                    for (int k2 = 0; k2 < 2; ++k2) { const bf16x8 bv = *(const LAS bf16x8*)(lds + ML_VT + (16 * ct + c16) * 144 + (k2 * 32 + 8 * q4) * 2); Cst[ct] = mfma16(ak[k2], bv, Cst[ct]); }
                    u32x2 o; o.x = pk2(Cst[ct][0], Cst[ct][1]); o.y = pk2(Cst[ct][2], Cst[ct][3]);
                    *(LAS u32x2*)(CTn + (16 * ct + c16) * 272 + (16 * w + 4 * q4) * 2) = o;
                }
            }
            m = m_new;
            __syncthreads();
        }
    }
}

constexpr int AT_KS = 0, AT_VT = 17408, AT_RPB = 35840;
__device__ void phase_attn(KP p, int l, LAS unsigned char* lds, int wid0) {
    const int tid = tid_fresh(wid0), lane = tid & 63, w = __builtin_amdgcn_readfirstlane(tid >> 6), q4 = lane >> 4, c16 = lane & 15;
    unsigned char* ws = launder(p->ws);
    bf16_t* CQ = (bf16_t*)(ws + WS_CQ); const bf16_t* CK = (const bf16_t*)(ws + WS_CK); const bf16_t* CV = (const bf16_t*)(ws + WS_CV);
    const int nunits = 2048 + (l == 0 ? 64 : 0);
    for (int u = blockIdx.x; u < nunits; u += gridDim.x) {
        int b, h, qrow = 0, g = 0, ntl = 0, r0a = 0, qbase;  bool is_ctx = u >= 2048;
        if (!is_ctx) { b = u >> 10; h = (u >> 6) & 15; const int rp = u & 63; qrow = 2 * rp + (w >> 2); g = w & 3;
            r0a = min(max(2 * rp - 4, 0), 120); const int r0b = min(max(2 * rp + 1 - 4, 0), 120); ntl = r0b + 8 - r0a;
            qbase = b * 8192 + qrow * 64 + 16 * g; }
        else { const int uu = u - 2048; b = uu >> 5; h = (uu >> 1) & 15; qbase = NLAT + b * 256 + (uu & 1) * 128 + 16 * w; }
        const int r0q = min(max(qrow - 4, 0), 120);
        const int a_g = (g == 0) ? 0 : (g == 1 ? 8 : (g == 2 ? 24 : 32));
        __syncthreads();
        if (!is_ctx) for (int i = tid; i < 465; i += NTHREADS) *(LAS float*)(lds + AT_RPB + i * 4) = p->c_rpb[((size_t)l * 16 + h) * 465 + i];
        bf16x8 qf[4];
#pragma unroll
        for (int ks = 0; ks < 4; ++ks) qf[ks] = *(const bf16x8*)(CQ + (size_t)(qbase + c16) * 2048 + h * 128 + ks * 32 + 8 * q4);
        f32x4 O[8];
#pragma unroll
        for (int i = 0; i < 8; ++i) O[i] = (f32x4){0.f, 0.f, 0.f, 0.f};
        float m_run = -1e30f, l_run = 0.f;
        const int ntiles = ntl + 4;
        u32x4 kreg[2], vreg[2];
        auto tile_row = [&](int t, int key) -> int { return (t < ntl) ? (b * 8192 + (r0a + t) * 64 + key) : (NLAT + b * 256 + (t - ntl) * 64 + key); };
        { const int r = tile_row(0, lane);
#pragma unroll
          for (int i = 0; i < 2; ++i) { kreg[i] = *(const u32x4*)(CK + (size_t)r * 2048 + h * 128 + (w * 2 + i) * 8); vreg[i] = *(const u32x4*)(CV + (size_t)r * 2048 + h * 128 + (w * 2 + i) * 8); } }
        for (int t = 0; t < ntiles; ++t) {
            __syncthreads();
#pragma unroll
            for (int i = 0; i < 2; ++i) {
                *(LAS u32x4*)(lds + AT_KS + lane * 272 + (w * 2 + i) * 16) = kreg[i];
                const unsigned vw[4] = {vreg[i].x, vreg[i].y, vreg[i].z, vreg[i].w};
#pragma unroll
                for (int j = 0; j < 4; ++j) { const int d = (w * 2 + i) * 8 + 2 * j;
                    *(LAS bf16_t*)(lds + AT_VT + d * 144 + lane * 2) = (bf16_t)(vw[j] & 0xffffu);
                    *(LAS bf16_t*)(lds + AT_VT + (d + 1) * 144 + lane * 2) = (bf16_t)(vw[j] >> 16); }
            }
            if (t + 1 < ntiles) { const int r = tile_row(t + 1, lane);
#pragma unroll
                for (int i = 0; i < 2; ++i) { kreg[i] = *(const u32x4*)(CK + (size_t)r * 2048 + h * 128 + (w * 2 + i) * 8); vreg[i] = *(const u32x4*)(CV + (size_t)r * 2048 + h * 128 + (w * 2 + i) * 8); } }
            __syncthreads();
            const bool local = t < ntl; const int kr = r0a + t;
            if (local && !(kr >= r0q && kr < r0q + 8)) continue;
            const int npass = local ? 1 : 2;
            for (int ps = 0; ps < npass; ++ps) {
                const int a0 = local ? a_g : ps * 32;
                f32x4 sc[2];
#pragma unroll
                for (int ct = 0; ct < 2; ++ct) { sc[ct] = (f32x4){0.f, 0.f, 0.f, 0.f};
#pragma unroll
                    for (int ks = 0; ks < 4; ++ks) { const bf16x8 ka = *(const LAS bf16x8*)(lds + AT_KS + (a0 + 16 * ct + c16) * 272 + (ks * 32 + 8 * q4) * 2); sc[ct] = mfma16(ka, qf[ks], sc[ct]); } }
                if (local) {
                    const int qc = 16 * g + c16, col0 = min(max(qc - 8, 0), 48); const int dr = kr - qrow + 7;
#pragma unroll
                    for (int ct = 0; ct < 2; ++ct)
#pragma unroll
                        for (int r = 0; r < 4; ++r) { const int kc = a0 + 16 * ct + 4 * q4 + r; const bool valid = (kc >= col0) && (kc < col0 + 16);
                            const int dc = min(max(kc - qc + 15, 0), 30);
                            const float bias = *(const LAS float*)(lds + AT_RPB + (dr * 31 + dc) * 4);
                            sc[ct][r] = valid ? sc[ct][r] + bias : -1e30f; }
                }
                float mx = fmaxf(fmaxf(fmaxf(sc[0][0], sc[0][1]), fmaxf(sc[0][2], sc[0][3])), fmaxf(fmaxf(sc[1][0], sc[1][1]), fmaxf(sc[1][2], sc[1][3])));
                mx = fmaxf(mx, __shfl_xor(mx, 16)); mx = fmaxf(mx, __shfl_xor(mx, 32));
                const float m_new = fmaxf(m_run, mx);
                const float alpha = __expf(m_run - m_new);
                float pe[8]; float psum = 0.f;
#pragma unroll
                for (int ct = 0; ct < 2; ++ct)
#pragma unroll
                    for (int r = 0; r < 4; ++r) { const float e = __expf(sc[ct][r] - m_new); pe[ct * 4 + r] = e; psum += e; }
                psum += __shfl_xor(psum, 16); psum += __shfl_xor(psum, 32);
                l_run = l_run * alpha + psum; m_run = m_new;
                bf16x8 pf; { u32x4 pw; pw.x = pk2(pe[0], pe[1]); pw.y = pk2(pe[2], pe[3]); pw.z = pk2(pe[4], pe[5]); pw.w = pk2(pe[6], pe[7]); pf = __builtin_bit_cast(bf16x8, pw); }
                float al[4];
#pragma unroll
                for (int r = 0; r < 4; ++r) al[r] = __shfl(alpha, 4 * q4 + r);
#pragma unroll
                for (int dt = 0; dt < 8; ++dt) {
#pragma unroll
                    for (int r = 0; r < 4; ++r) O[dt][r] *= al[r];
                    const u32x2 lo = *(const LAS u32x2*)(lds + AT_VT + (16 * dt + c16) * 144 + (a0 + 4 * q4) * 2);
                    const u32x2 hi = *(const LAS u32x2*)(lds + AT_VT + (16 * dt + c16) * 144 + (a0 + 16 + 4 * q4) * 2);
                    u32x4 bw; bw.x = lo.x; bw.y = lo.y; bw.z = hi.x; bw.w = hi.y;
                    O[dt] = mfma16(pf, __builtin_bit_cast(bf16x8, bw), O[dt]);
                }
            }
        }
        float linv[4];
#pragma unroll
        for (int r = 0; r < 4; ++r) linv[r] = 1.0f / __shfl(l_run, 4 * q4 + r);
#pragma unroll
        for (int dt = 0; dt < 8; ++dt)
#pragma unroll
            for (int r = 0; r < 4; ++r) CQ[(size_t)(qbase + 4 * q4 + r) * 2048 + h * 128 + 16 * dt + c16] = f2bf(O[dt][r] * linv[r]);
    }
}

__device__ void phase_e2(KP p, int l, int nrows, int wid0) {
    const int tid = tid_fresh(wid0); const int lane = tid & 63, gw = blockIdx.x * 8 + (tid >> 6), nw = gridDim.x * 8;
    unsigned char* ws = launder(p->ws);
    const bf16_t* HF = (const bf16_t*)(ws + WS_BC); const bf16_t* HB = (const bf16_t*)(ws + WS_BX); bf16_t* PO = (bf16_t*)(ws + WS_PO);
    const float* hg = p->a_hnorm_g + (size_t)l * 2048;
    for (int row = gw; row < nrows; row += nw) {
#pragma unroll
        for (int h = 0; h < 8; ++h) {
            const size_t o = (size_t)row * 2048 + h * 256 + lane * 4;
            const u32x2 f = *(const u32x2*)(HF + o), bb = *(const u32x2*)(HB + o), ov = *(const u32x2*)(PO + o);
            float v[4] = {bflo(f.x) + bflo(bb.x), bfhi(f.x) + bfhi(bb.x), bflo(f.y) + bflo(bb.y), bfhi(f.y) + bfhi(bb.y)};
            float ss = v[0] * v[0] + v[1] * v[1] + v[2] * v[2] + v[3] * v[3];
            ss = wave_sum(ss);
            const float rstd = rsqrtf(ss * (1.0f / 256.0f) + EPSF);
            const f32x4 gg = *(const f32x4*)(hg + h * 256 + lane * 4);
            const float og[4] = {bflo(ov.x), bfhi(ov.x), bflo(ov.y), bfhi(ov.y)};
            float y[4];
#pragma unroll
            for (int j = 0; j < 4; ++j) y[j] = sigmoidf_(og[j]) * v[j] * rstd * gg[j];
            u32x2 wv; wv.x = pk2(y[0], y[1]); wv.y = pk2(y[2], y[3]); *(u32x2*)(PO + o) = wv;
        }
    }
}

constexpr int PE_MAXT = 80;
constexpr int PE_IDX = 0, PE_W = PE_MAXT * 128 * 4, PE_SCR = 2 * PE_MAXT * 128 * 4, PE_SCRSZ = 16 * 132 * 4 + 4096 + 256;
__device__ __forceinline__ unsigned ordkey(float v) { const unsigned u = __float_as_uint(v); return (u & 0x80000000u) ? ~u : (u | 0x80000000u); }
__device__ void phase_peer(KP p, int l, LAS unsigned char* lds, int wid0) {
    const int tid = tid_fresh(wid0), lane = tid & 63, w = __builtin_amdgcn_readfirstlane(tid >> 6), q4 = lane >> 4, c16 = lane & 15;
    unsigned char* ws = launder(p->ws);
    const bf16_t* QP = (const bf16_t*)(ws + WS_PV); const bf16_t* KEYS = (const bf16_t*)(ws + WS_KEYS);
    const bf16_t* XN = (const bf16_t*)(ws + WS_XN);
    float* X = (float*)(ws + WS_X); const float* mod = (const float*)(ws + WS_MOD) + (size_t)l * 3 * 12288;
    const int ntok = (l == 0) ? MR : NLAT, G = gridDim.x;
    const int per = (ntok + G - 1) / G; const int t_begin = blockIdx.x * per, t_end = min(ntok, t_begin + per);
    for (int tb = t_begin; tb < t_end; tb += PE_MAXT) {
        const int nt = min(PE_MAXT, t_end - tb);
        __syncthreads();
        const int ntask = (nt + 15) >> 4;
        if (w < ntask) {
            LAS unsigned char* scr = lds + PE_SCR + w * PE_SCRSZ;
            LAS float* SC = (LAS float*)scr;
            LAS float* LS = (LAS float*)(scr + 16 * 132 * 4);
            LAS int* LI = (LAS int*)(scr + 16 * 132 * 4 + 2048);
            LAS unsigned char* PT = scr + 16 * 132 * 4 + 4096;
            if (lane < 52) {
                int cnt = 0, pa = 15, pb = 15;
                for (int a = 0; a < 16; ++a) { const int nb = 16 / (a + 1); for (int bb = 0; bb < nb; ++bb) { if (cnt == lane) { pa = a; pb = bb; } ++cnt; } }
                PT[lane * 2] = (unsigned char)pa; PT[lane * 2 + 1] = (unsigned char)pb;
            }
            const int tok_a = min(tb + 16 * w + c16, t_end - 1);
            const int tkl = lane >> 2, qq = lane & 3;
            for (int h = 0; h < 8; ++h) {
                for (int pp = 0; pp < 2; ++pp) {
                    const int hp = 2 * h + pp;
                    bf16x8 af[4];
#pragma unroll
                    for (int ks = 0; ks < 4; ++ks) af[ks] = *(const bf16x8*)(QP + (size_t)tok_a * 2048 + h * 256 + pp * 128 + ks * 32 + 8 * q4);
#pragma unroll
                    for (int ct = 0; ct < 8; ++ct) {
                        f32x4 acc = {0.f, 0.f, 0.f, 0.f};
#pragma unroll
                        for (int ks = 0; ks < 4; ++ks) { const bf16x8 bfr = *(const bf16x8*)(KEYS + ((size_t)hp * 128 + 16 * ct + c16) * 128 + ks * 32 + 8 * q4); acc = mfma16(af[ks], bfr, acc); }
#pragma unroll
                        for (int r = 0; r < 4; ++r) SC[(4 * q4 + r) * 132 + 16 * ct + c16] = acc[r];
                    }
                    asm volatile("s_waitcnt lgkmcnt(0)" ::: "memory");
                    unsigned key[32];
#pragma unroll
                    for (int i = 0; i < 8; ++i) { const f32x4 v = *(const LAS f32x4*)(SC + tkl * 132 + 32 * qq + 4 * i);
#pragma unroll
                        for (int j = 0; j < 4; ++j) key[4 * i + j] = (ordkey(v[j]) & ~127u) | (unsigned)(32 * qq + 4 * i + j); }
                    unsigned prev = 0xffffffffu;
#pragma unroll 1
                    for (int r = 0; r < 16; ++r) {
                        unsigned mxk = 0u;
#pragma unroll
                        for (int i = 0; i < 32; ++i) { const unsigned k = key[i] < prev ? key[i] : 0u; mxk = mxk > k ? mxk : k; }
                        unsigned o1 = __shfl_xor(mxk, 1); mxk = mxk > o1 ? mxk : o1; o1 = __shfl_xor(mxk, 2); mxk = mxk > o1 ? mxk : o1;
                        prev = mxk;
                        if (qq == (r & 3)) { const int idx = (int)(mxk & 127u); LS[(pp * 16 + tkl) * 16 + r] = SC[tkl * 132 + idx]; LI[(pp * 16 + tkl) * 16 + r] = idx; }
                    }
                    asm volatile("s_waitcnt lgkmcnt(0)" ::: "memory");
                }
                unsigned ck[13];
#pragma unroll
                for (int i = 0; i < 13; ++i) { const int cidx = qq + 4 * i;
                    if (cidx < 50) { const int a = PT[cidx * 2], bq = PT[cidx * 2 + 1]; const float sv = LS[(0 * 16 + tkl) * 16 + a] + LS[(1 * 16 + tkl) * 16 + bq]; ck[i] = (ordkey(sv) & ~63u) | (unsigned)cidx; }
                    else ck[i] = 0u; }
                unsigned prev = 0xffffffffu; float best0 = 0.f, esum = 0.f; float myexp[4] = {0.f, 0.f, 0.f, 0.f}; int myidx[4] = {0, 0, 0, 0};
#pragma unroll
                for (int r = 0; r < 16; ++r) {
                    unsigned mxk = 0u;
#pragma unroll
                    for (int i = 0; i < 13; ++i) { const unsigned k = ck[i] < prev ? ck[i] : 0u; mxk = mxk > k ? mxk : k; }
                    unsigned o1 = __shfl_xor(mxk, 1); mxk = mxk > o1 ? mxk : o1; o1 = __shfl_xor(mxk, 2); mxk = mxk > o1 ? mxk : o1;
                    prev = mxk;
                    const int cidx = (int)(mxk & 63u); const int a = PT[cidx * 2], bq = PT[cidx * 2 + 1];
                    const float best = LS[(0 * 16 + tkl) * 16 + a] + LS[(1 * 16 + tkl) * 16 + bq];
                    const int eidx = LI[(0 * 16 + tkl) * 16 + a] * 128 + LI[(1 * 16 + tkl) * 16 + bq];
                    if (r == 0) best0 = best;
                    const float e = __expf(best - best0); esum += e;
                    if (qq == (r & 3)) { myexp[r >> 2] = e; myidx[r >> 2] = eidx; }
                }
                const float inv = 1.0f / esum; const int tl = 16 * w + tkl;
                if (tl < nt) {
#pragma unroll
                    for (int i = 0; i < 4; ++i) { const int r = 4 * i + qq;
                        *(LAS int*)(lds + PE_IDX + (tl * 128 + h * 16 + r) * 4) = myidx[i];
                        *(LAS float*)(lds + PE_W + (tl * 128 + h * 16 + r) * 4) = myexp[i] * inv; }
                }
                asm volatile("s_waitcnt lgkmcnt(0)" ::: "memory");
            }
        }
        __syncthreads();
        for (int tl = w; tl < nt; tl += 8) {
            const int row = tb + tl;
            f32x2 xs[16];
#pragma unroll
            for (int i = 0; i < 2; ++i)
#pragma unroll
                for (int hq = 0; hq < 2; ++hq) { const u32x4 xw = *(const u32x4*)(XN + (size_t)row * 2048 + i * 1024 + lane * 16 + hq * 8);
                    const float sc = 1.0f / 2048.0f;
                    xs[i * 8 + hq * 4 + 0] = (f32x2){bflo(xw.x) * sc, bfhi(xw.x) * sc}; xs[i * 8 + hq * 4 + 1] = (f32x2){bflo(xw.y) * sc, bfhi(xw.y) * sc};
                    xs[i * 8 + hq * 4 + 2] = (f32x2){bflo(xw.z) * sc, bfhi(xw.z) * sc}; xs[i * 8 + hq * 4 + 3] = (f32x2){bflo(xw.w) * sc, bfhi(xw.w) * sc}; }
            const LAS int* idxp = (const LAS int*)(lds + PE_IDX + tl * 512);
            LAS float* wp = (LAS float*)(lds + PE_W + tl * 512);
            u32x4 bufA[8], bufB[8];
#define PE_ISSUE(buf, TAB, b) do { const int _e0 = idxp[4 * (b)], _e1 = idxp[4 * (b) + 1], _e2 = idxp[4 * (b) + 2], _e3 = idxp[4 * (b) + 3]; \
                const unsigned char* _r0 = (TAB) + (size_t)_e0 * 2048 + lane * 16; const unsigned char* _r1 = (TAB) + (size_t)_e1 * 2048 + lane * 16; \
                const unsigned char* _r2 = (TAB) + (size_t)_e2 * 2048 + lane * 16; const unsigned char* _r3 = (TAB) + (size_t)_e3 * 2048 + lane * 16; \
                buf[0] = *(const u32x4*)_r0; buf[1] = *(const u32x4*)(_r0 + 1024); buf[2] = *(const u32x4*)_r1; buf[3] = *(const u32x4*)(_r1 + 1024); \
                buf[4] = *(const u32x4*)_r2; buf[5] = *(const u32x4*)(_r2 + 1024); buf[6] = *(const u32x4*)_r3; buf[7] = *(const u32x4*)(_r3 + 1024); } while (0)
#define PE_CONS_U(buf, b) do { float _p[4]; \
                _Pragma("unroll") for (int _j = 0; _j < 4; ++_j) { f32x2 _d = {0.f, 0.f}; \
                    _Pragma("unroll") for (int _i = 0; _i < 2; ++_i) { const u32x4 _u = buf[_j * 2 + _i]; \
                        _Pragma("unroll") for (int _q = 0; _q < 4; ++_q) { const int _dw = (int)_u[_q]; \
                            _d += __builtin_amdgcn_cvt_pk_f32_fp8(_dw, false) * xs[_i * 8 + _q * 2]; _d += __builtin_amdgcn_cvt_pk_f32_fp8(_dw, true) * xs[_i * 8 + _q * 2 + 1]; } } \
                    _p[_j] = _d[0] + _d[1]; } \
                const bool _h32 = (lane & 32) != 0, _h16 = (lane & 16) != 0; \
                float _a = _h32 ? _p[2] : _p[0]; const float _as = _h32 ? _p[0] : _p[2]; float _bq = _h32 ? _p[3] : _p[1]; const float _bs = _h32 ? _p[1] : _p[3]; \
                _a += __shfl_xor(_as, 32); _bq += __shfl_xor(_bs, 32); \
                float _c = _h16 ? _bq : _a; const float _cs = _h16 ? _a : _bq; _c += __shfl_xor(_cs, 16); \
                _c += __shfl_xor(_c, 8); _c += __shfl_xor(_c, 4); _c += __shfl_xor(_c, 2); _c += __shfl_xor(_c, 1); \
                const int _e = 4 * (b) + (lane >> 4); const float _g = wp[_e]; \
                const float _w = _g * 0.5f * _c * (1.0f + erff(_c * 0.70710678118654752f)); \
                if ((lane & 15) == 0) wp[_e] = _w; } while (0)
#define PE_CONS_V(buf, b) do { const f32x4 _w4 = *(const LAS f32x4*)(wp + 4 * (b)); \
                _Pragma("unroll") for (int _j = 0; _j < 4; ++_j) { const f32x2 _wv = {_w4[_j], _w4[_j]}; \
                    _Pragma("unroll") for (int _i = 0; _i < 2; ++_i) { const u32x4 _v = buf[_j * 2 + _i]; \
                        _Pragma("unroll") for (int _q = 0; _q < 4; ++_q) { const int _dw = (int)_v[_q]; \
                            out2[_i * 8 + _q * 2] += _wv * __builtin_amdgcn_cvt_pk_f32_fp8(_dw, false); out2[_i * 8 + _q * 2 + 1] += _wv * __builtin_amdgcn_cvt_pk_f32_fp8(_dw, true); } } } } while (0)
            const unsigned char* TU = ws + WS_PU; const unsigned char* TV = ws + WS_PVW;
            PE_ISSUE(bufA, TU, 0);
#pragma unroll 1
            for (int b = 0; b < 32; b += 2) {
                PE_ISSUE(bufB, TU, b + 1);
                PE_CONS_U(bufA, b);
                if (b + 2 < 32) PE_ISSUE(bufA, TU, b + 2); else PE_ISSUE(bufA, TV, 0);
                PE_CONS_U(bufB, b + 1);
            }
            asm volatile("s_waitcnt lgkmcnt(0)" ::: "memory");
            f32x2 out2[16];
#pragma unroll
            for (int i = 0; i < 16; ++i) out2[i] = (f32x2){0.f, 0.f};
#pragma unroll 1
            for (int b = 0; b < 32; b += 2) {
                PE_ISSUE(bufB, TV, b + 1);
                PE_CONS_V(bufA, b);
                if (b + 2 < 32) PE_ISSUE(bufA, TV, b + 2);
                PE_CONS_V(bufB, b + 1);
            }
#undef PE_ISSUE
#undef PE_CONS_U
#undef PE_CONS_V
            const int which = row < NLAT ? (row >> 13) : 2;
            const float* mg = mod + (size_t)which * 12288 + 5 * 2048;
            float* xrow = X + (size_t)row * 2048; float* orow = (l == 1) ? (p->out + (size_t)row * 2048) : xrow;
#pragma unroll
            for (int i = 0; i < 2; ++i)
#pragma unroll
                for (int hh = 0; hh < 4; ++hh) { const int c = i * 1024 + lane * 16 + hh * 4;
                    const f32x4 xv = *(const f32x4*)(xrow + c), gv = *(const f32x4*)(mg + c);
                    const f32x2 o0 = out2[i * 8 + hh * 2], o1 = out2[i * 8 + hh * 2 + 1];
                    f32x4 ov; ov[0] = xv[0] + gv[0] * o0[0] * (1.0f / 128.0f); ov[1] = xv[1] + gv[1] * o0[1] * (1.0f / 128.0f); ov[2] = xv[2] + gv[2] * o1[0] * (1.0f / 128.0f); ov[3] = xv[3] + gv[3] * o1[1] * (1.0f / 128.0f);
                    *(f32x4*)(orow + c) = ov; }
        }
    }
}

__global__ void __launch_bounds__(NTHREADS, 2) fwd_kernel(Params p) {
    extern __shared__ __attribute__((aligned(16))) unsigned char lds_raw[];
    LAS unsigned char* lds = (LAS unsigned char*)lds_raw;
    const int tid = threadIdx.x, G = gridDim.x;
    const int wid0 = __builtin_amdgcn_readfirstlane(tid >> 6);
    KP kp = (KP)__builtin_amdgcn_kernarg_segment_ptr();
    unsigned char* ws0 = kp->ws;
    volatile LAS unsigned* bst = (volatile LAS unsigned*)(lds + LDS_BYTES - 16);
    if (tid == 0) { bst[0] = 0u; bst[1] = 0u; bst[2] = 0u; bst[3] = 0u; }
    __syncthreads();
    XcdBarrier bar; bar.bar = (unsigned*)(ws0 + WS_BAR); bar.x = 0; bar.st = bst;
    if (MK_SINGLE) bar = xcd_barrier_post((unsigned*)(ws0 + WS_BAR), bst);
    const int lo = kp->ph_lo, hi = kp->ph_hi;
#ifndef PHM
#define PHM 0x7ff
#endif
#define IN(k) (((PHM >> (((k) % NPH))) & 1) && lo <= (k) && (k) < hi)
#define SEAM(k) do { if (IN(k) && IN((k) + 1)) xcd_barrier(bar); } while (0)
    for (int l = 0; l < 2; ++l) {
        const int pb = l * NPH;
        const int M2 = (l == 0) ? MR : NLAT;
        if (IN(pb + 0)) { phase_w(launder_p(kp), l, lds, wid0); } SEAM(pb + 0);
        if (IN(pb + 1)) { phase_norm(launder_p(kp), l, 0, MR, wid0); } SEAM(pb + 1);
        if (IN(pb + 2)) { unsigned char* ws = launder(ws0);
            { pg8::PlainOrder S; S.init(ws + WS_XN8, ws + WS_WIN, MR, 72 * 256, 1024, G, (int)blockIdx.x); S.skip_from = 48; S.skip_cnt = 24;
              pg8::EpiProj E{ws};
              pg8::gemm_phase<pg8::EpiProj, pg8::PlainOrder, true>(lds, 1024, S, E, wid0); }
            { pg8::PlainOrder S; S.init(ws + WS_XN, ws + WS_WINB, MR, 24 * 256, 2048, G, (int)blockIdx.x); S.pn_base = 48; S.b_row0 = 48;
              pg8::EpiProj E{ws};
              pg8::gemm_phase<pg8::EpiProj, pg8::PlainOrder, false>(lds, 2048, S, E, wid0); }
        } SEAM(pb + 2);
        if (IN(pb + 3)) { phase_gates_gemm(launder_p(kp), l, wid0); phase_e1(launder_p(kp), l, wid0); } SEAM(pb + 3);
        if (IN(pb + 4)) { phase_mlstm(launder_p(kp), l, lds, wid0); phase_attn(launder_p(kp), l, lds, wid0); } SEAM(pb + 4);
        if (IN(pb + 5)) { phase_e2(launder_p(kp), l, M2, wid0); } SEAM(pb + 5);
        if (IN(pb + 6)) { unsigned char* ws = launder(ws0);
            pg8::BranchOrder S; S.T8 = (const char*)(ws + WS_T8); S.WA = (const char*)(ws + WS_WA);
            S.nM = M2 / 256; S.nN = 8; S.G = G; S.c = (int)blockIdx.x; S.tstep = (size_t)256 * 2048 * 2;
            pg8::EpiMerge E{(bf16_t*)(ws + WS_Y), (const bf16_t*)(ws + WS_GT)};
            pg8::gemm_phase<pg8::EpiMerge, pg8::BranchOrder>(lds, 2048, S, E, wid0);
        } SEAM(pb + 6);
        if (IN(pb + 7)) { unsigned char* ws = launder(ws0);
            pg8::PlainOrder S; S.init(ws + WS_Y, ws + WS_WO, M2, 2048, 2048, G, (int)blockIdx.x);
            pg8::EpiRes E{(float*)(ws + WS_X), (const float*)(ws + WS_MOD) + (size_t)l * 3 * 12288};
            pg8::gemm_phase<pg8::EpiRes, pg8::PlainOrder>(lds, 2048, S, E, wid0);
        } SEAM(pb + 7);
        if (IN(pb + 8)) { phase_norm(launder_p(kp), l, 1, M2, wid0); } SEAM(pb + 8);
        if (IN(pb + 9)) { unsigned char* ws = launder(ws0);
            pg8::PlainOrder S; S.init(ws + WS_XN, ws + WS_WQ, M2, 2048, 2048, G, (int)blockIdx.x);
            pg8::EpiBf E{(bf16_t*)(ws + WS_PV), 2048};
            pg8::gemm_phase<pg8::EpiBf, pg8::PlainOrder>(lds, 2048, S, E, wid0);
        } SEAM(pb + 9);
        if (IN(pb + 10)) { phase_peer(launder_p(kp), l, lds, wid0); } SEAM(pb + 10);
    }
#undef IN
#undef SEAM
}

#ifdef CUT
#ifndef DUMP_OFF
#define DUMP_OFF WS_PV
#endif
#ifndef DUMP_F32
#define DUMP_F32 0
#endif
#ifndef DUMP_N
#define DUMP_N ((size_t)NLAT * DM)
#endif
__global__ void dump_kernel(const unsigned char* ws, float* out, size_t n) {
    for (size_t i = (size_t)blockIdx.x * blockDim.x + threadIdx.x; i < n; i += (size_t)gridDim.x * blockDim.x)
        out[i] = (i >= (size_t)DUMP_N) ? 0.f : (DUMP_F32 ? ((const float*)(ws + DUMP_OFF))[i] : bf2f(((const bf16_t*)(ws + DUMP_OFF))[i]));
}
#endif
extern "C" void kernel_launch(void* const* d_in, const int* in_sizes, int n_in, void* d_out, int out_size, void* d_ws, size_t ws_size, hipStream_t stream) {
    static int grid = 0;
    if (grid == 0) {
        if (n_in != 21 || in_sizes[0] != NLAT * DM || out_size != NLAT * DM || ws_size < WS_END) {
            fprintf(stderr, "kernel_launch: unexpected shapes (n_in %d, in0 %d, out %d, ws %zu need %zu); nothing launched\n", n_in, n_in > 0 ? in_sizes[0] : -1, out_size, ws_size, (size_t)WS_END); grid = -1; return; }
        int dev = 0, cus = 0, per_cu = 0;
        if (hipGetDevice(&dev) != hipSuccess || hipDeviceGetAttribute(&cus, hipDeviceAttributeMultiprocessorCount, dev) != hipSuccess) { grid = -1; return; }
        if (hipFuncSetAttribute((const void*)fwd_kernel, hipFuncAttributeMaxDynamicSharedMemorySize, LDS_BYTES) != hipSuccess) { fprintf(stderr, "kernel_launch: hipFuncSetAttribute failed\n"); grid = -1; return; }
        if (hipOccupancyMaxActiveBlocksPerMultiprocessor(&per_cu, (const void*)fwd_kernel, NTHREADS, LDS_BYTES) != hipSuccess || per_cu < 1) { fprintf(stderr, "kernel_launch: occupancy query says %d\n", per_cu); }
        (void)hipGetLastError();
        grid = cus;
    }
    if (grid < 0) return;
    (void)hipMemsetAsync((char*)d_ws, 0, CTL_BYTES, stream);
    Params p{};
    const float** pp = (const float**)&p;
    for (int i = 0; i < 21; ++i) pp[i] = (const float*)d_in[i];
    p.out = (float*)d_out; p.ws = (unsigned char*)d_ws;
#if MK_SINGLE
    p.ph_lo = 0; p.ph_hi = 2 * NPH;
    hipLaunchKernelGGL(fwd_kernel, dim3(grid), dim3(NTHREADS), LDS_BYTES, stream, p);
#else
#ifdef CUT
    for (int k = 0; k <= CUT; ++k) { p.ph_lo = k; p.ph_hi = k + 1; hipLaunchKernelGGL(fwd_kernel, dim3(grid), dim3(NTHREADS), LDS_BYTES, stream, p); }
    hipLaunchKernelGGL(dump_kernel, dim3(1024), dim3(256), 0, stream, (const unsigned char*)d_ws, (float*)d_out, (size_t)NLAT * DM);
#else
    for (int k = 0; k < 2 * NPH; ++k) { p.ph_lo = k; p.ph_hi = k + 1; hipLaunchKernelGGL(fwd_kernel, dim3(grid), dim3(NTHREADS), LDS_BYTES, stream, p); }
#endif
#endif
}
```

```cpp
#include <hip/hip_runtime.h>
#include <stdint.h>
#include <stdio.h>
#include <type_traits>

#ifndef ABL
#define ABL 0
#endif
#ifndef MK_SINGLE
#define MK_SINGLE 1
#endif

#define LAS __attribute__((address_space(3)))
typedef unsigned short bf16_t;
typedef short bf16x8 __attribute__((ext_vector_type(8)));
typedef float f32x4 __attribute__((ext_vector_type(4)));
typedef float f32x2 __attribute__((ext_vector_type(2)));
typedef unsigned u32x4 __attribute__((ext_vector_type(4)));
typedef unsigned u32x2 __attribute__((ext_vector_type(2)));
typedef __bf16 bf2_t __attribute__((ext_vector_type(2)));
typedef int i32x4 __attribute__((ext_vector_type(4)));
typedef int i32x8 __attribute__((ext_vector_type(8)));
typedef float f32x16 __attribute__((ext_vector_type(16)));
typedef float f32x32 __attribute__((ext_vector_type(32)));
typedef unsigned u32x6 __attribute__((ext_vector_type(6)));
typedef __bf16 bf16x32_t __attribute__((ext_vector_type(32)));
typedef unsigned u32x16 __attribute__((ext_vector_type(16)));
#ifndef FP6_INTERLEAVED
#define FP6_INTERLEAVED 1
#endif

constexpr int DM = 2048, NBATCH = 2, SEQ = 8192, CTXL = 256;
constexpr int NLAT = NBATCH * SEQ;
constexpr int NCTX = NBATCH * CTXL;
constexpr int MR = NLAT + NCTX;
constexpr int PROJ_W = 24608;
constexpr int NPROJ = 24576;
constexpr int NTHREADS = 512;
constexpr int LDS_BYTES = 163840;
constexpr int NPH = 11;
constexpr float EPSF = 1e-6f;

constexpr size_t SZ_A = (size_t)MR * 2048 * 2;
constexpr size_t WS_BAR = 0;
constexpr size_t WS_MOD = 16384;
constexpr size_t CTL_BYTES = 16384 + 2 * 3 * 12288 * 4;
constexpr size_t WS_TAB = 311296;
constexpr size_t WS_X = WS_TAB + 32768;
constexpr size_t WS_XN = WS_X + (size_t)MR * 2048 * 4;
constexpr size_t WS_Y = WS_XN + SZ_A;
constexpr size_t WS_XN8 = WS_Y;
constexpr size_t WS_PQ = WS_Y + SZ_A;
constexpr size_t WS_PK = WS_PQ + SZ_A / 2;
constexpr size_t WS_T8 = WS_PK + SZ_A / 2;
constexpr size_t WS_PV = WS_T8 + 0 * SZ_A;
constexpr size_t WS_PO = WS_T8 + 1 * SZ_A;
constexpr size_t WS_CQ = WS_T8 + 2 * SZ_A;
constexpr size_t WS_CK = WS_T8 + 3 * SZ_A;
constexpr size_t WS_CV = WS_T8 + 4 * SZ_A;
constexpr size_t WS_BB = WS_T8 + 5 * SZ_A;
constexpr size_t WS_BC = WS_T8 + 6 * SZ_A;
constexpr size_t WS_BX = WS_T8 + 7 * SZ_A;
constexpr size_t WS_GT = WS_T8 + 8 * SZ_A;
constexpr size_t WS_GATES = WS_GT + 3 * SZ_A;
constexpr size_t WS_WIN = WS_GATES + (size_t)MR * 32 * 4;
constexpr size_t WS_WINB = WS_WIN + (size_t)NPROJ * 2048;
constexpr size_t WS_WG = WS_WIN + (size_t)NPROJ * 2048 * 2;
constexpr size_t SZ_W = (size_t)2048 * 2048 * 2;
constexpr size_t WS_WA = WS_WG + 32 * 2048 * 2;
constexpr size_t WS_WB = WS_WA + SZ_W;
constexpr size_t WS_WC = WS_WB + SZ_W;
constexpr size_t WS_WO = WS_WC + SZ_W;
constexpr size_t WS_WQ = WS_WO + SZ_W;
constexpr size_t WS_KEYS = WS_WQ + SZ_W;
constexpr size_t WS_PU = WS_KEYS + 16 * 128 * 128 * 2;
constexpr size_t WS_PVW = WS_PU + (size_t)16384 * 2048 * 2;
constexpr size_t WS_SCAN = WS_PU + (size_t)16384 * 2048;
constexpr size_t WS_END = WS_PVW + (size_t)16384 * 2048 * 2;

struct Params {
    const float *x, *c, *ctx, *c_ctx, *w_ada, *b_ada, *norm_g, *w_in, *a_gate_b, *a_hnorm_g, *b_conv, *c_qk_g, *c_rpb,
        *w_a_out, *w_b_out, *w_c_out, *w_out, *peer_wq, *peer_keys, *peer_u, *peer_v;
    float* out; unsigned char* ws; int ph_lo, ph_hi;
};
#define CAS __attribute__((address_space(4)))
typedef const CAS Params* KP;
__device__ __forceinline__ KP launder_p(KP q) { asm volatile("" : "+s"(q)); return q; }

__device__ __forceinline__ unsigned char* launder(unsigned char* q) { size_t z = 0; asm volatile("" : "+s"(z)); return q + z; }
__device__ __forceinline__ int tid_fresh(int wid0) { int t = wid0 * 64 + (int)__builtin_amdgcn_mbcnt_hi(~0u, __builtin_amdgcn_mbcnt_lo(~0u, 0u)); asm volatile("" : "+v"(t)); return t; }

__device__ __forceinline__ float bf2f(unsigned b) { return __uint_as_float(b << 16); }
__device__ __forceinline__ float bflo(unsigned w) { return __uint_as_float(w << 16); }
__device__ __forceinline__ float bfhi(unsigned w) { return __uint_as_float(w & 0xffff0000u); }
__device__ __forceinline__ unsigned pk2(float lo, float hi) { f32x2 v = {lo, hi}; bf2_t b = __builtin_convertvector(v, bf2_t); return __builtin_bit_cast(unsigned, b); }
__device__ __forceinline__ bf16_t f2bf(float f) { return (bf16_t)(pk2(f, 0.f) & 0xffffu); }
__device__ __forceinline__ f32x4 mfma16(bf16x8 a, bf16x8 b, f32x4 c) { return __builtin_amdgcn_mfma_f32_16x16x32_bf16(a, b, c, 0, 0, 0); }
__device__ __forceinline__ float dot2bf(unsigned a, unsigned b, float c) { return __builtin_amdgcn_fdot2_f32_bf16(__builtin_bit_cast(bf2_t, a), __builtin_bit_cast(bf2_t, b), c, false); }
#define LDS_BARRIER() do { asm volatile("s_waitcnt lgkmcnt(0)" ::: "memory"); __builtin_amdgcn_s_barrier(); asm volatile("" ::: "memory"); } while (0)
__device__ __forceinline__ float wave_sum(float v) {
#pragma unroll
    for (int o = 32; o >= 1; o >>= 1) v += __shfl_xor(v, o);
    return v;
}
__device__ __forceinline__ float sigmoidf_(float v) { return 1.0f / (1.0f + __expf(-v)); }
__device__ __forceinline__ float logsigmoidf_(float v) { return fminf(v, 0.f) - log1pf(__expf(-fabsf(v))); }

#define XB_TMO      128
#define XB_XCNT(j)  (256  + 64 * (j))
#define XB_XSUB(j)  (1280 + 64 * (j))
#define XB_XGEN(j)  (2304 + 64 * (j))
#define XB_TOP      3328
#define XB_TOPGEN   3392
#define XCD_BAR_WORDS 3456
#define XB_SPIN_CAP (1u << 22)
__device__ __forceinline__ unsigned xb_ld(unsigned* p)              { return __hip_atomic_load(p, __ATOMIC_RELAXED, __HIP_MEMORY_SCOPE_AGENT); }
__device__ __forceinline__ unsigned xb_add(unsigned* p, unsigned v) { return __hip_atomic_fetch_add(p, v, __ATOMIC_RELAXED, __HIP_MEMORY_SCOPE_AGENT); }
__device__ __forceinline__ unsigned xb_xcc_id() { return (unsigned)__builtin_amdgcn_s_getreg((3 << 11) | 20) & 0xFu; }
#define XB_SPIN(cond, bar) do { unsigned _sp = 0; while (cond) { __builtin_amdgcn_s_sleep(1); \
    if ((++_sp & 255u) == 0u) { if (xb_ld(&(bar)[XB_TMO])) break; if (_sp > XB_SPIN_CAP) { atomicAdd(&(bar)[XB_TMO], 1u); break; } } } } while (0)
struct XcdBarrier { unsigned* bar; unsigned x; volatile LAS unsigned* st; };
__device__ __forceinline__ XcdBarrier xcd_barrier_post(unsigned* bar, volatile LAS unsigned* st) {
    XcdBarrier b; b.bar = bar; b.x = xb_xcc_id(); b.st = st;
    if (threadIdx.x == 0) (void)xb_add(&bar[XB_XCNT(b.x)], 1u);
    return b;
}
__device__ __forceinline__ void xcd_barrier_complete(unsigned* bar, unsigned x, unsigned& nloc, unsigned& nx) {
    const unsigned G = gridDim.x * gridDim.y * gridDim.z;
    unsigned sum, cnt, mine, sp = 0u;
    for (;;) {
        sum = 0u; cnt = 0u; mine = 0u;
#pragma unroll
        for (unsigned j = 0; j < 16; ++j) { const unsigned c = xb_ld(&bar[XB_XCNT(j)]); sum += c; cnt += (c > 0u) ? 1u : 0u; mine = (j == x) ? c : mine; }
        if (sum == G) break;
        __builtin_amdgcn_s_sleep(1);
        if ((++sp & 255u) == 0u) { if (xb_ld(&bar[XB_TMO])) break; if (sp > XB_SPIN_CAP) { atomicAdd(&bar[XB_TMO], 1u); break; } }
    }
    nloc = mine > 0u ? mine : 1u; nx = cnt > 0u ? cnt : 1u;
}
__device__ __forceinline__ void xcd_barrier(const XcdBarrier& b) {
    asm volatile("s_waitcnt vmcnt(0)" ::: "memory");
    __syncthreads();
    if (threadIdx.x == 0) {
        unsigned* bar = b.bar;
        __builtin_amdgcn_s_waitcnt(0);
        unsigned nloc = b.st[0], nx = b.st[1];
        if (nloc == 0u) { xcd_barrier_complete(bar, b.x, nloc, nx); b.st[0] = nloc; b.st[1] = nx; }
        const unsigned old = xb_add(&bar[XB_XSUB(b.x)], 1u);
        const unsigned gen = old / nloc;
        if (old + 1u == (gen + 1u) * nloc) {
            __builtin_amdgcn_fence(__ATOMIC_RELEASE, "agent");
            asm volatile("s_waitcnt vmcnt(0)" ::: "memory");
            const unsigned og = xb_add(&bar[XB_TOP], 1u);
            const unsigned tg = og / nx;
            if (og + 1u == (tg + 1u) * nx) xb_add(&bar[XB_TOPGEN], 1u);
            else XB_SPIN(xb_ld(&bar[XB_TOPGEN]) == tg, bar);
            __builtin_amdgcn_fence(__ATOMIC_ACQUIRE, "agent");
            xb_add(&bar[XB_XGEN(b.x)], 1u);
            asm volatile("s_waitcnt vmcnt(0)" ::: "memory");
        } else {
            XB_SPIN(xb_ld(&bar[XB_XGEN(b.x)]) == gen, bar);
            __builtin_amdgcn_fence(__ATOMIC_ACQUIRE, "agent");
            asm volatile("s_waitcnt vmcnt(0)" ::: "memory");
        }
    }
    __syncthreads();
}

namespace pg8 {
constexpr int BM = 256, BK = 64, HALF = 128, HTB = HALF * BK * 2, STAGE_BYTES = 8 * HTB, NXCD = 8, WGM = 8;
__host__ __device__ __forceinline__ int lds_byte(int r, int c) { const int st = (r >> 4) * 2 + (c >> 5), rr = r & 15, cc = c & 31, ob = rr * 64 + cc * 2; return st * 1024 + (ob ^ (((ob >> 9) & 1) << 5)); }
__host__ __device__ __forceinline__ void stage_rc(int b, int& R, int& C) { const int st = b / 1024, sb = b % 1024, swz = sb ^ (((sb >> 9) & 1) << 5); R = (st >> 1) * 16 + swz / 64; C = (st & 1) * 32 + (swz % 64) / 2; }
__host__ __device__ __forceinline__ int perm32(int rho) { const int n = rho >> 4, i = rho & 15; return 8 * (i >> 2) + 4 * n + (i & 3); }

struct Unit { int pm, pn, br; const char* A; const char* B; };

__device__ __forceinline__ bool tile_of(int L, int nM, int nN, int& pm, int& pn) {
    const int nwg = nM * nN; if (L >= nwg) return false;
    int wgid = L; { const int q = nwg / NXCD, r = nwg % NXCD, xcd = wgid % NXCD, off = wgid / NXCD; wgid = (xcd < r ? xcd * (q + 1) : r * (q + 1) + (xcd - r) * q) + off; }
    const int nig = WGM * nN, gid = wgid / nig, fm = gid * WGM, gsz = (nM - fm) < WGM ? (nM - fm) : WGM;
    pm = fm + ((wgid % nig) % gsz); pn = (wgid % nig) / gsz; return true;
}
struct PlainOrder {
    const char* A; const char* Bt; int nM, nN, G, c; size_t tstep; int pn_base, skip_from, skip_cnt, b_row0;
    __device__ __forceinline__ void init(const void* A_, const void* Bt_, int M, int N, int K, int G_, int c_) { A = (const char*)A_; Bt = (const char*)Bt_; nM = M / BM; nN = N / BM; G = G_; c = c_; tstep = (size_t)BM * K * 2;
        pn_base = 0; skip_from = 1 << 30; skip_cnt = 0; b_row0 = 0; }
    __device__ __forceinline__ bool next(int i, Unit& u) const {
        int pm, pn; if (!tile_of(i * G + c, nM, nN, pm, pn)) return false;
        pn += pn_base; if (pn >= skip_from) pn += skip_cnt;
        u.pm = pm; u.pn = pn; u.br = 0; u.A = A + (size_t)pm * tstep; u.B = Bt + (size_t)(pn - b_row0) * tstep; return true;
    }
};
struct BranchOrder {
    const char* T8; const char* WA; int nM, nN, G, c; size_t tstep;
    __device__ __forceinline__ bool next(int i, Unit& u) const {
        const int tl = i / 3, br = i - 3 * tl; int pm, pn; if (!tile_of(tl * G + c, nM, nN, pm, pn)) return false;
        u.pm = pm; u.pn = pn; u.br = br;
        const int ti = 1 + 4 * (br == 1) + (br == 2);
        u.A = T8 + (size_t)ti * SZ_A + (size_t)pm * tstep; u.B = WA + (size_t)br * SZ_W + (size_t)pn * tstep; return true;
    }
};

template <class Epi, class Sched, bool FP8 = false>
__device__ __forceinline__ void gemm_phase(LAS unsigned char* lds, const int K, const Sched& S, const Epi& E, int wid0) {
    const int tid = tid_fresh(wid0), wid = __builtin_amdgcn_readfirstlane(tid >> 6), lane = tid & 63, wr = wid >> 2, wc = wid & 3, fr = lane & 15, fq = lane >> 4;
    const int nt = K / BK;
    unsigned voffA[2], voffB[2];
#pragma unroll
    for (int i = 0; i < 2; ++i) { int R, C; stage_rc(tid * 16 + i * 8192, R, C); const int Rb = Epi::PERM ? ((R & ~31) + perm32(R & 31)) : R;
        voffA[i] = (unsigned)(R * K + C) * 2u; voffB[i] = (unsigned)(Rb * K + C) * 2u; }
    const size_t kstep = (size_t)(BK * 2);
    const size_t hstep = (size_t)HALF * K * 2;
    const unsigned ldsw = (unsigned)wid * 1024u;
    const int aoff = lds_byte(wr * 64 + fr, fq * 8), boff = lds_byte(wc * 32 + fr, fq * 8);
#define PG8_SA(b, h) (((b) * 2 + (h)) * HTB)
#define PG8_SB(b, h) ((4 + (b) * 2 + (h)) * HTB)
#define PG8_STAGE(bufoff, gbase, voff) do { _Pragma("unroll") for (int _i = 0; _i < 2; ++_i) \
        __builtin_amdgcn_global_load_lds((const unsigned*)((const char*)(gbase) + (voff)[_i]), (LAS unsigned*)(lds + (bufoff) + ldsw + _i * 8192), 16, 0, 0); } while (0)
#define PG8_LD1(dstv, addr) do { if constexpr (FP8) { const i32x4 _lo = *(const LAS i32x4*)(lds + (addr)), _hi = *(const LAS i32x4*)(lds + (addr) + 1024); dstv[0] = __builtin_shufflevector(_lo, _hi, 0, 1, 2, 3, 4, 5, 6, 7); } \
        else { _Pragma("unroll") for (int k = 0; k < 2; ++k) dstv[k] = *(const LAS bf16x8*)(lds + (addr) + k * 1024); } } while (0)
#define PG8_LDA(dst, b, h) do { _Pragma("unroll") for (int m = 0; m < 4; ++m) PG8_LD1(dst[m], PG8_SA(b, h) + aoff + m * 2048); } while (0)
#define PG8_LDB(dst, b, h) do { _Pragma("unroll") for (int n = 0; n < 2; ++n) PG8_LD1(dst[n], PG8_SB(b, h) + boff + n * 2048); } while (0)
#define PG8_MMA(ai, bj, At, Bt) do { __builtin_amdgcn_s_setprio(1); _Pragma("unroll") for (int m = 0; m < 4; ++m) _Pragma("unroll") for (int n = 0; n < 2; ++n) { \
        if constexpr (FP8) asm volatile("v_mfma_scale_f32_16x16x128_f8f6f4 %0, %1, %2, %0, %3, %4 op_sel_hi:[0,0,0]" : "+v"(acc[ai][bj][m][n]) : "v"(Bt[n][0]), "v"(At[m][0]), "v"(sclW), "v"(sclX)); \
        else { _Pragma("unroll") for (int k = 0; k < 2; ++k) acc[ai][bj][m][n] = __builtin_amdgcn_mfma_f32_16x16x32_bf16(Bt[n][k], At[m][k], acc[ai][bj][m][n], 0, 0, 0); } } \
        __builtin_amdgcn_s_setprio(0); } while (0)
#define PG8_WAIT_V(n) asm volatile("s_waitcnt vmcnt(" #n ")" ::: "memory")
#define PG8_WAIT_L(n) asm volatile("s_waitcnt lgkmcnt(" #n ")" ::: "memory")
#define PG8_BAR __builtin_amdgcn_s_barrier()
#define PG8_SCHED __builtin_amdgcn_sched_barrier(0)
    Unit cur, nxt; int ui = 0;
    if (!S.next(0, cur)) return;
    const int sclW = 0x75757575, sclX = 0x7F7F7F7F;
    f32x4 acc[2][2][4][2];
#pragma unroll
    for (int a = 0; a < 2; ++a)
#pragma unroll
        for (int b = 0; b < 2; ++b)
#pragma unroll
            for (int m = 0; m < 4; ++m)
#pragma unroll
                for (int n = 0; n < 2; ++n) acc[a][b][m][n] = (f32x4){0.f, 0.f, 0.f, 0.f};
    typedef typename std::conditional<FP8, i32x8, bf16x8>::type frag_t;
    frag_t At[4][FP8 ? 1 : 2], B0[2][FP8 ? 1 : 2], B1[2][FP8 ? 1 : 2];
    const char* cA = cur.A; const char* cB = cur.B;
    PG8_STAGE(PG8_SB(0, 0), cB, voffB); PG8_STAGE(PG8_SA(0, 0), cA, voffA); PG8_STAGE(PG8_SB(0, 1), cB + hstep, voffB); PG8_STAGE(PG8_SA(0, 1), cA + hstep, voffA);
    if (wr == 1) PG8_BAR;
    PG8_WAIT_V(4); PG8_BAR;
    PG8_STAGE(PG8_SB(1, 0), cB + kstep, voffB); PG8_STAGE(PG8_SA(1, 0), cA + kstep, voffA); PG8_STAGE(PG8_SB(1, 1), cB + hstep + kstep, voffB);
    PG8_WAIT_V(6); PG8_BAR;
    for (;;) {
        const bool has_next = S.next(ui + 1, nxt);
        const char* nA = has_next ? nxt.A : cA; const char* nB = has_next ? nxt.B : cB;
        for (int t = 0; t < nt; t += 2) {
            const bool last = (t == nt - 2);
            const char* a1 = cA + (size_t)(t + 1) * kstep;
            const char* a2 = last ? nA : cA + (size_t)(t + 2) * kstep; const char* b2 = last ? nB : cB + (size_t)(t + 2) * kstep;
            const char* a3 = a2 + kstep; const char* b3 = b2 + kstep;
            PG8_LDB(B0, 0, 0); PG8_SCHED; PG8_LDA(At, 0, 0); PG8_STAGE(PG8_SA(1, 1), a1 + hstep, voffA);
            PG8_WAIT_L(8); PG8_BAR; PG8_WAIT_L(0); PG8_MMA(0, 0, At, B0); PG8_BAR; PG8_SCHED;
            PG8_LDB(B1, 0, 1); PG8_STAGE(PG8_SB(0, 0), b2, voffB);
            PG8_BAR; PG8_WAIT_L(0); PG8_MMA(0, 1, At, B1); PG8_BAR;
            PG8_LDA(At, 0, 1); PG8_STAGE(PG8_SA(0, 0), a2, voffA);
            PG8_BAR; PG8_WAIT_L(0); PG8_MMA(1, 0, At, B0); PG8_BAR; PG8_SCHED;
            PG8_STAGE(PG8_SB(0, 1), b2 + hstep, voffB);
            PG8_WAIT_V(6); PG8_BAR; PG8_MMA(1, 1, At, B1); PG8_BAR;
            PG8_LDB(B0, 1, 0); PG8_SCHED; PG8_LDA(At, 1, 0); PG8_STAGE(PG8_SA(0, 1), a2 + hstep, voffA);
            PG8_WAIT_L(8); PG8_BAR; PG8_WAIT_L(0); PG8_MMA(0, 0, At, B0); PG8_BAR; PG8_SCHED;
            PG8_LDB(B1, 1, 1); PG8_STAGE(PG8_SB(1, 0), b3, voffB);
            PG8_BAR; PG8_WAIT_L(0); PG8_MMA(0, 1, At, B1); PG8_BAR;
            PG8_LDA(At, 1, 1); PG8_STAGE(PG8_SA(1, 0), a3, voffA);
            PG8_BAR; PG8_WAIT_L(0); PG8_MMA(1, 0, At, B0); PG8_BAR; PG8_SCHED;
            PG8_STAGE(PG8_SB(1, 1), b3 + hstep, voffB);
            PG8_WAIT_V(6); PG8_BAR; PG8_MMA(1, 1, At, B1); PG8_BAR;
        }
        if constexpr (FP8) { asm volatile("s_nop 15\n\ts_nop 15\n\ts_nop 15" ::: "memory"); }
        E(acc, cur, wr, wc, fr, fq);
        if (!has_next) break;
#pragma unroll
        for (int a = 0; a < 2; ++a)
#pragma unroll
            for (int b = 0; b < 2; ++b)
#pragma unroll
                for (int m = 0; m < 4; ++m)
#pragma unroll
                    for (int n = 0; n < 2; ++n) acc[a][b][m][n] = (f32x4){0.f, 0.f, 0.f, 0.f};
        cur = nxt; cA = nA; cB = nB; ++ui;
    }
    PG8_WAIT_V(0);
    if (wr == 0) PG8_BAR;
    PG8_BAR;
#undef PG8_SA
#undef PG8_SB
#undef PG8_STAGE
#undef PG8_LD1
#undef PG8_LDA
#undef PG8_LDB
#undef PG8_MMA
#undef PG8_WAIT_V
#undef PG8_WAIT_L
#undef PG8_BAR
#undef PG8_SCHED
}

struct EpiProj {
    static constexpr bool PERM = true;
    unsigned char* ws;
    __device__ __forceinline__ void operator()(const f32x4 (&acc)[2][2][4][2], const Unit& u, int wr, int wc, int fr, int fq) const {
        const int pn = u.pn; size_t off; int ld, c0;
        if (pn < 4) { off = WS_PQ; ld = 1024; c0 = pn * 256; }
        else if (pn < 8) { off = WS_PK; ld = 1024; c0 = (pn - 4) * 256; }
        else if (pn < 72) { const int t = (pn - 8) >> 3; off = WS_T8 + (size_t)t * SZ_A; ld = 2048; c0 = ((pn - 8) & 7) * 256; }
        else { off = WS_GT; ld = 6144; c0 = (pn - 72) * 256; }
        bf16_t* rp = (bf16_t*)(ws + off) + (size_t)(u.pm * BM + wr * 64 + fr) * ld + c0 + wc * 32 + 8 * fq;
        const size_t step = (size_t)16 * ld;
#pragma unroll
        for (int ai = 0; ai < 2; ++ai) {
#pragma unroll
            for (int m = 0; m < 4; ++m) {
                asm volatile("" : "+v"(rp));
#pragma unroll
                for (int bj = 0; bj < 2; ++bj) { const f32x4 v0 = acc[ai][bj][m][0], v1 = acc[ai][bj][m][1];
                    u32x4 w; w.x = pk2(v0[0], v0[1]); w.y = pk2(v0[2], v0[3]); w.z = pk2(v1[0], v1[1]); w.w = pk2(v1[2], v1[3]);
                    *(u32x4*)(rp + bj * HALF) = w; }
                rp += step;
            }
            rp += 4 * step;
        }
    }
};
struct EpiBf {
    static constexpr bool PERM = true;
    bf16_t* O; int ld;
    __device__ __forceinline__ void operator()(const f32x4 (&acc)[2][2][4][2], const Unit& u, int wr, int wc, int fr, int fq) const {
        const int row0 = u.pm * BM + wr * 64 + fr, col0 = u.pn * BM + wc * 32 + 8 * fq;
#pragma unroll
        for (int ai = 0; ai < 2; ++ai)
#pragma unroll
            for (int m = 0; m < 4; ++m) { bf16_t* rowp = O + (size_t)(row0 + ai * HALF + m * 16) * ld + col0;
#pragma unroll
                for (int bj = 0; bj < 2; ++bj) { const f32x4 v0 = acc[ai][bj][m][0], v1 = acc[ai][bj][m][1];
                    u32x4 w; w.x = pk2(v0[0], v0[1]); w.y = pk2(v0[2], v0[3]); w.z = pk2(v1[0], v1[1]); w.w = pk2(v1[2], v1[3]);
                    *(u32x4*)(rowp + bj * HALF) = w; } }
    }
};
struct EpiMerge {
    static constexpr bool PERM = true;
    bf16_t* Y; const bf16_t* GT;
    __device__ __forceinline__ void operator()(const f32x4 (&acc)[2][2][4][2], const Unit& u, int wr, int wc, int fr, int fq) const {
        const int row0 = u.pm * BM + wr * 64 + fr, col0 = u.pn * BM + wc * 32 + 8 * fq;
#pragma unroll
        for (int ai = 0; ai < 2; ++ai)
#pragma unroll
            for (int m = 0; m < 4; ++m) { const size_t r = (size_t)(row0 + ai * HALF + m * 16);
                bf16_t* rowp = Y + r * 2048 + col0; const bf16_t* gp = GT + r * 6144 + (size_t)u.br * 2048 + col0;
#pragma unroll
                for (int bj = 0; bj < 2; ++bj) { const f32x4 v0 = acc[ai][bj][m][0], v1 = acc[ai][bj][m][1];
                    const u32x4 g = *(const u32x4*)(gp + bj * HALF);
                    const float ab = ((ABL >> u.br) & 1) ? 0.f : 1.f;
                    float o[8];
                    o[0] = ab * sigmoidf_(bflo(g.x)) * v0[0]; o[1] = ab * sigmoidf_(bfhi(g.x)) * v0[1]; o[2] = ab * sigmoidf_(bflo(g.y)) * v0[2]; o[3] = ab * sigmoidf_(bfhi(g.y)) * v0[3];
                    o[4] = ab * sigmoidf_(bflo(g.z)) * v1[0]; o[5] = ab * sigmoidf_(bfhi(g.z)) * v1[1]; o[6] = ab * sigmoidf_(bflo(g.w)) * v1[2]; o[7] = ab * sigmoidf_(bfhi(g.w)) * v1[3];
                    if (u.br != 0) { const u32x4 y = *(const u32x4*)(rowp + bj * HALF);
                        o[0] += bflo(y.x); o[1] += bfhi(y.x); o[2] += bflo(y.y); o[3] += bfhi(y.y); o[4] += bflo(y.z); o[5] += bfhi(y.z); o[6] += bflo(y.w); o[7] += bfhi(y.w); }
                    u32x4 w; w.x = pk2(o[0], o[1]); w.y = pk2(o[2], o[3]); w.z = pk2(o[4], o[5]); w.w = pk2(o[6], o[7]);
                    *(u32x4*)(rowp + bj * HALF) = w; } }
    }
};
struct EpiRes {
    static constexpr bool PERM = false;
    float* X; const float* mod;
    __device__ __forceinline__ void operator()(const f32x4 (&acc)[2][2][4][2], const Unit& u, int wr, int wc, int fr, int fq) const {
        const int row0 = u.pm * BM + wr * 64 + fr, col0 = u.pn * BM + wc * 32 + 4 * fq;
        const int which = (u.pm < 32) ? 0 : (u.pm < 64 ? 1 : 2);
        const float* mg = mod + (size_t)which * 12288 + 2 * 2048 + col0;
        f32x4 gv[2][2];
#pragma unroll
        for (int bj = 0; bj < 2; ++bj)
#pragma unroll
            for (int n = 0; n < 2; ++n) gv[bj][n] = *(const f32x4*)(mg + bj * HALF + n * 16);
#pragma unroll
        for (int ai = 0; ai < 2; ++ai)
#pragma unroll
            for (int m = 0; m < 4; ++m) { float* rowp = X + (size_t)(row0 + ai * HALF + m * 16) * 2048 + col0;
#pragma unroll
                for (int bj = 0; bj < 2; ++bj)
#pragma unroll
                    for (int n = 0; n < 2; ++n) { f32x4* q = (f32x4*)(rowp + bj * HALF + n * 16); *q = *q + gv[bj][n] * acc[ai][bj][m][n]; } }
    }
};
}

__device__ __forceinline__ int proj_src_col(int n) {
    if (n < 1024) return 7200 + n;
    if (n < 2048) return n - 1024;
    if (n < 4096) return 1024 + (n - 2048);
    if (n < 6144) return 8224 + (n - 4096);
    if (n < 8192) return 16416 + (n - 6144);
    if (n < 10240) return 3104 + (n - 8192);
    if (n < 12288) return 5152 + (n - 10240);
    if (n < 14336) return 10272 + (n - 12288);
    if (n < 16384) return 12320 + (n - 14336);
    if (n < 18432) return 14368 + (n - 16384);
    return 18464 + (n - 18432);
}
__device__ __forceinline__ void phase_w(KP p, int l, LAS unsigned char* lds, int wid0) {
    const int tid = tid_fresh(wid0), G = gridDim.x, bid = blockIdx.x;
    unsigned char* ws = launder(p->ws);
    {
        LAS float* tile = (LAS float*)lds;
        const int NT_IN = NPROJ / 64;
        const int total = (NT_IN + 5 * 32) * 32;
        for (int t = bid; t < total; t += G) {
            const int ntile = t >> 5, kt = t & 31, k0 = kt * 64;
            const float* src; int ld; bf16_t* dst; float scale = 1.0f; int n0;
            bool to8 = false;
            if (ntile < NT_IN) { n0 = ntile * 64; src = p->w_in + (size_t)l * 2048 * PROJ_W + proj_src_col(n0); ld = PROJ_W;
                if (n0 >= 12288 && n0 < 18432) { dst = (bf16_t*)(ws + WS_WINB) + (size_t)(n0 - 12288) * 2048; }
                else { to8 = true; dst = (bf16_t*)(ws + WS_WIN); scale = (n0 < 1024) ? 1024.0f * 0.08838834764831845f : 1024.0f; } }
            else { const int mi = (ntile - NT_IN) >> 5; n0 = ((ntile - NT_IN) & 31) * 64;
                const float* m5 = mi == 0 ? p->w_a_out : mi == 1 ? p->w_b_out : mi == 2 ? p->w_c_out : mi == 3 ? p->w_out : p->peer_wq;
                src = m5 + (size_t)l * 2048 * 2048 + n0; ld = 2048;
                dst = (bf16_t*)(ws + WS_WA + (size_t)mi * SZ_W) + (size_t)n0 * 2048; }
            { const int kk = tid >> 4, n4 = (tid & 15) * 4;
#pragma unroll
              for (int h = 0; h < 2; ++h) { const f32x4 v = *(const f32x4*)(src + (size_t)(k0 + kk + 32 * h) * ld + n4);
                  LAS float* tp = tile + (kk + 32 * h) * 65 + n4; tp[0] = v[0]; tp[1] = v[1]; tp[2] = v[2]; tp[3] = v[3]; } }
            __syncthreads();
            { const int n = tid >> 3, k8 = (tid & 7) * 8; float v[8];
#pragma unroll
              for (int j = 0; j < 8; ++j) v[j] = tile[(k8 + j) * 65 + n] * scale;
              if (to8) {
#pragma unroll
                  for (int j = 0; j < 8; ++j) v[j] = fminf(fmaxf(v[j], -448.f), 448.f);
                  int d0 = 0, d1 = 0; d0 = __builtin_amdgcn_cvt_pk_fp8_f32(v[0], v[1], d0, false); d0 = __builtin_amdgcn_cvt_pk_fp8_f32(v[2], v[3], d0, true);
                  d1 = __builtin_amdgcn_cvt_pk_fp8_f32(v[4], v[5], d1, false); d1 = __builtin_amdgcn_cvt_pk_fp8_f32(v[6], v[7], d1, true);
                  u32x2 w8; w8.x = (unsigned)d0; w8.y = (unsigned)d1; *(u32x2*)((unsigned char*)dst + (size_t)(n0 + n) * 2048 + k0 + k8) = w8; }
              else { u32x4 w; w.x = pk2(v[0], v[1]); w.y = pk2(v[2], v[3]); w.z = pk2(v[4], v[5]); w.w = pk2(v[6], v[7]);
                  *(u32x4*)(dst + (size_t)n * 2048 + k0 + k8) = w; } }
            __syncthreads();
        }
    }
    const size_t gtid = (size_t)bid * NTHREADS + tid, gthreads = (size_t)G * NTHREADS;
    for (size_t i = gtid; i < 32 * 2048; i += gthreads) { const int n = (int)(i >> 11), k = (int)(i & 2047);
        ((bf16_t*)(ws + WS_WG))[i] = f2bf(p->w_in[(size_t)l * 2048 * PROJ_W + (size_t)k * PROJ_W + 3072 + n]); }
    {
        const float* su = p->peer_u + (size_t)l * 16384 * 2048; const float* sv = p->peer_v + (size_t)l * 16384 * 2048;
        unsigned char* du = ws + WS_PU; unsigned char* dv = ws + WS_PVW;
        const size_t n32 = (size_t)16384 * 2048 / 32;
        for (size_t i = gtid; i < n32; i += gthreads) {
#pragma unroll
            for (int t = 0; t < 2; ++t) {
                const float* sp = (t ? sv : su) + i * 32; const float sc = t ? 4.0f : 64.0f;
                float e[32];
#pragma unroll
                for (int q = 0; q < 8; ++q) { const f32x4 a = *(const f32x4*)(sp + q * 4); e[q * 4] = a[0] * sc; e[q * 4 + 1] = a[1] * sc; e[q * 4 + 2] = a[2] * sc; e[q * 4 + 3] = a[3] * sc; }
                f32x16 va, vb;
#pragma unroll
                for (int j = 0; j < 16; ++j) { va[j] = FP6_INTERLEAVED ? e[2 * j] : e[j]; vb[j] = FP6_INTERLEAVED ? e[2 * j + 1] : e[16 + j]; }
                const u32x6 wv = __builtin_amdgcn_cvt_scalef32_2xpk16_fp6_f32(va, vb, 1.0f);
                unsigned* dp = (unsigned*)((t ? dv : du) + i * 24);
                u32x2 w0, w1, w2; w0.x = wv[0]; w0.y = wv[1]; w1.x = wv[2]; w1.y = wv[3]; w2.x = wv[4]; w2.y = wv[5];
                *(u32x2*)dp = w0; *(u32x2*)(dp + 2) = w1; *(u32x2*)(dp + 4) = w2;
            }
        }
        const float* sk = p->peer_keys + (size_t)l * 16 * 128 * 128; bf16_t* dk = (bf16_t*)(ws + WS_KEYS);
        for (size_t i = gtid; i < (size_t)16 * 128 * 128; i += gthreads) dk[i] = f2bf(sk[i]);
    }
    {
        float* mod = (float*)(ws + WS_MOD) + (size_t)l * 3 * 12288;
        const float* wa = p->w_ada + (size_t)l * 2048 * 12288; const float* ba = p->b_ada + (size_t)l * 12288;
        LAS float* part = (LAS float*)(lds + 32768);
        const int col = tid & 63, ks = tid >> 6;
        for (int t = bid; t < 256; t += G) {
            const int n = t * 48 + col;
            float a0 = 0.f, a1 = 0.f, a2 = 0.f;
            if (col < 48) {
                for (int k = ks * 256; k < ks * 256 + 256; ++k) {
                    const float w = wa[(size_t)k * 12288 + n];
                    const float c0 = p->c[k], c1 = p->c[2048 + k], c2 = p->c_ctx[k];
                    a0 += c0 * sigmoidf_(c0) * w; a1 += c1 * sigmoidf_(c1) * w; a2 += c2 * sigmoidf_(c2) * w;
                }
                part[(ks * 3 + 0) * 48 + col] = a0; part[(ks * 3 + 1) * 48 + col] = a1; part[(ks * 3 + 2) * 48 + col] = a2;
            }
            __syncthreads();
            if (tid < 144) { const int which = tid / 48, cc = tid - which * 48; float sacc = ba[t * 48 + cc];
#pragma unroll
                for (int q = 0; q < 8; ++q) sacc += part[(q * 3 + which) * 48 + cc];
                mod[(size_t)which * 12288 + t * 48 + cc] = sacc; }
            __syncthreads();
        }
    }
    if (l == 0) {
        float* X = (float*)(ws + WS_X);
        const size_t nl4 = (size_t)NLAT * 2048 / 4, nc4 = (size_t)NCTX * 2048 / 4;
        for (size_t i = gtid; i < nl4; i += gthreads) ((f32x4*)X)[i] = ((const f32x4*)p->x)[i];
        for (size_t i = gtid; i < nc4; i += gthreads) ((f32x4*)X)[nl4 + i] = ((const f32x4*)p->ctx)[i];
        float* tab = (float*)(ws + WS_TAB);
        for (size_t i = gtid; i < 4096; i += gthreads) { const int pos = (int)(i >> 5), j = (int)(i & 31);
            const float inv = powf(10000.0f, -(float)j / 32.0f); const float ang = (float)pos * inv;
            tab[i] = cosf(ang); tab[4096 + i] = sinf(ang); }
    }
}

__device__ __forceinline__ void phase_norm(KP p, int l, int which_norm, int nrows, int wid0) {
    const int tid = tid_fresh(wid0); const int lane = tid & 63, gw = blockIdx.x * 8 + (tid >> 6), nw = gridDim.x * 8;
    unsigned char* ws = launder(p->ws);
    const float* X = (const float*)(ws + WS_X); bf16_t* XN = (bf16_t*)(ws + WS_XN);
    const float* mod = (const float*)(ws + WS_MOD) + (size_t)l * 3 * 12288;
    const float* g = p->norm_g + (size_t)(l * 2 + which_norm) * 2048;
    const int shift_c = which_norm ? 3 : 0, scale_c = which_norm ? 4 : 1;
    for (int row = gw; row < nrows; row += nw) {
        const int which = row < NLAT ? (row >> 13) : 2;
        const float* xr = X + (size_t)row * 2048; const float* mb = mod + (size_t)which * 12288;
        f32x4 v[8]; float ss = 0.f;
#pragma unroll
        for (int i = 0; i < 8; ++i) { v[i] = *(const f32x4*)(xr + i * 256 + lane * 4); ss += v[i][0] * v[i][0] + v[i][1] * v[i][1] + v[i][2] * v[i][2] + v[i][3] * v[i][3]; }
        ss = wave_sum(ss);
        const float rstd = rsqrtf(ss * (1.0f / 2048.0f) + EPSF);
#pragma unroll
        for (int i = 0; i < 8; ++i) { const int c = i * 256 + lane * 4;
            const f32x4 gg = *(const f32x4*)(g + c), sh = *(const f32x4*)(mb + shift_c * 2048 + c), sc = *(const f32x4*)(mb + scale_c * 2048 + c);
            float o[4];
#pragma unroll
            for (int j = 0; j < 4; ++j) o[j] = v[i][j] * rstd * gg[j] * (1.0f + sc[j]) + sh[j];
            u32x2 w; w.x = pk2(o[0], o[1]); w.y = pk2(o[2], o[3]); *(u32x2*)(XN + (size_t)row * 2048 + c) = w;
            if (which_norm == 0) { int d = 0; d = __builtin_amdgcn_cvt_pk_fp8_f32(fminf(fmaxf(o[0], -448.f), 448.f), fminf(fmaxf(o[1], -448.f), 448.f), d, false);
                d = __builtin_amdgcn_cvt_pk_fp8_f32(fminf(fmaxf(o[2], -448.f), 448.f), fminf(fmaxf(o[3], -448.f), 448.f), d, true); *(unsigned*)(ws + WS_XN8 + (size_t)row * 2048 + c) = (unsigned)d; } }
    }
}

__device__ __forceinline__ void phase_gates_gemm(KP p, int l, int wid0) {
    const int tid = tid_fresh(wid0); const int lane = tid & 63, gw = blockIdx.x * 8 + (tid >> 6), nw = gridDim.x * 8;
    unsigned char* ws = launder(p->ws);
    const bf16_t* XN = (const bf16_t*)(ws + WS_XN); const bf16_t* WG = (const bf16_t*)(ws + WS_WG); float* GA = (float*)(ws + WS_GATES);
    const int q4 = lane >> 4, c = lane & 15;
    const float gb0 = p->a_gate_b[l * 32 + c], gb1 = p->a_gate_b[l * 32 + 16 + c];
    for (int task = gw; task < MR / 16; task += nw) {
        const int r0 = task * 16;
        f32x4 acc0 = {0.f, 0.f, 0.f, 0.f}, acc1 = {0.f, 0.f, 0.f, 0.f};
        const bf16_t* ap = XN + (size_t)(r0 + c) * 2048 + 8 * q4; const bf16_t* b0 = WG + (size_t)c * 2048 + 8 * q4; const bf16_t* b1 = b0 + 16 * 2048;
#pragma unroll 4
        for (int ks = 0; ks < 64; ++ks) { const bf16x8 a = *(const bf16x8*)(ap + ks * 32), x0 = *(const bf16x8*)(b0 + ks * 32), x1 = *(const bf16x8*)(b1 + ks * 32);
            acc0 = mfma16(a, x0, acc0); acc1 = mfma16(a, x1, acc1); }
#pragma unroll
        for (int r = 0; r < 4; ++r) {
            const float v0 = acc0[r] + gb0, v1 = acc1[r] + gb1;
            GA[(size_t)(r0 + 4 * q4 + r) * 32 + c] = (c >= 8) ? logsigmoidf_(v0) : v0; GA[(size_t)(r0 + 4 * q4 + r) * 32 + 16 + c] = (c >= 8) ? logsigmoidf_(v1) : v1; }
    }
}

__device__ __forceinline__ void phase_e1(KP p, int l, int wid0) {
    const int tid = tid_fresh(wid0); const int lane = tid & 63, gw = blockIdx.x * 8 + (tid >> 6), nw = gridDim.x * 8;
    unsigned char* ws = launder(p->ws);
    bf16_t* PQ = (bf16_t*)(ws + WS_PQ); bf16_t* PK = (bf16_t*)(ws + WS_PK); bf16_t* CQ = (bf16_t*)(ws + WS_CQ); bf16_t* CK = (bf16_t*)(ws + WS_CK);
    bf16_t* BB = (bf16_t*)(ws + WS_BB); const bf16_t* BC = (const bf16_t*)(ws + WS_BC); const bf16_t* BX = (const bf16_t*)(ws + WS_BX);
    float* GA = (float*)(ws + WS_GATES); const float* tab = (const float*)(ws + WS_TAB);
    const float* gq = p->c_qk_g + (size_t)(l * 2 + 0) * 128; const float* gk = p->c_qk_g + (size_t)(l * 2 + 1) * 128;
    const float* cw = p->b_conv + (size_t)l * 3 * 2048;
    float gqv[8], gkv[8];
#pragma unroll
    for (int j = 0; j < 8; ++j) { gqv[j] = gq[(lane & 15) * 8 + j] * 0.08838834764831845f; gkv[j] = gk[(lane & 15) * 8 + j]; }
    for (int row = gw; row < MR; row += nw) {
        if (row < NLAT) {
            const int s = row & 8191, gr = s >> 6, gc = s & 63;
#pragma unroll
            for (int it = 0; it < 2; ++it) {
                const int unit = it * 64 + lane, h = unit >> 4, hf = (unit >> 3) & 1, j4 = unit & 7;
                const int off = h * 128 + hf * 64 + j4 * 4, pos = hf ? gc : gr;
                const f32x4 cs = *(const f32x4*)(tab + pos * 32 + j4 * 4), sn = *(const f32x4*)(tab + 4096 + pos * 32 + j4 * 4);
#pragma unroll
                for (int tsel = 0; tsel < 2; ++tsel) { bf16_t* T = (tsel ? PK : PQ) + (size_t)row * 1024 + off;
                    const u32x2 u1 = *(const u32x2*)T, u2 = *(const u32x2*)(T + 32);
                    const float a0 = bflo(u1.x), a1 = bfhi(u1.x), a2 = bflo(u1.y), a3 = bfhi(u1.y), b0 = bflo(u2.x), b1 = bfhi(u2.x), b2 = bflo(u2.y), b3 = bfhi(u2.y);
                    u32x2 o1, o2;
                    o1.x = pk2(a0 * cs[0] - b0 * sn[0], a1 * cs[1] - b1 * sn[1]); o1.y = pk2(a2 * cs[2] - b2 * sn[2], a3 * cs[3] - b3 * sn[3]);
                    o2.x = pk2(b0 * cs[0] + a0 * sn[0], b1 * cs[1] + a1 * sn[1]); o2.y = pk2(b2 * cs[2] + a2 * sn[2], b3 * cs[3] + a3 * sn[3]);
                    *(u32x2*)T = o1; *(u32x2*)(T + 32) = o2; }
            }
        }
#pragma unroll
        for (int tsel = 0; tsel < 2; ++tsel) {
            bf16_t* T = (tsel ? CK : CQ) + (size_t)row * 2048;
#pragma unroll
            for (int ps = 0; ps < 4; ++ps) {
                const u32x4 w = *(const u32x4*)(T + ps * 512 + lane * 8);
                float v[8] = {bflo(w.x), bfhi(w.x), bflo(w.y), bfhi(w.y), bflo(w.z), bfhi(w.z), bflo(w.w), bfhi(w.w)};
                float ss = 0.f;
#pragma unroll
                for (int j = 0; j < 8; ++j) ss += v[j] * v[j];
                ss += __shfl_xor(ss, 1); ss += __shfl_xor(ss, 2); ss += __shfl_xor(ss, 4); ss += __shfl_xor(ss, 8);
                const float rstd = rsqrtf(ss * (1.0f / 128.0f) + EPSF);
#pragma unroll
                for (int j = 0; j < 8; ++j) v[j] = v[j] * rstd * (tsel ? gkv[j] : gqv[j]);
                u32x4 o; o.x = pk2(v[0], v[1]); o.y = pk2(v[2], v[3]); o.z = pk2(v[4], v[5]); o.w = pk2(v[6], v[7]);
                *(u32x4*)(T + ps * 512 + lane * 8) = o;
            }
        }
        {
            int pos, len; if (row < NLAT) { pos = row & 8191; len = SEQ; } else { pos = (row - NLAT) & 255; len = CTXL; }
            const bool hp = pos > 0, hn = pos < len - 1;
#pragma unroll
            for (int ps = 0; ps < 4; ++ps) {
                const int c = ps * 512 + lane * 8; const size_t o = (size_t)row * 2048 + c;
                const u32x4 bb = *(const u32x4*)(BB + o), c1 = *(const u32x4*)(BC + o), x1 = *(const u32x4*)(BX + o);
                u32x4 c0 = {0u, 0u, 0u, 0u}, x0 = c0, c2 = c0, x2 = c0;
                if (hp) { c0 = *(const u32x4*)(BC + o - 2048); x0 = *(const u32x4*)(BX + o - 2048); }
                if (hn) { c2 = *(const u32x4*)(BC + o + 2048); x2 = *(const u32x4*)(BX + o + 2048); }
                const unsigned bw[4] = {bb.x, bb.y, bb.z, bb.w}, c0w[4] = {c0.x, c0.y, c0.z, c0.w}, c1w[4] = {c1.x, c1.y, c1.z, c1.w}, c2w[4] = {c2.x, c2.y, c2.z, c2.w};
                const unsigned x0w[4] = {x0.x, x0.y, x0.z, x0.w}, x1w[4] = {x1.x, x1.y, x1.z, x1.w}, x2w[4] = {x2.x, x2.y, x2.z, x2.w};
                unsigned ow[4];
#pragma unroll
                for (int q = 0; q < 4; ++q) {
                    const int cc = c + 2 * q;
                    const float w00 = cw[cc], w01 = cw[cc + 1], w10 = cw[2048 + cc], w11 = cw[2048 + cc + 1], w20 = cw[4096 + cc], w21 = cw[4096 + cc + 1];
                    const float ylo = bflo(bw[q]) * (bflo(c0w[q]) * bflo(x0w[q]) * w00 + bflo(c1w[q]) * bflo(x1w[q]) * w10 + bflo(c2w[q]) * bflo(x2w[q]) * w20);
                    const float yhi = bfhi(bw[q]) * (bfhi(c0w[q]) * bfhi(x0w[q]) * w01 + bfhi(c1w[q]) * bfhi(x1w[q]) * w11 + bfhi(c2w[q]) * bfhi(x2w[q]) * w21);
                    ow[q] = pk2(ylo, yhi);
                }
                u32x4 ov; ov.x = ow[0]; ov.y = ow[1]; ov.z = ow[2]; ov.w = ow[3];
                *(u32x4*)(BB + o) = ov;
            }
        }
    }
}

constexpr int ML_QS = 0, ML_KS = 17408, ML_KET = 34816, ML_VT = 53248, ML_SS = 60160, ML_CT = 69376, ML_CTSZ = 13056;
__device__ __forceinline__ int ml_row(int pp, int b, int dir) {
    if (pp < 256) { const int j = dir ? 255 - pp : pp; return NLAT + b * 256 + j; }
    int s = pp - 256; if (dir) s = 8191 - s; return b * 8192 + s;
}
__device__ __forceinline__ void phase_mlstm(KP p, int l, LAS unsigned char* lds, int wid0) {
    const int tid = tid_fresh(wid0), lane = tid & 63, w = __builtin_amdgcn_readfirstlane(tid >> 6), q4 = lane >> 4, c16 = lane & 15;
    unsigned char* ws = launder(p->ws);
    const bf16_t* PQ = (const bf16_t*)(ws + WS_PQ); const bf16_t* PK = (const bf16_t*)(ws + WS_PK); const bf16_t* PV = (const bf16_t*)(ws + WS_PV);
    const float* GA = (const float*)(ws + WS_GATES);
    for (int task = blockIdx.x; task < 256; task += gridDim.x) {
        const int xq = task & 7, yq = task >> 3; const int bh = 2 * xq + (yq >> 4), dir = (yq >> 3) & 1, sl = yq & 7; const int b = bh >> 3, h = bh & 7;
        bf16_t* H = (bf16_t*)(ws + (dir ? WS_BX : WS_BC));
        float* SCN = (float*)(ws + WS_SCAN) + (size_t)task * 3 * 8448;
        __syncthreads();
        for (int cc = w; cc < 132; cc += 8) {
            const int r = ml_row(cc * 64 + lane, b, dir);
            const float li = GA[(size_t)r * 32 + (2 * dir) * 8 + h], lf = GA[(size_t)r * 32 + (2 * dir + 1) * 8 + h];
            float bc = lf;
#pragma unroll
            for (int o = 1; o < 64; o <<= 1) { const float t = __shfl_up(bc, o); if (lane >= o) bc += t; }
            const float a = li - bc;
            float pm = a;
#pragma unroll
            for (int o = 1; o < 64; o <<= 1) { const float t = __shfl_up(pm, o); if (lane >= o) pm = fmaxf(pm, t); }
            SCN[cc * 64 + lane] = bc; SCN[8448 + cc * 64 + lane] = a; SCN[2 * 8448 + cc * 64 + lane] = pm;
        }
        for (int i = tid; i < 16 * 32; i += NTHREADS) { const int r = 32 + (i >> 5), cdw = i & 31; *(LAS unsigned*)(lds + ML_VT + r * 144 + cdw * 4) = (r == 32) ? 0x3f803f80u : 0u; }
        for (int i = tid; i < 2 * ML_CTSZ / 4; i += NTHREADS) *(LAS unsigned*)(lds + ML_CT + i * 4) = 0u;
        __syncthreads();
        float m = 0.f;
        f32x4 Cst[3];
#pragma unroll
        for (int i = 0; i < 3; ++i) Cst[i] = (f32x4){0.f, 0.f, 0.f, 0.f};
        u32x4 qreg[2], kreg[2], vreg; float bc, a, pm;
        { const int r = ml_row(lane, b, dir);
#pragma unroll
          for (int i = 0; i < 2; ++i) { qreg[i] = *(const u32x4*)(PQ + (size_t)r * 1024 + h * 128 + (w * 2 + i) * 8); kreg[i] = *(const u32x4*)(PK + (size_t)r * 1024 + h * 128 + (w * 2 + i) * 8); }
          if (w < 4) vreg = *(const u32x4*)(PV + (size_t)r * 2048 + h * 256 + sl * 32 + w * 8);
          bc = SCN[lane]; a = SCN[8448 + lane]; pm = SCN[2 * 8448 + lane]; }
        for (int c = 0; c < 132; ++c) {
            const float total = __uint_as_float((unsigned)__builtin_amdgcn_readlane((int)__float_as_uint(bc), 63)), pmall = __uint_as_float((unsigned)__builtin_amdgcn_readlane((int)__float_as_uint(pm), 63));
            const float mx = fmaxf(m, pm);
            const float mrow = bc + mx;
            const float winter = __expf(m - mx);
            const float m_new = total + fmaxf(m, pmall);
            const float decay = __expf(total + m - m_new);
            const float kscale = __expf(total + a - m_new);
            const float a_cur = a;
#pragma unroll
            for (int i = 0; i < 2; ++i) {
                *(LAS u32x4*)(lds + ML_QS + lane * 272 + (w * 2 + i) * 16) = qreg[i];
                *(LAS u32x4*)(lds + ML_KS + lane * 272 + (w * 2 + i) * 16) = kreg[i];
                const unsigned kw[4] = {kreg[i].x, kreg[i].y, kreg[i].z, kreg[i].w};
#pragma unroll
                for (int j = 0; j < 4; ++j) { const int d = (w * 2 + i) * 8 + 2 * j;
                    *(LAS bf16_t*)(lds + ML_KET + d * 144 + lane * 2) = f2bf(bflo(kw[j]) * kscale);
                    *(LAS bf16_t*)(lds + ML_KET + (d + 1) * 144 + lane * 2) = f2bf(bfhi(kw[j]) * kscale); }
            }
            if (w < 4) { const unsigned vw[4] = {vreg.x, vreg.y, vreg.z, vreg.w};
#pragma unroll
                for (int j = 0; j < 4; ++j) { const int e = w * 8 + 2 * j;
                    *(LAS bf16_t*)(lds + ML_VT + e * 144 + lane * 2) = (bf16_t)(vw[j] & 0xffffu);
                    *(LAS bf16_t*)(lds + ML_VT + (e + 1) * 144 + lane * 2) = (bf16_t)(vw[j] >> 16); } }
            if (c + 1 < 132) { const int pp = (c + 1) * 64 + lane; const int r = ml_row(pp, b, dir);
#pragma unroll
                for (int i = 0; i < 2; ++i) { qreg[i] = *(const u32x4*)(PQ + (size_t)r * 1024 + h * 128 + (w * 2 + i) * 8); kreg[i] = *(const u32x4*)(PK + (size_t)r * 1024 + h * 128 + (w * 2 + i) * 8); }
                if (w < 4) vreg = *(const u32x4*)(PV + (size_t)r * 2048 + h * 256 + sl * 32 + w * 8);
                bc = SCN[pp]; a = SCN[8448 + pp]; pm = SCN[2 * 8448 + pp]; }
            LDS_BARRIER();
            const int tr = w >> 1;
            bf16x8 aq[4];
#pragma unroll
            for (int ks = 0; ks < 4; ++ks) aq[ks] = *(const LAS bf16x8*)(lds + ML_QS + (16 * tr + c16) * 272 + (ks * 32 + 8 * q4) * 2);
            float nmx_t[4], wi_t[4], mrow_t[4];
#pragma unroll
            for (int r = 0; r < 4; ++r) { const int t = 16 * tr + 4 * q4 + r; nmx_t[r] = -__shfl(mx, t); wi_t[r] = __shfl(winter, t); mrow_t[r] = __shfl(mrow, t); }
#pragma unroll
            for (int tci = 0; tci < 2; ++tci) {
                const int tc = 2 * (w & 1) + tci;
                const int scol = 16 * tc + c16;
                if (tc <= tr) {
                    f32x4 acc = {0.f, 0.f, 0.f, 0.f};
#pragma unroll
                    for (int ks = 0; ks < 4; ++ks) { const bf16x8 bk = *(const LAS bf16x8*)(lds + ML_KS + (16 * tc + c16) * 272 + (ks * 32 + 8 * q4) * 2); acc = mfma16(aq[ks], bk, acc); }
                    const float a_s = __shfl(a_cur, scol);
#pragma unroll
                    for (int r = 0; r < 4; ++r) { const int t = 16 * tr + 4 * q4 + r;
                        const float dv = (scol <= t) ? __expf(a_s + nmx_t[r]) : 0.f;
                        *(LAS bf16_t*)(lds + ML_SS + t * 144 + scol * 2) = f2bf(acc[r] * dv); }
                } else {
#pragma unroll
                    for (int r = 0; r < 4; ++r) *(LAS bf16_t*)(lds + ML_SS + (16 * tr + 4 * q4 + r) * 144 + scol * 2) = (bf16_t)0;
                }
            }
            LDS_BARRIER();
            {
                const LAS unsigned char* CTc = lds + ML_CT + (c & 1) * ML_CTSZ;
                const int part = w & 1;
                bf16x8 as2[2];
#pragma unroll
                for (int k2 = 0; k2 < 2; ++k2) as2[k2] = *(const LAS bf16x8*)(lds + ML_SS + (16 * tr + c16) * 144 + (k2 * 32 + 8 * q4) * 2);
                f32x4 accA = {0.f, 0.f, 0.f, 0.f}, accD = {0.f, 0.f, 0.f, 0.f};
#pragma unroll
                for (int ks = 0; ks < 4; ++ks) {
                    const bf16x8 b1 = *(const LAS bf16x8*)(CTc + (16 * part + c16) * 272 + (ks * 32 + 8 * q4) * 2);
                    const bf16x8 b2 = *(const LAS bf16x8*)(CTc + (32 + c16) * 272 + (ks * 32 + 8 * q4) * 2);
                    accA = mfma16(aq[ks], b1, accA); accD = mfma16(aq[ks], b2, accD); }
#pragma unroll
                for (int r = 0; r < 4; ++r) { accA[r] *= wi_t[r]; accD[r] *= wi_t[r]; }
#pragma unroll
                for (int k2 = 0; k2 < 2; ++k2) {
                    const bf16x8 v1 = *(const LAS bf16x8*)(lds + ML_VT + (16 * part + c16) * 144 + (k2 * 32 + 8 * q4) * 2);
                    const bf16x8 v2 = *(const LAS bf16x8*)(lds + ML_VT + (32 + c16) * 144 + (k2 * 32 + 8 * q4) * 2);
                    accA = mfma16(as2[k2], v1, accA); accD = mfma16(as2[k2], v2, accD); }
                if (l == 0 || c >= 4) {
#pragma unroll
                    for (int r = 0; r < 4; ++r) {
                        const float den = __shfl(accD[r], lane & 48);
                        const float hv = accA[r] / fmaxf(fabsf(den), __expf(-mrow_t[r]));
                        const int t = 16 * tr + 4 * q4 + r; const int row = ml_row(c * 64 + t, b, dir);
                        H[(size_t)row * 2048 + h * 256 + sl * 32 + 16 * part + c16] = f2bf(hv);
                    }
                }
            }
            {
                LAS unsigned char* CTn = lds + ML_CT + ((c + 1) & 1) * ML_CTSZ;
                bf16x8 ak[2];
#pragma unroll
                for (int k2 = 0; k2 < 2; ++k2) ak[k2] = *(const LAS bf16x8*)(lds + ML_KET + (16 * w + c16) * 144 + (k2 * 32 + 8 * q4) * 2);
#pragma unroll
                for (int ct = 0; ct < 3; ++ct) {
                    Cst[ct] = Cst[ct] * decay;
#pragma unroll
                    for (int k2 = 0; k2 < 2; ++k2) { const bf16x8 bv = *(const LAS bf16x8*)(lds + ML_VT + (16 * ct + c16) * 144 + (k2 * 32 + 8 * q4) * 2); Cst[ct] = mfma16(ak[k2], bv, Cst[ct]); }
                    u32x2 o; o.x = pk2(Cst[ct][0], Cst[ct][1]); o.y = pk2(Cst[ct][2], Cst[ct][3]);
                    *(LAS u32x2*)(CTn + (16 * ct + c16) * 272 + (16 * w + 4 * q4) * 2) = o;
                }
            }
            m = m_new;
            LDS_BARRIER();
        }
    }
}

constexpr int AT_KS = 0, AT_VT = 17408, AT_RPB = 35840;
__device__ __forceinline__ void phase_attn(KP p, int l, LAS unsigned char* lds, int wid0) {
    const int tid = tid_fresh(wid0), lane = tid & 63, w = __builtin_amdgcn_readfirstlane(tid >> 6), q4 = lane >> 4, c16 = lane & 15;
    unsigned char* ws = launder(p->ws);
    bf16_t* CQ = (bf16_t*)(ws + WS_CQ); const bf16_t* CK = (const bf16_t*)(ws + WS_CK); const bf16_t* CV = (const bf16_t*)(ws + WS_CV);
    const int nunits = 2048 + (l == 0 ? 64 : 0);
    for (int u = blockIdx.x; u < nunits; u += gridDim.x) {
        int b, h, qrow = 0, g = 0, ntl = 0, r0a = 0, qbase;  bool is_ctx = u >= 2048;
        if (!is_ctx) { b = u >> 10; h = (u >> 6) & 15; const int rp = u & 63; qrow = 2 * rp + (w >> 2); g = w & 3;
            r0a = min(max(2 * rp - 4, 0), 120); const int r0b = min(max(2 * rp + 1 - 4, 0), 120); ntl = r0b + 8 - r0a;
            qbase = b * 8192 + qrow * 64 + 16 * g; }
        else { const int uu = u - 2048; b = uu >> 5; h = (uu >> 1) & 15; qbase = NLAT + b * 256 + (uu & 1) * 128 + 16 * w; }
        const int r0q = min(max(qrow - 4, 0), 120);
        const int a_g = (g == 0) ? 0 : (g == 1 ? 8 : (g == 2 ? 24 : 32));
        __syncthreads();
        if (!is_ctx) for (int i = tid; i < 465; i += NTHREADS) *(LAS float*)(lds + AT_RPB + i * 4) = p->c_rpb[((size_t)l * 16 + h) * 465 + i];
        bf16x8 qf[4];
#pragma unroll
        for (int ks = 0; ks < 4; ++ks) qf[ks] = *(const bf16x8*)(CQ + (size_t)(qbase + c16) * 2048 + h * 128 + ks * 32 + 8 * q4);
        f32x4 O[8];
#pragma unroll
        for (int i = 0; i < 8; ++i) O[i] = (f32x4){0.f, 0.f, 0.f, 0.f};
        float m_run = -1e30f, l_run = 0.f;
        const int ntiles = ntl + 4;
        u32x4 kreg[2], vreg[2];
        auto tile_row = [&](int t, int key) -> int { return (t < ntl) ? (b * 8192 + (r0a + t) * 64 + key) : (NLAT + b * 256 + (t - ntl) * 64 + key); };
        { const int r = tile_row(0, lane);
#pragma unroll
          for (int i = 0; i < 2; ++i) { kreg[i] = *(const u32x4*)(CK + (size_t)r * 2048 + h * 128 + (w * 2 + i) * 8); vreg[i] = *(const u32x4*)(CV + (size_t)r * 2048 + h * 128 + (w * 2 + i) * 8); } }
        for (int t = 0; t < ntiles; ++t) {
            LDS_BARRIER();
#pragma unroll
            for (int i = 0; i < 2; ++i) {
                *(LAS u32x4*)(lds + AT_KS + lane * 272 + (w * 2 + i) * 16) = kreg[i];
                const unsigned vw[4] = {vreg[i].x, vreg[i].y, vreg[i].z, vreg[i].w};
#pragma unroll
                for (int j = 0; j < 4; ++j) { const int d = (w * 2 + i) * 8 + 2 * j;
                    *(LAS bf16_t*)(lds + AT_VT + d * 144 + lane * 2) = (bf16_t)(vw[j] & 0xffffu);
                    *(LAS bf16_t*)(lds + AT_VT + (d + 1) * 144 + lane * 2) = (bf16_t)(vw[j] >> 16); }
            }
            if (t + 1 < ntiles) { const int r = tile_row(t + 1, lane);
#pragma unroll
                for (int i = 0; i < 2; ++i) { kreg[i] = *(const u32x4*)(CK + (size_t)r * 2048 + h * 128 + (w * 2 + i) * 8); vreg[i] = *(const u32x4*)(CV + (size_t)r * 2048 + h * 128 + (w * 2 + i) * 8); } }
            LDS_BARRIER();
            const bool local = t < ntl; const int kr = r0a + t;
            if (local && !(kr >= r0q && kr < r0q + 8)) continue;
            const int npass = local ? 1 : 2;
            for (int ps = 0; ps < npass; ++ps) {
                const int a0 = local ? a_g : ps * 32;
                f32x4 sc[2];
#pragma unroll
                for (int ct = 0; ct < 2; ++ct) { sc[ct] = (f32x4){0.f, 0.f, 0.f, 0.f};
#pragma unroll
                    for (int ks = 0; ks < 4; ++ks) { const bf16x8 ka = *(const LAS bf16x8*)(lds + AT_KS + (a0 + 16 * ct + c16) * 272 + (ks * 32 + 8 * q4) * 2); sc[ct] = mfma16(ka, qf[ks], sc[ct]); } }
                if (local) {
                    const int qc = 16 * g + c16, col0 = min(max(qc - 8, 0), 48); const int dr = kr - qrow + 7;
#pragma unroll
                    for (int ct = 0; ct < 2; ++ct)
#pragma unroll
                        for (int r = 0; r < 4; ++r) { const int kc = a0 + 16 * ct + 4 * q4 + r; const bool valid = (kc >= col0) && (kc < col0 + 16);
                            const int dc = min(max(kc - qc + 15, 0), 30);
                            const float bias = *(const LAS float*)(lds + AT_RPB + (dr * 31 + dc) * 4);
                            sc[ct][r] = valid ? sc[ct][r] + bias : -1e30f; }
                }
                float mx = fmaxf(fmaxf(fmaxf(sc[0][0], sc[0][1]), fmaxf(sc[0][2], sc[0][3])), fmaxf(fmaxf(sc[1][0], sc[1][1]), fmaxf(sc[1][2], sc[1][3])));
                mx = fmaxf(mx, __shfl_xor(mx, 16)); mx = fmaxf(mx, __shfl_xor(mx, 32));
                const float m_new = fmaxf(m_run, mx);
                const float alpha = __expf(m_run - m_new);
                float pe[8]; float psum = 0.f;
#pragma unroll
                for (int ct = 0; ct < 2; ++ct)
#pragma unroll
                    for (int r = 0; r < 4; ++r) { const float e = __expf(sc[ct][r] - m_new); pe[ct * 4 + r] = e; psum += e; }
                psum += __shfl_xor(psum, 16); psum += __shfl_xor(psum, 32);
                l_run = l_run * alpha + psum; m_run = m_new;
                bf16x8 pf; { u32x4 pw; pw.x = pk2(pe[0], pe[1]); pw.y = pk2(pe[2], pe[3]); pw.z = pk2(pe[4], pe[5]); pw.w = pk2(pe[6], pe[7]); pf = __builtin_bit_cast(bf16x8, pw); }
                float al[4];
#pragma unroll
                for (int r = 0; r < 4; ++r) al[r] = __shfl(alpha, 4 * q4 + r);
#pragma unroll
                for (int dt = 0; dt < 8; ++dt) {
#pragma unroll
                    for (int r = 0; r < 4; ++r) O[dt][r] *= al[r];
                    const u32x2 lo = *(const LAS u32x2*)(lds + AT_VT + (16 * dt + c16) * 144 + (a0 + 4 * q4) * 2);
                    const u32x2 hi = *(const LAS u32x2*)(lds + AT_VT + (16 * dt + c16) * 144 + (a0 + 16 + 4 * q4) * 2);
                    u32x4 bw; bw.x = lo.x; bw.y = lo.y; bw.z = hi.x; bw.w = hi.y;
                    O[dt] = mfma16(pf, __builtin_bit_cast(bf16x8, bw), O[dt]);
                }
            }
        }
        float linv[4];
#pragma unroll
        for (int r = 0; r < 4; ++r) linv[r] = 1.0f / __shfl(l_run, 4 * q4 + r);
#pragma unroll
        for (int dt = 0; dt < 8; ++dt)
#pragma unroll
            for (int r = 0; r < 4; ++r) CQ[(size_t)(qbase + 4 * q4 + r) * 2048 + h * 128 + 16 * dt + c16] = f2bf(O[dt][r] * linv[r]);
    }
}

__device__ __forceinline__ void phase_e2(KP p, int l, int nrows, int wid0) {
    const int tid = tid_fresh(wid0); const int lane = tid & 63, gw = blockIdx.x * 8 + (tid >> 6), nw = gridDim.x * 8;
    unsigned char* ws = launder(p->ws);
    const bf16_t* HF = (const bf16_t*)(ws + WS_BC); const bf16_t* HB = (const bf16_t*)(ws + WS_BX); bf16_t* PO = (bf16_t*)(ws + WS_PO);
    const float* hg = p->a_hnorm_g + (size_t)l * 2048;
    for (int row = gw; row < nrows; row += nw) {
#pragma unroll
        for (int h = 0; h < 8; ++h) {
            const size_t o = (size_t)row * 2048 + h * 256 + lane * 4;
            const u32x2 f = *(const u32x2*)(HF + o), bb = *(const u32x2*)(HB + o), ov = *(const u32x2*)(PO + o);
            float v[4] = {bflo(f.x) + bflo(bb.x), bfhi(f.x) + bfhi(bb.x), bflo(f.y) + bflo(bb.y), bfhi(f.y) + bfhi(bb.y)};
            float ss = v[0] * v[0] + v[1] * v[1] + v[2] * v[2] + v[3] * v[3];
            ss = wave_sum(ss);
            const float rstd = rsqrtf(ss * (1.0f / 256.0f) + EPSF);
            const f32x4 gg = *(const f32x4*)(hg + h * 256 + lane * 4);
            const float og[4] = {bflo(ov.x), bfhi(ov.x), bflo(ov.y), bfhi(ov.y)};
            float y[4];
#pragma unroll
            for (int j = 0; j < 4; ++j) y[j] = sigmoidf_(og[j]) * v[j] * rstd * gg[j];
            u32x2 wv; wv.x = pk2(y[0], y[1]); wv.y = pk2(y[2], y[3]); *(u32x2*)(PO + o) = wv;
        }
    }
}

constexpr int PE_MAXT = 80;
constexpr int PE_IDX = 0, PE_W = PE_MAXT * 128 * 4, PE_SCR = 2 * PE_MAXT * 128 * 4, PE_SCRSZ = 16 * 132 * 4 + 4096 + 256;
__device__ __forceinline__ unsigned ordkey(float v) { const unsigned u = __float_as_uint(v); return (u & 0x80000000u) ? ~u : (u | 0x80000000u); }
__device__ __forceinline__ void phase_peer(KP p, int l, LAS unsigned char* lds, int wid0) {
    const int tid = tid_fresh(wid0), lane = tid & 63, w = __builtin_amdgcn_readfirstlane(tid >> 6), q4 = lane >> 4, c16 = lane & 15;
    unsigned char* ws = launder(p->ws);
    const bf16_t* QP = (const bf16_t*)(ws + WS_PV); const bf16_t* KEYS = (const bf16_t*)(ws + WS_KEYS);
    const bf16_t* XN = (const bf16_t*)(ws + WS_XN);
    float* X = (float*)(ws + WS_X); const float* mod = (const float*)(ws + WS_MOD) + (size_t)l * 3 * 12288;
    const int ntok = (l == 0) ? MR : NLAT, G = gridDim.x;
    const int per = (ntok + G - 1) / G; const int t_begin = blockIdx.x * per, t_end = min(ntok, t_begin + per);
    for (int tb = t_begin; tb < t_end; tb += PE_MAXT) {
        const int nt = min(PE_MAXT, t_end - tb);
        __syncthreads();
        const int ntask = (nt + 15) >> 4;
        if (w < ntask) {
            int lane_pe1 = lane; asm volatile("" : "+v"(lane_pe1));
            const int lane = lane_pe1, q4 = lane >> 4, c16 = lane & 15;
            LAS unsigned char* scr = lds + PE_SCR + w * PE_SCRSZ;
            LAS float* SC = (LAS float*)scr;
            LAS float* LS = (LAS float*)(scr + 16 * 132 * 4);
            LAS int* LI = (LAS int*)(scr + 16 * 132 * 4 + 2048);
            LAS unsigned char* PT = scr + 16 * 132 * 4 + 4096;
            if (lane < 52) {
                const int L = lane;
                const int ge16 = L >= 16, ge24 = L >= 24, ge29 = L >= 29, ge33 = L >= 33, ge36 = L >= 36, ge38 = L >= 38, ge40 = L >= 40, ge42 = L >= 42;
                int pa = ge16 + ge24 + ge29 + ge33 + ge36 + ge38 + ge40 + ge42; if (ge42) pa = 8 + (L - 42);
                int pb = L - (16 * ge16 + 8 * ge24 + 5 * ge29 + 4 * ge33 + 3 * ge36 + 2 * ge38 + 2 * ge40 + 2 * ge42); if (ge42) pb = 0;
                if (L >= 50) { pa = 15; pb = 15; }
                PT[lane * 2] = (unsigned char)pa; PT[lane * 2 + 1] = (unsigned char)pb;
            }
            const int tok_a = min(tb + 16 * w + c16, t_end - 1);
            const int tkl = lane >> 2, qq = lane & 3;
            for (int h = 0; h < 8; ++h) {
                for (int pp = 0; pp < 2; ++pp) {
                    const int hp = 2 * h + pp;
                    bf16x8 af[4];
#pragma unroll
                    for (int ks = 0; ks < 4; ++ks) af[ks] = *(const bf16x8*)(QP + (size_t)tok_a * 2048 + h * 256 + pp * 128 + ks * 32 + 8 * q4);
#pragma unroll 2
                    for (int ct = 0; ct < 8; ++ct) {
                        f32x4 acc = {0.f, 0.f, 0.f, 0.f};
#pragma unroll
                        for (int ks = 0; ks < 4; ++ks) { const bf16x8 bfr = *(const bf16x8*)(KEYS + ((size_t)hp * 128 + 16 * ct + c16) * 128 + ks * 32 + 8 * q4); acc = mfma16(af[ks], bfr, acc); }
#pragma unroll
                        for (int r = 0; r < 4; ++r) SC[(4 * q4 + r) * 132 + 16 * ct + c16] = acc[r];
                    }
                    asm volatile("s_waitcnt lgkmcnt(0)" ::: "memory");
                    unsigned key[32];
#pragma unroll
                    for (int i = 0; i < 8; ++i) { const f32x4 v = *(const LAS f32x4*)(SC + tkl * 132 + 32 * qq + 4 * i);
#pragma unroll
                        for (int j = 0; j < 4; ++j) key[4 * i + j] = (ordkey(v[j]) & ~127u) | (unsigned)(32 * qq + 4 * i + j); }
                    unsigned prev = 0xffffffffu;
#pragma unroll 1
                    for (int r = 0; r < 16; ++r) {
                        unsigned mxk = 0u;
#pragma unroll
                        for (int i = 0; i < 32; ++i) { const unsigned k = key[i] < prev ? key[i] : 0u; mxk = mxk > k ? mxk : k; }
                        unsigned o1 = __shfl_xor(mxk, 1); mxk = mxk > o1 ? mxk : o1; o1 = __shfl_xor(mxk, 2); mxk = mxk > o1 ? mxk : o1;
                        prev = mxk;
                        if (qq == (r & 3)) { const int idx = (int)(mxk & 127u); LS[(pp * 16 + tkl) * 16 + r] = SC[tkl * 132 + idx]; LI[(pp * 16 + tkl) * 16 + r] = idx; }
                    }
                    asm volatile("s_waitcnt lgkmcnt(0)" ::: "memory");
                }
                unsigned ck[13];
#pragma unroll
                for (int i = 0; i < 13; ++i) { const int cidx = qq + 4 * i;
                    if (cidx < 50) { const int a = PT[cidx * 2], bq = PT[cidx * 2 + 1]; const float sv = LS[(0 * 16 + tkl) * 16 + a] + LS[(1 * 16 + tkl) * 16 + bq]; ck[i] = (ordkey(sv) & ~63u) | (unsigned)cidx; }
                    else ck[i] = 0u; }
                unsigned prev = 0xffffffffu; float best0 = 0.f, esum = 0.f; float myexp[4] = {0.f, 0.f, 0.f, 0.f}; int myidx[4] = {0, 0, 0, 0};
#pragma unroll
                for (int r = 0; r < 16; ++r) {
                    unsigned mxk = 0u;
#pragma unroll
                    for (int i = 0; i < 13; ++i) { const unsigned k = ck[i] < prev ? ck[i] : 0u; mxk = mxk > k ? mxk : k; }
                    unsigned o1 = __shfl_xor(mxk, 1); mxk = mxk > o1 ? mxk : o1; o1 = __shfl_xor(mxk, 2); mxk = mxk > o1 ? mxk : o1;
                    prev = mxk;
                    const int cidx = (int)(mxk & 63u); const int a = PT[cidx * 2], bq = PT[cidx * 2 + 1];
                    const float best = LS[(0 * 16 + tkl) * 16 + a] + LS[(1 * 16 + tkl) * 16 + bq];
                    const int eidx = LI[(0 * 16 + tkl) * 16 + a] * 128 + LI[(1 * 16 + tkl) * 16 + bq];
                    if (r == 0) best0 = best;
                    const float e = __expf(best - best0); esum += e;
                    if (qq == (r & 3)) { myexp[r >> 2] = e; myidx[r >> 2] = eidx; }
                }
                const float inv = 1.0f / esum; const int tl = 16 * w + tkl;
                if (tl < nt) {
#pragma unroll
                    for (int i = 0; i < 4; ++i) { const int r = 4 * i + qq;
                        *(LAS int*)(lds + PE_IDX + (tl * 128 + h * 16 + r) * 4) = myidx[i];
                        *(LAS float*)(lds + PE_W + (tl * 128 + h * 16 + r) * 4) = myexp[i] * inv; }
                }
                asm volatile("s_waitcnt lgkmcnt(0)" ::: "memory");
            }
        }
        __syncthreads();
        int lane_pe2 = lane; asm volatile("" : "+v"(lane_pe2));
        for (int tl = w; tl < nt; tl += 8) {
            const int lane = lane_pe2;
            const int row = tb + tl;
            u32x16 xq;
#pragma unroll
            for (int i = 0; i < 4; ++i) { const u32x4 xw = *(const u32x4*)(XN + (size_t)row * 2048 + lane * 32 + i * 8); xq[4 * i] = xw.x; xq[4 * i + 1] = xw.y; xq[4 * i + 2] = xw.z; xq[4 * i + 3] = xw.w; }
            const LAS int* idxp = (const LAS int*)(lds + PE_IDX + tl * 512);
            LAS float* wp = (LAS float*)(lds + PE_W + tl * 512);
            u32x6 bufA[2], bufB[2], bufC[2];
#define PE_ISSUE(buf, TAB, b) do { const int _e0 = idxp[2 * (b)], _e1 = idxp[2 * (b) + 1]; \
                const unsigned char* _r0 = (TAB) + (size_t)_e0 * 1536 + lane * 24; const unsigned char* _r1 = (TAB) + (size_t)_e1 * 1536 + lane * 24; \
                { const u32x4 _a = *(const u32x4*)_r0; const u32x2 _b = *(const u32x2*)(_r0 + 16); buf[0][0] = _a.x; buf[0][1] = _a.y; buf[0][2] = _a.z; buf[0][3] = _a.w; buf[0][4] = _b.x; buf[0][5] = _b.y; } \
                { const u32x4 _a = *(const u32x4*)_r1; const u32x2 _b = *(const u32x2*)(_r1 + 16); buf[1][0] = _a.x; buf[1][1] = _a.y; buf[1][2] = _a.z; buf[1][3] = _a.w; buf[1][4] = _b.x; buf[1][5] = _b.y; } } while (0)
#define PE_CONS_U(buf, b) do { float _p[2]; \
                _Pragma("unroll") for (int _j = 0; _j < 2; ++_j) { const u32x16 _ub = __builtin_bit_cast(u32x16, __builtin_amdgcn_cvt_scalef32_pk32_bf16_fp6(buf[_j], 1.0f)); float _d = 0.f; \
                    _Pragma("unroll") for (int _q = 0; _q < 16; ++_q) _d = dot2bf(_ub[_q], xq[_q], _d); \
                    _p[_j] = _d * (1.0f / 64.0f); } \
                const bool _h32 = (lane & 32) != 0; \
                float _c = _h32 ? _p[1] : _p[0]; const float _cs = _h32 ? _p[0] : _p[1]; _c += __shfl_xor(_cs, 32); \
                _c += __shfl_xor(_c, 16); _c += __shfl_xor(_c, 8); _c += __shfl_xor(_c, 4); _c += __shfl_xor(_c, 2); _c += __shfl_xor(_c, 1); \
                const int _e = 2 * (b) + (lane >> 5); const float _g = wp[_e]; \
                const float _w = _g * 0.5f * _c * (1.0f + erff(_c * 0.70710678118654752f)); \
                if ((lane & 31) == 0) wp[_e] = _w; } while (0)
#define PE_CONS_V(buf, b) do { const f32x2 _w2 = *(const LAS f32x2*)(wp + 2 * (b)); \
                _Pragma("unroll") for (int _j = 0; _j < 2; ++_j) { const f32x32 _vf = __builtin_amdgcn_cvt_scalef32_pk32_f32_fp6(buf[_j], 1.0f); const float _wv = _w2[_j]; \
                    outv += _vf * _wv; } } while (0)
            const unsigned char* TU = ws + WS_PU; const unsigned char* TV = ws + WS_PVW;
            PE_ISSUE(bufA, TU, 0); PE_ISSUE(bufB, TU, 1);
#pragma unroll 1
            for (int b = 0; b < 63; b += 3) {
                PE_ISSUE(bufC, TU, b + 2); PE_CONS_U(bufA, b);
                PE_ISSUE(bufA, TU, b + 3); PE_CONS_U(bufB, b + 1);
                if (b + 4 < 64) PE_ISSUE(bufB, TU, b + 4); else PE_ISSUE(bufB, TV, 0);
                PE_CONS_U(bufC, b + 2);
            }
            PE_ISSUE(bufC, TV, 1);
            PE_CONS_U(bufA, 63);
            asm volatile("s_waitcnt lgkmcnt(0)" ::: "memory");
            f32x32 outv = 0.f;
#pragma unroll 1
            for (int b = 0; b < 63; b += 3) {
                PE_ISSUE(bufA, TV, b + 2); PE_CONS_V(bufB, b);
                PE_ISSUE(bufB, TV, b + 3); PE_CONS_V(bufC, b + 1);
                if (b + 4 < 64) PE_ISSUE(bufC, TV, b + 4);
                PE_CONS_V(bufA, b + 2);
            }
            PE_CONS_V(bufB, 63);
#undef PE_ISSUE
#undef PE_CONS_U
#undef PE_CONS_V
            float out[32];
#pragma unroll
            for (int i = 0; i < 32; ++i) out[i] = outv[i];
            const int which = row < NLAT ? (row >> 13) : 2;
            const float* mg = mod + (size_t)which * 12288 + 5 * 2048;
            float* xrow = X + (size_t)row * 2048; float* orow = (l == 1) ? (p->out + (size_t)row * 2048) : xrow;
#pragma unroll
            for (int hh = 0; hh < 8; ++hh) { const int c = lane * 32 + hh * 4;
                const f32x4 xv = *(const f32x4*)(xrow + c), gv = *(const f32x4*)(mg + c);
                f32x4 ov; ov[0] = xv[0] + gv[0] * out[hh * 4 + 0] * 0.25f; ov[1] = xv[1] + gv[1] * out[hh * 4 + 1] * 0.25f; ov[2] = xv[2] + gv[2] * out[hh * 4 + 2] * 0.25f; ov[3] = xv[3] + gv[3] * out[hh * 4 + 3] * 0.25f;
                *(f32x4*)(orow + c) = ov; }
        }
    }
}

#if !MK_SINGLE
#define LOHI_ARGS , const int lo, const int hi
#define LOHI_PASS , lo, hi
#else
#define LOHI_ARGS
#define LOHI_PASS
#endif
#ifndef PHM
#define PHM 0x7ff
#endif
#if MK_SINGLE
#define IN(k) (((PHM >> (((k) % NPH))) & 1) != 0)
#define SEAM(k) do { if ((k) + 1 < 2 * NPH) xcd_barrier(bar); } while (0)
#else
#define IN(k) (((PHM >> (((k) % NPH))) & 1) && lo <= (k) && (k) < hi)
#define SEAM(k) do { if (IN(k) && IN((k) + 1)) xcd_barrier(bar); } while (0)
#endif
template <int l>
__device__ __forceinline__ void layer_program(KP kp, unsigned char* ws0, LAS unsigned char* lds, const XcdBarrier& bar, const int G, const int wid0 LOHI_ARGS) {
        const int pb = l * NPH;
        const int M2 = (l == 0) ? MR : NLAT;
        if (IN(pb + 0)) { phase_w(launder_p(kp), l, lds, wid0); } SEAM(pb + 0);
        if (IN(pb + 1)) { phase_norm(launder_p(kp), l, 0, MR, wid0); } SEAM(pb + 1);
        if (IN(pb + 2)) { unsigned char* ws = launder(ws0);
            { pg8::PlainOrder S; S.init(ws + WS_XN8, ws + WS_WIN, MR, 72 * 256, 1024, G, (int)blockIdx.x); S.skip_from = 48; S.skip_cnt = 24;
              pg8::EpiProj E{ws};
              pg8::gemm_phase<pg8::EpiProj, pg8::PlainOrder, true>(lds, 1024, S, E, wid0); }
            { pg8::PlainOrder S; S.init(ws + WS_XN, ws + WS_WINB, MR, 24 * 256, 2048, G, (int)blockIdx.x); S.pn_base = 48; S.b_row0 = 48;
              pg8::EpiProj E{ws};
              pg8::gemm_phase<pg8::EpiProj, pg8::PlainOrder, false>(lds, 2048, S, E, wid0); }
        } SEAM(pb + 2);
        if (IN(pb + 3)) { phase_gates_gemm(launder_p(kp), l, wid0); phase_e1(launder_p(kp), l, wid0); } SEAM(pb + 3);
        if (IN(pb + 4)) { phase_mlstm(launder_p(kp), l, lds, wid0); phase_attn(launder_p(kp), l, lds, wid0); } SEAM(pb + 4);
        if (IN(pb + 5)) { phase_e2(launder_p(kp), l, M2, wid0); } SEAM(pb + 5);
        if (IN(pb + 6)) { unsigned char* ws = launder(ws0);
            pg8::BranchOrder S; S.T8 = (const char*)(ws + WS_T8); S.WA = (const char*)(ws + WS_WA);
            S.nM = M2 / 256; S.nN = 8; S.G = G; S.c = (int)blockIdx.x; S.tstep = (size_t)256 * 2048 * 2;
            pg8::EpiMerge E{(bf16_t*)(ws + WS_Y), (const bf16_t*)(ws + WS_GT)};
            pg8::gemm_phase<pg8::EpiMerge, pg8::BranchOrder>(lds, 2048, S, E, wid0);
        } SEAM(pb + 6);
        if (IN(pb + 7)) { unsigned char* ws = launder(ws0);
            pg8::PlainOrder S; S.init(ws + WS_Y, ws + WS_WO, M2, 2048, 2048, G, (int)blockIdx.x);
            pg8::EpiRes E{(float*)(ws + WS_X), (const float*)(ws + WS_MOD) + (size_t)l * 3 * 12288};
            pg8::gemm_phase<pg8::EpiRes, pg8::PlainOrder>(lds, 2048, S, E, wid0);
        } SEAM(pb + 7);
        if (IN(pb + 8)) { phase_norm(launder_p(kp), l, 1, M2, wid0); } SEAM(pb + 8);
        if (IN(pb + 9)) { unsigned char* ws = launder(ws0);
            pg8::PlainOrder S; S.init(ws + WS_XN, ws + WS_WQ, M2, 2048, 2048, G, (int)blockIdx.x);
            pg8::EpiBf E{(bf16_t*)(ws + WS_PV), 2048};
            pg8::gemm_phase<pg8::EpiBf, pg8::PlainOrder>(lds, 2048, S, E, wid0);
        } SEAM(pb + 9);
        if (IN(pb + 10)) { phase_peer(launder_p(kp), l, lds, wid0); } SEAM(pb + 10);
    }
#undef IN
#undef SEAM

__global__ void __launch_bounds__(NTHREADS, 2) fwd_kernel(Params p) {
    extern __shared__ __attribute__((aligned(16))) unsigned char lds_raw[];
    LAS unsigned char* lds = (LAS unsigned char*)lds_raw;
    const int tid = threadIdx.x, G = gridDim.x;
    const int wid0 = __builtin_amdgcn_readfirstlane(tid >> 6);
    KP kp = (KP)__builtin_amdgcn_kernarg_segment_ptr();
    unsigned char* ws0 = kp->ws;
    volatile LAS unsigned* bst = (volatile LAS unsigned*)(lds + LDS_BYTES - 16);
    if (tid == 0) { bst[0] = 0u; bst[1] = 0u; bst[2] = 0u; bst[3] = 0u; }
    __syncthreads();
    XcdBarrier bar; bar.bar = (unsigned*)(ws0 + WS_BAR); bar.x = 0; bar.st = bst;
    if (MK_SINGLE) bar = xcd_barrier_post((unsigned*)(ws0 + WS_BAR), bst);
#if !MK_SINGLE
    const int lo = kp->ph_lo, hi = kp->ph_hi;
#endif
    layer_program<0>(kp, ws0, lds, bar, G, wid0 LOHI_PASS);
    layer_program<1>(kp, ws0, lds, bar, G, wid0 LOHI_PASS);
}

#ifdef CUT
#ifndef DUMP_OFF
#define DUMP_OFF WS_PV
#endif
#ifndef DUMP_F32
#define DUMP_F32 0
#endif
#ifndef DUMP_N
#define DUMP_N ((size_t)NLAT * DM)
#endif
__global__ void dump_kernel(const unsigned char* ws, float* out, size_t n) {
    for (size_t i = (size_t)blockIdx.x * blockDim.x + threadIdx.x; i < n; i += (size_t)gridDim.x * blockDim.x)
        out[i] = (i >= (size_t)DUMP_N) ? 0.f : (DUMP_F32 ? ((const float*)(ws + DUMP_OFF))[i] : bf2f(((const bf16_t*)(ws + DUMP_OFF))[i]));
}
#endif
extern "C" void kernel_launch(void* const* d_in, const int* in_sizes, int n_in, void* d_out, int out_size, void* d_ws, size_t ws_size, hipStream_t stream) {
    static int grid = 0;
    if (grid == 0) {
        if (n_in != 21 || in_sizes[0] != NLAT * DM || out_size != NLAT * DM || ws_size < WS_END) {
            fprintf(stderr, "kernel_launch: unexpected shapes (n_in %d, in0 %d, out %d, ws %zu need %zu); nothing launched\n", n_in, n_in > 0 ? in_sizes[0] : -1, out_size, ws_size, (size_t)WS_END); grid = -1; return; }
        int dev = 0, cus = 0, per_cu = 0;
        if (hipGetDevice(&dev) != hipSuccess || hipDeviceGetAttribute(&cus, hipDeviceAttributeMultiprocessorCount, dev) != hipSuccess) { grid = -1; return; }
        if (hipFuncSetAttribute((const void*)fwd_kernel, hipFuncAttributeMaxDynamicSharedMemorySize, LDS_BYTES) != hipSuccess) { fprintf(stderr, "kernel_launch: hipFuncSetAttribute failed\n"); grid = -1; return; }
        if (hipOccupancyMaxActiveBlocksPerMultiprocessor(&per_cu, (const void*)fwd_kernel, NTHREADS, LDS_BYTES) != hipSuccess || per_cu < 1) { fprintf(stderr, "kernel_launch: occupancy query says %d\n", per_cu); }
        (void)hipGetLastError();
        grid = cus;
    }
    if (grid < 0) return;
    (void)hipMemsetAsync((char*)d_ws, 0, CTL_BYTES, stream);
    Params p{};
    const float** pp = (const float**)&p;
    for (int i = 0; i < 21; ++i) pp[i] = (const float*)d_in[i];
    p.out = (float*)d_out; p.ws = (unsigned char*)d_ws;
#if MK_SINGLE
    p.ph_lo = 0; p.ph_hi = 2 * NPH;
    hipLaunchKernelGGL(fwd_kernel, dim3(grid), dim3(NTHREADS), LDS_BYTES, stream, p);
#else
#ifdef CUT
    for (int k = 0; k <= CUT; ++k) { p.ph_lo = k; p.ph_hi = k + 1; hipLaunchKernelGGL(fwd_kernel, dim3(grid), dim3(NTHREADS), LDS_BYTES, stream, p); }
    hipLaunchKernelGGL(dump_kernel, dim3(1024), dim3(256), 0, stream, (const unsigned char*)d_ws, (float*)d_out, (size_t)NLAT * DM);
#else
    for (int k = 0; k < 2 * NPH; ++k) { p.ph_lo = k; p.ph_hi = k + 1; hipLaunchKernelGGL(fwd_kernel, dim3(grid), dim3(NTHREADS), LDS_BYTES, stream, p); }
#endif
#endif
}
```

```cpp
#include <hip/hip_runtime.h>
#include <stdint.h>
#include <stdio.h>
#include <type_traits>

#ifndef ABL
#define ABL 0
#endif
#ifndef MK_SINGLE
#define MK_SINGLE 1
#endif

#define LAS __attribute__((address_space(3)))
typedef unsigned short bf16_t;
typedef short bf16x8 __attribute__((ext_vector_type(8)));
typedef float f32x4 __attribute__((ext_vector_type(4)));
typedef float f32x2 __attribute__((ext_vector_type(2)));
typedef unsigned u32x4 __attribute__((ext_vector_type(4)));
typedef unsigned u32x2 __attribute__((ext_vector_type(2)));
typedef __bf16 bf2_t __attribute__((ext_vector_type(2)));
typedef int i32x4 __attribute__((ext_vector_type(4)));
typedef int i32x8 __attribute__((ext_vector_type(8)));
typedef float f32x16 __attribute__((ext_vector_type(16)));
typedef float f32x32 __attribute__((ext_vector_type(32)));
typedef unsigned u32x6 __attribute__((ext_vector_type(6)));
typedef __bf16 bf16x32_t __attribute__((ext_vector_type(32)));
typedef unsigned u32x16 __attribute__((ext_vector_type(16)));
typedef short s16x4 __attribute__((ext_vector_type(4)));
#ifndef FP6_INTERLEAVED
#define FP6_INTERLEAVED 1
#endif

constexpr int DM = 2048, NBATCH = 2, SEQ = 8192, CTXL = 256;
constexpr int NLAT = NBATCH * SEQ;
constexpr int NCTX = NBATCH * CTXL;
constexpr int MR = NLAT + NCTX;
constexpr int PROJ_W = 24608;
constexpr int NPROJ = 24576;
constexpr int NTHREADS = 512;
constexpr int LDS_BYTES = 163840;
constexpr int NPH = 11;
constexpr float EPSF = 1e-6f;

constexpr size_t SZ_A = (size_t)MR * 2048 * 2;
constexpr size_t WS_BAR = 0;
constexpr size_t WS_MOD = 16384;
constexpr size_t CTL_BYTES = 16384 + 2 * 3 * 12288 * 4;
constexpr size_t WS_TAB = 311296;
constexpr size_t WS_X = WS_TAB + 32768;
constexpr size_t WS_XN = WS_X + (size_t)MR * 2048 * 4;
constexpr size_t WS_Y = WS_XN + SZ_A;
constexpr size_t WS_XN8 = WS_Y;
constexpr size_t WS_PQ = WS_Y + SZ_A;
constexpr size_t WS_PK = WS_PQ + SZ_A / 2;
constexpr size_t WS_T8 = WS_PK + SZ_A / 2;
constexpr size_t WS_PV = WS_T8 + 0 * SZ_A;
constexpr size_t WS_PO = WS_T8 + 1 * SZ_A;
constexpr size_t WS_CQ = WS_T8 + 2 * SZ_A;
constexpr size_t WS_CK = WS_T8 + 3 * SZ_A;
constexpr size_t WS_CV = WS_T8 + 4 * SZ_A;
constexpr size_t WS_BB = WS_T8 + 5 * SZ_A;
constexpr size_t WS_BC = WS_T8 + 6 * SZ_A;
constexpr size_t WS_BX = WS_T8 + 7 * SZ_A;
constexpr size_t WS_GT = WS_T8 + 8 * SZ_A;
constexpr size_t WS_GATES = WS_GT + 3 * SZ_A;
constexpr size_t WS_WIN = WS_GATES + (size_t)MR * 32 * 4;
constexpr size_t WS_WINB = WS_WIN + (size_t)NPROJ * 2048;
constexpr size_t WS_WG = WS_WIN + (size_t)NPROJ * 2048 * 2;
constexpr size_t SZ_W = (size_t)2048 * 2048 * 2;
constexpr size_t WS_WA = WS_WG + 32 * 2048 * 2;
constexpr size_t WS_WB = WS_WA + SZ_W;
constexpr size_t WS_WC = WS_WB + SZ_W;
constexpr size_t WS_WO = WS_WC + SZ_W;
constexpr size_t WS_WQ = WS_WO + SZ_W;
constexpr size_t WS_KEYS = WS_WQ + SZ_W;
constexpr size_t WS_PU = WS_KEYS + 16 * 128 * 128 * 2;
constexpr size_t WS_PVW = WS_PU + (size_t)16384 * 2048 * 2;
constexpr size_t WS_SCAN = WS_PU + (size_t)16384 * 2048;
constexpr size_t WS_END = WS_PVW + (size_t)16384 * 2048 * 2;

struct Params {
    const float *x, *c, *ctx, *c_ctx, *w_ada, *b_ada, *norm_g, *w_in, *a_gate_b, *a_hnorm_g, *b_conv, *c_qk_g, *c_rpb,
        *w_a_out, *w_b_out, *w_c_out, *w_out, *peer_wq, *peer_keys, *peer_u, *peer_v;
    float* out; unsigned char* ws; int ph_lo, ph_hi;
};
#define CAS __attribute__((address_space(4)))
typedef const CAS Params* KP;
__device__ __forceinline__ KP launder_p(KP q) { asm volatile("" : "+s"(q)); return q; }

__device__ __forceinline__ unsigned char* launder(unsigned char* q) { size_t z = 0; asm volatile("" : "+s"(z)); return q + z; }
__device__ __forceinline__ int tid_fresh(int wid0) { int t = wid0 * 64 + (int)__builtin_amdgcn_mbcnt_hi(~0u, __builtin_amdgcn_mbcnt_lo(~0u, 0u)); asm volatile("" : "+v"(t)); return t; }

__device__ __forceinline__ float bf2f(unsigned b) { return __uint_as_float(b << 16); }
__device__ __forceinline__ float bflo(unsigned w) { return __uint_as_float(w << 16); }
__device__ __forceinline__ float bfhi(unsigned w) { return __uint_as_float(w & 0xffff0000u); }
__device__ __forceinline__ unsigned pk2(float lo, float hi) { f32x2 v = {lo, hi}; bf2_t b = __builtin_convertvector(v, bf2_t); return __builtin_bit_cast(unsigned, b); }
__device__ __forceinline__ bf16_t f2bf(float f) { return (bf16_t)(pk2(f, 0.f) & 0xffffu); }
__device__ __forceinline__ f32x4 mfma16(bf16x8 a, bf16x8 b, f32x4 c) { return __builtin_amdgcn_mfma_f32_16x16x32_bf16(a, b, c, 0, 0, 0); }
__device__ __forceinline__ float dot2bf(unsigned a, unsigned b, float c) { return __builtin_amdgcn_fdot2_f32_bf16(__builtin_bit_cast(bf2_t, a), __builtin_bit_cast(bf2_t, b), c, false); }
#define LDS_BARRIER() do { asm volatile("s_waitcnt lgkmcnt(0)" ::: "memory"); __builtin_amdgcn_s_barrier(); asm volatile("" ::: "memory"); } while (0)
__device__ __forceinline__ float wave_sum(float v) {
#pragma unroll
    for (int o = 32; o >= 1; o >>= 1) v += __shfl_xor(v, o);
    return v;
}
__device__ __forceinline__ float sigmoidf_(float v) { return 1.0f / (1.0f + __expf(-v)); }
__device__ __forceinline__ float logsigmoidf_(float v) { return fminf(v, 0.f) - log1pf(__expf(-fabsf(v))); }

#define XB_TMO      128
#define XB_XCNT(j)  (256  + 64 * (j))
#define XB_XSUB(j)  (1280 + 64 * (j))
#define XB_XGEN(j)  (2304 + 64 * (j))
#define XB_TOP      3328
#define XB_TOPGEN   3392
#define XCD_BAR_WORDS 3456
#define XB_SPIN_CAP (1u << 22)
__device__ __forceinline__ unsigned xb_ld(unsigned* p)              { return __hip_atomic_load(p, __ATOMIC_RELAXED, __HIP_MEMORY_SCOPE_AGENT); }
__device__ __forceinline__ unsigned xb_add(unsigned* p, unsigned v) { return __hip_atomic_fetch_add(p, v, __ATOMIC_RELAXED, __HIP_MEMORY_SCOPE_AGENT); }
__device__ __forceinline__ unsigned xb_xcc_id() { return (unsigned)__builtin_amdgcn_s_getreg((3 << 11) | 20) & 0xFu; }
#define XB_SPIN(cond, bar) do { unsigned _sp = 0; while (cond) { __builtin_amdgcn_s_sleep(1); \
    if ((++_sp & 255u) == 0u) { if (xb_ld(&(bar)[XB_TMO])) break; if (_sp > XB_SPIN_CAP) { atomicAdd(&(bar)[XB_TMO], 1u); break; } } } } while (0)
struct XcdBarrier { unsigned* bar; unsigned x; volatile LAS unsigned* st; };
__device__ __forceinline__ XcdBarrier xcd_barrier_post(unsigned* bar, volatile LAS unsigned* st) {
    XcdBarrier b; b.bar = bar; b.x = xb_xcc_id(); b.st = st;
    if (threadIdx.x == 0) (void)xb_add(&bar[XB_XCNT(b.x)], 1u);
    return b;
}
__device__ __forceinline__ void xcd_barrier_complete(unsigned* bar, unsigned x, unsigned& nloc, unsigned& nx) {
    const unsigned G = gridDim.x * gridDim.y * gridDim.z;
    unsigned sum, cnt, mine, sp = 0u;
    for (;;) {
        sum = 0u; cnt = 0u; mine = 0u;
#pragma unroll
        for (unsigned j = 0; j < 16; ++j) { const unsigned c = xb_ld(&bar[XB_XCNT(j)]); sum += c; cnt += (c > 0u) ? 1u : 0u; mine = (j == x) ? c : mine; }
        if (sum == G) break;
        __builtin_amdgcn_s_sleep(1);
        if ((++sp & 255u) == 0u) { if (xb_ld(&bar[XB_TMO])) break; if (sp > XB_SPIN_CAP) { atomicAdd(&bar[XB_TMO], 1u); break; } }
    }
    nloc = mine > 0u ? mine : 1u; nx = cnt > 0u ? cnt : 1u;
}
__device__ __forceinline__ void xcd_barrier(const XcdBarrier& b) {
    asm volatile("s_waitcnt vmcnt(0)" ::: "memory");
    __syncthreads();
    if (threadIdx.x == 0) {
        unsigned* bar = b.bar;
        __builtin_amdgcn_s_waitcnt(0);
        unsigned nloc = b.st[0], nx = b.st[1];
        if (nloc == 0u) { xcd_barrier_complete(bar, b.x, nloc, nx); b.st[0] = nloc; b.st[1] = nx; }
        const unsigned old = xb_add(&bar[XB_XSUB(b.x)], 1u);
        const unsigned gen = old / nloc;
        if (old + 1u == (gen + 1u) * nloc) {
            __builtin_amdgcn_fence(__ATOMIC_RELEASE, "agent");
            asm volatile("s_waitcnt vmcnt(0)" ::: "memory");
            const unsigned og = xb_add(&bar[XB_TOP], 1u);
            const unsigned tg = og / nx;
            if (og + 1u == (tg + 1u) * nx) xb_add(&bar[XB_TOPGEN], 1u);
            else XB_SPIN(xb_ld(&bar[XB_TOPGEN]) == tg, bar);
            __builtin_amdgcn_fence(__ATOMIC_ACQUIRE, "agent");
            xb_add(&bar[XB_XGEN(b.x)], 1u);
            asm volatile("s_waitcnt vmcnt(0)" ::: "memory");
        } else {
            XB_SPIN(xb_ld(&bar[XB_XGEN(b.x)]) == gen, bar);
            __builtin_amdgcn_fence(__ATOMIC_ACQUIRE, "agent");
            asm volatile("s_waitcnt vmcnt(0)" ::: "memory");
        }
    }
    __syncthreads();
}

namespace pg8 {
constexpr int BM = 256, BK = 64, HALF = 128, HTB = HALF * BK * 2, STAGE_BYTES = 8 * HTB, NXCD = 8, WGM = 8;
__host__ __device__ __forceinline__ int lds_byte(int r, int c) { const int st = (r >> 4) * 2 + (c >> 5), rr = r & 15, cc = c & 31, ob = rr * 64 + cc * 2; return st * 1024 + (ob ^ (((ob >> 9) & 1) << 5)); }
__host__ __device__ __forceinline__ void stage_rc(int b, int& R, int& C) { const int st = b / 1024, sb = b % 1024, swz = sb ^ (((sb >> 9) & 1) << 5); R = (st >> 1) * 16 + swz / 64; C = (st & 1) * 32 + (swz % 64) / 2; }
__host__ __device__ __forceinline__ int perm32(int rho) { const int n = rho >> 4, i = rho & 15; return 8 * (i >> 2) + 4 * n + (i & 3); }

struct Unit { int pm, pn, br; const char* A; const char* B; };

__device__ __forceinline__ bool tile_of(int L, int nM, int nN, int& pm, int& pn) {
    const int nwg = nM * nN; if (L >= nwg) return false;
    int wgid = L; { const int q = nwg / NXCD, r = nwg % NXCD, xcd = wgid % NXCD, off = wgid / NXCD; wgid = (xcd < r ? xcd * (q + 1) : r * (q + 1) + (xcd - r) * q) + off; }
    const int nig = WGM * nN, gid = wgid / nig, fm = gid * WGM, gsz = (nM - fm) < WGM ? (nM - fm) : WGM;
    pm = fm + ((wgid % nig) % gsz); pn = (wgid % nig) / gsz; return true;
}
struct PlainOrder {
    const char* A; const char* Bt; int nM, nN, G, c; size_t tstep; int pn_base, skip_from, skip_cnt, b_row0;
    __device__ __forceinline__ void init(const void* A_, const void* Bt_, int M, int N, int K, int G_, int c_) { A = (const char*)A_; Bt = (const char*)Bt_; nM = M / BM; nN = N / BM; G = G_; c = c_; tstep = (size_t)BM * K * 2;
        pn_base = 0; skip_from = 1 << 30; skip_cnt = 0; b_row0 = 0; }
    __device__ __forceinline__ bool next(int i, Unit& u) const {
        int pm, pn; if (!tile_of(i * G + c, nM, nN, pm, pn)) return false;
        pn += pn_base; if (pn >= skip_from) pn += skip_cnt;
        u.pm = pm; u.pn = pn; u.br = 0; u.A = A + (size_t)pm * tstep; u.B = Bt + (size_t)(pn - b_row0) * tstep; return true;
    }
};
struct BranchOrder {
    const char* T8; const char* WA; int nM, nN, G, c; size_t tstep;
    __device__ __forceinline__ bool next(int i, Unit& u) const {
        const int tl = i / 3, br = i - 3 * tl; int pm, pn; if (!tile_of(tl * G + c, nM, nN, pm, pn)) return false;
        u.pm = pm; u.pn = pn; u.br = br;
        const int ti = 1 + 4 * (br == 1) + (br == 2);
        u.A = T8 + (size_t)ti * SZ_A + (size_t)pm * tstep; u.B = WA + (size_t)br * SZ_W + (size_t)pn * tstep; return true;
    }
};

template <class Epi, class Sched, bool FP8 = false>
__device__ __forceinline__ void gemm_phase(LAS unsigned char* lds, const int K, const Sched& S, const Epi& E, int wid0) {
    const int tid = tid_fresh(wid0), wid = __builtin_amdgcn_readfirstlane(tid >> 6), lane = tid & 63, wr = wid >> 2, wc = wid & 3, fr = lane & 15, fq = lane >> 4;
    const int nt = K / BK;
    unsigned voffA[2], voffB[2];
#pragma unroll
    for (int i = 0; i < 2; ++i) { int R, C; stage_rc(tid * 16 + i * 8192, R, C); const int Rb = Epi::PERM ? ((R & ~31) + perm32(R & 31)) : R;
        voffA[i] = (unsigned)(R * K + C) * 2u; voffB[i] = (unsigned)(Rb * K + C) * 2u; }
    const size_t kstep = (size_t)(BK * 2);
    const size_t hstep = (size_t)HALF * K * 2;
    const unsigned ldsw = (unsigned)wid * 1024u;
    const int aoff = lds_byte(wr * 64 + fr, fq * 8), boff = lds_byte(wc * 32 + fr, fq * 8);
#define PG8_SA(b, h) (((b) * 2 + (h)) * HTB)
#define PG8_SB(b, h) ((4 + (b) * 2 + (h)) * HTB)
#define PG8_STAGE(bufoff, gbase, voff) do { _Pragma("unroll") for (int _i = 0; _i < 2; ++_i) \
        __builtin_amdgcn_global_load_lds((const unsigned*)((const char*)(gbase) + (voff)[_i]), (LAS unsigned*)(lds + (bufoff) + ldsw + _i * 8192), 16, 0, 0); } while (0)
#define PG8_LD1(dstv, addr) do { if constexpr (FP8) { const i32x4 _lo = *(const LAS i32x4*)(lds + (addr)), _hi = *(const LAS i32x4*)(lds + (addr) + 1024); dstv[0] = __builtin_shufflevector(_lo, _hi, 0, 1, 2, 3, 4, 5, 6, 7); } \
        else { _Pragma("unroll") for (int k = 0; k < 2; ++k) dstv[k] = *(const LAS bf16x8*)(lds + (addr) + k * 1024); } } while (0)
#define PG8_LDA(dst, b, h) do { _Pragma("unroll") for (int m = 0; m < 4; ++m) PG8_LD1(dst[m], PG8_SA(b, h) + aoff + m * 2048); } while (0)
#define PG8_LDB(dst, b, h) do { _Pragma("unroll") for (int n = 0; n < 2; ++n) PG8_LD1(dst[n], PG8_SB(b, h) + boff + n * 2048); } while (0)
#define PG8_MMA(ai, bj, At, Bt) do { __builtin_amdgcn_s_setprio(1); _Pragma("unroll") for (int m = 0; m < 4; ++m) _Pragma("unroll") for (int n = 0; n < 2; ++n) { \
        if constexpr (FP8) asm volatile("v_mfma_scale_f32_16x16x128_f8f6f4 %0, %1, %2, %0, %3, %4 op_sel_hi:[0,0,0]" : "+v"(acc[ai][bj][m][n]) : "v"(Bt[n][0]), "v"(At[m][0]), "v"(sclW), "v"(sclX)); \
        else { _Pragma("unroll") for (int k = 0; k < 2; ++k) acc[ai][bj][m][n] = __builtin_amdgcn_mfma_f32_16x16x32_bf16(Bt[n][k], At[m][k], acc[ai][bj][m][n], 0, 0, 0); } } \
        __builtin_amdgcn_s_setprio(0); } while (0)
#define PG8_WAIT_V(n) asm volatile("s_waitcnt vmcnt(" #n ")" ::: "memory")
#define PG8_WAIT_L(n) asm volatile("s_waitcnt lgkmcnt(" #n ")" ::: "memory")
#define PG8_BAR __builtin_amdgcn_s_barrier()
#define PG8_SCHED __builtin_amdgcn_sched_barrier(0)
    Unit cur, nxt; int ui = 0;
    if (!S.next(0, cur)) return;
    const int sclW = 0x75757575, sclX = 0x7F7F7F7F;
    f32x4 acc[2][2][4][2];
#pragma unroll
    for (int a = 0; a < 2; ++a)
#pragma unroll
        for (int b = 0; b < 2; ++b)
#pragma unroll
            for (int m = 0; m < 4; ++m)
#pragma unroll
                for (int n = 0; n < 2; ++n) acc[a][b][m][n] = (f32x4){0.f, 0.f, 0.f, 0.f};
    typedef typename std::conditional<FP8, i32x8, bf16x8>::type frag_t;
    frag_t At[4][FP8 ? 1 : 2], B0[2][FP8 ? 1 : 2], B1[2][FP8 ? 1 : 2];
    const char* cA = cur.A; const char* cB = cur.B;
    PG8_STAGE(PG8_SB(0, 0), cB, voffB); PG8_STAGE(PG8_SA(0, 0), cA, voffA); PG8_STAGE(PG8_SB(0, 1), cB + hstep, voffB); PG8_STAGE(PG8_SA(0, 1), cA + hstep, voffA);
    if (wr == 1) PG8_BAR;
    PG8_WAIT_V(4); PG8_BAR;
    PG8_STAGE(PG8_SB(1, 0), cB + kstep, voffB); PG8_STAGE(PG8_SA(1, 0), cA + kstep, voffA); PG8_STAGE(PG8_SB(1, 1), cB + hstep + kstep, voffB);
    PG8_WAIT_V(6); PG8_BAR;
    for (;;) {
        const bool has_next = S.next(ui + 1, nxt);
        const char* nA = has_next ? nxt.A : cA; const char* nB = has_next ? nxt.B : cB;
        for (int t = 0; t < nt; t += 2) {
            const bool last = (t == nt - 2);
            const char* a1 = cA + (size_t)(t + 1) * kstep;
            const char* a2 = last ? nA : cA + (size_t)(t + 2) * kstep; const char* b2 = last ? nB : cB + (size_t)(t + 2) * kstep;
            const char* a3 = a2 + kstep; const char* b3 = b2 + kstep;
            PG8_LDB(B0, 0, 0); PG8_SCHED; PG8_LDA(At, 0, 0); PG8_STAGE(PG8_SA(1, 1), a1 + hstep, voffA);
            PG8_WAIT_L(8); PG8_BAR; PG8_WAIT_L(0); PG8_MMA(0, 0, At, B0); PG8_BAR; PG8_SCHED;
            PG8_LDB(B1, 0, 1); PG8_STAGE(PG8_SB(0, 0), b2, voffB);
            PG8_BAR; PG8_WAIT_L(0); PG8_MMA(0, 1, At, B1); PG8_BAR;
            PG8_LDA(At, 0, 1); PG8_STAGE(PG8_SA(0, 0), a2, voffA);
            PG8_BAR; PG8_WAIT_L(0); PG8_MMA(1, 0, At, B0); PG8_BAR; PG8_SCHED;
            PG8_STAGE(PG8_SB(0, 1), b2 + hstep, voffB);
            PG8_WAIT_V(6); PG8_BAR; PG8_MMA(1, 1, At, B1); PG8_BAR;
            PG8_LDB(B0, 1, 0); PG8_SCHED; PG8_LDA(At, 1, 0); PG8_STAGE(PG8_SA(0, 1), a2 + hstep, voffA);
            PG8_WAIT_L(8); PG8_BAR; PG8_WAIT_L(0); PG8_MMA(0, 0, At, B0); PG8_BAR; PG8_SCHED;
            PG8_LDB(B1, 1, 1); PG8_STAGE(PG8_SB(1, 0), b3, voffB);
            PG8_BAR; PG8_WAIT_L(0); PG8_MMA(0, 1, At, B1); PG8_BAR;
            PG8_LDA(At, 1, 1); PG8_STAGE(PG8_SA(1, 0), a3, voffA);
            PG8_BAR; PG8_WAIT_L(0); PG8_MMA(1, 0, At, B0); PG8_BAR; PG8_SCHED;
            PG8_STAGE(PG8_SB(1, 1), b3 + hstep, voffB);
            PG8_WAIT_V(6); PG8_BAR; PG8_MMA(1, 1, At, B1); PG8_BAR;
        }
        if constexpr (FP8) { asm volatile("s_nop 15\n\ts_nop 15\n\ts_nop 15" ::: "memory"); }
        E(acc, cur, wr, wc, fr, fq);
        if (!has_next) break;
#pragma unroll
        for (int a = 0; a < 2; ++a)
#pragma unroll
            for (int b = 0; b < 2; ++b)
#pragma unroll
                for (int m = 0; m < 4; ++m)
#pragma unroll
                    for (int n = 0; n < 2; ++n) acc[a][b][m][n] = (f32x4){0.f, 0.f, 0.f, 0.f};
        cur = nxt; cA = nA; cB = nB; ++ui;
    }
    PG8_WAIT_V(0);
    if (wr == 0) PG8_BAR;
    PG8_BAR;
#undef PG8_SA
#undef PG8_SB
#undef PG8_STAGE
#undef PG8_LD1
#undef PG8_LDA
#undef PG8_LDB
#undef PG8_MMA
#undef PG8_WAIT_V
#undef PG8_WAIT_L
#undef PG8_BAR
#undef PG8_SCHED
}

struct EpiProj {
    static constexpr bool PERM = true;
    unsigned char* ws;
    __device__ __forceinline__ void operator()(const f32x4 (&acc)[2][2][4][2], const Unit& u, int wr, int wc, int fr, int fq) const {
        const int pn = u.pn; size_t off; int ld, c0;
        if (pn < 4) { off = WS_PQ; ld = 1024; c0 = pn * 256; }
        else if (pn < 8) { off = WS_PK; ld = 1024; c0 = (pn - 4) * 256; }
        else if (pn < 72) { const int t = (pn - 8) >> 3; off = WS_T8 + (size_t)t * SZ_A; ld = 2048; c0 = ((pn - 8) & 7) * 256; }
        else { off = WS_GT; ld = 6144; c0 = (pn - 72) * 256; }
        bf16_t* rp = (bf16_t*)(ws + off) + (size_t)(u.pm * BM + wr * 64 + fr) * ld + c0 + wc * 32 + 8 * fq;
        const size_t step = (size_t)16 * ld;
#pragma unroll
        for (int ai = 0; ai < 2; ++ai) {
#pragma unroll
            for (int m = 0; m < 4; ++m) {
                asm volatile("" : "+v"(rp));
#pragma unroll
                for (int bj = 0; bj < 2; ++bj) { const f32x4 v0 = acc[ai][bj][m][0], v1 = acc[ai][bj][m][1];
                    u32x4 w; w.x = pk2(v0[0], v0[1]); w.y = pk2(v0[2], v0[3]); w.z = pk2(v1[0], v1[1]); w.w = pk2(v1[2], v1[3]);
                    *(u32x4*)(rp + bj * HALF) = w; }
                rp += step;
            }
            rp += 4 * step;
        }
    }
};
struct EpiBf {
    static constexpr bool PERM = true;
    bf16_t* O; int ld;
    __device__ __forceinline__ void operator()(const f32x4 (&acc)[2][2][4][2], const Unit& u, int wr, int wc, int fr, int fq) const {
        const int row0 = u.pm * BM + wr * 64 + fr, col0 = u.pn * BM + wc * 32 + 8 * fq;
#pragma unroll
        for (int ai = 0; ai < 2; ++ai)
#pragma unroll
            for (int m = 0; m < 4; ++m) { bf16_t* rowp = O + (size_t)(row0 + ai * HALF + m * 16) * ld + col0;
#pragma unroll
                for (int bj = 0; bj < 2; ++bj) { const f32x4 v0 = acc[ai][bj][m][0], v1 = acc[ai][bj][m][1];
                    u32x4 w; w.x = pk2(v0[0], v0[1]); w.y = pk2(v0[2], v0[3]); w.z = pk2(v1[0], v1[1]); w.w = pk2(v1[2], v1[3]);
                    *(u32x4*)(rowp + bj * HALF) = w; } }
    }
};
struct EpiMerge {
    static constexpr bool PERM = true;
    bf16_t* Y; const bf16_t* GT;
    __device__ __forceinline__ void operator()(const f32x4 (&acc)[2][2][4][2], const Unit& u, int wr, int wc, int fr, int fq) const {
        const int row0 = u.pm * BM + wr * 64 + fr, col0 = u.pn * BM + wc * 32 + 8 * fq;
#pragma unroll
        for (int ai = 0; ai < 2; ++ai)
#pragma unroll
            for (int m = 0; m < 4; ++m) { const size_t r = (size_t)(row0 + ai * HALF + m * 16);
                bf16_t* rowp = Y + r * 2048 + col0; const bf16_t* gp = GT + r * 6144 + (size_t)u.br * 2048 + col0;
#pragma unroll
                for (int bj = 0; bj < 2; ++bj) { const f32x4 v0 = acc[ai][bj][m][0], v1 = acc[ai][bj][m][1];
                    const u32x4 g = *(const u32x4*)(gp + bj * HALF);
                    const float ab = ((ABL >> u.br) & 1) ? 0.f : 1.f;
                    float o[8];
                    o[0] = ab * sigmoidf_(bflo(g.x)) * v0[0]; o[1] = ab * sigmoidf_(bfhi(g.x)) * v0[1]; o[2] = ab * sigmoidf_(bflo(g.y)) * v0[2]; o[3] = ab * sigmoidf_(bfhi(g.y)) * v0[3];
                    o[4] = ab * sigmoidf_(bflo(g.z)) * v1[0]; o[5] = ab * sigmoidf_(bfhi(g.z)) * v1[1]; o[6] = ab * sigmoidf_(bflo(g.w)) * v1[2]; o[7] = ab * sigmoidf_(bfhi(g.w)) * v1[3];
                    if (u.br != 0) { const u32x4 y = *(const u32x4*)(rowp + bj * HALF);
                        o[0] += bflo(y.x); o[1] += bfhi(y.x); o[2] += bflo(y.y); o[3] += bfhi(y.y); o[4] += bflo(y.z); o[5] += bfhi(y.z); o[6] += bflo(y.w); o[7] += bfhi(y.w); }
                    u32x4 w; w.x = pk2(o[0], o[1]); w.y = pk2(o[2], o[3]); w.z = pk2(o[4], o[5]); w.w = pk2(o[6], o[7]);
                    *(u32x4*)(rowp + bj * HALF) = w; } }
    }
};
struct EpiRes {
    static constexpr bool PERM = false;
    float* X; const float* mod;
    __device__ __forceinline__ void operator()(const f32x4 (&acc)[2][2][4][2], const Unit& u, int wr, int wc, int fr, int fq) const {
        const int row0 = u.pm * BM + wr * 64 + fr, col0 = u.pn * BM + wc * 32 + 4 * fq;
        const int which = (u.pm < 32) ? 0 : (u.pm < 64 ? 1 : 2);
        const float* mg = mod + (size_t)which * 12288 + 2 * 2048 + col0;
        f32x4 gv[2][2];
#pragma unroll
        for (int bj = 0; bj < 2; ++bj)
#pragma unroll
            for (int n = 0; n < 2; ++n) gv[bj][n] = *(const f32x4*)(mg + bj * HALF + n * 16);
#pragma unroll
        for (int ai = 0; ai < 2; ++ai)
#pragma unroll
            for (int m = 0; m < 4; ++m) { float* rowp = X + (size_t)(row0 + ai * HALF + m * 16) * 2048 + col0;
#pragma unroll
                for (int bj = 0; bj < 2; ++bj)
#pragma unroll
                    for (int n = 0; n < 2; ++n) { f32x4* q = (f32x4*)(rowp + bj * HALF + n * 16); *q = *q + gv[bj][n] * acc[ai][bj][m][n]; } }
    }
};
}

__device__ __forceinline__ int proj_src_col(int n) {
    if (n < 1024) return 7200 + n;
    if (n < 2048) return n - 1024;
    if (n < 4096) return 1024 + (n - 2048);
    if (n < 6144) return 8224 + (n - 4096);
    if (n < 8192) return 16416 + (n - 6144);
    if (n < 10240) return 3104 + (n - 8192);
    if (n < 12288) return 5152 + (n - 10240);
    if (n < 14336) return 10272 + (n - 12288);
    if (n < 16384) return 12320 + (n - 14336);
    if (n < 18432) return 14368 + (n - 16384);
    return 18464 + (n - 18432);
}
__device__ __forceinline__ void phase_w(KP p, int l, LAS unsigned char* lds, int wid0) {
    const int tid = tid_fresh(wid0), G = gridDim.x, bid = blockIdx.x;
    unsigned char* ws = launder(p->ws);
    {
        LAS float* tile = (LAS float*)lds;
        const int NT_IN = NPROJ / 64;
        const int total = (NT_IN + 5 * 32) * 32;
        for (int t = bid; t < total; t += G) {
            const int ntile = t >> 5, kt = t & 31, k0 = kt * 64;
            const float* src; int ld; bf16_t* dst; float scale = 1.0f; int n0;
            bool to8 = false;
            if (ntile < NT_IN) { n0 = ntile * 64; src = p->w_in + (size_t)l * 2048 * PROJ_W + proj_src_col(n0); ld = PROJ_W;
                if (n0 >= 12288 && n0 < 18432) { dst = (bf16_t*)(ws + WS_WINB) + (size_t)(n0 - 12288) * 2048; }
                else { to8 = true; dst = (bf16_t*)(ws + WS_WIN); scale = (n0 < 1024) ? 1024.0f * 0.08838834764831845f : 1024.0f; } }
            else { const int mi = (ntile - NT_IN) >> 5; n0 = ((ntile - NT_IN) & 31) * 64;
                const float* m5 = mi == 0 ? p->w_a_out : mi == 1 ? p->w_b_out : mi == 2 ? p->w_c_out : mi == 3 ? p->w_out : p->peer_wq;
                src = m5 + (size_t)l * 2048 * 2048 + n0; ld = 2048;
                dst = (bf16_t*)(ws + WS_WA + (size_t)mi * SZ_W) + (size_t)n0 * 2048; }
            { const int kk = tid >> 4, n4 = (tid & 15) * 4;
#pragma unroll
              for (int h = 0; h < 2; ++h) { const f32x4 v = *(const f32x4*)(src + (size_t)(k0 + kk + 32 * h) * ld + n4);
                  LAS float* tp = tile + (kk + 32 * h) * 65 + n4; tp[0] = v[0]; tp[1] = v[1]; tp[2] = v[2]; tp[3] = v[3]; } }
            __syncthreads();
            { const int n = tid >> 3, k8 = (tid & 7) * 8; float v[8];
#pragma unroll
              for (int j = 0; j < 8; ++j) v[j] = tile[(k8 + j) * 65 + n] * scale;
              if (to8) {
#pragma unroll
                  for (int j = 0; j < 8; ++j) v[j] = fminf(fmaxf(v[j], -448.f), 448.f);
                  int d0 = 0, d1 = 0; d0 = __builtin_amdgcn_cvt_pk_fp8_f32(v[0], v[1], d0, false); d0 = __builtin_amdgcn_cvt_pk_fp8_f32(v[2], v[3], d0, true);
                  d1 = __builtin_amdgcn_cvt_pk_fp8_f32(v[4], v[5], d1, false); d1 = __builtin_amdgcn_cvt_pk_fp8_f32(v[6], v[7], d1, true);
                  u32x2 w8; w8.x = (unsigned)d0; w8.y = (unsigned)d1; *(u32x2*)((unsigned char*)dst + (size_t)(n0 + n) * 2048 + k0 + k8) = w8; }
              else { u32x4 w; w.x = pk2(v[0], v[1]); w.y = pk2(v[2], v[3]); w.z = pk2(v[4], v[5]); w.w = pk2(v[6], v[7]);
                  *(u32x4*)(dst + (size_t)n * 2048 + k0 + k8) = w; } }
            __syncthreads();
        }
    }
    const size_t gtid = (size_t)bid * NTHREADS + tid, gthreads = (size_t)G * NTHREADS;
    for (size_t i = gtid; i < 32 * 2048; i += gthreads) { const int n = (int)(i >> 11), k = (int)(i & 2047);
        ((bf16_t*)(ws + WS_WG))[i] = f2bf(p->w_in[(size_t)l * 2048 * PROJ_W + (size_t)k * PROJ_W + 3072 + n]); }
    {
        const float* su = p->peer_u + (size_t)l * 16384 * 2048; const float* sv = p->peer_v + (size_t)l * 16384 * 2048;
        unsigned char* du = ws + WS_PU; unsigned char* dv = ws + WS_PVW;
        const size_t n32 = (size_t)16384 * 2048 / 32;
        for (size_t i = gtid; i < n32; i += gthreads) {
#pragma unroll
            for (int t = 0; t < 2; ++t) {
                const float* sp = (t ? sv : su) + i * 32; const float sc = t ? 4.0f : 64.0f;
                float e[32];
#pragma unroll
                for (int q = 0; q < 8; ++q) { const f32x4 a = *(const f32x4*)(sp + q * 4); e[q * 4] = a[0] * sc; e[q * 4 + 1] = a[1] * sc; e[q * 4 + 2] = a[2] * sc; e[q * 4 + 3] = a[3] * sc; }
                f32x16 va, vb;
#pragma unroll
                for (int j = 0; j < 16; ++j) { va[j] = FP6_INTERLEAVED ? e[2 * j] : e[j]; vb[j] = FP6_INTERLEAVED ? e[2 * j + 1] : e[16 + j]; }
                const u32x6 wv = __builtin_amdgcn_cvt_scalef32_2xpk16_fp6_f32(va, vb, 1.0f);
                unsigned* dp = (unsigned*)((t ? dv : du) + i * 24);
                u32x2 w0, w1, w2; w0.x = wv[0]; w0.y = wv[1]; w1.x = wv[2]; w1.y = wv[3]; w2.x = wv[4]; w2.y = wv[5];
                *(u32x2*)dp = w0; *(u32x2*)(dp + 2) = w1; *(u32x2*)(dp + 4) = w2;
            }
        }
        const float* sk = p->peer_keys + (size_t)l * 16 * 128 * 128; bf16_t* dk = (bf16_t*)(ws + WS_KEYS);
        for (size_t i = gtid; i < (size_t)16 * 128 * 128; i += gthreads) dk[i] = f2bf(sk[i]);
    }
    {
        float* mod = (float*)(ws + WS_MOD) + (size_t)l * 3 * 12288;
        const float* wa = p->w_ada + (size_t)l * 2048 * 12288; const float* ba = p->b_ada + (size_t)l * 12288;
        LAS float* part = (LAS float*)(lds + 32768);
        const int col = tid & 63, ks = tid >> 6;
        for (int t = bid; t < 256; t += G) {
            const int n = t * 48 + col;
            float a0 = 0.f, a1 = 0.f, a2 = 0.f;
            if (col < 48) {
                for (int k = ks * 256; k < ks * 256 + 256; ++k) {
                    const float w = wa[(size_t)k * 12288 + n];
                    const float c0 = p->c[k], c1 = p->c[2048 + k], c2 = p->c_ctx[k];
                    a0 += c0 * sigmoidf_(c0) * w; a1 += c1 * sigmoidf_(c1) * w; a2 += c2 * sigmoidf_(c2) * w;
                }
                part[(ks * 3 + 0) * 48 + col] = a0; part[(ks * 3 + 1) * 48 + col] = a1; part[(ks * 3 + 2) * 48 + col] = a2;
            }
            __syncthreads();
            if (tid < 144) { const int which = tid / 48, cc = tid - which * 48; float sacc = ba[t * 48 + cc];
#pragma unroll
                for (int q = 0; q < 8; ++q) sacc += part[(q * 3 + which) * 48 + cc];
                mod[(size_t)which * 12288 + t * 48 + cc] = sacc; }
            __syncthreads();
        }
    }
    if (l == 0) {
        float* X = (float*)(ws + WS_X);
        const size_t nl4 = (size_t)NLAT * 2048 / 4, nc4 = (size_t)NCTX * 2048 / 4;
        for (size_t i = gtid; i < nl4; i += gthreads) ((f32x4*)X)[i] = ((const f32x4*)p->x)[i];
        for (size_t i = gtid; i < nc4; i += gthreads) ((f32x4*)X)[nl4 + i] = ((const f32x4*)p->ctx)[i];
        float* tab = (float*)(ws + WS_TAB);
        for (size_t i = gtid; i < 4096; i += gthreads) { const int pos = (int)(i >> 5), j = (int)(i & 31);
            const float inv = powf(10000.0f, -(float)j / 32.0f); const float ang = (float)pos * inv;
            tab[i] = cosf(ang); tab[4096 + i] = sinf(ang); }
    }
}

__device__ __forceinline__ void phase_norm(KP p, int l, int which_norm, int nrows, int wid0) {
    const int tid = tid_fresh(wid0); const int lane = tid & 63, gw = blockIdx.x * 8 + (tid >> 6), nw = gridDim.x * 8;
    unsigned char* ws = launder(p->ws);
    const float* X = (const float*)(ws + WS_X); bf16_t* XN = (bf16_t*)(ws + WS_XN);
    const float* mod = (const float*)(ws + WS_MOD) + (size_t)l * 3 * 12288;
    const float* g = p->norm_g + (size_t)(l * 2 + which_norm) * 2048;
    const int shift_c = which_norm ? 3 : 0, scale_c = which_norm ? 4 : 1;
    for (int row = gw; row < nrows; row += nw) {
        const int which = row < NLAT ? (row >> 13) : 2;
        const float* xr = X + (size_t)row * 2048; const float* mb = mod + (size_t)which * 12288;
        f32x4 v[8]; float ss = 0.f;
#pragma unroll
        for (int i = 0; i < 8; ++i) { v[i] = *(const f32x4*)(xr + i * 256 + lane * 4); ss += v[i][0] * v[i][0] + v[i][1] * v[i][1] + v[i][2] * v[i][2] + v[i][3] * v[i][3]; }
        ss = wave_sum(ss);
        const float rstd = rsqrtf(ss * (1.0f / 2048.0f) + EPSF);
#pragma unroll
        for (int i = 0; i < 8; ++i) { const int c = i * 256 + lane * 4;
            const f32x4 gg = *(const f32x4*)(g + c), sh = *(const f32x4*)(mb + shift_c * 2048 + c), sc = *(const f32x4*)(mb + scale_c * 2048 + c);
            float o[4];
#pragma unroll
            for (int j = 0; j < 4; ++j) o[j] = v[i][j] * rstd * gg[j] * (1.0f + sc[j]) + sh[j];
            u32x2 w; w.x = pk2(o[0], o[1]); w.y = pk2(o[2], o[3]); *(u32x2*)(XN + (size_t)row * 2048 + c) = w;
            if (which_norm == 0) { int d = 0; d = __builtin_amdgcn_cvt_pk_fp8_f32(fminf(fmaxf(o[0], -448.f), 448.f), fminf(fmaxf(o[1], -448.f), 448.f), d, false);
                d = __builtin_amdgcn_cvt_pk_fp8_f32(fminf(fmaxf(o[2], -448.f), 448.f), fminf(fmaxf(o[3], -448.f), 448.f), d, true); *(unsigned*)(ws + WS_XN8 + (size_t)row * 2048 + c) = (unsigned)d; } }
    }
}

__device__ __forceinline__ void phase_gates_gemm(KP p, int l, int wid0) {
    const int tid = tid_fresh(wid0); const int lane = tid & 63, gw = blockIdx.x * 8 + (tid >> 6), nw = gridDim.x * 8;
    unsigned char* ws = launder(p->ws);
    const bf16_t* XN = (const bf16_t*)(ws + WS_XN); const bf16_t* WG = (const bf16_t*)(ws + WS_WG); float* GA = (float*)(ws + WS_GATES);
    const int q4 = lane >> 4, c = lane & 15;
    const float gb0 = p->a_gate_b[l * 32 + c], gb1 = p->a_gate_b[l * 32 + 16 + c];
    for (int task = gw; task < MR / 16; task += nw) {
        const int r0 = task * 16;
        f32x4 acc0 = {0.f, 0.f, 0.f, 0.f}, acc1 = {0.f, 0.f, 0.f, 0.f};
        const bf16_t* ap = XN + (size_t)(r0 + c) * 2048 + 8 * q4; const bf16_t* b0 = WG + (size_t)c * 2048 + 8 * q4; const bf16_t* b1 = b0 + 16 * 2048;
#pragma unroll 4
        for (int ks = 0; ks < 64; ++ks) { const bf16x8 a = *(const bf16x8*)(ap + ks * 32), x0 = *(const bf16x8*)(b0 + ks * 32), x1 = *(const bf16x8*)(b1 + ks * 32);
            acc0 = mfma16(a, x0, acc0); acc1 = mfma16(a, x1, acc1); }
#pragma unroll
        for (int r = 0; r < 4; ++r) {
            const float v0 = acc0[r] + gb0, v1 = acc1[r] + gb1;
            GA[(size_t)(r0 + 4 * q4 + r) * 32 + c] = (c >= 8) ? logsigmoidf_(v0) : v0; GA[(size_t)(r0 + 4 * q4 + r) * 32 + 16 + c] = (c >= 8) ? logsigmoidf_(v1) : v1; }
    }
}

__device__ __forceinline__ void phase_e1(KP p, int l, int wid0) {
    const int tid = tid_fresh(wid0); const int lane = tid & 63, gw = blockIdx.x * 8 + (tid >> 6), nw = gridDim.x * 8;
    unsigned char* ws = launder(p->ws);
    bf16_t* PQ = (bf16_t*)(ws + WS_PQ); bf16_t* PK = (bf16_t*)(ws + WS_PK); bf16_t* CQ = (bf16_t*)(ws + WS_CQ); bf16_t* CK = (bf16_t*)(ws + WS_CK);
    bf16_t* BB = (bf16_t*)(ws + WS_BB); const bf16_t* BC = (const bf16_t*)(ws + WS_BC); const bf16_t* BX = (const bf16_t*)(ws + WS_BX);
    float* GA = (float*)(ws + WS_GATES); const float* tab = (const float*)(ws + WS_TAB);
    const float* gq = p->c_qk_g + (size_t)(l * 2 + 0) * 128; const float* gk = p->c_qk_g + (size_t)(l * 2 + 1) * 128;
    const float* cw = p->b_conv + (size_t)l * 3 * 2048;
    float gqv[8], gkv[8];
#pragma unroll
    for (int j = 0; j < 8; ++j) { gqv[j] = gq[(lane & 15) * 8 + j] * 0.08838834764831845f; gkv[j] = gk[(lane & 15) * 8 + j]; }
    for (int row = gw; row < MR; row += nw) {
        if (row < NLAT) {
            const int s = row & 8191, gr = s >> 6, gc = s & 63;
#pragma unroll
            for (int it = 0; it < 2; ++it) {
                const int unit = it * 64 + lane, h = unit >> 4, hf = (unit >> 3) & 1, j4 = unit & 7;
                const int off = h * 128 + hf * 64 + j4 * 4, pos = hf ? gc : gr;
                const f32x4 cs = *(const f32x4*)(tab + pos * 32 + j4 * 4), sn = *(const f32x4*)(tab + 4096 + pos * 32 + j4 * 4);
#pragma unroll
                for (int tsel = 0; tsel < 2; ++tsel) { bf16_t* T = (tsel ? PK : PQ) + (size_t)row * 1024 + off;
                    const u32x2 u1 = *(const u32x2*)T, u2 = *(const u32x2*)(T + 32);
                    const float a0 = bflo(u1.x), a1 = bfhi(u1.x), a2 = bflo(u1.y), a3 = bfhi(u1.y), b0 = bflo(u2.x), b1 = bfhi(u2.x), b2 = bflo(u2.y), b3 = bfhi(u2.y);
                    u32x2 o1, o2;
                    o1.x = pk2(a0 * cs[0] - b0 * sn[0], a1 * cs[1] - b1 * sn[1]); o1.y = pk2(a2 * cs[2] - b2 * sn[2], a3 * cs[3] - b3 * sn[3]);
                    o2.x = pk2(b0 * cs[0] + a0 * sn[0], b1 * cs[1] + a1 * sn[1]); o2.y = pk2(b2 * cs[2] + a2 * sn[2], b3 * cs[3] + a3 * sn[3]);
                    *(u32x2*)T = o1; *(u32x2*)(T + 32) = o2; }
            }
        }
#pragma unroll
        for (int tsel = 0; tsel < 2; ++tsel) {
            bf16_t* T = (tsel ? CK : CQ) + (size_t)row * 2048;
#pragma unroll
            for (int ps = 0; ps < 4; ++ps) {
                const u32x4 w = *(const u32x4*)(T + ps * 512 + lane * 8);
                float v[8] = {bflo(w.x), bfhi(w.x), bflo(w.y), bfhi(w.y), bflo(w.z), bfhi(w.z), bflo(w.w), bfhi(w.w)};
                float ss = 0.f;
#pragma unroll
                for (int j = 0; j < 8; ++j) ss += v[j] * v[j];
                ss += __shfl_xor(ss, 1); ss += __shfl_xor(ss, 2); ss += __shfl_xor(ss, 4); ss += __shfl_xor(ss, 8);
                const float rstd = rsqrtf(ss * (1.0f / 128.0f) + EPSF);
#pragma unroll
                for (int j = 0; j < 8; ++j) v[j] = v[j] * rstd * (tsel ? gkv[j] : gqv[j]);
                u32x4 o; o.x = pk2(v[0], v[1]); o.y = pk2(v[2], v[3]); o.z = pk2(v[4], v[5]); o.w = pk2(v[6], v[7]);
                *(u32x4*)(T + ps * 512 + lane * 8) = o;
            }
        }
        {
            int pos, len; if (row < NLAT) { pos = row & 8191; len = SEQ; } else { pos = (row - NLAT) & 255; len = CTXL; }
            const bool hp = pos > 0, hn = pos < len - 1;
#pragma unroll
            for (int ps = 0; ps < 4; ++ps) {
                const int c = ps * 512 + lane * 8; const size_t o = (size_t)row * 2048 + c;
                const u32x4 bb = *(const u32x4*)(BB + o), c1 = *(const u32x4*)(BC + o), x1 = *(const u32x4*)(BX + o);
                u32x4 c0 = {0u, 0u, 0u, 0u}, x0 = c0, c2 = c0, x2 = c0;
                if (hp) { c0 = *(const u32x4*)(BC + o - 2048); x0 = *(const u32x4*)(BX + o - 2048); }
                if (hn) { c2 = *(const u32x4*)(BC + o + 2048); x2 = *(const u32x4*)(BX + o + 2048); }
                const unsigned bw[4] = {bb.x, bb.y, bb.z, bb.w}, c0w[4] = {c0.x, c0.y, c0.z, c0.w}, c1w[4] = {c1.x, c1.y, c1.z, c1.w}, c2w[4] = {c2.x, c2.y, c2.z, c2.w};
                const unsigned x0w[4] = {x0.x, x0.y, x0.z, x0.w}, x1w[4] = {x1.x, x1.y, x1.z, x1.w}, x2w[4] = {x2.x, x2.y, x2.z, x2.w};
                unsigned ow[4];
#pragma unroll
                for (int q = 0; q < 4; ++q) {
                    const int cc = c + 2 * q;
                    const float w00 = cw[cc], w01 = cw[cc + 1], w10 = cw[2048 + cc], w11 = cw[2048 + cc + 1], w20 = cw[4096 + cc], w21 = cw[4096 + cc + 1];
                    const float ylo = bflo(bw[q]) * (bflo(c0w[q]) * bflo(x0w[q]) * w00 + bflo(c1w[q]) * bflo(x1w[q]) * w10 + bflo(c2w[q]) * bflo(x2w[q]) * w20);
                    const float yhi = bfhi(bw[q]) * (bfhi(c0w[q]) * bfhi(x0w[q]) * w01 + bfhi(c1w[q]) * bfhi(x1w[q]) * w11 + bfhi(c2w[q]) * bfhi(x2w[q]) * w21);
                    ow[q] = pk2(ylo, yhi);
                }
                u32x4 ov; ov.x = ow[0]; ov.y = ow[1]; ov.z = ow[2]; ov.w = ow[3];
                *(u32x4*)(BB + o) = ov;
            }
        }
    }
}

constexpr int ML_QS = 0, ML_KS = 17408, ML_KET = 34816, ML_VT = 53248, ML_SS = 60160, ML_CT = 69376, ML_CTSZ = 13056;
__device__ __forceinline__ int ml_row(int pp, int b, int dir) {
    if (pp < 256) { const int j = dir ? 255 - pp : pp; return NLAT + b * 256 + j; }
    int s = pp - 256; if (dir) s = 8191 - s; return b * 8192 + s;
}
__device__ __forceinline__ void phase_mlstm(KP p, int l, LAS unsigned char* lds, int wid0) {
    const int tid = tid_fresh(wid0), lane = tid & 63, w = __builtin_amdgcn_readfirstlane(tid >> 6), q4 = lane >> 4, c16 = lane & 15;
    unsigned char* ws = launder(p->ws);
    const bf16_t* PQ = (const bf16_t*)(ws + WS_PQ); const bf16_t* PK = (const bf16_t*)(ws + WS_PK); const bf16_t* PV = (const bf16_t*)(ws + WS_PV);
    const float* GA = (const float*)(ws + WS_GATES);
    for (int task = blockIdx.x; task < 256; task += gridDim.x) {
        const int xq = task & 7, yq = task >> 3; const int bh = 2 * xq + (yq >> 4), dir = (yq >> 3) & 1, sl = yq & 7; const int b = bh >> 3, h = bh & 7;
        bf16_t* H = (bf16_t*)(ws + (dir ? WS_BX : WS_BC));
        float* SCN = (float*)(ws + WS_SCAN) + (size_t)task * 3 * 8448;
        __syncthreads();
        for (int cc = w; cc < 132; cc += 8) {
            const int r = ml_row(cc * 64 + lane, b, dir);
            const float li = GA[(size_t)r * 32 + (2 * dir) * 8 + h], lf = GA[(size_t)r * 32 + (2 * dir + 1) * 8 + h];
            float bc = lf;
#pragma unroll
            for (int o = 1; o < 64; o <<= 1) { const float t = __shfl_up(bc, o); if (lane >= o) bc += t; }
            const float a = li - bc;
            float pm = a;
#pragma unroll
            for (int o = 1; o < 64; o <<= 1) { const float t = __shfl_up(pm, o); if (lane >= o) pm = fmaxf(pm, t); }
            SCN[cc * 64 + lane] = bc; SCN[8448 + cc * 64 + lane] = a; SCN[2 * 8448 + cc * 64 + lane] = pm;
        }
        for (int i = tid; i < 16 * 32; i += NTHREADS) { const int r = 32 + (i >> 5), cdw = i & 31; *(LAS unsigned*)(lds + ML_VT + r * 144 + cdw * 4) = (r == 32) ? 0x3f803f80u : 0u; }
        for (int i = tid; i < 2 * ML_CTSZ / 4; i += NTHREADS) *(LAS unsigned*)(lds + ML_CT + i * 4) = 0u;
        __syncthreads();
        float m = 0.f;
        f32x4 Cst[3];
#pragma unroll
        for (int i = 0; i < 3; ++i) Cst[i] = (f32x4){0.f, 0.f, 0.f, 0.f};
        u32x4 qreg[2], kreg[2], vreg; float bc, a, pm;
        const int qrow_l = lane >> 4, qpc = lane & 15, vrow_l = lane >> 2, vpc = lane & 3;
        {
#pragma unroll
          for (int i = 0; i < 2; ++i) { const int r = ml_row(8 * w + 4 * i + qrow_l, b, dir);
              qreg[i] = *(const u32x4*)(PQ + (size_t)r * 1024 + h * 128 + qpc * 8); kreg[i] = *(const u32x4*)(PK + (size_t)r * 1024 + h * 128 + qpc * 8); }
          if (w < 4) { const int r = ml_row(16 * w + vrow_l, b, dir); vreg = *(const u32x4*)(PV + (size_t)r * 2048 + h * 256 + sl * 32 + vpc * 8); }
          bc = SCN[lane]; a = SCN[8448 + lane]; pm = SCN[2 * 8448 + lane]; }
        for (int c = 0; c < 132; ++c) {
            const float total = __uint_as_float((unsigned)__builtin_amdgcn_readlane((int)__float_as_uint(bc), 63)), pmall = __uint_as_float((unsigned)__builtin_amdgcn_readlane((int)__float_as_uint(pm), 63));
            const float mx = fmaxf(m, pm);
            const float mrow = bc + mx;
            const float winter = __expf(m - mx);
            const float m_new = total + fmaxf(m, pmall);
            const float decay = __expf(total + m - m_new);
            const float kscale = __expf(total + a - m_new);
            const float a_cur = a;
#pragma unroll
            for (int i = 0; i < 2; ++i) { const int sr = 8 * w + 4 * i + qrow_l;
                *(LAS u32x4*)(lds + ML_QS + sr * 272 + qpc * 16) = qreg[i];
                *(LAS u32x4*)(lds + ML_KS + sr * 272 + qpc * 16) = kreg[i]; }
            if (w < 4) { const unsigned vw[4] = {vreg.x, vreg.y, vreg.z, vreg.w}; const int sv = 16 * w + vrow_l;
#pragma unroll
                for (int j = 0; j < 4; ++j) { const int e = vpc * 8 + 2 * j;
                    *(LAS bf16_t*)(lds + ML_VT + e * 144 + sv * 2) = (bf16_t)(vw[j] & 0xffffu);
                    *(LAS bf16_t*)(lds + ML_VT + (e + 1) * 144 + sv * 2) = (bf16_t)(vw[j] >> 16); } }
            if (w == 1) *(LAS float*)(lds + ML_SS + 256 + lane * 4) = kscale;
            if (c + 1 < 132) { const int p0 = (c + 1) * 64;
#pragma unroll
                for (int i = 0; i < 2; ++i) { const int r = ml_row(p0 + 8 * w + 4 * i + qrow_l, b, dir);
                    qreg[i] = *(const u32x4*)(PQ + (size_t)r * 1024 + h * 128 + qpc * 8); kreg[i] = *(const u32x4*)(PK + (size_t)r * 1024 + h * 128 + qpc * 8); }
                if (w < 4) { const int r = ml_row(p0 + 16 * w + vrow_l, b, dir); vreg = *(const u32x4*)(PV + (size_t)r * 2048 + h * 256 + sl * 32 + vpc * 8); }
                bc = SCN[p0 + lane]; a = SCN[8448 + p0 + lane]; pm = SCN[2 * 8448 + p0 + lane]; }
            if (w == 0) *(LAS float*)(lds + ML_SS + lane * 4) = a_cur;
            LDS_BARRIER();
            {
                const int tr = w >> 1, part = w & 1;
                const LAS unsigned char* CTc = lds + ML_CT + (c & 1) * ML_CTSZ;
                bf16x8 aq[4];
#pragma unroll
                for (int ks = 0; ks < 4; ++ks) aq[ks] = *(const LAS bf16x8*)(lds + ML_QS + (16 * tr + c16) * 272 + (ks * 32 + 8 * q4) * 2);
                float wi_t[4], mrow_t[4];
#pragma unroll
                for (int r = 0; r < 4; ++r) { const int t = 16 * tr + 4 * q4 + r; wi_t[r] = __shfl(winter, t); mrow_t[r] = __shfl(mrow, t); }
                f32x4 accA = {0.f, 0.f, 0.f, 0.f}, accD = {0.f, 0.f, 0.f, 0.f};
#pragma unroll
                for (int ks = 0; ks < 4; ++ks) {
                    const bf16x8 b1 = *(const LAS bf16x8*)(CTc + (16 * part + c16) * 272 + (ks * 32 + 8 * q4) * 2);
                    const bf16x8 b2 = *(const LAS bf16x8*)(CTc + (32 + c16) * 272 + (ks * 32 + 8 * q4) * 2);
                    accA = mfma16(aq[ks], b1, accA); accD = mfma16(aq[ks], b2, accD); }
#pragma unroll
                for (int r = 0; r < 4; ++r) { accA[r] *= wi_t[r]; accD[r] *= wi_t[r]; }
                const int tq = 16 * tr + c16;
                const float nmx = -__shfl(mx, tq);
#pragma unroll
                for (int kk = 0; kk < 2; ++kk) {
                    if (2 * kk <= tr) {
                        f32x4 s0 = {0.f, 0.f, 0.f, 0.f}, s1 = {0.f, 0.f, 0.f, 0.f};
#pragma unroll
                        for (int ks = 0; ks < 4; ++ks) { const bf16x8 ka = *(const LAS bf16x8*)(lds + ML_KS + (32 * kk + c16) * 272 + (ks * 32 + 8 * q4) * 2); s0 = mfma16(ka, aq[ks], s0); }
                        if (2 * kk + 1 <= tr) {
#pragma unroll
                            for (int ks = 0; ks < 4; ++ks) { const bf16x8 ka = *(const LAS bf16x8*)(lds + ML_KS + (32 * kk + 16 + c16) * 272 + (ks * 32 + 8 * q4) * 2); s1 = mfma16(ka, aq[ks], s1); }
                        }
                        const f32x4 a0 = *(const LAS f32x4*)(lds + ML_SS + (32 * kk + 4 * q4) * 4), a1 = *(const LAS f32x4*)(lds + ML_SS + (32 * kk + 16 + 4 * q4) * 4);
                        float pe[8];
#pragma unroll
                        for (int r = 0; r < 4; ++r) { const int sp0 = 32 * kk + 4 * q4 + r, sp1 = sp0 + 16;
                            pe[r] = (sp0 <= tq) ? s0[r] * __expf(a0[r] + nmx) : 0.f; pe[4 + r] = (sp1 <= tq) ? s1[r] * __expf(a1[r] + nmx) : 0.f; }
                        u32x4 pw; pw.x = pk2(pe[0], pe[1]); pw.y = pk2(pe[2], pe[3]); pw.z = pk2(pe[4], pe[5]); pw.w = pk2(pe[6], pe[7]);
                        const bf16x8 pf = __builtin_bit_cast(bf16x8, pw);
                        const u32x2 v1l = *(const LAS u32x2*)(lds + ML_VT + (16 * part + c16) * 144 + (32 * kk + 4 * q4) * 2), v1h = *(const LAS u32x2*)(lds + ML_VT + (16 * part + c16) * 144 + (32 * kk + 16 + 4 * q4) * 2);
                        const u32x2 v2l = *(const LAS u32x2*)(lds + ML_VT + (32 + c16) * 144 + (32 * kk + 4 * q4) * 2), v2h = *(const LAS u32x2*)(lds + ML_VT + (32 + c16) * 144 + (32 * kk + 16 + 4 * q4) * 2);
                        u32x4 bw1, bw2; bw1.x = v1l.x; bw1.y = v1l.y; bw1.z = v1h.x; bw1.w = v1h.y; bw2.x = v2l.x; bw2.y = v2l.y; bw2.z = v2h.x; bw2.w = v2h.y;
                        accA = mfma16(pf, __builtin_bit_cast(bf16x8, bw1), accA); accD = mfma16(pf, __builtin_bit_cast(bf16x8, bw2), accD);
                    }
                }
                if (l == 0 || c >= 4) {
#pragma unroll
                    for (int r = 0; r < 4; ++r) {
                        const float den = __shfl(accD[r], lane & 48);
                        const float hv = accA[r] / fmaxf(fabsf(den), __expf(-mrow_t[r]));
                        const int t = 16 * tr + 4 * q4 + r; const int row = ml_row(c * 64 + t, b, dir);
                        H[(size_t)row * 2048 + h * 256 + sl * 32 + 16 * part + c16] = f2bf(hv);
                    }
                }
            }
            {
                LAS unsigned char* CTn = lds + ML_CT + ((c + 1) & 1) * ML_CTSZ;
                bf16x8 ak[2];
#pragma unroll
                for (int k2 = 0; k2 < 2; ++k2) {
                    const f32x4 sc0 = *(const LAS f32x4*)(lds + ML_SS + 256 + (k2 * 32 + 8 * q4) * 4), sc1 = *(const LAS f32x4*)(lds + ML_SS + 256 + (k2 * 32 + 8 * q4 + 4) * 4);
                    float kv[8];
#pragma unroll
                    for (int j = 0; j < 8; ++j) kv[j] = bf2f((unsigned)*(const LAS bf16_t*)(lds + ML_KS + (k2 * 32 + 8 * q4 + j) * 272 + (16 * w + c16) * 2)) * (j < 4 ? sc0[j] : sc1[j - 4]);
                    u32x4 kw; kw.x = pk2(kv[0], kv[1]); kw.y = pk2(kv[2], kv[3]); kw.z = pk2(kv[4], kv[5]); kw.w = pk2(kv[6], kv[7]);
                    ak[k2] = __builtin_bit_cast(bf16x8, kw);
                }
#pragma unroll
                for (int ct = 0; ct < 3; ++ct) {
                    Cst[ct] = Cst[ct] * decay;
#pragma unroll
                    for (int k2 = 0; k2 < 2; ++k2) { const bf16x8 bv = *(const LAS bf16x8*)(lds + ML_VT + (16 * ct + c16) * 144 + (k2 * 32 + 8 * q4) * 2); Cst[ct] = mfma16(ak[k2], bv, Cst[ct]); }
                    u32x2 o; o.x = pk2(Cst[ct][0], Cst[ct][1]); o.y = pk2(Cst[ct][2], Cst[ct][3]);
                    *(LAS u32x2*)(CTn + (16 * ct + c16) * 272 + (16 * w + 4 * q4) * 2) = o;
                }
            }
            m = m_new;
            LDS_BARRIER();
        }
    }
}

constexpr int AT_KS = 0, AT_VS = 17408, AT_RPB = 35840;
__device__ __forceinline__ void phase_attn(KP p, int l, LAS unsigned char* lds, int wid0) {
    const int tid = tid_fresh(wid0), lane = tid & 63, w = __builtin_amdgcn_readfirstlane(tid >> 6), q4 = lane >> 4, c16 = lane & 15;
    unsigned char* ws = launder(p->ws);
    bf16_t* CQ = (bf16_t*)(ws + WS_CQ); const bf16_t* CK = (const bf16_t*)(ws + WS_CK); const bf16_t* CV = (const bf16_t*)(ws + WS_CV);
    const int nunits = 2048 + (l == 0 ? 64 : 0);
    for (int u = blockIdx.x; u < nunits; u += gridDim.x) {
        int b, h, qrow = 0, g = 0, ntl = 0, r0a = 0, qbase;  bool is_ctx = u >= 2048;
        if (!is_ctx) { b = u >> 10; h = (u >> 6) & 15; const int rp = u & 63; qrow = 2 * rp + (w >> 2); g = w & 3;
            r0a = min(max(2 * rp - 4, 0), 120); const int r0b = min(max(2 * rp + 1 - 4, 0), 120); ntl = r0b + 8 - r0a;
            qbase = b * 8192 + qrow * 64 + 16 * g; }
        else { const int uu = u - 2048; b = uu >> 5; h = (uu >> 1) & 15; qbase = NLAT + b * 256 + (uu & 1) * 128 + 16 * w; }
        const int r0q = min(max(qrow - 4, 0), 120);
        const int a_g = (g == 0) ? 0 : (g == 1 ? 8 : (g == 2 ? 24 : 32));
        __syncthreads();
        if (!is_ctx) for (int i = tid; i < 465; i += NTHREADS) *(LAS float*)(lds + AT_RPB + i * 4) = p->c_rpb[((size_t)l * 16 + h) * 465 + i];
        bf16x8 qf[4];
#pragma unroll
        for (int ks = 0; ks < 4; ++ks) qf[ks] = *(const bf16x8*)(CQ + (size_t)(qbase + c16) * 2048 + h * 128 + ks * 32 + 8 * q4);
        f32x4 O[8];
#pragma unroll
        for (int i = 0; i < 8; ++i) O[i] = (f32x4){0.f, 0.f, 0.f, 0.f};
        float m_run = -1e30f, l_run = 0.f;
        const int ntiles = ntl + 4;
        u32x4 kreg[2], vreg[2];
        auto tile_row = [&](int t, int key) -> int { return (t < ntl) ? (b * 8192 + (r0a + t) * 64 + key) : (NLAT + b * 256 + (t - ntl) * 64 + key); };
        const int krow_l = lane >> 4, kpc = lane & 15;
        {
#pragma unroll
          for (int i = 0; i < 2; ++i) { const int r = tile_row(0, 8 * w + 4 * i + krow_l); kreg[i] = *(const u32x4*)(CK + (size_t)r * 2048 + h * 128 + kpc * 8); vreg[i] = *(const u32x4*)(CV + (size_t)r * 2048 + h * 128 + kpc * 8); } }
        for (int t = 0; t < ntiles; ++t) {
            LDS_BARRIER();
#pragma unroll
            for (int i = 0; i < 2; ++i) { const int key = 8 * w + 4 * i + krow_l;
                *(LAS u32x4*)(lds + AT_KS + key * 272 + kpc * 16) = kreg[i];
                *(LAS u32x4*)(lds + AT_VS + key * 288 + kpc * 16) = vreg[i]; }
            if (t + 1 < ntiles) {
#pragma unroll
                for (int i = 0; i < 2; ++i) { const int r = tile_row(t + 1, 8 * w + 4 * i + krow_l); kreg[i] = *(const u32x4*)(CK + (size_t)r * 2048 + h * 128 + kpc * 8); vreg[i] = *(const u32x4*)(CV + (size_t)r * 2048 + h * 128 + kpc * 8); } }
            LDS_BARRIER();
            const bool local = t < ntl; const int kr = r0a + t;
            if (local && !(kr >= r0q && kr < r0q + 8)) continue;
            const int npass = local ? 1 : 2;
            for (int ps = 0; ps < npass; ++ps) {
                const int a0 = local ? a_g : ps * 32;
                f32x4 sc[2];
#pragma unroll
                for (int ct = 0; ct < 2; ++ct) { sc[ct] = (f32x4){0.f, 0.f, 0.f, 0.f};
#pragma unroll
                    for (int ks = 0; ks < 4; ++ks) { const bf16x8 ka = *(const LAS bf16x8*)(lds + AT_KS + (a0 + 16 * ct + c16) * 272 + (ks * 32 + 8 * q4) * 2); sc[ct] = mfma16(ka, qf[ks], sc[ct]); } }
                if (local) {
                    const int qc = 16 * g + c16, col0 = min(max(qc - 8, 0), 48); const int dr = kr - qrow + 7;
#pragma unroll
                    for (int ct = 0; ct < 2; ++ct)
#pragma unroll
                        for (int r = 0; r < 4; ++r) { const int kc = a0 + 16 * ct + 4 * q4 + r; const bool valid = (kc >= col0) && (kc < col0 + 16);
                            const int dc = min(max(kc - qc + 15, 0), 30);
                            const float bias = *(const LAS float*)(lds + AT_RPB + (dr * 31 + dc) * 4);
                            sc[ct][r] = valid ? sc[ct][r] + bias : -1e30f; }
                }
                float mx = fmaxf(fmaxf(fmaxf(sc[0][0], sc[0][1]), fmaxf(sc[0][2], sc[0][3])), fmaxf(fmaxf(sc[1][0], sc[1][1]), fmaxf(sc[1][2], sc[1][3])));
                mx = fmaxf(mx, __shfl_xor(mx, 16)); mx = fmaxf(mx, __shfl_xor(mx, 32));
                const float m_new = fmaxf(m_run, mx);
                const float alpha = __expf(m_run - m_new);
                float pe[8]; float psum = 0.f;
#pragma unroll
                for (int ct = 0; ct < 2; ++ct)
#pragma unroll
                    for (int r = 0; r < 4; ++r) { const float e = __expf(sc[ct][r] - m_new); pe[ct * 4 + r] = e; psum += e; }
                psum += __shfl_xor(psum, 16); psum += __shfl_xor(psum, 32);
                l_run = l_run * alpha + psum; m_run = m_new;
                bf16x8 pf; { u32x4 pw; pw.x = pk2(pe[0], pe[1]); pw.y = pk2(pe[2], pe[3]); pw.z = pk2(pe[4], pe[5]); pw.w = pk2(pe[6], pe[7]); pf = __builtin_bit_cast(bf16x8, pw); }
                float al[4];
#pragma unroll
                for (int r = 0; r < 4; ++r) al[r] = __shfl(alpha, 4 * q4 + r);
#pragma unroll
                for (int dt = 0; dt < 8; ++dt) {
#pragma unroll
                    for (int r = 0; r < 4; ++r) O[dt][r] *= al[r];
                    const s16x4 lo = __builtin_amdgcn_ds_read_tr16_b64_v4i16((LAS s16x4*)(lds + AT_VS + (a0 + 4 * q4 + (c16 >> 2)) * 288 + (16 * dt + 4 * (c16 & 3)) * 2));
                    const s16x4 hi = __builtin_amdgcn_ds_read_tr16_b64_v4i16((LAS s16x4*)(lds + AT_VS + (a0 + 16 + 4 * q4 + (c16 >> 2)) * 288 + (16 * dt + 4 * (c16 & 3)) * 2));
                    const bf16x8 bw = __builtin_shufflevector(lo, hi, 0, 1, 2, 3, 4, 5, 6, 7);
                    O[dt] = mfma16(pf, bw, O[dt]);
                }
            }
        }
        float linv[4];
#pragma unroll
        for (int r = 0; r < 4; ++r) linv[r] = 1.0f / __shfl(l_run, 4 * q4 + r);
#pragma unroll
        for (int dt = 0; dt < 8; ++dt)
#pragma unroll
            for (int r = 0; r < 4; ++r) CQ[(size_t)(qbase + 4 * q4 + r) * 2048 + h * 128 + 16 * dt + c16] = f2bf(O[dt][r] * linv[r]);
    }
}

__device__ __forceinline__ void phase_e2(KP p, int l, int nrows, int wid0) {
    const int tid = tid_fresh(wid0); const int lane = tid & 63, gw = blockIdx.x * 8 + (tid >> 6), nw = gridDim.x * 8;
    unsigned char* ws = launder(p->ws);
    const bf16_t* HF = (const bf16_t*)(ws + WS_BC); const bf16_t* HB = (const bf16_t*)(ws + WS_BX); bf16_t* PO = (bf16_t*)(ws + WS_PO);
    const float* hg = p->a_hnorm_g + (size_t)l * 2048;
    for (int row = gw; row < nrows; row += nw) {
#pragma unroll
        for (int h = 0; h < 8; ++h) {
            const size_t o = (size_t)row * 2048 + h * 256 + lane * 4;
            const u32x2 f = *(const u32x2*)(HF + o), bb = *(const u32x2*)(HB + o), ov = *(const u32x2*)(PO + o);
            float v[4] = {bflo(f.x) + bflo(bb.x), bfhi(f.x) + bfhi(bb.x), bflo(f.y) + bflo(bb.y), bfhi(f.y) + bfhi(bb.y)};
            float ss = v[0] * v[0] + v[1] * v[1] + v[2] * v[2] + v[3] * v[3];
            ss = wave_sum(ss);
            const float rstd = rsqrtf(ss * (1.0f / 256.0f) + EPSF);
            const f32x4 gg = *(const f32x4*)(hg + h * 256 + lane * 4);
            const float og[4] = {bflo(ov.x), bfhi(ov.x), bflo(ov.y), bfhi(ov.y)};
            float y[4];
#pragma unroll
            for (int j = 0; j < 4; ++j) y[j] = sigmoidf_(og[j]) * v[j] * rstd * gg[j];
            u32x2 wv; wv.x = pk2(y[0], y[1]); wv.y = pk2(y[2], y[3]); *(u32x2*)(PO + o) = wv;
        }
    }
}

constexpr int PE_MAXT = 80;
constexpr int PE_IDX = 0, PE_W = PE_MAXT * 128 * 4, PE_SCR = 2 * PE_MAXT * 128 * 4, PE_SCRSZ = 16 * 132 * 4 + 4096 + 256;
__device__ __forceinline__ unsigned ordkey(float v) { const unsigned u = __float_as_uint(v); return (u & 0x80000000u) ? ~u : (u | 0x80000000u); }
__device__ __forceinline__ void phase_peer(KP p, int l, LAS unsigned char* lds, int wid0) {
    const int tid = tid_fresh(wid0), lane = tid & 63, w = __builtin_amdgcn_readfirstlane(tid >> 6), q4 = lane >> 4, c16 = lane & 15;
    unsigned char* ws = launder(p->ws);
    const bf16_t* QP = (const bf16_t*)(ws + WS_PV); const bf16_t* KEYS = (const bf16_t*)(ws + WS_KEYS);
    const bf16_t* XN = (const bf16_t*)(ws + WS_XN);
    float* X = (float*)(ws + WS_X); const float* mod = (const float*)(ws + WS_MOD) + (size_t)l * 3 * 12288;
    const int ntok = (l == 0) ? MR : NLAT, G = gridDim.x;
    const int per = (ntok + G - 1) / G; const int t_begin = blockIdx.x * per, t_end = min(ntok, t_begin + per);
    for (int tb = t_begin; tb < t_end; tb += PE_MAXT) {
        const int nt = min(PE_MAXT, t_end - tb);
        __syncthreads();
        const int ntask = (nt + 15) >> 4;
        if (w < ntask) {
            int lane_pe1 = lane; asm volatile("" : "+v"(lane_pe1));
            const int lane = lane_pe1, q4 = lane >> 4, c16 = lane & 15;
            LAS unsigned char* scr = lds + PE_SCR + w * PE_SCRSZ;
            LAS float* SC = (LAS float*)scr;
            LAS float* LS = (LAS float*)(scr + 16 * 132 * 4);
            LAS int* LI = (LAS int*)(scr + 16 * 132 * 4 + 2048);
            LAS unsigned char* PT = scr + 16 * 132 * 4 + 4096;
            if (lane < 52) {
                const int L = lane;
                const int ge16 = L >= 16, ge24 = L >= 24, ge29 = L >= 29, ge33 = L >= 33, ge36 = L >= 36, ge38 = L >= 38, ge40 = L >= 40, ge42 = L >= 42;
                int pa = ge16 + ge24 + ge29 + ge33 + ge36 + ge38 + ge40 + ge42; if (ge42) pa = 8 + (L - 42);
                int pb = L - (16 * ge16 + 8 * ge24 + 5 * ge29 + 4 * ge33 + 3 * ge36 + 2 * ge38 + 2 * ge40 + 2 * ge42); if (ge42) pb = 0;
                if (L >= 50) { pa = 15; pb = 15; }
                PT[lane * 2] = (unsigned char)pa; PT[lane * 2 + 1] = (unsigned char)pb;
            }
            const int tok_a = min(tb + 16 * w + c16, t_end - 1);
            const int tkl = lane >> 2, qq = lane & 3;
            for (int h = 0; h < 8; ++h) {
                for (int pp = 0; pp < 2; ++pp) {
                    const int hp = 2 * h + pp;
                    bf16x8 af[4];
#pragma unroll
                    for (int ks = 0; ks < 4; ++ks) af[ks] = *(const bf16x8*)(QP + (size_t)tok_a * 2048 + h * 256 + pp * 128 + ks * 32 + 8 * q4);
#pragma unroll 2
                    for (int ct = 0; ct < 8; ++ct) {
                        f32x4 acc = {0.f, 0.f, 0.f, 0.f};
#pragma unroll
                        for (int ks = 0; ks < 4; ++ks) { const bf16x8 bfr = *(const bf16x8*)(KEYS + ((size_t)hp * 128 + 16 * ct + c16) * 128 + ks * 32 + 8 * q4); acc = mfma16(af[ks], bfr, acc); }
#pragma unroll
                        for (int r = 0; r < 4; ++r) SC[(4 * q4 + r) * 132 + 16 * ct + c16] = acc[r];
                    }
                    asm volatile("s_waitcnt lgkmcnt(0)" ::: "memory");
                    unsigned key[32];
#pragma unroll
                    for (int i = 0; i < 8; ++i) { const f32x4 v = *(const LAS f32x4*)(SC + tkl * 132 + 32 * qq + 4 * i);
#pragma unroll
                        for (int j = 0; j < 4; ++j) key[4 * i + j] = (ordkey(v[j]) & ~127u) | (unsigned)(32 * qq + 4 * i + j); }
                    unsigned prev = 0xffffffffu;
#pragma unroll 1
                    for (int r = 0; r < 16; ++r) {
                        unsigned mxk = 0u;
#pragma unroll
                        for (int i = 0; i < 32; ++i) { const unsigned k = key[i] < prev ? key[i] : 0u; mxk = mxk > k ? mxk : k; }
                        unsigned o1 = __shfl_xor(mxk, 1); mxk = mxk > o1 ? mxk : o1; o1 = __shfl_xor(mxk, 2); mxk = mxk > o1 ? mxk : o1;
                        prev = mxk;
                        if (qq == (r & 3)) { const int idx = (int)(mxk & 127u); LS[(pp * 16 + tkl) * 16 + r] = SC[tkl * 132 + idx]; LI[(pp * 16 + tkl) * 16 + r] = idx; }
                    }
                    asm volatile("s_waitcnt lgkmcnt(0)" ::: "memory");
                }
                unsigned ck[13];
#pragma unroll
                for (int i = 0; i < 13; ++i) { const int cidx = qq + 4 * i;
                    if (cidx < 50) { const int a = PT[cidx * 2], bq = PT[cidx * 2 + 1]; const float sv = LS[(0 * 16 + tkl) * 16 + a] + LS[(1 * 16 + tkl) * 16 + bq]; ck[i] = (ordkey(sv) & ~63u) | (unsigned)cidx; }
                    else ck[i] = 0u; }
                unsigned prev = 0xffffffffu; float best0 = 0.f, esum = 0.f; float myexp[4] = {0.f, 0.f, 0.f, 0.f}; int myidx[4] = {0, 0, 0, 0};
#pragma unroll
                for (int r = 0; r < 16; ++r) {
                    unsigned mxk = 0u;
#pragma unroll
                    for (int i = 0; i < 13; ++i) { const unsigned k = ck[i] < prev ? ck[i] : 0u; mxk = mxk > k ? mxk : k; }
                    unsigned o1 = __shfl_xor(mxk, 1); mxk = mxk > o1 ? mxk : o1; o1 = __shfl_xor(mxk, 2); mxk = mxk > o1 ? mxk : o1;
                    prev = mxk;
                    const int cidx = (int)(mxk & 63u); const int a = PT[cidx * 2], bq = PT[cidx * 2 + 1];
                    const float best = LS[(0 * 16 + tkl) * 16 + a] + LS[(1 * 16 + tkl) * 16 + bq];
                    const int eidx = LI[(0 * 16 + tkl) * 16 + a] * 128 + LI[(1 * 16 + tkl) * 16 + bq];
                    if (r == 0) best0 = best;
                    const float e = __expf(best - best0); esum += e;
                    if (qq == (r & 3)) { myexp[r >> 2] = e; myidx[r >> 2] = eidx; }
                }
                const float inv = 1.0f / esum; const int tl = 16 * w + tkl;
                if (tl < nt) {
#pragma unroll
                    for (int i = 0; i < 4; ++i) { const int r = 4 * i + qq;
                        *(LAS int*)(lds + PE_IDX + (tl * 128 + h * 16 + r) * 4) = myidx[i];
                        *(LAS float*)(lds + PE_W + (tl * 128 + h * 16 + r) * 4) = myexp[i] * inv; }
                }
                asm volatile("s_waitcnt lgkmcnt(0)" ::: "memory");
            }
        }
        __syncthreads();
        int lane_pe2 = lane; asm volatile("" : "+v"(lane_pe2));
        for (int tl = w; tl < nt; tl += 8) {
            const int lane = lane_pe2;
            const int row = tb + tl;
            u32x16 xq;
#pragma unroll
            for (int i = 0; i < 4; ++i) { const u32x4 xw = *(const u32x4*)(XN + (size_t)row * 2048 + lane * 32 + i * 8); xq[4 * i] = xw.x; xq[4 * i + 1] = xw.y; xq[4 * i + 2] = xw.z; xq[4 * i + 3] = xw.w; }
            const LAS int* idxp = (const LAS int*)(lds + PE_IDX + tl * 512);
            LAS float* wp = (LAS float*)(lds + PE_W + tl * 512);
            u32x6 bufA[2], bufB[2], bufC[2];
#define PE_ISSUE(buf, TAB, b) do { const int _e0 = idxp[2 * (b)], _e1 = idxp[2 * (b) + 1]; \
                const unsigned char* _r0 = (TAB) + (size_t)_e0 * 1536 + lane * 24; const unsigned char* _r1 = (TAB) + (size_t)_e1 * 1536 + lane * 24; \
                { const u32x4 _a = *(const u32x4*)_r0; const u32x2 _b = *(const u32x2*)(_r0 + 16); buf[0][0] = _a.x; buf[0][1] = _a.y; buf[0][2] = _a.z; buf[0][3] = _a.w; buf[0][4] = _b.x; buf[0][5] = _b.y; } \
                { const u32x4 _a = *(const u32x4*)_r1; const u32x2 _b = *(const u32x2*)(_r1 + 16); buf[1][0] = _a.x; buf[1][1] = _a.y; buf[1][2] = _a.z; buf[1][3] = _a.w; buf[1][4] = _b.x; buf[1][5] = _b.y; } } while (0)
#define PE_CONS_U(buf, b) do { float _p[2]; \
                _Pragma("unroll") for (int _j = 0; _j < 2; ++_j) { const u32x16 _ub = __builtin_bit_cast(u32x16, __builtin_amdgcn_cvt_scalef32_pk32_bf16_fp6(buf[_j], 1.0f)); float _d = 0.f; \
                    _Pragma("unroll") for (int _q = 0; _q < 16; ++_q) _d = dot2bf(_ub[_q], xq[_q], _d); \
                    _p[_j] = _d * (1.0f / 64.0f); } \
                const bool _h32 = (lane & 32) != 0; \
                float _c = _h32 ? _p[1] : _p[0]; const float _cs = _h32 ? _p[0] : _p[1]; _c += __shfl_xor(_cs, 32); \
                _c += __shfl_xor(_c, 16); _c += __shfl_xor(_c, 8); _c += __shfl_xor(_c, 4); _c += __shfl_xor(_c, 2); _c += __shfl_xor(_c, 1); \
                const int _e = 2 * (b) + (lane >> 5); const float _g = wp[_e]; \
                const float _w = _g * 0.5f * _c * (1.0f + erff(_c * 0.70710678118654752f)); \
                if ((lane & 31) == 0) wp[_e] = _w; } while (0)
#define PE_CONS_V(buf, b) do { const f32x2 _w2 = *(const LAS f32x2*)(wp + 2 * (b)); \
                _Pragma("unroll") for (int _j = 0; _j < 2; ++_j) { const f32x32 _vf = __builtin_amdgcn_cvt_scalef32_pk32_f32_fp6(buf[_j], 1.0f); const float _wv = _w2[_j]; \
                    outv += _vf * _wv; } } while (0)
            const unsigned char* TU = ws + WS_PU; const unsigned char* TV = ws + WS_PVW;
            PE_ISSUE(bufA, TU, 0); PE_ISSUE(bufB, TU, 1);
#pragma unroll 1
            for (int b = 0; b < 63; b += 3) {
                PE_ISSUE(bufC, TU, b + 2); PE_CONS_U(bufA, b);
                PE_ISSUE(bufA, TU, b + 3); PE_CONS_U(bufB, b + 1);
                if (b + 4 < 64) PE_ISSUE(bufB, TU, b + 4); else PE_ISSUE(bufB, TV, 0);
                PE_CONS_U(bufC, b + 2);
            }
            PE_ISSUE(bufC, TV, 1);
            PE_CONS_U(bufA, 63);
            asm volatile("s_waitcnt lgkmcnt(0)" ::: "memory");
            f32x32 outv = 0.f;
#pragma unroll 1
            for (int b = 0; b < 63; b += 3) {
                PE_ISSUE(bufA, TV, b + 2); PE_CONS_V(bufB, b);
                PE_ISSUE(bufB, TV, b + 3); PE_CONS_V(bufC, b + 1);
                if (b + 4 < 64) PE_ISSUE(bufC, TV, b + 4);
                PE_CONS_V(bufA, b + 2);
            }
            PE_CONS_V(bufB, 63);
#undef PE_ISSUE
#undef PE_CONS_U
#undef PE_CONS_V
            float out[32];
#pragma unroll
            for (int i = 0; i < 32; ++i) out[i] = outv[i];
            const int which = row < NLAT ? (row >> 13) : 2;
            const float* mg = mod + (size_t)which * 12288 + 5 * 2048;
            float* xrow = X + (size_t)row * 2048; float* orow = (l == 1) ? (p->out + (size_t)row * 2048) : xrow;
#pragma unroll
            for (int hh = 0; hh < 8; ++hh) { const int c = lane * 32 + hh * 4;
                const f32x4 xv = *(const f32x4*)(xrow + c), gv = *(const f32x4*)(mg + c);
                f32x4 ov; ov[0] = xv[0] + gv[0] * out[hh * 4 + 0] * 0.25f; ov[1] = xv[1] + gv[1] * out[hh * 4 + 1] * 0.25f; ov[2] = xv[2] + gv[2] * out[hh * 4 + 2] * 0.25f; ov[3] = xv[3] + gv[3] * out[hh * 4 + 3] * 0.25f;
                *(f32x4*)(orow + c) = ov; }
        }
    }
}

#if !MK_SINGLE
#define LOHI_ARGS , const int lo, const int hi
#define LOHI_PASS , lo, hi
#else
#define LOHI_ARGS
#define LOHI_PASS
#endif
#ifndef PHM
#define PHM 0x7ff
#endif
#if MK_SINGLE
#define IN(k) (((PHM >> (((k) % NPH))) & 1) != 0)
#define SEAM(k) do { if ((k) + 1 < 2 * NPH) xcd_barrier(bar); } while (0)
#else
#define IN(k) (((PHM >> (((k) % NPH))) & 1) && lo <= (k) && (k) < hi)
#define SEAM(k) do { if (IN(k) && IN((k) + 1)) xcd_barrier(bar); } while (0)
#endif
template <int l>
__device__ __forceinline__ void layer_program(KP kp, unsigned char* ws0, LAS unsigned char* lds, const XcdBarrier& bar, const int G, const int wid0 LOHI_ARGS) {
        const int pb = l * NPH;
        const int M2 = (l == 0) ? MR : NLAT;
        if (IN(pb + 0)) { phase_w(launder_p(kp), l, lds, wid0); } SEAM(pb + 0);
        if (IN(pb + 1)) { phase_norm(launder_p(kp), l, 0, MR, wid0); } SEAM(pb + 1);
        if (IN(pb + 2)) { unsigned char* ws = launder(ws0);
            { pg8::PlainOrder S; S.init(ws + WS_XN8, ws + WS_WIN, MR, 72 * 256, 1024, G, (int)blockIdx.x); S.skip_from = 48; S.skip_cnt = 24;
              pg8::EpiProj E{ws};
              pg8::gemm_phase<pg8::EpiProj, pg8::PlainOrder, true>(lds, 1024, S, E, wid0); }
            { pg8::PlainOrder S; S.init(ws + WS_XN, ws + WS_WINB, MR, 24 * 256, 2048, G, (int)blockIdx.x); S.pn_base = 48; S.b_row0 = 48;
              pg8::EpiProj E{ws};
              pg8::gemm_phase<pg8::EpiProj, pg8::PlainOrder, false>(lds, 2048, S, E, wid0); }
        } SEAM(pb + 2);
        if (IN(pb + 3)) { phase_gates_gemm(launder_p(kp), l, wid0); phase_e1(launder_p(kp), l, wid0); } SEAM(pb + 3);
        if (IN(pb + 4)) { phase_mlstm(launder_p(kp), l, lds, wid0); phase_attn(launder_p(kp), l, lds, wid0); } SEAM(pb + 4);
        if (IN(pb + 5)) { phase_e2(launder_p(kp), l, M2, wid0); } SEAM(pb + 5);
        if (IN(pb + 6)) { unsigned char* ws = launder(ws0);
            pg8::BranchOrder S; S.T8 = (const char*)(ws + WS_T8); S.WA = (const char*)(ws + WS_WA);
            S.nM = M2 / 256; S.nN = 8; S.G = G; S.c = (int)blockIdx.x; S.tstep = (size_t)256 * 2048 * 2;
            pg8::EpiMerge E{(bf16_t*)(ws + WS_Y), (const bf16_t*)(ws + WS_GT)};
            pg8::gemm_phase<pg8::EpiMerge, pg8::BranchOrder>(lds, 2048, S, E, wid0);
        } SEAM(pb + 6);
        if (IN(pb + 7)) { unsigned char* ws = launder(ws0);
            pg8::PlainOrder S; S.init(ws + WS_Y, ws + WS_WO, M2, 2048, 2048, G, (int)blockIdx.x);
            pg8::EpiRes E{(float*)(ws + WS_X), (const float*)(ws + WS_MOD) + (size_t)l * 3 * 12288};
            pg8::gemm_phase<pg8::EpiRes, pg8::PlainOrder>(lds, 2048, S, E, wid0);
        } SEAM(pb + 7);
        if (IN(pb + 8)) { phase_norm(launder_p(kp), l, 1, M2, wid0); } SEAM(pb + 8);
        if (IN(pb + 9)) { unsigned char* ws = launder(ws0);
            pg8::PlainOrder S; S.init(ws + WS_XN, ws + WS_WQ, M2, 2048, 2048, G, (int)blockIdx.x);
            pg8::EpiBf E{(bf16_t*)(ws + WS_PV), 2048};
            pg8::gemm_phase<pg8::EpiBf, pg8::PlainOrder>(lds, 2048, S, E, wid0);
        } SEAM(pb + 9);
        if (IN(pb + 10)) { phase_peer(launder_p(kp), l, lds, wid0); } SEAM(pb + 10);
    }
#undef IN
#undef SEAM

__global__ void __launch_bounds__(NTHREADS, 2) fwd_kernel(Params p) {
    extern __shared__ __attribute__((aligned(16))) unsigned char lds_raw[];
    LAS unsigned char* lds = (LAS unsigned char*)lds_raw;
    const int tid = threadIdx.x, G = gridDim.x;
    const int wid0 = __builtin_amdgcn_readfirstlane(tid >> 6);
    KP kp = (KP)__builtin_amdgcn_kernarg_segment_ptr();
    unsigned char* ws0 = kp->ws;
    volatile LAS unsigned* bst = (volatile LAS unsigned*)(lds + LDS_BYTES - 16);
    if (tid == 0) { bst[0] = 0u; bst[1] = 0u; bst[2] = 0u; bst[3] = 0u; }
    __syncthreads();
    XcdBarrier bar; bar.bar = (unsigned*)(ws0 + WS_BAR); bar.x = 0; bar.st = bst;
    if (MK_SINGLE) bar = xcd_barrier_post((unsigned*)(ws0 + WS_BAR), bst);
#if !MK_SINGLE
    const int lo = kp->ph_lo, hi = kp->ph_hi;
#endif
    layer_program<0>(kp, ws0, lds, bar, G, wid0 LOHI_PASS);
    layer_program<1>(kp, ws0, lds, bar, G, wid0 LOHI_PASS);
}

#ifdef CUT
#ifndef DUMP_OFF
#define DUMP_OFF WS_PV
#endif
#ifndef DUMP_F32
#define DUMP_F32 0
#endif
#ifndef DUMP_N
#define DUMP_N ((size_t)NLAT * DM)
#endif
__global__ void dump_kernel(const unsigned char* ws, float* out, size_t n) {
    for (size_t i = (size_t)blockIdx.x * blockDim.x + threadIdx.x; i < n; i += (size_t)gridDim.x * blockDim.x)
        out[i] = (i >= (size_t)DUMP_N) ? 0.f : (DUMP_F32 ? ((const float*)(ws + DUMP_OFF))[i] : bf2f(((const bf16_t*)(ws + DUMP_OFF))[i]));
}
#endif
extern "C" void kernel_launch(void* const* d_in, const int* in_sizes, int n_in, void* d_out, int out_size, void* d_ws, size_t ws_size, hipStream_t stream) {
    static int grid = 0;
    if (grid == 0) {
        if (n_in != 21 || in_sizes[0] != NLAT * DM || out_size != NLAT * DM || ws_size < WS_END) {
            fprintf(stderr, "kernel_launch: unexpected shapes (n_in %d, in0 %d, out %d, ws %zu need %zu); nothing launched\n", n_in, n_in > 0 ? in_sizes[0] : -1, out_size, ws_size, (size_t)WS_END); grid = -1; return; }
        int dev = 0, cus = 0, per_cu = 0;
        if (hipGetDevice(&dev) != hipSuccess || hipDeviceGetAttribute(&cus, hipDeviceAttributeMultiprocessorCount, dev) != hipSuccess) { grid = -1; return; }
        if (hipFuncSetAttribute((const void*)fwd_kernel, hipFuncAttributeMaxDynamicSharedMemorySize, LDS_BYTES) != hipSuccess) { fprintf(stderr, "kernel_launch: hipFuncSetAttribute failed\n"); grid = -1; return; }
        if (hipOccupancyMaxActiveBlocksPerMultiprocessor(&per_cu, (const void*)fwd_kernel, NTHREADS, LDS_BYTES) != hipSuccess || per_cu < 1) { fprintf(stderr, "kernel_launch: occupancy query says %d\n", per_cu); }
        (void)hipGetLastError();
        grid = cus;
    }
    if (grid < 0) return;
    (void)hipMemsetAsync((char*)d_ws, 0, CTL_BYTES, stream);
    Params p{};
    const float** pp = (const float**)&p;
    for (int i = 0; i < 21; ++i) pp[i] = (const float*)d_in[i];
    p.out = (float*)d_out; p.ws = (unsigned char*)d_ws;
#if MK_SINGLE
    p.ph_lo = 0; p.ph_hi = 2 * NPH;
    hipLaunchKernelGGL(fwd_kernel, dim3(grid), dim3(NTHREADS), LDS_BYTES, stream, p);
#else
#ifdef CUT
    for (int k = 0; k <= CUT; ++k) { p.ph_lo = k; p.ph_hi = k + 1; hipLaunchKernelGGL(fwd_kernel, dim3(grid), dim3(NTHREADS), LDS_BYTES, stream, p); }
    hipLaunchKernelGGL(dump_kernel, dim3(1024), dim3(256), 0, stream, (const unsigned char*)d_ws, (float*)d_out, (size_t)NLAT * DM);
#else
    for (int k = 0; k < 2 * NPH; ++k) { p.ph_lo = k; p.ph_hi = k + 1; hipLaunchKernelGGL(fwd_kernel, dim3(grid), dim3(NTHREADS), LDS_BYTES, stream, p); }
#endif
#endif
}
```

```cpp
#include <hip/hip_runtime.h>
#include <stdint.h>
#include <stdio.h>
#include <type_traits>

#ifndef ABL
#define ABL 0
#endif
#ifndef MK_SINGLE
#define MK_SINGLE 1
#endif

#define LAS __attribute__((address_space(3)))
typedef unsigned short bf16_t;
typedef short bf16x8 __attribute__((ext_vector_type(8)));
typedef float f32x4 __attribute__((ext_vector_type(4)));
typedef float f32x2 __attribute__((ext_vector_type(2)));
typedef unsigned u32x4 __attribute__((ext_vector_type(4)));
typedef unsigned u32x2 __attribute__((ext_vector_type(2)));
typedef __bf16 bf2_t __attribute__((ext_vector_type(2)));
typedef int i32x4 __attribute__((ext_vector_type(4)));
typedef int i32x8 __attribute__((ext_vector_type(8)));
typedef float f32x16 __attribute__((ext_vector_type(16)));
typedef float f32x32 __attribute__((ext_vector_type(32)));
typedef unsigned u32x6 __attribute__((ext_vector_type(6)));
typedef __bf16 bf16x32_t __attribute__((ext_vector_type(32)));
typedef unsigned u32x16 __attribute__((ext_vector_type(16)));
typedef short s16x4 __attribute__((ext_vector_type(4)));
#ifndef FP6_INTERLEAVED
#define FP6_INTERLEAVED 1
#endif

constexpr int DM = 2048, NBATCH = 2, SEQ = 8192, CTXL = 256;
constexpr int NLAT = NBATCH * SEQ;
constexpr int NCTX = NBATCH * CTXL;
constexpr int MR = NLAT + NCTX;
constexpr int PROJ_W = 24608;
constexpr int NPROJ = 24576;
constexpr int NTHREADS = 512;
constexpr int LDS_BYTES = 163840;
constexpr int NPH = 11;
constexpr float EPSF = 1e-6f;

constexpr size_t SZ_A = (size_t)MR * 2048 * 2;
constexpr size_t WS_BAR = 0;
constexpr size_t WS_MOD = 16384;
constexpr size_t CTL_BYTES = 16384 + 2 * 3 * 12288 * 4;
constexpr size_t WS_TAB = 311296;
constexpr size_t WS_X = WS_TAB + 32768;
constexpr size_t WS_XN = WS_X + (size_t)MR * 2048 * 4;
constexpr size_t WS_Y = WS_XN + SZ_A;
constexpr size_t WS_XN8 = WS_Y;
constexpr size_t WS_PQ = WS_Y + SZ_A;
constexpr size_t WS_PK = WS_PQ + SZ_A / 2;
constexpr size_t WS_T8 = WS_PK + SZ_A / 2;
constexpr size_t WS_PV = WS_T8 + 0 * SZ_A;
constexpr size_t WS_PO = WS_T8 + 1 * SZ_A;
constexpr size_t WS_CQ = WS_T8 + 2 * SZ_A;
constexpr size_t WS_CK = WS_T8 + 3 * SZ_A;
constexpr size_t WS_CV = WS_T8 + 4 * SZ_A;
constexpr size_t WS_BB = WS_T8 + 5 * SZ_A;
constexpr size_t WS_BC = WS_T8 + 6 * SZ_A;
constexpr size_t WS_BX = WS_T8 + 7 * SZ_A;
constexpr size_t WS_GT = WS_T8 + 8 * SZ_A;
constexpr size_t WS_GATES = WS_GT + 3 * SZ_A;
constexpr size_t WS_WIN = WS_GATES + (size_t)MR * 32 * 4;
constexpr size_t WS_WINB = WS_WIN + (size_t)NPROJ * 2048;
constexpr size_t WS_WG = WS_WIN + (size_t)NPROJ * 2048 * 2;
constexpr size_t SZ_W = (size_t)2048 * 2048 * 2;
constexpr size_t WS_WA = WS_WG + 32 * 2048 * 2;
constexpr size_t WS_WB = WS_WA + SZ_W;
constexpr size_t WS_WC = WS_WB + SZ_W;
constexpr size_t WS_WO = WS_WC + SZ_W;
constexpr size_t WS_WQ = WS_WO + SZ_W;
constexpr size_t WS_KEYS = WS_WQ + SZ_W;
constexpr size_t WS_PU = WS_KEYS + 16 * 128 * 128 * 2;
constexpr size_t WS_PVW = WS_PU + (size_t)16384 * 2048 * 2;
constexpr size_t WS_SCAN = WS_PU + (size_t)16384 * 2048;
constexpr size_t WS_END = WS_PVW + (size_t)16384 * 2048 * 2;

struct Params {
    const float *x, *c, *ctx, *c_ctx, *w_ada, *b_ada, *norm_g, *w_in, *a_gate_b, *a_hnorm_g, *b_conv, *c_qk_g, *c_rpb,
        *w_a_out, *w_b_out, *w_c_out, *w_out, *peer_wq, *peer_keys, *peer_u, *peer_v;
    float* out; unsigned char* ws; int ph_lo, ph_hi;
};
#define CAS __attribute__((address_space(4)))
typedef const CAS Params* KP;
__device__ __forceinline__ KP launder_p(KP q) { asm volatile("" : "+s"(q)); return q; }

__device__ __forceinline__ unsigned char* launder(unsigned char* q) { size_t z = 0; asm volatile("" : "+s"(z)); return q + z; }
__device__ __forceinline__ int tid_fresh(int wid0) { int t = wid0 * 64 + (int)__builtin_amdgcn_mbcnt_hi(~0u, __builtin_amdgcn_mbcnt_lo(~0u, 0u)); asm volatile("" : "+v"(t)); return t; }

__device__ __forceinline__ float bf2f(unsigned b) { return __uint_as_float(b << 16); }
__device__ __forceinline__ float bflo(unsigned w) { return __uint_as_float(w << 16); }
__device__ __forceinline__ float bfhi(unsigned w) { return __uint_as_float(w & 0xffff0000u); }
__device__ __forceinline__ unsigned pk2(float lo, float hi) { f32x2 v = {lo, hi}; bf2_t b = __builtin_convertvector(v, bf2_t); return __builtin_bit_cast(unsigned, b); }
__device__ __forceinline__ bf16_t f2bf(float f) { return (bf16_t)(pk2(f, 0.f) & 0xffffu); }
__device__ __forceinline__ f32x4 mfma16(bf16x8 a, bf16x8 b, f32x4 c) { return __builtin_amdgcn_mfma_f32_16x16x32_bf16(a, b, c, 0, 0, 0); }
__device__ __forceinline__ float dot2bf(unsigned a, unsigned b, float c) { return __builtin_amdgcn_fdot2_f32_bf16(__builtin_bit_cast(bf2_t, a), __builtin_bit_cast(bf2_t, b), c, false); }
#define LDS_BARRIER() do { asm volatile("s_waitcnt lgkmcnt(0)" ::: "memory"); __builtin_amdgcn_s_barrier(); asm volatile("" ::: "memory"); } while (0)
__device__ __forceinline__ float wave_sum(float v) {
#pragma unroll
    for (int o = 32; o >= 1; o >>= 1) v += __shfl_xor(v, o);
    return v;
}
__device__ __forceinline__ float sigmoidf_(float v) { return 1.0f / (1.0f + __expf(-v)); }
__device__ __forceinline__ float logsigmoidf_(float v) { return fminf(v, 0.f) - log1pf(__expf(-fabsf(v))); }

#define XB_TMO      128
#define XB_XCNT(j)  (256  + 64 * (j))
#define XB_XSUB(j)  (1280 + 64 * (j))
#define XB_XGEN(j)  (2304 + 64 * (j))
#define XB_TOP      3328
#define XB_TOPGEN   3392
#define XCD_BAR_WORDS 3456
#define XB_SPIN_CAP (1u << 22)
__device__ __forceinline__ unsigned xb_ld(unsigned* p)              { return __hip_atomic_load(p, __ATOMIC_RELAXED, __HIP_MEMORY_SCOPE_AGENT); }
__device__ __forceinline__ unsigned xb_add(unsigned* p, unsigned v) { return __hip_atomic_fetch_add(p, v, __ATOMIC_RELAXED, __HIP_MEMORY_SCOPE_AGENT); }
__device__ __forceinline__ unsigned xb_xcc_id() { return (unsigned)__builtin_amdgcn_s_getreg((3 << 11) | 20) & 0xFu; }
#define XB_SPIN(cond, bar) do { unsigned _sp = 0; while (cond) { __builtin_amdgcn_s_sleep(1); \
    if ((++_sp & 255u) == 0u) { if (xb_ld(&(bar)[XB_TMO])) break; if (_sp > XB_SPIN_CAP) { atomicAdd(&(bar)[XB_TMO], 1u); break; } } } } while (0)
struct XcdBarrier { unsigned* bar; unsigned x; volatile LAS unsigned* st; };
__device__ __forceinline__ XcdBarrier xcd_barrier_post(unsigned* bar, volatile LAS unsigned* st) {
    XcdBarrier b; b.bar = bar; b.x = xb_xcc_id(); b.st = st;
    if (threadIdx.x == 0) (void)xb_add(&bar[XB_XCNT(b.x)], 1u);
    return b;
}
__device__ __forceinline__ void xcd_barrier_complete(unsigned* bar, unsigned x, unsigned& nloc, unsigned& nx) {
    const unsigned G = gridDim.x * gridDim.y * gridDim.z;
    unsigned sum, cnt, mine, sp = 0u;
    for (;;) {
        sum = 0u; cnt = 0u; mine = 0u;
#pragma unroll
        for (unsigned j = 0; j < 16; ++j) { const unsigned c = xb_ld(&bar[XB_XCNT(j)]); sum += c; cnt += (c > 0u) ? 1u : 0u; mine = (j == x) ? c : mine; }
        if (sum == G) break;
        __builtin_amdgcn_s_sleep(1);
        if ((++sp & 255u) == 0u) { if (xb_ld(&bar[XB_TMO])) break; if (sp > XB_SPIN_CAP) { atomicAdd(&bar[XB_TMO], 1u); break; } }
    }
    nloc = mine > 0u ? mine : 1u; nx = cnt > 0u ? cnt : 1u;
}
__device__ __forceinline__ void xcd_barrier(const XcdBarrier& b) {
    asm volatile("s_waitcnt vmcnt(0)" ::: "memory");
    __syncthreads();
    if (threadIdx.x == 0) {
        unsigned* bar = b.bar;
        __builtin_amdgcn_s_waitcnt(0);
        unsigned nloc = b.st[0], nx = b.st[1];
        if (nloc == 0u) { xcd_barrier_complete(bar, b.x, nloc, nx); b.st[0] = nloc; b.st[1] = nx; }
        const unsigned old = xb_add(&bar[XB_XSUB(b.x)], 1u);
        const unsigned gen = old / nloc;
        if (old + 1u == (gen + 1u) * nloc) {
            __builtin_amdgcn_fence(__ATOMIC_RELEASE, "agent");
            asm volatile("s_waitcnt vmcnt(0)" ::: "memory");
            const unsigned og = xb_add(&bar[XB_TOP], 1u);
            const unsigned tg = og / nx;
            if (og + 1u == (tg + 1u) * nx) xb_add(&bar[XB_TOPGEN], 1u);
            else XB_SPIN(xb_ld(&bar[XB_TOPGEN]) == tg, bar);
            __builtin_amdgcn_fence(__ATOMIC_ACQUIRE, "agent");
            xb_add(&bar[XB_XGEN(b.x)], 1u);
            asm volatile("s_waitcnt vmcnt(0)" ::: "memory");
        } else {
            XB_SPIN(xb_ld(&bar[XB_XGEN(b.x)]) == gen, bar);
            __builtin_amdgcn_fence(__ATOMIC_ACQUIRE, "agent");
            asm volatile("s_waitcnt vmcnt(0)" ::: "memory");
        }
    }
    __syncthreads();
}

namespace pg8 {
constexpr int BM = 256, BK = 64, HALF = 128, HTB = HALF * BK * 2, STAGE_BYTES = 8 * HTB, NXCD = 8, WGM = 8;
__host__ __device__ __forceinline__ int lds_byte(int r, int c) { const int st = (r >> 4) * 2 + (c >> 5), rr = r & 15, cc = c & 31, ob = rr * 64 + cc * 2; return st * 1024 + (ob ^ (((ob >> 9) & 1) << 5)); }
__host__ __device__ __forceinline__ void stage_rc(int b, int& R, int& C) { const int st = b / 1024, sb = b % 1024, swz = sb ^ (((sb >> 9) & 1) << 5); R = (st >> 1) * 16 + swz / 64; C = (st & 1) * 32 + (swz % 64) / 2; }
__host__ __device__ __forceinline__ int perm32(int rho) { const int n = rho >> 4, i = rho & 15; return 8 * (i >> 2) + 4 * n + (i & 3); }

struct Unit { int pm, pn, br; const char* A; const char* B; };

__device__ __forceinline__ bool tile_of(int L, int nM, int nN, int& pm, int& pn) {
    const int nwg = nM * nN; if (L >= nwg) return false;
    int wgid = L; { const int q = nwg / NXCD, r = nwg % NXCD, xcd = wgid % NXCD, off = wgid / NXCD; wgid = (xcd < r ? xcd * (q + 1) : r * (q + 1) + (xcd - r) * q) + off; }
    const int nig = WGM * nN, gid = wgid / nig, fm = gid * WGM, gsz = (nM - fm) < WGM ? (nM - fm) : WGM;
    pm = fm + ((wgid % nig) % gsz); pn = (wgid % nig) / gsz; return true;
}
struct PlainOrder {
    const char* A; const char* Bt; int nM, nN, G, c; size_t tstep; int pn_base, skip_from, skip_cnt, b_row0;
    __device__ __forceinline__ void init(const void* A_, const void* Bt_, int M, int N, int K, int G_, int c_) { A = (const char*)A_; Bt = (const char*)Bt_; nM = M / BM; nN = N / BM; G = G_; c = c_; tstep = (size_t)BM * K * 2;
        pn_base = 0; skip_from = 1 << 30; skip_cnt = 0; b_row0 = 0; }
    __device__ __forceinline__ bool next(int i, Unit& u) const {
        int pm, pn; if (!tile_of(i * G + c, nM, nN, pm, pn)) return false;
        pn += pn_base; if (pn >= skip_from) pn += skip_cnt;
        u.pm = pm; u.pn = pn; u.br = 0; u.A = A + (size_t)pm * tstep; u.B = Bt + (size_t)(pn - b_row0) * tstep; return true;
    }
};
struct BranchOrder {
    const char* T8; const char* WA; int nM, nN, G, c; size_t tstep;
    __device__ __forceinline__ bool next(int i, Unit& u) const {
        const int tl = i / 3, br = i - 3 * tl; int pm, pn; if (!tile_of(tl * G + c, nM, nN, pm, pn)) return false;
        u.pm = pm; u.pn = pn; u.br = br;
        const int ti = 1 + 4 * (br == 1) + (br == 2);
        u.A = T8 + (size_t)ti * SZ_A + (size_t)pm * tstep; u.B = WA + (size_t)br * SZ_W + (size_t)pn * tstep; return true;
    }
};

template <class Epi, class Sched, bool FP8 = false>
__device__ __forceinline__ void gemm_phase(LAS unsigned char* lds, const int K, const Sched& S, const Epi& E, int wid0) {
    const int tid = tid_fresh(wid0), wid = __builtin_amdgcn_readfirstlane(tid >> 6), lane = tid & 63, wr = wid >> 2, wc = wid & 3, fr = lane & 15, fq = lane >> 4;
    const int nt = K / BK;
    unsigned voffA[2], voffB[2];
#pragma unroll
    for (int i = 0; i < 2; ++i) { int R, C; stage_rc(tid * 16 + i * 8192, R, C); const int Rb = Epi::PERM ? ((R & ~31) + perm32(R & 31)) : R;
        voffA[i] = (unsigned)(R * K + C) * 2u; voffB[i] = (unsigned)(Rb * K + C) * 2u; }
    const size_t kstep = (size_t)(BK * 2);
    const size_t hstep = (size_t)HALF * K * 2;
    const unsigned ldsw = (unsigned)wid * 1024u;
    const int aoff = lds_byte(wr * 64 + fr, fq * 8), boff = lds_byte(wc * 32 + fr, fq * 8);
#define PG8_SA(b, h) (((b) * 2 + (h)) * HTB)
#define PG8_SB(b, h) ((4 + (b) * 2 + (h)) * HTB)
#define PG8_STAGE(bufoff, gbase, voff) do { _Pragma("unroll") for (int _i = 0; _i < 2; ++_i) \
        __builtin_amdgcn_global_load_lds((const unsigned*)((const char*)(gbase) + (voff)[_i]), (LAS unsigned*)(lds + (bufoff) + ldsw + _i * 8192), 16, 0, 0); } while (0)
#define PG8_LD1(dstv, addr) do { if constexpr (FP8) { const i32x4 _lo = *(const LAS i32x4*)(lds + (addr)), _hi = *(const LAS i32x4*)(lds + (addr) + 1024); dstv[0] = __builtin_shufflevector(_lo, _hi, 0, 1, 2, 3, 4, 5, 6, 7); } \
        else { _Pragma("unroll") for (int k = 0; k < 2; ++k) dstv[k] = *(const LAS bf16x8*)(lds + (addr) + k * 1024); } } while (0)
#define PG8_LDA(dst, b, h) do { _Pragma("unroll") for (int m = 0; m < 4; ++m) PG8_LD1(dst[m], PG8_SA(b, h) + aoff + m * 2048); } while (0)
#define PG8_LDB(dst, b, h) do { _Pragma("unroll") for (int n = 0; n < 2; ++n) PG8_LD1(dst[n], PG8_SB(b, h) + boff + n * 2048); } while (0)
#define PG8_MMA(ai, bj, At, Bt) do { __builtin_amdgcn_s_setprio(1); _Pragma("unroll") for (int m = 0; m < 4; ++m) _Pragma("unroll") for (int n = 0; n < 2; ++n) { \
        if constexpr (FP8) asm volatile("v_mfma_scale_f32_16x16x128_f8f6f4 %0, %1, %2, %0, %3, %4 op_sel_hi:[0,0,0]" : "+v"(acc[ai][bj][m][n]) : "v"(Bt[n][0]), "v"(At[m][0]), "v"(sclW), "v"(sclX)); \
        else { _Pragma("unroll") for (int k = 0; k < 2; ++k) acc[ai][bj][m][n] = __builtin_amdgcn_mfma_f32_16x16x32_bf16(Bt[n][k], At[m][k], acc[ai][bj][m][n], 0, 0, 0); } } \
        __builtin_amdgcn_s_setprio(0); } while (0)
#define PG8_WAIT_V(n) asm volatile("s_waitcnt vmcnt(" #n ")" ::: "memory")
#define PG8_WAIT_L(n) asm volatile("s_waitcnt lgkmcnt(" #n ")" ::: "memory")
#define PG8_BAR __builtin_amdgcn_s_barrier()
#define PG8_SCHED __builtin_amdgcn_sched_barrier(0)
    Unit cur, nxt; int ui = 0;
    if (!S.next(0, cur)) return;
    const int sclW = 0x75757575, sclX = 0x7F7F7F7F;
    f32x4 acc[2][2][4][2];
#pragma unroll
    for (int a = 0; a < 2; ++a)
#pragma unroll
        for (int b = 0; b < 2; ++b)
#pragma unroll
            for (int m = 0; m < 4; ++m)
#pragma unroll
                for (int n = 0; n < 2; ++n) acc[a][b][m][n] = (f32x4){0.f, 0.f, 0.f, 0.f};
    typedef typename std::conditional<FP8, i32x8, bf16x8>::type frag_t;
    frag_t At[4][FP8 ? 1 : 2], B0[2][FP8 ? 1 : 2], B1[2][FP8 ? 1 : 2];
    const char* cA = cur.A; const char* cB = cur.B;
    PG8_STAGE(PG8_SB(0, 0), cB, voffB); PG8_STAGE(PG8_SA(0, 0), cA, voffA); PG8_STAGE(PG8_SB(0, 1), cB + hstep, voffB); PG8_STAGE(PG8_SA(0, 1), cA + hstep, voffA);
    if (wr == 1) PG8_BAR;
    PG8_WAIT_V(4); PG8_BAR;
    PG8_STAGE(PG8_SB(1, 0), cB + kstep, voffB); PG8_STAGE(PG8_SA(1, 0), cA + kstep, voffA); PG8_STAGE(PG8_SB(1, 1), cB + hstep + kstep, voffB);
    PG8_WAIT_V(6); PG8_BAR;
    for (;;) {
        const bool has_next = S.next(ui + 1, nxt);
        const char* nA = has_next ? nxt.A : cA; const char* nB = has_next ? nxt.B : cB;
        for (int t = 0; t < nt; t += 2) {
            const bool last = (t == nt - 2);
            const char* a1 = cA + (size_t)(t + 1) * kstep;
            const char* a2 = last ? nA : cA + (size_t)(t + 2) * kstep; const char* b2 = last ? nB : cB + (size_t)(t + 2) * kstep;
            const char* a3 = a2 + kstep; const char* b3 = b2 + kstep;
            PG8_LDB(B0, 0, 0); PG8_SCHED; PG8_LDA(At, 0, 0); PG8_STAGE(PG8_SA(1, 1), a1 + hstep, voffA);
            PG8_WAIT_L(8); PG8_BAR; PG8_WAIT_L(0); PG8_MMA(0, 0, At, B0); PG8_BAR; PG8_SCHED;
            PG8_LDB(B1, 0, 1); PG8_STAGE(PG8_SB(0, 0), b2, voffB);
            PG8_BAR; PG8_WAIT_L(0); PG8_MMA(0, 1, At, B1); PG8_BAR;
            PG8_LDA(At, 0, 1); PG8_STAGE(PG8_SA(0, 0), a2, voffA);
            PG8_BAR; PG8_WAIT_L(0); PG8_MMA(1, 0, At, B0); PG8_BAR; PG8_SCHED;
            PG8_STAGE(PG8_SB(0, 1), b2 + hstep, voffB);
            PG8_WAIT_V(6); PG8_BAR; PG8_MMA(1, 1, At, B1); PG8_BAR;
            PG8_LDB(B0, 1, 0); PG8_SCHED; PG8_LDA(At, 1, 0); PG8_STAGE(PG8_SA(0, 1), a2 + hstep, voffA);
            PG8_WAIT_L(8); PG8_BAR; PG8_WAIT_L(0); PG8_MMA(0, 0, At, B0); PG8_BAR; PG8_SCHED;
            PG8_LDB(B1, 1, 1); PG8_STAGE(PG8_SB(1, 0), b3, voffB);
            PG8_BAR; PG8_WAIT_L(0); PG8_MMA(0, 1, At, B1); PG8_BAR;
            PG8_LDA(At, 1, 1); PG8_STAGE(PG8_SA(1, 0), a3, voffA);
            PG8_BAR; PG8_WAIT_L(0); PG8_MMA(1, 0, At, B0); PG8_BAR; PG8_SCHED;
            PG8_STAGE(PG8_SB(1, 1), b3 + hstep, voffB);
            PG8_WAIT_V(6); PG8_BAR; PG8_MMA(1, 1, At, B1); PG8_BAR;
        }
        if constexpr (FP8) { asm volatile("s_nop 15\n\ts_nop 15\n\ts_nop 15" ::: "memory"); }
        E(acc, cur, wr, wc, fr, fq);
        if (!has_next) break;
#pragma unroll
        for (int a = 0; a < 2; ++a)
#pragma unroll
            for (int b = 0; b < 2; ++b)
#pragma unroll
                for (int m = 0; m < 4; ++m)
#pragma unroll
                    for (int n = 0; n < 2; ++n) acc[a][b][m][n] = (f32x4){0.f, 0.f, 0.f, 0.f};
        cur = nxt; cA = nA; cB = nB; ++ui;
    }
    PG8_WAIT_V(0);
    if (wr == 0) PG8_BAR;
    PG8_BAR;
#undef PG8_SA
#undef PG8_SB
#undef PG8_STAGE
#undef PG8_LD1
#undef PG8_LDA
#undef PG8_LDB
#undef PG8_MMA
#undef PG8_WAIT_V
#undef PG8_WAIT_L
#undef PG8_BAR
#undef PG8_SCHED
}

struct EpiProj {
    static constexpr bool PERM = true;
    unsigned char* ws;
    __device__ __forceinline__ void operator()(const f32x4 (&acc)[2][2][4][2], const Unit& u, int wr, int wc, int fr, int fq) const {
        const int pn = u.pn; size_t off; int ld, c0;
        if (pn < 4) { off = WS_PQ; ld = 1024; c0 = pn * 256; }
        else if (pn < 8) { off = WS_PK; ld = 1024; c0 = (pn - 4) * 256; }
        else if (pn < 72) { const int t = (pn - 8) >> 3; off = WS_T8 + (size_t)t * SZ_A; ld = 2048; c0 = ((pn - 8) & 7) * 256; }
        else { off = WS_GT; ld = 6144; c0 = (pn - 72) * 256; }
        bf16_t* rp = (bf16_t*)(ws + off) + (size_t)(u.pm * BM + wr * 64 + fr) * ld + c0 + wc * 32 + 8 * fq;
        const size_t step = (size_t)16 * ld;
#pragma unroll
        for (int ai = 0; ai < 2; ++ai) {
#pragma unroll
            for (int m = 0; m < 4; ++m) {
                asm volatile("" : "+v"(rp));
#pragma unroll
                for (int bj = 0; bj < 2; ++bj) { const f32x4 v0 = acc[ai][bj][m][0], v1 = acc[ai][bj][m][1];
                    u32x4 w; w.x = pk2(v0[0], v0[1]); w.y = pk2(v0[2], v0[3]); w.z = pk2(v1[0], v1[1]); w.w = pk2(v1[2], v1[3]);
                    *(u32x4*)(rp + bj * HALF) = w; }
                rp += step;
            }
            rp += 4 * step;
        }
    }
};
struct EpiBf {
    static constexpr bool PERM = true;
    bf16_t* O; int ld;
    __device__ __forceinline__ void operator()(const f32x4 (&acc)[2][2][4][2], const Unit& u, int wr, int wc, int fr, int fq) const {
        const int row0 = u.pm * BM + wr * 64 + fr, col0 = u.pn * BM + wc * 32 + 8 * fq;
#pragma unroll
        for (int ai = 0; ai < 2; ++ai)
#pragma unroll
            for (int m = 0; m < 4; ++m) { bf16_t* rowp = O + (size_t)(row0 + ai * HALF + m * 16) * ld + col0;
#pragma unroll
                for (int bj = 0; bj < 2; ++bj) { const f32x4 v0 = acc[ai][bj][m][0], v1 = acc[ai][bj][m][1];
                    u32x4 w; w.x = pk2(v0[0], v0[1]); w.y = pk2(v0[2], v0[3]); w.z = pk2(v1[0], v1[1]); w.w = pk2(v1[2], v1[3]);
                    *(u32x4*)(rowp + bj * HALF) = w; } }
    }
};
struct EpiMerge {
    static constexpr bool PERM = true;
    bf16_t* Y; const bf16_t* GT;
    __device__ __forceinline__ void operator()(const f32x4 (&acc)[2][2][4][2], const Unit& u, int wr, int wc, int fr, int fq) const {
        const int row0 = u.pm * BM + wr * 64 + fr, col0 = u.pn * BM + wc * 32 + 8 * fq;
#pragma unroll
        for (int ai = 0; ai < 2; ++ai)
#pragma unroll
            for (int m = 0; m < 4; ++m) { const size_t r = (size_t)(row0 + ai * HALF + m * 16);
                bf16_t* rowp = Y + r * 2048 + col0; const bf16_t* gp = GT + r * 6144 + (size_t)u.br * 2048 + col0;
#pragma unroll
                for (int bj = 0; bj < 2; ++bj) { const f32x4 v0 = acc[ai][bj][m][0], v1 = acc[ai][bj][m][1];
                    const u32x4 g = *(const u32x4*)(gp + bj * HALF);
                    const float ab = ((ABL >> u.br) & 1) ? 0.f : 1.f;
                    float o[8];
                    o[0] = ab * sigmoidf_(bflo(g.x)) * v0[0]; o[1] = ab * sigmoidf_(bfhi(g.x)) * v0[1]; o[2] = ab * sigmoidf_(bflo(g.y)) * v0[2]; o[3] = ab * sigmoidf_(bfhi(g.y)) * v0[3];
                    o[4] = ab * sigmoidf_(bflo(g.z)) * v1[0]; o[5] = ab * sigmoidf_(bfhi(g.z)) * v1[1]; o[6] = ab * sigmoidf_(bflo(g.w)) * v1[2]; o[7] = ab * sigmoidf_(bfhi(g.w)) * v1[3];
                    if (u.br != 0) { const u32x4 y = *(const u32x4*)(rowp + bj * HALF);
                        o[0] += bflo(y.x); o[1] += bfhi(y.x); o[2] += bflo(y.y); o[3] += bfhi(y.y); o[4] += bflo(y.z); o[5] += bfhi(y.z); o[6] += bflo(y.w); o[7] += bfhi(y.w); }
                    u32x4 w; w.x = pk2(o[0], o[1]); w.y = pk2(o[2], o[3]); w.z = pk2(o[4], o[5]); w.w = pk2(o[6], o[7]);
                    *(u32x4*)(rowp + bj * HALF) = w; } }
    }
};
struct EpiRes {
    static constexpr bool PERM = false;
    float* X; const float* mod;
    __device__ __forceinline__ void operator()(const f32x4 (&acc)[2][2][4][2], const Unit& u, int wr, int wc, int fr, int fq) const {
        const int row0 = u.pm * BM + wr * 64 + fr, col0 = u.pn * BM + wc * 32 + 4 * fq;
        const int which = (u.pm < 32) ? 0 : (u.pm < 64 ? 1 : 2);
        const float* mg = mod + (size_t)which * 12288 + 2 * 2048 + col0;
        f32x4 gv[2][2];
#pragma unroll
        for (int bj = 0; bj < 2; ++bj)
#pragma unroll
            for (int n = 0; n < 2; ++n) gv[bj][n] = *(const f32x4*)(mg + bj * HALF + n * 16);
#pragma unroll
        for (int ai = 0; ai < 2; ++ai)
#pragma unroll
            for (int m = 0; m < 4; ++m) { float* rowp = X + (size_t)(row0 + ai * HALF + m * 16) * 2048 + col0;
#pragma unroll
                for (int bj = 0; bj < 2; ++bj)
#pragma unroll
                    for (int n = 0; n < 2; ++n) { f32x4* q = (f32x4*)(rowp + bj * HALF + n * 16); *q = *q + gv[bj][n] * acc[ai][bj][m][n]; } }
    }
};
}

__device__ __forceinline__ int proj_src_col(int n) {
    if (n < 1024) return 7200 + n;
    if (n < 2048) return n - 1024;
    if (n < 4096) return 1024 + (n - 2048);
    if (n < 6144) return 8224 + (n - 4096);
    if (n < 8192) return 16416 + (n - 6144);
    if (n < 10240) return 3104 + (n - 8192);
    if (n < 12288) return 5152 + (n - 10240);
    if (n < 14336) return 10272 + (n - 12288);
    if (n < 16384) return 12320 + (n - 14336);
    if (n < 18432) return 14368 + (n - 16384);
    return 18464 + (n - 18432);
}
__device__ __forceinline__ void phase_w(KP p, int l, LAS unsigned char* lds, int wid0) {
    const int tid = tid_fresh(wid0), G = gridDim.x, bid = blockIdx.x;
    unsigned char* ws = launder(p->ws);
    {
        LAS float* tile = (LAS float*)lds;
        const int NT_IN = NPROJ / 64;
        const int total = (NT_IN + 5 * 32) * 32;
        for (int t = bid; t < total; t += G) {
            const int ntile = t >> 5, kt = t & 31, k0 = kt * 64;
            const float* src; int ld; bf16_t* dst; float scale = 1.0f; int n0;
            bool to8 = false;
            if (ntile < NT_IN) { n0 = ntile * 64; src = p->w_in + (size_t)l * 2048 * PROJ_W + proj_src_col(n0); ld = PROJ_W;
                if (n0 >= 12288 && n0 < 18432) { dst = (bf16_t*)(ws + WS_WINB) + (size_t)(n0 - 12288) * 2048; }
                else { to8 = true; dst = (bf16_t*)(ws + WS_WIN); scale = (n0 < 1024) ? 1024.0f * 0.08838834764831845f : 1024.0f; } }
            else { const int mi = (ntile - NT_IN) >> 5; n0 = ((ntile - NT_IN) & 31) * 64;
                const float* m5 = mi == 0 ? p->w_a_out : mi == 1 ? p->w_b_out : mi == 2 ? p->w_c_out : mi == 3 ? p->w_out : p->peer_wq;
                src = m5 + (size_t)l * 2048 * 2048 + n0; ld = 2048;
                dst = (bf16_t*)(ws + WS_WA + (size_t)mi * SZ_W) + (size_t)n0 * 2048; }
            { const int kk = tid >> 4, n4 = (tid & 15) * 4;
#pragma unroll
              for (int h = 0; h < 2; ++h) { const f32x4 v = *(const f32x4*)(src + (size_t)(k0 + kk + 32 * h) * ld + n4);
                  LAS float* tp = tile + (kk + 32 * h) * 65 + n4; tp[0] = v[0]; tp[1] = v[1]; tp[2] = v[2]; tp[3] = v[3]; } }
            __syncthreads();
            { const int n = tid >> 3, k8 = (tid & 7) * 8; float v[8];
#pragma unroll
              for (int j = 0; j < 8; ++j) v[j] = tile[(k8 + j) * 65 + n] * scale;
              if (to8) {
#pragma unroll
                  for (int j = 0; j < 8; ++j) v[j] = fminf(fmaxf(v[j], -448.f), 448.f);
                  int d0 = 0, d1 = 0; d0 = __builtin_amdgcn_cvt_pk_fp8_f32(v[0], v[1], d0, false); d0 = __builtin_amdgcn_cvt_pk_fp8_f32(v[2], v[3], d0, true);
                  d1 = __builtin_amdgcn_cvt_pk_fp8_f32(v[4], v[5], d1, false); d1 = __builtin_amdgcn_cvt_pk_fp8_f32(v[6], v[7], d1, true);
                  u32x2 w8; w8.x = (unsigned)d0; w8.y = (unsigned)d1; *(u32x2*)((unsigned char*)dst + (size_t)(n0 + n) * 2048 + k0 + k8) = w8; }
              else { u32x4 w; w.x = pk2(v[0], v[1]); w.y = pk2(v[2], v[3]); w.z = pk2(v[4], v[5]); w.w = pk2(v[6], v[7]);
                  *(u32x4*)(dst + (size_t)n * 2048 + k0 + k8) = w; } }
            __syncthreads();
        }
    }
    const size_t gtid = (size_t)bid * NTHREADS + tid, gthreads = (size_t)G * NTHREADS;
    for (size_t i = gtid; i < 32 * 2048; i += gthreads) { const int n = (int)(i >> 11), k = (int)(i & 2047);
        ((bf16_t*)(ws + WS_WG))[i] = f2bf(p->w_in[(size_t)l * 2048 * PROJ_W + (size_t)k * PROJ_W + 3072 + n]); }
    {
        const float* su = p->peer_u + (size_t)l * 16384 * 2048; const float* sv = p->peer_v + (size_t)l * 16384 * 2048;
        unsigned char* du = ws + WS_PU; unsigned char* dv = ws + WS_PVW;
        const size_t n32 = (size_t)16384 * 2048 / 32;
        for (size_t i = gtid; i < n32; i += gthreads) {
#pragma unroll
            for (int t = 0; t < 2; ++t) {
                const float* sp = (t ? sv : su) + i * 32; const float sc = t ? 4.0f : 64.0f;
                float e[32];
#pragma unroll
                for (int q = 0; q < 8; ++q) { const f32x4 a = *(const f32x4*)(sp + q * 4); e[q * 4] = a[0] * sc; e[q * 4 + 1] = a[1] * sc; e[q * 4 + 2] = a[2] * sc; e[q * 4 + 3] = a[3] * sc; }
                f32x16 va, vb;
#pragma unroll
                for (int j = 0; j < 16; ++j) { va[j] = FP6_INTERLEAVED ? e[2 * j] : e[j]; vb[j] = FP6_INTERLEAVED ? e[2 * j + 1] : e[16 + j]; }
                const u32x6 wv = __builtin_amdgcn_cvt_scalef32_2xpk16_fp6_f32(va, vb, 1.0f);
                unsigned* dp = (unsigned*)((t ? dv : du) + i * 24);
                u32x2 w0, w1, w2; w0.x = wv[0]; w0.y = wv[1]; w1.x = wv[2]; w1.y = wv[3]; w2.x = wv[4]; w2.y = wv[5];
                *(u32x2*)dp = w0; *(u32x2*)(dp + 2) = w1; *(u32x2*)(dp + 4) = w2;
            }
        }
        const float* sk = p->peer_keys + (size_t)l * 16 * 128 * 128; bf16_t* dk = (bf16_t*)(ws + WS_KEYS);
        for (size_t i = gtid; i < (size_t)16 * 128 * 128; i += gthreads) dk[i] = f2bf(sk[i]);
    }
    {
        float* mod = (float*)(ws + WS_MOD) + (size_t)l * 3 * 12288;
        const float* wa = p->w_ada + (size_t)l * 2048 * 12288; const float* ba = p->b_ada + (size_t)l * 12288;
        LAS float* part = (LAS float*)(lds + 32768);
        const int col = tid & 63, ks = tid >> 6;
        for (int t = bid; t < 256; t += G) {
            const int n = t * 48 + col;
            float a0 = 0.f, a1 = 0.f, a2 = 0.f;
            if (col < 48) {
                for (int k = ks * 256; k < ks * 256 + 256; ++k) {
                    const float w = wa[(size_t)k * 12288 + n];
                    const float c0 = p->c[k], c1 = p->c[2048 + k], c2 = p->c_ctx[k];
                    a0 += c0 * sigmoidf_(c0) * w; a1 += c1 * sigmoidf_(c1) * w; a2 += c2 * sigmoidf_(c2) * w;
                }
                part[(ks * 3 + 0) * 48 + col] = a0; part[(ks * 3 + 1) * 48 + col] = a1; part[(ks * 3 + 2) * 48 + col] = a2;
            }
            __syncthreads();
            if (tid < 144) { const int which = tid / 48, cc = tid - which * 48; float sacc = ba[t * 48 + cc];
#pragma unroll
                for (int q = 0; q < 8; ++q) sacc += part[(q * 3 + which) * 48 + cc];
                mod[(size_t)which * 12288 + t * 48 + cc] = sacc; }
            __syncthreads();
        }
    }
    if (l == 0) {
        float* X = (float*)(ws + WS_X);
        const size_t nl4 = (size_t)NLAT * 2048 / 4, nc4 = (size_t)NCTX * 2048 / 4;
        for (size_t i = gtid; i < nl4; i += gthreads) ((f32x4*)X)[i] = ((const f32x4*)p->x)[i];
        for (size_t i = gtid; i < nc4; i += gthreads) ((f32x4*)X)[nl4 + i] = ((const f32x4*)p->ctx)[i];
        float* tab = (float*)(ws + WS_TAB);
        for (size_t i = gtid; i < 4096; i += gthreads) { const int pos = (int)(i >> 5), j = (int)(i & 31);
            const float inv = powf(10000.0f, -(float)j / 32.0f); const float ang = (float)pos * inv;
            tab[i] = cosf(ang); tab[4096 + i] = sinf(ang); }
    }
}

__device__ __forceinline__ void phase_norm(KP p, int l, int which_norm, int nrows, int wid0) {
    const int tid = tid_fresh(wid0); const int lane = tid & 63, gw = blockIdx.x * 8 + (tid >> 6), nw = gridDim.x * 8;
    unsigned char* ws = launder(p->ws);
    const float* X = (const float*)(ws + WS_X); bf16_t* XN = (bf16_t*)(ws + WS_XN);
    const float* mod = (const float*)(ws + WS_MOD) + (size_t)l * 3 * 12288;
    const float* g = p->norm_g + (size_t)(l * 2 + which_norm) * 2048;
    const int shift_c = which_norm ? 3 : 0, scale_c = which_norm ? 4 : 1;
    for (int row = gw; row < nrows; row += nw) {
        const int which = row < NLAT ? (row >> 13) : 2;
        const float* xr = X + (size_t)row * 2048; const float* mb = mod + (size_t)which * 12288;
        f32x4 v[8]; float ss = 0.f;
#pragma unroll
        for (int i = 0; i < 8; ++i) { v[i] = *(const f32x4*)(xr + i * 256 + lane * 4); ss += v[i][0] * v[i][0] + v[i][1] * v[i][1] + v[i][2] * v[i][2] + v[i][3] * v[i][3]; }
        ss = wave_sum(ss);
        const float rstd = rsqrtf(ss * (1.0f / 2048.0f) + EPSF);
#pragma unroll
        for (int i = 0; i < 8; ++i) { const int c = i * 256 + lane * 4;
            const f32x4 gg = *(const f32x4*)(g + c), sh = *(const f32x4*)(mb + shift_c * 2048 + c), sc = *(const f32x4*)(mb + scale_c * 2048 + c);
            float o[4];
#pragma unroll
            for (int j = 0; j < 4; ++j) o[j] = v[i][j] * rstd * gg[j] * (1.0f + sc[j]) + sh[j];
            u32x2 w; w.x = pk2(o[0], o[1]); w.y = pk2(o[2], o[3]); *(u32x2*)(XN + (size_t)row * 2048 + c) = w;
            if (which_norm == 0) { int d = 0; d = __builtin_amdgcn_cvt_pk_fp8_f32(fminf(fmaxf(o[0], -448.f), 448.f), fminf(fmaxf(o[1], -448.f), 448.f), d, false);
                d = __builtin_amdgcn_cvt_pk_fp8_f32(fminf(fmaxf(o[2], -448.f), 448.f), fminf(fmaxf(o[3], -448.f), 448.f), d, true); *(unsigned*)(ws + WS_XN8 + (size_t)row * 2048 + c) = (unsigned)d; } }
    }
}

__device__ __forceinline__ void phase_gates_gemm(KP p, int l, int wid0) {
    const int tid = tid_fresh(wid0); const int lane = tid & 63, gw = blockIdx.x * 8 + (tid >> 6), nw = gridDim.x * 8;
    unsigned char* ws = launder(p->ws);
    const bf16_t* XN = (const bf16_t*)(ws + WS_XN); const bf16_t* WG = (const bf16_t*)(ws + WS_WG); float* GA = (float*)(ws + WS_GATES);
    const int q4 = lane >> 4, c = lane & 15;
    const float gb0 = p->a_gate_b[l * 32 + c], gb1 = p->a_gate_b[l * 32 + 16 + c];
    for (int task = gw; task < MR / 16; task += nw) {
        const int r0 = task * 16;
        f32x4 acc0 = {0.f, 0.f, 0.f, 0.f}, acc1 = {0.f, 0.f, 0.f, 0.f};
        const bf16_t* ap = XN + (size_t)(r0 + c) * 2048 + 8 * q4; const bf16_t* b0 = WG + (size_t)c * 2048 + 8 * q4; const bf16_t* b1 = b0 + 16 * 2048;
#pragma unroll 4
        for (int ks = 0; ks < 64; ++ks) { const bf16x8 a = *(const bf16x8*)(ap + ks * 32), x0 = *(const bf16x8*)(b0 + ks * 32), x1 = *(const bf16x8*)(b1 + ks * 32);
            acc0 = mfma16(a, x0, acc0); acc1 = mfma16(a, x1, acc1); }
#pragma unroll
        for (int r = 0; r < 4; ++r) {
            const float v0 = acc0[r] + gb0, v1 = acc1[r] + gb1;
            GA[(size_t)(r0 + 4 * q4 + r) * 32 + c] = (c >= 8) ? logsigmoidf_(v0) : v0; GA[(size_t)(r0 + 4 * q4 + r) * 32 + 16 + c] = (c >= 8) ? logsigmoidf_(v1) : v1; }
    }
}

__device__ __forceinline__ void phase_e1(KP p, int l, int wid0) {
    const int tid = tid_fresh(wid0); const int lane = tid & 63, gw = blockIdx.x * 8 + (tid >> 6), nw = gridDim.x * 8;
    unsigned char* ws = launder(p->ws);
    bf16_t* PQ = (bf16_t*)(ws + WS_PQ); bf16_t* PK = (bf16_t*)(ws + WS_PK); bf16_t* CQ = (bf16_t*)(ws + WS_CQ); bf16_t* CK = (bf16_t*)(ws + WS_CK);
    bf16_t* BB = (bf16_t*)(ws + WS_BB); const bf16_t* BC = (const bf16_t*)(ws + WS_BC); const bf16_t* BX = (const bf16_t*)(ws + WS_BX);
    float* GA = (float*)(ws + WS_GATES); const float* tab = (const float*)(ws + WS_TAB);
    const float* gq = p->c_qk_g + (size_t)(l * 2 + 0) * 128; const float* gk = p->c_qk_g + (size_t)(l * 2 + 1) * 128;
    const float* cw = p->b_conv + (size_t)l * 3 * 2048;
    float gqv[8], gkv[8];
#pragma unroll
    for (int j = 0; j < 8; ++j) { gqv[j] = gq[(lane & 15) * 8 + j] * 0.08838834764831845f; gkv[j] = gk[(lane & 15) * 8 + j]; }
    for (int row = gw; row < MR; row += nw) {
        if (row < NLAT) {
            const int s = row & 8191, gr = s >> 6, gc = s & 63;
#pragma unroll
            for (int it = 0; it < 2; ++it) {
                const int unit = it * 64 + lane, h = unit >> 4, hf = (unit >> 3) & 1, j4 = unit & 7;
                const int off = h * 128 + hf * 64 + j4 * 4, pos = hf ? gc : gr;
                const f32x4 cs = *(const f32x4*)(tab + pos * 32 + j4 * 4), sn = *(const f32x4*)(tab + 4096 + pos * 32 + j4 * 4);
#pragma unroll
                for (int tsel = 0; tsel < 2; ++tsel) { bf16_t* T = (tsel ? PK : PQ) + (size_t)row * 1024 + off;
                    const u32x2 u1 = *(const u32x2*)T, u2 = *(const u32x2*)(T + 32);
                    const float a0 = bflo(u1.x), a1 = bfhi(u1.x), a2 = bflo(u1.y), a3 = bfhi(u1.y), b0 = bflo(u2.x), b1 = bfhi(u2.x), b2 = bflo(u2.y), b3 = bfhi(u2.y);
                    u32x2 o1, o2;
                    o1.x = pk2(a0 * cs[0] - b0 * sn[0], a1 * cs[1] - b1 * sn[1]); o1.y = pk2(a2 * cs[2] - b2 * sn[2], a3 * cs[3] - b3 * sn[3]);
                    o2.x = pk2(b0 * cs[0] + a0 * sn[0], b1 * cs[1] + a1 * sn[1]); o2.y = pk2(b2 * cs[2] + a2 * sn[2], b3 * cs[3] + a3 * sn[3]);
                    *(u32x2*)T = o1; *(u32x2*)(T + 32) = o2; }
            }
        }
#pragma unroll
        for (int tsel = 0; tsel < 2; ++tsel) {
            bf16_t* T = (tsel ? CK : CQ) + (size_t)row * 2048;
#pragma unroll
            for (int ps = 0; ps < 4; ++ps) {
                const u32x4 w = *(const u32x4*)(T + ps * 512 + lane * 8);
                float v[8] = {bflo(w.x), bfhi(w.x), bflo(w.y), bfhi(w.y), bflo(w.z), bfhi(w.z), bflo(w.w), bfhi(w.w)};
                float ss = 0.f;
#pragma unroll
                for (int j = 0; j < 8; ++j) ss += v[j] * v[j];
                ss += __shfl_xor(ss, 1); ss += __shfl_xor(ss, 2); ss += __shfl_xor(ss, 4); ss += __shfl_xor(ss, 8);
                const float rstd = rsqrtf(ss * (1.0f / 128.0f) + EPSF);
#pragma unroll
                for (int j = 0; j < 8; ++j) v[j] = v[j] * rstd * (tsel ? gkv[j] : gqv[j]);
                u32x4 o; o.x = pk2(v[0], v[1]); o.y = pk2(v[2], v[3]); o.z = pk2(v[4], v[5]); o.w = pk2(v[6], v[7]);
                *(u32x4*)(T + ps * 512 + lane * 8) = o;
            }
        }
        {
            int pos, len; if (row < NLAT) { pos = row & 8191; len = SEQ; } else { pos = (row - NLAT) & 255; len = CTXL; }
            const bool hp = pos > 0, hn = pos < len - 1;
#pragma unroll
            for (int ps = 0; ps < 4; ++ps) {
                const int c = ps * 512 + lane * 8; const size_t o = (size_t)row * 2048 + c;
                const u32x4 bb = *(const u32x4*)(BB + o), c1 = *(const u32x4*)(BC + o), x1 = *(const u32x4*)(BX + o);
                u32x4 c0 = {0u, 0u, 0u, 0u}, x0 = c0, c2 = c0, x2 = c0;
                if (hp) { c0 = *(const u32x4*)(BC + o - 2048); x0 = *(const u32x4*)(BX + o - 2048); }
                if (hn) { c2 = *(const u32x4*)(BC + o + 2048); x2 = *(const u32x4*)(BX + o + 2048); }
                const unsigned bw[4] = {bb.x, bb.y, bb.z, bb.w}, c0w[4] = {c0.x, c0.y, c0.z, c0.w}, c1w[4] = {c1.x, c1.y, c1.z, c1.w}, c2w[4] = {c2.x, c2.y, c2.z, c2.w};
                const unsigned x0w[4] = {x0.x, x0.y, x0.z, x0.w}, x1w[4] = {x1.x, x1.y, x1.z, x1.w}, x2w[4] = {x2.x, x2.y, x2.z, x2.w};
                unsigned ow[4];
#pragma unroll
                for (int q = 0; q < 4; ++q) {
                    const int cc = c + 2 * q;
                    const float w00 = cw[cc], w01 = cw[cc + 1], w10 = cw[2048 + cc], w11 = cw[2048 + cc + 1], w20 = cw[4096 + cc], w21 = cw[4096 + cc + 1];
                    const float ylo = bflo(bw[q]) * (bflo(c0w[q]) * bflo(x0w[q]) * w00 + bflo(c1w[q]) * bflo(x1w[q]) * w10 + bflo(c2w[q]) * bflo(x2w[q]) * w20);
                    const float yhi = bfhi(bw[q]) * (bfhi(c0w[q]) * bfhi(x0w[q]) * w01 + bfhi(c1w[q]) * bfhi(x1w[q]) * w11 + bfhi(c2w[q]) * bfhi(x2w[q]) * w21);
                    ow[q] = pk2(ylo, yhi);
                }
                u32x4 ov; ov.x = ow[0]; ov.y = ow[1]; ov.z = ow[2]; ov.w = ow[3];
                *(u32x4*)(BB + o) = ov;
            }
        }
    }
}

constexpr int ML_QS = 0, ML_KS = 17408, ML_KET = 34816, ML_VT = 53248, ML_SS = 60160, ML_CT = 69376, ML_CTSZ = 13056;
__device__ __forceinline__ int ml_row(int pp, int b, int dir) {
    if (pp < 256) { const int j = dir ? 255 - pp : pp; return NLAT + b * 256 + j; }
    int s = pp - 256; if (dir) s = 8191 - s; return b * 8192 + s;
}
__device__ __forceinline__ void phase_mlstm(KP p, int l, LAS unsigned char* lds, int wid0) {
    const int tid = tid_fresh(wid0), lane = tid & 63, w = __builtin_amdgcn_readfirstlane(tid >> 6), q4 = lane >> 4, c16 = lane & 15;
    unsigned char* ws = launder(p->ws);
    const bf16_t* PQ = (const bf16_t*)(ws + WS_PQ); const bf16_t* PK = (const bf16_t*)(ws + WS_PK); const bf16_t* PV = (const bf16_t*)(ws + WS_PV);
    const float* GA = (const float*)(ws + WS_GATES);
    for (int task = blockIdx.x; task < 256; task += gridDim.x) {
        const int xq = task & 7, yq = task >> 3; const int bh = 2 * xq + (yq >> 4), dir = (yq >> 3) & 1, sl = yq & 7; const int b = bh >> 3, h = bh & 7;
        bf16_t* H = (bf16_t*)(ws + (dir ? WS_BX : WS_BC));
        float* SCN = (float*)(ws + WS_SCAN) + (size_t)task * 3 * 8448;
        __syncthreads();
        for (int cc = w; cc < 132; cc += 8) {
            const int r = ml_row(cc * 64 + lane, b, dir);
            const float li = GA[(size_t)r * 32 + (2 * dir) * 8 + h], lf = GA[(size_t)r * 32 + (2 * dir + 1) * 8 + h];
            float bc = lf;
#pragma unroll
            for (int o = 1; o < 64; o <<= 1) { const float t = __shfl_up(bc, o); if (lane >= o) bc += t; }
            const float a = li - bc;
            float pm = a;
#pragma unroll
            for (int o = 1; o < 64; o <<= 1) { const float t = __shfl_up(pm, o); if (lane >= o) pm = fmaxf(pm, t); }
            SCN[cc * 64 + lane] = bc; SCN[8448 + cc * 64 + lane] = a; SCN[2 * 8448 + cc * 64 + lane] = pm;
        }
        for (int i = tid; i < 16 * 32; i += NTHREADS) { const int r = 32 + (i >> 5), cdw = i & 31; *(LAS unsigned*)(lds + ML_VT + r * 144 + cdw * 4) = (r == 32) ? 0x3f803f80u : 0u; }
        for (int i = tid; i < 2 * ML_CTSZ / 4; i += NTHREADS) *(LAS unsigned*)(lds + ML_CT + i * 4) = 0u;
        __syncthreads();
        float m = 0.f;
        f32x4 Cst[3];
#pragma unroll
        for (int i = 0; i < 3; ++i) Cst[i] = (f32x4){0.f, 0.f, 0.f, 0.f};
        u32x4 qreg[2], kreg[2], vreg; float bc, a, pm;
        const int qrow_l = lane >> 4, qpc = lane & 15, vrow_l = lane >> 2, vpc = lane & 3;
        {
#pragma unroll
          for (int i = 0; i < 2; ++i) { const int r = ml_row(8 * w + 4 * i + qrow_l, b, dir);
              qreg[i] = *(const u32x4*)(PQ + (size_t)r * 1024 + h * 128 + qpc * 8); kreg[i] = *(const u32x4*)(PK + (size_t)r * 1024 + h * 128 + qpc * 8); }
          if (w < 4) { const int r = ml_row(16 * w + vrow_l, b, dir); vreg = *(const u32x4*)(PV + (size_t)r * 2048 + h * 256 + sl * 32 + vpc * 8); }
          bc = SCN[lane]; a = SCN[8448 + lane]; pm = SCN[2 * 8448 + lane]; }
        for (int c = 0; c < 132; ++c) {
            const float total = __uint_as_float((unsigned)__builtin_amdgcn_readlane((int)__float_as_uint(bc), 63)), pmall = __uint_as_float((unsigned)__builtin_amdgcn_readlane((int)__float_as_uint(pm), 63));
            const float mx = fmaxf(m, pm);
            const float mrow = bc + mx;
            const float winter = __expf(m - mx);
            const float m_new = total + fmaxf(m, pmall);
            const float decay = __expf(total + m - m_new);
            const float kscale = __expf(total + a - m_new);
            const float a_cur = a;
#pragma unroll
            for (int i = 0; i < 2; ++i) { const int sr = 8 * w + 4 * i + qrow_l;
                *(LAS u32x4*)(lds + ML_QS + sr * 272 + qpc * 16) = qreg[i];
                *(LAS u32x4*)(lds + ML_KS + sr * 272 + qpc * 16) = kreg[i]; }
            if (w < 4) { const unsigned vw[4] = {vreg.x, vreg.y, vreg.z, vreg.w}; const int sv = 16 * w + vrow_l;
#pragma unroll
                for (int j = 0; j < 4; ++j) { const int e = vpc * 8 + 2 * j;
                    *(LAS bf16_t*)(lds + ML_VT + e * 144 + sv * 2) = (bf16_t)(vw[j] & 0xffffu);
                    *(LAS bf16_t*)(lds + ML_VT + (e + 1) * 144 + sv * 2) = (bf16_t)(vw[j] >> 16); } }
            if (w == 1) *(LAS float*)(lds + ML_SS + 256 + lane * 4) = kscale;
            if (c + 1 < 132) { const int p0 = (c + 1) * 64;
#pragma unroll
                for (int i = 0; i < 2; ++i) { const int r = ml_row(p0 + 8 * w + 4 * i + qrow_l, b, dir);
                    qreg[i] = *(const u32x4*)(PQ + (size_t)r * 1024 + h * 128 + qpc * 8); kreg[i] = *(const u32x4*)(PK + (size_t)r * 1024 + h * 128 + qpc * 8); }
                if (w < 4) { const int r = ml_row(p0 + 16 * w + vrow_l, b, dir); vreg = *(const u32x4*)(PV + (size_t)r * 2048 + h * 256 + sl * 32 + vpc * 8); }
                bc = SCN[p0 + lane]; a = SCN[8448 + p0 + lane]; pm = SCN[2 * 8448 + p0 + lane]; }
            if (w == 0) *(LAS float*)(lds + ML_SS + lane * 4) = a_cur;
            LDS_BARRIER();
            {
                const int tr = w >> 1, part = w & 1;
                const LAS unsigned char* CTc = lds + ML_CT + (c & 1) * ML_CTSZ;
                bf16x8 aq[4];
#pragma unroll
                for (int ks = 0; ks < 4; ++ks) aq[ks] = *(const LAS bf16x8*)(lds + ML_QS + (16 * tr + c16) * 272 + (ks * 32 + 8 * q4) * 2);
                float wi_t[4], mrow_t[4];
#pragma unroll
                for (int r = 0; r < 4; ++r) { const int t = 16 * tr + 4 * q4 + r; wi_t[r] = __shfl(winter, t); mrow_t[r] = __shfl(mrow, t); }
                f32x4 accA = {0.f, 0.f, 0.f, 0.f}, accD = {0.f, 0.f, 0.f, 0.f};
#pragma unroll
                for (int ks = 0; ks < 4; ++ks) {
                    const bf16x8 b1 = *(const LAS bf16x8*)(CTc + (16 * part + c16) * 272 + (ks * 32 + 8 * q4) * 2);
                    const bf16x8 b2 = *(const LAS bf16x8*)(CTc + (32 + c16) * 272 + (ks * 32 + 8 * q4) * 2);
                    accA = mfma16(aq[ks], b1, accA); accD = mfma16(aq[ks], b2, accD); }
#pragma unroll
                for (int r = 0; r < 4; ++r) { accA[r] *= wi_t[r]; accD[r] *= wi_t[r]; }
                const int tq = 16 * tr + c16;
                const float nmx = -__shfl(mx, tq);
#pragma unroll
                for (int kk = 0; kk < 2; ++kk) {
                    if (2 * kk <= tr) {
                        f32x4 s0 = {0.f, 0.f, 0.f, 0.f}, s1 = {0.f, 0.f, 0.f, 0.f};
#pragma unroll
                        for (int ks = 0; ks < 4; ++ks) { const bf16x8 ka = *(const LAS bf16x8*)(lds + ML_KS + (32 * kk + c16) * 272 + (ks * 32 + 8 * q4) * 2); s0 = mfma16(ka, aq[ks], s0); }
                        if (2 * kk + 1 <= tr) {
#pragma unroll
                            for (int ks = 0; ks < 4; ++ks) { const bf16x8 ka = *(const LAS bf16x8*)(lds + ML_KS + (32 * kk + 16 + c16) * 272 + (ks * 32 + 8 * q4) * 2); s1 = mfma16(ka, aq[ks], s1); }
                        }
                        const f32x4 a0 = *(const LAS f32x4*)(lds + ML_SS + (32 * kk + 4 * q4) * 4), a1 = *(const LAS f32x4*)(lds + ML_SS + (32 * kk + 16 + 4 * q4) * 4);
                        float pe[8];
#pragma unroll
                        for (int r = 0; r < 4; ++r) { const int sp0 = 32 * kk + 4 * q4 + r, sp1 = sp0 + 16;
                            pe[r] = (sp0 <= tq) ? s0[r] * __expf(a0[r] + nmx) : 0.f; pe[4 + r] = (sp1 <= tq) ? s1[r] * __expf(a1[r] + nmx) : 0.f; }
                        u32x4 pw; pw.x = pk2(pe[0], pe[1]); pw.y = pk2(pe[2], pe[3]); pw.z = pk2(pe[4], pe[5]); pw.w = pk2(pe[6], pe[7]);
                        const bf16x8 pf = __builtin_bit_cast(bf16x8, pw);
                        const u32x2 v1l = *(const LAS u32x2*)(lds + ML_VT + (16 * part + c16) * 144 + (32 * kk + 4 * q4) * 2), v1h = *(const LAS u32x2*)(lds + ML_VT + (16 * part + c16) * 144 + (32 * kk + 16 + 4 * q4) * 2);
                        const u32x2 v2l = *(const LAS u32x2*)(lds + ML_VT + (32 + c16) * 144 + (32 * kk + 4 * q4) * 2), v2h = *(const LAS u32x2*)(lds + ML_VT + (32 + c16) * 144 + (32 * kk + 16 + 4 * q4) * 2);
                        u32x4 bw1, bw2; bw1.x = v1l.x; bw1.y = v1l.y; bw1.z = v1h.x; bw1.w = v1h.y; bw2.x = v2l.x; bw2.y = v2l.y; bw2.z = v2h.x; bw2.w = v2h.y;
                        accA = mfma16(pf, __builtin_bit_cast(bf16x8, bw1), accA); accD = mfma16(pf, __builtin_bit_cast(bf16x8, bw2), accD);
                    }
                }
                if (l == 0 || c >= 4) {
#pragma unroll
                    for (int r = 0; r < 4; ++r) {
                        const float den = __shfl(accD[r], lane & 48);
                        const float hv = accA[r] / fmaxf(fabsf(den), __expf(-mrow_t[r]));
                        const int t = 16 * tr + 4 * q4 + r; const int row = ml_row(c * 64 + t, b, dir);
                        H[(size_t)row * 2048 + h * 256 + sl * 32 + 16 * part + c16] = f2bf(hv);
                    }
                }
            }
            {
                LAS unsigned char* CTn = lds + ML_CT + ((c + 1) & 1) * ML_CTSZ;
                bf16x8 ak[2];
#pragma unroll
                for (int k2 = 0; k2 < 2; ++k2) {
                    const f32x4 sc0 = *(const LAS f32x4*)(lds + ML_SS + 256 + (k2 * 32 + 8 * q4) * 4), sc1 = *(const LAS f32x4*)(lds + ML_SS + 256 + (k2 * 32 + 8 * q4 + 4) * 4);
                    float kv[8];
#pragma unroll
                    for (int j = 0; j < 8; ++j) kv[j] = bf2f((unsigned)*(const LAS bf16_t*)(lds + ML_KS + (k2 * 32 + 8 * q4 + j) * 272 + (16 * w + c16) * 2)) * (j < 4 ? sc0[j] : sc1[j - 4]);
                    u32x4 kw; kw.x = pk2(kv[0], kv[1]); kw.y = pk2(kv[2], kv[3]); kw.z = pk2(kv[4], kv[5]); kw.w = pk2(kv[6], kv[7]);
                    ak[k2] = __builtin_bit_cast(bf16x8, kw);
                }
#pragma unroll
                for (int ct = 0; ct < 3; ++ct) {
                    Cst[ct] = Cst[ct] * decay;
#pragma unroll
                    for (int k2 = 0; k2 < 2; ++k2) { const bf16x8 bv = *(const LAS bf16x8*)(lds + ML_VT + (16 * ct + c16) * 144 + (k2 * 32 + 8 * q4) * 2); Cst[ct] = mfma16(ak[k2], bv, Cst[ct]); }
                    u32x2 o; o.x = pk2(Cst[ct][0], Cst[ct][1]); o.y = pk2(Cst[ct][2], Cst[ct][3]);
                    *(LAS u32x2*)(CTn + (16 * ct + c16) * 272 + (16 * w + 4 * q4) * 2) = o;
                }
            }
            m = m_new;
            LDS_BARRIER();
        }
    }
}

constexpr int AT_KS = 0, AT_VS = 17408, AT_RPB = 35840;
__device__ __forceinline__ void phase_attn(KP p, int l, LAS unsigned char* lds, int wid0) {
    const int tid = tid_fresh(wid0), lane = tid & 63, w = __builtin_amdgcn_readfirstlane(tid >> 6), q4 = lane >> 4, c16 = lane & 15;
    unsigned char* ws = launder(p->ws);
    bf16_t* CQ = (bf16_t*)(ws + WS_CQ); const bf16_t* CK = (const bf16_t*)(ws + WS_CK); const bf16_t* CV = (const bf16_t*)(ws + WS_CV);
    const int nunits = 2048 + (l == 0 ? 64 : 0);
    for (int u = blockIdx.x; u < nunits; u += gridDim.x) {
        int b, h, qrow = 0, g = 0, ntl = 0, r0a = 0, qbase;  bool is_ctx = u >= 2048;
        if (!is_ctx) { b = u >> 10; h = (u >> 6) & 15; const int rp = u & 63; qrow = 2 * rp + (w >> 2); g = w & 3;
            r0a = min(max(2 * rp - 4, 0), 120); const int r0b = min(max(2 * rp + 1 - 4, 0), 120); ntl = r0b + 8 - r0a;
            qbase = b * 8192 + qrow * 64 + 16 * g; }
        else { const int uu = u - 2048; b = uu >> 5; h = (uu >> 1) & 15; qbase = NLAT + b * 256 + (uu & 1) * 128 + 16 * w; }
        const int r0q = min(max(qrow - 4, 0), 120);
        const int a_g = (g == 0) ? 0 : (g == 1 ? 8 : (g == 2 ? 24 : 32));
        __syncthreads();
        if (!is_ctx) for (int i = tid; i < 465; i += NTHREADS) *(LAS float*)(lds + AT_RPB + i * 4) = p->c_rpb[((size_t)l * 16 + h) * 465 + i];
        bf16x8 qf[4];
#pragma unroll
        for (int ks = 0; ks < 4; ++ks) qf[ks] = *(const bf16x8*)(CQ + (size_t)(qbase + c16) * 2048 + h * 128 + ks * 32 + 8 * q4);
        f32x4 O[8];
#pragma unroll
        for (int i = 0; i < 8; ++i) O[i] = (f32x4){0.f, 0.f, 0.f, 0.f};
        float m_run = -1e30f, l_run = 0.f;
        const int ntiles = ntl + 4;
        u32x4 kreg[2], vreg[2];
        auto tile_row = [&](int t, int key) -> int { return (t < ntl) ? (b * 8192 + (r0a + t) * 64 + key) : (NLAT + b * 256 + (t - ntl) * 64 + key); };
        const int krow_l = lane >> 4, kpc = lane & 15;
        {
#pragma unroll
          for (int i = 0; i < 2; ++i) { const int r = tile_row(0, 8 * w + 4 * i + krow_l); kreg[i] = *(const u32x4*)(CK + (size_t)r * 2048 + h * 128 + kpc * 8); vreg[i] = *(const u32x4*)(CV + (size_t)r * 2048 + h * 128 + kpc * 8); } }
        for (int t = 0; t < ntiles; ++t) {
            LDS_BARRIER();
#pragma unroll
            for (int i = 0; i < 2; ++i) { const int key = 8 * w + 4 * i + krow_l;
                *(LAS u32x4*)(lds + AT_KS + key * 272 + kpc * 16) = kreg[i];
                *(LAS u32x4*)(lds + AT_VS + key * 288 + kpc * 16) = vreg[i]; }
            if (t + 1 < ntiles) {
#pragma unroll
                for (int i = 0; i < 2; ++i) { const int r = tile_row(t + 1, 8 * w + 4 * i + krow_l); kreg[i] = *(const u32x4*)(CK + (size_t)r * 2048 + h * 128 + kpc * 8); vreg[i] = *(const u32x4*)(CV + (size_t)r * 2048 + h * 128 + kpc * 8); } }
            LDS_BARRIER();
            const bool local = t < ntl; const int kr = r0a + t;
            if (local && !(kr >= r0q && kr < r0q + 8)) continue;
            const int npass = local ? 1 : 2;
            for (int ps = 0; ps < npass; ++ps) {
                const int a0 = local ? a_g : ps * 32;
                f32x4 sc[2];
#pragma unroll
                for (int ct = 0; ct < 2; ++ct) { sc[ct] = (f32x4){0.f, 0.f, 0.f, 0.f};
#pragma unroll
                    for (int ks = 0; ks < 4; ++ks) { const bf16x8 ka = *(const LAS bf16x8*)(lds + AT_KS + (a0 + 16 * ct + c16) * 272 + (ks * 32 + 8 * q4) * 2); sc[ct] = mfma16(ka, qf[ks], sc[ct]); } }
                if (local) {
                    const int qc = 16 * g + c16, col0 = min(max(qc - 8, 0), 48); const int dr = kr - qrow + 7;
#pragma unroll
                    for (int ct = 0; ct < 2; ++ct)
#pragma unroll
                        for (int r = 0; r < 4; ++r) { const int kc = a0 + 16 * ct + 4 * q4 + r; const bool valid = (kc >= col0) && (kc < col0 + 16);
                            const int dc = min(max(kc - qc + 15, 0), 30);
                            const float bias = *(const LAS float*)(lds + AT_RPB + (dr * 31 + dc) * 4);
                            sc[ct][r] = valid ? sc[ct][r] + bias : -1e30f; }
                }
                float mx = fmaxf(fmaxf(fmaxf(sc[0][0], sc[0][1]), fmaxf(sc[0][2], sc[0][3])), fmaxf(fmaxf(sc[1][0], sc[1][1]), fmaxf(sc[1][2], sc[1][3])));
                mx = fmaxf(mx, __shfl_xor(mx, 16)); mx = fmaxf(mx, __shfl_xor(mx, 32));
                const float m_new = fmaxf(m_run, mx);
                const float alpha = __expf(m_run - m_new);
                float pe[8]; float psum = 0.f;
#pragma unroll
                for (int ct = 0; ct < 2; ++ct)
#pragma unroll
                    for (int r = 0; r < 4; ++r) { const float e = __expf(sc[ct][r] - m_new); pe[ct * 4 + r] = e; psum += e; }
                psum += __shfl_xor(psum, 16); psum += __shfl_xor(psum, 32);
                l_run = l_run * alpha + psum; m_run = m_new;
                bf16x8 pf; { u32x4 pw; pw.x = pk2(pe[0], pe[1]); pw.y = pk2(pe[2], pe[3]); pw.z = pk2(pe[4], pe[5]); pw.w = pk2(pe[6], pe[7]); pf = __builtin_bit_cast(bf16x8, pw); }
                float al[4];
#pragma unroll
                for (int r = 0; r < 4; ++r) al[r] = __shfl(alpha, 4 * q4 + r);
#pragma unroll
                for (int dt = 0; dt < 8; ++dt) {
#pragma unroll
                    for (int r = 0; r < 4; ++r) O[dt][r] *= al[r];
                    const s16x4 lo = __builtin_amdgcn_ds_read_tr16_b64_v4i16((LAS s16x4*)(lds + AT_VS + (a0 + 4 * q4 + (c16 >> 2)) * 288 + (16 * dt + 4 * (c16 & 3)) * 2));
                    const s16x4 hi = __builtin_amdgcn_ds_read_tr16_b64_v4i16((LAS s16x4*)(lds + AT_VS + (a0 + 16 + 4 * q4 + (c16 >> 2)) * 288 + (16 * dt + 4 * (c16 & 3)) * 2));
                    const bf16x8 bw = __builtin_shufflevector(lo, hi, 0, 1, 2, 3, 4, 5, 6, 7);
                    O[dt] = mfma16(pf, bw, O[dt]);
                }
            }
        }
        float linv[4];
#pragma unroll
        for (int r = 0; r < 4; ++r) linv[r] = 1.0f / __shfl(l_run, 4 * q4 + r);
#pragma unroll
        for (int dt = 0; dt < 8; ++dt)
#pragma unroll
            for (int r = 0; r < 4; ++r) CQ[(size_t)(qbase + 4 * q4 + r) * 2048 + h * 128 + 16 * dt + c16] = f2bf(O[dt][r] * linv[r]);
    }
}

__device__ __forceinline__ void phase_e2(KP p, int l, int nrows, int wid0) {
    const int tid = tid_fresh(wid0); const int lane = tid & 63, gw = blockIdx.x * 8 + (tid >> 6), nw = gridDim.x * 8;
    unsigned char* ws = launder(p->ws);
    const bf16_t* HF = (const bf16_t*)(ws + WS_BC); const bf16_t* HB = (const bf16_t*)(ws + WS_BX); bf16_t* PO = (bf16_t*)(ws + WS_PO);
    const float* hg = p->a_hnorm_g + (size_t)l * 2048;
    for (int row = gw; row < nrows; row += nw) {
#pragma unroll
        for (int h = 0; h < 8; ++h) {
            const size_t o = (size_t)row * 2048 + h * 256 + lane * 4;
            const u32x2 f = *(const u32x2*)(HF + o), bb = *(const u32x2*)(HB + o), ov = *(const u32x2*)(PO + o);
            float v[4] = {bflo(f.x) + bflo(bb.x), bfhi(f.x) + bfhi(bb.x), bflo(f.y) + bflo(bb.y), bfhi(f.y) + bfhi(bb.y)};
            float ss = v[0] * v[0] + v[1] * v[1] + v[2] * v[2] + v[3] * v[3];
            ss = wave_sum(ss);
            const float rstd = rsqrtf(ss * (1.0f / 256.0f) + EPSF);
            const f32x4 gg = *(const f32x4*)(hg + h * 256 + lane * 4);
            const float og[4] = {bflo(ov.x), bfhi(ov.x), bflo(ov.y), bfhi(ov.y)};
            float y[4];
#pragma unroll
            for (int j = 0; j < 4; ++j) y[j] = sigmoidf_(og[j]) * v[j] * rstd * gg[j];
            u32x2 wv; wv.x = pk2(y[0], y[1]); wv.y = pk2(y[2], y[3]); *(u32x2*)(PO + o) = wv;
        }
    }
}


template <int MODE>
__device__ __forceinline__ void ctx_gemm(KP p, int l, LAS unsigned char* lds, int wid0) {
    const int tid = tid_fresh(wid0); const int lane = tid & 63, w = __builtin_amdgcn_readfirstlane(tid >> 6), q4 = lane >> 4, c16 = lane & 15;
    unsigned char* ws = launder(p->ws);
    for (int task = blockIdx.x; task < (NCTX / 64) * 32; task += gridDim.x) {
        const int rg = task >> 5, cb = task & 31; const int row0 = NLAT + rg * 64, col0 = cb * 64;
        const int orow = row0 + (tid >> 3), ocol = col0 + (tid & 7) * 8;
        float yv[8];
#pragma unroll
        for (int i = 0; i < 8; ++i) yv[i] = 0.f;
#pragma unroll 1
        for (int br = 0; br < (MODE == 0 ? 3 : 1); ++br) {
            const bf16_t* A; const bf16_t* Bt;
            if (MODE == 0) { const int ti = 1 + 4 * (br == 1) + (br == 2); A = (const bf16_t*)(ws + WS_T8 + (size_t)ti * SZ_A); Bt = (const bf16_t*)(ws + WS_WA + (size_t)br * SZ_W); }
            else if (MODE == 1) { A = (const bf16_t*)(ws + WS_Y); Bt = (const bf16_t*)(ws + WS_WO); }
            else { A = (const bf16_t*)(ws + WS_XN); Bt = (const bf16_t*)(ws + WS_WQ); }
            const bf16_t* ap = A + (size_t)(row0 + c16) * 2048 + w * 256 + 8 * q4; const bf16_t* bp = Bt + (size_t)(col0 + c16) * 2048 + w * 256 + 8 * q4;
            f32x4 acc[4][4];
#pragma unroll
            for (int mi = 0; mi < 4; ++mi)
#pragma unroll
                for (int j = 0; j < 4; ++j) acc[mi][j] = (f32x4){0.f, 0.f, 0.f, 0.f};
#pragma unroll 2
            for (int ks = 0; ks < 8; ++ks) {
                bf16x8 a[4], bb[4];
#pragma unroll
                for (int mi = 0; mi < 4; ++mi) a[mi] = *(const bf16x8*)(ap + (size_t)mi * 16 * 2048 + ks * 32);
#pragma unroll
                for (int j = 0; j < 4; ++j) bb[j] = *(const bf16x8*)(bp + (size_t)j * 16 * 2048 + ks * 32);
#pragma unroll
                for (int mi = 0; mi < 4; ++mi)
#pragma unroll
                    for (int j = 0; j < 4; ++j) acc[mi][j] = mfma16(a[mi], bb[j], acc[mi][j]);
            }
            __syncthreads();
#pragma unroll
            for (int mi = 0; mi < 4; ++mi)
#pragma unroll
                for (int j = 0; j < 4; ++j)
#pragma unroll
                    for (int r = 0; r < 4; ++r) *(LAS float*)(lds + ((w * 64 + 16 * mi + 4 * q4 + r) * 64 + 16 * j + c16) * 4) = acc[mi][j][r];
            __syncthreads();
            float sv[8];
#pragma unroll
            for (int i = 0; i < 8; ++i) sv[i] = 0.f;
#pragma unroll
            for (int ww = 0; ww < 8; ++ww) { const f32x4 p0 = *(const LAS f32x4*)(lds + ((ww * 64 + (tid >> 3)) * 64 + (tid & 7) * 8) * 4), p1 = *(const LAS f32x4*)(lds + ((ww * 64 + (tid >> 3)) * 64 + (tid & 7) * 8 + 4) * 4);
                sv[0] += p0[0]; sv[1] += p0[1]; sv[2] += p0[2]; sv[3] += p0[3]; sv[4] += p1[0]; sv[5] += p1[1]; sv[6] += p1[2]; sv[7] += p1[3]; }
            if (MODE == 0) { const u32x4 g = *(const u32x4*)((const bf16_t*)(ws + WS_GT) + (size_t)orow * 6144 + (size_t)br * 2048 + ocol);
                yv[0] += sigmoidf_(bflo(g.x)) * sv[0]; yv[1] += sigmoidf_(bfhi(g.x)) * sv[1]; yv[2] += sigmoidf_(bflo(g.y)) * sv[2]; yv[3] += sigmoidf_(bfhi(g.y)) * sv[3];
                yv[4] += sigmoidf_(bflo(g.z)) * sv[4]; yv[5] += sigmoidf_(bfhi(g.z)) * sv[5]; yv[6] += sigmoidf_(bflo(g.w)) * sv[6]; yv[7] += sigmoidf_(bfhi(g.w)) * sv[7]; }
            else {
#pragma unroll
                for (int i = 0; i < 8; ++i) yv[i] = sv[i]; }
        }
        if (MODE == 1) { float* xp = (float*)(ws + WS_X) + (size_t)orow * 2048 + ocol; const float* mg = (const float*)(ws + WS_MOD) + (size_t)l * 3 * 12288 + 2 * 12288 + 2 * 2048 + ocol;
            const f32x4 x0 = *(const f32x4*)xp, x1 = *(const f32x4*)(xp + 4), g0 = *(const f32x4*)mg, g1 = *(const f32x4*)(mg + 4);
            f32x4 o0, o1; o0[0] = x0[0] + g0[0] * yv[0]; o0[1] = x0[1] + g0[1] * yv[1]; o0[2] = x0[2] + g0[2] * yv[2]; o0[3] = x0[3] + g0[3] * yv[3];
            o1[0] = x1[0] + g1[0] * yv[4]; o1[1] = x1[1] + g1[1] * yv[5]; o1[2] = x1[2] + g1[2] * yv[6]; o1[3] = x1[3] + g1[3] * yv[7];
            *(f32x4*)xp = o0; *(f32x4*)(xp + 4) = o1; }
        else { u32x4 ov; ov.x = pk2(yv[0], yv[1]); ov.y = pk2(yv[2], yv[3]); ov.z = pk2(yv[4], yv[5]); ov.w = pk2(yv[6], yv[7]);
            *(u32x4*)((bf16_t*)(ws + (MODE == 0 ? WS_Y : WS_PV)) + (size_t)orow * 2048 + ocol) = ov; }
    }
}

constexpr int PE_MAXT = 80;
constexpr int PE_IDX = 0, PE_W = PE_MAXT * 128 * 4, PE_SCR = 2 * PE_MAXT * 128 * 4, PE_SCRSZ = 16 * 132 * 4 + 4096 + 256;
__device__ __forceinline__ unsigned ordkey(float v) { const unsigned u = __float_as_uint(v); return (u & 0x80000000u) ? ~u : (u | 0x80000000u); }
__device__ __forceinline__ void phase_peer(KP p, int l, LAS unsigned char* lds, int wid0) {
    const int tid = tid_fresh(wid0), lane = tid & 63, w = __builtin_amdgcn_readfirstlane(tid >> 6), q4 = lane >> 4, c16 = lane & 15;
    unsigned char* ws = launder(p->ws);
    const bf16_t* QP = (const bf16_t*)(ws + WS_PV); const bf16_t* KEYS = (const bf16_t*)(ws + WS_KEYS);
    const bf16_t* XN = (const bf16_t*)(ws + WS_XN);
    float* X = (float*)(ws + WS_X); const float* mod = (const float*)(ws + WS_MOD) + (size_t)l * 3 * 12288;
    const int ntok = (l == 0) ? MR : NLAT, G = gridDim.x;
    const int per = (ntok + G - 1) / G; const int t_begin = blockIdx.x * per, t_end = min(ntok, t_begin + per);
    for (int tb = t_begin; tb < t_end; tb += PE_MAXT) {
        const int nt = min(PE_MAXT, t_end - tb);
        __syncthreads();
        const int ntask = (nt + 15) >> 4;
        if (w < ntask) {
            int lane_pe1 = lane; asm volatile("" : "+v"(lane_pe1));
            const int lane = lane_pe1, q4 = lane >> 4, c16 = lane & 15;
            LAS unsigned char* scr = lds + PE_SCR + w * PE_SCRSZ;
            LAS float* SC = (LAS float*)scr;
            LAS float* LS = (LAS float*)(scr + 16 * 132 * 4);
            LAS int* LI = (LAS int*)(scr + 16 * 132 * 4 + 2048);
            LAS unsigned char* PT = scr + 16 * 132 * 4 + 4096;
            if (lane < 52) {
                const int L = lane;
                const int ge16 = L >= 16, ge24 = L >= 24, ge29 = L >= 29, ge33 = L >= 33, ge36 = L >= 36, ge38 = L >= 38, ge40 = L >= 40, ge42 = L >= 42;
                int pa = ge16 + ge24 + ge29 + ge33 + ge36 + ge38 + ge40 + ge42; if (ge42) pa = 8 + (L - 42);
                int pb = L - (16 * ge16 + 8 * ge24 + 5 * ge29 + 4 * ge33 + 3 * ge36 + 2 * ge38 + 2 * ge40 + 2 * ge42); if (ge42) pb = 0;
                if (L >= 50) { pa = 15; pb = 15; }
                PT[lane * 2] = (unsigned char)pa; PT[lane * 2 + 1] = (unsigned char)pb;
            }
            const int tok_a = min(tb + 16 * w + c16, t_end - 1);
            const int tkl = lane >> 2, qq = lane & 3;
            for (int h = 0; h < 8; ++h) {
                for (int pp = 0; pp < 2; ++pp) {
                    const int hp = 2 * h + pp;
                    bf16x8 af[4];
#pragma unroll
                    for (int ks = 0; ks < 4; ++ks) af[ks] = *(const bf16x8*)(QP + (size_t)tok_a * 2048 + h * 256 + pp * 128 + ks * 32 + 8 * q4);
#pragma unroll 2
                    for (int ct = 0; ct < 8; ++ct) {
                        f32x4 acc = {0.f, 0.f, 0.f, 0.f};
#pragma unroll
                        for (int ks = 0; ks < 4; ++ks) { const bf16x8 bfr = *(const bf16x8*)(KEYS + ((size_t)hp * 128 + 16 * ct + c16) * 128 + ks * 32 + 8 * q4); acc = mfma16(af[ks], bfr, acc); }
#pragma unroll
                        for (int r = 0; r < 4; ++r) SC[(4 * q4 + r) * 132 + 16 * ct + c16] = acc[r];
                    }
                    asm volatile("s_waitcnt lgkmcnt(0)" ::: "memory");
                    unsigned key[32];
#pragma unroll
                    for (int i = 0; i < 8; ++i) { const f32x4 v = *(const LAS f32x4*)(SC + tkl * 132 + 32 * qq + 4 * i);
#pragma unroll
                        for (int j = 0; j < 4; ++j) key[4 * i + j] = (ordkey(v[j]) & ~127u) | (unsigned)(32 * qq + 4 * i + j); }
                    unsigned prev = 0xffffffffu;
#pragma unroll 1
                    for (int r = 0; r < 16; ++r) {
                        unsigned mxk = 0u;
#pragma unroll
                        for (int i = 0; i < 32; ++i) { const unsigned k = key[i] < prev ? key[i] : 0u; mxk = mxk > k ? mxk : k; }
                        unsigned o1 = __shfl_xor(mxk, 1); mxk = mxk > o1 ? mxk : o1; o1 = __shfl_xor(mxk, 2); mxk = mxk > o1 ? mxk : o1;
                        prev = mxk;
                        if (qq == (r & 3)) { const int idx = (int)(mxk & 127u); LS[(pp * 16 + tkl) * 16 + r] = SC[tkl * 132 + idx]; LI[(pp * 16 + tkl) * 16 + r] = idx; }
                    }
                    asm volatile("s_waitcnt lgkmcnt(0)" ::: "memory");
                }
                unsigned ck[13];
#pragma unroll
                for (int i = 0; i < 13; ++i) { const int cidx = qq + 4 * i;
                    if (cidx < 50) { const int a = PT[cidx * 2], bq = PT[cidx * 2 + 1]; const float sv = LS[(0 * 16 + tkl) * 16 + a] + LS[(1 * 16 + tkl) * 16 + bq]; ck[i] = (ordkey(sv) & ~63u) | (unsigned)cidx; }
                    else ck[i] = 0u; }
                unsigned prev = 0xffffffffu; float best0 = 0.f, esum = 0.f; float myexp[4] = {0.f, 0.f, 0.f, 0.f}; int myidx[4] = {0, 0, 0, 0};
#pragma unroll
                for (int r = 0; r < 16; ++r) {
                    unsigned mxk = 0u;
#pragma unroll
                    for (int i = 0; i < 13; ++i) { const unsigned k = ck[i] < prev ? ck[i] : 0u; mxk = mxk > k ? mxk : k; }
                    unsigned o1 = __shfl_xor(mxk, 1); mxk = mxk > o1 ? mxk : o1; o1 = __shfl_xor(mxk, 2); mxk = mxk > o1 ? mxk : o1;
                    prev = mxk;
                    const int cidx = (int)(mxk & 63u); const int a = PT[cidx * 2], bq = PT[cidx * 2 + 1];
                    const float best = LS[(0 * 16 + tkl) * 16 + a] + LS[(1 * 16 + tkl) * 16 + bq];
                    const int eidx = LI[(0 * 16 + tkl) * 16 + a] * 128 + LI[(1 * 16 + tkl) * 16 + bq];
                    if (r == 0) best0 = best;
                    const float e = __expf(best - best0); esum += e;
                    if (qq == (r & 3)) { myexp[r >> 2] = e; myidx[r >> 2] = eidx; }
                }
                const float inv = 1.0f / esum; const int tl = 16 * w + tkl;
                if (tl < nt) {
#pragma unroll
                    for (int i = 0; i < 4; ++i) { const int r = 4 * i + qq;
                        *(LAS int*)(lds + PE_IDX + (tl * 128 + h * 16 + r) * 4) = myidx[i];
                        *(LAS float*)(lds + PE_W + (tl * 128 + h * 16 + r) * 4) = myexp[i] * inv; }
                }
                asm volatile("s_waitcnt lgkmcnt(0)" ::: "memory");
            }
        }
        __syncthreads();
        int lane_pe2 = lane; asm volatile("" : "+v"(lane_pe2));
        for (int tl = w; tl < nt; tl += 8) {
            const int lane = lane_pe2;
            const int row = tb + tl;
            u32x16 xq;
#pragma unroll
            for (int i = 0; i < 4; ++i) { const u32x4 xw = *(const u32x4*)(XN + (size_t)row * 2048 + lane * 32 + i * 8); xq[4 * i] = xw.x; xq[4 * i + 1] = xw.y; xq[4 * i + 2] = xw.z; xq[4 * i + 3] = xw.w; }
            const LAS int* idxp = (const LAS int*)(lds + PE_IDX + tl * 512);
            LAS float* wp = (LAS float*)(lds + PE_W + tl * 512);
            u32x6 bufA[2], bufB[2], bufC[2];
#define PE_ISSUE(buf, TAB, b) do { const int _e0 = idxp[2 * (b)], _e1 = idxp[2 * (b) + 1]; \
                const unsigned char* _r0 = (TAB) + (size_t)_e0 * 1536 + lane * 24; const unsigned char* _r1 = (TAB) + (size_t)_e1 * 1536 + lane * 24; \
                { const u32x4 _a = *(const u32x4*)_r0; const u32x2 _b = *(const u32x2*)(_r0 + 16); buf[0][0] = _a.x; buf[0][1] = _a.y; buf[0][2] = _a.z; buf[0][3] = _a.w; buf[0][4] = _b.x; buf[0][5] = _b.y; } \
                { const u32x4 _a = *(const u32x4*)_r1; const u32x2 _b = *(const u32x2*)(_r1 + 16); buf[1][0] = _a.x; buf[1][1] = _a.y; buf[1][2] = _a.z; buf[1][3] = _a.w; buf[1][4] = _b.x; buf[1][5] = _b.y; } } while (0)
#define PE_CONS_U(buf, b) do { float _p[2]; \
                _Pragma("unroll") for (int _j = 0; _j < 2; ++_j) { const u32x16 _ub = __builtin_bit_cast(u32x16, __builtin_amdgcn_cvt_scalef32_pk32_bf16_fp6(buf[_j], 1.0f)); float _d = 0.f; \
                    _Pragma("unroll") for (int _q = 0; _q < 16; ++_q) _d = dot2bf(_ub[_q], xq[_q], _d); \
                    _p[_j] = _d * (1.0f / 64.0f); } \
                const bool _h32 = (lane & 32) != 0; \
                float _c = _h32 ? _p[1] : _p[0]; const float _cs = _h32 ? _p[0] : _p[1]; _c += __shfl_xor(_cs, 32); \
                _c += __shfl_xor(_c, 16); _c += __shfl_xor(_c, 8); _c += __shfl_xor(_c, 4); _c += __shfl_xor(_c, 2); _c += __shfl_xor(_c, 1); \
                const int _e = 2 * (b) + (lane >> 5); const float _g = wp[_e]; \
                const float _w = _g * 0.5f * _c * (1.0f + erff(_c * 0.70710678118654752f)); \
                if ((lane & 31) == 0) wp[_e] = _w; } while (0)
#define PE_CONS_V(buf, b) do { const f32x2 _w2 = *(const LAS f32x2*)(wp + 2 * (b)); \
                _Pragma("unroll") for (int _j = 0; _j < 2; ++_j) { const f32x32 _vf = __builtin_amdgcn_cvt_scalef32_pk32_f32_fp6(buf[_j], 1.0f); const float _wv = _w2[_j]; \
                    outv += _vf * _wv; } } while (0)
            const unsigned char* TU = ws + WS_PU; const unsigned char* TV = ws + WS_PVW;
            PE_ISSUE(bufA, TU, 0); PE_ISSUE(bufB, TU, 1);
#pragma unroll 1
            for (int b = 0; b < 63; b += 3) {
                PE_ISSUE(bufC, TU, b + 2); PE_CONS_U(bufA, b);
                PE_ISSUE(bufA, TU, b + 3); PE_CONS_U(bufB, b + 1);
                if (b + 4 < 64) PE_ISSUE(bufB, TU, b + 4); else PE_ISSUE(bufB, TV, 0);
                PE_CONS_U(bufC, b + 2);
            }
            PE_ISSUE(bufC, TV, 1);
            PE_CONS_U(bufA, 63);
            asm volatile("s_waitcnt lgkmcnt(0)" ::: "memory");
            f32x32 outv = 0.f;
#pragma unroll 1
            for (int b = 0; b < 63; b += 3) {
                PE_ISSUE(bufA, TV, b + 2); PE_CONS_V(bufB, b);
                PE_ISSUE(bufB, TV, b + 3); PE_CONS_V(bufC, b + 1);
                if (b + 4 < 64) PE_ISSUE(bufC, TV, b + 4);
                PE_CONS_V(bufA, b + 2);
            }
            PE_CONS_V(bufB, 63);
#undef PE_ISSUE
#undef PE_CONS_U
#undef PE_CONS_V
            float out[32];
#pragma unroll
            for (int i = 0; i < 32; ++i) out[i] = outv[i];
            const int which = row < NLAT ? (row >> 13) : 2;
            const float* mg = mod + (size_t)which * 12288 + 5 * 2048;
            float* xrow = X + (size_t)row * 2048; float* orow = (l == 1) ? (p->out + (size_t)row * 2048) : xrow;
#pragma unroll
            for (int hh = 0; hh < 8; ++hh) { const int c = lane * 32 + hh * 4;
                const f32x4 xv = *(const f32x4*)(xrow + c), gv = *(const f32x4*)(mg + c);
                f32x4 ov; ov[0] = xv[0] + gv[0] * out[hh * 4 + 0] * 0.25f; ov[1] = xv[1] + gv[1] * out[hh * 4 + 1] * 0.25f; ov[2] = xv[2] + gv[2] * out[hh * 4 + 2] * 0.25f; ov[3] = xv[3] + gv[3] * out[hh * 4 + 3] * 0.25f;
                *(f32x4*)(orow + c) = ov; }
        }
    }
}

#if !MK_SINGLE
#define LOHI_ARGS , const int lo, const int hi
#define LOHI_PASS , lo, hi
#else
#define LOHI_ARGS
#define LOHI_PASS
#endif
#ifndef PHM
#define PHM 0x7ff
#endif
#if MK_SINGLE
#define IN(k) (((PHM >> (((k) % NPH))) & 1) != 0)
#define SEAM(k) do { if ((k) + 1 < 2 * NPH) xcd_barrier(bar); } while (0)
#else
#define IN(k) (((PHM >> (((k) % NPH))) & 1) && lo <= (k) && (k) < hi)
#define SEAM(k) do { if (IN(k) && IN((k) + 1)) xcd_barrier(bar); } while (0)
#endif
template <int l>
__device__ __forceinline__ void layer_program(KP kp, unsigned char* ws0, LAS unsigned char* lds, const XcdBarrier& bar, const int G, const int wid0 LOHI_ARGS) {
        const int pb = l * NPH;
        const int M2 = (l == 0) ? MR : NLAT;
        constexpr int MG = NLAT;
        if (IN(pb + 0)) { phase_w(launder_p(kp), l, lds, wid0); } SEAM(pb + 0);
        if (IN(pb + 1)) { phase_norm(launder_p(kp), l, 0, MR, wid0); } SEAM(pb + 1);
        if (IN(pb + 2)) { unsigned char* ws = launder(ws0);
            { pg8::PlainOrder S; S.init(ws + WS_XN8, ws + WS_WIN, MR, 72 * 256, 1024, G, (int)blockIdx.x); S.skip_from = 48; S.skip_cnt = 24;
              pg8::EpiProj E{ws};
              pg8::gemm_phase<pg8::EpiProj, pg8::PlainOrder, true>(lds, 1024, S, E, wid0); }
            { pg8::PlainOrder S; S.init(ws + WS_XN, ws + WS_WINB, MR, 24 * 256, 2048, G, (int)blockIdx.x); S.pn_base = 48; S.b_row0 = 48;
              pg8::EpiProj E{ws};
              pg8::gemm_phase<pg8::EpiProj, pg8::PlainOrder, false>(lds, 2048, S, E, wid0); }
        } SEAM(pb + 2);
        if (IN(pb + 3)) { phase_gates_gemm(launder_p(kp), l, wid0); phase_e1(launder_p(kp), l, wid0); } SEAM(pb + 3);
        if (IN(pb + 4)) { phase_mlstm(launder_p(kp), l, lds, wid0); phase_attn(launder_p(kp), l, lds, wid0); } SEAM(pb + 4);
        if (IN(pb + 5)) { phase_e2(launder_p(kp), l, M2, wid0); } SEAM(pb + 5);
        if (IN(pb + 6)) { unsigned char* ws = launder(ws0);
            pg8::BranchOrder S; S.T8 = (const char*)(ws + WS_T8); S.WA = (const char*)(ws + WS_WA);
            S.nM = MG / 256; S.nN = 8; S.G = G; S.c = (int)blockIdx.x; S.tstep = (size_t)256 * 2048 * 2;
            pg8::EpiMerge E{(bf16_t*)(ws + WS_Y), (const bf16_t*)(ws + WS_GT)};
            pg8::gemm_phase<pg8::EpiMerge, pg8::BranchOrder>(lds, 2048, S, E, wid0);
            if (l == 0) ctx_gemm<0>(launder_p(kp), l, lds, wid0);
        } SEAM(pb + 6);
        if (IN(pb + 7)) { unsigned char* ws = launder(ws0);
            pg8::PlainOrder S; S.init(ws + WS_Y, ws + WS_WO, MG, 2048, 2048, G, (int)blockIdx.x);
            pg8::EpiRes E{(float*)(ws + WS_X), (const float*)(ws + WS_MOD) + (size_t)l * 3 * 12288};
            pg8::gemm_phase<pg8::EpiRes, pg8::PlainOrder>(lds, 2048, S, E, wid0);
            if (l == 0) ctx_gemm<1>(launder_p(kp), l, lds, wid0);
        } SEAM(pb + 7);
        if (IN(pb + 8)) { phase_norm(launder_p(kp), l, 1, M2, wid0); } SEAM(pb + 8);
        if (IN(pb + 9)) { unsigned char* ws = launder(ws0);
            pg8::PlainOrder S; S.init(ws + WS_XN, ws + WS_WQ, MG, 2048, 2048, G, (int)blockIdx.x);
            pg8::EpiBf E{(bf16_t*)(ws + WS_PV), 2048};
            pg8::gemm_phase<pg8::EpiBf, pg8::PlainOrder>(lds, 2048, S, E, wid0);
            if (l == 0) ctx_gemm<2>(launder_p(kp), l, lds, wid0);
        } SEAM(pb + 9);
        if (IN(pb + 10)) { phase_peer(launder_p(kp), l, lds, wid0); } SEAM(pb + 10);
    }
#undef IN
#undef SEAM

__global__ void __launch_bounds__(NTHREADS, 2) fwd_kernel(Params p) {
    extern __shared__ __attribute__((aligned(16))) unsigned char lds_raw[];
    LAS unsigned char* lds = (LAS unsigned char*)lds_raw;
    const int tid = threadIdx.x, G = gridDim.x;
    const int wid0 = __builtin_amdgcn_readfirstlane(tid >> 6);
    KP kp = (KP)__builtin_amdgcn_kernarg_segment_ptr();
    unsigned char* ws0 = kp->ws;
    volatile LAS unsigned* bst = (volatile LAS unsigned*)(lds + LDS_BYTES - 16);
    if (tid == 0) { bst[0] = 0u; bst[1] = 0u; bst[2] = 0u; bst[3] = 0u; }
    __syncthreads();
    XcdBarrier bar; bar.bar = (unsigned*)(ws0 + WS_BAR); bar.x = 0; bar.st = bst;
    if (MK_SINGLE) bar = xcd_barrier_post((unsigned*)(ws0 + WS_BAR), bst);
#if !MK_SINGLE
    const int lo = kp->ph_lo, hi = kp->ph_hi;
#endif
    layer_program<0>(kp, ws0, lds, bar, G, wid0 LOHI_PASS);
    layer_program<1>(kp, ws0, lds, bar, G, wid0 LOHI_PASS);
}

#ifdef CUT
#ifndef DUMP_OFF
#define DUMP_OFF WS_PV
#endif
#ifndef DUMP_F32
#define DUMP_F32 0
#endif
#ifndef DUMP_N
#define DUMP_N ((size_t)NLAT * DM)
#endif
__global__ void dump_kernel(const unsigned char* ws, float* out, size_t n) {
    for (size_t i = (size_t)blockIdx.x * blockDim.x + threadIdx.x; i < n; i += (size_t)gridDim.x * blockDim.x)
        out[i] = (i >= (size_t)DUMP_N) ? 0.f : (DUMP_F32 ? ((const float*)(ws + DUMP_OFF))[i] : bf2f(((const bf16_t*)(ws + DUMP_OFF))[i]));
}
#endif
extern "C" void kernel_launch(void* const* d_in, const int* in_sizes, int n_in, void* d_out, int out_size, void* d_ws, size_t ws_size, hipStream_t stream) {
    static int grid = 0;
    if (grid == 0) {
        if (n_in != 21 || in_sizes[0] != NLAT * DM || out_size != NLAT * DM || ws_size < WS_END) {
            fprintf(stderr, "kernel_launch: unexpected shapes (n_in %d, in0 %d, out %d, ws %zu need %zu); nothing launched\n", n_in, n_in > 0 ? in_sizes[0] : -1, out_size, ws_size, (size_t)WS_END); grid = -1; return; }
        int dev = 0, cus = 0, per_cu = 0;
        if (hipGetDevice(&dev) != hipSuccess || hipDeviceGetAttribute(&cus, hipDeviceAttributeMultiprocessorCount, dev) != hipSuccess) { grid = -1; return; }
        if (hipFuncSetAttribute((const void*)fwd_kernel, hipFuncAttributeMaxDynamicSharedMemorySize, LDS_BYTES) != hipSuccess) { fprintf(stderr, "kernel_launch: hipFuncSetAttribute failed\n"); grid = -1; return; }
        if (hipOccupancyMaxActiveBlocksPerMultiprocessor(&per_cu, (const void*)fwd_kernel, NTHREADS, LDS_BYTES) != hipSuccess || per_cu < 1) { fprintf(stderr, "kernel_launch: occupancy query says %d\n", per_cu); }
        (void)hipGetLastError();
        grid = cus;
    }
    if (grid < 0) return;
    (void)hipMemsetAsync((char*)d_ws, 0, CTL_BYTES, stream);
    Params p{};
    const float** pp = (const float**)&p;
    for (int i = 0; i < 21; ++i) pp[i] = (const float*)d_in[i];
    p.out = (float*)d_out; p.ws = (unsigned char*)d_ws;
#if MK_SINGLE
    p.ph_lo = 0; p.ph_hi = 2 * NPH;
    hipLaunchKernelGGL(fwd_kernel, dim3(grid), dim3(NTHREADS), LDS_BYTES, stream, p);
#else
#ifdef CUT
    for (int k = 0; k <= CUT; ++k) { p.ph_lo = k; p.ph_hi = k + 1; hipLaunchKernelGGL(fwd_kernel, dim3(grid), dim3(NTHREADS), LDS_BYTES, stream, p); }
    hipLaunchKernelGGL(dump_kernel, dim3(1024), dim3(256), 0, stream, (const unsigned char*)d_ws, (float*)d_out, (size_t)NLAT * DM);
#else
    for (int k = 0; k < 2 * NPH; ++k) { p.ph_lo = k; p.ph_hi = k + 1; hipLaunchKernelGGL(fwd_kernel, dim3(grid), dim3(NTHREADS), LDS_BYTES, stream, p); }
#endif
#endif
}
```

```cpp
#include <hip/hip_runtime.h>
#include <stdint.h>
#include <stdio.h>
#include <type_traits>

#ifndef ABL
#define ABL 0
#endif
#ifndef MK_SINGLE
#define MK_SINGLE 1
#endif

#define LAS __attribute__((address_space(3)))
typedef unsigned short bf16_t;
typedef short bf16x8 __attribute__((ext_vector_type(8)));
typedef float f32x4 __attribute__((ext_vector_type(4)));
typedef float f32x2 __attribute__((ext_vector_type(2)));
typedef unsigned u32x4 __attribute__((ext_vector_type(4)));
typedef unsigned u32x2 __attribute__((ext_vector_type(2)));
typedef __bf16 bf2_t __attribute__((ext_vector_type(2)));
typedef int i32x4 __attribute__((ext_vector_type(4)));
typedef int i32x8 __attribute__((ext_vector_type(8)));
typedef float f32x16 __attribute__((ext_vector_type(16)));
typedef float f32x32 __attribute__((ext_vector_type(32)));
typedef unsigned u32x6 __attribute__((ext_vector_type(6)));
typedef __bf16 bf16x32_t __attribute__((ext_vector_type(32)));
typedef unsigned u32x16 __attribute__((ext_vector_type(16)));
typedef short s16x4 __attribute__((ext_vector_type(4)));
#ifndef FP6_INTERLEAVED
#define FP6_INTERLEAVED 1
#endif

constexpr int DM = 2048, NBATCH = 2, SEQ = 8192, CTXL = 256;
constexpr int NLAT = NBATCH * SEQ;
constexpr int NCTX = NBATCH * CTXL;
constexpr int MR = NLAT + NCTX;
constexpr int PROJ_W = 24608;
constexpr int NPROJ = 24576;
constexpr int NTHREADS = 512;
constexpr int LDS_BYTES = 163840;
constexpr int NPH = 11;
constexpr float EPSF = 1e-6f;

constexpr size_t SZ_A = (size_t)MR * 2048 * 2;
constexpr size_t WS_BAR = 0;
constexpr size_t WS_MOD = 16384;
constexpr size_t CTL_BYTES = 16384 + 2 * 3 * 12288 * 4;
constexpr size_t WS_TAB = 311296;
constexpr size_t WS_X = WS_TAB + 32768;
constexpr size_t WS_XN = WS_X + (size_t)MR * 2048 * 4;
constexpr size_t WS_Y = WS_XN + SZ_A;
constexpr size_t WS_XN8 = WS_Y;
constexpr size_t WS_PQ = WS_Y + SZ_A;
constexpr size_t WS_PK = WS_PQ + SZ_A / 2;
constexpr size_t WS_T8 = WS_PK + SZ_A / 2;
constexpr size_t WS_PV = WS_T8 + 0 * SZ_A;
constexpr size_t WS_PO = WS_T8 + 1 * SZ_A;
constexpr size_t WS_CQ = WS_T8 + 2 * SZ_A;
constexpr size_t WS_CK = WS_T8 + 3 * SZ_A;
constexpr size_t WS_CV = WS_T8 + 4 * SZ_A;
constexpr size_t WS_BB = WS_T8 + 5 * SZ_A;
constexpr size_t WS_BC = WS_T8 + 6 * SZ_A;
constexpr size_t WS_BX = WS_T8 + 7 * SZ_A;
constexpr size_t WS_GT = WS_T8 + 8 * SZ_A;
constexpr size_t WS_GATES = WS_GT + 3 * SZ_A;
constexpr size_t WS_WIN = WS_GATES + (size_t)MR * 32 * 4;
constexpr size_t WS_WINB = WS_WIN + (size_t)NPROJ * 2048;
constexpr size_t WS_WG = WS_WIN + (size_t)NPROJ * 2048 * 2;
constexpr size_t SZ_W = (size_t)2048 * 2048 * 2;
constexpr size_t WS_WA = WS_WG + 32 * 2048 * 2;
constexpr size_t WS_WB = WS_WA + SZ_W;
constexpr size_t WS_WC = WS_WB + SZ_W;
constexpr size_t WS_WO = WS_WC + SZ_W;
constexpr size_t WS_WQ = WS_WO + SZ_W;
constexpr size_t WS_KEYS = WS_WQ + SZ_W;
constexpr size_t WS_PU = WS_KEYS + 16 * 128 * 128 * 2;
constexpr size_t WS_PVW = WS_PU + (size_t)16384 * 2048 * 2;
constexpr size_t WS_SCAN = WS_PU + (size_t)16384 * 2048;
constexpr size_t WS_END = WS_PVW + (size_t)16384 * 2048 * 2;

struct Params {
    const float *x, *c, *ctx, *c_ctx, *w_ada, *b_ada, *norm_g, *w_in, *a_gate_b, *a_hnorm_g, *b_conv, *c_qk_g, *c_rpb,
        *w_a_out, *w_b_out, *w_c_out, *w_out, *peer_wq, *peer_keys, *peer_u, *peer_v;
    float* out; unsigned char* ws; int ph_lo, ph_hi;
};
#define CAS __attribute__((address_space(4)))
typedef const CAS Params* KP;
__device__ __forceinline__ KP launder_p(KP q) { asm volatile("" : "+s"(q)); return q; }

__device__ __forceinline__ unsigned char* launder(unsigned char* q) { size_t z = 0; asm volatile("" : "+s"(z)); return q + z; }
__device__ __forceinline__ int tid_fresh(int wid0) { int t = wid0 * 64 + (int)__builtin_amdgcn_mbcnt_hi(~0u, __builtin_amdgcn_mbcnt_lo(~0u, 0u)); asm volatile("" : "+v"(t)); return t; }

__device__ __forceinline__ float bf2f(unsigned b) { return __uint_as_float(b << 16); }
__device__ __forceinline__ float bflo(unsigned w) { return __uint_as_float(w << 16); }
__device__ __forceinline__ float bfhi(unsigned w) { return __uint_as_float(w & 0xffff0000u); }
__device__ __forceinline__ unsigned pk2(float lo, float hi) { f32x2 v = {lo, hi}; bf2_t b = __builtin_convertvector(v, bf2_t); return __builtin_bit_cast(unsigned, b); }
__device__ __forceinline__ bf16_t f2bf(float f) { return (bf16_t)(pk2(f, 0.f) & 0xffffu); }
__device__ __forceinline__ f32x4 mfma16(bf16x8 a, bf16x8 b, f32x4 c) { return __builtin_amdgcn_mfma_f32_16x16x32_bf16(a, b, c, 0, 0, 0); }
__device__ __forceinline__ float dot2bf(unsigned a, unsigned b, float c) { return __builtin_amdgcn_fdot2_f32_bf16(__builtin_bit_cast(bf2_t, a), __builtin_bit_cast(bf2_t, b), c, false); }
#define LDS_BARRIER() do { asm volatile("s_waitcnt lgkmcnt(0)" ::: "memory"); __builtin_amdgcn_s_barrier(); asm volatile("" ::: "memory"); } while (0)
__device__ __forceinline__ float wave_sum(float v) {
#pragma unroll
    for (int o = 32; o >= 1; o >>= 1) v += __shfl_xor(v, o);
    return v;
}
__device__ __forceinline__ float sigmoidf_(float v) { return __builtin_amdgcn_rcpf(1.0f + __expf(-v)); }
__device__ __forceinline__ float logsigmoidf_(float v) { return fminf(v, 0.f) - log1pf(__expf(-fabsf(v))); }

#define XB_TMO      128
#define XB_XCNT(j)  (256  + 64 * (j))
#define XB_XSUB(j)  (1280 + 64 * (j))
#define XB_XGEN(j)  (2304 + 64 * (j))
#define XB_TOP      3328
#define XB_TOPGEN   3392
#define XCD_BAR_WORDS 3456
#define XB_SPIN_CAP (1u << 22)
__device__ __forceinline__ unsigned xb_ld(unsigned* p)              { return __hip_atomic_load(p, __ATOMIC_RELAXED, __HIP_MEMORY_SCOPE_AGENT); }
__device__ __forceinline__ unsigned xb_add(unsigned* p, unsigned v) { return __hip_atomic_fetch_add(p, v, __ATOMIC_RELAXED, __HIP_MEMORY_SCOPE_AGENT); }
__device__ __forceinline__ unsigned xb_xcc_id() { return (unsigned)__builtin_amdgcn_s_getreg((3 << 11) | 20) & 0xFu; }
#define XB_SPIN(cond, bar) do { unsigned _sp = 0; while (cond) { __builtin_amdgcn_s_sleep(1); \
    if ((++_sp & 255u) == 0u) { if (xb_ld(&(bar)[XB_TMO])) break; if (_sp > XB_SPIN_CAP) { atomicAdd(&(bar)[XB_TMO], 1u); break; } } } } while (0)
struct XcdBarrier { unsigned* bar; unsigned x; volatile LAS unsigned* st; };
__device__ __forceinline__ XcdBarrier xcd_barrier_post(unsigned* bar, volatile LAS unsigned* st) {
    XcdBarrier b; b.bar = bar; b.x = xb_xcc_id(); b.st = st;
    if (threadIdx.x == 0) (void)xb_add(&bar[XB_XCNT(b.x)], 1u);
    return b;
}
__device__ __forceinline__ void xcd_barrier_complete(unsigned* bar, unsigned x, unsigned& nloc, unsigned& nx) {
    const unsigned G = gridDim.x * gridDim.y * gridDim.z;
    unsigned sum, cnt, mine, sp = 0u;
    for (;;) {
        sum = 0u; cnt = 0u; mine = 0u;
#pragma unroll
        for (unsigned j = 0; j < 16; ++j) { const unsigned c = xb_ld(&bar[XB_XCNT(j)]); sum += c; cnt += (c > 0u) ? 1u : 0u; mine = (j == x) ? c : mine; }
        if (sum == G) break;
        __builtin_amdgcn_s_sleep(1);
        if ((++sp & 255u) == 0u) { if (xb_ld(&bar[XB_TMO])) break; if (sp > XB_SPIN_CAP) { atomicAdd(&bar[XB_TMO], 1u); break; } }
    }
    nloc = mine > 0u ? mine : 1u; nx = cnt > 0u ? cnt : 1u;
}
__device__ __forceinline__ void xcd_barrier(const XcdBarrier& b) {
    asm volatile("s_waitcnt vmcnt(0)" ::: "memory");
    __syncthreads();
    if (threadIdx.x == 0) {
        unsigned* bar = b.bar;
        __builtin_amdgcn_s_waitcnt(0);
        unsigned nloc = b.st[0], nx = b.st[1];
        if (nloc == 0u) { xcd_barrier_complete(bar, b.x, nloc, nx); b.st[0] = nloc; b.st[1] = nx; }
        const unsigned old = xb_add(&bar[XB_XSUB(b.x)], 1u);
        const unsigned gen = old / nloc;
        if (old + 1u == (gen + 1u) * nloc) {
            __builtin_amdgcn_fence(__ATOMIC_RELEASE, "agent");
            asm volatile("s_waitcnt vmcnt(0)" ::: "memory");
            const unsigned og = xb_add(&bar[XB_TOP], 1u);
            const unsigned tg = og / nx;
            if (og + 1u == (tg + 1u) * nx) xb_add(&bar[XB_TOPGEN], 1u);
            else XB_SPIN(xb_ld(&bar[XB_TOPGEN]) == tg, bar);
            __builtin_amdgcn_fence(__ATOMIC_ACQUIRE, "agent");
            xb_add(&bar[XB_XGEN(b.x)], 1u);
            asm volatile("s_waitcnt vmcnt(0)" ::: "memory");
        } else {
            XB_SPIN(xb_ld(&bar[XB_XGEN(b.x)]) == gen, bar);
            __builtin_amdgcn_fence(__ATOMIC_ACQUIRE, "agent");
            asm volatile("s_waitcnt vmcnt(0)" ::: "memory");
        }
    }
    __syncthreads();
}

namespace pg8 {
constexpr int BM = 256, BK = 64, HALF = 128, HTB = HALF * BK * 2, STAGE_BYTES = 8 * HTB, NXCD = 8, WGM = 8;
__host__ __device__ __forceinline__ int lds_byte(int r, int c) { const int st = (r >> 4) * 2 + (c >> 5), rr = r & 15, cc = c & 31, ob = rr * 64 + cc * 2; return st * 1024 + (ob ^ (((ob >> 9) & 1) << 5)); }
__host__ __device__ __forceinline__ void stage_rc(int b, int& R, int& C) { const int st = b / 1024, sb = b % 1024, swz = sb ^ (((sb >> 9) & 1) << 5); R = (st >> 1) * 16 + swz / 64; C = (st & 1) * 32 + (swz % 64) / 2; }
__host__ __device__ __forceinline__ int perm32(int rho) { const int n = rho >> 4, i = rho & 15; return 8 * (i >> 2) + 4 * n + (i & 3); }

struct Unit { int pm, pn, br; const char* A; const char* B; };

__device__ __forceinline__ bool tile_of(int L, int nM, int nN, int& pm, int& pn) {
    const int nwg = nM * nN; if (L >= nwg) return false;
    int wgid = L; { const int q = nwg / NXCD, r = nwg % NXCD, xcd = wgid % NXCD, off = wgid / NXCD; wgid = (xcd < r ? xcd * (q + 1) : r * (q + 1) + (xcd - r) * q) + off; }
    const int nig = WGM * nN, gid = wgid / nig, fm = gid * WGM, gsz = (nM - fm) < WGM ? (nM - fm) : WGM;
    pm = fm + ((wgid % nig) % gsz); pn = (wgid % nig) / gsz; return true;
}
struct PlainOrder {
    const char* A; const char* Bt; int nM, nN, G, c; size_t tstep; int pn_base, skip_from, skip_cnt, b_row0;
    __device__ __forceinline__ void init(const void* A_, const void* Bt_, int M, int N, int K, int G_, int c_) { A = (const char*)A_; Bt = (const char*)Bt_; nM = M / BM; nN = N / BM; G = G_; c = c_; tstep = (size_t)BM * K * 2;
        pn_base = 0; skip_from = 1 << 30; skip_cnt = 0; b_row0 = 0; }
    __device__ __forceinline__ bool next(int i, Unit& u) const {
        int pm, pn; if (!tile_of(i * G + c, nM, nN, pm, pn)) return false;
        pn += pn_base; if (pn >= skip_from) pn += skip_cnt;
        u.pm = pm; u.pn = pn; u.br = 0; u.A = A + (size_t)pm * tstep; u.B = Bt + (size_t)(pn - b_row0) * tstep; return true;
    }
};
struct BranchOrder {
    const char* T8; const char* WA; int nM, nN, G, c; size_t tstep;
    __device__ __forceinline__ bool next(int i, Unit& u) const {
        const int tl = i / 3, br = i - 3 * tl; int pm, pn; if (!tile_of(tl * G + c, nM, nN, pm, pn)) return false;
        u.pm = pm; u.pn = pn; u.br = br;
        const int ti = 1 + 4 * (br == 1) + (br == 2);
        u.A = T8 + (size_t)ti * SZ_A + (size_t)pm * tstep; u.B = WA + (size_t)br * SZ_W + (size_t)pn * tstep; return true;
    }
};

template <class Epi, class Sched, bool FP8 = false>
__device__ __forceinline__ void gemm_phase(LAS unsigned char* lds, const int K, const Sched& S, const Epi& E, int wid0) {
    const int tid = tid_fresh(wid0), wid = __builtin_amdgcn_readfirstlane(tid >> 6), lane = tid & 63, wr = wid >> 2, wc = wid & 3, fr = lane & 15, fq = lane >> 4;
    const int nt = K / BK;
    unsigned voffA[2], voffB[2];
#pragma unroll
    for (int i = 0; i < 2; ++i) { int R, C; stage_rc(tid * 16 + i * 8192, R, C); const int Rb = Epi::PERM ? ((R & ~31) + perm32(R & 31)) : R;
        voffA[i] = (unsigned)(R * K + C) * 2u; voffB[i] = (unsigned)(Rb * K + C) * 2u; }
    const size_t kstep = (size_t)(BK * 2);
    const size_t hstep = (size_t)HALF * K * 2;
    const unsigned ldsw = (unsigned)wid * 1024u;
    const int aoff = lds_byte(wr * 64 + fr, fq * 8), boff = lds_byte(wc * 32 + fr, fq * 8);
#define PG8_SA(b, h) (((b) * 2 + (h)) * HTB)
#define PG8_SB(b, h) ((4 + (b) * 2 + (h)) * HTB)
#define PG8_STAGE(bufoff, gbase, voff) do { _Pragma("unroll") for (int _i = 0; _i < 2; ++_i) \
        __builtin_amdgcn_global_load_lds((const unsigned*)((const char*)(gbase) + (voff)[_i]), (LAS unsigned*)(lds + (bufoff) + ldsw + _i * 8192), 16, 0, 0); } while (0)
#define PG8_LD1(dstv, addr) do { if constexpr (FP8) { const i32x4 _lo = *(const LAS i32x4*)(lds + (addr)), _hi = *(const LAS i32x4*)(lds + (addr) + 1024); dstv[0] = __builtin_shufflevector(_lo, _hi, 0, 1, 2, 3, 4, 5, 6, 7); } \
        else { _Pragma("unroll") for (int k = 0; k < 2; ++k) dstv[k] = *(const LAS bf16x8*)(lds + (addr) + k * 1024); } } while (0)
#define PG8_LDA(dst, b, h) do { _Pragma("unroll") for (int m = 0; m < 4; ++m) PG8_LD1(dst[m], PG8_SA(b, h) + aoff + m * 2048); } while (0)
#define PG8_LDB(dst, b, h) do { _Pragma("unroll") for (int n = 0; n < 2; ++n) PG8_LD1(dst[n], PG8_SB(b, h) + boff + n * 2048); } while (0)
#define PG8_MMA(ai, bj, At, Bt) do { __builtin_amdgcn_s_setprio(1); _Pragma("unroll") for (int m = 0; m < 4; ++m) _Pragma("unroll") for (int n = 0; n < 2; ++n) { \
        if constexpr (FP8) asm volatile("v_mfma_scale_f32_16x16x128_f8f6f4 %0, %1, %2, %0, %3, %4 op_sel_hi:[0,0,0]" : "+v"(acc[ai][bj][m][n]) : "v"(Bt[n][0]), "v"(At[m][0]), "v"(sclW), "v"(sclX)); \
        else { _Pragma("unroll") for (int k = 0; k < 2; ++k) acc[ai][bj][m][n] = __builtin_amdgcn_mfma_f32_16x16x32_bf16(Bt[n][k], At[m][k], acc[ai][bj][m][n], 0, 0, 0); } } \
        __builtin_amdgcn_s_setprio(0); } while (0)
#define PG8_WAIT_V(n) asm volatile("s_waitcnt vmcnt(" #n ")" ::: "memory")
#define PG8_WAIT_L(n) asm volatile("s_waitcnt lgkmcnt(" #n ")" ::: "memory")
#define PG8_BAR __builtin_amdgcn_s_barrier()
#define PG8_SCHED __builtin_amdgcn_sched_barrier(0)
    Unit cur, nxt; int ui = 0;
    if (!S.next(0, cur)) return;
    const int sclW = 0x75757575, sclX = 0x7F7F7F7F;
    f32x4 acc[2][2][4][2];
#pragma unroll
    for (int a = 0; a < 2; ++a)
#pragma unroll
        for (int b = 0; b < 2; ++b)
#pragma unroll
            for (int m = 0; m < 4; ++m)
#pragma unroll
                for (int n = 0; n < 2; ++n) acc[a][b][m][n] = (f32x4){0.f, 0.f, 0.f, 0.f};
    typedef typename std::conditional<FP8, i32x8, bf16x8>::type frag_t;
    frag_t At[4][FP8 ? 1 : 2], B0[2][FP8 ? 1 : 2], B1[2][FP8 ? 1 : 2];
    const char* cA = cur.A; const char* cB = cur.B;
    PG8_STAGE(PG8_SB(0, 0), cB, voffB); PG8_STAGE(PG8_SA(0, 0), cA, voffA); PG8_STAGE(PG8_SB(0, 1), cB + hstep, voffB); PG8_STAGE(PG8_SA(0, 1), cA + hstep, voffA);
    if (wr == 1) PG8_BAR;
    PG8_WAIT_V(4); PG8_BAR;
    PG8_STAGE(PG8_SB(1, 0), cB + kstep, voffB); PG8_STAGE(PG8_SA(1, 0), cA + kstep, voffA); PG8_STAGE(PG8_SB(1, 1), cB + hstep + kstep, voffB);
    PG8_WAIT_V(6); PG8_BAR;
    for (;;) {
        const bool has_next = S.next(ui + 1, nxt);
        const char* nA = has_next ? nxt.A : cA; const char* nB = has_next ? nxt.B : cB;
        for (int t = 0; t < nt; t += 2) {
            const bool last = (t == nt - 2);
            const char* a1 = cA + (size_t)(t + 1) * kstep;
            const char* a2 = last ? nA : cA + (size_t)(t + 2) * kstep; const char* b2 = last ? nB : cB + (size_t)(t + 2) * kstep;
            const char* a3 = a2 + kstep; const char* b3 = b2 + kstep;
            PG8_LDB(B0, 0, 0); PG8_SCHED; PG8_LDA(At, 0, 0); PG8_STAGE(PG8_SA(1, 1), a1 + hstep, voffA);
            PG8_WAIT_L(8); PG8_BAR; PG8_WAIT_L(0); PG8_MMA(0, 0, At, B0); PG8_BAR; PG8_SCHED;
            PG8_LDB(B1, 0, 1); PG8_STAGE(PG8_SB(0, 0), b2, voffB);
            PG8_BAR; PG8_WAIT_L(0); PG8_MMA(0, 1, At, B1); PG8_BAR;
            PG8_LDA(At, 0, 1); PG8_STAGE(PG8_SA(0, 0), a2, voffA);
            PG8_BAR; PG8_WAIT_L(0); PG8_MMA(1, 0, At, B0); PG8_BAR; PG8_SCHED;
            PG8_STAGE(PG8_SB(0, 1), b2 + hstep, voffB);
            PG8_WAIT_V(6); PG8_BAR; PG8_MMA(1, 1, At, B1); PG8_BAR;
            PG8_LDB(B0, 1, 0); PG8_SCHED; PG8_LDA(At, 1, 0); PG8_STAGE(PG8_SA(0, 1), a2 + hstep, voffA);
            PG8_WAIT_L(8); PG8_BAR; PG8_WAIT_L(0); PG8_MMA(0, 0, At, B0); PG8_BAR; PG8_SCHED;
            PG8_LDB(B1, 1, 1); PG8_STAGE(PG8_SB(1, 0), b3, voffB);
            PG8_BAR; PG8_WAIT_L(0); PG8_MMA(0, 1, At, B1); PG8_BAR;
            PG8_LDA(At, 1, 1); PG8_STAGE(PG8_SA(1, 0), a3, voffA);
            PG8_BAR; PG8_WAIT_L(0); PG8_MMA(1, 0, At, B0); PG8_BAR; PG8_SCHED;
            PG8_STAGE(PG8_SB(1, 1), b3 + hstep, voffB);
            PG8_WAIT_V(6); PG8_BAR; PG8_MMA(1, 1, At, B1); PG8_BAR;
        }
        if constexpr (FP8) { asm volatile("s_nop 15\n\ts_nop 15\n\ts_nop 15" ::: "memory"); }
        E(acc, cur, wr, wc, fr, fq);
        if (!has_next) break;
#pragma unroll
        for (int a = 0; a < 2; ++a)
#pragma unroll
            for (int b = 0; b < 2; ++b)
#pragma unroll
                for (int m = 0; m < 4; ++m)
#pragma unroll
                    for (int n = 0; n < 2; ++n) acc[a][b][m][n] = (f32x4){0.f, 0.f, 0.f, 0.f};
        cur = nxt; cA = nA; cB = nB; ++ui;
    }
    PG8_WAIT_V(0);
    if (wr == 0) PG8_BAR;
    PG8_BAR;
#undef PG8_SA
#undef PG8_SB
#undef PG8_STAGE
#undef PG8_LD1
#undef PG8_LDA
#undef PG8_LDB
#undef PG8_MMA
#undef PG8_WAIT_V
#undef PG8_WAIT_L
#undef PG8_BAR
#undef PG8_SCHED
}

struct EpiProj {
    static constexpr bool PERM = true;
    unsigned char* ws;
    __device__ __forceinline__ void operator()(const f32x4 (&acc)[2][2][4][2], const Unit& u, int wr, int wc, int fr, int fq) const {
        const int pn = u.pn; size_t off; int ld, c0;
        if (pn < 4) { off = WS_PQ; ld = 1024; c0 = pn * 256; }
        else if (pn < 8) { off = WS_PK; ld = 1024; c0 = (pn - 4) * 256; }
        else if (pn < 72) { const int t = (pn - 8) >> 3; off = WS_T8 + (size_t)t * SZ_A; ld = 2048; c0 = ((pn - 8) & 7) * 256; }
        else { off = WS_GT; ld = 6144; c0 = (pn - 72) * 256; }
        bf16_t* rp = (bf16_t*)(ws + off) + (size_t)(u.pm * BM + wr * 64 + fr) * ld + c0 + wc * 32 + 8 * fq;
        const size_t step = (size_t)16 * ld;
#pragma unroll
        for (int ai = 0; ai < 2; ++ai) {
#pragma unroll
            for (int m = 0; m < 4; ++m) {
                asm volatile("" : "+v"(rp));
#pragma unroll
                for (int bj = 0; bj < 2; ++bj) { const f32x4 v0 = acc[ai][bj][m][0], v1 = acc[ai][bj][m][1];
                    u32x4 w; w.x = pk2(v0[0], v0[1]); w.y = pk2(v0[2], v0[3]); w.z = pk2(v1[0], v1[1]); w.w = pk2(v1[2], v1[3]);
                    *(u32x4*)(rp + bj * HALF) = w; }
                rp += step;
            }
            rp += 4 * step;
        }
    }
};
struct EpiBf {
    static constexpr bool PERM = true;
    bf16_t* O; int ld;
    __device__ __forceinline__ void operator()(const f32x4 (&acc)[2][2][4][2], const Unit& u, int wr, int wc, int fr, int fq) const {
        const int row0 = u.pm * BM + wr * 64 + fr, col0 = u.pn * BM + wc * 32 + 8 * fq;
#pragma unroll
        for (int ai = 0; ai < 2; ++ai)
#pragma unroll
            for (int m = 0; m < 4; ++m) { bf16_t* rowp = O + (size_t)(row0 + ai * HALF + m * 16) * ld + col0;
#pragma unroll
                for (int bj = 0; bj < 2; ++bj) { const f32x4 v0 = acc[ai][bj][m][0], v1 = acc[ai][bj][m][1];
                    u32x4 w; w.x = pk2(v0[0], v0[1]); w.y = pk2(v0[2], v0[3]); w.z = pk2(v1[0], v1[1]); w.w = pk2(v1[2], v1[3]);
                    *(u32x4*)(rowp + bj * HALF) = w; } }
    }
};
struct EpiMerge {
    static constexpr bool PERM = true;
    bf16_t* Y; const bf16_t* GT;
    __device__ __forceinline__ void operator()(const f32x4 (&acc)[2][2][4][2], const Unit& u, int wr, int wc, int fr, int fq) const {
        const int row0 = u.pm * BM + wr * 64 + fr, col0 = u.pn * BM + wc * 32 + 8 * fq;
#pragma unroll
        for (int ai = 0; ai < 2; ++ai)
#pragma unroll
            for (int m = 0; m < 4; ++m) { const size_t r = (size_t)(row0 + ai * HALF + m * 16);
                bf16_t* rowp = Y + r * 2048 + col0; const bf16_t* gp = GT + r * 6144 + (size_t)u.br * 2048 + col0;
#pragma unroll
                for (int bj = 0; bj < 2; ++bj) { const f32x4 v0 = acc[ai][bj][m][0], v1 = acc[ai][bj][m][1];
                    const u32x4 g = *(const u32x4*)(gp + bj * HALF);
                    const float ab = ((ABL >> u.br) & 1) ? 0.f : 1.f;
                    float o[8];
                    o[0] = ab * sigmoidf_(bflo(g.x)) * v0[0]; o[1] = ab * sigmoidf_(bfhi(g.x)) * v0[1]; o[2] = ab * sigmoidf_(bflo(g.y)) * v0[2]; o[3] = ab * sigmoidf_(bfhi(g.y)) * v0[3];
                    o[4] = ab * sigmoidf_(bflo(g.z)) * v1[0]; o[5] = ab * sigmoidf_(bfhi(g.z)) * v1[1]; o[6] = ab * sigmoidf_(bflo(g.w)) * v1[2]; o[7] = ab * sigmoidf_(bfhi(g.w)) * v1[3];
                    if (u.br != 0) { const u32x4 y = *(const u32x4*)(rowp + bj * HALF);
                        o[0] += bflo(y.x); o[1] += bfhi(y.x); o[2] += bflo(y.y); o[3] += bfhi(y.y); o[4] += bflo(y.z); o[5] += bfhi(y.z); o[6] += bflo(y.w); o[7] += bfhi(y.w); }
                    u32x4 w; w.x = pk2(o[0], o[1]); w.y = pk2(o[2], o[3]); w.z = pk2(o[4], o[5]); w.w = pk2(o[6], o[7]);
                    *(u32x4*)(rowp + bj * HALF) = w; } }
    }
};
struct EpiRes {
    static constexpr bool PERM = false;
    float* X; const float* mod;
    __device__ __forceinline__ void operator()(const f32x4 (&acc)[2][2][4][2], const Unit& u, int wr, int wc, int fr, int fq) const {
        const int row0 = u.pm * BM + wr * 64 + fr, col0 = u.pn * BM + wc * 32 + 4 * fq;
        const int which = (u.pm < 32) ? 0 : (u.pm < 64 ? 1 : 2);
        const float* mg = mod + (size_t)which * 12288 + 2 * 2048 + col0;
        f32x4 gv[2][2];
#pragma unroll
        for (int bj = 0; bj < 2; ++bj)
#pragma unroll
            for (int n = 0; n < 2; ++n) gv[bj][n] = *(const f32x4*)(mg + bj * HALF + n * 16);
#pragma unroll
        for (int ai = 0; ai < 2; ++ai)
#pragma unroll
            for (int m = 0; m < 4; ++m) { float* rowp = X + (size_t)(row0 + ai * HALF + m * 16) * 2048 + col0;
#pragma unroll
                for (int bj = 0; bj < 2; ++bj)
#pragma unroll
                    for (int n = 0; n < 2; ++n) { f32x4* q = (f32x4*)(rowp + bj * HALF + n * 16); *q = *q + gv[bj][n] * acc[ai][bj][m][n]; } }
    }
};
}

__device__ __forceinline__ int proj_src_col(int n) {
    if (n < 1024) return 7200 + n;
    if (n < 2048) return n - 1024;
    if (n < 4096) return 1024 + (n - 2048);
    if (n < 6144) return 8224 + (n - 4096);
    if (n < 8192) return 16416 + (n - 6144);
    if (n < 10240) return 3104 + (n - 8192);
    if (n < 12288) return 5152 + (n - 10240);
    if (n < 14336) return 10272 + (n - 12288);
    if (n < 16384) return 12320 + (n - 14336);
    if (n < 18432) return 14368 + (n - 16384);
    return 18464 + (n - 18432);
}
__device__ __forceinline__ void phase_w(KP p, int l, LAS unsigned char* lds, int wid0) {
    const int tid = tid_fresh(wid0), G = gridDim.x, bid = blockIdx.x;
    unsigned char* ws = launder(p->ws);
    {
        LAS float* tile = (LAS float*)lds;
        const int NT_IN = NPROJ / 64;
        const int total = (NT_IN + 5 * 32) * 32;
        for (int t = bid; t < total; t += G) {
            const int ntile = t >> 5, kt = t & 31, k0 = kt * 64;
            const float* src; int ld; bf16_t* dst; float scale = 1.0f; int n0;
            bool to8 = false;
            if (ntile < NT_IN) { n0 = ntile * 64; src = p->w_in + (size_t)l * 2048 * PROJ_W + proj_src_col(n0); ld = PROJ_W;
                if (n0 >= 12288 && n0 < 18432) { dst = (bf16_t*)(ws + WS_WINB) + (size_t)(n0 - 12288) * 2048; }
                else { to8 = true; dst = (bf16_t*)(ws + WS_WIN); scale = (n0 < 1024) ? 1024.0f * 0.08838834764831845f : 1024.0f; } }
            else { const int mi = (ntile - NT_IN) >> 5; n0 = ((ntile - NT_IN) & 31) * 64;
                const float* m5 = mi == 0 ? p->w_a_out : mi == 1 ? p->w_b_out : mi == 2 ? p->w_c_out : mi == 3 ? p->w_out : p->peer_wq;
                src = m5 + (size_t)l * 2048 * 2048 + n0; ld = 2048;
                dst = (bf16_t*)(ws + WS_WA + (size_t)mi * SZ_W) + (size_t)n0 * 2048; }
            { const int kk = tid >> 4, n4 = (tid & 15) * 4;
#pragma unroll
              for (int h = 0; h < 2; ++h) { const f32x4 v = *(const f32x4*)(src + (size_t)(k0 + kk + 32 * h) * ld + n4);
                  LAS float* tp = tile + (kk + 32 * h) * 65 + n4; tp[0] = v[0]; tp[1] = v[1]; tp[2] = v[2]; tp[3] = v[3]; } }
            __syncthreads();
            { const int n = tid >> 3, k8 = (tid & 7) * 8; float v[8];
#pragma unroll
              for (int j = 0; j < 8; ++j) v[j] = tile[(k8 + j) * 65 + n] * scale;
              if (to8) {
#pragma unroll
                  for (int j = 0; j < 8; ++j) v[j] = fminf(fmaxf(v[j], -448.f), 448.f);
                  int d0 = 0, d1 = 0; d0 = __builtin_amdgcn_cvt_pk_fp8_f32(v[0], v[1], d0, false); d0 = __builtin_amdgcn_cvt_pk_fp8_f32(v[2], v[3], d0, true);
                  d1 = __builtin_amdgcn_cvt_pk_fp8_f32(v[4], v[5], d1, false); d1 = __builtin_amdgcn_cvt_pk_fp8_f32(v[6], v[7], d1, true);
                  u32x2 w8; w8.x = (unsigned)d0; w8.y = (unsigned)d1; *(u32x2*)((unsigned char*)dst + (size_t)(n0 + n) * 2048 + k0 + k8) = w8; }
              else { u32x4 w; w.x = pk2(v[0], v[1]); w.y = pk2(v[2], v[3]); w.z = pk2(v[4], v[5]); w.w = pk2(v[6], v[7]);
                  *(u32x4*)(dst + (size_t)n * 2048 + k0 + k8) = w; } }
            __syncthreads();
        }
    }
    const size_t gtid = (size_t)bid * NTHREADS + tid, gthreads = (size_t)G * NTHREADS;
    for (size_t i = gtid; i < 32 * 2048; i += gthreads) { const int n = (int)(i >> 11), k = (int)(i & 2047);
        ((bf16_t*)(ws + WS_WG))[i] = f2bf(p->w_in[(size_t)l * 2048 * PROJ_W + (size_t)k * PROJ_W + 3072 + n]); }
    {
        const float* su = p->peer_u + (size_t)l * 16384 * 2048; const float* sv = p->peer_v + (size_t)l * 16384 * 2048;
        unsigned char* du = ws + WS_PU; unsigned char* dv = ws + WS_PVW;
        const size_t n32 = (size_t)16384 * 2048 / 32;
        for (size_t i = gtid; i < n32; i += gthreads) {
#pragma unroll
            for (int t = 0; t < 2; ++t) {
                const float* sp = (t ? sv : su) + i * 32; const float sc = t ? 4.0f : 64.0f;
                float e[32];
#pragma unroll
                for (int q = 0; q < 8; ++q) { const f32x4 a = *(const f32x4*)(sp + q * 4); e[q * 4] = a[0] * sc; e[q * 4 + 1] = a[1] * sc; e[q * 4 + 2] = a[2] * sc; e[q * 4 + 3] = a[3] * sc; }
                f32x16 va, vb;
#pragma unroll
                for (int j = 0; j < 16; ++j) { va[j] = FP6_INTERLEAVED ? e[2 * j] : e[j]; vb[j] = FP6_INTERLEAVED ? e[2 * j + 1] : e[16 + j]; }
                const u32x6 wv = __builtin_amdgcn_cvt_scalef32_2xpk16_fp6_f32(va, vb, 1.0f);
                unsigned* dp = (unsigned*)((t ? dv : du) + i * 24);
                u32x2 w0, w1, w2; w0.x = wv[0]; w0.y = wv[1]; w1.x = wv[2]; w1.y = wv[3]; w2.x = wv[4]; w2.y = wv[5];
                *(u32x2*)dp = w0; *(u32x2*)(dp + 2) = w1; *(u32x2*)(dp + 4) = w2;
            }
        }
        const float* sk = p->peer_keys + (size_t)l * 16 * 128 * 128; bf16_t* dk = (bf16_t*)(ws + WS_KEYS);
        for (size_t i = gtid; i < (size_t)16 * 128 * 128; i += gthreads) dk[i] = f2bf(sk[i]);
    }
    {
        float* mod = (float*)(ws + WS_MOD) + (size_t)l * 3 * 12288;
        const float* wa = p->w_ada + (size_t)l * 2048 * 12288; const float* ba = p->b_ada + (size_t)l * 12288;
        LAS float* part = (LAS float*)(lds + 32768);
        const int col = tid & 63, ks = tid >> 6;
        for (int t = bid; t < 256; t += G) {
            const int n = t * 48 + col;
            float a0 = 0.f, a1 = 0.f, a2 = 0.f;
            if (col < 48) {
                for (int k = ks * 256; k < ks * 256 + 256; ++k) {
                    const float w = wa[(size_t)k * 12288 + n];
                    const float c0 = p->c[k], c1 = p->c[2048 + k], c2 = p->c_ctx[k];
                    a0 += c0 * sigmoidf_(c0) * w; a1 += c1 * sigmoidf_(c1) * w; a2 += c2 * sigmoidf_(c2) * w;
                }
                part[(ks * 3 + 0) * 48 + col] = a0; part[(ks * 3 + 1) * 48 + col] = a1; part[(ks * 3 + 2) * 48 + col] = a2;
            }
            __syncthreads();
            if (tid < 144) { const int which = tid / 48, cc = tid - which * 48; float sacc = ba[t * 48 + cc];
#pragma unroll
                for (int q = 0; q < 8; ++q) sacc += part[(q * 3 + which) * 48 + cc];
                mod[(size_t)which * 12288 + t * 48 + cc] = sacc; }
            __syncthreads();
        }
    }
    if (l == 0) {
        float* X = (float*)(ws + WS_X);
        const size_t nl4 = (size_t)NLAT * 2048 / 4, nc4 = (size_t)NCTX * 2048 / 4;
        for (size_t i = gtid; i < nl4; i += gthreads) ((f32x4*)X)[i] = ((const f32x4*)p->x)[i];
        for (size_t i = gtid; i < nc4; i += gthreads) ((f32x4*)X)[nl4 + i] = ((const f32x4*)p->ctx)[i];
        float* tab = (float*)(ws + WS_TAB);
        for (size_t i = gtid; i < 4096; i += gthreads) { const int pos = (int)(i >> 5), j = (int)(i & 31);
            const float inv = powf(10000.0f, -(float)j / 32.0f); const float ang = (float)pos * inv;
            tab[i] = cosf(ang); tab[4096 + i] = sinf(ang); }
    }
}

__device__ __forceinline__ void phase_norm(KP p, int l, int which_norm, int nrows, int wid0) {
    const int tid = tid_fresh(wid0); const int lane = tid & 63, gw = blockIdx.x * 8 + (tid >> 6), nw = gridDim.x * 8;
    unsigned char* ws = launder(p->ws);
    const float* X = (const float*)(ws + WS_X); bf16_t* XN = (bf16_t*)(ws + WS_XN);
    const float* mod = (const float*)(ws + WS_MOD) + (size_t)l * 3 * 12288;
    const float* g = p->norm_g + (size_t)(l * 2 + which_norm) * 2048;
    const int shift_c = which_norm ? 3 : 0, scale_c = which_norm ? 4 : 1;
    for (int row = gw; row < nrows; row += nw) {
        const int which = row < NLAT ? (row >> 13) : 2;
        const float* xr = X + (size_t)row * 2048; const float* mb = mod + (size_t)which * 12288;
        f32x4 v[8]; float ss = 0.f;
#pragma unroll
        for (int i = 0; i < 8; ++i) { v[i] = *(const f32x4*)(xr + i * 256 + lane * 4); ss += v[i][0] * v[i][0] + v[i][1] * v[i][1] + v[i][2] * v[i][2] + v[i][3] * v[i][3]; }
        ss = wave_sum(ss);
        const float rstd = rsqrtf(ss * (1.0f / 2048.0f) + EPSF);
#pragma unroll
        for (int i = 0; i < 8; ++i) { const int c = i * 256 + lane * 4;
            const f32x4 gg = *(const f32x4*)(g + c), sh = *(const f32x4*)(mb + shift_c * 2048 + c), sc = *(const f32x4*)(mb + scale_c * 2048 + c);
            float o[4];
#pragma unroll
            for (int j = 0; j < 4; ++j) o[j] = v[i][j] * rstd * gg[j] * (1.0f + sc[j]) + sh[j];
            u32x2 w; w.x = pk2(o[0], o[1]); w.y = pk2(o[2], o[3]); *(u32x2*)(XN + (size_t)row * 2048 + c) = w;
            if (which_norm == 0) { int d = 0; d = __builtin_amdgcn_cvt_pk_fp8_f32(fminf(fmaxf(o[0], -448.f), 448.f), fminf(fmaxf(o[1], -448.f), 448.f), d, false);
                d = __builtin_amdgcn_cvt_pk_fp8_f32(fminf(fmaxf(o[2], -448.f), 448.f), fminf(fmaxf(o[3], -448.f), 448.f), d, true); *(unsigned*)(ws + WS_XN8 + (size_t)row * 2048 + c) = (unsigned)d; } }
    }
}

__device__ __forceinline__ void phase_gates_gemm(KP p, int l, int wid0) {
    const int tid = tid_fresh(wid0); const int lane = tid & 63, gw = blockIdx.x * 8 + (tid >> 6), nw = gridDim.x * 8;
    unsigned char* ws = launder(p->ws);
    const bf16_t* XN = (const bf16_t*)(ws + WS_XN); const bf16_t* WG = (const bf16_t*)(ws + WS_WG); float* GA = (float*)(ws + WS_GATES);
    const int q4 = lane >> 4, c = lane & 15;
    const float gb0 = p->a_gate_b[l * 32 + c], gb1 = p->a_gate_b[l * 32 + 16 + c];
    for (int task = gw; task < MR / 16; task += nw) {
        const int r0 = task * 16;
        f32x4 acc0 = {0.f, 0.f, 0.f, 0.f}, acc1 = {0.f, 0.f, 0.f, 0.f};
        const bf16_t* ap = XN + (size_t)(r0 + c) * 2048 + 8 * q4; const bf16_t* b0 = WG + (size_t)c * 2048 + 8 * q4; const bf16_t* b1 = b0 + 16 * 2048;
#pragma unroll 4
        for (int ks = 0; ks < 64; ++ks) { const bf16x8 a = *(const bf16x8*)(ap + ks * 32), x0 = *(const bf16x8*)(b0 + ks * 32), x1 = *(const bf16x8*)(b1 + ks * 32);
            acc0 = mfma16(a, x0, acc0); acc1 = mfma16(a, x1, acc1); }
#pragma unroll
        for (int r = 0; r < 4; ++r) {
            const float v0 = acc0[r] + gb0, v1 = acc1[r] + gb1;
            GA[(size_t)(r0 + 4 * q4 + r) * 32 + c] = (c >= 8) ? logsigmoidf_(v0) : v0; GA[(size_t)(r0 + 4 * q4 + r) * 32 + 16 + c] = (c >= 8) ? logsigmoidf_(v1) : v1; }
    }
}

__device__ __forceinline__ void phase_e1(KP p, int l, int wid0) {
    const int tid = tid_fresh(wid0); const int lane = tid & 63, gw = blockIdx.x * 8 + (tid >> 6), nw = gridDim.x * 8;
    unsigned char* ws = launder(p->ws);
    bf16_t* PQ = (bf16_t*)(ws + WS_PQ); bf16_t* PK = (bf16_t*)(ws + WS_PK); bf16_t* CQ = (bf16_t*)(ws + WS_CQ); bf16_t* CK = (bf16_t*)(ws + WS_CK);
    bf16_t* BB = (bf16_t*)(ws + WS_BB); const bf16_t* BC = (const bf16_t*)(ws + WS_BC); const bf16_t* BX = (const bf16_t*)(ws + WS_BX);
    float* GA = (float*)(ws + WS_GATES); const float* tab = (const float*)(ws + WS_TAB);
    const float* gq = p->c_qk_g + (size_t)(l * 2 + 0) * 128; const float* gk = p->c_qk_g + (size_t)(l * 2 + 1) * 128;
    const float* cw = p->b_conv + (size_t)l * 3 * 2048;
    float gqv[8], gkv[8];
#pragma unroll
    for (int j = 0; j < 8; ++j) { gqv[j] = gq[(lane & 15) * 8 + j] * 0.08838834764831845f; gkv[j] = gk[(lane & 15) * 8 + j]; }
    const int nitems = NLAT / 8 + NCTX;
    for (int item = gw; item < nitems; item += nw) {
        const int row_first = item < NLAT / 8 ? item * 8 : NLAT + (item - NLAT / 8), nrun = item < NLAT / 8 ? 8 : 1;
        for (int rr = 0; rr < nrun; ++rr) { const int row = row_first + rr;
        if (row < NLAT) {
            const int s = row & 8191, gr = s >> 6, gc = s & 63;
#pragma unroll
            for (int it = 0; it < 2; ++it) {
                const int unit = it * 64 + lane, h = unit >> 4, hf = (unit >> 3) & 1, j4 = unit & 7;
                const int off = h * 128 + hf * 64 + j4 * 4, pos = hf ? gc : gr;
                const f32x4 cs = *(const f32x4*)(tab + pos * 32 + j4 * 4), sn = *(const f32x4*)(tab + 4096 + pos * 32 + j4 * 4);
#pragma unroll
                for (int tsel = 0; tsel < 2; ++tsel) { bf16_t* T = (tsel ? PK : PQ) + (size_t)row * 1024 + off;
                    const u32x2 u1 = *(const u32x2*)T, u2 = *(const u32x2*)(T + 32);
                    const float a0 = bflo(u1.x), a1 = bfhi(u1.x), a2 = bflo(u1.y), a3 = bfhi(u1.y), b0 = bflo(u2.x), b1 = bfhi(u2.x), b2 = bflo(u2.y), b3 = bfhi(u2.y);
                    u32x2 o1, o2;
                    o1.x = pk2(a0 * cs[0] - b0 * sn[0], a1 * cs[1] - b1 * sn[1]); o1.y = pk2(a2 * cs[2] - b2 * sn[2], a3 * cs[3] - b3 * sn[3]);
                    o2.x = pk2(b0 * cs[0] + a0 * sn[0], b1 * cs[1] + a1 * sn[1]); o2.y = pk2(b2 * cs[2] + a2 * sn[2], b3 * cs[3] + a3 * sn[3]);
                    *(u32x2*)T = o1; *(u32x2*)(T + 32) = o2; }
            }
        }
#pragma unroll
        for (int tsel = 0; tsel < 2; ++tsel) {
            bf16_t* T = (tsel ? CK : CQ) + (size_t)row * 2048;
#pragma unroll
            for (int ps = 0; ps < 4; ++ps) {
                const u32x4 w = *(const u32x4*)(T + ps * 512 + lane * 8);
                float v[8] = {bflo(w.x), bfhi(w.x), bflo(w.y), bfhi(w.y), bflo(w.z), bfhi(w.z), bflo(w.w), bfhi(w.w)};
                float ss = 0.f;
#pragma unroll
                for (int j = 0; j < 8; ++j) ss += v[j] * v[j];
                ss += __shfl_xor(ss, 1); ss += __shfl_xor(ss, 2); ss += __shfl_xor(ss, 4); ss += __shfl_xor(ss, 8);
                const float rstd = rsqrtf(ss * (1.0f / 128.0f) + EPSF);
#pragma unroll
                for (int j = 0; j < 8; ++j) v[j] = v[j] * rstd * (tsel ? gkv[j] : gqv[j]);
                u32x4 o; o.x = pk2(v[0], v[1]); o.y = pk2(v[2], v[3]); o.z = pk2(v[4], v[5]); o.w = pk2(v[6], v[7]);
                *(u32x4*)(T + ps * 512 + lane * 8) = o;
            }
        }
        }
        {
            int pos0, len; if (row_first < NLAT) { pos0 = row_first & 8191; len = SEQ; } else { pos0 = (row_first - NLAT) & 255; len = CTXL; }
#pragma unroll 1
            for (int ps = 0; ps < 4; ++ps) {
                const int c = ps * 512 + lane * 8;
                float w0[8], w1[8], w2[8];
#pragma unroll
                for (int hq = 0; hq < 2; ++hq) { const f32x4 a = *(const f32x4*)(cw + c + hq * 4), bq = *(const f32x4*)(cw + 2048 + c + hq * 4), cq = *(const f32x4*)(cw + 4096 + c + hq * 4);
#pragma unroll
                    for (int j = 0; j < 4; ++j) { w0[hq * 4 + j] = a[j]; w1[hq * 4 + j] = bq[j]; w2[hq * 4 + j] = cq[j]; } }
                float up[8], uc[8], un[8];
                auto load_u = [&](int row, float (&u)[8]) { const size_t o = (size_t)row * 2048 + c; const u32x4 cv = *(const u32x4*)(BC + o), xv = *(const u32x4*)(BX + o);
                    u[0] = bflo(cv.x) * bflo(xv.x); u[1] = bfhi(cv.x) * bfhi(xv.x); u[2] = bflo(cv.y) * bflo(xv.y); u[3] = bfhi(cv.y) * bfhi(xv.y);
                    u[4] = bflo(cv.z) * bflo(xv.z); u[5] = bfhi(cv.z) * bfhi(xv.z); u[6] = bflo(cv.w) * bflo(xv.w); u[7] = bfhi(cv.w) * bfhi(xv.w); };
#pragma unroll
                for (int j = 0; j < 8; ++j) { up[j] = 0.f; un[j] = 0.f; }
                if (pos0 > 0) load_u(row_first - 1, up);
                load_u(row_first, uc);
                for (int rr = 0; rr < nrun; ++rr) { const int row = row_first + rr;
                    if (pos0 + rr < len - 1) load_u(row + 1, un); else {
#pragma unroll
                        for (int j = 0; j < 8; ++j) un[j] = 0.f; }
                    const size_t o = (size_t)row * 2048 + c; const u32x4 bb = *(const u32x4*)(BB + o);
                    const float bv[8] = {bflo(bb.x), bfhi(bb.x), bflo(bb.y), bfhi(bb.y), bflo(bb.z), bfhi(bb.z), bflo(bb.w), bfhi(bb.w)};
                    float y[8];
#pragma unroll
                    for (int j = 0; j < 8; ++j) y[j] = bv[j] * (up[j] * w0[j] + uc[j] * w1[j] + un[j] * w2[j]);
                    u32x4 ov; ov.x = pk2(y[0], y[1]); ov.y = pk2(y[2], y[3]); ov.z = pk2(y[4], y[5]); ov.w = pk2(y[6], y[7]);
                    *(u32x4*)(BB + o) = ov;
#pragma unroll
                    for (int j = 0; j < 8; ++j) { up[j] = uc[j]; uc[j] = un[j]; }
                }
            }
        }
    }
}

constexpr int ML_QS = 0, ML_KS = 17408, ML_KET = 34816, ML_VT = 53248, ML_SS = 60160, ML_CT = 69376, ML_CTSZ = 13056;
__device__ __forceinline__ int ml_row(int pp, int b, int dir) {
    if (pp < 256) { const int j = dir ? 255 - pp : pp; return NLAT + b * 256 + j; }
    int s = pp - 256; if (dir) s = 8191 - s; return b * 8192 + s;
}
__device__ __forceinline__ void phase_mlstm(KP p, int l, LAS unsigned char* lds, int wid0) {
    const int tid = tid_fresh(wid0), lane = tid & 63, w = __builtin_amdgcn_readfirstlane(tid >> 6), q4 = lane >> 4, c16 = lane & 15;
    unsigned char* ws = launder(p->ws);
    const bf16_t* PQ = (const bf16_t*)(ws + WS_PQ); const bf16_t* PK = (const bf16_t*)(ws + WS_PK); const bf16_t* PV = (const bf16_t*)(ws + WS_PV);
    const float* GA = (const float*)(ws + WS_GATES);
    for (int task = blockIdx.x; task < 256; task += gridDim.x) {
        const int xq = task & 7, yq = task >> 3; const int bh = 2 * xq + (yq >> 4), dir = (yq >> 3) & 1, sl = yq & 7; const int b = bh >> 3, h = bh & 7;
        bf16_t* H = (bf16_t*)(ws + (dir ? WS_BX : WS_BC));
        float* SCN = (float*)(ws + WS_SCAN) + (size_t)task * 3 * 8448;
        __syncthreads();
        for (int cc = w; cc < 132; cc += 8) {
            const int r = ml_row(cc * 64 + lane, b, dir);
            const float li = GA[(size_t)r * 32 + (2 * dir) * 8 + h], lf = GA[(size_t)r * 32 + (2 * dir + 1) * 8 + h];
            float bc = lf;
#pragma unroll
            for (int o = 1; o < 64; o <<= 1) { const float t = __shfl_up(bc, o); if (lane >= o) bc += t; }
            const float a = li - bc;
            float pm = a;
#pragma unroll
            for (int o = 1; o < 64; o <<= 1) { const float t = __shfl_up(pm, o); if (lane >= o) pm = fmaxf(pm, t); }
            SCN[cc * 64 + lane] = bc; SCN[8448 + cc * 64 + lane] = a; SCN[2 * 8448 + cc * 64 + lane] = pm;
        }
        for (int i = tid; i < 16 * 32; i += NTHREADS) { const int r = 32 + (i >> 5), cdw = i & 31; *(LAS unsigned*)(lds + ML_VT + r * 144 + cdw * 4) = (r == 32) ? 0x3f803f80u : 0u; }
        for (int i = tid; i < 2 * ML_CTSZ / 4; i += NTHREADS) *(LAS unsigned*)(lds + ML_CT + i * 4) = 0u;
        __syncthreads();
        float m = 0.f;
        f32x4 Cst[3];
#pragma unroll
        for (int i = 0; i < 3; ++i) Cst[i] = (f32x4){0.f, 0.f, 0.f, 0.f};
        u32x4 qreg[2], kreg[2], vreg; float bc, a, pm;
        const int qrow_l = lane >> 4, qpc = lane & 15, vrow_l = lane >> 2, vpc = lane & 3;
        {
#pragma unroll
          for (int i = 0; i < 2; ++i) { const int r = ml_row(8 * w + 4 * i + qrow_l, b, dir);
              qreg[i] = *(const u32x4*)(PQ + (size_t)r * 1024 + h * 128 + qpc * 8); kreg[i] = *(const u32x4*)(PK + (size_t)r * 1024 + h * 128 + qpc * 8); }
          if (w < 4) { const int r = ml_row(16 * w + vrow_l, b, dir); vreg = *(const u32x4*)(PV + (size_t)r * 2048 + h * 256 + sl * 32 + vpc * 8); }
          bc = SCN[lane]; a = SCN[8448 + lane]; pm = SCN[2 * 8448 + lane]; }
        for (int c = 0; c < 132; ++c) {
            const float total = __uint_as_float((unsigned)__builtin_amdgcn_readlane((int)__float_as_uint(bc), 63)), pmall = __uint_as_float((unsigned)__builtin_amdgcn_readlane((int)__float_as_uint(pm), 63));
            const float mx = fmaxf(m, pm);
            const float mrow = bc + mx;
            const float winter = __expf(m - mx);
            const float m_new = total + fmaxf(m, pmall);
            const float decay = __expf(total + m - m_new);
            const float kscale = __expf(total + a - m_new);
            const float mref = fmaxf(m, pmall);
            const float ea_cur = __expf(a - mref), em_cur = __expf(mref - mx), emr_cur = __expf(-mrow);
#pragma unroll
            for (int i = 0; i < 2; ++i) { const int sr = 8 * w + 4 * i + qrow_l;
                *(LAS u32x4*)(lds + ML_QS + sr * 272 + qpc * 16) = qreg[i];
                *(LAS u32x4*)(lds + ML_KS + sr * 272 + qpc * 16) = kreg[i]; }
            if (w < 4) { const unsigned vw[4] = {vreg.x, vreg.y, vreg.z, vreg.w}; const int sv = 16 * w + vrow_l;
#pragma unroll
                for (int j = 0; j < 4; ++j) { const int e = vpc * 8 + 2 * j;
                    *(LAS bf16_t*)(lds + ML_VT + e * 144 + sv * 2) = (bf16_t)(vw[j] & 0xffffu);
                    *(LAS bf16_t*)(lds + ML_VT + (e + 1) * 144 + sv * 2) = (bf16_t)(vw[j] >> 16); } }
            if (w == 1) *(LAS float*)(lds + ML_SS + 256 + lane * 4) = kscale;
            if (c + 1 < 132) { const int p0 = (c + 1) * 64;
#pragma unroll
                for (int i = 0; i < 2; ++i) { const int r = ml_row(p0 + 8 * w + 4 * i + qrow_l, b, dir);
                    qreg[i] = *(const u32x4*)(PQ + (size_t)r * 1024 + h * 128 + qpc * 8); kreg[i] = *(const u32x4*)(PK + (size_t)r * 1024 + h * 128 + qpc * 8); }
                if (w < 4) { const int r = ml_row(p0 + 16 * w + vrow_l, b, dir); vreg = *(const u32x4*)(PV + (size_t)r * 2048 + h * 256 + sl * 32 + vpc * 8); }
                bc = SCN[p0 + lane]; a = SCN[8448 + p0 + lane]; pm = SCN[2 * 8448 + p0 + lane]; }
            if (w == 0) *(LAS float*)(lds + ML_SS + lane * 4) = ea_cur;
            LDS_BARRIER();
            {
                const int tr = w >> 1, part = w & 1;
                const LAS unsigned char* CTc = lds + ML_CT + (c & 1) * ML_CTSZ;
                bf16x8 aq[4];
#pragma unroll
                for (int ks = 0; ks < 4; ++ks) aq[ks] = *(const LAS bf16x8*)(lds + ML_QS + (16 * tr + c16) * 272 + (ks * 32 + 8 * q4) * 2);
                float wi_t[4], emr_t[4];
#pragma unroll
                for (int r = 0; r < 4; ++r) { const int t = 16 * tr + 4 * q4 + r; wi_t[r] = __shfl(winter, t); emr_t[r] = __shfl(emr_cur, t); }
                f32x4 accA = {0.f, 0.f, 0.f, 0.f}, accD = {0.f, 0.f, 0.f, 0.f};
#pragma unroll
                for (int ks = 0; ks < 4; ++ks) {
                    const bf16x8 b1 = *(const LAS bf16x8*)(CTc + (16 * part + c16) * 272 + (ks * 32 + 8 * q4) * 2);
                    const bf16x8 b2 = *(const LAS bf16x8*)(CTc + (32 + c16) * 272 + (ks * 32 + 8 * q4) * 2);
                    accA = mfma16(aq[ks], b1, accA); accD = mfma16(aq[ks], b2, accD); }
#pragma unroll
                for (int r = 0; r < 4; ++r) { accA[r] *= wi_t[r]; accD[r] *= wi_t[r]; }
                const int tq = 16 * tr + c16;
                const float emq = __shfl(em_cur, tq);
#pragma unroll
                for (int kk = 0; kk < 2; ++kk) {
                    if (2 * kk <= tr) {
                        f32x4 s0 = {0.f, 0.f, 0.f, 0.f}, s1 = {0.f, 0.f, 0.f, 0.f};
#pragma unroll
                        for (int ks = 0; ks < 4; ++ks) { const bf16x8 ka = *(const LAS bf16x8*)(lds + ML_KS + (32 * kk + c16) * 272 + (ks * 32 + 8 * q4) * 2); s0 = mfma16(ka, aq[ks], s0); }
                        if (2 * kk + 1 <= tr) {
#pragma unroll
                            for (int ks = 0; ks < 4; ++ks) { const bf16x8 ka = *(const LAS bf16x8*)(lds + ML_KS + (32 * kk + 16 + c16) * 272 + (ks * 32 + 8 * q4) * 2); s1 = mfma16(ka, aq[ks], s1); }
                        }
                        const f32x4 a0 = *(const LAS f32x4*)(lds + ML_SS + (32 * kk + 4 * q4) * 4), a1 = *(const LAS f32x4*)(lds + ML_SS + (32 * kk + 16 + 4 * q4) * 4);
                        float pe[8];
#pragma unroll
                        for (int r = 0; r < 4; ++r) { const int sp0 = 32 * kk + 4 * q4 + r, sp1 = sp0 + 16;
                            pe[r] = (sp0 <= tq) ? s0[r] * (a0[r] * emq) : 0.f; pe[4 + r] = (sp1 <= tq) ? s1[r] * (a1[r] * emq) : 0.f; }
                        u32x4 pw; pw.x = pk2(pe[0], pe[1]); pw.y = pk2(pe[2], pe[3]); pw.z = pk2(pe[4], pe[5]); pw.w = pk2(pe[6], pe[7]);
                        const bf16x8 pf = __builtin_bit_cast(bf16x8, pw);
                        const u32x2 v1l = *(const LAS u32x2*)(lds + ML_VT + (16 * part + c16) * 144 + (32 * kk + 4 * q4) * 2), v1h = *(const LAS u32x2*)(lds + ML_VT + (16 * part + c16) * 144 + (32 * kk + 16 + 4 * q4) * 2);
                        const u32x2 v2l = *(const LAS u32x2*)(lds + ML_VT + (32 + c16) * 144 + (32 * kk + 4 * q4) * 2), v2h = *(const LAS u32x2*)(lds + ML_VT + (32 + c16) * 144 + (32 * kk + 16 + 4 * q4) * 2);
                        u32x4 bw1, bw2; bw1.x = v1l.x; bw1.y = v1l.y; bw1.z = v1h.x; bw1.w = v1h.y; bw2.x = v2l.x; bw2.y = v2l.y; bw2.z = v2h.x; bw2.w = v2h.y;
                        accA = mfma16(pf, __builtin_bit_cast(bf16x8, bw1), accA); accD = mfma16(pf, __builtin_bit_cast(bf16x8, bw2), accD);
                    }
                }
                if (l == 0 || c >= 4) {
                    const int hrow0 = ml_row(c * 64, b, dir), hsgn = dir ? -1 : 1;
#pragma unroll
                    for (int r = 0; r < 4; ++r) {
                        const float den = __shfl(accD[r], lane & 48);
                        const float hv = accA[r] * __builtin_amdgcn_rcpf(fmaxf(fabsf(den), emr_t[r]));
                        const int t = 16 * tr + 4 * q4 + r; const int row = hrow0 + hsgn * t;
                        H[(size_t)row * 2048 + h * 256 + sl * 32 + 16 * part + c16] = f2bf(hv);
                    }
                }
            }
            {
                LAS unsigned char* CTn = lds + ML_CT + ((c + 1) & 1) * ML_CTSZ;
                bf16x8 ak[2];
#pragma unroll
                for (int k2 = 0; k2 < 2; ++k2) {
                    const f32x4 sc0 = *(const LAS f32x4*)(lds + ML_SS + 256 + (k2 * 32 + 8 * q4) * 4), sc1 = *(const LAS f32x4*)(lds + ML_SS + 256 + (k2 * 32 + 8 * q4 + 4) * 4);
                    const s16x4 t0 = __builtin_amdgcn_ds_read_tr16_b64_v4i16((LAS s16x4*)(lds + ML_KS + (k2 * 32 + 8 * q4 + (c16 >> 2)) * 272 + (16 * w + 4 * (c16 & 3)) * 2));
                    const s16x4 t1 = __builtin_amdgcn_ds_read_tr16_b64_v4i16((LAS s16x4*)(lds + ML_KS + (k2 * 32 + 8 * q4 + 4 + (c16 >> 2)) * 272 + (16 * w + 4 * (c16 & 3)) * 2));
                    const u32x2 u0 = __builtin_bit_cast(u32x2, t0), u1 = __builtin_bit_cast(u32x2, t1);
                    u32x4 kw; kw.x = pk2(bflo(u0.x) * sc0[0], bfhi(u0.x) * sc0[1]); kw.y = pk2(bflo(u0.y) * sc0[2], bfhi(u0.y) * sc0[3]);
                    kw.z = pk2(bflo(u1.x) * sc1[0], bfhi(u1.x) * sc1[1]); kw.w = pk2(bflo(u1.y) * sc1[2], bfhi(u1.y) * sc1[3]);
                    ak[k2] = __builtin_bit_cast(bf16x8, kw);
                }
#pragma unroll
                for (int ct = 0; ct < 3; ++ct) {
                    Cst[ct] = Cst[ct] * decay;
#pragma unroll
                    for (int k2 = 0; k2 < 2; ++k2) { const bf16x8 bv = *(const LAS bf16x8*)(lds + ML_VT + (16 * ct + c16) * 144 + (k2 * 32 + 8 * q4) * 2); Cst[ct] = mfma16(ak[k2], bv, Cst[ct]); }
                    u32x2 o; o.x = pk2(Cst[ct][0], Cst[ct][1]); o.y = pk2(Cst[ct][2], Cst[ct][3]);
                    *(LAS u32x2*)(CTn + (16 * ct + c16) * 272 + (16 * w + 4 * q4) * 2) = o;
                }
            }
            m = m_new;
            LDS_BARRIER();
        }
    }
}

constexpr int AT_KS = 0, AT_VS = 17408, AT_RPB = 35840;
__device__ __forceinline__ void phase_attn(KP p, int l, LAS unsigned char* lds, int wid0) {
    const int tid = tid_fresh(wid0), lane = tid & 63, w = __builtin_amdgcn_readfirstlane(tid >> 6), q4 = lane >> 4, c16 = lane & 15;
    unsigned char* ws = launder(p->ws);
    bf16_t* CQ = (bf16_t*)(ws + WS_CQ); const bf16_t* CK = (const bf16_t*)(ws + WS_CK); const bf16_t* CV = (const bf16_t*)(ws + WS_CV);
    const int nunits = 2048 + (l == 0 ? 64 : 0);
    for (int u = blockIdx.x; u < nunits; u += gridDim.x) {
        int b, h, qrow = 0, g = 0, ntl = 0, r0a = 0, qbase;  bool is_ctx = u >= 2048;
        if (!is_ctx) { b = u >> 10; h = (u >> 6) & 15; const int rp = u & 63; qrow = 2 * rp + (w >> 2); g = w & 3;
            r0a = min(max(2 * rp - 4, 0), 120); const int r0b = min(max(2 * rp + 1 - 4, 0), 120); ntl = r0b + 8 - r0a;
            qbase = b * 8192 + qrow * 64 + 16 * g; }
        else { const int uu = u - 2048; b = uu >> 5; h = (uu >> 1) & 15; qbase = NLAT + b * 256 + (uu & 1) * 128 + 16 * w; }
        const int r0q = min(max(qrow - 4, 0), 120);
        const int a_g = (g == 0) ? 0 : (g == 1 ? 8 : (g == 2 ? 24 : 32));
        __syncthreads();
        if (!is_ctx) for (int i = tid; i < 465; i += NTHREADS) *(LAS float*)(lds + AT_RPB + i * 4) = p->c_rpb[((size_t)l * 16 + h) * 465 + i];
        bf16x8 qf[4];
#pragma unroll
        for (int ks = 0; ks < 4; ++ks) qf[ks] = *(const bf16x8*)(CQ + (size_t)(qbase + c16) * 2048 + h * 128 + ks * 32 + 8 * q4);
        f32x4 O[8];
#pragma unroll
        for (int i = 0; i < 8; ++i) O[i] = (f32x4){0.f, 0.f, 0.f, 0.f};
        float m_run = -1e30f, l_run = 0.f;
        const int ntiles = ntl + 4;
        u32x4 kreg[2], vreg[2];
        auto tile_row = [&](int t, int key) -> int { return (t < ntl) ? (b * 8192 + (r0a + t) * 64 + key) : (NLAT + b * 256 + (t - ntl) * 64 + key); };
        const int krow_l = lane >> 4, kpc = lane & 15;
        {
#pragma unroll
          for (int i = 0; i < 2; ++i) { const int r = tile_row(0, 8 * w + 4 * i + krow_l); kreg[i] = *(const u32x4*)(CK + (size_t)r * 2048 + h * 128 + kpc * 8); vreg[i] = *(const u32x4*)(CV + (size_t)r * 2048 + h * 128 + kpc * 8); } }
        for (int t = 0; t < ntiles; ++t) {
            LDS_BARRIER();
#pragma unroll
            for (int i = 0; i < 2; ++i) { const int key = 8 * w + 4 * i + krow_l;
                *(LAS u32x4*)(lds + AT_KS + key * 272 + kpc * 16) = kreg[i];
                *(LAS u32x4*)(lds + AT_VS + key * 288 + kpc * 16) = vreg[i]; }
            if (t + 1 < ntiles) {
#pragma unroll
                for (int i = 0; i < 2; ++i) { const int r = tile_row(t + 1, 8 * w + 4 * i + krow_l); kreg[i] = *(const u32x4*)(CK + (size_t)r * 2048 + h * 128 + kpc * 8); vreg[i] = *(const u32x4*)(CV + (size_t)r * 2048 + h * 128 + kpc * 8); } }
            LDS_BARRIER();
            const bool local = t < ntl; const int kr = r0a + t;
            if (local && !(kr >= r0q && kr < r0q + 8)) continue;
            const int npass = local ? 1 : 2;
            for (int ps = 0; ps < npass; ++ps) {
                const int a0 = local ? a_g : ps * 32;
                f32x4 sc[2];
#pragma unroll
                for (int ct = 0; ct < 2; ++ct) { sc[ct] = (f32x4){0.f, 0.f, 0.f, 0.f};
#pragma unroll
                    for (int ks = 0; ks < 4; ++ks) { const bf16x8 ka = *(const LAS bf16x8*)(lds + AT_KS + (a0 + 16 * ct + c16) * 272 + (ks * 32 + 8 * q4) * 2); sc[ct] = mfma16(ka, qf[ks], sc[ct]); } }
                if (local) {
                    const int qc = 16 * g + c16, col0 = min(max(qc - 8, 0), 48); const int dr = kr - qrow + 7;
#pragma unroll
                    for (int ct = 0; ct < 2; ++ct)
#pragma unroll
                        for (int r = 0; r < 4; ++r) { const int kc = a0 + 16 * ct + 4 * q4 + r; const bool valid = (kc >= col0) && (kc < col0 + 16);
                            const int dc = min(max(kc - qc + 15, 0), 30);
                            const float bias = *(const LAS float*)(lds + AT_RPB + (dr * 31 + dc) * 4);
                            sc[ct][r] = valid ? sc[ct][r] + bias : -1e30f; }
                }
                float mx = fmaxf(fmaxf(fmaxf(sc[0][0], sc[0][1]), fmaxf(sc[0][2], sc[0][3])), fmaxf(fmaxf(sc[1][0], sc[1][1]), fmaxf(sc[1][2], sc[1][3])));
                mx = fmaxf(mx, __shfl_xor(mx, 16)); mx = fmaxf(mx, __shfl_xor(mx, 32));
                const float m_new = fmaxf(m_run, mx);
                const float alpha = __expf(m_run - m_new);
                float pe[8]; float psum = 0.f;
#pragma unroll
                for (int ct = 0; ct < 2; ++ct)
#pragma unroll
                    for (int r = 0; r < 4; ++r) { const float e = __expf(sc[ct][r] - m_new); pe[ct * 4 + r] = e; psum += e; }
                psum += __shfl_xor(psum, 16); psum += __shfl_xor(psum, 32);
                l_run = l_run * alpha + psum; m_run = m_new;
                bf16x8 pf; { u32x4 pw; pw.x = pk2(pe[0], pe[1]); pw.y = pk2(pe[2], pe[3]); pw.z = pk2(pe[4], pe[5]); pw.w = pk2(pe[6], pe[7]); pf = __builtin_bit_cast(bf16x8, pw); }
                float al[4];
#pragma unroll
                for (int r = 0; r < 4; ++r) al[r] = __shfl(alpha, 4 * q4 + r);
#pragma unroll
                for (int dt = 0; dt < 8; ++dt) {
#pragma unroll
                    for (int r = 0; r < 4; ++r) O[dt][r] *= al[r];
                    const s16x4 lo = __builtin_amdgcn_ds_read_tr16_b64_v4i16((LAS s16x4*)(lds + AT_VS + (a0 + 4 * q4 + (c16 >> 2)) * 288 + (16 * dt + 4 * (c16 & 3)) * 2));
                    const s16x4 hi = __builtin_amdgcn_ds_read_tr16_b64_v4i16((LAS s16x4*)(lds + AT_VS + (a0 + 16 + 4 * q4 + (c16 >> 2)) * 288 + (16 * dt + 4 * (c16 & 3)) * 2));
                    const bf16x8 bw = __builtin_shufflevector(lo, hi, 0, 1, 2, 3, 4, 5, 6, 7);
                    O[dt] = mfma16(pf, bw, O[dt]);
                }
            }
        }
        float linv[4];
#pragma unroll
        for (int r = 0; r < 4; ++r) linv[r] = 1.0f / __shfl(l_run, 4 * q4 + r);
#pragma unroll
        for (int dt = 0; dt < 8; ++dt)
#pragma unroll
            for (int r = 0; r < 4; ++r) CQ[(size_t)(qbase + 4 * q4 + r) * 2048 + h * 128 + 16 * dt + c16] = f2bf(O[dt][r] * linv[r]);
    }
}

__device__ __forceinline__ void phase_e2(KP p, int l, int nrows, int wid0) {
    const int tid = tid_fresh(wid0); const int lane = tid & 63, gw = blockIdx.x * 8 + (tid >> 6), nw = gridDim.x * 8;
    unsigned char* ws = launder(p->ws);
    const bf16_t* HF = (const bf16_t*)(ws + WS_BC); const bf16_t* HB = (const bf16_t*)(ws + WS_BX); bf16_t* PO = (bf16_t*)(ws + WS_PO);
    const float* hg = p->a_hnorm_g + (size_t)l * 2048;
    for (int row = gw; row < nrows; row += nw) {
#pragma unroll
        for (int h = 0; h < 8; ++h) {
            const size_t o = (size_t)row * 2048 + h * 256 + lane * 4;
            const u32x2 f = *(const u32x2*)(HF + o), bb = *(const u32x2*)(HB + o), ov = *(const u32x2*)(PO + o);
            float v[4] = {bflo(f.x) + bflo(bb.x), bfhi(f.x) + bfhi(bb.x), bflo(f.y) + bflo(bb.y), bfhi(f.y) + bfhi(bb.y)};
            float ss = v[0] * v[0] + v[1] * v[1] + v[2] * v[2] + v[3] * v[3];
            ss = wave_sum(ss);
            const float rstd = rsqrtf(ss * (1.0f / 256.0f) + EPSF);
            const f32x4 gg = *(const f32x4*)(hg + h * 256 + lane * 4);
            const float og[4] = {bflo(ov.x), bfhi(ov.x), bflo(ov.y), bfhi(ov.y)};
            float y[4];
#pragma unroll
            for (int j = 0; j < 4; ++j) y[j] = sigmoidf_(og[j]) * v[j] * rstd * gg[j];
            u32x2 wv; wv.x = pk2(y[0], y[1]); wv.y = pk2(y[2], y[3]); *(u32x2*)(PO + o) = wv;
        }
    }
}


template <int MODE>
__device__ __forceinline__ void ctx_gemm(KP p, int l, LAS unsigned char* lds, int wid0) {
    const int tid = tid_fresh(wid0); const int lane = tid & 63, w = __builtin_amdgcn_readfirstlane(tid >> 6), q4 = lane >> 4, c16 = lane & 15;
    unsigned char* ws = launder(p->ws);
    for (int task = blockIdx.x; task < (NCTX / 64) * 32; task += gridDim.x) {
        const int rg = task >> 5, cb = task & 31; const int row0 = NLAT + rg * 64, col0 = cb * 64;
        const int orow = row0 + (tid >> 3), ocol = col0 + (tid & 7) * 8;
        float yv[8];
#pragma unroll
        for (int i = 0; i < 8; ++i) yv[i] = 0.f;
#pragma unroll 1
        for (int br = 0; br < (MODE == 0 ? 3 : 1); ++br) {
            const bf16_t* A; const bf16_t* Bt;
            if (MODE == 0) { const int ti = 1 + 4 * (br == 1) + (br == 2); A = (const bf16_t*)(ws + WS_T8 + (size_t)ti * SZ_A); Bt = (const bf16_t*)(ws + WS_WA + (size_t)br * SZ_W); }
            else if (MODE == 1) { A = (const bf16_t*)(ws + WS_Y); Bt = (const bf16_t*)(ws + WS_WO); }
            else { A = (const bf16_t*)(ws + WS_XN); Bt = (const bf16_t*)(ws + WS_WQ); }
            const bf16_t* ap = A + (size_t)(row0 + c16) * 2048 + w * 256 + 8 * q4; const bf16_t* bp = Bt + (size_t)(col0 + c16) * 2048 + w * 256 + 8 * q4;
            f32x4 acc[4][4];
#pragma unroll
            for (int mi = 0; mi < 4; ++mi)
#pragma unroll
                for (int j = 0; j < 4; ++j) acc[mi][j] = (f32x4){0.f, 0.f, 0.f, 0.f};
#pragma unroll 2
            for (int ks = 0; ks < 8; ++ks) {
                bf16x8 a[4], bb[4];
#pragma unroll
                for (int mi = 0; mi < 4; ++mi) a[mi] = *(const bf16x8*)(ap + (size_t)mi * 16 * 2048 + ks * 32);
#pragma unroll
                for (int j = 0; j < 4; ++j) bb[j] = *(const bf16x8*)(bp + (size_t)j * 16 * 2048 + ks * 32);
#pragma unroll
                for (int mi = 0; mi < 4; ++mi)
#pragma unroll
                    for (int j = 0; j < 4; ++j) acc[mi][j] = mfma16(a[mi], bb[j], acc[mi][j]);
            }
            __syncthreads();
#pragma unroll
            for (int mi = 0; mi < 4; ++mi)
#pragma unroll
                for (int j = 0; j < 4; ++j)
#pragma unroll
                    for (int r = 0; r < 4; ++r) *(LAS float*)(lds + ((w * 64 + 16 * mi + 4 * q4 + r) * 64 + 16 * j + c16) * 4) = acc[mi][j][r];
            __syncthreads();
            float sv[8];
#pragma unroll
            for (int i = 0; i < 8; ++i) sv[i] = 0.f;
#pragma unroll
            for (int ww = 0; ww < 8; ++ww) { const f32x4 p0 = *(const LAS f32x4*)(lds + ((ww * 64 + (tid >> 3)) * 64 + (tid & 7) * 8) * 4), p1 = *(const LAS f32x4*)(lds + ((ww * 64 + (tid >> 3)) * 64 + (tid & 7) * 8 + 4) * 4);
                sv[0] += p0[0]; sv[1] += p0[1]; sv[2] += p0[2]; sv[3] += p0[3]; sv[4] += p1[0]; sv[5] += p1[1]; sv[6] += p1[2]; sv[7] += p1[3]; }
            if (MODE == 0) { const u32x4 g = *(const u32x4*)((const bf16_t*)(ws + WS_GT) + (size_t)orow * 6144 + (size_t)br * 2048 + ocol);
                yv[0] += sigmoidf_(bflo(g.x)) * sv[0]; yv[1] += sigmoidf_(bfhi(g.x)) * sv[1]; yv[2] += sigmoidf_(bflo(g.y)) * sv[2]; yv[3] += sigmoidf_(bfhi(g.y)) * sv[3];
                yv[4] += sigmoidf_(bflo(g.z)) * sv[4]; yv[5] += sigmoidf_(bfhi(g.z)) * sv[5]; yv[6] += sigmoidf_(bflo(g.w)) * sv[6]; yv[7] += sigmoidf_(bfhi(g.w)) * sv[7]; }
            else {
#pragma unroll
                for (int i = 0; i < 8; ++i) yv[i] = sv[i]; }
        }
        if (MODE == 1) { float* xp = (float*)(ws + WS_X) + (size_t)orow * 2048 + ocol; const float* mg = (const float*)(ws + WS_MOD) + (size_t)l * 3 * 12288 + 2 * 12288 + 2 * 2048 + ocol;
            const f32x4 x0 = *(const f32x4*)xp, x1 = *(const f32x4*)(xp + 4), g0 = *(const f32x4*)mg, g1 = *(const f32x4*)(mg + 4);
            f32x4 o0, o1; o0[0] = x0[0] + g0[0] * yv[0]; o0[1] = x0[1] + g0[1] * yv[1]; o0[2] = x0[2] + g0[2] * yv[2]; o0[3] = x0[3] + g0[3] * yv[3];
            o1[0] = x1[0] + g1[0] * yv[4]; o1[1] = x1[1] + g1[1] * yv[5]; o1[2] = x1[2] + g1[2] * yv[6]; o1[3] = x1[3] + g1[3] * yv[7];
            *(f32x4*)xp = o0; *(f32x4*)(xp + 4) = o1; }
        else { u32x4 ov; ov.x = pk2(yv[0], yv[1]); ov.y = pk2(yv[2], yv[3]); ov.z = pk2(yv[4], yv[5]); ov.w = pk2(yv[6], yv[7]);
            *(u32x4*)((bf16_t*)(ws + (MODE == 0 ? WS_Y : WS_PV)) + (size_t)orow * 2048 + ocol) = ov; }
    }
}

constexpr int PE_MAXT = 80;
constexpr int PE_IDX = 0, PE_W = PE_MAXT * 128 * 4, PE_SCR = 2 * PE_MAXT * 128 * 4, PE_SCRSZ = 16 * 132 * 4 + 4096 + 256;
__device__ __forceinline__ unsigned ordkey(float v) { const unsigned u = __float_as_uint(v); return (u & 0x80000000u) ? ~u : (u | 0x80000000u); }
__device__ __forceinline__ void phase_peer(KP p, int l, LAS unsigned char* lds, int wid0) {
    const int tid = tid_fresh(wid0), lane = tid & 63, w = __builtin_amdgcn_readfirstlane(tid >> 6), q4 = lane >> 4, c16 = lane & 15;
    unsigned char* ws = launder(p->ws);
    const bf16_t* QP = (const bf16_t*)(ws + WS_PV); const bf16_t* KEYS = (const bf16_t*)(ws + WS_KEYS);
    const bf16_t* XN = (const bf16_t*)(ws + WS_XN);
    float* X = (float*)(ws + WS_X); const float* mod = (const float*)(ws + WS_MOD) + (size_t)l * 3 * 12288;
    const int ntok = (l == 0) ? MR : NLAT, G = gridDim.x;
    const int per = (ntok + G - 1) / G; const int t_begin = blockIdx.x * per, t_end = min(ntok, t_begin + per);
    for (int tb = t_begin; tb < t_end; tb += PE_MAXT) {
        const int nt = min(PE_MAXT, t_end - tb);
        __syncthreads();
        const int ntask = (nt + 15) >> 4;
        if (w < ntask) {
            int lane_pe1 = lane; asm volatile("" : "+v"(lane_pe1));
            const int lane = lane_pe1, q4 = lane >> 4, c16 = lane & 15;
            LAS unsigned char* scr = lds + PE_SCR + w * PE_SCRSZ;
            LAS float* SC = (LAS float*)scr;
            LAS float* LS = (LAS float*)(scr + 16 * 132 * 4);
            LAS int* LI = (LAS int*)(scr + 16 * 132 * 4 + 2048);
            LAS unsigned char* PT = scr + 16 * 132 * 4 + 4096;
            if (lane < 52) {
                const int L = lane;
                const int ge16 = L >= 16, ge24 = L >= 24, ge29 = L >= 29, ge33 = L >= 33, ge36 = L >= 36, ge38 = L >= 38, ge40 = L >= 40, ge42 = L >= 42;
                int pa = ge16 + ge24 + ge29 + ge33 + ge36 + ge38 + ge40 + ge42; if (ge42) pa = 8 + (L - 42);
                int pb = L - (16 * ge16 + 8 * ge24 + 5 * ge29 + 4 * ge33 + 3 * ge36 + 2 * ge38 + 2 * ge40 + 2 * ge42); if (ge42) pb = 0;
                if (L >= 50) { pa = 15; pb = 15; }
                PT[lane * 2] = (unsigned char)pa; PT[lane * 2 + 1] = (unsigned char)pb;
            }
            const int tok_a = min(tb + 16 * w + c16, t_end - 1);
            const int tkl = lane >> 2, qq = lane & 3;
            for (int h = 0; h < 8; ++h) {
                for (int pp = 0; pp < 2; ++pp) {
                    const int hp = 2 * h + pp;
                    bf16x8 af[4];
#pragma unroll
                    for (int ks = 0; ks < 4; ++ks) af[ks] = *(const bf16x8*)(QP + (size_t)tok_a * 2048 + h * 256 + pp * 128 + ks * 32 + 8 * q4);
#pragma unroll 2
                    for (int ct = 0; ct < 8; ++ct) {
                        f32x4 acc = {0.f, 0.f, 0.f, 0.f};
#pragma unroll
                        for (int ks = 0; ks < 4; ++ks) { const bf16x8 bfr = *(const bf16x8*)(KEYS + ((size_t)hp * 128 + 16 * ct + c16) * 128 + ks * 32 + 8 * q4); acc = mfma16(af[ks], bfr, acc); }
#pragma unroll
                        for (int r = 0; r < 4; ++r) SC[(4 * q4 + r) * 132 + 16 * ct + c16] = acc[r];
                    }
                    asm volatile("s_waitcnt lgkmcnt(0)" ::: "memory");
                    unsigned key[32];
#pragma unroll
                    for (int i = 0; i < 8; ++i) { const f32x4 v = *(const LAS f32x4*)(SC + tkl * 132 + 32 * qq + 4 * i);
#pragma unroll
                        for (int j = 0; j < 4; ++j) key[4 * i + j] = (ordkey(v[j]) & ~127u) | (unsigned)(32 * qq + 4 * i + j); }
                    unsigned prev = 0xffffffffu;
#pragma unroll 1
                    for (int r = 0; r < 16; ++r) {
                        unsigned mxk = 0u;
#pragma unroll
                        for (int i = 0; i < 32; ++i) { const unsigned k = key[i] < prev ? key[i] : 0u; mxk = mxk > k ? mxk : k; }
                        unsigned o1 = __shfl_xor(mxk, 1); mxk = mxk > o1 ? mxk : o1; o1 = __shfl_xor(mxk, 2); mxk = mxk > o1 ? mxk : o1;
                        prev = mxk;
                        if (qq == (r & 3)) { const int idx = (int)(mxk & 127u); LS[(pp * 16 + tkl) * 16 + r] = SC[tkl * 132 + idx]; LI[(pp * 16 + tkl) * 16 + r] = idx; }
                    }
                    asm volatile("s_waitcnt lgkmcnt(0)" ::: "memory");
                }
                unsigned ck[13];
#pragma unroll
                for (int i = 0; i < 13; ++i) { const int cidx = qq + 4 * i;
                    if (cidx < 50) { const int a = PT[cidx * 2], bq = PT[cidx * 2 + 1]; const float sv = LS[(0 * 16 + tkl) * 16 + a] + LS[(1 * 16 + tkl) * 16 + bq]; ck[i] = (ordkey(sv) & ~63u) | (unsigned)cidx; }
                    else ck[i] = 0u; }
                unsigned prev = 0xffffffffu; float best0 = 0.f, esum = 0.f; float myexp[4] = {0.f, 0.f, 0.f, 0.f}; int myidx[4] = {0, 0, 0, 0};
#pragma unroll
                for (int r = 0; r < 16; ++r) {
                    unsigned mxk = 0u;
#pragma unroll
                    for (int i = 0; i < 13; ++i) { const unsigned k = ck[i] < prev ? ck[i] : 0u; mxk = mxk > k ? mxk : k; }
                    unsigned o1 = __shfl_xor(mxk, 1); mxk = mxk > o1 ? mxk : o1; o1 = __shfl_xor(mxk, 2); mxk = mxk > o1 ? mxk : o1;
                    prev = mxk;
                    const int cidx = (int)(mxk & 63u); const int a = PT[cidx * 2], bq = PT[cidx * 2 + 1];
                    const float best = LS[(0 * 16 + tkl) * 16 + a] + LS[(1 * 16 + tkl) * 16 + bq];
                    const int eidx = LI[(0 * 16 + tkl) * 16 + a] * 128 + LI[(1 * 16 + tkl) * 16 + bq];
                    if (r == 0) best0 = best;
                    const float e = __expf(best - best0); esum += e;
                    if (qq == (r & 3)) { myexp[r >> 2] = e; myidx[r >> 2] = eidx; }
                }
                const float inv = 1.0f / esum; const int tl = 16 * w + tkl;
                if (tl < nt) {
#pragma unroll
                    for (int i = 0; i < 4; ++i) { const int r = 4 * i + qq;
                        *(LAS int*)(lds + PE_IDX + (tl * 128 + h * 16 + r) * 4) = myidx[i];
                        *(LAS float*)(lds + PE_W + (tl * 128 + h * 16 + r) * 4) = myexp[i] * inv; }
                }
                asm volatile("s_waitcnt lgkmcnt(0)" ::: "memory");
            }
        }
        __syncthreads();
        int lane_pe2 = lane; asm volatile("" : "+v"(lane_pe2));
        for (int tl = w; tl < nt; tl += 8) {
            const int lane = lane_pe2;
            const int row = tb + tl;
            u32x16 xq;
#pragma unroll
            for (int i = 0; i < 4; ++i) { const u32x4 xw = *(const u32x4*)(XN + (size_t)row * 2048 + lane * 32 + i * 8); xq[4 * i] = xw.x; xq[4 * i + 1] = xw.y; xq[4 * i + 2] = xw.z; xq[4 * i + 3] = xw.w; }
            const LAS int* idxp = (const LAS int*)(lds + PE_IDX + tl * 512);
            LAS float* wp = (LAS float*)(lds + PE_W + tl * 512);
            u32x6 bufA[2], bufB[2], bufC[2], bufD[2];
#define PE_ISSUE(buf, TAB, b) do { const int _e0 = idxp[2 * (b)], _e1 = idxp[2 * (b) + 1]; \
                const unsigned char* _r0 = (TAB) + (size_t)_e0 * 1536 + lane * 24; const unsigned char* _r1 = (TAB) + (size_t)_e1 * 1536 + lane * 24; \
                { const u32x4 _a = *(const u32x4*)_r0; const u32x2 _b = *(const u32x2*)(_r0 + 16); buf[0][0] = _a.x; buf[0][1] = _a.y; buf[0][2] = _a.z; buf[0][3] = _a.w; buf[0][4] = _b.x; buf[0][5] = _b.y; } \
                { const u32x4 _a = *(const u32x4*)_r1; const u32x2 _b = *(const u32x2*)(_r1 + 16); buf[1][0] = _a.x; buf[1][1] = _a.y; buf[1][2] = _a.z; buf[1][3] = _a.w; buf[1][4] = _b.x; buf[1][5] = _b.y; } } while (0)
#define PE_CONS_U(buf, b) do { float _p[2]; \
                _Pragma("unroll") for (int _j = 0; _j < 2; ++_j) { const u32x16 _ub = __builtin_bit_cast(u32x16, __builtin_amdgcn_cvt_scalef32_pk32_bf16_fp6(buf[_j], 1.0f)); float _d = 0.f; \
                    _Pragma("unroll") for (int _q = 0; _q < 16; ++_q) _d = dot2bf(_ub[_q], xq[_q], _d); \
                    _p[_j] = _d * (1.0f / 64.0f); } \
                const bool _h32 = (lane & 32) != 0; \
                float _c = _h32 ? _p[1] : _p[0]; const float _cs = _h32 ? _p[0] : _p[1]; _c += __shfl_xor(_cs, 32); \
                _c += __shfl_xor(_c, 16); _c += __shfl_xor(_c, 8); _c += __shfl_xor(_c, 4); _c += __shfl_xor(_c, 2); _c += __shfl_xor(_c, 1); \
                const int _e = 2 * (b) + (lane >> 5); const float _g = wp[_e]; \
                const float _w = _g * 0.5f * _c * (1.0f + erff(_c * 0.70710678118654752f)); \
                if ((lane & 31) == 0) wp[_e] = _w; } while (0)
#define PE_CONS_V(buf, b) do { const f32x2 _w2 = *(const LAS f32x2*)(wp + 2 * (b)); \
                _Pragma("unroll") for (int _j = 0; _j < 2; ++_j) { const f32x32 _vf = __builtin_amdgcn_cvt_scalef32_pk32_f32_fp6(buf[_j], 1.0f); const float _wv = _w2[_j]; \
                    outv += _vf * _wv; } } while (0)
            const unsigned char* TU = ws + WS_PU; const unsigned char* TV = ws + WS_PVW;
#define PE_ISSUE_UV(buf, i) do { if ((i) < 64) PE_ISSUE(buf, TU, (i)); else PE_ISSUE(buf, TV, (i) - 64); } while (0)
#define PE_ISSUE_V(buf, i) do { if ((i) < 64) PE_ISSUE(buf, TV, (i)); } while (0)
            PE_ISSUE(bufA, TU, 0); PE_ISSUE(bufB, TU, 1); PE_ISSUE(bufC, TU, 2);
#pragma unroll 1
            for (int b = 0; b < 64; b += 4) {
                PE_ISSUE_UV(bufD, b + 3); PE_CONS_U(bufA, b);
                PE_ISSUE_UV(bufA, b + 4); PE_CONS_U(bufB, b + 1);
                PE_ISSUE_UV(bufB, b + 5); PE_CONS_U(bufC, b + 2);
                PE_ISSUE_UV(bufC, b + 6); PE_CONS_U(bufD, b + 3);
            }
            asm volatile("s_waitcnt lgkmcnt(0)" ::: "memory");
            f32x32 outv = 0.f;
#pragma unroll 1
            for (int b = 0; b < 64; b += 4) {
                PE_ISSUE_V(bufD, b + 3); PE_CONS_V(bufA, b);
                PE_ISSUE_V(bufA, b + 4); PE_CONS_V(bufB, b + 1);
                PE_ISSUE_V(bufB, b + 5); PE_CONS_V(bufC, b + 2);
                PE_ISSUE_V(bufC, b + 6); PE_CONS_V(bufD, b + 3);
            }
#undef PE_ISSUE_UV
#undef PE_ISSUE_V
#undef PE_ISSUE
#undef PE_CONS_U
#undef PE_CONS_V
            float out[32];
#pragma unroll
            for (int i = 0; i < 32; ++i) out[i] = outv[i];
            const int which = row < NLAT ? (row >> 13) : 2;
            const float* mg = mod + (size_t)which * 12288 + 5 * 2048;
            float* xrow = X + (size_t)row * 2048; float* orow = (l == 1) ? (p->out + (size_t)row * 2048) : xrow;
#pragma unroll
            for (int hh = 0; hh < 8; ++hh) { const int c = lane * 32 + hh * 4;
                const f32x4 xv = *(const f32x4*)(xrow + c), gv = *(const f32x4*)(mg + c);
                f32x4 ov; ov[0] = xv[0] + gv[0] * out[hh * 4 + 0] * 0.25f; ov[1] = xv[1] + gv[1] * out[hh * 4 + 1] * 0.25f; ov[2] = xv[2] + gv[2] * out[hh * 4 + 2] * 0.25f; ov[3] = xv[3] + gv[3] * out[hh * 4 + 3] * 0.25f;
                *(f32x4*)(orow + c) = ov; }
        }
    }
}

#if !MK_SINGLE
#define LOHI_ARGS , const int lo, const int hi
#define LOHI_PASS , lo, hi
#else
#define LOHI_ARGS
#define LOHI_PASS
#endif
#ifndef PHM
#define PHM 0x7ff
#endif
#if MK_SINGLE
#define IN(k) (((PHM >> (((k) % NPH))) & 1) != 0)
#define SEAM(k) do { if ((k) + 1 < 2 * NPH) xcd_barrier(bar); } while (0)
#else
#define IN(k) (((PHM >> (((k) % NPH))) & 1) && lo <= (k) && (k) < hi)
#define SEAM(k) do { if (IN(k) && IN((k) + 1)) xcd_barrier(bar); } while (0)
#endif
template <int l>
__device__ __forceinline__ void layer_program(KP kp, unsigned char* ws0, LAS unsigned char* lds, const XcdBarrier& bar, const int G, const int wid0 LOHI_ARGS) {
        const int pb = l * NPH;
        const int M2 = (l == 0) ? MR : NLAT;
        constexpr int MG = NLAT;
        if (IN(pb + 0)) { phase_w(launder_p(kp), l, lds, wid0); } SEAM(pb + 0);
        if (IN(pb + 1)) { phase_norm(launder_p(kp), l, 0, MR, wid0); } SEAM(pb + 1);
        if (IN(pb + 2)) { unsigned char* ws = launder(ws0);
            { pg8::PlainOrder S; S.init(ws + WS_XN8, ws + WS_WIN, MR, 72 * 256, 1024, G, (int)blockIdx.x); S.skip_from = 48; S.skip_cnt = 24;
              pg8::EpiProj E{ws};
              pg8::gemm_phase<pg8::EpiProj, pg8::PlainOrder, true>(lds, 1024, S, E, wid0); }
            { pg8::PlainOrder S; S.init(ws + WS_XN, ws + WS_WINB, MR, 24 * 256, 2048, G, (int)blockIdx.x); S.pn_base = 48; S.b_row0 = 48;
              pg8::EpiProj E{ws};
              pg8::gemm_phase<pg8::EpiProj, pg8::PlainOrder, false>(lds, 2048, S, E, wid0); }
        } SEAM(pb + 2);
        if (IN(pb + 3)) { phase_gates_gemm(launder_p(kp), l, wid0); phase_e1(launder_p(kp), l, wid0); } SEAM(pb + 3);
        if (IN(pb + 4)) { phase_mlstm(launder_p(kp), l, lds, wid0); phase_attn(launder_p(kp), l, lds, wid0); } SEAM(pb + 4);
        if (IN(pb + 5)) { phase_e2(launder_p(kp), l, M2, wid0); } SEAM(pb + 5);
        if (IN(pb + 6)) { unsigned char* ws = launder(ws0);
            pg8::BranchOrder S; S.T8 = (const char*)(ws + WS_T8); S.WA = (const char*)(ws + WS_WA);
            S.nM = MG / 256; S.nN = 8; S.G = G; S.c = (int)blockIdx.x; S.tstep = (size_t)256 * 2048 * 2;
            pg8::EpiMerge E{(bf16_t*)(ws + WS_Y), (const bf16_t*)(ws + WS_GT)};
            pg8::gemm_phase<pg8::EpiMerge, pg8::BranchOrder>(lds, 2048, S, E, wid0);
            if (l == 0) ctx_gemm<0>(launder_p(kp), l, lds, wid0);
        } SEAM(pb + 6);
        if (IN(pb + 7)) { unsigned char* ws = launder(ws0);
            pg8::PlainOrder S; S.init(ws + WS_Y, ws + WS_WO, MG, 2048, 2048, G, (int)blockIdx.x);
            pg8::EpiRes E{(float*)(ws + WS_X), (const float*)(ws + WS_MOD) + (size_t)l * 3 * 12288};
            pg8::gemm_phase<pg8::EpiRes, pg8::PlainOrder>(lds, 2048, S, E, wid0);
            if (l == 0) ctx_gemm<1>(launder_p(kp), l, lds, wid0);
        } SEAM(pb + 7);
        if (IN(pb + 8)) { phase_norm(launder_p(kp), l, 1, M2, wid0); } SEAM(pb + 8);
        if (IN(pb + 9)) { unsigned char* ws = launder(ws0);
            pg8::PlainOrder S; S.init(ws + WS_XN, ws + WS_WQ, MG, 2048, 2048, G, (int)blockIdx.x);
            pg8::EpiBf E{(bf16_t*)(ws + WS_PV), 2048};
            pg8::gemm_phase<pg8::EpiBf, pg8::PlainOrder>(lds, 2048, S, E, wid0);
            if (l == 0) ctx_gemm<2>(launder_p(kp), l, lds, wid0);
        } SEAM(pb + 9);
        if (IN(pb + 10)) { phase_peer(launder_p(kp), l, lds, wid0); } SEAM(pb + 10);
    }
#undef IN
#undef SEAM

__global__ void __launch_bounds__(NTHREADS, 2) fwd_kernel(Params p) {
    extern __shared__ __attribute__((aligned(16))) unsigned char lds_raw[];
    LAS unsigned char* lds = (LAS unsigned char*)lds_raw;
    const int tid = threadIdx.x, G = gridDim.x;
    const int wid0 = __builtin_amdgcn_readfirstlane(tid >> 6);
    KP kp = (KP)__builtin_amdgcn_kernarg_segment_ptr();
    unsigned char* ws0 = kp->ws;
    volatile LAS unsigned* bst = (volatile LAS unsigned*)(lds + LDS_BYTES - 16);
    if (tid == 0) { bst[0] = 0u; bst[1] = 0u; bst[2] = 0u; bst[3] = 0u; }
    __syncthreads();
    XcdBarrier bar; bar.bar = (unsigned*)(ws0 + WS_BAR); bar.x = 0; bar.st = bst;
    if (MK_SINGLE) bar = xcd_barrier_post((unsigned*)(ws0 + WS_BAR), bst);
#if !MK_SINGLE
    const int lo = kp->ph_lo, hi = kp->ph_hi;
#endif
    layer_program<0>(kp, ws0, lds, bar, G, wid0 LOHI_PASS);
    layer_program<1>(kp, ws0, lds, bar, G, wid0 LOHI_PASS);
}

#ifdef CUT
#ifndef DUMP_OFF
#define DUMP_OFF WS_PV
#endif
#ifndef DUMP_F32
#define DUMP_F32 0
#endif
#ifndef DUMP_N
#define DUMP_N ((size_t)NLAT * DM)
#endif
__global__ void dump_kernel(const unsigned char* ws, float* out, size_t n) {
    for (size_t i = (size_t)blockIdx.x * blockDim.x + threadIdx.x; i < n; i += (size_t)gridDim.x * blockDim.x)
        out[i] = (i >= (size_t)DUMP_N) ? 0.f : (DUMP_F32 ? ((const float*)(ws + DUMP_OFF))[i] : bf2f(((const bf16_t*)(ws + DUMP_OFF))[i]));
}
#endif
extern "C" void kernel_launch(void* const* d_in, const int* in_sizes, int n_in, void* d_out, int out_size, void* d_ws, size_t ws_size, hipStream_t stream) {
    static int grid = 0;
    if (grid == 0) {
        if (n_in != 21 || in_sizes[0] != NLAT * DM || out_size != NLAT * DM || ws_size < WS_END) {
            fprintf(stderr, "kernel_launch: unexpected shapes (n_in %d, in0 %d, out %d, ws %zu need %zu); nothing launched\n", n_in, n_in > 0 ? in_sizes[0] : -1, out_size, ws_size, (size_t)WS_END); grid = -1; return; }
        int dev = 0, cus = 0, per_cu = 0;
        if (hipGetDevice(&dev) != hipSuccess || hipDeviceGetAttribute(&cus, hipDeviceAttributeMultiprocessorCount, dev) != hipSuccess) { grid = -1; return; }
        if (hipFuncSetAttribute((const void*)fwd_kernel, hipFuncAttributeMaxDynamicSharedMemorySize, LDS_BYTES) != hipSuccess) { fprintf(stderr, "kernel_launch: hipFuncSetAttribute failed\n"); grid = -1; return; }
        if (hipOccupancyMaxActiveBlocksPerMultiprocessor(&per_cu, (const void*)fwd_kernel, NTHREADS, LDS_BYTES) != hipSuccess || per_cu < 1) { fprintf(stderr, "kernel_launch: occupancy query says %d\n", per_cu); }
        (void)hipGetLastError();
        grid = cus;
    }
    if (grid < 0) return;
    (void)hipMemsetAsync((char*)d_ws, 0, CTL_BYTES, stream);
    Params p{};
    const float** pp = (const float**)&p;
    for (int i = 0; i < 21; ++i) pp[i] = (const float*)d_in[i];
    p.out = (float*)d_out; p.ws = (unsigned char*)d_ws;
#if MK_SINGLE
    p.ph_lo = 0; p.ph_hi = 2 * NPH;
    hipLaunchKernelGGL(fwd_kernel, dim3(grid), dim3(NTHREADS), LDS_BYTES, stream, p);
#else
#ifdef CUT
    for (int k = 0; k <= CUT; ++k) { p.ph_lo = k; p.ph_hi = k + 1; hipLaunchKernelGGL(fwd_kernel, dim3(grid), dim3(NTHREADS), LDS_BYTES, stream, p); }
    hipLaunchKernelGGL(dump_kernel, dim3(1024), dim3(256), 0, stream, (const unsigned char*)d_ws, (float*)d_out, (size_t)NLAT * DM);
#else
    for (int k = 0; k < 2 * NPH; ++k) { p.ph_lo = k; p.ph_hi = k + 1; hipLaunchKernelGGL(fwd_kernel, dim3(grid), dim3(NTHREADS), LDS_BYTES, stream, p); }
#endif
#endif
}
```

```cpp
#include <hip/hip_runtime.h>
#include <stdint.h>
#include <stdio.h>
#include <type_traits>

#ifndef MK_SINGLE
#define MK_SINGLE 1
#endif

#define LAS __attribute__((address_space(3)))
typedef unsigned short bf16_t;
typedef short bf16x8 __attribute__((ext_vector_type(8)));
typedef float f32x4 __attribute__((ext_vector_type(4)));
typedef float f32x2 __attribute__((ext_vector_type(2)));
typedef unsigned u32x4 __attribute__((ext_vector_type(4)));
typedef unsigned u32x2 __attribute__((ext_vector_type(2)));
typedef __bf16 bf2_t __attribute__((ext_vector_type(2)));
typedef int i32x4 __attribute__((ext_vector_type(4)));
typedef int i32x8 __attribute__((ext_vector_type(8)));
typedef float f32x16 __attribute__((ext_vector_type(16)));
typedef float f32x32 __attribute__((ext_vector_type(32)));
typedef unsigned u32x6 __attribute__((ext_vector_type(6)));
typedef __bf16 bf16x32_t __attribute__((ext_vector_type(32)));
typedef unsigned u32x16 __attribute__((ext_vector_type(16)));
typedef short s16x4 __attribute__((ext_vector_type(4)));
#ifndef FP6_INTERLEAVED
#define FP6_INTERLEAVED 1
#endif

constexpr int DM = 2048, NBATCH = 2, SEQ = 8192, CTXL = 256;
constexpr int NLAT = NBATCH * SEQ;
constexpr int NCTX = NBATCH * CTXL;
constexpr int MR = NLAT + NCTX;
constexpr int PROJ_W = 24608;
constexpr int NPROJ = 24576;
constexpr int NTHREADS = 512;
constexpr int LDS_BYTES = 163840;
constexpr int NPH = 11;
constexpr float EPSF = 1e-6f;

constexpr size_t SZ_A = (size_t)MR * 2048 * 2;
constexpr size_t WS_BAR = 0;
constexpr size_t WS_MOD = 16384;
constexpr size_t CTL_BYTES = 16384 + 2 * 3 * 12288 * 4;
constexpr size_t WS_TAB = 311296;
constexpr size_t WS_X = WS_TAB + 32768;
constexpr size_t WS_XN = WS_X + (size_t)MR * 2048 * 4;
constexpr size_t WS_Y = WS_XN + SZ_A;
constexpr size_t WS_XN8 = WS_Y;
constexpr size_t WS_PQ = WS_Y + SZ_A;
constexpr size_t WS_PK = WS_PQ + SZ_A / 2;
constexpr size_t WS_T8 = WS_PK + SZ_A / 2;
constexpr size_t WS_PV = WS_T8 + 0 * SZ_A;
constexpr size_t WS_PO = WS_T8 + 1 * SZ_A;
constexpr size_t WS_CQ = WS_T8 + 2 * SZ_A;
constexpr size_t WS_CK = WS_T8 + 3 * SZ_A;
constexpr size_t WS_CV = WS_T8 + 4 * SZ_A;
constexpr size_t WS_BB = WS_T8 + 5 * SZ_A;
constexpr size_t WS_BC = WS_T8 + 6 * SZ_A;
constexpr size_t WS_BX = WS_T8 + 7 * SZ_A;
constexpr size_t WS_GT = WS_T8 + 8 * SZ_A;
constexpr size_t WS_GATES = WS_GT + 3 * SZ_A;
constexpr size_t WS_WIN = WS_GATES + (size_t)MR * 32 * 4;
constexpr size_t WS_WINB = WS_WIN + (size_t)NPROJ * 2048;
constexpr size_t WS_WG = WS_WIN + (size_t)NPROJ * 2048 * 2;
constexpr size_t SZ_W = (size_t)2048 * 2048 * 2;
constexpr size_t WS_WA = WS_WG + 32 * 2048 * 2;
constexpr size_t WS_WB = WS_WA + SZ_W;
constexpr size_t WS_WC = WS_WB + SZ_W;
constexpr size_t WS_WO = WS_WC + SZ_W;
constexpr size_t WS_WQ = WS_WO + SZ_W;
constexpr size_t WS_KEYS = WS_WQ + SZ_W;
constexpr size_t WS_PU = WS_KEYS + 16 * 128 * 128 * 2;
constexpr size_t WS_PVW = WS_PU + (size_t)16384 * 2048 * 2;
constexpr size_t WS_SCAN = WS_PU + (size_t)16384 * 2048;
constexpr size_t WS_END = WS_PVW + (size_t)16384 * 2048 * 2;

struct Params {
    const float *x, *c, *ctx, *c_ctx, *w_ada, *b_ada, *norm_g, *w_in, *a_gate_b, *a_hnorm_g, *b_conv, *c_qk_g, *c_rpb,
        *w_a_out, *w_b_out, *w_c_out, *w_out, *peer_wq, *peer_keys, *peer_u, *peer_v;
    float* out; unsigned char* ws; int ph_lo, ph_hi;
};
#define CAS __attribute__((address_space(4)))
typedef const CAS Params* KP;
__device__ __forceinline__ KP launder_p(KP q) { asm volatile("" : "+s"(q)); return q; }

__device__ __forceinline__ unsigned char* launder(unsigned char* q) { size_t z = 0; asm volatile("" : "+s"(z)); return q + z; }
__device__ __forceinline__ int tid_fresh(int wid0) { int t = wid0 * 64 + (int)__builtin_amdgcn_mbcnt_hi(~0u, __builtin_amdgcn_mbcnt_lo(~0u, 0u)); asm volatile("" : "+v"(t)); return t; }

__device__ __forceinline__ float bf2f(unsigned b) { return __uint_as_float(b << 16); }
__device__ __forceinline__ float bflo(unsigned w) { return __uint_as_float(w << 16); }
__device__ __forceinline__ float bfhi(unsigned w) { return __uint_as_float(w & 0xffff0000u); }
__device__ __forceinline__ unsigned pk2(float lo, float hi) { f32x2 v = {lo, hi}; bf2_t b = __builtin_convertvector(v, bf2_t); return __builtin_bit_cast(unsigned, b); }
__device__ __forceinline__ bf16_t f2bf(float f) { return (bf16_t)(pk2(f, 0.f) & 0xffffu); }
__device__ __forceinline__ f32x4 mfma16(bf16x8 a, bf16x8 b, f32x4 c) { return __builtin_amdgcn_mfma_f32_16x16x32_bf16(a, b, c, 0, 0, 0); }
__device__ __forceinline__ float dot2bf(unsigned a, unsigned b, float c) { return __builtin_amdgcn_fdot2_f32_bf16(__builtin_bit_cast(bf2_t, a), __builtin_bit_cast(bf2_t, b), c, false); }
#define LDS_BARRIER() do { asm volatile("s_waitcnt lgkmcnt(0)" ::: "memory"); __builtin_amdgcn_s_barrier(); asm volatile("" ::: "memory"); } while (0)
__device__ __forceinline__ float wave_sum(float v) {
#pragma unroll
    for (int o = 32; o >= 1; o >>= 1) v += __shfl_xor(v, o);
    return v;
}
__device__ __forceinline__ float sigmoidf_(float v) { return __builtin_amdgcn_rcpf(1.0f + __expf(-v)); }
__device__ __forceinline__ float logsigmoidf_(float v) { return fminf(v, 0.f) - log1pf(__expf(-fabsf(v))); }

#define XB_TMO      128
#define XB_XCNT(j)  (256  + 64 * (j))
#define XB_XSUB(j)  (1280 + 64 * (j))
#define XB_XGEN(j)  (2304 + 64 * (j))
#define XB_TOP      3328
#define XB_TOPGEN   3392
#define XCD_BAR_WORDS 3456
#define XB_SPIN_CAP (1u << 22)
__device__ __forceinline__ unsigned xb_ld(unsigned* p)              { return __hip_atomic_load(p, __ATOMIC_RELAXED, __HIP_MEMORY_SCOPE_AGENT); }
__device__ __forceinline__ unsigned xb_add(unsigned* p, unsigned v) { return __hip_atomic_fetch_add(p, v, __ATOMIC_RELAXED, __HIP_MEMORY_SCOPE_AGENT); }
__device__ __forceinline__ unsigned xb_xcc_id() { return (unsigned)__builtin_amdgcn_s_getreg((3 << 11) | 20) & 0xFu; }
#define XB_SPIN(cond, bar) do { unsigned _sp = 0; while (cond) { __builtin_amdgcn_s_sleep(1); \
    if ((++_sp & 255u) == 0u) { if (xb_ld(&(bar)[XB_TMO])) break; if (_sp > XB_SPIN_CAP) { atomicAdd(&(bar)[XB_TMO], 1u); break; } } } } while (0)
struct XcdBarrier { unsigned* bar; unsigned x; volatile LAS unsigned* st; };
__device__ __forceinline__ XcdBarrier xcd_barrier_post(unsigned* bar, volatile LAS unsigned* st) {
    XcdBarrier b; b.bar = bar; b.x = xb_xcc_id(); b.st = st;
    if (threadIdx.x == 0) (void)xb_add(&bar[XB_XCNT(b.x)], 1u);
    return b;
}
__device__ __forceinline__ void xcd_barrier_complete(unsigned* bar, unsigned x, unsigned& nloc, unsigned& nx) {
    const unsigned G = gridDim.x * gridDim.y * gridDim.z;
    unsigned sum, cnt, mine, sp = 0u;
    for (;;) {
        sum = 0u; cnt = 0u; mine = 0u;
#pragma unroll
        for (unsigned j = 0; j < 16; ++j) { const unsigned c = xb_ld(&bar[XB_XCNT(j)]); sum += c; cnt += (c > 0u) ? 1u : 0u; mine = (j == x) ? c : mine; }
        if (sum == G) break;
        __builtin_amdgcn_s_sleep(1);
        if ((++sp & 255u) == 0u) { if (xb_ld(&bar[XB_TMO])) break; if (sp > XB_SPIN_CAP) { atomicAdd(&bar[XB_TMO], 1u); break; } }
    }
    nloc = mine > 0u ? mine : 1u; nx = cnt > 0u ? cnt : 1u;
}
__device__ __forceinline__ void xcd_barrier(const XcdBarrier& b) {
    asm volatile("s_waitcnt vmcnt(0)" ::: "memory");
    __syncthreads();
    if (threadIdx.x == 0) {
        unsigned* bar = b.bar;
        __builtin_amdgcn_s_waitcnt(0);
        unsigned nloc = b.st[0], nx = b.st[1];
        if (nloc == 0u) { xcd_barrier_complete(bar, b.x, nloc, nx); b.st[0] = nloc; b.st[1] = nx; }
        const unsigned old = xb_add(&bar[XB_XSUB(b.x)], 1u);
        const unsigned gen = old / nloc;
        if (old + 1u == (gen + 1u) * nloc) {
            __builtin_amdgcn_fence(__ATOMIC_RELEASE, "agent");
            asm volatile("s_waitcnt vmcnt(0)" ::: "memory");
            const unsigned og = xb_add(&bar[XB_TOP], 1u);
            const unsigned tg = og / nx;
            if (og + 1u == (tg + 1u) * nx) xb_add(&bar[XB_TOPGEN], 1u);
            else XB_SPIN(xb_ld(&bar[XB_TOPGEN]) == tg, bar);
            __builtin_amdgcn_fence(__ATOMIC_ACQUIRE, "agent");
            xb_add(&bar[XB_XGEN(b.x)], 1u);
            asm volatile("s_waitcnt vmcnt(0)" ::: "memory");
        } else {
            XB_SPIN(xb_ld(&bar[XB_XGEN(b.x)]) == gen, bar);
            __builtin_amdgcn_fence(__ATOMIC_ACQUIRE, "agent");
            asm volatile("s_waitcnt vmcnt(0)" ::: "memory");
        }
    }
    __syncthreads();
}

namespace pg8 {
constexpr int BM = 256, BK = 64, HALF = 128, HTB = HALF * BK * 2, STAGE_BYTES = 8 * HTB, NXCD = 8, WGM = 8;
__host__ __device__ __forceinline__ int lds_byte(int r, int c) { const int st = (r >> 4) * 2 + (c >> 5), rr = r & 15, cc = c & 31, ob = rr * 64 + cc * 2; return st * 1024 + (ob ^ (((ob >> 9) & 1) << 5)); }
__host__ __device__ __forceinline__ void stage_rc(int b, int& R, int& C) { const int st = b / 1024, sb = b % 1024, swz = sb ^ (((sb >> 9) & 1) << 5); R = (st >> 1) * 16 + swz / 64; C = (st & 1) * 32 + (swz % 64) / 2; }
__host__ __device__ __forceinline__ int perm32(int rho) { const int n = rho >> 4, i = rho & 15; return 8 * (i >> 2) + 4 * n + (i & 3); }

struct Unit { int pm, pn, br; const char* A; const char* B; };

__device__ __forceinline__ bool tile_of(int L, int nM, int nN, int& pm, int& pn) {
    const int nwg = nM * nN; if (L >= nwg) return false;
    int wgid = L; { const int q = nwg / NXCD, r = nwg % NXCD, xcd = wgid % NXCD, off = wgid / NXCD; wgid = (xcd < r ? xcd * (q + 1) : r * (q + 1) + (xcd - r) * q) + off; }
    const int nig = WGM * nN, gid = wgid / nig, fm = gid * WGM, gsz = (nM - fm) < WGM ? (nM - fm) : WGM;
    pm = fm + ((wgid % nig) % gsz); pn = (wgid % nig) / gsz; return true;
}
struct PlainOrder {
    const char* A; const char* Bt; int nM, nN, G, c; size_t tstep; int pn_base, skip_from, skip_cnt, b_row0;
    __device__ __forceinline__ void init(const void* A_, const void* Bt_, int M, int N, int K, int G_, int c_) { A = (const char*)A_; Bt = (const char*)Bt_; nM = M / BM; nN = N / BM; G = G_; c = c_; tstep = (size_t)BM * K * 2;
        pn_base = 0; skip_from = 1 << 30; skip_cnt = 0; b_row0 = 0; }
    __device__ __forceinline__ bool next(int i, Unit& u) const {
        int pm, pn; if (!tile_of(i * G + c, nM, nN, pm, pn)) return false;
        pn += pn_base; if (pn >= skip_from) pn += skip_cnt;
        u.pm = pm; u.pn = pn; u.br = 0; u.A = A + (size_t)pm * tstep; u.B = Bt + (size_t)(pn - b_row0) * tstep; return true;
    }
};
struct BranchOrder {
    const char* T8; const char* WA; int nM, nN, G, c; size_t tstep;
    __device__ __forceinline__ bool next(int i, Unit& u) const {
        const int tl = i / 3, br = i - 3 * tl; int pm, pn; if (!tile_of(tl * G + c, nM, nN, pm, pn)) return false;
        u.pm = pm; u.pn = pn; u.br = br;
        const int ti = 1 + 4 * (br == 1) + (br == 2);
        u.A = T8 + (size_t)ti * SZ_A + (size_t)pm * tstep; u.B = WA + (size_t)br * SZ_W + (size_t)pn * tstep; return true;
    }
};

template <class Epi, class Sched, bool FP8 = false>
__device__ __forceinline__ void gemm_phase(LAS unsigned char* lds, const int K, const Sched& S, const Epi& E, int wid0) {
    const int tid = tid_fresh(wid0), wid = __builtin_amdgcn_readfirstlane(tid >> 6), lane = tid & 63, wr = wid >> 2, wc = wid & 3, fr = lane & 15, fq = lane >> 4;
    const int nt = K / BK;
    unsigned voffA[2], voffB[2];
#pragma unroll
    for (int i = 0; i < 2; ++i) { int R, C; stage_rc(tid * 16 + i * 8192, R, C); const int Rb = Epi::PERM ? ((R & ~31) + perm32(R & 31)) : R;
        voffA[i] = (unsigned)(R * K + C) * 2u; voffB[i] = (unsigned)(Rb * K + C) * 2u; }
    const size_t kstep = (size_t)(BK * 2);
    const size_t hstep = (size_t)HALF * K * 2;
    const unsigned ldsw = (unsigned)wid * 1024u;
    const int aoff = lds_byte(wr * 64 + fr, fq * 8), boff = lds_byte(wc * 32 + fr, fq * 8);
#define PG8_SA(b, h) (((b) * 2 + (h)) * HTB)
#define PG8_SB(b, h) ((4 + (b) * 2 + (h)) * HTB)
#define PG8_STAGE(bufoff, gbase, voff) do { _Pragma("unroll") for (int _i = 0; _i < 2; ++_i) \
        __builtin_amdgcn_global_load_lds((const unsigned*)((const char*)(gbase) + (voff)[_i]), (LAS unsigned*)(lds + (bufoff) + ldsw + _i * 8192), 16, 0, 0); } while (0)
#define PG8_LD1(dstv, addr) do { if constexpr (FP8) { const i32x4 _lo = *(const LAS i32x4*)(lds + (addr)), _hi = *(const LAS i32x4*)(lds + (addr) + 1024); dstv[0] = __builtin_shufflevector(_lo, _hi, 0, 1, 2, 3, 4, 5, 6, 7); } \
        else { _Pragma("unroll") for (int k = 0; k < 2; ++k) dstv[k] = *(const LAS bf16x8*)(lds + (addr) + k * 1024); } } while (0)
#define PG8_LDA(dst, b, h) do { _Pragma("unroll") for (int m = 0; m < 4; ++m) PG8_LD1(dst[m], PG8_SA(b, h) + aoff + m * 2048); } while (0)
#define PG8_LDB(dst, b, h) do { _Pragma("unroll") for (int n = 0; n < 2; ++n) PG8_LD1(dst[n], PG8_SB(b, h) + boff + n * 2048); } while (0)
#define PG8_MMA(ai, bj, At, Bt) do { __builtin_amdgcn_s_setprio(1); _Pragma("unroll") for (int m = 0; m < 4; ++m) _Pragma("unroll") for (int n = 0; n < 2; ++n) { \
        if constexpr (FP8) asm volatile("v_mfma_scale_f32_16x16x128_f8f6f4 %0, %1, %2, %0, %3, %4 op_sel_hi:[0,0,0]" : "+v"(acc[ai][bj][m][n]) : "v"(Bt[n][0]), "v"(At[m][0]), "v"(sclW), "v"(sclX)); \
        else { _Pragma("unroll") for (int k = 0; k < 2; ++k) acc[ai][bj][m][n] = __builtin_amdgcn_mfma_f32_16x16x32_bf16(Bt[n][k], At[m][k], acc[ai][bj][m][n], 0, 0, 0); } } \
        __builtin_amdgcn_s_setprio(0); } while (0)
#define PG8_WAIT_V(n) asm volatile("s_waitcnt vmcnt(" #n ")" ::: "memory")
#define PG8_WAIT_L(n) asm volatile("s_waitcnt lgkmcnt(" #n ")" ::: "memory")
#define PG8_BAR __builtin_amdgcn_s_barrier()
#define PG8_SCHED __builtin_amdgcn_sched_barrier(0)
    Unit cur, nxt; int ui = 0;
    if (!S.next(0, cur)) return;
    const int sclW = 0x75757575, sclX = 0x7F7F7F7F;
    f32x4 acc[2][2][4][2];
#pragma unroll
    for (int a = 0; a < 2; ++a)
#pragma unroll
        for (int b = 0; b < 2; ++b)
#pragma unroll
            for (int m = 0; m < 4; ++m)
#pragma unroll
                for (int n = 0; n < 2; ++n) acc[a][b][m][n] = (f32x4){0.f, 0.f, 0.f, 0.f};
    typedef typename std::conditional<FP8, i32x8, bf16x8>::type frag_t;
    frag_t At[4][FP8 ? 1 : 2], B0[2][FP8 ? 1 : 2], B1[2][FP8 ? 1 : 2];
    const char* cA = cur.A; const char* cB = cur.B;
    PG8_STAGE(PG8_SB(0, 0), cB, voffB); PG8_STAGE(PG8_SA(0, 0), cA, voffA); PG8_STAGE(PG8_SB(0, 1), cB + hstep, voffB); PG8_STAGE(PG8_SA(0, 1), cA + hstep, voffA);
    if (wr == 1) PG8_BAR;
    PG8_WAIT_V(4); PG8_BAR;
    PG8_STAGE(PG8_SB(1, 0), cB + kstep, voffB); PG8_STAGE(PG8_SA(1, 0), cA + kstep, voffA); PG8_STAGE(PG8_SB(1, 1), cB + hstep + kstep, voffB);
    PG8_WAIT_V(6); PG8_BAR;
    for (;;) {
        const bool has_next = S.next(ui + 1, nxt);
        const char* nA = has_next ? nxt.A : cA; const char* nB = has_next ? nxt.B : cB;
        for (int t = 0; t < nt; t += 2) {
            const bool last = (t == nt - 2);
            const char* a1 = cA + (size_t)(t + 1) * kstep;
            const char* a2 = last ? nA : cA + (size_t)(t + 2) * kstep; const char* b2 = last ? nB : cB + (size_t)(t + 2) * kstep;
            const char* a3 = a2 + kstep; const char* b3 = b2 + kstep;
            PG8_LDB(B0, 0, 0); PG8_SCHED; PG8_LDA(At, 0, 0); PG8_STAGE(PG8_SA(1, 1), a1 + hstep, voffA);
            PG8_WAIT_L(8); PG8_BAR; PG8_WAIT_L(0); PG8_MMA(0, 0, At, B0); PG8_BAR; PG8_SCHED;
            PG8_LDB(B1, 0, 1); PG8_STAGE(PG8_SB(0, 0), b2, voffB);
            PG8_BAR; PG8_WAIT_L(0); PG8_MMA(0, 1, At, B1); PG8_BAR;
            PG8_LDA(At, 0, 1); PG8_STAGE(PG8_SA(0, 0), a2, voffA);
            PG8_BAR; PG8_WAIT_L(0); PG8_MMA(1, 0, At, B0); PG8_BAR; PG8_SCHED;
            PG8_STAGE(PG8_SB(0, 1), b2 + hstep, voffB);
            PG8_WAIT_V(6); PG8_BAR; PG8_MMA(1, 1, At, B1); PG8_BAR;
            PG8_LDB(B0, 1, 0); PG8_SCHED; PG8_LDA(At, 1, 0); PG8_STAGE(PG8_SA(0, 1), a2 + hstep, voffA);
            PG8_WAIT_L(8); PG8_BAR; PG8_WAIT_L(0); PG8_MMA(0, 0, At, B0); PG8_BAR; PG8_SCHED;
            PG8_LDB(B1, 1, 1); PG8_STAGE(PG8_SB(1, 0), b3, voffB);
            PG8_BAR; PG8_WAIT_L(0); PG8_MMA(0, 1, At, B1); PG8_BAR;
            PG8_LDA(At, 1, 1); PG8_STAGE(PG8_SA(1, 0), a3, voffA);
            PG8_BAR; PG8_WAIT_L(0); PG8_MMA(1, 0, At, B0); PG8_BAR; PG8_SCHED;
            PG8_STAGE(PG8_SB(1, 1), b3 + hstep, voffB);
            PG8_WAIT_V(6); PG8_BAR; PG8_MMA(1, 1, At, B1); PG8_BAR;
        }
        if constexpr (FP8) { asm volatile("s_nop 15\n\ts_nop 15\n\ts_nop 15" ::: "memory"); }
        E(acc, cur, wr, wc, fr, fq);
        if (!has_next) break;
#pragma unroll
        for (int a = 0; a < 2; ++a)
#pragma unroll
            for (int b = 0; b < 2; ++b)
#pragma unroll
                for (int m = 0; m < 4; ++m)
#pragma unroll
                    for (int n = 0; n < 2; ++n) acc[a][b][m][n] = (f32x4){0.f, 0.f, 0.f, 0.f};
        cur = nxt; cA = nA; cB = nB; ++ui;
    }
    PG8_WAIT_V(0);
    if (wr == 0) PG8_BAR;
    PG8_BAR;
#undef PG8_SA
#undef PG8_SB
#undef PG8_STAGE
#undef PG8_LD1
#undef PG8_LDA
#undef PG8_LDB
#undef PG8_MMA
#undef PG8_WAIT_V
#undef PG8_WAIT_L
#undef PG8_BAR
#undef PG8_SCHED
}

struct EpiProj {
    static constexpr bool PERM = true;
    unsigned char* ws;
    __device__ __forceinline__ void operator()(const f32x4 (&acc)[2][2][4][2], const Unit& u, int wr, int wc, int fr, int fq) const {
        const int pn = u.pn; size_t off; int ld, c0;
        if (pn < 4) { off = WS_PQ; ld = 1024; c0 = pn * 256; }
        else if (pn < 8) { off = WS_PK; ld = 1024; c0 = (pn - 4) * 256; }
        else if (pn < 72) { const int t = (pn - 8) >> 3; off = WS_T8 + (size_t)t * SZ_A; ld = 2048; c0 = ((pn - 8) & 7) * 256; }
        else { off = WS_GT; ld = 6144; c0 = (pn - 72) * 256; }
        bf16_t* rp = (bf16_t*)(ws + off) + (size_t)(u.pm * BM + wr * 64 + fr) * ld + c0 + wc * 32 + 8 * fq;
        const size_t step = (size_t)16 * ld;
#pragma unroll
        for (int ai = 0; ai < 2; ++ai) {
#pragma unroll
            for (int m = 0; m < 4; ++m) {
                asm volatile("" : "+v"(rp));
#pragma unroll
                for (int bj = 0; bj < 2; ++bj) { const f32x4 v0 = acc[ai][bj][m][0], v1 = acc[ai][bj][m][1];
                    u32x4 w; w.x = pk2(v0[0], v0[1]); w.y = pk2(v0[2], v0[3]); w.z = pk2(v1[0], v1[1]); w.w = pk2(v1[2], v1[3]);
                    *(u32x4*)(rp + bj * HALF) = w; }
                rp += step;
            }
            rp += 4 * step;
        }
    }
};
struct EpiBf {
    static constexpr bool PERM = true;
    bf16_t* O; int ld;
    __device__ __forceinline__ void operator()(const f32x4 (&acc)[2][2][4][2], const Unit& u, int wr, int wc, int fr, int fq) const {
        const int row0 = u.pm * BM + wr * 64 + fr, col0 = u.pn * BM + wc * 32 + 8 * fq;
#pragma unroll
        for (int ai = 0; ai < 2; ++ai)
#pragma unroll
            for (int m = 0; m < 4; ++m) { bf16_t* rowp = O + (size_t)(row0 + ai * HALF + m * 16) * ld + col0;
#pragma unroll
                for (int bj = 0; bj < 2; ++bj) { const f32x4 v0 = acc[ai][bj][m][0], v1 = acc[ai][bj][m][1];
                    u32x4 w; w.x = pk2(v0[0], v0[1]); w.y = pk2(v0[2], v0[3]); w.z = pk2(v1[0], v1[1]); w.w = pk2(v1[2], v1[3]);
                    *(u32x4*)(rowp + bj * HALF) = w; } }
    }
};
struct EpiMerge {
    static constexpr bool PERM = true;
    bf16_t* Y; const bf16_t* GT;
    __device__ __forceinline__ void operator()(const f32x4 (&acc)[2][2][4][2], const Unit& u, int wr, int wc, int fr, int fq) const {
        const int row0 = u.pm * BM + wr * 64 + fr, col0 = u.pn * BM + wc * 32 + 8 * fq;
        const bool addy = u.br != 0;
#pragma unroll
        for (int ai = 0; ai < 2; ++ai) {
            u32x4 g[4][2], y[4][2];
#pragma unroll
            for (int m = 0; m < 4; ++m)
#pragma unroll
                for (int bj = 0; bj < 2; ++bj) { const size_t r = (size_t)(row0 + ai * HALF + m * 16);
                    g[m][bj] = *(const u32x4*)(GT + r * 6144 + (size_t)u.br * 2048 + col0 + bj * HALF); }
            if (addy) {
#pragma unroll
                for (int m = 0; m < 4; ++m)
#pragma unroll
                    for (int bj = 0; bj < 2; ++bj) { const size_t r = (size_t)(row0 + ai * HALF + m * 16); y[m][bj] = *(const u32x4*)(Y + r * 2048 + col0 + bj * HALF); }
            } else {
#pragma unroll
                for (int m = 0; m < 4; ++m)
#pragma unroll
                    for (int bj = 0; bj < 2; ++bj) y[m][bj] = (u32x4){0u, 0u, 0u, 0u};
            }
#pragma unroll
            for (int m = 0; m < 4; ++m)
#pragma unroll
                for (int bj = 0; bj < 2; ++bj) { const size_t r = (size_t)(row0 + ai * HALF + m * 16);
                    const f32x4 v0 = acc[ai][bj][m][0], v1 = acc[ai][bj][m][1]; const u32x4 gg = g[m][bj], yy = y[m][bj];
                    float o[8];
                    o[0] = sigmoidf_(bflo(gg.x)) * v0[0] + bflo(yy.x); o[1] = sigmoidf_(bfhi(gg.x)) * v0[1] + bfhi(yy.x); o[2] = sigmoidf_(bflo(gg.y)) * v0[2] + bflo(yy.y); o[3] = sigmoidf_(bfhi(gg.y)) * v0[3] + bfhi(yy.y);
                    o[4] = sigmoidf_(bflo(gg.z)) * v1[0] + bflo(yy.z); o[5] = sigmoidf_(bfhi(gg.z)) * v1[1] + bfhi(yy.z); o[6] = sigmoidf_(bflo(gg.w)) * v1[2] + bflo(yy.w); o[7] = sigmoidf_(bfhi(gg.w)) * v1[3] + bfhi(yy.w);
                    u32x4 w; w.x = pk2(o[0], o[1]); w.y = pk2(o[2], o[3]); w.z = pk2(o[4], o[5]); w.w = pk2(o[6], o[7]);
                    *(u32x4*)(Y + r * 2048 + col0 + bj * HALF) = w; }
        }
    }
};
struct EpiRes {
    static constexpr bool PERM = false;
    float* X; const float* Xin; const float* mod;
    __device__ __forceinline__ void operator()(const f32x4 (&acc)[2][2][4][2], const Unit& u, int wr, int wc, int fr, int fq) const {
        const int row0 = u.pm * BM + wr * 64 + fr, col0 = u.pn * BM + wc * 32 + 4 * fq;
        const int which = (u.pm < 32) ? 0 : (u.pm < 64 ? 1 : 2);
        const float* mg = mod + (size_t)which * 12288 + 2 * 2048 + col0;
        f32x4 gv[2][2];
#pragma unroll
        for (int bj = 0; bj < 2; ++bj)
#pragma unroll
            for (int n = 0; n < 2; ++n) gv[bj][n] = *(const f32x4*)(mg + bj * HALF + n * 16);
#pragma unroll
        for (int ai = 0; ai < 2; ++ai) {
            f32x4 xin[4][2][2];
#pragma unroll
            for (int m = 0; m < 4; ++m)
#pragma unroll
                for (int bj = 0; bj < 2; ++bj)
#pragma unroll
                    for (int n = 0; n < 2; ++n) xin[m][bj][n] = *(const f32x4*)(Xin + (size_t)(row0 + ai * HALF + m * 16) * 2048 + col0 + bj * HALF + n * 16);
#pragma unroll
            for (int m = 0; m < 4; ++m)
#pragma unroll
                for (int bj = 0; bj < 2; ++bj)
#pragma unroll
                    for (int n = 0; n < 2; ++n) *(f32x4*)(X + (size_t)(row0 + ai * HALF + m * 16) * 2048 + col0 + bj * HALF + n * 16) = xin[m][bj][n] + gv[bj][n] * acc[ai][bj][m][n];
        }
    }
};
}

__device__ __forceinline__ int proj_src_col(int n) {
    if (n < 1024) return 7200 + n;
    if (n < 2048) return n - 1024;
    if (n < 4096) return 1024 + (n - 2048);
    if (n < 6144) return 8224 + (n - 4096);
    if (n < 8192) return 16416 + (n - 6144);
    if (n < 10240) return 3104 + (n - 8192);
    if (n < 12288) return 5152 + (n - 10240);
    if (n < 14336) return 10272 + (n - 12288);
    if (n < 16384) return 12320 + (n - 14336);
    if (n < 18432) return 14368 + (n - 16384);
    return 18464 + (n - 18432);
}
__device__ __forceinline__ void phase_w(KP p, int l, LAS unsigned char* lds, int wid0) {
    const int tid = tid_fresh(wid0), G = gridDim.x, bid = blockIdx.x;
    unsigned char* ws = launder(p->ws);
    {
        LAS float* tile = (LAS float*)lds;
        const int NT_IN = NPROJ / 64;
        const int total = (NT_IN + 5 * 32) * 8;
        for (int t = bid; t < total; t += G) {
            const int ntile = t >> 3, kt = t & 7, k0 = kt * 256;
            const float* src; int ld; bf16_t* dst; float scale = 1.0f; int n0;
            bool to8 = false;
            if (ntile < NT_IN) { n0 = ntile * 64; src = p->w_in + (size_t)l * 2048 * PROJ_W + proj_src_col(n0); ld = PROJ_W;
                if (n0 >= 12288 && n0 < 18432) { dst = (bf16_t*)(ws + WS_WINB) + (size_t)(n0 - 12288) * 2048; }
                else { to8 = true; dst = (bf16_t*)(ws + WS_WIN); scale = (n0 < 1024) ? 1024.0f * 0.08838834764831845f : 1024.0f; } }
            else { const int mi = (ntile - NT_IN) >> 5; n0 = ((ntile - NT_IN) & 31) * 64;
                const float* m5 = mi == 0 ? p->w_a_out : mi == 1 ? p->w_b_out : mi == 2 ? p->w_c_out : mi == 3 ? p->w_out : p->peer_wq;
                src = m5 + (size_t)l * 2048 * 2048 + n0; ld = 2048;
                dst = (bf16_t*)(ws + WS_WA + (size_t)mi * SZ_W) + (size_t)n0 * 2048; }
            { const int kk = tid >> 4, n4 = (tid & 15) * 4;
              f32x4 v[8];
#pragma unroll
              for (int h = 0; h < 8; ++h) v[h] = *(const f32x4*)(src + (size_t)(k0 + kk + 32 * h) * ld + n4);
#pragma unroll
              for (int h = 0; h < 8; ++h) { LAS float* tp = tile + (kk + 32 * h) * 65 + n4; tp[0] = v[h][0]; tp[1] = v[h][1]; tp[2] = v[h][2]; tp[3] = v[h][3]; } }
            __syncthreads();
            { const int n = tid >> 3, kq = (tid & 7) * 8;
#pragma unroll
              for (int sub = 0; sub < 4; ++sub) { const int k8 = sub * 64 + kq; float v[8];
#pragma unroll
                  for (int j = 0; j < 8; ++j) v[j] = tile[(k8 + j) * 65 + n] * scale;
                  if (to8) {
#pragma unroll
                      for (int j = 0; j < 8; ++j) v[j] = fminf(fmaxf(v[j], -448.f), 448.f);
                      int d0 = 0, d1 = 0; d0 = __builtin_amdgcn_cvt_pk_fp8_f32(v[0], v[1], d0, false); d0 = __builtin_amdgcn_cvt_pk_fp8_f32(v[2], v[3], d0, true);
                      d1 = __builtin_amdgcn_cvt_pk_fp8_f32(v[4], v[5], d1, false); d1 = __builtin_amdgcn_cvt_pk_fp8_f32(v[6], v[7], d1, true);
                      u32x2 w8; w8.x = (unsigned)d0; w8.y = (unsigned)d1; *(u32x2*)((unsigned char*)dst + (size_t)(n0 + n) * 2048 + k0 + k8) = w8; }
                  else { u32x4 w; w.x = pk2(v[0], v[1]); w.y = pk2(v[2], v[3]); w.z = pk2(v[4], v[5]); w.w = pk2(v[6], v[7]);
                      *(u32x4*)(dst + (size_t)n * 2048 + k0 + k8) = w; } } }
            __syncthreads();
        }
    }
    const size_t gtid = (size_t)bid * NTHREADS + tid, gthreads = (size_t)G * NTHREADS;
    for (size_t i = gtid; i < 32 * 2048; i += gthreads) { const int n = (int)(i >> 11), k = (int)(i & 2047);
        ((bf16_t*)(ws + WS_WG))[i] = f2bf(p->w_in[(size_t)l * 2048 * PROJ_W + (size_t)k * PROJ_W + 3072 + n]); }
    {
        const float* su = p->peer_u + (size_t)l * 16384 * 2048; const float* sv = p->peer_v + (size_t)l * 16384 * 2048;
        unsigned char* du = ws + WS_PU; unsigned char* dv = ws + WS_PVW;
        const size_t n32 = (size_t)16384 * 2048 / 32;
        for (size_t i = gtid; i < n32; i += gthreads) {
            f32x4 raw[2][8];
#pragma unroll
            for (int t = 0; t < 2; ++t)
#pragma unroll
                for (int q = 0; q < 8; ++q) raw[t][q] = *(const f32x4*)((t ? sv : su) + i * 32 + q * 4);
#pragma unroll
            for (int t = 0; t < 2; ++t) {
                const float sc = t ? 4.0f : 64.0f;
                float e[32];
#pragma unroll
                for (int q = 0; q < 8; ++q) { const f32x4 a = raw[t][q]; e[q * 4] = a[0] * sc; e[q * 4 + 1] = a[1] * sc; e[q * 4 + 2] = a[2] * sc; e[q * 4 + 3] = a[3] * sc; }
                f32x16 va, vb;
#pragma unroll
                for (int j = 0; j < 16; ++j) { va[j] = FP6_INTERLEAVED ? e[2 * j] : e[j]; vb[j] = FP6_INTERLEAVED ? e[2 * j + 1] : e[16 + j]; }
                const u32x6 wv = __builtin_amdgcn_cvt_scalef32_2xpk16_fp6_f32(va, vb, 1.0f);
                unsigned* dp = (unsigned*)((t ? dv : du) + i * 24);
                u32x2 w0, w1, w2; w0.x = wv[0]; w0.y = wv[1]; w1.x = wv[2]; w1.y = wv[3]; w2.x = wv[4]; w2.y = wv[5];
                *(u32x2*)dp = w0; *(u32x2*)(dp + 2) = w1; *(u32x2*)(dp + 4) = w2;
            }
        }
        const float* sk = p->peer_keys + (size_t)l * 16 * 128 * 128; bf16_t* dk = (bf16_t*)(ws + WS_KEYS);
        for (size_t i = gtid; i < (size_t)16 * 128 * 128; i += gthreads) dk[i] = f2bf(sk[i]);
    }
    {
        float* mod = (float*)(ws + WS_MOD) + (size_t)l * 3 * 12288;
        const float* wa = p->w_ada + (size_t)l * 2048 * 12288; const float* ba = p->b_ada + (size_t)l * 12288;
        LAS float* part = (LAS float*)(lds + 69632);
        const int col = tid & 63, ks = tid >> 6;
        for (int t = bid; t < 256; t += G) {
            const int n = t * 48 + col;
            float a0 = 0.f, a1 = 0.f, a2 = 0.f;
            if (col < 48) {
#pragma unroll 8
                for (int k = ks * 256; k < ks * 256 + 256; ++k) {
                    const float w = wa[(size_t)k * 12288 + n];
                    const float c0 = p->c[k], c1 = p->c[2048 + k], c2 = p->c_ctx[k];
                    a0 += c0 * sigmoidf_(c0) * w; a1 += c1 * sigmoidf_(c1) * w; a2 += c2 * sigmoidf_(c2) * w;
                }
                part[(ks * 3 + 0) * 48 + col] = a0; part[(ks * 3 + 1) * 48 + col] = a1; part[(ks * 3 + 2) * 48 + col] = a2;
            }
            __syncthreads();
            if (tid < 144) { const int which = tid / 48, cc = tid - which * 48; float sacc = ba[t * 48 + cc];
#pragma unroll
                for (int q = 0; q < 8; ++q) sacc += part[(q * 3 + which) * 48 + cc];
                mod[(size_t)which * 12288 + t * 48 + cc] = sacc; }
            __syncthreads();
        }
    }
    if (l == 0) {
        float* tab = (float*)(ws + WS_TAB);
        for (size_t i = gtid; i < 4096; i += gthreads) { const int pos = (int)(i >> 5), j = (int)(i & 31);
            const float inv = powf(10000.0f, -(float)j / 32.0f); const float ang = (float)pos * inv;
            tab[i] = cosf(ang); tab[4096 + i] = sinf(ang); }
    }
}

__device__ __forceinline__ void phase_norm(KP p, int l, int which_norm, int nrows, int wid0) {
    const int tid = tid_fresh(wid0); const int lane = tid & 63, gw = blockIdx.x * 8 + (tid >> 6), nw = gridDim.x * 8;
    unsigned char* ws = launder(p->ws);
    const float* X = (const float*)(ws + WS_X); bf16_t* XN = (bf16_t*)(ws + WS_XN);
    const float* mod = (const float*)(ws + WS_MOD) + (size_t)l * 3 * 12288;
    const float* g = p->norm_g + (size_t)(l * 2 + which_norm) * 2048;
    const int shift_c = which_norm ? 3 : 0, scale_c = which_norm ? 4 : 1;
    for (int row = gw; row < nrows; row += nw) {
        const int which = row < NLAT ? (row >> 13) : 2;
        const float* xr = (l == 0 && which_norm == 0) ? (row < NLAT ? p->x + (size_t)row * 2048 : p->ctx + (size_t)(row - NLAT) * 2048) : X + (size_t)row * 2048;
        const float* mb = mod + (size_t)which * 12288;
        f32x4 v[8]; float ss = 0.f;
#pragma unroll
        for (int i = 0; i < 8; ++i) { v[i] = *(const f32x4*)(xr + i * 256 + lane * 4); ss += v[i][0] * v[i][0] + v[i][1] * v[i][1] + v[i][2] * v[i][2] + v[i][3] * v[i][3]; }
        ss = wave_sum(ss);
        const float rstd = rsqrtf(ss * (1.0f / 2048.0f) + EPSF);
        f32x4 ggv[8], shv[8], scv[8];
#pragma unroll
        for (int i = 0; i < 8; ++i) { const int c = i * 256 + lane * 4; ggv[i] = *(const f32x4*)(g + c); shv[i] = *(const f32x4*)(mb + shift_c * 2048 + c); scv[i] = *(const f32x4*)(mb + scale_c * 2048 + c); }
#pragma unroll
        for (int i = 0; i < 8; ++i) { const int c = i * 256 + lane * 4;
            const f32x4 gg = ggv[i], sh = shv[i], sc = scv[i];
            float o[4];
#pragma unroll
            for (int j = 0; j < 4; ++j) o[j] = v[i][j] * rstd * gg[j] * (1.0f + sc[j]) + sh[j];
            u32x2 w; w.x = pk2(o[0], o[1]); w.y = pk2(o[2], o[3]); *(u32x2*)(XN + (size_t)row * 2048 + c) = w;
            if (which_norm == 0) { int d = 0; d = __builtin_amdgcn_cvt_pk_fp8_f32(fminf(fmaxf(o[0], -448.f), 448.f), fminf(fmaxf(o[1], -448.f), 448.f), d, false);
                d = __builtin_amdgcn_cvt_pk_fp8_f32(fminf(fmaxf(o[2], -448.f), 448.f), fminf(fmaxf(o[3], -448.f), 448.f), d, true); *(unsigned*)(ws + WS_XN8 + (size_t)row * 2048 + c) = (unsigned)d; } }
    }
}

__device__ __forceinline__ void phase_gates_gemm(KP p, int l, int wid0) {
    const int tid = tid_fresh(wid0); const int lane = tid & 63, gw = blockIdx.x * 8 + (tid >> 6), nw = gridDim.x * 8;
    unsigned char* ws = launder(p->ws);
    const bf16_t* XN = (const bf16_t*)(ws + WS_XN); const bf16_t* WG = (const bf16_t*)(ws + WS_WG); float* GA = (float*)(ws + WS_GATES);
    const int q4 = lane >> 4, c = lane & 15;
    const float gb0 = p->a_gate_b[l * 32 + c], gb1 = p->a_gate_b[l * 32 + 16 + c];
    for (int task = gw; task < MR / 16; task += nw) {
        const int r0 = task * 16;
        f32x4 acc0 = {0.f, 0.f, 0.f, 0.f}, acc1 = {0.f, 0.f, 0.f, 0.f};
        const bf16_t* ap = XN + (size_t)(r0 + c) * 2048 + 8 * q4; const bf16_t* b0 = WG + (size_t)c * 2048 + 8 * q4; const bf16_t* b1 = b0 + 16 * 2048;
#pragma unroll 4
        for (int ks = 0; ks < 64; ++ks) { const bf16x8 a = *(const bf16x8*)(ap + ks * 32), x0 = *(const bf16x8*)(b0 + ks * 32), x1 = *(const bf16x8*)(b1 + ks * 32);
            acc0 = mfma16(a, x0, acc0); acc1 = mfma16(a, x1, acc1); }
#pragma unroll
        for (int r = 0; r < 4; ++r) {
            const float v0 = acc0[r] + gb0, v1 = acc1[r] + gb1;
            GA[(size_t)(r0 + 4 * q4 + r) * 32 + c] = (c >= 8) ? logsigmoidf_(v0) : v0; GA[(size_t)(r0 + 4 * q4 + r) * 32 + 16 + c] = (c >= 8) ? logsigmoidf_(v1) : v1; }
    }
}

__device__ __forceinline__ void phase_e1(KP p, int l, int wid0) {
    const int tid = tid_fresh(wid0); const int lane = tid & 63, gw = blockIdx.x * 8 + (tid >> 6), nw = gridDim.x * 8;
    unsigned char* ws = launder(p->ws);
    bf16_t* PQ = (bf16_t*)(ws + WS_PQ); bf16_t* PK = (bf16_t*)(ws + WS_PK); bf16_t* CQ = (bf16_t*)(ws + WS_CQ); bf16_t* CK = (bf16_t*)(ws + WS_CK);
    bf16_t* BB = (bf16_t*)(ws + WS_BB); const bf16_t* BC = (const bf16_t*)(ws + WS_BC); const bf16_t* BX = (const bf16_t*)(ws + WS_BX);
    float* GA = (float*)(ws + WS_GATES); const float* tab = (const float*)(ws + WS_TAB);
    const float* gq = p->c_qk_g + (size_t)(l * 2 + 0) * 128; const float* gk = p->c_qk_g + (size_t)(l * 2 + 1) * 128;
    const float* cw = p->b_conv + (size_t)l * 3 * 2048;
    float gqv[8], gkv[8];
#pragma unroll
    for (int j = 0; j < 8; ++j) { gqv[j] = gq[(lane & 15) * 8 + j] * 0.08838834764831845f; gkv[j] = gk[(lane & 15) * 8 + j]; }
    const int nitems = NLAT / 8 + NCTX;
    for (int item = gw; item < nitems; item += nw) {
        const int row_first = item < NLAT / 8 ? item * 8 : NLAT + (item - NLAT / 8), nrun = item < NLAT / 8 ? 8 : 1;
        for (int rr = 0; rr < nrun; ++rr) { const int row = row_first + rr;
        if (row < NLAT) {
            const int s = row & 8191, gr = s >> 6, gc = s & 63;
#pragma unroll
            for (int it = 0; it < 2; ++it) {
                const int unit = it * 64 + lane, h = unit >> 4, hf = (unit >> 3) & 1, j4 = unit & 7;
                const int off = h * 128 + hf * 64 + j4 * 4, pos = hf ? gc : gr;
                const f32x4 cs = *(const f32x4*)(tab + pos * 32 + j4 * 4), sn = *(const f32x4*)(tab + 4096 + pos * 32 + j4 * 4);
#pragma unroll
                for (int tsel = 0; tsel < 2; ++tsel) { bf16_t* T = (tsel ? PK : PQ) + (size_t)row * 1024 + off;
                    const u32x2 u1 = *(const u32x2*)T, u2 = *(const u32x2*)(T + 32);
                    const float a0 = bflo(u1.x), a1 = bfhi(u1.x), a2 = bflo(u1.y), a3 = bfhi(u1.y), b0 = bflo(u2.x), b1 = bfhi(u2.x), b2 = bflo(u2.y), b3 = bfhi(u2.y);
                    u32x2 o1, o2;
                    o1.x = pk2(a0 * cs[0] - b0 * sn[0], a1 * cs[1] - b1 * sn[1]); o1.y = pk2(a2 * cs[2] - b2 * sn[2], a3 * cs[3] - b3 * sn[3]);
                    o2.x = pk2(b0 * cs[0] + a0 * sn[0], b1 * cs[1] + a1 * sn[1]); o2.y = pk2(b2 * cs[2] + a2 * sn[2], b3 * cs[3] + a3 * sn[3]);
                    *(u32x2*)T = o1; *(u32x2*)(T + 32) = o2; }
            }
        }
#pragma unroll
        for (int tsel = 0; tsel < 2; ++tsel) {
            bf16_t* T = (tsel ? CK : CQ) + (size_t)row * 2048;
            u32x4 wq4[4];
#pragma unroll
            for (int ps = 0; ps < 4; ++ps) wq4[ps] = *(const u32x4*)(T + ps * 512 + lane * 8);
#pragma unroll
            for (int ps = 0; ps < 4; ++ps) {
                const u32x4 w = wq4[ps];
                float v[8] = {bflo(w.x), bfhi(w.x), bflo(w.y), bfhi(w.y), bflo(w.z), bfhi(w.z), bflo(w.w), bfhi(w.w)};
                float ss = 0.f;
#pragma unroll
                for (int j = 0; j < 8; ++j) ss += v[j] * v[j];
                ss += __shfl_xor(ss, 1); ss += __shfl_xor(ss, 2); ss += __shfl_xor(ss, 4); ss += __shfl_xor(ss, 8);
                const float rstd = rsqrtf(ss * (1.0f / 128.0f) + EPSF);
#pragma unroll
                for (int j = 0; j < 8; ++j) v[j] = v[j] * rstd * (tsel ? gkv[j] : gqv[j]);
                u32x4 o; o.x = pk2(v[0], v[1]); o.y = pk2(v[2], v[3]); o.z = pk2(v[4], v[5]); o.w = pk2(v[6], v[7]);
                *(u32x4*)(T + ps * 512 + lane * 8) = o;
            }
        }
        }
        {
            int pos0, len; if (row_first < NLAT) { pos0 = row_first & 8191; len = SEQ; } else { pos0 = (row_first - NLAT) & 255; len = CTXL; }
#pragma unroll 1
            for (int ps = 0; ps < 4; ++ps) {
                const int c = ps * 512 + lane * 8;
                float w0[8], w1[8], w2[8];
#pragma unroll
                for (int hq = 0; hq < 2; ++hq) { const f32x4 a = *(const f32x4*)(cw + c + hq * 4), bq = *(const f32x4*)(cw + 2048 + c + hq * 4), cq = *(const f32x4*)(cw + 4096 + c + hq * 4);
#pragma unroll
                    for (int j = 0; j < 4; ++j) { w0[hq * 4 + j] = a[j]; w1[hq * 4 + j] = bq[j]; w2[hq * 4 + j] = cq[j]; } }
                u32x4 cvr[10], xvr[10], bbr[8];
                const u32x4 zero4 = {0u, 0u, 0u, 0u};
#pragma unroll
                for (int k = 0; k < 10; ++k) { const int rel = k - 1; const bool ok = (rel <= nrun) && (pos0 + rel >= 0) && (pos0 + rel < len) && (rel < nrun || pos0 + rel < len);
                    if (ok && rel <= nrun) { const size_t o = (size_t)(row_first + rel) * 2048 + c; cvr[k] = *(const u32x4*)(BC + o); xvr[k] = *(const u32x4*)(BX + o); } else { cvr[k] = zero4; xvr[k] = zero4; } }
#pragma unroll
                for (int rr = 0; rr < 8; ++rr) bbr[rr] = (rr < nrun) ? *(const u32x4*)(BB + (size_t)(row_first + rr) * 2048 + c) : zero4;
                float up[8], uc[8], un[8];
                auto mk_u = [&](const u32x4 cv, const u32x4 xv, float (&u)[8]) {
                    u[0] = bflo(cv.x) * bflo(xv.x); u[1] = bfhi(cv.x) * bfhi(xv.x); u[2] = bflo(cv.y) * bflo(xv.y); u[3] = bfhi(cv.y) * bfhi(xv.y);
                    u[4] = bflo(cv.z) * bflo(xv.z); u[5] = bfhi(cv.z) * bfhi(xv.z); u[6] = bflo(cv.w) * bflo(xv.w); u[7] = bfhi(cv.w) * bfhi(xv.w); };
                mk_u(cvr[0], xvr[0], up); mk_u(cvr[1], xvr[1], uc);
#pragma unroll
                for (int rr = 0; rr < 8; ++rr) {
                    if (rr < nrun) {
                        mk_u(cvr[rr + 2], xvr[rr + 2], un);
                        const size_t o = (size_t)(row_first + rr) * 2048 + c; const u32x4 bb = bbr[rr];
                        const float bv[8] = {bflo(bb.x), bfhi(bb.x), bflo(bb.y), bfhi(bb.y), bflo(bb.z), bfhi(bb.z), bflo(bb.w), bfhi(bb.w)};
                        float y[8];
#pragma unroll
                        for (int j = 0; j < 8; ++j) y[j] = bv[j] * (up[j] * w0[j] + uc[j] * w1[j] + un[j] * w2[j]);
                        u32x4 ov; ov.x = pk2(y[0], y[1]); ov.y = pk2(y[2], y[3]); ov.z = pk2(y[4], y[5]); ov.w = pk2(y[6], y[7]);
                        *(u32x4*)(BB + o) = ov;
#pragma unroll
                        for (int j = 0; j < 8; ++j) { up[j] = uc[j]; uc[j] = un[j]; }
                    }
                }
            }
        }
    }
}

constexpr int ML_QS = 0, ML_KS = 17408, ML_VT = 53248, ML_SS = 60160, ML_CT = 69376, ML_CTSZ = 13056;
__device__ __forceinline__ int ml_row(int pp, int b, int dir) {
    if (pp < 256) { const int j = dir ? 255 - pp : pp; return NLAT + b * 256 + j; }
    int s = pp - 256; if (dir) s = 8191 - s; return b * 8192 + s;
}
__device__ __forceinline__ void phase_mlstm(KP p, int l, LAS unsigned char* lds, int wid0) {
    const int tid = tid_fresh(wid0), lane = tid & 63, w = __builtin_amdgcn_readfirstlane(tid >> 6), q4 = lane >> 4, c16 = lane & 15;
    unsigned char* ws = launder(p->ws);
    const bf16_t* PQ = (const bf16_t*)(ws + WS_PQ); const bf16_t* PK = (const bf16_t*)(ws + WS_PK); const bf16_t* PV = (const bf16_t*)(ws + WS_PV);
    const float* GA = (const float*)(ws + WS_GATES);
    for (int task = blockIdx.x; task < 256; task += gridDim.x) {
        const int xq = task & 7, yq = task >> 3; const int bh = 2 * xq + (yq >> 4), dir = (yq >> 3) & 1, sl = yq & 7; const int b = bh >> 3, h = bh & 7;
        bf16_t* H = (bf16_t*)(ws + (dir ? WS_BX : WS_BC));
        float* SCN = (float*)(ws + WS_SCAN) + (size_t)task * 3 * 8448;
        __syncthreads();
        for (int cc = w; cc < 132; cc += 8) {
            const int r = ml_row(cc * 64 + lane, b, dir);
            const float li = GA[(size_t)r * 32 + (2 * dir) * 8 + h], lf = GA[(size_t)r * 32 + (2 * dir + 1) * 8 + h];
            float bc = lf;
#pragma unroll
            for (int o = 1; o < 64; o <<= 1) { const float t = __shfl_up(bc, o); if (lane >= o) bc += t; }
            const float a = li - bc;
            float pm = a;
#pragma unroll
            for (int o = 1; o < 64; o <<= 1) { const float t = __shfl_up(pm, o); if (lane >= o) pm = fmaxf(pm, t); }
            SCN[cc * 64 + lane] = bc; SCN[8448 + cc * 64 + lane] = a; SCN[2 * 8448 + cc * 64 + lane] = pm;
        }
        for (int i = tid; i < 16 * 32; i += NTHREADS) { const int r = 32 + (i >> 5), cdw = i & 31; *(LAS unsigned*)(lds + ML_VT + r * 144 + cdw * 4) = (r == 32) ? 0x3f803f80u : 0u; }
        for (int i = tid; i < 2 * ML_CTSZ / 4; i += NTHREADS) *(LAS unsigned*)(lds + ML_CT + i * 4) = 0u;
        __syncthreads();
        float m = 0.f;
        f32x4 Cst[3];
#pragma unroll
        for (int i = 0; i < 3; ++i) Cst[i] = (f32x4){0.f, 0.f, 0.f, 0.f};
        u32x4 qreg[2], kreg[2], vreg; float bc, a, pm;
        const int qrow_l = lane >> 4, qpc = lane & 15, vrow_l = lane >> 2, vpc = lane & 3;
        {
#pragma unroll
          for (int i = 0; i < 2; ++i) { const int r = ml_row(8 * w + 4 * i + qrow_l, b, dir);
              qreg[i] = *(const u32x4*)(PQ + (size_t)r * 1024 + h * 128 + qpc * 8); kreg[i] = *(const u32x4*)(PK + (size_t)r * 1024 + h * 128 + qpc * 8); }
          if (w < 4) { const int r = ml_row(16 * w + vrow_l, b, dir); vreg = *(const u32x4*)(PV + (size_t)r * 2048 + h * 256 + sl * 32 + vpc * 8); }
          bc = SCN[lane]; a = SCN[8448 + lane]; pm = SCN[2 * 8448 + lane]; }
        for (int c = 0; c < 132; ++c) {
            const float total = __uint_as_float((unsigned)__builtin_amdgcn_readlane((int)__float_as_uint(bc), 63)), pmall = __uint_as_float((unsigned)__builtin_amdgcn_readlane((int)__float_as_uint(pm), 63));
            const float mx = fmaxf(m, pm);
            const float mrow = bc + mx;
            const float winter = __expf(m - mx);
            const float m_new = total + fmaxf(m, pmall);
            const float decay = __expf(total + m - m_new);
            const float kscale = __expf(total + a - m_new);
            const float mref = fmaxf(m, pmall);
            const float ea_cur = __expf(a - mref), em_cur = __expf(mref - mx), emr_cur = __expf(-mrow);
#pragma unroll
            for (int i = 0; i < 2; ++i) { const int sr = 8 * w + 4 * i + qrow_l;
                *(LAS u32x4*)(lds + ML_QS + sr * 272 + qpc * 16) = qreg[i];
                *(LAS u32x4*)(lds + ML_KS + sr * 272 + qpc * 16) = kreg[i]; }
            if (w < 4) { const unsigned vw[4] = {vreg.x, vreg.y, vreg.z, vreg.w}; const int sv = 16 * w + vrow_l;
#pragma unroll
                for (int j = 0; j < 4; ++j) { const int e = vpc * 8 + 2 * j;
                    *(LAS bf16_t*)(lds + ML_VT + e * 144 + sv * 2) = (bf16_t)(vw[j] & 0xffffu);
                    *(LAS bf16_t*)(lds + ML_VT + (e + 1) * 144 + sv * 2) = (bf16_t)(vw[j] >> 16); } }
            if (w == 1) *(LAS float*)(lds + ML_SS + 256 + lane * 4) = kscale;
            if (c + 1 < 132) { const int p0 = (c + 1) * 64;
#pragma unroll
                for (int i = 0; i < 2; ++i) { const int r = ml_row(p0 + 8 * w + 4 * i + qrow_l, b, dir);
                    qreg[i] = *(const u32x4*)(PQ + (size_t)r * 1024 + h * 128 + qpc * 8); kreg[i] = *(const u32x4*)(PK + (size_t)r * 1024 + h * 128 + qpc * 8); }
                if (w < 4) { const int r = ml_row(p0 + 16 * w + vrow_l, b, dir); vreg = *(const u32x4*)(PV + (size_t)r * 2048 + h * 256 + sl * 32 + vpc * 8); }
                bc = SCN[p0 + lane]; a = SCN[8448 + p0 + lane]; pm = SCN[2 * 8448 + p0 + lane]; }
            if (w == 0) *(LAS float*)(lds + ML_SS + lane * 4) = ea_cur;
            LDS_BARRIER();
            {
                const int tr = w >> 1, part = w & 1;
                const LAS unsigned char* CTc = lds + ML_CT + (c & 1) * ML_CTSZ;
                bf16x8 aq[4];
#pragma unroll
                for (int ks = 0; ks < 4; ++ks) aq[ks] = *(const LAS bf16x8*)(lds + ML_QS + (16 * tr + c16) * 272 + (ks * 32 + 8 * q4) * 2);
                float wi_t[4], emr_t[4];
#pragma unroll
                for (int r = 0; r < 4; ++r) { const int t = 16 * tr + 4 * q4 + r; wi_t[r] = __shfl(winter, t); emr_t[r] = __shfl(emr_cur, t); }
                f32x4 accA = {0.f, 0.f, 0.f, 0.f}, accD = {0.f, 0.f, 0.f, 0.f};
#pragma unroll
                for (int ks = 0; ks < 4; ++ks) {
                    const bf16x8 b1 = *(const LAS bf16x8*)(CTc + (16 * part + c16) * 272 + (ks * 32 + 8 * q4) * 2);
                    const bf16x8 b2 = *(const LAS bf16x8*)(CTc + (32 + c16) * 272 + (ks * 32 + 8 * q4) * 2);
                    accA = mfma16(aq[ks], b1, accA); accD = mfma16(aq[ks], b2, accD); }
#pragma unroll
                for (int r = 0; r < 4; ++r) { accA[r] *= wi_t[r]; accD[r] *= wi_t[r]; }
                const int tq = 16 * tr + c16;
                const float emq = __shfl(em_cur, tq);
#pragma unroll
                for (int kk = 0; kk < 2; ++kk) {
                    if (2 * kk <= tr) {
                        f32x4 s0 = {0.f, 0.f, 0.f, 0.f}, s1 = {0.f, 0.f, 0.f, 0.f};
#pragma unroll
                        for (int ks = 0; ks < 4; ++ks) { const bf16x8 ka = *(const LAS bf16x8*)(lds + ML_KS + (32 * kk + c16) * 272 + (ks * 32 + 8 * q4) * 2); s0 = mfma16(ka, aq[ks], s0); }
                        if (2 * kk + 1 <= tr) {
#pragma unroll
                            for (int ks = 0; ks < 4; ++ks) { const bf16x8 ka = *(const LAS bf16x8*)(lds + ML_KS + (32 * kk + 16 + c16) * 272 + (ks * 32 + 8 * q4) * 2); s1 = mfma16(ka, aq[ks], s1); }
                        }
                        const f32x4 a0 = *(const LAS f32x4*)(lds + ML_SS + (32 * kk + 4 * q4) * 4), a1 = *(const LAS f32x4*)(lds + ML_SS + (32 * kk + 16 + 4 * q4) * 4);
                        float pe[8];
#pragma unroll
                        for (int r = 0; r < 4; ++r) { const int sp0 = 32 * kk + 4 * q4 + r, sp1 = sp0 + 16;
                            pe[r] = (sp0 <= tq) ? s0[r] * (a0[r] * emq) : 0.f; pe[4 + r] = (sp1 <= tq) ? s1[r] * (a1[r] * emq) : 0.f; }
                        u32x4 pw; pw.x = pk2(pe[0], pe[1]); pw.y = pk2(pe[2], pe[3]); pw.z = pk2(pe[4], pe[5]); pw.w = pk2(pe[6], pe[7]);
                        const bf16x8 pf = __builtin_bit_cast(bf16x8, pw);
                        const u32x2 v1l = *(const LAS u32x2*)(lds + ML_VT + (16 * part + c16) * 144 + (32 * kk + 4 * q4) * 2), v1h = *(const LAS u32x2*)(lds + ML_VT + (16 * part + c16) * 144 + (32 * kk + 16 + 4 * q4) * 2);
                        const u32x2 v2l = *(const LAS u32x2*)(lds + ML_VT + (32 + c16) * 144 + (32 * kk + 4 * q4) * 2), v2h = *(const LAS u32x2*)(lds + ML_VT + (32 + c16) * 144 + (32 * kk + 16 + 4 * q4) * 2);
                        u32x4 bw1, bw2; bw1.x = v1l.x; bw1.y = v1l.y; bw1.z = v1h.x; bw1.w = v1h.y; bw2.x = v2l.x; bw2.y = v2l.y; bw2.z = v2h.x; bw2.w = v2h.y;
                        accA = mfma16(pf, __builtin_bit_cast(bf16x8, bw1), accA); accD = mfma16(pf, __builtin_bit_cast(bf16x8, bw2), accD);
                    }
                }
                if (l == 0 || c >= 4) {
                    const int hrow0 = ml_row(c * 64, b, dir), hsgn = dir ? -1 : 1;
#pragma unroll
                    for (int r = 0; r < 4; ++r) {
                        const float den = __shfl(accD[r], lane & 48);
                        const float hv = accA[r] * __builtin_amdgcn_rcpf(fmaxf(fabsf(den), emr_t[r]));
                        const int t = 16 * tr + 4 * q4 + r; const int row = hrow0 + hsgn * t;
                        H[(size_t)row * 2048 + h * 256 + sl * 32 + 16 * part + c16] = f2bf(hv);
                    }
                }
            }
            {
                LAS unsigned char* CTn = lds + ML_CT + ((c + 1) & 1) * ML_CTSZ;
                bf16x8 ak[2];
#pragma unroll
                for (int k2 = 0; k2 < 2; ++k2) {
                    const f32x4 sc0 = *(const LAS f32x4*)(lds + ML_SS + 256 + (k2 * 32 + 8 * q4) * 4), sc1 = *(const LAS f32x4*)(lds + ML_SS + 256 + (k2 * 32 + 8 * q4 + 4) * 4);
                    const s16x4 t0 = __builtin_amdgcn_ds_read_tr16_b64_v4i16((LAS s16x4*)(lds + ML_KS + (k2 * 32 + 8 * q4 + (c16 >> 2)) * 272 + (16 * w + 4 * (c16 & 3)) * 2));
                    const s16x4 t1 = __builtin_amdgcn_ds_read_tr16_b64_v4i16((LAS s16x4*)(lds + ML_KS + (k2 * 32 + 8 * q4 + 4 + (c16 >> 2)) * 272 + (16 * w + 4 * (c16 & 3)) * 2));
                    const u32x2 u0 = __builtin_bit_cast(u32x2, t0), u1 = __builtin_bit_cast(u32x2, t1);
                    u32x4 kw; kw.x = pk2(bflo(u0.x) * sc0[0], bfhi(u0.x) * sc0[1]); kw.y = pk2(bflo(u0.y) * sc0[2], bfhi(u0.y) * sc0[3]);
                    kw.z = pk2(bflo(u1.x) * sc1[0], bfhi(u1.x) * sc1[1]); kw.w = pk2(bflo(u1.y) * sc1[2], bfhi(u1.y) * sc1[3]);
                    ak[k2] = __builtin_bit_cast(bf16x8, kw);
                }
#pragma unroll
                for (int ct = 0; ct < 3; ++ct) {
                    Cst[ct] = Cst[ct] * decay;
#pragma unroll
                    for (int k2 = 0; k2 < 2; ++k2) { const bf16x8 bv = *(const LAS bf16x8*)(lds + ML_VT + (16 * ct + c16) * 144 + (k2 * 32 + 8 * q4) * 2); Cst[ct] = mfma16(ak[k2], bv, Cst[ct]); }
                    u32x2 o; o.x = pk2(Cst[ct][0], Cst[ct][1]); o.y = pk2(Cst[ct][2], Cst[ct][3]);
                    *(LAS u32x2*)(CTn + (16 * ct + c16) * 272 + (16 * w + 4 * q4) * 2) = o;
                }
            }
            m = m_new;
            LDS_BARRIER();
        }
    }
}

constexpr int AT_KS = 0, AT_VS = 17408, AT_RPB = 35840;
__device__ __forceinline__ void phase_attn(KP p, int l, LAS unsigned char* lds, int wid0) {
    const int tid = tid_fresh(wid0), lane = tid & 63, w = __builtin_amdgcn_readfirstlane(tid >> 6), q4 = lane >> 4, c16 = lane & 15;
    unsigned char* ws = launder(p->ws);
    bf16_t* CQ = (bf16_t*)(ws + WS_CQ); const bf16_t* CK = (const bf16_t*)(ws + WS_CK); const bf16_t* CV = (const bf16_t*)(ws + WS_CV);
    const int nunits = 2048 + (l == 0 ? 64 : 0);
    for (int u = blockIdx.x; u < nunits; u += gridDim.x) {
        int b, h, qrow = 0, g = 0, ntl = 0, r0a = 0, qbase;  bool is_ctx = u >= 2048;
        if (!is_ctx) { b = u >> 10; h = (u >> 6) & 15; const int rp = u & 63; qrow = 2 * rp + (w >> 2); g = w & 3;
            r0a = min(max(2 * rp - 4, 0), 120); const int r0b = min(max(2 * rp + 1 - 4, 0), 120); ntl = r0b + 8 - r0a;
            qbase = b * 8192 + qrow * 64 + 16 * g; }
        else { const int uu = u - 2048; b = uu >> 5; h = (uu >> 1) & 15; qbase = NLAT + b * 256 + (uu & 1) * 128 + 16 * w; }
        const int r0q = min(max(qrow - 4, 0), 120);
        const int a_g = (g == 0) ? 0 : (g == 1 ? 8 : (g == 2 ? 24 : 32));
        __syncthreads();
        if (!is_ctx) for (int i = tid; i < 465; i += NTHREADS) *(LAS float*)(lds + AT_RPB + i * 4) = p->c_rpb[((size_t)l * 16 + h) * 465 + i];
        bf16x8 qf[4];
#pragma unroll
        for (int ks = 0; ks < 4; ++ks) qf[ks] = *(const bf16x8*)(CQ + (size_t)(qbase + c16) * 2048 + h * 128 + ks * 32 + 8 * q4);
        f32x4 O[8];
#pragma unroll
        for (int i = 0; i < 8; ++i) O[i] = (f32x4){0.f, 0.f, 0.f, 0.f};
        float m_run = -1e30f, l_run = 0.f;
        const int ntiles = ntl + 4;
        u32x4 kreg[2], vreg[2];
        auto tile_row = [&](int t, int key) -> int { return (t < ntl) ? (b * 8192 + (r0a + t) * 64 + key) : (NLAT + b * 256 + (t - ntl) * 64 + key); };
        const int krow_l = lane >> 4, kpc = lane & 15;
        {
#pragma unroll
          for (int i = 0; i < 2; ++i) { const int r = tile_row(0, 8 * w + 4 * i + krow_l); kreg[i] = *(const u32x4*)(CK + (size_t)r * 2048 + h * 128 + kpc * 8); vreg[i] = *(const u32x4*)(CV + (size_t)r * 2048 + h * 128 + kpc * 8); } }
        for (int t = 0; t < ntiles; ++t) {
            LDS_BARRIER();
#pragma unroll
            for (int i = 0; i < 2; ++i) { const int key = 8 * w + 4 * i + krow_l;
                *(LAS u32x4*)(lds + AT_KS + key * 272 + kpc * 16) = kreg[i];
                *(LAS u32x4*)(lds + AT_VS + key * 288 + kpc * 16) = vreg[i]; }
            if (t + 1 < ntiles) {
#pragma unroll
                for (int i = 0; i < 2; ++i) { const int r = tile_row(t + 1, 8 * w + 4 * i + krow_l); kreg[i] = *(const u32x4*)(CK + (size_t)r * 2048 + h * 128 + kpc * 8); vreg[i] = *(const u32x4*)(CV + (size_t)r * 2048 + h * 128 + kpc * 8); } }
            LDS_BARRIER();
            const bool local = t < ntl; const int kr = r0a + t;
            if (local && !(kr >= r0q && kr < r0q + 8)) continue;
            const int npass = local ? 1 : 2;
            for (int ps = 0; ps < npass; ++ps) {
                const int a0 = local ? a_g : ps * 32;
                f32x4 sc[2];
#pragma unroll
                for (int ct = 0; ct < 2; ++ct) { sc[ct] = (f32x4){0.f, 0.f, 0.f, 0.f};
#pragma unroll
                    for (int ks = 0; ks < 4; ++ks) { const bf16x8 ka = *(const LAS bf16x8*)(lds + AT_KS + (a0 + 16 * ct + c16) * 272 + (ks * 32 + 8 * q4) * 2); sc[ct] = mfma16(ka, qf[ks], sc[ct]); } }
                if (local) {
                    const int qc = 16 * g + c16, col0 = min(max(qc - 8, 0), 48); const int dr = kr - qrow + 7;
#pragma unroll
                    for (int ct = 0; ct < 2; ++ct)
#pragma unroll
                        for (int r = 0; r < 4; ++r) { const int kc = a0 + 16 * ct + 4 * q4 + r; const bool valid = (kc >= col0) && (kc < col0 + 16);
                            const int dc = min(max(kc - qc + 15, 0), 30);
                            const float bias = *(const LAS float*)(lds + AT_RPB + (dr * 31 + dc) * 4);
                            sc[ct][r] = valid ? sc[ct][r] + bias : -1e30f; }
                }
                float mx = fmaxf(fmaxf(fmaxf(sc[0][0], sc[0][1]), fmaxf(sc[0][2], sc[0][3])), fmaxf(fmaxf(sc[1][0], sc[1][1]), fmaxf(sc[1][2], sc[1][3])));
                mx = fmaxf(mx, __shfl_xor(mx, 16)); mx = fmaxf(mx, __shfl_xor(mx, 32));
                const float m_new = fmaxf(m_run, mx);
                const float alpha = __expf(m_run - m_new);
                float pe[8]; float psum = 0.f;
#pragma unroll
                for (int ct = 0; ct < 2; ++ct)
#pragma unroll
                    for (int r = 0; r < 4; ++r) { const float e = __expf(sc[ct][r] - m_new); pe[ct * 4 + r] = e; psum += e; }
                psum += __shfl_xor(psum, 16); psum += __shfl_xor(psum, 32);
                l_run = l_run * alpha + psum; m_run = m_new;
                bf16x8 pf; { u32x4 pw; pw.x = pk2(pe[0], pe[1]); pw.y = pk2(pe[2], pe[3]); pw.z = pk2(pe[4], pe[5]); pw.w = pk2(pe[6], pe[7]); pf = __builtin_bit_cast(bf16x8, pw); }
                float al[4];
#pragma unroll
                for (int r = 0; r < 4; ++r) al[r] = __shfl(alpha, 4 * q4 + r);
#pragma unroll
                for (int dt = 0; dt < 8; ++dt) {
#pragma unroll
                    for (int r = 0; r < 4; ++r) O[dt][r] *= al[r];
                    const s16x4 lo = __builtin_amdgcn_ds_read_tr16_b64_v4i16((LAS s16x4*)(lds + AT_VS + (a0 + 4 * q4 + (c16 >> 2)) * 288 + (16 * dt + 4 * (c16 & 3)) * 2));
                    const s16x4 hi = __builtin_amdgcn_ds_read_tr16_b64_v4i16((LAS s16x4*)(lds + AT_VS + (a0 + 16 + 4 * q4 + (c16 >> 2)) * 288 + (16 * dt + 4 * (c16 & 3)) * 2));
                    const bf16x8 bw = __builtin_shufflevector(lo, hi, 0, 1, 2, 3, 4, 5, 6, 7);
                    O[dt] = mfma16(pf, bw, O[dt]);
                }
            }
        }
        float linv[4];
#pragma unroll
        for (int r = 0; r < 4; ++r) linv[r] = 1.0f / __shfl(l_run, 4 * q4 + r);
#pragma unroll
        for (int dt = 0; dt < 8; ++dt)
#pragma unroll
            for (int r = 0; r < 4; ++r) CQ[(size_t)(qbase + 4 * q4 + r) * 2048 + h * 128 + 16 * dt + c16] = f2bf(O[dt][r] * linv[r]);
    }
}

__device__ __forceinline__ void phase_e2(KP p, int l, int nrows, int wid0) {
    const int tid = tid_fresh(wid0); const int lane = tid & 63, gw = blockIdx.x * 8 + (tid >> 6), nw = gridDim.x * 8;
    unsigned char* ws = launder(p->ws);
    const bf16_t* HF = (const bf16_t*)(ws + WS_BC); const bf16_t* HB = (const bf16_t*)(ws + WS_BX); bf16_t* PO = (bf16_t*)(ws + WS_PO);
    const float* hg = p->a_hnorm_g + (size_t)l * 2048;
    for (int row = gw; row < nrows; row += nw) {
        u32x2 fv[8], bv[8], ovv[8];
#pragma unroll
        for (int h = 0; h < 8; ++h) { const size_t o = (size_t)row * 2048 + h * 256 + lane * 4; fv[h] = *(const u32x2*)(HF + o); bv[h] = *(const u32x2*)(HB + o); ovv[h] = *(const u32x2*)(PO + o); }
#pragma unroll
        for (int h = 0; h < 8; ++h) {
            const size_t o = (size_t)row * 2048 + h * 256 + lane * 4;
            const u32x2 f = fv[h], bb = bv[h], ov = ovv[h];
            float v[4] = {bflo(f.x) + bflo(bb.x), bfhi(f.x) + bfhi(bb.x), bflo(f.y) + bflo(bb.y), bfhi(f.y) + bfhi(bb.y)};
            float ss = v[0] * v[0] + v[1] * v[1] + v[2] * v[2] + v[3] * v[3];
            ss = wave_sum(ss);
            const float rstd = rsqrtf(ss * (1.0f / 256.0f) + EPSF);
            const f32x4 gg = *(const f32x4*)(hg + h * 256 + lane * 4);
            const float og[4] = {bflo(ov.x), bfhi(ov.x), bflo(ov.y), bfhi(ov.y)};
            float y[4];
#pragma unroll
            for (int j = 0; j < 4; ++j) y[j] = sigmoidf_(og[j]) * v[j] * rstd * gg[j];
            u32x2 wv; wv.x = pk2(y[0], y[1]); wv.y = pk2(y[2], y[3]); *(u32x2*)(PO + o) = wv;
        }
    }
}

template <int MODE>
__device__ __forceinline__ void ctx_gemm(KP p, int l, LAS unsigned char* lds, int wid0) {
    const int tid = tid_fresh(wid0); const int lane = tid & 63, w = __builtin_amdgcn_readfirstlane(tid >> 6), q4 = lane >> 4, c16 = lane & 15;
    unsigned char* ws = launder(p->ws);
    for (int task = blockIdx.x; task < (NCTX / 64) * 32; task += gridDim.x) {
        const int rg = task >> 5, cb = task & 31; const int row0 = NLAT + rg * 64, col0 = cb * 64;
        const int orow = row0 + (tid >> 3), ocol = col0 + (tid & 7) * 8;
        float yv[8];
#pragma unroll
        for (int i = 0; i < 8; ++i) yv[i] = 0.f;
#pragma unroll 1
        for (int br = 0; br < (MODE == 0 ? 3 : 1); ++br) {
            const bf16_t* A; const bf16_t* Bt;
            if (MODE == 0) { const int ti = 1 + 4 * (br == 1) + (br == 2); A = (const bf16_t*)(ws + WS_T8 + (size_t)ti * SZ_A); Bt = (const bf16_t*)(ws + WS_WA + (size_t)br * SZ_W); }
            else if (MODE == 1) { A = (const bf16_t*)(ws + WS_Y); Bt = (const bf16_t*)(ws + WS_WO); }
            else { A = (const bf16_t*)(ws + WS_XN); Bt = (const bf16_t*)(ws + WS_WQ); }
            const bf16_t* ap = A + (size_t)(row0 + c16) * 2048 + w * 256 + 8 * q4; const bf16_t* bp = Bt + (size_t)(col0 + c16) * 2048 + w * 256 + 8 * q4;
            f32x4 acc[4][4];
#pragma unroll
            for (int mi = 0; mi < 4; ++mi)
#pragma unroll
                for (int j = 0; j < 4; ++j) acc[mi][j] = (f32x4){0.f, 0.f, 0.f, 0.f};
#pragma unroll 2
            for (int ks = 0; ks < 8; ++ks) {
                bf16x8 a[4], bb[4];
#pragma unroll
                for (int mi = 0; mi < 4; ++mi) a[mi] = *(const bf16x8*)(ap + (size_t)mi * 16 * 2048 + ks * 32);
#pragma unroll
                for (int j = 0; j < 4; ++j) bb[j] = *(const bf16x8*)(bp + (size_t)j * 16 * 2048 + ks * 32);
#pragma unroll
                for (int mi = 0; mi < 4; ++mi)
#pragma unroll
                    for (int j = 0; j < 4; ++j) acc[mi][j] = mfma16(a[mi], bb[j], acc[mi][j]);
            }
            __syncthreads();
#pragma unroll
            for (int mi = 0; mi < 4; ++mi)
#pragma unroll
                for (int j = 0; j < 4; ++j)
#pragma unroll
                    for (int r = 0; r < 4; ++r) *(LAS float*)(lds + ((w * 64 + 16 * mi + 4 * q4 + r) * 64 + 16 * j + c16) * 4) = acc[mi][j][r];
            __syncthreads();
            float sv[8];
#pragma unroll
            for (int i = 0; i < 8; ++i) sv[i] = 0.f;
#pragma unroll
            for (int ww = 0; ww < 8; ++ww) { const f32x4 p0 = *(const LAS f32x4*)(lds + ((ww * 64 + (tid >> 3)) * 64 + (tid & 7) * 8) * 4), p1 = *(const LAS f32x4*)(lds + ((ww * 64 + (tid >> 3)) * 64 + (tid & 7) * 8 + 4) * 4);
                sv[0] += p0[0]; sv[1] += p0[1]; sv[2] += p0[2]; sv[3] += p0[3]; sv[4] += p1[0]; sv[5] += p1[1]; sv[6] += p1[2]; sv[7] += p1[3]; }
            if (MODE == 0) { const u32x4 g = *(const u32x4*)((const bf16_t*)(ws + WS_GT) + (size_t)orow * 6144 + (size_t)br * 2048 + ocol);
                yv[0] += sigmoidf_(bflo(g.x)) * sv[0]; yv[1] += sigmoidf_(bfhi(g.x)) * sv[1]; yv[2] += sigmoidf_(bflo(g.y)) * sv[2]; yv[3] += sigmoidf_(bfhi(g.y)) * sv[3];
                yv[4] += sigmoidf_(bflo(g.z)) * sv[4]; yv[5] += sigmoidf_(bfhi(g.z)) * sv[5]; yv[6] += sigmoidf_(bflo(g.w)) * sv[6]; yv[7] += sigmoidf_(bfhi(g.w)) * sv[7]; }
            else {
#pragma unroll
                for (int i = 0; i < 8; ++i) yv[i] = sv[i]; }
        }
        if (MODE == 1) { float* xp = (float*)(ws + WS_X) + (size_t)orow * 2048 + ocol; const float* xi = p->ctx + (size_t)(orow - NLAT) * 2048 + ocol; const float* mg = (const float*)(ws + WS_MOD) + (size_t)l * 3 * 12288 + 2 * 12288 + 2 * 2048 + ocol;
            const f32x4 x0 = *(const f32x4*)xi, x1 = *(const f32x4*)(xi + 4), g0 = *(const f32x4*)mg, g1 = *(const f32x4*)(mg + 4);
            f32x4 o0, o1; o0[0] = x0[0] + g0[0] * yv[0]; o0[1] = x0[1] + g0[1] * yv[1]; o0[2] = x0[2] + g0[2] * yv[2]; o0[3] = x0[3] + g0[3] * yv[3];
            o1[0] = x1[0] + g1[0] * yv[4]; o1[1] = x1[1] + g1[1] * yv[5]; o1[2] = x1[2] + g1[2] * yv[6]; o1[3] = x1[3] + g1[3] * yv[7];
            *(f32x4*)xp = o0; *(f32x4*)(xp + 4) = o1; }
        else { u32x4 ov; ov.x = pk2(yv[0], yv[1]); ov.y = pk2(yv[2], yv[3]); ov.z = pk2(yv[4], yv[5]); ov.w = pk2(yv[6], yv[7]);
            *(u32x4*)((bf16_t*)(ws + (MODE == 0 ? WS_Y : WS_PV)) + (size_t)orow * 2048 + ocol) = ov; }
    }
}

constexpr int PE_MAXT = 80;
constexpr int PE_IDX = 0, PE_W = PE_MAXT * 128 * 4, PE_SCR = 2 * PE_MAXT * 128 * 4, PE_SCRSZ = 16 * 132 * 4 + 4096 + 256;
__device__ __forceinline__ unsigned ordkey(float v) { const unsigned u = __float_as_uint(v); return (u & 0x80000000u) ? ~u : (u | 0x80000000u); }
__device__ __forceinline__ void phase_peer(KP p, int l, LAS unsigned char* lds, int wid0) {
    const int tid = tid_fresh(wid0), lane = tid & 63, w = __builtin_amdgcn_readfirstlane(tid >> 6), q4 = lane >> 4, c16 = lane & 15;
    unsigned char* ws = launder(p->ws);
    const bf16_t* QP = (const bf16_t*)(ws + WS_PV); const bf16_t* KEYS = (const bf16_t*)(ws + WS_KEYS);
    const bf16_t* XN = (const bf16_t*)(ws + WS_XN);
    float* X = (float*)(ws + WS_X); const float* mod = (const float*)(ws + WS_MOD) + (size_t)l * 3 * 12288;
    const int ntok = (l == 0) ? MR : NLAT, G = gridDim.x;
    const int per = (ntok + G - 1) / G; const int t_begin = blockIdx.x * per, t_end = min(ntok, t_begin + per);
    for (int tb = t_begin; tb < t_end; tb += PE_MAXT) {
        const int nt = min(PE_MAXT, t_end - tb);
        __syncthreads();
        const int ntask = (nt + 15) >> 4;
        if (w < ntask) {
            int lane_pe1 = lane; asm volatile("" : "+v"(lane_pe1));
            const int lane = lane_pe1, q4 = lane >> 4, c16 = lane & 15;
            LAS unsigned char* scr = lds + PE_SCR + w * PE_SCRSZ;
            LAS float* SC = (LAS float*)scr;
            LAS float* LS = (LAS float*)(scr + 16 * 132 * 4);
            LAS int* LI = (LAS int*)(scr + 16 * 132 * 4 + 2048);
            LAS unsigned char* PT = scr + 16 * 132 * 4 + 4096;
            if (lane < 52) {
                const int L = lane;
                const int ge16 = L >= 16, ge24 = L >= 24, ge29 = L >= 29, ge33 = L >= 33, ge36 = L >= 36, ge38 = L >= 38, ge40 = L >= 40, ge42 = L >= 42;
                int pa = ge16 + ge24 + ge29 + ge33 + ge36 + ge38 + ge40 + ge42; if (ge42) pa = 8 + (L - 42);
                int pb = L - (16 * ge16 + 8 * ge24 + 5 * ge29 + 4 * ge33 + 3 * ge36 + 2 * ge38 + 2 * ge40 + 2 * ge42); if (ge42) pb = 0;
                if (L >= 50) { pa = 15; pb = 15; }
                PT[lane * 2] = (unsigned char)pa; PT[lane * 2 + 1] = (unsigned char)pb;
            }
            const int tok_a = min(tb + 16 * w + c16, t_end - 1);
            const int tkl = lane >> 2, qq = lane & 3;
            for (int h = 0; h < 8; ++h) {
                for (int pp = 0; pp < 2; ++pp) {
                    const int hp = 2 * h + pp;
                    bf16x8 af[4];
#pragma unroll
                    for (int ks = 0; ks < 4; ++ks) af[ks] = *(const bf16x8*)(QP + (size_t)tok_a * 2048 + h * 256 + pp * 128 + ks * 32 + 8 * q4);
#pragma unroll 2
                    for (int ct = 0; ct < 8; ++ct) {
                        f32x4 acc = {0.f, 0.f, 0.f, 0.f};
#pragma unroll
                        for (int ks = 0; ks < 4; ++ks) { const bf16x8 bfr = *(const bf16x8*)(KEYS + ((size_t)hp * 128 + 16 * ct + c16) * 128 + ks * 32 + 8 * q4); acc = mfma16(af[ks], bfr, acc); }
#pragma unroll
                        for (int r = 0; r < 4; ++r) SC[(4 * q4 + r) * 132 + 16 * ct + c16] = acc[r];
                    }
                    asm volatile("s_waitcnt lgkmcnt(0)" ::: "memory");
                    unsigned key[32];
#pragma unroll
                    for (int i = 0; i < 8; ++i) { const f32x4 v = *(const LAS f32x4*)(SC + tkl * 132 + 32 * qq + 4 * i);
#pragma unroll
                        for (int j = 0; j < 4; ++j) key[4 * i + j] = (ordkey(v[j]) & ~127u) | (unsigned)(32 * qq + 4 * i + j); }
                    unsigned prev = 0xffffffffu;
#pragma unroll 1
                    for (int r = 0; r < 16; ++r) {
                        unsigned mxk = 0u;
#pragma unroll
                        for (int i = 0; i < 32; ++i) { const unsigned k = key[i] < prev ? key[i] : 0u; mxk = mxk > k ? mxk : k; }
                        unsigned o1 = __shfl_xor(mxk, 1); mxk = mxk > o1 ? mxk : o1; o1 = __shfl_xor(mxk, 2); mxk = mxk > o1 ? mxk : o1;
                        prev = mxk;
                        if (qq == (r & 3)) { const int idx = (int)(mxk & 127u); LS[(pp * 16 + tkl) * 16 + r] = SC[tkl * 132 + idx]; LI[(pp * 16 + tkl) * 16 + r] = idx; }
                    }
                    asm volatile("s_waitcnt lgkmcnt(0)" ::: "memory");
                }
                unsigned ck[13];
#pragma unroll
                for (int i = 0; i < 13; ++i) { const int cidx = qq + 4 * i;
                    if (cidx < 50) { const int a = PT[cidx * 2], bq = PT[cidx * 2 + 1]; const float sv = LS[(0 * 16 + tkl) * 16 + a] + LS[(1 * 16 + tkl) * 16 + bq]; ck[i] = (ordkey(sv) & ~63u) | (unsigned)cidx; }
                    else ck[i] = 0u; }
                unsigned prev = 0xffffffffu; float best0 = 0.f, esum = 0.f; float myexp[4] = {0.f, 0.f, 0.f, 0.f}; int myidx[4] = {0, 0, 0, 0};
#pragma unroll
                for (int r = 0; r < 16; ++r) {
                    unsigned mxk = 0u;
#pragma unroll
                    for (int i = 0; i < 13; ++i) { const unsigned k = ck[i] < prev ? ck[i] : 0u; mxk = mxk > k ? mxk : k; }
                    unsigned o1 = __shfl_xor(mxk, 1); mxk = mxk > o1 ? mxk : o1; o1 = __shfl_xor(mxk, 2); mxk = mxk > o1 ? mxk : o1;
                    prev = mxk;
                    const int cidx = (int)(mxk & 63u); const int a = PT[cidx * 2], bq = PT[cidx * 2 + 1];
                    const float best = LS[(0 * 16 + tkl) * 16 + a] + LS[(1 * 16 + tkl) * 16 + bq];
                    const int eidx = LI[(0 * 16 + tkl) * 16 + a] * 128 + LI[(1 * 16 + tkl) * 16 + bq];
                    if (r == 0) best0 = best;
                    const float e = __expf(best - best0); esum += e;
                    if (qq == (r & 3)) { myexp[r >> 2] = e; myidx[r >> 2] = eidx; }
                }
                const float inv = 1.0f / esum; const int tl = 16 * w + tkl;
                if (tl < nt) {
#pragma unroll
                    for (int i = 0; i < 4; ++i) { const int r = 4 * i + qq;
                        *(LAS int*)(lds + PE_IDX + (tl * 128 + h * 16 + r) * 4) = myidx[i];
                        *(LAS float*)(lds + PE_W + (tl * 128 + h * 16 + r) * 4) = myexp[i] * inv; }
                }
                asm volatile("s_waitcnt lgkmcnt(0)" ::: "memory");
            }
        }
        __syncthreads();
        int lane_pe2 = lane; asm volatile("" : "+v"(lane_pe2));
        const int nfull = nt & ~7, nleft = nt - nfull;
        const int S = (nleft == 1 || nleft == 2 || nleft == 4) ? 8 / nleft : 1;
        const int nrounds = (nfull >> 3) + (nleft ? 1 : 0);
        for (int rd = 0; rd < nrounds; ++rd) {
            const int lane = lane_pe2;
            const bool split = (rd == (nfull >> 3)) && S > 1;
            const int tl = split ? nfull + w / S : rd * 8 + w;
            const int NB = split ? 64 / S : 64, B0 = split ? (w % S) * NB : 0;
            const bool active = tl < nt;
            if (active) {
            const int row = tb + tl;
            u32x16 xq;
#pragma unroll
            for (int i = 0; i < 4; ++i) { const u32x4 xw = *(const u32x4*)(XN + (size_t)row * 2048 + lane * 32 + i * 8); xq[4 * i] = xw.x; xq[4 * i + 1] = xw.y; xq[4 * i + 2] = xw.z; xq[4 * i + 3] = xw.w; }
            const LAS int* idxp = (const LAS int*)(lds + PE_IDX + tl * 512);
            LAS float* wp = (LAS float*)(lds + PE_W + tl * 512);
            u32x6 bufA[2], bufB[2], bufC[2], bufD[2];
#define PE_ISSUE(buf, TAB, b) do { const int _e0 = idxp[2 * (b)], _e1 = idxp[2 * (b) + 1]; \
                const unsigned char* _r0 = (TAB) + (size_t)_e0 * 1536 + lane * 24; const unsigned char* _r1 = (TAB) + (size_t)_e1 * 1536 + lane * 24; \
                { const u32x4 _a = *(const u32x4*)_r0; const u32x2 _b = *(const u32x2*)(_r0 + 16); buf[0][0] = _a.x; buf[0][1] = _a.y; buf[0][2] = _a.z; buf[0][3] = _a.w; buf[0][4] = _b.x; buf[0][5] = _b.y; } \
                { const u32x4 _a = *(const u32x4*)_r1; const u32x2 _b = *(const u32x2*)(_r1 + 16); buf[1][0] = _a.x; buf[1][1] = _a.y; buf[1][2] = _a.z; buf[1][3] = _a.w; buf[1][4] = _b.x; buf[1][5] = _b.y; } } while (0)
#define PE_CONS_U(buf, b) do { float _p[2]; \
                _Pragma("unroll") for (int _j = 0; _j < 2; ++_j) { const u32x16 _ub = __builtin_bit_cast(u32x16, __builtin_amdgcn_cvt_scalef32_pk32_bf16_fp6(buf[_j], 1.0f)); float _d = 0.f; \
                    _Pragma("unroll") for (int _q = 0; _q < 16; ++_q) _d = dot2bf(_ub[_q], xq[_q], _d); \
                    _p[_j] = _d * (1.0f / 64.0f); } \
                const bool _h32 = (lane & 32) != 0; \
                float _c = _h32 ? _p[1] : _p[0]; const float _cs = _h32 ? _p[0] : _p[1]; _c += __shfl_xor(_cs, 32); \
                _c += __shfl_xor(_c, 16); _c += __shfl_xor(_c, 8); _c += __shfl_xor(_c, 4); _c += __shfl_xor(_c, 2); _c += __shfl_xor(_c, 1); \
                const int _e = 2 * (b) + (lane >> 5); const float _g = wp[_e]; \
                const float _w = _g * 0.5f * _c * (1.0f + erff(_c * 0.70710678118654752f)); \
                if ((lane & 31) == 0) wp[_e] = _w; } while (0)
#define PE_CONS_V(buf, b) do { const f32x2 _w2 = *(const LAS f32x2*)(wp + 2 * (b)); \
                _Pragma("unroll") for (int _j = 0; _j < 2; ++_j) { const f32x32 _vf = __builtin_amdgcn_cvt_scalef32_pk32_f32_fp6(buf[_j], 1.0f); const float _wv = _w2[_j]; \
                    outv += _vf * _wv; } } while (0)
            const unsigned char* TU = ws + WS_PU; const unsigned char* TV = ws + WS_PVW;
#define PE_ISSUE_UV(buf, i) do { if ((i) < NB) PE_ISSUE(buf, TU, B0 + (i)); else PE_ISSUE(buf, TV, B0 + (i) - NB); } while (0)
#define PE_ISSUE_V(buf, i) do { if ((i) < NB) PE_ISSUE(buf, TV, B0 + (i)); } while (0)
            PE_ISSUE(bufA, TU, B0); PE_ISSUE(bufB, TU, B0 + 1); PE_ISSUE(bufC, TU, B0 + 2);
#pragma unroll 1
            for (int b = 0; b < NB; b += 4) {
                PE_ISSUE_UV(bufD, b + 3); PE_CONS_U(bufA, B0 + b);
                PE_ISSUE_UV(bufA, b + 4); PE_CONS_U(bufB, B0 + b + 1);
                PE_ISSUE_UV(bufB, b + 5); PE_CONS_U(bufC, B0 + b + 2);
                PE_ISSUE_UV(bufC, b + 6); PE_CONS_U(bufD, B0 + b + 3);
            }
            asm volatile("s_waitcnt lgkmcnt(0)" ::: "memory");
            f32x32 outv = 0.f;
#pragma unroll 1
            for (int b = 0; b < NB; b += 4) {
                PE_ISSUE_V(bufD, b + 3); PE_CONS_V(bufA, B0 + b);
                PE_ISSUE_V(bufA, b + 4); PE_CONS_V(bufB, B0 + b + 1);
                PE_ISSUE_V(bufB, b + 5); PE_CONS_V(bufC, B0 + b + 2);
                PE_ISSUE_V(bufC, b + 6); PE_CONS_V(bufD, B0 + b + 3);
            }
#undef PE_ISSUE_UV
#undef PE_ISSUE_V
#undef PE_ISSUE
#undef PE_CONS_U
#undef PE_CONS_V
            if (split) {
                LAS float* pp = (LAS float*)(lds + PE_SCR) + ((size_t)((tl - nfull) * S + (w % S)) * 64 + lane) * 32;
#pragma unroll
                for (int i = 0; i < 8; ++i) { f32x4 t4; t4[0] = outv[4 * i]; t4[1] = outv[4 * i + 1]; t4[2] = outv[4 * i + 2]; t4[3] = outv[4 * i + 3]; *(LAS f32x4*)(pp + 4 * i) = t4; }
            }
            if (!split) {
            const int which = row < NLAT ? (row >> 13) : 2;
            const float* mg = mod + (size_t)which * 12288 + 5 * 2048;
            float* xrow = X + (size_t)row * 2048; float* orow = (l == 1) ? (p->out + (size_t)row * 2048) : xrow;
            f32x4 xvv[8], gvv[8];
#pragma unroll
            for (int hh = 0; hh < 8; ++hh) { const int c = lane * 32 + hh * 4; xvv[hh] = *(const f32x4*)(xrow + c); gvv[hh] = *(const f32x4*)(mg + c); }
#pragma unroll
            for (int hh = 0; hh < 8; ++hh) { const int c = lane * 32 + hh * 4;
                const f32x4 xv = xvv[hh], gv = gvv[hh];
                f32x4 ov; ov[0] = xv[0] + gv[0] * outv[hh * 4 + 0] * 0.25f; ov[1] = xv[1] + gv[1] * outv[hh * 4 + 1] * 0.25f; ov[2] = xv[2] + gv[2] * outv[hh * 4 + 2] * 0.25f; ov[3] = xv[3] + gv[3] * outv[hh * 4 + 3] * 0.25f;
                *(f32x4*)(orow + c) = ov; }
            }
            }
            if (split) {
                __syncthreads();
                if ((w % S) == 0 && tl < nt) {
                    const int row = tb + tl;
                    const int which = row < NLAT ? (row >> 13) : 2;
                    const float* mg = mod + (size_t)which * 12288 + 5 * 2048;
                    float* xrow = X + (size_t)row * 2048; float* orow = (l == 1) ? (p->out + (size_t)row * 2048) : xrow;
                    const LAS float* pp = (const LAS float*)(lds + PE_SCR) + ((size_t)((tl - nfull) * S) * 64 + lane) * 32;
#pragma unroll
                    for (int hh = 0; hh < 8; ++hh) { const int c = lane * 32 + hh * 4;
                        f32x4 acc4 = *(const LAS f32x4*)(pp + hh * 4);
                        for (int q = 1; q < S; ++q) acc4 += *(const LAS f32x4*)(pp + (size_t)q * 64 * 32 + hh * 4);
                        const f32x4 xv = *(const f32x4*)(xrow + c), gv = *(const f32x4*)(mg + c);
                        f32x4 ov; ov[0] = xv[0] + gv[0] * acc4[0] * 0.25f; ov[1] = xv[1] + gv[1] * acc4[1] * 0.25f; ov[2] = xv[2] + gv[2] * acc4[2] * 0.25f; ov[3] = xv[3] + gv[3] * acc4[3] * 0.25f;
                        *(f32x4*)(orow + c) = ov; }
                }
            }
        }
    }
}

#if !MK_SINGLE
#define LOHI_ARGS , const int lo, const int hi
#define LOHI_PASS , lo, hi
#else
#define LOHI_ARGS
#define LOHI_PASS
#endif
#ifndef PHM
#define PHM 0x7ff
#endif
#if MK_SINGLE
#define IN(k) (((PHM >> (((k) % NPH))) & 1) != 0)
#define SEAM(k) do { if ((k) + 1 < 2 * NPH) xcd_barrier(bar); } while (0)
#else
#define IN(k) (((PHM >> (((k) % NPH))) & 1) && lo <= (k) && (k) < hi)
#define SEAM(k) do { if (IN(k) && IN((k) + 1)) xcd_barrier(bar); } while (0)
#endif
template <int l>
__device__ __forceinline__ void layer_program(KP kp, unsigned char* ws0, LAS unsigned char* lds, const XcdBarrier& bar, const int G, const int wid0 LOHI_ARGS) {
        const int pb = l * NPH;
        const int M2 = (l == 0) ? MR : NLAT;
        constexpr int MG = NLAT;
        if (IN(pb + 0)) { phase_w(launder_p(kp), l, lds, wid0); } SEAM(pb + 0);
        if (IN(pb + 1)) { phase_norm(launder_p(kp), l, 0, MR, wid0); } SEAM(pb + 1);
        if (IN(pb + 2)) { unsigned char* ws = launder(ws0);
            { pg8::PlainOrder S; S.init(ws + WS_XN8, ws + WS_WIN, MR, 72 * 256, 1024, G, (int)blockIdx.x); S.skip_from = 48; S.skip_cnt = 24;
              pg8::EpiProj E{ws};
              pg8::gemm_phase<pg8::EpiProj, pg8::PlainOrder, true>(lds, 1024, S, E, wid0); }
            { pg8::PlainOrder S; S.init(ws + WS_XN, ws + WS_WINB, MR, 24 * 256, 2048, G, G - 1 - (int)blockIdx.x); S.pn_base = 48; S.b_row0 = 48;
              pg8::EpiProj E{ws};
              pg8::gemm_phase<pg8::EpiProj, pg8::PlainOrder, false>(lds, 2048, S, E, wid0); }
        } SEAM(pb + 2);
        if (IN(pb + 3)) { phase_gates_gemm(launder_p(kp), l, wid0); phase_e1(launder_p(kp), l, wid0); } SEAM(pb + 3);
        if (IN(pb + 4)) { phase_mlstm(launder_p(kp), l, lds, wid0); phase_attn(launder_p(kp), l, lds, wid0); } SEAM(pb + 4);
        if (IN(pb + 5)) { phase_e2(launder_p(kp), l, M2, wid0); } SEAM(pb + 5);
        if (IN(pb + 6)) { unsigned char* ws = launder(ws0);
            pg8::BranchOrder S; S.T8 = (const char*)(ws + WS_T8); S.WA = (const char*)(ws + WS_WA);
            S.nM = MG / 256; S.nN = 8; S.G = G; S.c = (int)blockIdx.x; S.tstep = (size_t)256 * 2048 * 2;
            pg8::EpiMerge E{(bf16_t*)(ws + WS_Y), (const bf16_t*)(ws + WS_GT)};
            pg8::gemm_phase<pg8::EpiMerge, pg8::BranchOrder>(lds, 2048, S, E, wid0);
            if (l == 0) ctx_gemm<0>(launder_p(kp), l, lds, wid0);
        } SEAM(pb + 6);
        if (IN(pb + 7)) { unsigned char* ws = launder(ws0);
            pg8::PlainOrder S; S.init(ws + WS_Y, ws + WS_WO, MG, 2048, 2048, G, (int)blockIdx.x);
            pg8::EpiRes E{(float*)(ws + WS_X), l == 0 ? kp->x : (const float*)(ws + WS_X), (const float*)(ws + WS_MOD) + (size_t)l * 3 * 12288};
            pg8::gemm_phase<pg8::EpiRes, pg8::PlainOrder>(lds, 2048, S, E, wid0);
            if (l == 0) ctx_gemm<1>(launder_p(kp), l, lds, wid0);
        } SEAM(pb + 7);
        if (IN(pb + 8)) { phase_norm(launder_p(kp), l, 1, M2, wid0); } SEAM(pb + 8);
        if (IN(pb + 9)) { unsigned char* ws = launder(ws0);
            pg8::PlainOrder S; S.init(ws + WS_XN, ws + WS_WQ, MG, 2048, 2048, G, (int)blockIdx.x);
            pg8::EpiBf E{(bf16_t*)(ws + WS_PV), 2048};
            pg8::gemm_phase<pg8::EpiBf, pg8::PlainOrder>(lds, 2048, S, E, wid0);
            if (l == 0) ctx_gemm<2>(launder_p(kp), l, lds, wid0);
        } SEAM(pb + 9);
        if (IN(pb + 10)) { phase_peer(launder_p(kp), l, lds, wid0); } SEAM(pb + 10);
    }
#undef IN
#undef SEAM

__global__ void __launch_bounds__(NTHREADS, 2) fwd_kernel(Params p) {
    extern __shared__ __attribute__((aligned(16))) unsigned char lds_raw[];
    LAS unsigned char* lds = (LAS unsigned char*)lds_raw;
    const int tid = threadIdx.x, G = gridDim.x;
    const int wid0 = __builtin_amdgcn_readfirstlane(tid >> 6);
    KP kp = (KP)__builtin_amdgcn_kernarg_segment_ptr();
    unsigned char* ws0 = kp->ws;
    volatile LAS unsigned* bst = (volatile LAS unsigned*)(lds + LDS_BYTES - 16);
    if (tid == 0) { bst[0] = 0u; bst[1] = 0u; bst[2] = 0u; bst[3] = 0u; }
    __syncthreads();
    XcdBarrier bar; bar.bar = (unsigned*)(ws0 + WS_BAR); bar.x = 0; bar.st = bst;
    if (MK_SINGLE) bar = xcd_barrier_post((unsigned*)(ws0 + WS_BAR), bst);
#if !MK_SINGLE
    const int lo = kp->ph_lo, hi = kp->ph_hi;
#endif
    layer_program<0>(kp, ws0, lds, bar, G, wid0 LOHI_PASS);
    layer_program<1>(kp, ws0, lds, bar, G, wid0 LOHI_PASS);
}

extern "C" void kernel_launch(void* const* d_in, const int* in_sizes, int n_in, void* d_out, int out_size, void* d_ws, size_t ws_size, hipStream_t stream) {
    static int grid = 0;
    if (grid == 0) {
        if (n_in != 21 || in_sizes[0] != NLAT * DM || out_size != NLAT * DM || ws_size < WS_END) {
            fprintf(stderr, "kernel_launch: unexpected shapes (n_in %d, in0 %d, out %d, ws %zu need %zu); nothing launched\n", n_in, n_in > 0 ? in_sizes[0] : -1, out_size, ws_size, (size_t)WS_END); grid = -1; return; }
        int dev = 0, cus = 0, per_cu = 0;
        if (hipGetDevice(&dev) != hipSuccess || hipDeviceGetAttribute(&cus, hipDeviceAttributeMultiprocessorCount, dev) != hipSuccess) { grid = -1; return; }
        if (hipFuncSetAttribute((const void*)fwd_kernel, hipFuncAttributeMaxDynamicSharedMemorySize, LDS_BYTES) != hipSuccess) { fprintf(stderr, "kernel_launch: hipFuncSetAttribute failed\n"); grid = -1; return; }
        if (hipOccupancyMaxActiveBlocksPerMultiprocessor(&per_cu, (const void*)fwd_kernel, NTHREADS, LDS_BYTES) != hipSuccess || per_cu < 1) { fprintf(stderr, "kernel_launch: occupancy query says %d\n", per_cu); }
        (void)hipGetLastError();
        grid = cus;
    }
    if (grid < 0) return;
    (void)hipMemsetAsync((char*)d_ws, 0, 16384, stream);
    Params p{};
    const float** pp = (const float**)&p;
    for (int i = 0; i < 21; ++i) pp[i] = (const float*)d_in[i];
    p.out = (float*)d_out; p.ws = (unsigned char*)d_ws;
#if MK_SINGLE
    p.ph_lo = 0; p.ph_hi = 2 * NPH;
    hipLaunchKernelGGL(fwd_kernel, dim3(grid), dim3(NTHREADS), LDS_BYTES, stream, p);
#else
    for (int k = 0; k < 2 * NPH; ++k) { p.ph_lo = k; p.ph_hi = k + 1; hipLaunchKernelGGL(fwd_kernel, dim3(grid), dim3(NTHREADS), LDS_BYTES, stream, p); }
#endif
}
```

```cpp
#include <hip/hip_runtime.h>
#include <stdint.h>
#include <stdio.h>
#include <type_traits>

#ifndef BF_LO
#define BF_LO 0
#define BF_HI 8
#endif
#ifndef MK_SINGLE
#define MK_SINGLE 1
#endif

#define LAS __attribute__((address_space(3)))
typedef unsigned short bf16_t;
typedef short bf16x8 __attribute__((ext_vector_type(8)));
typedef float f32x4 __attribute__((ext_vector_type(4)));
typedef float f32x2 __attribute__((ext_vector_type(2)));
typedef unsigned u32x4 __attribute__((ext_vector_type(4)));
typedef unsigned u32x2 __attribute__((ext_vector_type(2)));
typedef __bf16 bf2_t __attribute__((ext_vector_type(2)));
typedef int i32x4 __attribute__((ext_vector_type(4)));
typedef int i32x8 __attribute__((ext_vector_type(8)));
typedef float f32x16 __attribute__((ext_vector_type(16)));
typedef float f32x32 __attribute__((ext_vector_type(32)));
typedef unsigned u32x6 __attribute__((ext_vector_type(6)));
typedef __bf16 bf16x32_t __attribute__((ext_vector_type(32)));
typedef unsigned u32x16 __attribute__((ext_vector_type(16)));
typedef short s16x4 __attribute__((ext_vector_type(4)));
#ifndef FP6_INTERLEAVED
#define FP6_INTERLEAVED 1
#endif

constexpr int DM = 2048, NBATCH = 2, SEQ = 8192, CTXL = 256;
constexpr int NLAT = NBATCH * SEQ;
constexpr int NCTX = NBATCH * CTXL;
constexpr int MR = NLAT + NCTX;
constexpr int PROJ_W = 24608;
constexpr int NPROJ = 24576;
constexpr int NTHREADS = 512;
constexpr int LDS_BYTES = 163840;
constexpr int NPH = 11;
constexpr float EPSF = 1e-6f;

constexpr size_t SZ_A = (size_t)MR * 2048 * 2;
constexpr size_t WS_BAR = 0;
constexpr size_t WS_MOD = 16384;
constexpr size_t CTL_BYTES = 16384 + 2 * 3 * 12288 * 4;
constexpr size_t WS_TAB = 311296;
constexpr size_t WS_X = WS_TAB + 32768;
constexpr size_t WS_XN = WS_X + (size_t)MR * 2048 * 4;
constexpr size_t WS_Y = WS_XN + SZ_A;
constexpr size_t WS_XN8 = WS_Y;
constexpr size_t WS_PQ = WS_Y + SZ_A;
constexpr size_t WS_PK = WS_PQ + SZ_A / 2;
constexpr size_t WS_T8 = WS_PK + SZ_A / 2;
constexpr size_t WS_PV = WS_T8 + 0 * SZ_A;
constexpr size_t WS_PO = WS_T8 + 1 * SZ_A;
constexpr size_t WS_CQ = WS_T8 + 2 * SZ_A;
constexpr size_t WS_CK = WS_T8 + 3 * SZ_A;
constexpr size_t WS_CV = WS_T8 + 4 * SZ_A;
constexpr size_t WS_BB = WS_T8 + 5 * SZ_A;
constexpr size_t WS_BC = WS_T8 + 6 * SZ_A;
constexpr size_t WS_BX = WS_T8 + 7 * SZ_A;
constexpr size_t WS_GT = WS_T8 + 8 * SZ_A;
constexpr size_t WS_GATES = WS_GT + 3 * SZ_A;
constexpr size_t WS_WIN = WS_GATES + (size_t)MR * 32 * 4;
constexpr size_t WS_WINB = WS_WIN + (size_t)NPROJ * 2048;
constexpr size_t WS_WG = WS_WIN + (size_t)NPROJ * 2048 * 2;
constexpr size_t SZ_W = (size_t)2048 * 2048 * 2;
constexpr size_t WS_WA = WS_WG + 32 * 2048 * 2;
constexpr size_t WS_WB = WS_WA + SZ_W;
constexpr size_t WS_WC = WS_WB + SZ_W;
constexpr size_t WS_WO = WS_WC + SZ_W;
constexpr size_t WS_WQ = WS_WO + SZ_W;
constexpr size_t WS_KEYS = WS_WQ + SZ_W;
constexpr size_t WS_PU = WS_KEYS + 16 * 128 * 128 * 2;
constexpr size_t WS_PVW = WS_PU + (size_t)16384 * 2048 * 2;
constexpr size_t WS_SCAN = WS_PU + (size_t)16384 * 2048;
constexpr size_t WS_END = WS_PVW + (size_t)16384 * 2048 * 2;

struct Params {
    const float *x, *c, *ctx, *c_ctx, *w_ada, *b_ada, *norm_g, *w_in, *a_gate_b, *a_hnorm_g, *b_conv, *c_qk_g, *c_rpb,
        *w_a_out, *w_b_out, *w_c_out, *w_out, *peer_wq, *peer_keys, *peer_u, *peer_v;
    float* out; unsigned char* ws; int ph_lo, ph_hi;
};
#define CAS __attribute__((address_space(4)))
typedef const CAS Params* KP;
__device__ __forceinline__ KP launder_p(KP q) { asm volatile("" : "+s"(q)); return q; }

__device__ __forceinline__ unsigned char* launder(unsigned char* q) { size_t z = 0; asm volatile("" : "+s"(z)); return q + z; }
__device__ __forceinline__ int tid_fresh(int wid0) { int t = wid0 * 64 + (int)__builtin_amdgcn_mbcnt_hi(~0u, __builtin_amdgcn_mbcnt_lo(~0u, 0u)); asm volatile("" : "+v"(t)); return t; }

__device__ __forceinline__ float bf2f(unsigned b) { return __uint_as_float(b << 16); }
__device__ __forceinline__ float bflo(unsigned w) { return __uint_as_float(w << 16); }
__device__ __forceinline__ float bfhi(unsigned w) { return __uint_as_float(w & 0xffff0000u); }
__device__ __forceinline__ unsigned pk2(float lo, float hi) { f32x2 v = {lo, hi}; bf2_t b = __builtin_convertvector(v, bf2_t); return __builtin_bit_cast(unsigned, b); }
__device__ __forceinline__ bf16_t f2bf(float f) { return (bf16_t)(pk2(f, 0.f) & 0xffffu); }
__device__ __forceinline__ f32x4 mfma16(bf16x8 a, bf16x8 b, f32x4 c) { return __builtin_amdgcn_mfma_f32_16x16x32_bf16(a, b, c, 0, 0, 0); }
__device__ __forceinline__ float dot2bf(unsigned a, unsigned b, float c) { return __builtin_amdgcn_fdot2_f32_bf16(__builtin_bit_cast(bf2_t, a), __builtin_bit_cast(bf2_t, b), c, false); }
#define LDS_BARRIER() do { asm volatile("s_waitcnt lgkmcnt(0)" ::: "memory"); __builtin_amdgcn_s_barrier(); asm volatile("" ::: "memory"); } while (0)
__device__ __forceinline__ float wave_sum(float v) {
#pragma unroll
    for (int o = 32; o >= 1; o >>= 1) v += __shfl_xor(v, o);
    return v;
}
__device__ __forceinline__ float sigmoidf_(float v) { return __builtin_amdgcn_rcpf(1.0f + __expf(-v)); }
__device__ __forceinline__ float logsigmoidf_(float v) { return fminf(v, 0.f) - log1pf(__expf(-fabsf(v))); }

#define XB_TMO      128
#define XB_XCNT(j)  (256  + 64 * (j))
#define XB_XSUB(j)  (1280 + 64 * (j))
#define XB_XGEN(j)  (2304 + 64 * (j))
#define XB_TOP      3328
#define XB_TOPGEN   3392
#define XCD_BAR_WORDS 3456
#define XB_SPIN_CAP (1u << 22)
__device__ __forceinline__ unsigned xb_ld(unsigned* p)              { return __hip_atomic_load(p, __ATOMIC_RELAXED, __HIP_MEMORY_SCOPE_AGENT); }
__device__ __forceinline__ unsigned xb_add(unsigned* p, unsigned v) { return __hip_atomic_fetch_add(p, v, __ATOMIC_RELAXED, __HIP_MEMORY_SCOPE_AGENT); }
__device__ __forceinline__ unsigned xb_xcc_id() { return (unsigned)__builtin_amdgcn_s_getreg((3 << 11) | 20) & 0xFu; }
#define XB_SPIN(cond, bar) do { unsigned _sp = 0; while (cond) { __builtin_amdgcn_s_sleep(1); \
    if ((++_sp & 255u) == 0u) { if (xb_ld(&(bar)[XB_TMO])) break; if (_sp > XB_SPIN_CAP) { atomicAdd(&(bar)[XB_TMO], 1u); break; } } } } while (0)
struct XcdBarrier { unsigned* bar; unsigned x; volatile LAS unsigned* st; };
__device__ __forceinline__ XcdBarrier xcd_barrier_post(unsigned* bar, volatile LAS unsigned* st) {
    XcdBarrier b; b.bar = bar; b.x = xb_xcc_id(); b.st = st;
    if (threadIdx.x == 0) (void)xb_add(&bar[XB_XCNT(b.x)], 1u);
    return b;
}
__device__ __forceinline__ void xcd_barrier_complete(unsigned* bar, unsigned x, unsigned& nloc, unsigned& nx) {
    const unsigned G = gridDim.x * gridDim.y * gridDim.z;
    unsigned sum, cnt, mine, sp = 0u;
    for (;;) {
        sum = 0u; cnt = 0u; mine = 0u;
#pragma unroll
        for (unsigned j = 0; j < 16; ++j) { const unsigned c = xb_ld(&bar[XB_XCNT(j)]); sum += c; cnt += (c > 0u) ? 1u : 0u; mine = (j == x) ? c : mine; }
        if (sum == G) break;
        __builtin_amdgcn_s_sleep(1);
        if ((++sp & 255u) == 0u) { if (xb_ld(&bar[XB_TMO])) break; if (sp > XB_SPIN_CAP) { atomicAdd(&bar[XB_TMO], 1u); break; } }
    }
    nloc = mine > 0u ? mine : 1u; nx = cnt > 0u ? cnt : 1u;
}
__device__ __forceinline__ void xcd_barrier(const XcdBarrier& b) {
    asm volatile("s_waitcnt vmcnt(0)" ::: "memory");
    __syncthreads();
    if (threadIdx.x == 0) {
        unsigned* bar = b.bar;
        __builtin_amdgcn_s_waitcnt(0);
        unsigned nloc = b.st[0], nx = b.st[1];
        if (nloc == 0u) { xcd_barrier_complete(bar, b.x, nloc, nx); b.st[0] = nloc; b.st[1] = nx; }
        const unsigned old = xb_add(&bar[XB_XSUB(b.x)], 1u);
        const unsigned gen = old / nloc;
        if (old + 1u == (gen + 1u) * nloc) {
            __builtin_amdgcn_fence(__ATOMIC_RELEASE, "agent");
            asm volatile("s_waitcnt vmcnt(0)" ::: "memory");
            const unsigned og = xb_add(&bar[XB_TOP], 1u);
            const unsigned tg = og / nx;
            if (og + 1u == (tg + 1u) * nx) xb_add(&bar[XB_TOPGEN], 1u);
            else XB_SPIN(xb_ld(&bar[XB_TOPGEN]) == tg, bar);
            __builtin_amdgcn_fence(__ATOMIC_ACQUIRE, "agent");
            xb_add(&bar[XB_XGEN(b.x)], 1u);
            asm volatile("s_waitcnt vmcnt(0)" ::: "memory");
        } else {
            XB_SPIN(xb_ld(&bar[XB_XGEN(b.x)]) == gen, bar);
            __builtin_amdgcn_fence(__ATOMIC_ACQUIRE, "agent");
            asm volatile("s_waitcnt vmcnt(0)" ::: "memory");
        }
    }
    __syncthreads();
}

namespace pg8 {
constexpr int BM = 256, BK = 64, HALF = 128, HTB = HALF * BK * 2, STAGE_BYTES = 8 * HTB, NXCD = 8, WGM = 8;
__host__ __device__ __forceinline__ int lds_byte(int r, int c) { const int st = (r >> 4) * 2 + (c >> 5), rr = r & 15, cc = c & 31, ob = rr * 64 + cc * 2; return st * 1024 + (ob ^ (((ob >> 9) & 1) << 5)); }
__host__ __device__ __forceinline__ void stage_rc(int b, int& R, int& C) { const int st = b / 1024, sb = b % 1024, swz = sb ^ (((sb >> 9) & 1) << 5); R = (st >> 1) * 16 + swz / 64; C = (st & 1) * 32 + (swz % 64) / 2; }
__host__ __device__ __forceinline__ int perm32(int rho) { const int n = rho >> 4, i = rho & 15; return 8 * (i >> 2) + 4 * n + (i & 3); }

struct Unit { int pm, pn, br; const char* A; const char* B; };

__device__ __forceinline__ bool tile_of(int L, int nM, int nN, int& pm, int& pn) {
    const int nwg = nM * nN; if (L >= nwg) return false;
    int wgid = L; { const int q = nwg / NXCD, r = nwg % NXCD, xcd = wgid % NXCD, off = wgid / NXCD; wgid = (xcd < r ? xcd * (q + 1) : r * (q + 1) + (xcd - r) * q) + off; }
    const int nig = WGM * nN, gid = wgid / nig, fm = gid * WGM, gsz = (nM - fm) < WGM ? (nM - fm) : WGM;
    pm = fm + ((wgid % nig) % gsz); pn = (wgid % nig) / gsz; return true;
}
struct PlainOrder {
    const char* A; const char* Bt; int nM, nN, G, c; size_t tstep; int pn_base, skip_from, skip_cnt, skip2_from, skip2_cnt, b_row0, b_compact;
    __device__ __forceinline__ void init(const void* A_, const void* Bt_, int M, int N, int K, int G_, int c_) { A = (const char*)A_; Bt = (const char*)Bt_; nM = M / BM; nN = N / BM; G = G_; c = c_; tstep = (size_t)BM * K * 2;
        pn_base = 0; skip_from = 1 << 30; skip_cnt = 0; skip2_from = 1 << 30; skip2_cnt = 0; b_row0 = 0; b_compact = 0; }
    __device__ __forceinline__ bool next(int i, Unit& u) const {
        int pm, pn; if (!tile_of(i * G + c, nM, nN, pm, pn)) return false;
        const int pnc = pn;
        pn += pn_base; if (pn >= skip_from) pn += skip_cnt; if (pn >= skip2_from) pn += skip2_cnt;
        u.pm = pm; u.pn = pn; u.br = 0; u.A = A + (size_t)pm * tstep; u.B = Bt + (size_t)(b_compact ? pnc : pn - b_row0) * tstep; return true;
    }
};
struct BranchOrder {
    const char* T8; const char* WA; int nM, nN, G, c; size_t tstep;
    __device__ __forceinline__ bool next(int i, Unit& u) const {
        const int tl = i / 3, br = i - 3 * tl; int pm, pn; if (!tile_of(tl * G + c, nM, nN, pm, pn)) return false;
        u.pm = pm; u.pn = pn; u.br = br;
        const int ti = 1 + 4 * (br == 1) + (br == 2);
        u.A = T8 + (size_t)ti * SZ_A + (size_t)pm * tstep; u.B = WA + (size_t)br * SZ_W + (size_t)pn * tstep; return true;
    }
};

template <class Epi, class Sched, bool FP8 = false>
__device__ __forceinline__ void gemm_phase(LAS unsigned char* lds, const int K, const Sched& S, const Epi& E, int wid0) {
    const int tid = tid_fresh(wid0), wid = __builtin_amdgcn_readfirstlane(tid >> 6), lane = tid & 63, wr = wid >> 2, wc = wid & 3, fr = lane & 15, fq = lane >> 4;
    const int nt = K / BK;
    unsigned voffA[2], voffB[2];
#pragma unroll
    for (int i = 0; i < 2; ++i) { int R, C; stage_rc(tid * 16 + i * 8192, R, C); const int Rb = Epi::PERM ? ((R & ~31) + perm32(R & 31)) : R;
        voffA[i] = (unsigned)(R * K + C) * 2u; voffB[i] = (unsigned)(Rb * K + C) * 2u; }
    const size_t kstep = (size_t)(BK * 2);
    const size_t hstep = (size_t)HALF * K * 2;
    const unsigned ldsw = (unsigned)wid * 1024u;
    const int aoff = lds_byte(wr * 64 + fr, fq * 8), boff = lds_byte(wc * 32 + fr, fq * 8);
#define PG8_SA(b, h) (((b) * 2 + (h)) * HTB)
#define PG8_SB(b, h) ((4 + (b) * 2 + (h)) * HTB)
#define PG8_STAGE(bufoff, gbase, voff) do { _Pragma("unroll") for (int _i = 0; _i < 2; ++_i) \
        __builtin_amdgcn_global_load_lds((const unsigned*)((const char*)(gbase) + (voff)[_i]), (LAS unsigned*)(lds + (bufoff) + ldsw + _i * 8192), 16, 0, 0); } while (0)
#define PG8_LD1(dstv, addr) do { if constexpr (FP8) { const i32x4 _lo = *(const LAS i32x4*)(lds + (addr)), _hi = *(const LAS i32x4*)(lds + (addr) + 1024); dstv[0] = __builtin_shufflevector(_lo, _hi, 0, 1, 2, 3, 4, 5, 6, 7); } \
        else { _Pragma("unroll") for (int k = 0; k < 2; ++k) dstv[k] = *(const LAS bf16x8*)(lds + (addr) + k * 1024); } } while (0)
#define PG8_LDA(dst, b, h) do { _Pragma("unroll") for (int m = 0; m < 4; ++m) PG8_LD1(dst[m], PG8_SA(b, h) + aoff + m * 2048); } while (0)
#define PG8_LDB(dst, b, h) do { _Pragma("unroll") for (int n = 0; n < 2; ++n) PG8_LD1(dst[n], PG8_SB(b, h) + boff + n * 2048); } while (0)
#define PG8_MMA(ai, bj, At, Bt) do { __builtin_amdgcn_s_setprio(1); _Pragma("unroll") for (int m = 0; m < 4; ++m) _Pragma("unroll") for (int n = 0; n < 2; ++n) { \
        if constexpr (FP8) asm volatile("v_mfma_scale_f32_16x16x128_f8f6f4 %0, %1, %2, %0, %3, %4 op_sel_hi:[0,0,0]" : "+v"(acc[ai][bj][m][n]) : "v"(Bt[n][0]), "v"(At[m][0]), "v"(sclW), "v"(sclX)); \
        else { _Pragma("unroll") for (int k = 0; k < 2; ++k) acc[ai][bj][m][n] = __builtin_amdgcn_mfma_f32_16x16x32_bf16(Bt[n][k], At[m][k], acc[ai][bj][m][n], 0, 0, 0); } } \
        __builtin_amdgcn_s_setprio(0); } while (0)
#define PG8_WAIT_V(n) asm volatile("s_waitcnt vmcnt(" #n ")" ::: "memory")
#define PG8_WAIT_L(n) asm volatile("s_waitcnt lgkmcnt(" #n ")" ::: "memory")
#define PG8_BAR __builtin_amdgcn_s_barrier()
#define PG8_SCHED __builtin_amdgcn_sched_barrier(0)
    Unit cur, nxt; int ui = 0;
    if (!S.next(0, cur)) return;
    const int sclW = 0x75757575, sclX = 0x7F7F7F7F;
    f32x4 acc[2][2][4][2];
#pragma unroll
    for (int a = 0; a < 2; ++a)
#pragma unroll
        for (int b = 0; b < 2; ++b)
#pragma unroll
            for (int m = 0; m < 4; ++m)
#pragma unroll
                for (int n = 0; n < 2; ++n) acc[a][b][m][n] = (f32x4){0.f, 0.f, 0.f, 0.f};
    typedef typename std::conditional<FP8, i32x8, bf16x8>::type frag_t;
    frag_t At[4][FP8 ? 1 : 2], B0[2][FP8 ? 1 : 2], B1[2][FP8 ? 1 : 2];
    const char* cA = cur.A; const char* cB = cur.B;
    PG8_STAGE(PG8_SB(0, 0), cB, voffB); PG8_STAGE(PG8_SA(0, 0), cA, voffA); PG8_STAGE(PG8_SB(0, 1), cB + hstep, voffB); PG8_STAGE(PG8_SA(0, 1), cA + hstep, voffA);
    if (wr == 1) PG8_BAR;
    PG8_WAIT_V(4); PG8_BAR;
    PG8_STAGE(PG8_SB(1, 0), cB + kstep, voffB); PG8_STAGE(PG8_SA(1, 0), cA + kstep, voffA); PG8_STAGE(PG8_SB(1, 1), cB + hstep + kstep, voffB);
    PG8_WAIT_V(6); PG8_BAR;
    for (;;) {
        const bool has_next = S.next(ui + 1, nxt);
        const char* nA = has_next ? nxt.A : cA; const char* nB = has_next ? nxt.B : cB;
        for (int t = 0; t < nt; t += 2) {
            const bool last = (t == nt - 2);
            const char* a1 = cA + (size_t)(t + 1) * kstep;
            const char* a2 = last ? nA : cA + (size_t)(t + 2) * kstep; const char* b2 = last ? nB : cB + (size_t)(t + 2) * kstep;
            const char* a3 = a2 + kstep; const char* b3 = b2 + kstep;
            PG8_LDB(B0, 0, 0); PG8_SCHED; PG8_LDA(At, 0, 0); PG8_STAGE(PG8_SA(1, 1), a1 + hstep, voffA);
            PG8_WAIT_L(8); PG8_BAR; PG8_WAIT_L(0); PG8_MMA(0, 0, At, B0); PG8_BAR; PG8_SCHED;
            PG8_LDB(B1, 0, 1); PG8_STAGE(PG8_SB(0, 0), b2, voffB);
            PG8_BAR; PG8_WAIT_L(0); PG8_MMA(0, 1, At, B1); PG8_BAR;
            PG8_LDA(At, 0, 1); PG8_STAGE(PG8_SA(0, 0), a2, voffA);
            PG8_BAR; PG8_WAIT_L(0); PG8_MMA(1, 0, At, B0); PG8_BAR; PG8_SCHED;
            PG8_STAGE(PG8_SB(0, 1), b2 + hstep, voffB);
            PG8_WAIT_V(6); PG8_BAR; PG8_MMA(1, 1, At, B1); PG8_BAR;
            PG8_LDB(B0, 1, 0); PG8_SCHED; PG8_LDA(At, 1, 0); PG8_STAGE(PG8_SA(0, 1), a2 + hstep, voffA);
            PG8_WAIT_L(8); PG8_BAR; PG8_WAIT_L(0); PG8_MMA(0, 0, At, B0); PG8_BAR; PG8_SCHED;
            PG8_LDB(B1, 1, 1); PG8_STAGE(PG8_SB(1, 0), b3, voffB);
            PG8_BAR; PG8_WAIT_L(0); PG8_MMA(0, 1, At, B1); PG8_BAR;
            PG8_LDA(At, 1, 1); PG8_STAGE(PG8_SA(1, 0), a3, voffA);
            PG8_BAR; PG8_WAIT_L(0); PG8_MMA(1, 0, At, B0); PG8_BAR; PG8_SCHED;
            PG8_STAGE(PG8_SB(1, 1), b3 + hstep, voffB);
            PG8_WAIT_V(6); PG8_BAR; PG8_MMA(1, 1, At, B1); PG8_BAR;
        }
        if constexpr (FP8) { asm volatile("s_nop 15\n\ts_nop 15\n\ts_nop 15" ::: "memory"); }
        E(acc, cur, wr, wc, fr, fq);
        if (!has_next) break;
#pragma unroll
        for (int a = 0; a < 2; ++a)
#pragma unroll
            for (int b = 0; b < 2; ++b)
#pragma unroll
                for (int m = 0; m < 4; ++m)
#pragma unroll
                    for (int n = 0; n < 2; ++n) acc[a][b][m][n] = (f32x4){0.f, 0.f, 0.f, 0.f};
        cur = nxt; cA = nA; cB = nB; ++ui;
    }
    PG8_WAIT_V(0);
    if (wr == 0) PG8_BAR;
    PG8_BAR;
#undef PG8_SA
#undef PG8_SB
#undef PG8_STAGE
#undef PG8_LD1
#undef PG8_LDA
#undef PG8_LDB
#undef PG8_MMA
#undef PG8_WAIT_V
#undef PG8_WAIT_L
#undef PG8_BAR
#undef PG8_SCHED
}

struct EpiProj {
    static constexpr bool PERM = true;
    unsigned char* ws;
    __device__ __forceinline__ void operator()(const f32x4 (&acc)[2][2][4][2], const Unit& u, int wr, int wc, int fr, int fq) const {
        const int pn = u.pn; size_t off; int ld, c0;
        if (pn < 4) { off = WS_PQ; ld = 1024; c0 = pn * 256; }
        else if (pn < 8) { off = WS_PK; ld = 1024; c0 = (pn - 4) * 256; }
        else if (pn < 72) { const int t = (pn - 8) >> 3; off = WS_T8 + (size_t)t * SZ_A; ld = 2048; c0 = ((pn - 8) & 7) * 256; }
        else { off = WS_GT; ld = 6144; c0 = (pn - 72) * 256; }
        bf16_t* rp = (bf16_t*)(ws + off) + (size_t)(u.pm * BM + wr * 64 + fr) * ld + c0 + wc * 32 + 8 * fq;
        const size_t step = (size_t)16 * ld;
#pragma unroll
        for (int ai = 0; ai < 2; ++ai) {
#pragma unroll
            for (int m = 0; m < 4; ++m) {
                asm volatile("" : "+v"(rp));
#pragma unroll
                for (int bj = 0; bj < 2; ++bj) { const f32x4 v0 = acc[ai][bj][m][0], v1 = acc[ai][bj][m][1];
                    u32x4 w; w.x = pk2(v0[0], v0[1]); w.y = pk2(v0[2], v0[3]); w.z = pk2(v1[0], v1[1]); w.w = pk2(v1[2], v1[3]);
                    *(u32x4*)(rp + bj * HALF) = w; }
                rp += step;
            }
            rp += 4 * step;
        }
    }
};
struct EpiBf {
    static constexpr bool PERM = true;
    bf16_t* O; int ld;
    __device__ __forceinline__ void operator()(const f32x4 (&acc)[2][2][4][2], const Unit& u, int wr, int wc, int fr, int fq) const {
        const int row0 = u.pm * BM + wr * 64 + fr, col0 = u.pn * BM + wc * 32 + 8 * fq;
#pragma unroll
        for (int ai = 0; ai < 2; ++ai)
#pragma unroll
            for (int m = 0; m < 4; ++m) { bf16_t* rowp = O + (size_t)(row0 + ai * HALF + m * 16) * ld + col0;
#pragma unroll
                for (int bj = 0; bj < 2; ++bj) { const f32x4 v0 = acc[ai][bj][m][0], v1 = acc[ai][bj][m][1];
                    u32x4 w; w.x = pk2(v0[0], v0[1]); w.y = pk2(v0[2], v0[3]); w.z = pk2(v1[0], v1[1]); w.w = pk2(v1[2], v1[3]);
                    *(u32x4*)(rowp + bj * HALF) = w; } }
    }
};
struct EpiMerge {
    static constexpr bool PERM = true;
    bf16_t* Y; const bf16_t* GT;
    __device__ __forceinline__ void operator()(const f32x4 (&acc)[2][2][4][2], const Unit& u, int wr, int wc, int fr, int fq) const {
        const int row0 = u.pm * BM + wr * 64 + fr, col0 = u.pn * BM + wc * 32 + 8 * fq;
        const bool addy = u.br != 0;
#pragma unroll
        for (int ai = 0; ai < 2; ++ai) {
            u32x4 g[4][2], y[4][2];
#pragma unroll
            for (int m = 0; m < 4; ++m)
#pragma unroll
                for (int bj = 0; bj < 2; ++bj) { const size_t r = (size_t)(row0 + ai * HALF + m * 16);
                    g[m][bj] = *(const u32x4*)(GT + r * 6144 + (size_t)u.br * 2048 + col0 + bj * HALF); }
            if (addy) {
#pragma unroll
                for (int m = 0; m < 4; ++m)
#pragma unroll
                    for (int bj = 0; bj < 2; ++bj) { const size_t r = (size_t)(row0 + ai * HALF + m * 16); y[m][bj] = *(const u32x4*)(Y + r * 2048 + col0 + bj * HALF); }
            } else {
#pragma unroll
                for (int m = 0; m < 4; ++m)
#pragma unroll
                    for (int bj = 0; bj < 2; ++bj) y[m][bj] = (u32x4){0u, 0u, 0u, 0u};
            }
#pragma unroll
            for (int m = 0; m < 4; ++m)
#pragma unroll
                for (int bj = 0; bj < 2; ++bj) { const size_t r = (size_t)(row0 + ai * HALF + m * 16);
                    const f32x4 v0 = acc[ai][bj][m][0], v1 = acc[ai][bj][m][1]; const u32x4 gg = g[m][bj], yy = y[m][bj];
                    float o[8];
                    o[0] = sigmoidf_(bflo(gg.x)) * v0[0] + bflo(yy.x); o[1] = sigmoidf_(bfhi(gg.x)) * v0[1] + bfhi(yy.x); o[2] = sigmoidf_(bflo(gg.y)) * v0[2] + bflo(yy.y); o[3] = sigmoidf_(bfhi(gg.y)) * v0[3] + bfhi(yy.y);
                    o[4] = sigmoidf_(bflo(gg.z)) * v1[0] + bflo(yy.z); o[5] = sigmoidf_(bfhi(gg.z)) * v1[1] + bfhi(yy.z); o[6] = sigmoidf_(bflo(gg.w)) * v1[2] + bflo(yy.w); o[7] = sigmoidf_(bfhi(gg.w)) * v1[3] + bfhi(yy.w);
                    u32x4 w; w.x = pk2(o[0], o[1]); w.y = pk2(o[2], o[3]); w.z = pk2(o[4], o[5]); w.w = pk2(o[6], o[7]);
                    *(u32x4*)(Y + r * 2048 + col0 + bj * HALF) = w; }
        }
    }
};
struct EpiRes {
    static constexpr bool PERM = false;
    float* X; const float* Xin; const float* mod;
    __device__ __forceinline__ void operator()(const f32x4 (&acc)[2][2][4][2], const Unit& u, int wr, int wc, int fr, int fq) const {
        const int row0 = u.pm * BM + wr * 64 + fr, col0 = u.pn * BM + wc * 32 + 4 * fq;
        const int which = (u.pm < 32) ? 0 : (u.pm < 64 ? 1 : 2);
        const float* mg = mod + (size_t)which * 12288 + 2 * 2048 + col0;
        f32x4 gv[2][2];
#pragma unroll
        for (int bj = 0; bj < 2; ++bj)
#pragma unroll
            for (int n = 0; n < 2; ++n) gv[bj][n] = *(const f32x4*)(mg + bj * HALF + n * 16);
#pragma unroll
        for (int ai = 0; ai < 2; ++ai) {
            f32x4 xin[4][2][2];
#pragma unroll
            for (int m = 0; m < 4; ++m)
#pragma unroll
                for (int bj = 0; bj < 2; ++bj)
#pragma unroll
                    for (int n = 0; n < 2; ++n) xin[m][bj][n] = *(const f32x4*)(Xin + (size_t)(row0 + ai * HALF + m * 16) * 2048 + col0 + bj * HALF + n * 16);
#pragma unroll
            for (int m = 0; m < 4; ++m)
#pragma unroll
                for (int bj = 0; bj < 2; ++bj)
#pragma unroll
                    for (int n = 0; n < 2; ++n) *(f32x4*)(X + (size_t)(row0 + ai * HALF + m * 16) * 2048 + col0 + bj * HALF + n * 16) = xin[m][bj][n] + gv[bj][n] * acc[ai][bj][m][n];
        }
    }
};
}

__device__ __forceinline__ int proj_src_col(int n) {
    if (n < 1024) return 7200 + n;
    if (n < 2048) return n - 1024;
    if (n < 4096) return 1024 + (n - 2048);
    if (n < 6144) return 8224 + (n - 4096);
    if (n < 8192) return 16416 + (n - 6144);
    if (n < 10240) return 3104 + (n - 8192);
    if (n < 12288) return 5152 + (n - 10240);
    if (n < 14336) return 10272 + (n - 12288);
    if (n < 16384) return 12320 + (n - 14336);
    if (n < 18432) return 14368 + (n - 16384);
    return 18464 + (n - 18432);
}
__device__ __forceinline__ void phase_w(KP p, int l, LAS unsigned char* lds, int wid0) {
    const int tid = tid_fresh(wid0), G = gridDim.x, bid = blockIdx.x;
    unsigned char* ws = launder(p->ws);
    {
        LAS float* tile = (LAS float*)lds;
        const int NT_IN = NPROJ / 64;
        const int total = (NT_IN + 5 * 32) * 8;
        for (int t = bid; t < total; t += G) {
            const int ntile = t >> 3, kt = t & 7, k0 = kt * 256;
            const float* src; int ld; bf16_t* dst; float scale = 1.0f; int n0;
            bool to8 = false;
            if (ntile < NT_IN) { n0 = ntile * 64; src = p->w_in + (size_t)l * 2048 * PROJ_W + proj_src_col(n0); ld = PROJ_W;
                const int pnl = n0 >> 8; const bool isb = (pnl >= BF_LO && pnl < BF_HI) || (pnl >= 48 && pnl < 72);
                if (isb) { const int cpn = pnl < 48 ? pnl - BF_LO : pnl - 48 + (BF_HI - BF_LO); dst = (bf16_t*)(ws + WS_WINB) + (size_t)(cpn * 256 + (n0 & 255)) * 2048; if (n0 < 1024) scale = 0.08838834764831845f; }
                else { to8 = true; dst = (bf16_t*)(ws + WS_WIN); scale = (n0 < 1024) ? 1024.0f * 0.08838834764831845f : 1024.0f; } }
            else { const int mi = (ntile - NT_IN) >> 5; n0 = ((ntile - NT_IN) & 31) * 64;
                const float* m5 = mi == 0 ? p->w_a_out : mi == 1 ? p->w_b_out : mi == 2 ? p->w_c_out : mi == 3 ? p->w_out : p->peer_wq;
                src = m5 + (size_t)l * 2048 * 2048 + n0; ld = 2048;
                dst = (bf16_t*)(ws + WS_WA + (size_t)mi * SZ_W) + (size_t)n0 * 2048; }
            { const int kk = tid >> 4, n4 = (tid & 15) * 4;
              f32x4 v[8];
#pragma unroll
              for (int h = 0; h < 8; ++h) v[h] = *(const f32x4*)(src + (size_t)(k0 + kk + 32 * h) * ld + n4);
#pragma unroll
              for (int h = 0; h < 8; ++h) { LAS float* tp = tile + (kk + 32 * h) * 65 + n4; tp[0] = v[h][0]; tp[1] = v[h][1]; tp[2] = v[h][2]; tp[3] = v[h][3]; } }
            __syncthreads();
            { const int n = tid >> 3, kq = (tid & 7) * 8;
#pragma unroll
              for (int sub = 0; sub < 4; ++sub) { const int k8 = sub * 64 + kq; float v[8];
#pragma unroll
                  for (int j = 0; j < 8; ++j) v[j] = tile[(k8 + j) * 65 + n] * scale;
                  if (to8) {
#pragma unroll
                      for (int j = 0; j < 8; ++j) v[j] = fminf(fmaxf(v[j], -448.f), 448.f);
                      int d0 = 0, d1 = 0; d0 = __builtin_amdgcn_cvt_pk_fp8_f32(v[0], v[1], d0, false); d0 = __builtin_amdgcn_cvt_pk_fp8_f32(v[2], v[3], d0, true);
                      d1 = __builtin_amdgcn_cvt_pk_fp8_f32(v[4], v[5], d1, false); d1 = __builtin_amdgcn_cvt_pk_fp8_f32(v[6], v[7], d1, true);
                      u32x2 w8; w8.x = (unsigned)d0; w8.y = (unsigned)d1; *(u32x2*)((unsigned char*)dst + (size_t)(n0 + n) * 2048 + k0 + k8) = w8; }
                  else { u32x4 w; w.x = pk2(v[0], v[1]); w.y = pk2(v[2], v[3]); w.z = pk2(v[4], v[5]); w.w = pk2(v[6], v[7]);
                      *(u32x4*)(dst + (size_t)n * 2048 + k0 + k8) = w; } } }
            __syncthreads();
        }
    }
    const size_t gtid = (size_t)bid * NTHREADS + tid, gthreads = (size_t)G * NTHREADS;
    for (size_t i = gtid; i < 32 * 2048; i += gthreads) { const int n = (int)(i >> 11), k = (int)(i & 2047);
        ((bf16_t*)(ws + WS_WG))[i] = f2bf(p->w_in[(size_t)l * 2048 * PROJ_W + (size_t)k * PROJ_W + 3072 + n]); }
    {
        const float* su = p->peer_u + (size_t)l * 16384 * 2048; const float* sv = p->peer_v + (size_t)l * 16384 * 2048;
        unsigned char* du = ws + WS_PU; unsigned char* dv = ws + WS_PVW;
        const size_t n32 = (size_t)16384 * 2048 / 32;
        for (size_t i = gtid; i < n32; i += gthreads) {
#pragma unroll
            for (int t = 0; t < 2; ++t) {
                const float* sp = (t ? sv : su) + i * 32; const float sc = t ? 4.0f : 64.0f;
                u32x4 wv;
#pragma unroll
                for (int q = 0; q < 4; ++q) { const f32x4 a = *(const f32x4*)(sp + q * 8), b = *(const f32x4*)(sp + q * 8 + 4);
                    unsigned d = 0;
                    d = __builtin_amdgcn_cvt_scalef32_pk_fp4_f32(d, a[0] * sc, a[1] * sc, 1.0f, 0); d = __builtin_amdgcn_cvt_scalef32_pk_fp4_f32(d, a[2] * sc, a[3] * sc, 1.0f, 1);
                    d = __builtin_amdgcn_cvt_scalef32_pk_fp4_f32(d, b[0] * sc, b[1] * sc, 1.0f, 2); d = __builtin_amdgcn_cvt_scalef32_pk_fp4_f32(d, b[2] * sc, b[3] * sc, 1.0f, 3);
                    wv[q] = d; }
                *(u32x4*)((t ? dv : du) + i * 16) = wv;
            }
        }
        const float* sk = p->peer_keys + (size_t)l * 16 * 128 * 128; bf16_t* dk = (bf16_t*)(ws + WS_KEYS);
        for (size_t i = gtid; i < (size_t)16 * 128 * 128; i += gthreads) dk[i] = f2bf(sk[i]);
    }
    {
        float* mod = (float*)(ws + WS_MOD) + (size_t)l * 3 * 12288;
        const float* wa = p->w_ada + (size_t)l * 2048 * 12288; const float* ba = p->b_ada + (size_t)l * 12288;
        LAS float* part = (LAS float*)(lds + 69632);
        const int col = tid & 63, ks = tid >> 6;
        for (int t = bid; t < 256; t += G) {
            const int n = t * 48 + col;
            float a0 = 0.f, a1 = 0.f, a2 = 0.f;
            if (col < 48) {
#pragma unroll 8
                for (int k = ks * 256; k < ks * 256 + 256; ++k) {
                    const float w = wa[(size_t)k * 12288 + n];
                    const float c0 = p->c[k], c1 = p->c[2048 + k], c2 = p->c_ctx[k];
                    a0 += c0 * sigmoidf_(c0) * w; a1 += c1 * sigmoidf_(c1) * w; a2 += c2 * sigmoidf_(c2) * w;
                }
                part[(ks * 3 + 0) * 48 + col] = a0; part[(ks * 3 + 1) * 48 + col] = a1; part[(ks * 3 + 2) * 48 + col] = a2;
            }
            __syncthreads();
            if (tid < 144) { const int which = tid / 48, cc = tid - which * 48; float sacc = ba[t * 48 + cc];
#pragma unroll
                for (int q = 0; q < 8; ++q) sacc += part[(q * 3 + which) * 48 + cc];
                mod[(size_t)which * 12288 + t * 48 + cc] = sacc; }
            __syncthreads();
        }
    }
    if (l == 0) {
        float* tab = (float*)(ws + WS_TAB);
        for (size_t i = gtid; i < 4096; i += gthreads) { const int pos = (int)(i >> 5), j = (int)(i & 31);
            const float inv = powf(10000.0f, -(float)j / 32.0f); const float ang = (float)pos * inv;
            tab[i] = cosf(ang); tab[4096 + i] = sinf(ang); }
    }
}

__device__ __forceinline__ void phase_norm(KP p, int l, int which_norm, int nrows, int wid0) {
    const int tid = tid_fresh(wid0); const int lane = tid & 63, gw = blockIdx.x * 8 + (tid >> 6), nw = gridDim.x * 8;
    unsigned char* ws = launder(p->ws);
    const float* X = (const float*)(ws + WS_X); bf16_t* XN = (bf16_t*)(ws + WS_XN);
    const float* mod = (const float*)(ws + WS_MOD) + (size_t)l * 3 * 12288;
    const float* g = p->norm_g + (size_t)(l * 2 + which_norm) * 2048;
    const int shift_c = which_norm ? 3 : 0, scale_c = which_norm ? 4 : 1;
    for (int row = gw; row < nrows; row += nw) {
        const int which = row < NLAT ? (row >> 13) : 2;
        const float* xr = (l == 0 && which_norm == 0) ? (row < NLAT ? p->x + (size_t)row * 2048 : p->ctx + (size_t)(row - NLAT) * 2048) : X + (size_t)row * 2048;
        const float* mb = mod + (size_t)which * 12288;
        f32x4 v[8]; float ss = 0.f;
#pragma unroll
        for (int i = 0; i < 8; ++i) { v[i] = *(const f32x4*)(xr + i * 256 + lane * 4); ss += v[i][0] * v[i][0] + v[i][1] * v[i][1] + v[i][2] * v[i][2] + v[i][3] * v[i][3]; }
        ss = wave_sum(ss);
        const float rstd = rsqrtf(ss * (1.0f / 2048.0f) + EPSF);
        f32x4 ggv[8], shv[8], scv[8];
#pragma unroll
        for (int i = 0; i < 8; ++i) { const int c = i * 256 + lane * 4; ggv[i] = *(const f32x4*)(g + c); shv[i] = *(const f32x4*)(mb + shift_c * 2048 + c); scv[i] = *(const f32x4*)(mb + scale_c * 2048 + c); }
#pragma unroll
        for (int i = 0; i < 8; ++i) { const int c = i * 256 + lane * 4;
            const f32x4 gg = ggv[i], sh = shv[i], sc = scv[i];
            float o[4];
#pragma unroll
            for (int j = 0; j < 4; ++j) o[j] = v[i][j] * rstd * gg[j] * (1.0f + sc[j]) + sh[j];
            u32x2 w; w.x = pk2(o[0], o[1]); w.y = pk2(o[2], o[3]); *(u32x2*)(XN + (size_t)row * 2048 + c) = w;
            if (which_norm == 0) { int d = 0; d = __builtin_amdgcn_cvt_pk_fp8_f32(fminf(fmaxf(o[0], -448.f), 448.f), fminf(fmaxf(o[1], -448.f), 448.f), d, false);
                d = __builtin_amdgcn_cvt_pk_fp8_f32(fminf(fmaxf(o[2], -448.f), 448.f), fminf(fmaxf(o[3], -448.f), 448.f), d, true); *(unsigned*)(ws + WS_XN8 + (size_t)row * 2048 + c) = (unsigned)d; } }
    }
}

__device__ __forceinline__ void phase_gates_gemm(KP p, int l, int wid0) {
    const int tid = tid_fresh(wid0); const int lane = tid & 63, gw = blockIdx.x * 8 + (tid >> 6), nw = gridDim.x * 8;
    unsigned char* ws = launder(p->ws);
    const bf16_t* XN = (const bf16_t*)(ws + WS_XN); const bf16_t* WG = (const bf16_t*)(ws + WS_WG); float* GA = (float*)(ws + WS_GATES);
    const int q4 = lane >> 4, c = lane & 15;
    const float gb0 = p->a_gate_b[l * 32 + c], gb1 = p->a_gate_b[l * 32 + 16 + c];
    for (int task = gw; task < MR / 16; task += nw) {
        const int r0 = task * 16;
        f32x4 acc0 = {0.f, 0.f, 0.f, 0.f}, acc1 = {0.f, 0.f, 0.f, 0.f};
        const bf16_t* ap = XN + (size_t)(r0 + c) * 2048 + 8 * q4; const bf16_t* b0 = WG + (size_t)c * 2048 + 8 * q4; const bf16_t* b1 = b0 + 16 * 2048;
#pragma unroll 4
        for (int ks = 0; ks < 64; ++ks) { const bf16x8 a = *(const bf16x8*)(ap + ks * 32), x0 = *(const bf16x8*)(b0 + ks * 32), x1 = *(const bf16x8*)(b1 + ks * 32);
            acc0 = mfma16(a, x0, acc0); acc1 = mfma16(a, x1, acc1); }
#pragma unroll
        for (int r = 0; r < 4; ++r) {
            const float v0 = acc0[r] + gb0, v1 = acc1[r] + gb1;
            GA[(size_t)(r0 + 4 * q4 + r) * 32 + c] = (c >= 8) ? logsigmoidf_(v0) : v0; GA[(size_t)(r0 + 4 * q4 + r) * 32 + 16 + c] = (c >= 8) ? logsigmoidf_(v1) : v1; }
    }
}

__device__ __forceinline__ void phase_e1(KP p, int l, int wid0) {
    const int tid = tid_fresh(wid0); const int lane = tid & 63, gw = blockIdx.x * 8 + (tid >> 6), nw = gridDim.x * 8;
    unsigned char* ws = launder(p->ws);
    bf16_t* PQ = (bf16_t*)(ws + WS_PQ); bf16_t* PK = (bf16_t*)(ws + WS_PK); bf16_t* CQ = (bf16_t*)(ws + WS_CQ); bf16_t* CK = (bf16_t*)(ws + WS_CK);
    bf16_t* BB = (bf16_t*)(ws + WS_BB); const bf16_t* BC = (const bf16_t*)(ws + WS_BC); const bf16_t* BX = (const bf16_t*)(ws + WS_BX);
    float* GA = (float*)(ws + WS_GATES); const float* tab = (const float*)(ws + WS_TAB);
    const float* gq = p->c_qk_g + (size_t)(l * 2 + 0) * 128; const float* gk = p->c_qk_g + (size_t)(l * 2 + 1) * 128;
    const float* cw = p->b_conv + (size_t)l * 3 * 2048;
    float gqv[8], gkv[8];
#pragma unroll
    for (int j = 0; j < 8; ++j) { gqv[j] = gq[(lane & 15) * 8 + j] * 0.08838834764831845f; gkv[j] = gk[(lane & 15) * 8 + j]; }
    const int nitems = NLAT / 8 + NCTX;
    for (int item = gw; item < nitems; item += nw) {
        const int row_first = item < NLAT / 8 ? item * 8 : NLAT + (item - NLAT / 8), nrun = item < NLAT / 8 ? 8 : 1;
        for (int rr = 0; rr < nrun; ++rr) { const int row = row_first + rr;
        if (row < NLAT) {
            const int s = row & 8191, gr = s >> 6, gc = s & 63;
#pragma unroll
            for (int it = 0; it < 2; ++it) {
                const int unit = it * 64 + lane, h = unit >> 4, hf = (unit >> 3) & 1, j4 = unit & 7;
                const int off = h * 128 + hf * 64 + j4 * 4, pos = hf ? gc : gr;
                const f32x4 cs = *(const f32x4*)(tab + pos * 32 + j4 * 4), sn = *(const f32x4*)(tab + 4096 + pos * 32 + j4 * 4);
#pragma unroll
                for (int tsel = 0; tsel < 2; ++tsel) { bf16_t* T = (tsel ? PK : PQ) + (size_t)row * 1024 + off;
                    const u32x2 u1 = *(const u32x2*)T, u2 = *(const u32x2*)(T + 32);
                    const float a0 = bflo(u1.x), a1 = bfhi(u1.x), a2 = bflo(u1.y), a3 = bfhi(u1.y), b0 = bflo(u2.x), b1 = bfhi(u2.x), b2 = bflo(u2.y), b3 = bfhi(u2.y);
                    u32x2 o1, o2;
                    o1.x = pk2(a0 * cs[0] - b0 * sn[0], a1 * cs[1] - b1 * sn[1]); o1.y = pk2(a2 * cs[2] - b2 * sn[2], a3 * cs[3] - b3 * sn[3]);
                    o2.x = pk2(b0 * cs[0] + a0 * sn[0], b1 * cs[1] + a1 * sn[1]); o2.y = pk2(b2 * cs[2] + a2 * sn[2], b3 * cs[3] + a3 * sn[3]);
                    *(u32x2*)T = o1; *(u32x2*)(T + 32) = o2; }
            }
        }
#pragma unroll
        for (int tsel = 0; tsel < 2; ++tsel) {
            bf16_t* T = (tsel ? CK : CQ) + (size_t)row * 2048;
            u32x4 wq4[4];
#pragma unroll
            for (int ps = 0; ps < 4; ++ps) wq4[ps] = *(const u32x4*)(T + ps * 512 + lane * 8);
#pragma unroll
            for (int ps = 0; ps < 4; ++ps) {
                const u32x4 w = wq4[ps];
                float v[8] = {bflo(w.x), bfhi(w.x), bflo(w.y), bfhi(w.y), bflo(w.z), bfhi(w.z), bflo(w.w), bfhi(w.w)};
                float ss = 0.f;
#pragma unroll
                for (int j = 0; j < 8; ++j) ss += v[j] * v[j];
                ss += __shfl_xor(ss, 1); ss += __shfl_xor(ss, 2); ss += __shfl_xor(ss, 4); ss += __shfl_xor(ss, 8);
                const float rstd = rsqrtf(ss * (1.0f / 128.0f) + EPSF);
#pragma unroll
                for (int j = 0; j < 8; ++j) v[j] = v[j] * rstd * (tsel ? gkv[j] : gqv[j]);
                u32x4 o; o.x = pk2(v[0], v[1]); o.y = pk2(v[2], v[3]); o.z = pk2(v[4], v[5]); o.w = pk2(v[6], v[7]);
                *(u32x4*)(T + ps * 512 + lane * 8) = o;
            }
        }
        }
        {
            int pos0, len; if (row_first < NLAT) { pos0 = row_first & 8191; len = SEQ; } else { pos0 = (row_first - NLAT) & 255; len = CTXL; }
#pragma unroll 1
            for (int ps = 0; ps < 4; ++ps) {
                const int c = ps * 512 + lane * 8;
                float w0[8], w1[8], w2[8];
#pragma unroll
                for (int hq = 0; hq < 2; ++hq) { const f32x4 a = *(const f32x4*)(cw + c + hq * 4), bq = *(const f32x4*)(cw + 2048 + c + hq * 4), cq = *(const f32x4*)(cw + 4096 + c + hq * 4);
#pragma unroll
                    for (int j = 0; j < 4; ++j) { w0[hq * 4 + j] = a[j]; w1[hq * 4 + j] = bq[j]; w2[hq * 4 + j] = cq[j]; } }
                u32x4 cvr[10], xvr[10], bbr[8];
                const u32x4 zero4 = {0u, 0u, 0u, 0u};
#pragma unroll
                for (int k = 0; k < 10; ++k) { const int rel = k - 1; const bool ok = (rel <= nrun) && (pos0 + rel >= 0) && (pos0 + rel < len) && (rel < nrun || pos0 + rel < len);
                    if (ok && rel <= nrun) { const size_t o = (size_t)(row_first + rel) * 2048 + c; cvr[k] = *(const u32x4*)(BC + o); xvr[k] = *(const u32x4*)(BX + o); } else { cvr[k] = zero4; xvr[k] = zero4; } }
#pragma unroll
                for (int rr = 0; rr < 8; ++rr) bbr[rr] = (rr < nrun) ? *(const u32x4*)(BB + (size_t)(row_first + rr) * 2048 + c) : zero4;
                float up[8], uc[8], un[8];
                auto mk_u = [&](const u32x4 cv, const u32x4 xv, float (&u)[8]) {
                    u[0] = bflo(cv.x) * bflo(xv.x); u[1] = bfhi(cv.x) * bfhi(xv.x); u[2] = bflo(cv.y) * bflo(xv.y); u[3] = bfhi(cv.y) * bfhi(xv.y);
                    u[4] = bflo(cv.z) * bflo(xv.z); u[5] = bfhi(cv.z) * bfhi(xv.z); u[6] = bflo(cv.w) * bflo(xv.w); u[7] = bfhi(cv.w) * bfhi(xv.w); };
                mk_u(cvr[0], xvr[0], up); mk_u(cvr[1], xvr[1], uc);
#pragma unroll
                for (int rr = 0; rr < 8; ++rr) {
                    if (rr < nrun) {
                        mk_u(cvr[rr + 2], xvr[rr + 2], un);
                        const size_t o = (size_t)(row_first + rr) * 2048 + c; const u32x4 bb = bbr[rr];
                        const float bv[8] = {bflo(bb.x), bfhi(bb.x), bflo(bb.y), bfhi(bb.y), bflo(bb.z), bfhi(bb.z), bflo(bb.w), bfhi(bb.w)};
                        float y[8];
#pragma unroll
                        for (int j = 0; j < 8; ++j) y[j] = bv[j] * (up[j] * w0[j] + uc[j] * w1[j] + un[j] * w2[j]);
                        u32x4 ov; ov.x = pk2(y[0], y[1]); ov.y = pk2(y[2], y[3]); ov.z = pk2(y[4], y[5]); ov.w = pk2(y[6], y[7]);
                        *(u32x4*)(BB + o) = ov;
#pragma unroll
                        for (int j = 0; j < 8; ++j) { up[j] = uc[j]; uc[j] = un[j]; }
                    }
                }
            }
        }
    }
}

constexpr int ML_QS = 0, ML_KS = 17408, ML_VT = 53248, ML_SS = 60160, ML_CT = 69376, ML_CTSZ = 13056;
__device__ __forceinline__ int ml_row(int pp, int b, int dir) {
    if (pp < 256) { const int j = dir ? 255 - pp : pp; return NLAT + b * 256 + j; }
    int s = pp - 256; if (dir) s = 8191 - s; return b * 8192 + s;
}
__device__ __forceinline__ void phase_mlstm(KP p, int l, LAS unsigned char* lds, int wid0) {
    const int tid = tid_fresh(wid0), lane = tid & 63, w = __builtin_amdgcn_readfirstlane(tid >> 6), q4 = lane >> 4, c16 = lane & 15;
    unsigned char* ws = launder(p->ws);
    const bf16_t* PQ = (const bf16_t*)(ws + WS_PQ); const bf16_t* PK = (const bf16_t*)(ws + WS_PK); const bf16_t* PV = (const bf16_t*)(ws + WS_PV);
    const float* GA = (const float*)(ws + WS_GATES);
    for (int task = blockIdx.x; task < 256; task += gridDim.x) {
        const int xq = task & 7, yq = task >> 3; const int bh = 2 * xq + (yq >> 4), dir = (yq >> 3) & 1, sl = yq & 7; const int b = bh >> 3, h = bh & 7;
        bf16_t* H = (bf16_t*)(ws + (dir ? WS_BX : WS_BC));
        float* SCN = (float*)(ws + WS_SCAN) + (size_t)task * 3 * 8448;
        __syncthreads();
        for (int cc = w; cc < 132; cc += 8) {
            const int r = ml_row(cc * 64 + lane, b, dir);
            const float li = GA[(size_t)r * 32 + (2 * dir) * 8 + h], lf = GA[(size_t)r * 32 + (2 * dir + 1) * 8 + h];
            float bc = lf;
#pragma unroll
            for (int o = 1; o < 64; o <<= 1) { const float t = __shfl_up(bc, o); if (lane >= o) bc += t; }
            const float a = li - bc;
            float pm = a;
#pragma unroll
            for (int o = 1; o < 64; o <<= 1) { const float t = __shfl_up(pm, o); if (lane >= o) pm = fmaxf(pm, t); }
            SCN[cc * 64 + lane] = bc; SCN[8448 + cc * 64 + lane] = a; SCN[2 * 8448 + cc * 64 + lane] = pm;
        }
        for (int i = tid; i < 16 * 32; i += NTHREADS) { const int r = 32 + (i >> 5), cdw = i & 31; *(LAS unsigned*)(lds + ML_VT + r * 144 + cdw * 4) = (r == 32) ? 0x3f803f80u : 0u; }
        for (int i = tid; i < 2 * ML_CTSZ / 4; i += NTHREADS) *(LAS unsigned*)(lds + ML_CT + i * 4) = 0u;
        __syncthreads();
        float m = 0.f;
        f32x4 Cst[3];
#pragma unroll
        for (int i = 0; i < 3; ++i) Cst[i] = (f32x4){0.f, 0.f, 0.f, 0.f};
        u32x4 qreg[2], kreg[2], vreg; float bc, a, pm;
        const int qrow_l = lane >> 4, qpc = lane & 15, vrow_l = lane >> 2, vpc = lane & 3;
        {
#pragma unroll
          for (int i = 0; i < 2; ++i) { const int r = ml_row(8 * w + 4 * i + qrow_l, b, dir);
              qreg[i] = *(const u32x4*)(PQ + (size_t)r * 1024 + h * 128 + qpc * 8); kreg[i] = *(const u32x4*)(PK + (size_t)r * 1024 + h * 128 + qpc * 8); }
          if (w < 4) { const int r = ml_row(16 * w + vrow_l, b, dir); vreg = *(const u32x4*)(PV + (size_t)r * 2048 + h * 256 + sl * 32 + vpc * 8); }
          bc = SCN[lane]; a = SCN[8448 + lane]; pm = SCN[2 * 8448 + lane]; }
        for (int c = 0; c < 132; ++c) {
            const float total = __uint_as_float((unsigned)__builtin_amdgcn_readlane((int)__float_as_uint(bc), 63)), pmall = __uint_as_float((unsigned)__builtin_amdgcn_readlane((int)__float_as_uint(pm), 63));
            const float mx = fmaxf(m, pm);
            const float mrow = bc + mx;
            const float winter = __expf(m - mx);
            const float m_new = total + fmaxf(m, pmall);
            const float decay = __expf(total + m - m_new);
            const float kscale = __expf(total + a - m_new);
            const float mref = fmaxf(m, pmall);
            const float ea_cur = __expf(a - mref), em_cur = __expf(mref - mx), emr_cur = __expf(-mrow);
#pragma unroll
            for (int i = 0; i < 2; ++i) { const int sr = 8 * w + 4 * i + qrow_l;
                *(LAS u32x4*)(lds + ML_QS + sr * 272 + qpc * 16) = qreg[i];
                *(LAS u32x4*)(lds + ML_KS + sr * 272 + qpc * 16) = kreg[i]; }
            if (w < 4) { const unsigned vw[4] = {vreg.x, vreg.y, vreg.z, vreg.w}; const int sv = 16 * w + vrow_l;
#pragma unroll
                for (int j = 0; j < 4; ++j) { const int e = vpc * 8 + 2 * j;
                    *(LAS bf16_t*)(lds + ML_VT + e * 144 + sv * 2) = (bf16_t)(vw[j] & 0xffffu);
                    *(LAS bf16_t*)(lds + ML_VT + (e + 1) * 144 + sv * 2) = (bf16_t)(vw[j] >> 16); } }
            if (w == 1) *(LAS float*)(lds + ML_SS + 256 + lane * 4) = kscale;
            if (c + 1 < 132) { const int p0 = (c + 1) * 64;
#pragma unroll
                for (int i = 0; i < 2; ++i) { const int r = ml_row(p0 + 8 * w + 4 * i + qrow_l, b, dir);
                    qreg[i] = *(const u32x4*)(PQ + (size_t)r * 1024 + h * 128 + qpc * 8); kreg[i] = *(const u32x4*)(PK + (size_t)r * 1024 + h * 128 + qpc * 8); }
                if (w < 4) { const int r = ml_row(p0 + 16 * w + vrow_l, b, dir); vreg = *(const u32x4*)(PV + (size_t)r * 2048 + h * 256 + sl * 32 + vpc * 8); }
                bc = SCN[p0 + lane]; a = SCN[8448 + p0 + lane]; pm = SCN[2 * 8448 + p0 + lane]; }
            if (w == 0) *(LAS float*)(lds + ML_SS + lane * 4) = ea_cur;
            LDS_BARRIER();
            {
                const int tr = w >> 1, part = w & 1;
                const LAS unsigned char* CTc = lds + ML_CT + (c & 1) * ML_CTSZ;
                bf16x8 aq[4];
#pragma unroll
                for (int ks = 0; ks < 4; ++ks) aq[ks] = *(const LAS bf16x8*)(lds + ML_QS + (16 * tr + c16) * 272 + (ks * 32 + 8 * q4) * 2);
                float wi_t[4], emr_t[4];
#pragma unroll
                for (int r = 0; r < 4; ++r) { const int t = 16 * tr + 4 * q4 + r; wi_t[r] = __shfl(winter, t); emr_t[r] = __shfl(emr_cur, t); }
                f32x4 accA = {0.f, 0.f, 0.f, 0.f}, accD = {0.f, 0.f, 0.f, 0.f};
#pragma unroll
                for (int ks = 0; ks < 4; ++ks) {
                    const bf16x8 b1 = *(const LAS bf16x8*)(CTc + (16 * part + c16) * 272 + (ks * 32 + 8 * q4) * 2);
                    const bf16x8 b2 = *(const LAS bf16x8*)(CTc + (32 + c16) * 272 + (ks * 32 + 8 * q4) * 2);
                    accA = mfma16(aq[ks], b1, accA); accD = mfma16(aq[ks], b2, accD); }
#pragma unroll
                for (int r = 0; r < 4; ++r) { accA[r] *= wi_t[r]; accD[r] *= wi_t[r]; }
                const int tq = 16 * tr + c16;
                const float emq = __shfl(em_cur, tq);
#pragma unroll
                for (int kk = 0; kk < 2; ++kk) {
                    if (2 * kk <= tr) {
                        f32x4 s0 = {0.f, 0.f, 0.f, 0.f}, s1 = {0.f, 0.f, 0.f, 0.f};
#pragma unroll
                        for (int ks = 0; ks < 4; ++ks) { const bf16x8 ka = *(const LAS bf16x8*)(lds + ML_KS + (32 * kk + c16) * 272 + (ks * 32 + 8 * q4) * 2); s0 = mfma16(ka, aq[ks], s0); }
                        if (2 * kk + 1 <= tr) {
#pragma unroll
                            for (int ks = 0; ks < 4; ++ks) { const bf16x8 ka = *(const LAS bf16x8*)(lds + ML_KS + (32 * kk + 16 + c16) * 272 + (ks * 32 + 8 * q4) * 2); s1 = mfma16(ka, aq[ks], s1); }
                        }
                        const f32x4 a0 = *(const LAS f32x4*)(lds + ML_SS + (32 * kk + 4 * q4) * 4), a1 = *(const LAS f32x4*)(lds + ML_SS + (32 * kk + 16 + 4 * q4) * 4);
                        float pe[8];
#pragma unroll
                        for (int r = 0; r < 4; ++r) { const int sp0 = 32 * kk + 4 * q4 + r, sp1 = sp0 + 16;
                            pe[r] = (sp0 <= tq) ? s0[r] * (a0[r] * emq) : 0.f; pe[4 + r] = (sp1 <= tq) ? s1[r] * (a1[r] * emq) : 0.f; }
                        u32x4 pw; pw.x = pk2(pe[0], pe[1]); pw.y = pk2(pe[2], pe[3]); pw.z = pk2(pe[4], pe[5]); pw.w = pk2(pe[6], pe[7]);
                        const bf16x8 pf = __builtin_bit_cast(bf16x8, pw);
                        const u32x2 v1l = *(const LAS u32x2*)(lds + ML_VT + (16 * part + c16) * 144 + (32 * kk + 4 * q4) * 2), v1h = *(const LAS u32x2*)(lds + ML_VT + (16 * part + c16) * 144 + (32 * kk + 16 + 4 * q4) * 2);
                        const u32x2 v2l = *(const LAS u32x2*)(lds + ML_VT + (32 + c16) * 144 + (32 * kk + 4 * q4) * 2), v2h = *(const LAS u32x2*)(lds + ML_VT + (32 + c16) * 144 + (32 * kk + 16 + 4 * q4) * 2);
                        u32x4 bw1, bw2; bw1.x = v1l.x; bw1.y = v1l.y; bw1.z = v1h.x; bw1.w = v1h.y; bw2.x = v2l.x; bw2.y = v2l.y; bw2.z = v2h.x; bw2.w = v2h.y;
                        accA = mfma16(pf, __builtin_bit_cast(bf16x8, bw1), accA); accD = mfma16(pf, __builtin_bit_cast(bf16x8, bw2), accD);
                    }
                }
                if (l == 0 || c >= 4) {
                    const int hrow0 = ml_row(c * 64, b, dir), hsgn = dir ? -1 : 1;
#pragma unroll
                    for (int r = 0; r < 4; ++r) {
                        const float den = __shfl(accD[r], lane & 48);
                        const float hv = accA[r] * __builtin_amdgcn_rcpf(fmaxf(fabsf(den), emr_t[r]));
                        const int t = 16 * tr + 4 * q4 + r; const int row = hrow0 + hsgn * t;
                        H[(size_t)row * 2048 + h * 256 + sl * 32 + 16 * part + c16] = f2bf(hv);
                    }
                }
            }
            {
                LAS unsigned char* CTn = lds + ML_CT + ((c + 1) & 1) * ML_CTSZ;
                bf16x8 ak[2];
#pragma unroll
                for (int k2 = 0; k2 < 2; ++k2) {
                    const f32x4 sc0 = *(const LAS f32x4*)(lds + ML_SS + 256 + (k2 * 32 + 8 * q4) * 4), sc1 = *(const LAS f32x4*)(lds + ML_SS + 256 + (k2 * 32 + 8 * q4 + 4) * 4);
                    const s16x4 t0 = __builtin_amdgcn_ds_read_tr16_b64_v4i16((LAS s16x4*)(lds + ML_KS + (k2 * 32 + 8 * q4 + (c16 >> 2)) * 272 + (16 * w + 4 * (c16 & 3)) * 2));
                    const s16x4 t1 = __builtin_amdgcn_ds_read_tr16_b64_v4i16((LAS s16x4*)(lds + ML_KS + (k2 * 32 + 8 * q4 + 4 + (c16 >> 2)) * 272 + (16 * w + 4 * (c16 & 3)) * 2));
                    const u32x2 u0 = __builtin_bit_cast(u32x2, t0), u1 = __builtin_bit_cast(u32x2, t1);
                    u32x4 kw; kw.x = pk2(bflo(u0.x) * sc0[0], bfhi(u0.x) * sc0[1]); kw.y = pk2(bflo(u0.y) * sc0[2], bfhi(u0.y) * sc0[3]);
                    kw.z = pk2(bflo(u1.x) * sc1[0], bfhi(u1.x) * sc1[1]); kw.w = pk2(bflo(u1.y) * sc1[2], bfhi(u1.y) * sc1[3]);
                    ak[k2] = __builtin_bit_cast(bf16x8, kw);
                }
#pragma unroll
                for (int ct = 0; ct < 3; ++ct) {
                    Cst[ct] = Cst[ct] * decay;
#pragma unroll
                    for (int k2 = 0; k2 < 2; ++k2) { const bf16x8 bv = *(const LAS bf16x8*)(lds + ML_VT + (16 * ct + c16) * 144 + (k2 * 32 + 8 * q4) * 2); Cst[ct] = mfma16(ak[k2], bv, Cst[ct]); }
                    u32x2 o; o.x = pk2(Cst[ct][0], Cst[ct][1]); o.y = pk2(Cst[ct][2], Cst[ct][3]);
                    *(LAS u32x2*)(CTn + (16 * ct + c16) * 272 + (16 * w + 4 * q4) * 2) = o;
                }
            }
            m = m_new;
            LDS_BARRIER();
        }
    }
}

constexpr int AT_KS = 0, AT_VS = 17408, AT_RPB = 35840;
__device__ __forceinline__ void phase_attn(KP p, int l, LAS unsigned char* lds, int wid0) {
    const int tid = tid_fresh(wid0), lane = tid & 63, w = __builtin_amdgcn_readfirstlane(tid >> 6), q4 = lane >> 4, c16 = lane & 15;
    unsigned char* ws = launder(p->ws);
    bf16_t* CQ = (bf16_t*)(ws + WS_CQ); const bf16_t* CK = (const bf16_t*)(ws + WS_CK); const bf16_t* CV = (const bf16_t*)(ws + WS_CV);
    const int nunits = 2048 + (l == 0 ? 64 : 0);
    for (int u = blockIdx.x; u < nunits; u += gridDim.x) {
        int b, h, qrow = 0, g = 0, ntl = 0, r0a = 0, qbase;  bool is_ctx = u >= 2048;
        if (!is_ctx) { b = u >> 10; h = (u >> 6) & 15; const int rp = u & 63; qrow = 2 * rp + (w >> 2); g = w & 3;
            r0a = min(max(2 * rp - 4, 0), 120); const int r0b = min(max(2 * rp + 1 - 4, 0), 120); ntl = r0b + 8 - r0a;
            qbase = b * 8192 + qrow * 64 + 16 * g; }
        else { const int uu = u - 2048; b = uu >> 5; h = (uu >> 1) & 15; qbase = NLAT + b * 256 + (uu & 1) * 128 + 16 * w; }
        const int r0q = min(max(qrow - 4, 0), 120);
        const int a_g = (g == 0) ? 0 : (g == 1 ? 8 : (g == 2 ? 24 : 32));
        __syncthreads();
        if (!is_ctx) for (int i = tid; i < 465; i += NTHREADS) *(LAS float*)(lds + AT_RPB + i * 4) = p->c_rpb[((size_t)l * 16 + h) * 465 + i];
        bf16x8 qf[4];
#pragma unroll
        for (int ks = 0; ks < 4; ++ks) qf[ks] = *(const bf16x8*)(CQ + (size_t)(qbase + c16) * 2048 + h * 128 + ks * 32 + 8 * q4);
        f32x4 O[8];
#pragma unroll
        for (int i = 0; i < 8; ++i) O[i] = (f32x4){0.f, 0.f, 0.f, 0.f};
        float m_run = -1e30f, l_run = 0.f;
        const int ntiles = ntl + 4;
        u32x4 kreg[2], vreg[2];
        auto tile_row = [&](int t, int key) -> int { return (t < ntl) ? (b * 8192 + (r0a + t) * 64 + key) : (NLAT + b * 256 + (t - ntl) * 64 + key); };
        const int krow_l = lane >> 4, kpc = lane & 15;
        {
#pragma unroll
          for (int i = 0; i < 2; ++i) { const int r = tile_row(0, 8 * w + 4 * i + krow_l); kreg[i] = *(const u32x4*)(CK + (size_t)r * 2048 + h * 128 + kpc * 8); vreg[i] = *(const u32x4*)(CV + (size_t)r * 2048 + h * 128 + kpc * 8); } }
        for (int t = 0; t < ntiles; ++t) {
            LDS_BARRIER();
#pragma unroll
            for (int i = 0; i < 2; ++i) { const int key = 8 * w + 4 * i + krow_l;
                *(LAS u32x4*)(lds + AT_KS + key * 272 + kpc * 16) = kreg[i];
                *(LAS u32x4*)(lds + AT_VS + key * 288 + kpc * 16) = vreg[i]; }
            if (t + 1 < ntiles) {
#pragma unroll
                for (int i = 0; i < 2; ++i) { const int r = tile_row(t + 1, 8 * w + 4 * i + krow_l); kreg[i] = *(const u32x4*)(CK + (size_t)r * 2048 + h * 128 + kpc * 8); vreg[i] = *(const u32x4*)(CV + (size_t)r * 2048 + h * 128 + kpc * 8); } }
            LDS_BARRIER();
            const bool local = t < ntl; const int kr = r0a + t;
            if (local && !(kr >= r0q && kr < r0q + 8)) continue;
            const int npass = local ? 1 : 2;
            for (int ps = 0; ps < npass; ++ps) {
                const int a0 = local ? a_g : ps * 32;
                f32x4 sc[2];
#pragma unroll
                for (int ct = 0; ct < 2; ++ct) { sc[ct] = (f32x4){0.f, 0.f, 0.f, 0.f};
#pragma unroll
                    for (int ks = 0; ks < 4; ++ks) { const bf16x8 ka = *(const LAS bf16x8*)(lds + AT_KS + (a0 + 16 * ct + c16) * 272 + (ks * 32 + 8 * q4) * 2); sc[ct] = mfma16(ka, qf[ks], sc[ct]); } }
                if (local) {
                    const int qc = 16 * g + c16, col0 = min(max(qc - 8, 0), 48); const int dr = kr - qrow + 7;
#pragma unroll
                    for (int ct = 0; ct < 2; ++ct)
#pragma unroll
                        for (int r = 0; r < 4; ++r) { const int kc = a0 + 16 * ct + 4 * q4 + r; const bool valid = (kc >= col0) && (kc < col0 + 16);
                            const int dc = min(max(kc - qc + 15, 0), 30);
                            const float bias = *(const LAS float*)(lds + AT_RPB + (dr * 31 + dc) * 4);
                            sc[ct][r] = valid ? sc[ct][r] + bias : -1e30f; }
                }
                float mx = fmaxf(fmaxf(fmaxf(sc[0][0], sc[0][1]), fmaxf(sc[0][2], sc[0][3])), fmaxf(fmaxf(sc[1][0], sc[1][1]), fmaxf(sc[1][2], sc[1][3])));
                mx = fmaxf(mx, __shfl_xor(mx, 16)); mx = fmaxf(mx, __shfl_xor(mx, 32));
                const float m_new = fmaxf(m_run, mx);
                const float alpha = __expf(m_run - m_new);
                float pe[8]; float psum = 0.f;
#pragma unroll
                for (int ct = 0; ct < 2; ++ct)
#pragma unroll
                    for (int r = 0; r < 4; ++r) { const float e = __expf(sc[ct][r] - m_new); pe[ct * 4 + r] = e; psum += e; }
                psum += __shfl_xor(psum, 16); psum += __shfl_xor(psum, 32);
                l_run = l_run * alpha + psum; m_run = m_new;
                bf16x8 pf; { u32x4 pw; pw.x = pk2(pe[0], pe[1]); pw.y = pk2(pe[2], pe[3]); pw.z = pk2(pe[4], pe[5]); pw.w = pk2(pe[6], pe[7]); pf = __builtin_bit_cast(bf16x8, pw); }
                float al[4];
#pragma unroll
                for (int r = 0; r < 4; ++r) al[r] = __shfl(alpha, 4 * q4 + r);
#pragma unroll
                for (int dt = 0; dt < 8; ++dt) {
#pragma unroll
                    for (int r = 0; r < 4; ++r) O[dt][r] *= al[r];
                    const s16x4 lo = __builtin_amdgcn_ds_read_tr16_b64_v4i16((LAS s16x4*)(lds + AT_VS + (a0 + 4 * q4 + (c16 >> 2)) * 288 + (16 * dt + 4 * (c16 & 3)) * 2));
                    const s16x4 hi = __builtin_amdgcn_ds_read_tr16_b64_v4i16((LAS s16x4*)(lds + AT_VS + (a0 + 16 + 4 * q4 + (c16 >> 2)) * 288 + (16 * dt + 4 * (c16 & 3)) * 2));
                    const bf16x8 bw = __builtin_shufflevector(lo, hi, 0, 1, 2, 3, 4, 5, 6, 7);
                    O[dt] = mfma16(pf, bw, O[dt]);
                }
            }
        }
        float linv[4];
#pragma unroll
        for (int r = 0; r < 4; ++r) linv[r] = 1.0f / __shfl(l_run, 4 * q4 + r);
#pragma unroll
        for (int dt = 0; dt < 8; ++dt)
#pragma unroll
            for (int r = 0; r < 4; ++r) CQ[(size_t)(qbase + 4 * q4 + r) * 2048 + h * 128 + 16 * dt + c16] = f2bf(O[dt][r] * linv[r]);
    }
}

__device__ __forceinline__ void phase_e2(KP p, int l, int nrows, int wid0) {
    const int tid = tid_fresh(wid0); const int lane = tid & 63, gw = blockIdx.x * 8 + (tid >> 6), nw = gridDim.x * 8;
    unsigned char* ws = launder(p->ws);
    const bf16_t* HF = (const bf16_t*)(ws + WS_BC); const bf16_t* HB = (const bf16_t*)(ws + WS_BX); bf16_t* PO = (bf16_t*)(ws + WS_PO);
    const float* hg = p->a_hnorm_g + (size_t)l * 2048;
    for (int row = gw; row < nrows; row += nw) {
        u32x2 fv[8], bv[8], ovv[8];
#pragma unroll
        for (int h = 0; h < 8; ++h) { const size_t o = (size_t)row * 2048 + h * 256 + lane * 4; fv[h] = *(const u32x2*)(HF + o); bv[h] = *(const u32x2*)(HB + o); ovv[h] = *(const u32x2*)(PO + o); }
#pragma unroll
        for (int h = 0; h < 8; ++h) {
            const size_t o = (size_t)row * 2048 + h * 256 + lane * 4;
            const u32x2 f = fv[h], bb = bv[h], ov = ovv[h];
            float v[4] = {bflo(f.x) + bflo(bb.x), bfhi(f.x) + bfhi(bb.x), bflo(f.y) + bflo(bb.y), bfhi(f.y) + bfhi(bb.y)};
            float ss = v[0] * v[0] + v[1] * v[1] + v[2] * v[2] + v[3] * v[3];
            ss = wave_sum(ss);
            const float rstd = rsqrtf(ss * (1.0f / 256.0f) + EPSF);
            const f32x4 gg = *(const f32x4*)(hg + h * 256 + lane * 4);
            const float og[4] = {bflo(ov.x), bfhi(ov.x), bflo(ov.y), bfhi(ov.y)};
            float y[4];
#pragma unroll
            for (int j = 0; j < 4; ++j) y[j] = sigmoidf_(og[j]) * v[j] * rstd * gg[j];
            u32x2 wv; wv.x = pk2(y[0], y[1]); wv.y = pk2(y[2], y[3]); *(u32x2*)(PO + o) = wv;
        }
    }
}

template <int MODE>
__device__ __forceinline__ void ctx_gemm(KP p, int l, LAS unsigned char* lds, int wid0) {
    const int tid = tid_fresh(wid0); const int lane = tid & 63, w = __builtin_amdgcn_readfirstlane(tid >> 6), q4 = lane >> 4, c16 = lane & 15;
    unsigned char* ws = launder(p->ws);
    for (int task = blockIdx.x; task < (NCTX / 64) * 32; task += gridDim.x) {
        const int rg = task >> 5, cb = task & 31; const int row0 = NLAT + rg * 64, col0 = cb * 64;
        const int orow = row0 + (tid >> 3), ocol = col0 + (tid & 7) * 8;
        float yv[8];
#pragma unroll
        for (int i = 0; i < 8; ++i) yv[i] = 0.f;
#pragma unroll 1
        for (int br = 0; br < (MODE == 0 ? 3 : 1); ++br) {
            const bf16_t* A; const bf16_t* Bt;
            if (MODE == 0) { const int ti = 1 + 4 * (br == 1) + (br == 2); A = (const bf16_t*)(ws + WS_T8 + (size_t)ti * SZ_A); Bt = (const bf16_t*)(ws + WS_WA + (size_t)br * SZ_W); }
            else if (MODE == 1) { A = (const bf16_t*)(ws + WS_Y); Bt = (const bf16_t*)(ws + WS_WO); }
            else { A = (const bf16_t*)(ws + WS_XN); Bt = (const bf16_t*)(ws + WS_WQ); }
            const bf16_t* ap = A + (size_t)(row0 + c16) * 2048 + w * 256 + 8 * q4; const bf16_t* bp = Bt + (size_t)(col0 + c16) * 2048 + w * 256 + 8 * q4;
            f32x4 acc[4][4];
#pragma unroll
            for (int mi = 0; mi < 4; ++mi)
#pragma unroll
                for (int j = 0; j < 4; ++j) acc[mi][j] = (f32x4){0.f, 0.f, 0.f, 0.f};
#pragma unroll 2
            for (int ks = 0; ks < 8; ++ks) {
                bf16x8 a[4], bb[4];
#pragma unroll
                for (int mi = 0; mi < 4; ++mi) a[mi] = *(const bf16x8*)(ap + (size_t)mi * 16 * 2048 + ks * 32);
#pragma unroll
                for (int j = 0; j < 4; ++j) bb[j] = *(const bf16x8*)(bp + (size_t)j * 16 * 2048 + ks * 32);
#pragma unroll
                for (int mi = 0; mi < 4; ++mi)
#pragma unroll
                    for (int j = 0; j < 4; ++j) acc[mi][j] = mfma16(a[mi], bb[j], acc[mi][j]);
            }
            __syncthreads();
#pragma unroll
            for (int mi = 0; mi < 4; ++mi)
#pragma unroll
                for (int j = 0; j < 4; ++j)
#pragma unroll
                    for (int r = 0; r < 4; ++r) *(LAS float*)(lds + ((w * 64 + 16 * mi + 4 * q4 + r) * 64 + 16 * j + c16) * 4) = acc[mi][j][r];
            __syncthreads();
            float sv[8];
#pragma unroll
            for (int i = 0; i < 8; ++i) sv[i] = 0.f;
#pragma unroll
            for (int ww = 0; ww < 8; ++ww) { const f32x4 p0 = *(const LAS f32x4*)(lds + ((ww * 64 + (tid >> 3)) * 64 + (tid & 7) * 8) * 4), p1 = *(const LAS f32x4*)(lds + ((ww * 64 + (tid >> 3)) * 64 + (tid & 7) * 8 + 4) * 4);
                sv[0] += p0[0]; sv[1] += p0[1]; sv[2] += p0[2]; sv[3] += p0[3]; sv[4] += p1[0]; sv[5] += p1[1]; sv[6] += p1[2]; sv[7] += p1[3]; }
            if (MODE == 0) { const u32x4 g = *(const u32x4*)((const bf16_t*)(ws + WS_GT) + (size_t)orow * 6144 + (size_t)br * 2048 + ocol);
                yv[0] += sigmoidf_(bflo(g.x)) * sv[0]; yv[1] += sigmoidf_(bfhi(g.x)) * sv[1]; yv[2] += sigmoidf_(bflo(g.y)) * sv[2]; yv[3] += sigmoidf_(bfhi(g.y)) * sv[3];
                yv[4] += sigmoidf_(bflo(g.z)) * sv[4]; yv[5] += sigmoidf_(bfhi(g.z)) * sv[5]; yv[6] += sigmoidf_(bflo(g.w)) * sv[6]; yv[7] += sigmoidf_(bfhi(g.w)) * sv[7]; }
            else {
#pragma unroll
                for (int i = 0; i < 8; ++i) yv[i] = sv[i]; }
        }
        if (MODE == 1) { float* xp = (float*)(ws + WS_X) + (size_t)orow * 2048 + ocol; const float* xi = p->ctx + (size_t)(orow - NLAT) * 2048 + ocol; const float* mg = (const float*)(ws + WS_MOD) + (size_t)l * 3 * 12288 + 2 * 12288 + 2 * 2048 + ocol;
            const f32x4 x0 = *(const f32x4*)xi, x1 = *(const f32x4*)(xi + 4), g0 = *(const f32x4*)mg, g1 = *(const f32x4*)(mg + 4);
            f32x4 o0, o1; o0[0] = x0[0] + g0[0] * yv[0]; o0[1] = x0[1] + g0[1] * yv[1]; o0[2] = x0[2] + g0[2] * yv[2]; o0[3] = x0[3] + g0[3] * yv[3];
            o1[0] = x1[0] + g1[0] * yv[4]; o1[1] = x1[1] + g1[1] * yv[5]; o1[2] = x1[2] + g1[2] * yv[6]; o1[3] = x1[3] + g1[3] * yv[7];
            *(f32x4*)xp = o0; *(f32x4*)(xp + 4) = o1; }
        else { u32x4 ov; ov.x = pk2(yv[0], yv[1]); ov.y = pk2(yv[2], yv[3]); ov.z = pk2(yv[4], yv[5]); ov.w = pk2(yv[6], yv[7]);
            *(u32x4*)((bf16_t*)(ws + (MODE == 0 ? WS_Y : WS_PV)) + (size_t)orow * 2048 + ocol) = ov; }
    }
}

constexpr int PE_MAXT = 80;
constexpr int PE_IDX = 0, PE_W = PE_MAXT * 128 * 4, PE_SCR = 2 * PE_MAXT * 128 * 4, PE_SCRSZ = 16 * 132 * 4 + 4096 + 256;
__device__ __forceinline__ unsigned ordkey(float v) { const unsigned u = __float_as_uint(v); return (u & 0x80000000u) ? ~u : (u | 0x80000000u); }
__device__ __forceinline__ void phase_peer(KP p, int l, LAS unsigned char* lds, int wid0) {
    const int tid = tid_fresh(wid0), lane = tid & 63, w = __builtin_amdgcn_readfirstlane(tid >> 6), q4 = lane >> 4, c16 = lane & 15;
    unsigned char* ws = launder(p->ws);
    const bf16_t* QP = (const bf16_t*)(ws + WS_PV); const bf16_t* KEYS = (const bf16_t*)(ws + WS_KEYS);
    const bf16_t* XN = (const bf16_t*)(ws + WS_XN);
    float* X = (float*)(ws + WS_X); const float* mod = (const float*)(ws + WS_MOD) + (size_t)l * 3 * 12288;
    const int ntok = (l == 0) ? MR : NLAT, G = gridDim.x;
    const int per = (ntok + G - 1) / G; const int t_begin = blockIdx.x * per, t_end = min(ntok, t_begin + per);
    for (int tb = t_begin; tb < t_end; tb += PE_MAXT) {
        const int nt = min(PE_MAXT, t_end - tb);
        __syncthreads();
        const int ntask = (nt + 15) >> 4;
        if (w < ntask) {
            int lane_pe1 = lane; asm volatile("" : "+v"(lane_pe1));
            const int lane = lane_pe1, q4 = lane >> 4, c16 = lane & 15;
            LAS unsigned char* scr = lds + PE_SCR + w * PE_SCRSZ;
            LAS float* SC = (LAS float*)scr;
            LAS float* LS = (LAS float*)(scr + 16 * 132 * 4);
            LAS int* LI = (LAS int*)(scr + 16 * 132 * 4 + 2048);
            LAS unsigned char* PT = scr + 16 * 132 * 4 + 4096;
            if (lane < 52) {
                const int L = lane;
                const int ge16 = L >= 16, ge24 = L >= 24, ge29 = L >= 29, ge33 = L >= 33, ge36 = L >= 36, ge38 = L >= 38, ge40 = L >= 40, ge42 = L >= 42;
                int pa = ge16 + ge24 + ge29 + ge33 + ge36 + ge38 + ge40 + ge42; if (ge42) pa = 8 + (L - 42);
                int pb = L - (16 * ge16 + 8 * ge24 + 5 * ge29 + 4 * ge33 + 3 * ge36 + 2 * ge38 + 2 * ge40 + 2 * ge42); if (ge42) pb = 0;
                if (L >= 50) { pa = 15; pb = 15; }
                PT[lane * 2] = (unsigned char)pa; PT[lane * 2 + 1] = (unsigned char)pb;
            }
            const int tok_a = min(tb + 16 * w + c16, t_end - 1);
            const int tkl = lane >> 2, qq = lane & 3;
            for (int h = 0; h < 8; ++h) {
                for (int pp = 0; pp < 2; ++pp) {
                    const int hp = 2 * h + pp;
                    bf16x8 af[4];
#pragma unroll
                    for (int ks = 0; ks < 4; ++ks) af[ks] = *(const bf16x8*)(QP + (size_t)tok_a * 2048 + h * 256 + pp * 128 + ks * 32 + 8 * q4);
#pragma unroll 4
                    for (int ct = 0; ct < 8; ++ct) {
                        f32x4 acc = {0.f, 0.f, 0.f, 0.f};
#pragma unroll
                        for (int ks = 0; ks < 4; ++ks) { const bf16x8 bfr = *(const bf16x8*)(KEYS + ((size_t)hp * 128 + 16 * ct + c16) * 128 + ks * 32 + 8 * q4); acc = mfma16(af[ks], bfr, acc); }
#pragma unroll
                        for (int r = 0; r < 4; ++r) SC[(4 * q4 + r) * 132 + 16 * ct + c16] = acc[r];
                    }
                    asm volatile("s_waitcnt lgkmcnt(0)" ::: "memory");
                    unsigned key[32];
#pragma unroll
                    for (int i = 0; i < 8; ++i) { const f32x4 v = *(const LAS f32x4*)(SC + tkl * 132 + 32 * qq + 4 * i);
#pragma unroll
                        for (int j = 0; j < 4; ++j) key[4 * i + j] = (ordkey(v[j]) & ~127u) | (unsigned)(32 * qq + 4 * i + j); }
                    unsigned prev = 0xffffffffu;
#pragma unroll 1
                    for (int r = 0; r < 16; ++r) {
                        unsigned mxk = 0u;
#pragma unroll
                        for (int i = 0; i < 32; ++i) { const unsigned k = key[i] < prev ? key[i] : 0u; mxk = mxk > k ? mxk : k; }
                        unsigned o1 = __shfl_xor(mxk, 1); mxk = mxk > o1 ? mxk : o1; o1 = __shfl_xor(mxk, 2); mxk = mxk > o1 ? mxk : o1;
                        prev = mxk;
                        if (qq == (r & 3)) { const int idx = (int)(mxk & 127u); LS[(pp * 16 + tkl) * 16 + r] = SC[tkl * 132 + idx]; LI[(pp * 16 + tkl) * 16 + r] = idx; }
                    }
                    asm volatile("s_waitcnt lgkmcnt(0)" ::: "memory");
                }
                unsigned ck[13];
#pragma unroll
                for (int i = 0; i < 13; ++i) { const int cidx = qq + 4 * i;
                    if (cidx < 50) { const int a = PT[cidx * 2], bq = PT[cidx * 2 + 1]; const float sv = LS[(0 * 16 + tkl) * 16 + a] + LS[(1 * 16 + tkl) * 16 + bq]; ck[i] = (ordkey(sv) & ~63u) | (unsigned)cidx; }
                    else ck[i] = 0u; }
                unsigned prev = 0xffffffffu; float best0 = 0.f, esum = 0.f; float myexp[4] = {0.f, 0.f, 0.f, 0.f}; int myidx[4] = {0, 0, 0, 0};
#pragma unroll
                for (int r = 0; r < 16; ++r) {
                    unsigned mxk = 0u;
#pragma unroll
                    for (int i = 0; i < 13; ++i) { const unsigned k = ck[i] < prev ? ck[i] : 0u; mxk = mxk > k ? mxk : k; }
                    unsigned o1 = __shfl_xor(mxk, 1); mxk = mxk > o1 ? mxk : o1; o1 = __shfl_xor(mxk, 2); mxk = mxk > o1 ? mxk : o1;
                    prev = mxk;
                    const int cidx = (int)(mxk & 63u); const int a = PT[cidx * 2], bq = PT[cidx * 2 + 1];
                    const float best = LS[(0 * 16 + tkl) * 16 + a] + LS[(1 * 16 + tkl) * 16 + bq];
                    const int eidx = LI[(0 * 16 + tkl) * 16 + a] * 128 + LI[(1 * 16 + tkl) * 16 + bq];
                    if (r == 0) best0 = best;
                    const float e = __expf(best - best0); esum += e;
                    if (qq == (r & 3)) { myexp[r >> 2] = e; myidx[r >> 2] = eidx; }
                }
                const float inv = 1.0f / esum; const int tl = 16 * w + tkl;
                if (tl < nt) {
#pragma unroll
                    for (int i = 0; i < 4; ++i) { const int r = 4 * i + qq;
                        *(LAS int*)(lds + PE_IDX + (tl * 128 + h * 16 + r) * 4) = myidx[i];
                        *(LAS float*)(lds + PE_W + (tl * 128 + h * 16 + r) * 4) = myexp[i] * inv; }
                }
                asm volatile("s_waitcnt lgkmcnt(0)" ::: "memory");
            }
        }
        __syncthreads();
        int lane_pe2 = lane; asm volatile("" : "+v"(lane_pe2));
        const int nfull = nt & ~7, nleft = nt - nfull;
        const int S = (nleft == 1 || nleft == 2 || nleft == 4) ? 8 / nleft : 1;
        const int nrounds = (nfull >> 3) + (nleft ? 1 : 0);
        for (int rd = 0; rd < nrounds; ++rd) {
            const int lane = lane_pe2;
            const bool split = (rd == (nfull >> 3)) && S > 1;
            const int tl = split ? nfull + w / S : rd * 8 + w;
            const int NB = split ? 64 / S : 64, B0 = split ? (w % S) * NB : 0;
            const bool active = tl < nt;
            if (active) {
            const int row = tb + tl;
            u32x16 xq;
#pragma unroll
            for (int i = 0; i < 4; ++i) { const u32x4 xw = *(const u32x4*)(XN + (size_t)row * 2048 + lane * 32 + i * 8); xq[4 * i] = xw.x; xq[4 * i + 1] = xw.y; xq[4 * i + 2] = xw.z; xq[4 * i + 3] = xw.w; }
            const LAS int* idxp = (const LAS int*)(lds + PE_IDX + tl * 512);
            LAS float* wp = (LAS float*)(lds + PE_W + tl * 512);
            u32x4 bufA[2], bufB[2], bufC[2], bufD[2];
#define PE_ISSUE(buf, TAB, b) do { const int _e0 = idxp[2 * (b)], _e1 = idxp[2 * (b) + 1]; \
                buf[0] = *(const u32x4*)((TAB) + (size_t)_e0 * 1024 + lane * 16); buf[1] = *(const u32x4*)((TAB) + (size_t)_e1 * 1024 + lane * 16); } while (0)
#define PE_CONS_U(buf, b) do { float _p[2]; \
                _Pragma("unroll") for (int _j = 0; _j < 2; ++_j) { float _d = 0.f; \
                    _Pragma("unroll") for (int _q = 0; _q < 4; ++_q) { const unsigned _dw = buf[_j][_q]; \
                        _d = dot2bf(__builtin_bit_cast(unsigned, __builtin_amdgcn_cvt_scalef32_pk_bf16_fp4(_dw, 1.0f, 0)), xq[4 * _q + 0], _d); _d = dot2bf(__builtin_bit_cast(unsigned, __builtin_amdgcn_cvt_scalef32_pk_bf16_fp4(_dw, 1.0f, 1)), xq[4 * _q + 1], _d); \
                        _d = dot2bf(__builtin_bit_cast(unsigned, __builtin_amdgcn_cvt_scalef32_pk_bf16_fp4(_dw, 1.0f, 2)), xq[4 * _q + 2], _d); _d = dot2bf(__builtin_bit_cast(unsigned, __builtin_amdgcn_cvt_scalef32_pk_bf16_fp4(_dw, 1.0f, 3)), xq[4 * _q + 3], _d); } \
                    _p[_j] = _d * (1.0f / 64.0f); } \
                const bool _h32 = (lane & 32) != 0; \
                float _c = _h32 ? _p[1] : _p[0]; const float _cs = _h32 ? _p[0] : _p[1]; _c += __shfl_xor(_cs, 32); \
                _c += __shfl_xor(_c, 16); _c += __shfl_xor(_c, 8); _c += __shfl_xor(_c, 4); _c += __shfl_xor(_c, 2); _c += __shfl_xor(_c, 1); \
                const int _e = 2 * (b) + (lane >> 5); const float _g = wp[_e]; \
                const float _w = _g * 0.5f * _c * (1.0f + erff(_c * 0.70710678118654752f)); \
                if ((lane & 31) == 0) wp[_e] = _w; } while (0)
#define PE_CONS_V(buf, b) do { const f32x2 _w2 = *(const LAS f32x2*)(wp + 2 * (b)); \
                _Pragma("unroll") for (int _j = 0; _j < 2; ++_j) { const f32x2 _wv = {_w2[_j], _w2[_j]}; \
                    _Pragma("unroll") for (int _q = 0; _q < 4; ++_q) { const unsigned _dw = buf[_j][_q]; \
                        out2[4 * _q + 0] += _wv * __builtin_amdgcn_cvt_scalef32_pk_f32_fp4(_dw, 1.0f, 0); out2[4 * _q + 1] += _wv * __builtin_amdgcn_cvt_scalef32_pk_f32_fp4(_dw, 1.0f, 1); \
                        out2[4 * _q + 2] += _wv * __builtin_amdgcn_cvt_scalef32_pk_f32_fp4(_dw, 1.0f, 2); out2[4 * _q + 3] += _wv * __builtin_amdgcn_cvt_scalef32_pk_f32_fp4(_dw, 1.0f, 3); } } } while (0)
            const unsigned char* TU = ws + WS_PU; const unsigned char* TV = ws + WS_PVW;
#define PE_ISSUE_UV(buf, i) do { if ((i) < NB) PE_ISSUE(buf, TU, B0 + (i)); else PE_ISSUE(buf, TV, B0 + (i) - NB); } while (0)
#define PE_ISSUE_V(buf, i) do { if ((i) < NB) PE_ISSUE(buf, TV, B0 + (i)); } while (0)
            PE_ISSUE(bufA, TU, B0); PE_ISSUE(bufB, TU, B0 + 1); PE_ISSUE(bufC, TU, B0 + 2);
#pragma unroll 1
            for (int b = 0; b < NB; b += 4) {
                PE_ISSUE_UV(bufD, b + 3); PE_CONS_U(bufA, B0 + b);
                PE_ISSUE_UV(bufA, b + 4); PE_CONS_U(bufB, B0 + b + 1);
                PE_ISSUE_UV(bufB, b + 5); PE_CONS_U(bufC, B0 + b + 2);
                PE_ISSUE_UV(bufC, b + 6); PE_CONS_U(bufD, B0 + b + 3);
            }
            asm volatile("s_waitcnt lgkmcnt(0)" ::: "memory");
            f32x2 out2[16];
#pragma unroll
            for (int i = 0; i < 16; ++i) out2[i] = (f32x2){0.f, 0.f};
#pragma unroll 1
            for (int b = 0; b < NB; b += 4) {
                PE_ISSUE_V(bufD, b + 3); PE_CONS_V(bufA, B0 + b);
                PE_ISSUE_V(bufA, b + 4); PE_CONS_V(bufB, B0 + b + 1);
                PE_ISSUE_V(bufB, b + 5); PE_CONS_V(bufC, B0 + b + 2);
                PE_ISSUE_V(bufC, b + 6); PE_CONS_V(bufD, B0 + b + 3);
            }
#undef PE_ISSUE_UV
#undef PE_ISSUE_V
#undef PE_ISSUE
#undef PE_CONS_U
#undef PE_CONS_V
            f32x32 outv;
#pragma unroll
            for (int i = 0; i < 16; ++i) { outv[2 * i] = out2[i][0]; outv[2 * i + 1] = out2[i][1]; }
            if (split) {
                LAS float* pp = (LAS float*)(lds + PE_SCR) + ((size_t)((tl - nfull) * S + (w % S)) * 64 + lane) * 32;
#pragma unroll
                for (int i = 0; i < 8; ++i) { f32x4 t4; t4[0] = outv[4 * i]; t4[1] = outv[4 * i + 1]; t4[2] = outv[4 * i + 2]; t4[3] = outv[4 * i + 3]; *(LAS f32x4*)(pp + 4 * i) = t4; }
            }
            if (!split) {
            const int which = row < NLAT ? (row >> 13) : 2;
            const float* mg = mod + (size_t)which * 12288 + 5 * 2048;
            float* xrow = X + (size_t)row * 2048; float* orow = (l == 1) ? (p->out + (size_t)row * 2048) : xrow;
            f32x4 xvv[8], gvv[8];
#pragma unroll
            for (int hh = 0; hh < 8; ++hh) { const int c = lane * 32 + hh * 4; xvv[hh] = *(const f32x4*)(xrow + c); gvv[hh] = *(const f32x4*)(mg + c); }
#pragma unroll
            for (int hh = 0; hh < 8; ++hh) { const int c = lane * 32 + hh * 4;
                const f32x4 xv = xvv[hh], gv = gvv[hh];
                f32x4 ov; ov[0] = xv[0] + gv[0] * outv[hh * 4 + 0] * 0.25f; ov[1] = xv[1] + gv[1] * outv[hh * 4 + 1] * 0.25f; ov[2] = xv[2] + gv[2] * outv[hh * 4 + 2] * 0.25f; ov[3] = xv[3] + gv[3] * outv[hh * 4 + 3] * 0.25f;
                *(f32x4*)(orow + c) = ov; }
            }
            }
            if (split) {
                __syncthreads();
                if ((w % S) == 0 && tl < nt) {
                    const int row = tb + tl;
                    const int which = row < NLAT ? (row >> 13) : 2;
                    const float* mg = mod + (size_t)which * 12288 + 5 * 2048;
                    float* xrow = X + (size_t)row * 2048; float* orow = (l == 1) ? (p->out + (size_t)row * 2048) : xrow;
                    const LAS float* pp = (const LAS float*)(lds + PE_SCR) + ((size_t)((tl - nfull) * S) * 64 + lane) * 32;
#pragma unroll
                    for (int hh = 0; hh < 8; ++hh) { const int c = lane * 32 + hh * 4;
                        f32x4 acc4 = *(const LAS f32x4*)(pp + hh * 4);
                        for (int q = 1; q < S; ++q) acc4 += *(const LAS f32x4*)(pp + (size_t)q * 64 * 32 + hh * 4);
                        const f32x4 xv = *(const f32x4*)(xrow + c), gv = *(const f32x4*)(mg + c);
                        f32x4 ov; ov[0] = xv[0] + gv[0] * acc4[0] * 0.25f; ov[1] = xv[1] + gv[1] * acc4[1] * 0.25f; ov[2] = xv[2] + gv[2] * acc4[2] * 0.25f; ov[3] = xv[3] + gv[3] * acc4[3] * 0.25f;
                        *(f32x4*)(orow + c) = ov; }
                }
            }
        }
    }
}

#if !MK_SINGLE
#define LOHI_ARGS , const int lo, const int hi
#define LOHI_PASS , lo, hi
#else
#define LOHI_ARGS
#define LOHI_PASS
#endif
#ifndef PHM
#define PHM 0x7ff
#endif
#if MK_SINGLE
#define IN(k) (((PHM >> (((k) % NPH))) & 1) != 0)
#define SEAM(k) do { if ((k) + 1 < 2 * NPH) xcd_barrier(bar); } while (0)
#else
#define IN(k) (((PHM >> (((k) % NPH))) & 1) && lo <= (k) && (k) < hi)
#define SEAM(k) do { if (IN(k) && IN((k) + 1)) xcd_barrier(bar); } while (0)
#endif
template <int l>
__device__ __forceinline__ void layer_program(KP kp, unsigned char* ws0, LAS unsigned char* lds, const XcdBarrier& bar, const int G, const int wid0 LOHI_ARGS) {
        const int pb = l * NPH;
        const int M2 = (l == 0) ? MR : NLAT;
        constexpr int MG = NLAT;
        if (IN(pb + 0)) { phase_w(launder_p(kp), l, lds, wid0); } SEAM(pb + 0);
        if (IN(pb + 1)) { phase_norm(launder_p(kp), l, 0, MR, wid0); } SEAM(pb + 1);
        if (IN(pb + 2)) { unsigned char* ws = launder(ws0);
            { pg8::PlainOrder S; S.init(ws + WS_XN8, ws + WS_WIN, MR, (72 - (BF_HI - BF_LO)) * 256, 1024, G, (int)blockIdx.x); S.skip_from = BF_LO; S.skip_cnt = BF_HI - BF_LO; S.skip2_from = 48; S.skip2_cnt = 24;
              pg8::EpiProj E{ws};
              pg8::gemm_phase<pg8::EpiProj, pg8::PlainOrder, true>(lds, 1024, S, E, wid0); }
            { pg8::PlainOrder S; S.init(ws + WS_XN, ws + WS_WINB, MR, (24 + BF_HI - BF_LO) * 256, 2048, G, G - 1 - (int)blockIdx.x); S.pn_base = BF_LO; S.skip_from = BF_HI; S.skip_cnt = 48 - BF_HI; S.b_compact = 1;
              pg8::EpiProj E{ws};
              pg8::gemm_phase<pg8::EpiProj, pg8::PlainOrder, false>(lds, 2048, S, E, wid0); }
        } SEAM(pb + 2);
        if (IN(pb + 3)) { phase_gates_gemm(launder_p(kp), l, wid0); phase_e1(launder_p(kp), l, wid0); } SEAM(pb + 3);
        if (IN(pb + 4)) { phase_mlstm(launder_p(kp), l, lds, wid0); phase_attn(launder_p(kp), l, lds, wid0); } SEAM(pb + 4);
        if (IN(pb + 5)) { phase_e2(launder_p(kp), l, M2, wid0); } SEAM(pb + 5);
        if (IN(pb + 6)) { unsigned char* ws = launder(ws0);
            pg8::BranchOrder S; S.T8 = (const char*)(ws + WS_T8); S.WA = (const char*)(ws + WS_WA);
            S.nM = MG / 256; S.nN = 8; S.G = G; S.c = (int)blockIdx.x; S.tstep = (size_t)256 * 2048 * 2;
            pg8::EpiMerge E{(bf16_t*)(ws + WS_Y), (const bf16_t*)(ws + WS_GT)};
            pg8::gemm_phase<pg8::EpiMerge, pg8::BranchOrder>(lds, 2048, S, E, wid0);
            if (l == 0) ctx_gemm<0>(launder_p(kp), l, lds, wid0);
        } SEAM(pb + 6);
        if (IN(pb + 7)) { unsigned char* ws = launder(ws0);
            pg8::PlainOrder S; S.init(ws + WS_Y, ws + WS_WO, MG, 2048, 2048, G, (int)blockIdx.x);
            pg8::EpiRes E{(float*)(ws + WS_X), l == 0 ? kp->x : (const float*)(ws + WS_X), (const float*)(ws + WS_MOD) + (size_t)l * 3 * 12288};
            pg8::gemm_phase<pg8::EpiRes, pg8::PlainOrder>(lds, 2048, S, E, wid0);
            if (l == 0) ctx_gemm<1>(launder_p(kp), l, lds, wid0);
        } SEAM(pb + 7);
        if (IN(pb + 8)) { phase_norm(launder_p(kp), l, 1, M2, wid0); } SEAM(pb + 8);
        if (IN(pb + 9)) { unsigned char* ws = launder(ws0);
            pg8::PlainOrder S; S.init(ws + WS_XN, ws + WS_WQ, MG, 2048, 2048, G, (int)blockIdx.x);
            pg8::EpiBf E{(bf16_t*)(ws + WS_PV), 2048};
            pg8::gemm_phase<pg8::EpiBf, pg8::PlainOrder>(lds, 2048, S, E, wid0);
            if (l == 0) ctx_gemm<2>(launder_p(kp), l, lds, wid0);
        } SEAM(pb + 9);
        if (IN(pb + 10)) { phase_peer(launder_p(kp), l, lds, wid0); } SEAM(pb + 10);
    }
#undef IN
#undef SEAM

__global__ void __launch_bounds__(NTHREADS, 2) fwd_kernel(Params p) {
    extern __shared__ __attribute__((aligned(16))) unsigned char lds_raw[];
    LAS unsigned char* lds = (LAS unsigned char*)lds_raw;
    const int tid = threadIdx.x, G = gridDim.x;
    const int wid0 = __builtin_amdgcn_readfirstlane(tid >> 6);
    KP kp = (KP)__builtin_amdgcn_kernarg_segment_ptr();
    unsigned char* ws0 = kp->ws;
    volatile LAS unsigned* bst = (volatile LAS unsigned*)(lds + LDS_BYTES - 16);
    if (tid == 0) { bst[0] = 0u; bst[1] = 0u; bst[2] = 0u; bst[3] = 0u; }
    __syncthreads();
    XcdBarrier bar; bar.bar = (unsigned*)(ws0 + WS_BAR); bar.x = 0; bar.st = bst;
    if (MK_SINGLE) bar = xcd_barrier_post((unsigned*)(ws0 + WS_BAR), bst);
#if !MK_SINGLE
    const int lo = kp->ph_lo, hi = kp->ph_hi;
#endif
    layer_program<0>(kp, ws0, lds, bar, G, wid0 LOHI_PASS);
    layer_program<1>(kp, ws0, lds, bar, G, wid0 LOHI_PASS);
}

extern "C" void kernel_launch(void* const* d_in, const int* in_sizes, int n_in, void* d_out, int out_size, void* d_ws, size_t ws_size, hipStream_t stream) {
    static int grid = 0;
    if (grid == 0) {
        if (n_in != 21 || in_sizes[0] != NLAT * DM || out_size != NLAT * DM || ws_size < WS_END) {
            fprintf(stderr, "kernel_launch: unexpected shapes (n_in %d, in0 %d, out %d, ws %zu need %zu); nothing launched\n", n_in, n_in > 0 ? in_sizes[0] : -1, out_size, ws_size, (size_t)WS_END); grid = -1; return; }
        int dev = 0, cus = 0, per_cu = 0;
        if (hipGetDevice(&dev) != hipSuccess || hipDeviceGetAttribute(&cus, hipDeviceAttributeMultiprocessorCount, dev) != hipSuccess) { grid = -1; return; }
        if (hipFuncSetAttribute((const void*)fwd_kernel, hipFuncAttributeMaxDynamicSharedMemorySize, LDS_BYTES) != hipSuccess) { fprintf(stderr, "kernel_launch: hipFuncSetAttribute failed\n"); grid = -1; return; }
        if (hipOccupancyMaxActiveBlocksPerMultiprocessor(&per_cu, (const void*)fwd_kernel, NTHREADS, LDS_BYTES) != hipSuccess || per_cu < 1) { fprintf(stderr, "kernel_launch: occupancy query says %d\n", per_cu); }
        (void)hipGetLastError();
        grid = cus;
    }
    if (grid < 0) return;
    (void)hipMemsetAsync((char*)d_ws, 0, 16384, stream);
    Params p{};
    const float** pp = (const float**)&p;
    for (int i = 0; i < 21; ++i) pp[i] = (const float*)d_in[i];
    p.out = (float*)d_out; p.ws = (unsigned char*)d_ws;
#if MK_SINGLE
    p.ph_lo = 0; p.ph_hi = 2 * NPH;
    hipLaunchKernelGGL(fwd_kernel, dim3(grid), dim3(NTHREADS), LDS_BYTES, stream, p);
#else
    for (int k = 0; k < 2 * NPH; ++k) { p.ph_lo = k; p.ph_hi = k + 1; hipLaunchKernelGGL(fwd_kernel, dim3(grid), dim3(NTHREADS), LDS_BYTES, stream, p); }
#endif
}
```

```cpp
#include <hip/hip_runtime.h>
#include <stdint.h>
#include <stdio.h>
#include <type_traits>

#ifndef BF_LO
#define BF_LO 0
#define BF_HI 8
#endif
#ifndef MK_SINGLE
#define MK_SINGLE 1
#endif

#define LAS __attribute__((address_space(3)))
typedef unsigned short bf16_t;
typedef short bf16x8 __attribute__((ext_vector_type(8)));
typedef float f32x4 __attribute__((ext_vector_type(4)));
typedef float f32x2 __attribute__((ext_vector_type(2)));
typedef unsigned u32x4 __attribute__((ext_vector_type(4)));
typedef unsigned u32x2 __attribute__((ext_vector_type(2)));
typedef __bf16 bf2_t __attribute__((ext_vector_type(2)));
typedef int i32x4 __attribute__((ext_vector_type(4)));
typedef int i32x8 __attribute__((ext_vector_type(8)));
typedef float f32x16 __attribute__((ext_vector_type(16)));
typedef float f32x32 __attribute__((ext_vector_type(32)));
typedef unsigned u32x6 __attribute__((ext_vector_type(6)));
typedef __bf16 bf16x32_t __attribute__((ext_vector_type(32)));
typedef unsigned u32x16 __attribute__((ext_vector_type(16)));
typedef short s16x4 __attribute__((ext_vector_type(4)));
#ifndef FP6_INTERLEAVED
#define FP6_INTERLEAVED 1
#endif

constexpr int DM = 2048, NBATCH = 2, SEQ = 8192, CTXL = 256;
constexpr int NLAT = NBATCH * SEQ;
constexpr int NCTX = NBATCH * CTXL;
constexpr int MR = NLAT + NCTX;
constexpr int PROJ_W = 24608;
constexpr int NPROJ = 24576;
constexpr int NTHREADS = 512;
constexpr int LDS_BYTES = 163840;
constexpr int NPH = 11;
constexpr float EPSF = 1e-6f;

constexpr size_t SZ_A = (size_t)MR * 2048 * 2;
constexpr size_t WS_BAR = 0;
constexpr size_t WS_MOD = 16384;
constexpr size_t CTL_BYTES = 16384 + 2 * 3 * 12288 * 4;
constexpr size_t WS_TAB = 311296;
constexpr size_t WS_X = WS_TAB + 32768;
constexpr size_t WS_XN = WS_X + (size_t)MR * 2048 * 4;
constexpr size_t WS_Y = WS_XN + SZ_A;
constexpr size_t WS_XN8 = WS_Y;
constexpr size_t WS_PQ = WS_Y + SZ_A;
constexpr size_t WS_PK = WS_PQ + SZ_A / 2;
constexpr size_t WS_T8 = WS_PK + SZ_A / 2;
constexpr size_t WS_PV = WS_T8 + 0 * SZ_A;
constexpr size_t WS_PO = WS_T8 + 1 * SZ_A;
constexpr size_t WS_CQ = WS_T8 + 2 * SZ_A;
constexpr size_t WS_CK = WS_T8 + 3 * SZ_A;
constexpr size_t WS_CV = WS_T8 + 4 * SZ_A;
constexpr size_t WS_BB = WS_T8 + 5 * SZ_A;
constexpr size_t WS_BC = WS_T8 + 6 * SZ_A;
constexpr size_t WS_BX = WS_T8 + 7 * SZ_A;
constexpr size_t WS_GT = WS_T8 + 8 * SZ_A;
constexpr size_t WS_GATES = WS_GT + 3 * SZ_A;
constexpr size_t WS_WIN = WS_GATES + (size_t)MR * 32 * 4;
constexpr size_t WS_WINB = WS_WIN + (size_t)NPROJ * 2048;
constexpr size_t WS_WG = WS_WIN + (size_t)NPROJ * 2048 * 2;
constexpr size_t SZ_W = (size_t)2048 * 2048 * 2;
constexpr size_t WS_WA = WS_WG + 32 * 2048 * 2;
constexpr size_t WS_WB = WS_WA + SZ_W;
constexpr size_t WS_WC = WS_WB + SZ_W;
constexpr size_t WS_WO = WS_WC + SZ_W;
constexpr size_t WS_WQ = WS_WO + SZ_W;
constexpr size_t WS_KEYS = WS_WQ + SZ_W;
constexpr size_t WS_PU = WS_KEYS + 16 * 128 * 128 * 2;
constexpr size_t WS_PVW = WS_PU + (size_t)16384 * 2048 * 2;
constexpr size_t WS_SCAN = WS_PU + (size_t)16384 * 1024;
constexpr size_t WS_END = WS_PVW + (size_t)16384 * 2048 * 2;

struct Params {
    const float *x, *c, *ctx, *c_ctx, *w_ada, *b_ada, *norm_g, *w_in, *a_gate_b, *a_hnorm_g, *b_conv, *c_qk_g, *c_rpb,
        *w_a_out, *w_b_out, *w_c_out, *w_out, *peer_wq, *peer_keys, *peer_u, *peer_v;
    float* out; unsigned char* ws; int ph_lo, ph_hi;
};
#define CAS __attribute__((address_space(4)))
typedef const CAS Params* KP;
__device__ __forceinline__ KP launder_p(KP q) { asm volatile("" : "+s"(q)); return q; }

__device__ __forceinline__ unsigned char* launder(unsigned char* q) { size_t z = 0; asm volatile("" : "+s"(z)); return q + z; }
__device__ __forceinline__ int tid_fresh(int wid0) { int t = wid0 * 64 + (int)__builtin_amdgcn_mbcnt_hi(~0u, __builtin_amdgcn_mbcnt_lo(~0u, 0u)); asm volatile("" : "+v"(t)); return t; }

__device__ __forceinline__ float bf2f(unsigned b) { return __uint_as_float(b << 16); }
__device__ __forceinline__ float bflo(unsigned w) { return __uint_as_float(w << 16); }
__device__ __forceinline__ float bfhi(unsigned w) { return __uint_as_float(w & 0xffff0000u); }
__device__ __forceinline__ unsigned pk2(float lo, float hi) { f32x2 v = {lo, hi}; bf2_t b = __builtin_convertvector(v, bf2_t); return __builtin_bit_cast(unsigned, b); }
__device__ __forceinline__ bf16_t f2bf(float f) { return (bf16_t)(pk2(f, 0.f) & 0xffffu); }
__device__ __forceinline__ f32x4 mfma16(bf16x8 a, bf16x8 b, f32x4 c) { return __builtin_amdgcn_mfma_f32_16x16x32_bf16(a, b, c, 0, 0, 0); }
__device__ __forceinline__ float dot2bf(unsigned a, unsigned b, float c) { return __builtin_amdgcn_fdot2_f32_bf16(__builtin_bit_cast(bf2_t, a), __builtin_bit_cast(bf2_t, b), c, false); }
#define LDS_BARRIER() do { asm volatile("s_waitcnt lgkmcnt(0)" ::: "memory"); __builtin_amdgcn_s_barrier(); asm volatile("" ::: "memory"); } while (0)
__device__ __forceinline__ float rlane(float v, int l) { return __uint_as_float((unsigned)__builtin_amdgcn_readlane((int)__float_as_uint(v), l)); }
__device__ __forceinline__ float wave_sum(float v) {
#pragma unroll
    for (int o = 32; o >= 1; o >>= 1) v += __shfl_xor(v, o);
    return v;
}
__device__ __forceinline__ float sigmoidf_(float v) { return __builtin_amdgcn_rcpf(1.0f + __expf(-v)); }
__device__ __forceinline__ float logsigmoidf_(float v) { return fminf(v, 0.f) - log1pf(__expf(-fabsf(v))); }

#define XB_TMO      128
#define XB_XCNT(j)  (256  + 64 * (j))
#define XB_XSUB(j)  (1280 + 64 * (j))
#define XB_XGEN(j)  (2304 + 64 * (j))
#define XB_TOP      3328
#define XB_TOPGEN   3392
#define XCD_BAR_WORDS 3456
#define XB_SPIN_CAP (1u << 22)
__device__ __forceinline__ unsigned xb_ld(unsigned* p)              { return __hip_atomic_load(p, __ATOMIC_RELAXED, __HIP_MEMORY_SCOPE_AGENT); }
__device__ __forceinline__ unsigned xb_add(unsigned* p, unsigned v) { return __hip_atomic_fetch_add(p, v, __ATOMIC_RELAXED, __HIP_MEMORY_SCOPE_AGENT); }
__device__ __forceinline__ unsigned xb_xcc_id() { return (unsigned)__builtin_amdgcn_s_getreg((3 << 11) | 20) & 0xFu; }
#define XB_SPIN(cond, bar) do { unsigned _sp = 0; while (cond) { __builtin_amdgcn_s_sleep(1); \
    if ((++_sp & 255u) == 0u) { if (xb_ld(&(bar)[XB_TMO])) break; if (_sp > XB_SPIN_CAP) { atomicAdd(&(bar)[XB_TMO], 1u); break; } } } } while (0)
struct XcdBarrier { unsigned* bar; unsigned x; volatile LAS unsigned* st; };
__device__ __forceinline__ XcdBarrier xcd_barrier_post(unsigned* bar, volatile LAS unsigned* st) {
    XcdBarrier b; b.bar = bar; b.x = xb_xcc_id(); b.st = st;
    if (threadIdx.x == 0) (void)xb_add(&bar[XB_XCNT(b.x)], 1u);
    return b;
}
__device__ __forceinline__ void xcd_barrier_complete(unsigned* bar, unsigned x, unsigned& nloc, unsigned& nx) {
    const unsigned G = gridDim.x * gridDim.y * gridDim.z;
    unsigned sum, cnt, mine, sp = 0u;
    for (;;) {
        sum = 0u; cnt = 0u; mine = 0u;
#pragma unroll
        for (unsigned j = 0; j < 16; ++j) { const unsigned c = xb_ld(&bar[XB_XCNT(j)]); sum += c; cnt += (c > 0u) ? 1u : 0u; mine = (j == x) ? c : mine; }
        if (sum == G) break;
        __builtin_amdgcn_s_sleep(1);
        if ((++sp & 255u) == 0u) { if (xb_ld(&bar[XB_TMO])) break; if (sp > XB_SPIN_CAP) { atomicAdd(&bar[XB_TMO], 1u); break; } }
    }
    nloc = mine > 0u ? mine : 1u; nx = cnt > 0u ? cnt : 1u;
}
__device__ __forceinline__ void xcd_barrier(const XcdBarrier& b) {
    asm volatile("s_waitcnt vmcnt(0)" ::: "memory");
    __syncthreads();
    if (threadIdx.x == 0) {
        unsigned* bar = b.bar;
        __builtin_amdgcn_s_waitcnt(0);
        unsigned nloc = b.st[0], nx = b.st[1];
        if (nloc == 0u) { xcd_barrier_complete(bar, b.x, nloc, nx); b.st[0] = nloc; b.st[1] = nx; }
        const unsigned old = xb_add(&bar[XB_XSUB(b.x)], 1u);
        const unsigned gen = old / nloc;
        if (old + 1u == (gen + 1u) * nloc) {
            __builtin_amdgcn_fence(__ATOMIC_RELEASE, "agent");
            asm volatile("s_waitcnt vmcnt(0)" ::: "memory");
            const unsigned og = xb_add(&bar[XB_TOP], 1u);
            const unsigned tg = og / nx;
            if (og + 1u == (tg + 1u) * nx) xb_add(&bar[XB_TOPGEN], 1u);
            else XB_SPIN(xb_ld(&bar[XB_TOPGEN]) == tg, bar);
            __builtin_amdgcn_fence(__ATOMIC_ACQUIRE, "agent");
            xb_add(&bar[XB_XGEN(b.x)], 1u);
            asm volatile("s_waitcnt vmcnt(0)" ::: "memory");
        } else {
            XB_SPIN(xb_ld(&bar[XB_XGEN(b.x)]) == gen, bar);
            __builtin_amdgcn_fence(__ATOMIC_ACQUIRE, "agent");
            asm volatile("s_waitcnt vmcnt(0)" ::: "memory");
        }
    }
    __syncthreads();
}

namespace pg8 {
constexpr int BM = 256, BK = 64, HALF = 128, HTB = HALF * BK * 2, STAGE_BYTES = 8 * HTB, NXCD = 8, WGM = 8;
__host__ __device__ __forceinline__ int lds_byte(int r, int c) { const int st = (r >> 4) * 2 + (c >> 5), rr = r & 15, cc = c & 31, ob = rr * 64 + cc * 2; return st * 1024 + (ob ^ (((ob >> 9) & 1) << 5)); }
__host__ __device__ __forceinline__ void stage_rc(int b, int& R, int& C) { const int st = b / 1024, sb = b % 1024, swz = sb ^ (((sb >> 9) & 1) << 5); R = (st >> 1) * 16 + swz / 64; C = (st & 1) * 32 + (swz % 64) / 2; }
__host__ __device__ __forceinline__ int perm32(int rho) { const int n = rho >> 4, i = rho & 15; return 8 * (i >> 2) + 4 * n + (i & 3); }

struct Unit { int pm, pn, br; const char* A; const char* B; };

__device__ __forceinline__ bool tile_of(int L, int nM, int nN, int& pm, int& pn) {
    const int nwg = nM * nN; if (L >= nwg) return false;
    int wgid = L; { const int q = nwg / NXCD, r = nwg % NXCD, xcd = wgid % NXCD, off = wgid / NXCD; wgid = (xcd < r ? xcd * (q + 1) : r * (q + 1) + (xcd - r) * q) + off; }
    const int nig = WGM * nN, gid = wgid / nig, fm = gid * WGM, gsz = (nM - fm) < WGM ? (nM - fm) : WGM;
    pm = fm + ((wgid % nig) % gsz); pn = (wgid % nig) / gsz; return true;
}
struct PlainOrder {
    const char* A; const char* Bt; int nM, nN, G, c; size_t tstep; int pn_base, skip_from, skip_cnt, skip2_from, skip2_cnt, b_row0, b_compact, short_rounds, n_long;
    __device__ __forceinline__ void init(const void* A_, const void* Bt_, int M, int N, int K, int G_, int c_) { A = (const char*)A_; Bt = (const char*)Bt_; nM = M / BM; nN = N / BM; G = G_; c = c_; tstep = (size_t)BM * K * 2;
        pn_base = 0; skip_from = 1 << 30; skip_cnt = 0; skip2_from = 1 << 30; skip2_cnt = 0; b_row0 = 0; b_compact = 0; short_rounds = 1 << 30; n_long = 0; }
    __device__ __forceinline__ bool next(int i, Unit& u) const {
        int L = i * G + c;
        if (i >= short_rounds) { if (c >= n_long) return false; const int per = (nM * nN - short_rounds * G) / n_long, j = i - short_rounds; if (j >= per) return false; L = short_rounds * G + per * c + j; }
        int pm, pn; if (!tile_of(L, nM, nN, pm, pn)) return false;
        const int pnc = pn;
        pn += pn_base; if (pn >= skip_from) pn += skip_cnt; if (pn >= skip2_from) pn += skip2_cnt;
        u.pm = pm; u.pn = pn; u.br = 0; u.A = A + (size_t)pm * tstep; u.B = Bt + (size_t)(b_compact ? pnc : pn - b_row0) * tstep; return true;
    }
};
struct BranchOrder {
    const char* T8; const char* WA; int nM, nN, G, c; size_t tstep;
    __device__ __forceinline__ bool next(int i, Unit& u) const {
        const int tl = i / 3, br = i - 3 * tl; int pm, pn; if (!tile_of(tl * G + c, nM, nN, pm, pn)) return false;
        u.pm = pm; u.pn = pn; u.br = br;
        const int ti = 1 + 4 * (br == 1) + (br == 2);
        u.A = T8 + (size_t)ti * SZ_A + (size_t)pm * tstep; u.B = WA + (size_t)br * SZ_W + (size_t)pn * tstep; return true;
    }
};

template <class Epi, class Sched, bool FP8 = false>
__device__ __forceinline__ void gemm_phase(LAS unsigned char* lds, const int K, const Sched& S, const Epi& E, int wid0) {
    const int tid = tid_fresh(wid0), wid = __builtin_amdgcn_readfirstlane(tid >> 6), lane = tid & 63, wr = wid >> 2, wc = wid & 3, fr = lane & 15, fq = lane >> 4;
    const int nt = K / BK;
    unsigned voffA[2], voffB[2];
#pragma unroll
    for (int i = 0; i < 2; ++i) { int R, C; stage_rc(tid * 16 + i * 8192, R, C); const int Rb = Epi::PERM ? ((R & ~31) + perm32(R & 31)) : R;
        voffA[i] = (unsigned)(R * K + C) * 2u; voffB[i] = (unsigned)(Rb * K + C) * 2u; }
    const size_t kstep = (size_t)(BK * 2);
    const size_t hstep = (size_t)HALF * K * 2;
    const unsigned ldsw = (unsigned)wid * 1024u;
    const int aoff = lds_byte(wr * 64 + fr, fq * 8), boff = lds_byte(wc * 32 + fr, fq * 8);
#define PG8_SA(b, h) (((b) * 2 + (h)) * HTB)
#define PG8_SB(b, h) ((4 + (b) * 2 + (h)) * HTB)
#define PG8_STAGE(bufoff, gbase, voff) do { _Pragma("unroll") for (int _i = 0; _i < 2; ++_i) \
        __builtin_amdgcn_global_load_lds((const unsigned*)((const char*)(gbase) + (voff)[_i]), (LAS unsigned*)(lds + (bufoff) + ldsw + _i * 8192), 16, 0, 0); } while (0)
#define PG8_LD1(dstv, addr) do { if constexpr (FP8) { const i32x4 _lo = *(const LAS i32x4*)(lds + (addr)), _hi = *(const LAS i32x4*)(lds + (addr) + 1024); dstv[0] = __builtin_shufflevector(_lo, _hi, 0, 1, 2, 3, 4, 5, 6, 7); } \
        else { _Pragma("unroll") for (int k = 0; k < 2; ++k) dstv[k] = *(const LAS bf16x8*)(lds + (addr) + k * 1024); } } while (0)
#define PG8_LDA(dst, b, h) do { _Pragma("unroll") for (int m = 0; m < 4; ++m) PG8_LD1(dst[m], PG8_SA(b, h) + aoff + m * 2048); } while (0)
#define PG8_LDB(dst, b, h) do { _Pragma("unroll") for (int n = 0; n < 2; ++n) PG8_LD1(dst[n], PG8_SB(b, h) + boff + n * 2048); } while (0)
#define PG8_MMA(ai, bj, At, Bt) do { __builtin_amdgcn_s_setprio(1); _Pragma("unroll") for (int m = 0; m < 4; ++m) _Pragma("unroll") for (int n = 0; n < 2; ++n) { \
        if constexpr (FP8) asm volatile("v_mfma_scale_f32_16x16x128_f8f6f4 %0, %1, %2, %0, %3, %4 op_sel_hi:[0,0,0]" : "+v"(acc[ai][bj][m][n]) : "v"(Bt[n][0]), "v"(At[m][0]), "v"(sclW), "v"(sclX)); \
        else { _Pragma("unroll") for (int k = 0; k < 2; ++k) acc[ai][bj][m][n] = __builtin_amdgcn_mfma_f32_16x16x32_bf16(Bt[n][k], At[m][k], acc[ai][bj][m][n], 0, 0, 0); } } \
        __builtin_amdgcn_s_setprio(0); } while (0)
#define PG8_WAIT_V(n) asm volatile("s_waitcnt vmcnt(" #n ")" ::: "memory")
#define PG8_WAIT_L(n) asm volatile("s_waitcnt lgkmcnt(" #n ")" ::: "memory")
#define PG8_BAR __builtin_amdgcn_s_barrier()
#define PG8_SCHED __builtin_amdgcn_sched_barrier(0)
    Unit cur, nxt; int ui = 0;
    if (!S.next(0, cur)) return;
    const int sclW = 0x75757575, sclX = 0x7F7F7F7F;
    f32x4 acc[2][2][4][2];
#pragma unroll
    for (int a = 0; a < 2; ++a)
#pragma unroll
        for (int b = 0; b < 2; ++b)
#pragma unroll
            for (int m = 0; m < 4; ++m)
#pragma unroll
                for (int n = 0; n < 2; ++n) acc[a][b][m][n] = (f32x4){0.f, 0.f, 0.f, 0.f};
    typedef typename std::conditional<FP8, i32x8, bf16x8>::type frag_t;
    frag_t At[4][FP8 ? 1 : 2], B0[2][FP8 ? 1 : 2], B1[2][FP8 ? 1 : 2];
    const char* cA = cur.A; const char* cB = cur.B;
    PG8_STAGE(PG8_SB(0, 0), cB, voffB); PG8_STAGE(PG8_SA(0, 0), cA, voffA); PG8_STAGE(PG8_SB(0, 1), cB + hstep, voffB); PG8_STAGE(PG8_SA(0, 1), cA + hstep, voffA);
    if (wr == 1) PG8_BAR;
    PG8_WAIT_V(4); PG8_BAR;
    PG8_STAGE(PG8_SB(1, 0), cB + kstep, voffB); PG8_STAGE(PG8_SA(1, 0), cA + kstep, voffA); PG8_STAGE(PG8_SB(1, 1), cB + hstep + kstep, voffB);
    PG8_WAIT_V(6); PG8_BAR;
    for (;;) {
        const bool has_next = S.next(ui + 1, nxt);
        const char* nA = has_next ? nxt.A : cA; const char* nB = has_next ? nxt.B : cB;
        for (int t = 0; t < nt; t += 2) {
            const bool last = (t == nt - 2);
            const char* a1 = cA + (size_t)(t + 1) * kstep;
            const char* a2 = last ? nA : cA + (size_t)(t + 2) * kstep; const char* b2 = last ? nB : cB + (size_t)(t + 2) * kstep;
            const char* a3 = a2 + kstep; const char* b3 = b2 + kstep;
            PG8_LDB(B0, 0, 0); PG8_SCHED; PG8_LDA(At, 0, 0); PG8_STAGE(PG8_SA(1, 1), a1 + hstep, voffA);
            PG8_WAIT_L(8); PG8_BAR; PG8_WAIT_L(0); PG8_MMA(0, 0, At, B0); PG8_BAR; PG8_SCHED;
            PG8_LDB(B1, 0, 1); PG8_STAGE(PG8_SB(0, 0), b2, voffB);
            PG8_BAR; PG8_WAIT_L(0); PG8_MMA(0, 1, At, B1); PG8_BAR;
            PG8_LDA(At, 0, 1); PG8_STAGE(PG8_SA(0, 0), a2, voffA);
            PG8_BAR; PG8_WAIT_L(0); PG8_MMA(1, 0, At, B0); PG8_BAR; PG8_SCHED;
            PG8_STAGE(PG8_SB(0, 1), b2 + hstep, voffB);
            PG8_WAIT_V(6); PG8_BAR; PG8_MMA(1, 1, At, B1); PG8_BAR;
            PG8_LDB(B0, 1, 0); PG8_SCHED; PG8_LDA(At, 1, 0); PG8_STAGE(PG8_SA(0, 1), a2 + hstep, voffA);
            PG8_WAIT_L(8); PG8_BAR; PG8_WAIT_L(0); PG8_MMA(0, 0, At, B0); PG8_BAR; PG8_SCHED;
            PG8_LDB(B1, 1, 1); PG8_STAGE(PG8_SB(1, 0), b3, voffB);
            PG8_BAR; PG8_WAIT_L(0); PG8_MMA(0, 1, At, B1); PG8_BAR;
            PG8_LDA(At, 1, 1); PG8_STAGE(PG8_SA(1, 0), a3, voffA);
            PG8_BAR; PG8_WAIT_L(0); PG8_MMA(1, 0, At, B0); PG8_BAR; PG8_SCHED;
            PG8_STAGE(PG8_SB(1, 1), b3 + hstep, voffB);
            PG8_WAIT_V(6); PG8_BAR; PG8_MMA(1, 1, At, B1); PG8_BAR;
        }
        if constexpr (FP8) { asm volatile("s_nop 15\n\ts_nop 15\n\ts_nop 15" ::: "memory"); }
        E(acc, cur, wr, wc, fr, fq);
        if (!has_next) break;
#pragma unroll
        for (int a = 0; a < 2; ++a)
#pragma unroll
            for (int b = 0; b < 2; ++b)
#pragma unroll
                for (int m = 0; m < 4; ++m)
#pragma unroll
                    for (int n = 0; n < 2; ++n) acc[a][b][m][n] = (f32x4){0.f, 0.f, 0.f, 0.f};
        cur = nxt; cA = nA; cB = nB; ++ui;
    }
    PG8_WAIT_V(0);
    if (wr == 0) PG8_BAR;
    PG8_BAR;
#undef PG8_SA
#undef PG8_SB
#undef PG8_STAGE
#undef PG8_LD1
#undef PG8_LDA
#undef PG8_LDB
#undef PG8_MMA
#undef PG8_WAIT_V
#undef PG8_WAIT_L
#undef PG8_BAR
#undef PG8_SCHED
}

struct EpiProj {
    static constexpr bool PERM = true;
    unsigned char* ws;
    __device__ __forceinline__ void operator()(const f32x4 (&acc)[2][2][4][2], const Unit& u, int wr, int wc, int fr, int fq) const {
        const int pn = u.pn; size_t off; int ld, c0;
        if (pn < 4) { off = WS_PQ; ld = 1024; c0 = pn * 256; }
        else if (pn < 8) { off = WS_PK; ld = 1024; c0 = (pn - 4) * 256; }
        else if (pn < 72) { const int t = (pn - 8) >> 3; off = WS_T8 + (size_t)t * SZ_A; ld = 2048; c0 = ((pn - 8) & 7) * 256; }
        else {
            unsigned char* gp = ws + WS_GT + (size_t)(u.pm * BM + wr * 64 + fr) * 6144 + (pn - 72) * 256 + wc * 32 + 8 * fq;
#pragma unroll
            for (int ai = 0; ai < 2; ++ai) {
#pragma unroll
                for (int m = 0; m < 4; ++m) {
                    asm volatile("" : "+v"(gp));
#pragma unroll
                    for (int bj = 0; bj < 2; ++bj) { const f32x4 v0 = acc[ai][bj][m][0], v1 = acc[ai][bj][m][1];
                        unsigned q[8];
#pragma unroll
                        for (int j = 0; j < 4; ++j) { q[j] = (unsigned)(sigmoidf_(v0[j]) * 255.0f + 0.5f); q[4 + j] = (unsigned)(sigmoidf_(v1[j]) * 255.0f + 0.5f); }
                        u32x2 w; w.x = q[0] | (q[1] << 8) | (q[2] << 16) | (q[3] << 24); w.y = q[4] | (q[5] << 8) | (q[6] << 16) | (q[7] << 24);
                        *(u32x2*)(gp + bj * HALF) = w; }
                    gp += (size_t)16 * 6144;
                }
                gp += (size_t)64 * 6144;
            }
            return;
        }
        bf16_t* rp = (bf16_t*)(ws + off) + (size_t)(u.pm * BM + wr * 64 + fr) * ld + c0 + wc * 32 + 8 * fq;
        const size_t step = (size_t)16 * ld;
#pragma unroll
        for (int ai = 0; ai < 2; ++ai) {
#pragma unroll
            for (int m = 0; m < 4; ++m) {
                asm volatile("" : "+v"(rp));
#pragma unroll
                for (int bj = 0; bj < 2; ++bj) { const f32x4 v0 = acc[ai][bj][m][0], v1 = acc[ai][bj][m][1];
                    u32x4 w; w.x = pk2(v0[0], v0[1]); w.y = pk2(v0[2], v0[3]); w.z = pk2(v1[0], v1[1]); w.w = pk2(v1[2], v1[3]);
                    *(u32x4*)(rp + bj * HALF) = w; }
                rp += step;
            }
            rp += 4 * step;
        }
    }
};
struct EpiBf {
    static constexpr bool PERM = true;
    bf16_t* O; int ld;
    __device__ __forceinline__ void operator()(const f32x4 (&acc)[2][2][4][2], const Unit& u, int wr, int wc, int fr, int fq) const {
        const int row0 = u.pm * BM + wr * 64 + fr, col0 = u.pn * BM + wc * 32 + 8 * fq;
#pragma unroll
        for (int ai = 0; ai < 2; ++ai)
#pragma unroll
            for (int m = 0; m < 4; ++m) { bf16_t* rowp = O + (size_t)(row0 + ai * HALF + m * 16) * ld + col0;
#pragma unroll
                for (int bj = 0; bj < 2; ++bj) { const f32x4 v0 = acc[ai][bj][m][0], v1 = acc[ai][bj][m][1];
                    u32x4 w; w.x = pk2(v0[0], v0[1]); w.y = pk2(v0[2], v0[3]); w.z = pk2(v1[0], v1[1]); w.w = pk2(v1[2], v1[3]);
                    *(u32x4*)(rowp + bj * HALF) = w; } }
    }
};
__device__ __forceinline__ float gq8(unsigned w, int i) { return (float)((w >> (8 * i)) & 0xffu); }
struct EpiMerge {
    static constexpr bool PERM = true;
    bf16_t* Y; const unsigned char* GT;
    __device__ __forceinline__ void operator()(const f32x4 (&acc)[2][2][4][2], const Unit& u, int wr, int wc, int fr, int fq) const {
        const int row0 = u.pm * BM + wr * 64 + fr, col0 = u.pn * BM + wc * 32 + 8 * fq;
        const bool addy = u.br != 0;
#pragma unroll
        for (int ai = 0; ai < 2; ++ai) {
            u32x2 g[4][2]; u32x4 y[4][2];
#pragma unroll
            for (int m = 0; m < 4; ++m)
#pragma unroll
                for (int bj = 0; bj < 2; ++bj) { const size_t r = (size_t)(row0 + ai * HALF + m * 16);
                    g[m][bj] = *(const u32x2*)(GT + r * 6144 + (size_t)u.br * 2048 + col0 + bj * HALF); }
            if (addy) {
#pragma unroll
                for (int m = 0; m < 4; ++m)
#pragma unroll
                    for (int bj = 0; bj < 2; ++bj) { const size_t r = (size_t)(row0 + ai * HALF + m * 16); y[m][bj] = *(const u32x4*)(Y + r * 2048 + col0 + bj * HALF); }
            } else {
#pragma unroll
                for (int m = 0; m < 4; ++m)
#pragma unroll
                    for (int bj = 0; bj < 2; ++bj) y[m][bj] = (u32x4){0u, 0u, 0u, 0u};
            }
#pragma unroll
            for (int m = 0; m < 4; ++m)
#pragma unroll
                for (int bj = 0; bj < 2; ++bj) { const size_t r = (size_t)(row0 + ai * HALF + m * 16);
                    const f32x4 v0 = acc[ai][bj][m][0] * (1.0f / 255.0f), v1 = acc[ai][bj][m][1] * (1.0f / 255.0f); const u32x2 gg = g[m][bj]; const u32x4 yy = y[m][bj];
                    float o[8];
                    o[0] = gq8(gg.x, 0) * v0[0] + bflo(yy.x); o[1] = gq8(gg.x, 1) * v0[1] + bfhi(yy.x); o[2] = gq8(gg.x, 2) * v0[2] + bflo(yy.y); o[3] = gq8(gg.x, 3) * v0[3] + bfhi(yy.y);
                    o[4] = gq8(gg.y, 0) * v1[0] + bflo(yy.z); o[5] = gq8(gg.y, 1) * v1[1] + bfhi(yy.z); o[6] = gq8(gg.y, 2) * v1[2] + bflo(yy.w); o[7] = gq8(gg.y, 3) * v1[3] + bfhi(yy.w);
                    u32x4 w; w.x = pk2(o[0], o[1]); w.y = pk2(o[2], o[3]); w.z = pk2(o[4], o[5]); w.w = pk2(o[6], o[7]);
                    *(u32x4*)(Y + r * 2048 + col0 + bj * HALF) = w; }
        }
    }
};
template <bool XF32> struct EpiRes {
    static constexpr bool PERM = true;
    bf16_t* X; const float* Xf; const float* mod;
    __device__ __forceinline__ void operator()(const f32x4 (&acc)[2][2][4][2], const Unit& u, int wr, int wc, int fr, int fq) const {
        const int row0 = u.pm * BM + wr * 64 + fr, col0 = u.pn * BM + wc * 32 + 8 * fq;
        const int which = (u.pm < 32) ? 0 : (u.pm < 64 ? 1 : 2);
        const float* mg = mod + (size_t)which * 12288 + 2 * 2048 + col0;
        f32x4 gv[2][2];
#pragma unroll
        for (int bj = 0; bj < 2; ++bj)
#pragma unroll
            for (int n = 0; n < 2; ++n) gv[bj][n] = *(const f32x4*)(mg + bj * HALF + n * 4);
#pragma unroll
        for (int ai = 0; ai < 2; ++ai) {
            if constexpr (XF32) {
#pragma unroll
              for (int mh = 0; mh < 2; ++mh) {
                f32x4 xin[2][2][2];
#pragma unroll
                for (int m = 0; m < 2; ++m)
#pragma unroll
                    for (int bj = 0; bj < 2; ++bj)
#pragma unroll
                        for (int n = 0; n < 2; ++n) xin[m][bj][n] = *(const f32x4*)(Xf + (size_t)(row0 + ai * HALF + (2 * mh + m) * 16) * 2048 + col0 + bj * HALF + n * 4);
#pragma unroll
                for (int m = 0; m < 2; ++m)
#pragma unroll
                    for (int bj = 0; bj < 2; ++bj) {
                        const f32x4 o0 = xin[m][bj][0] + gv[bj][0] * acc[ai][bj][2 * mh + m][0], o1 = xin[m][bj][1] + gv[bj][1] * acc[ai][bj][2 * mh + m][1];
                        u32x4 ow; ow.x = pk2(o0[0], o0[1]); ow.y = pk2(o0[2], o0[3]); ow.z = pk2(o1[0], o1[1]); ow.w = pk2(o1[2], o1[3]);
                        *(u32x4*)(X + (size_t)(row0 + ai * HALF + (2 * mh + m) * 16) * 2048 + col0 + bj * HALF) = ow; }
              }
            } else {
                u32x4 xb[4][2];
#pragma unroll
                for (int m = 0; m < 4; ++m)
#pragma unroll
                    for (int bj = 0; bj < 2; ++bj) xb[m][bj] = *(const u32x4*)(X + (size_t)(row0 + ai * HALF + m * 16) * 2048 + col0 + bj * HALF);
#pragma unroll
                for (int m = 0; m < 4; ++m)
#pragma unroll
                    for (int bj = 0; bj < 2; ++bj) { const u32x4 xw = xb[m][bj]; const f32x4 a0 = acc[ai][bj][m][0], a1 = acc[ai][bj][m][1], g0 = gv[bj][0], g1 = gv[bj][1];
                        u32x4 ow; ow.x = pk2(bflo(xw.x) + g0[0] * a0[0], bfhi(xw.x) + g0[1] * a0[1]); ow.y = pk2(bflo(xw.y) + g0[2] * a0[2], bfhi(xw.y) + g0[3] * a0[3]);
                        ow.z = pk2(bflo(xw.z) + g1[0] * a1[0], bfhi(xw.z) + g1[1] * a1[1]); ow.w = pk2(bflo(xw.w) + g1[2] * a1[2], bfhi(xw.w) + g1[3] * a1[3]);
                        *(u32x4*)(X + (size_t)(row0 + ai * HALF + m * 16) * 2048 + col0 + bj * HALF) = ow; }
            }
        }
    }
};
}

__device__ __forceinline__ int proj_src_col(int n) {
    if (n < 1024) return 7200 + n;
    if (n < 2048) return n - 1024;
    if (n < 4096) return 1024 + (n - 2048);
    if (n < 6144) return 8224 + (n - 4096);
    if (n < 8192) return 16416 + (n - 6144);
    if (n < 10240) return 3104 + (n - 8192);
    if (n < 12288) return 5152 + (n - 10240);
    if (n < 14336) return 10272 + (n - 12288);
    if (n < 16384) return 12320 + (n - 14336);
    if (n < 18432) return 14368 + (n - 16384);
    return 18464 + (n - 18432);
}
__device__ __forceinline__ void phase_w(KP p, int l, LAS unsigned char* lds, int wid0) {
    const int tid = tid_fresh(wid0), G = gridDim.x, bid = blockIdx.x;
    unsigned char* ws = launder(p->ws);
    {
        LAS float* tile = (LAS float*)lds;
        const int NT_IN = NPROJ / 64;
        const int total = (NT_IN + 5 * 32) * 8;
        const int kk = tid >> 4, n4 = (tid & 15) * 4;
        auto tile_src = [&](int t, const float*& src, int& ld, bf16_t*& dst, float& scale, int& n0, int& k0, bool& to8) {
            const int ntile = t >> 3, kt = t & 7; k0 = kt * 256; scale = 1.0f; to8 = false;
            if (ntile < NT_IN) { n0 = ntile * 64; src = p->w_in + (size_t)l * 2048 * PROJ_W + proj_src_col(n0); ld = PROJ_W;
                const int pnl = n0 >> 8; const bool isb = (pnl >= BF_LO && pnl < BF_HI) || (pnl >= 48 && pnl < 72);
                if (isb) { const int cpn = pnl < 48 ? pnl - BF_LO : pnl - 48 + (BF_HI - BF_LO); dst = (bf16_t*)(ws + WS_WINB) + (size_t)(cpn * 256 + (n0 & 255)) * 2048; if (n0 < 1024) scale = 0.08838834764831845f; }
                else { to8 = true; dst = (bf16_t*)(ws + WS_WIN); scale = (n0 < 1024) ? 1024.0f * 0.08838834764831845f : 1024.0f; } }
            else { const int mi = (ntile - NT_IN) >> 5; n0 = ((ntile - NT_IN) & 31) * 64;
                const float* m5 = mi == 0 ? p->w_a_out : mi == 1 ? p->w_b_out : mi == 2 ? p->w_c_out : mi == 3 ? p->w_out : p->peer_wq;
                src = m5 + (size_t)l * 2048 * 2048 + n0; ld = 2048;
                dst = (bf16_t*)(ws + WS_WA + (size_t)mi * SZ_W) + (size_t)n0 * 2048; } };
        f32x4 v[8];
        if (bid < total) { const float* src; int ld, n0, k0; bf16_t* dst; float scale; bool to8; tile_src(bid, src, ld, dst, scale, n0, k0, to8);
#pragma unroll
            for (int h = 0; h < 8; ++h) v[h] = *(const f32x4*)(src + (size_t)(k0 + kk + 32 * h) * ld + n4); }
        for (int t = bid; t < total; t += G) {
            const float* src; int ld, n0, k0; bf16_t* dst; float scale; bool to8; tile_src(t, src, ld, dst, scale, n0, k0, to8);
#pragma unroll
            for (int h = 0; h < 8; ++h) { LAS float* tp = tile + (kk + 32 * h) * 65 + n4; tp[0] = v[h][0]; tp[1] = v[h][1]; tp[2] = v[h][2]; tp[3] = v[h][3]; }
            if (t + G < total) { const float* src2; int ld2, n02, k02; bf16_t* dst2; float scale2; bool to82; tile_src(t + G, src2, ld2, dst2, scale2, n02, k02, to82);
#pragma unroll
                for (int h = 0; h < 8; ++h) v[h] = *(const f32x4*)(src2 + (size_t)(k02 + kk + 32 * h) * ld2 + n4); }
            __syncthreads();
            { const int n = tid >> 3, kq = (tid & 7) * 8;
#pragma unroll
              for (int sub = 0; sub < 4; ++sub) { const int k8 = sub * 64 + kq; float vv[8];
#pragma unroll
                  for (int j = 0; j < 8; ++j) vv[j] = tile[(k8 + j) * 65 + n] * scale;
                  if (to8) {
#pragma unroll
                      for (int j = 0; j < 8; ++j) vv[j] = fminf(fmaxf(vv[j], -448.f), 448.f);
                      int d0 = 0, d1 = 0; d0 = __builtin_amdgcn_cvt_pk_fp8_f32(vv[0], vv[1], d0, false); d0 = __builtin_amdgcn_cvt_pk_fp8_f32(vv[2], vv[3], d0, true);
                      d1 = __builtin_amdgcn_cvt_pk_fp8_f32(vv[4], vv[5], d1, false); d1 = __builtin_amdgcn_cvt_pk_fp8_f32(vv[6], vv[7], d1, true);
                      u32x2 w8; w8.x = (unsigned)d0; w8.y = (unsigned)d1; *(u32x2*)((unsigned char*)dst + (size_t)(n0 + n) * 2048 + k0 + k8) = w8; }
                  else { u32x4 w; w.x = pk2(vv[0], vv[1]); w.y = pk2(vv[2], vv[3]); w.z = pk2(vv[4], vv[5]); w.w = pk2(vv[6], vv[7]);
                      *(u32x4*)(dst + (size_t)n * 2048 + k0 + k8) = w; } } }
            __syncthreads();
        }
    }
    const size_t gtid = (size_t)bid * NTHREADS + tid, gthreads = (size_t)G * NTHREADS;
    for (size_t i = gtid; i < 32 * 2048; i += gthreads) { const int n = (int)(i >> 11), k = (int)(i & 2047);
        ((bf16_t*)(ws + WS_WG))[i] = f2bf(p->w_in[(size_t)l * 2048 * PROJ_W + (size_t)k * PROJ_W + 3072 + n]); }
    {
        const float* su = p->peer_u + (size_t)l * 16384 * 2048; const float* sv = p->peer_v + (size_t)l * 16384 * 2048;
        unsigned char* du = ws + WS_PU; unsigned char* dv = ws + WS_PVW;
        const size_t n32 = (size_t)16384 * 2048 / 32;
        for (size_t i = gtid; i < n32; i += gthreads) {
#pragma unroll
            for (int t = 0; t < 2; ++t) {
                const float* sp = (t ? sv : su) + i * 32; const float sc = t ? 4.0f : 64.0f;
                u32x4 wv;
#pragma unroll
                for (int q = 0; q < 4; ++q) { const f32x4 a = *(const f32x4*)(sp + q * 8), b = *(const f32x4*)(sp + q * 8 + 4);
                    unsigned d = 0;
                    d = __builtin_amdgcn_cvt_scalef32_pk_fp4_f32(d, a[0] * sc, a[1] * sc, 1.0f, 0); d = __builtin_amdgcn_cvt_scalef32_pk_fp4_f32(d, a[2] * sc, a[3] * sc, 1.0f, 1);
                    d = __builtin_amdgcn_cvt_scalef32_pk_fp4_f32(d, b[0] * sc, b[1] * sc, 1.0f, 2); d = __builtin_amdgcn_cvt_scalef32_pk_fp4_f32(d, b[2] * sc, b[3] * sc, 1.0f, 3);
                    wv[q] = d; }
                *(u32x4*)((t ? dv : du) + i * 16) = wv;
            }
        }
        const float* sk = p->peer_keys + (size_t)l * 16 * 128 * 128; bf16_t* dk = (bf16_t*)(ws + WS_KEYS);
        for (size_t i = gtid; i < (size_t)16 * 128 * 128; i += gthreads) dk[i] = f2bf(sk[i]);
    }
    {
        float* mod = (float*)(ws + WS_MOD) + (size_t)l * 3 * 12288;
        const float* wa = p->w_ada + (size_t)l * 2048 * 12288; const float* ba = p->b_ada + (size_t)l * 12288;
        LAS float* part = (LAS float*)(lds + 69632);
        const int col = tid & 63, ks = tid >> 6;
        for (int t = bid; t < 256; t += G) {
            const int n = t * 48 + col;
            float a0 = 0.f, a1 = 0.f, a2 = 0.f;
            if (col < 48) {
#pragma unroll 8
                for (int k = ks * 256; k < ks * 256 + 256; ++k) {
                    const float w = wa[(size_t)k * 12288 + n];
                    const float c0 = p->c[k], c1 = p->c[2048 + k], c2 = p->c_ctx[k];
                    a0 += c0 * sigmoidf_(c0) * w; a1 += c1 * sigmoidf_(c1) * w; a2 += c2 * sigmoidf_(c2) * w;
                }
                part[(ks * 3 + 0) * 48 + col] = a0; part[(ks * 3 + 1) * 48 + col] = a1; part[(ks * 3 + 2) * 48 + col] = a2;
            }
            __syncthreads();
            if (tid < 144) { const int which = tid / 48, cc = tid - which * 48; float sacc = ba[t * 48 + cc];
#pragma unroll
                for (int q = 0; q < 8; ++q) sacc += part[(q * 3 + which) * 48 + cc];
                mod[(size_t)which * 12288 + t * 48 + cc] = sacc; }
            __syncthreads();
        }
    }
    if (l == 0) {
        float* tab = (float*)(ws + WS_TAB);
        for (size_t i = gtid; i < 4096; i += gthreads) { const int pos = (int)(i >> 5), j = (int)(i & 31);
            const float inv = powf(10000.0f, -(float)j / 32.0f); const float ang = (float)pos * inv;
            tab[i] = cosf(ang); tab[4096 + i] = sinf(ang); }
    }
}

__device__ __forceinline__ void phase_norm(KP p, int l, int which_norm, int nrows, int wid0) {
    const int tid = tid_fresh(wid0); const int lane = tid & 63, gw = blockIdx.x * 8 + (tid >> 6), nw = gridDim.x * 8;
    unsigned char* ws = launder(p->ws);
    const bf16_t* X = (const bf16_t*)(ws + WS_X); bf16_t* XN = (bf16_t*)(ws + WS_XN);
    const float* mod = (const float*)(ws + WS_MOD) + (size_t)l * 3 * 12288;
    const float* g = p->norm_g + (size_t)(l * 2 + which_norm) * 2048;
    const int shift_c = which_norm ? 3 : 0, scale_c = which_norm ? 4 : 1;
    for (int row = gw; row < nrows; row += nw) {
        const int which = row < NLAT ? (row >> 13) : 2;
        const float* mb = mod + (size_t)which * 12288;
        f32x4 v[8]; float ss = 0.f;
        if (l == 0 && which_norm == 0) {
            const float* xr = row < NLAT ? p->x + (size_t)row * 2048 : p->ctx + (size_t)(row - NLAT) * 2048;
#pragma unroll
            for (int i = 0; i < 8; ++i) v[i] = *(const f32x4*)(xr + i * 256 + lane * 4);
        } else {
            const bf16_t* xr = X + (size_t)row * 2048;
            u32x2 xb[8];
#pragma unroll
            for (int i = 0; i < 8; ++i) xb[i] = *(const u32x2*)(xr + i * 256 + lane * 4);
#pragma unroll
            for (int i = 0; i < 8; ++i) { v[i][0] = bflo(xb[i].x); v[i][1] = bfhi(xb[i].x); v[i][2] = bflo(xb[i].y); v[i][3] = bfhi(xb[i].y); }
        }
#pragma unroll
        for (int i = 0; i < 8; ++i) ss += v[i][0] * v[i][0] + v[i][1] * v[i][1] + v[i][2] * v[i][2] + v[i][3] * v[i][3];
        ss = wave_sum(ss);
        const float rstd = rsqrtf(ss * (1.0f / 2048.0f) + EPSF);
        f32x4 ggv[8], shv[8], scv[8];
#pragma unroll
        for (int i = 0; i < 8; ++i) { const int c = i * 256 + lane * 4; ggv[i] = *(const f32x4*)(g + c); shv[i] = *(const f32x4*)(mb + shift_c * 2048 + c); scv[i] = *(const f32x4*)(mb + scale_c * 2048 + c); }
#pragma unroll
        for (int i = 0; i < 8; ++i) { const int c = i * 256 + lane * 4;
            const f32x4 gg = ggv[i], sh = shv[i], sc = scv[i];
            float o[4];
#pragma unroll
            for (int j = 0; j < 4; ++j) o[j] = v[i][j] * rstd * gg[j] * (1.0f + sc[j]) + sh[j];
            u32x2 w; w.x = pk2(o[0], o[1]); w.y = pk2(o[2], o[3]); *(u32x2*)(XN + (size_t)row * 2048 + c) = w;
            if (which_norm == 0) { int d = 0; d = __builtin_amdgcn_cvt_pk_fp8_f32(fminf(fmaxf(o[0], -448.f), 448.f), fminf(fmaxf(o[1], -448.f), 448.f), d, false);
                d = __builtin_amdgcn_cvt_pk_fp8_f32(fminf(fmaxf(o[2], -448.f), 448.f), fminf(fmaxf(o[3], -448.f), 448.f), d, true); *(unsigned*)(ws + WS_XN8 + (size_t)row * 2048 + c) = (unsigned)d; } }
    }
}

__device__ __forceinline__ void phase_gates_gemm(KP p, int l, int wid0) {
    const int tid = tid_fresh(wid0); const int lane = tid & 63, gw = blockIdx.x * 8 + (tid >> 6), nw = gridDim.x * 8;
    unsigned char* ws = launder(p->ws);
    const bf16_t* XN = (const bf16_t*)(ws + WS_XN); const bf16_t* WG = (const bf16_t*)(ws + WS_WG); float* GA = (float*)(ws + WS_GATES);
    const int q4 = lane >> 4, c = lane & 15;
    const float gb0 = p->a_gate_b[l * 32 + c], gb1 = p->a_gate_b[l * 32 + 16 + c];
    for (int task = gw; task < MR / 16; task += nw) {
        const int r0 = task * 16;
        f32x4 acc0 = {0.f, 0.f, 0.f, 0.f}, acc1 = {0.f, 0.f, 0.f, 0.f};
        const bf16_t* ap = XN + (size_t)(r0 + c) * 2048 + 8 * q4; const bf16_t* b0 = WG + (size_t)c * 2048 + 8 * q4; const bf16_t* b1 = b0 + 16 * 2048;
#pragma unroll 4
        for (int ks = 0; ks < 64; ++ks) { const bf16x8 a = *(const bf16x8*)(ap + ks * 32), x0 = *(const bf16x8*)(b0 + ks * 32), x1 = *(const bf16x8*)(b1 + ks * 32);
            acc0 = mfma16(a, x0, acc0); acc1 = mfma16(a, x1, acc1); }
#pragma unroll
        for (int r = 0; r < 4; ++r) {
            const float v0 = acc0[r] + gb0, v1 = acc1[r] + gb1;
            GA[(size_t)(r0 + 4 * q4 + r) * 32 + c] = (c >= 8) ? logsigmoidf_(v0) : v0; GA[(size_t)(r0 + 4 * q4 + r) * 32 + 16 + c] = (c >= 8) ? logsigmoidf_(v1) : v1; }
    }
}

__device__ __forceinline__ void phase_e1(KP p, int l, int wid0) {
    const int tid = tid_fresh(wid0); const int lane = tid & 63, gw = blockIdx.x * 8 + (tid >> 6), nw = gridDim.x * 8;
    unsigned char* ws = launder(p->ws);
    bf16_t* PQ = (bf16_t*)(ws + WS_PQ); bf16_t* PK = (bf16_t*)(ws + WS_PK); bf16_t* CQ = (bf16_t*)(ws + WS_CQ); bf16_t* CK = (bf16_t*)(ws + WS_CK);
    bf16_t* BB = (bf16_t*)(ws + WS_BB); const bf16_t* BC = (const bf16_t*)(ws + WS_BC); const bf16_t* BX = (const bf16_t*)(ws + WS_BX);
    float* GA = (float*)(ws + WS_GATES); const float* tab = (const float*)(ws + WS_TAB);
    const float* gq = p->c_qk_g + (size_t)(l * 2 + 0) * 128; const float* gk = p->c_qk_g + (size_t)(l * 2 + 1) * 128;
    const float* cw = p->b_conv + (size_t)l * 3 * 2048;
    float gqv[8], gkv[8];
#pragma unroll
    for (int j = 0; j < 8; ++j) { gqv[j] = gq[(lane & 15) * 8 + j] * 0.12751743082459868f;        gkv[j] = gk[(lane & 15) * 8 + j]; }
    const int nitems = NLAT / 8 + NCTX;
    for (int item = gw; item < nitems; item += nw) {
        const int row_first = item < NLAT / 8 ? item * 8 : NLAT + (item - NLAT / 8), nrun = item < NLAT / 8 ? 8 : 1;
        for (int rr = 0; rr < nrun; ++rr) { const int row = row_first + rr;
        if (row < NLAT) {
            const int s = row & 8191, gr = s >> 6, gc = s & 63;
#pragma unroll
            for (int it = 0; it < 2; ++it) {
                const int unit = it * 64 + lane, h = unit >> 4, hf = (unit >> 3) & 1, j4 = unit & 7;
                const int off = h * 128 + hf * 64 + j4 * 4, pos = hf ? gc : gr;
                const f32x4 cs = *(const f32x4*)(tab + pos * 32 + j4 * 4), sn = *(const f32x4*)(tab + 4096 + pos * 32 + j4 * 4);
#pragma unroll
                for (int tsel = 0; tsel < 2; ++tsel) { bf16_t* T = (tsel ? PK : PQ) + (size_t)row * 1024 + off;
                    const u32x2 u1 = *(const u32x2*)T, u2 = *(const u32x2*)(T + 32);
                    const float a0 = bflo(u1.x), a1 = bfhi(u1.x), a2 = bflo(u1.y), a3 = bfhi(u1.y), b0 = bflo(u2.x), b1 = bfhi(u2.x), b2 = bflo(u2.y), b3 = bfhi(u2.y);
                    u32x2 o1, o2;
                    o1.x = pk2(a0 * cs[0] - b0 * sn[0], a1 * cs[1] - b1 * sn[1]); o1.y = pk2(a2 * cs[2] - b2 * sn[2], a3 * cs[3] - b3 * sn[3]);
                    o2.x = pk2(b0 * cs[0] + a0 * sn[0], b1 * cs[1] + a1 * sn[1]); o2.y = pk2(b2 * cs[2] + a2 * sn[2], b3 * cs[3] + a3 * sn[3]);
                    *(u32x2*)T = o1; *(u32x2*)(T + 32) = o2; }
            }
        }
#pragma unroll
        for (int tsel = 0; tsel < 2; ++tsel) {
            bf16_t* T = (tsel ? CK : CQ) + (size_t)row * 2048;
            u32x4 wq4[4];
#pragma unroll
            for (int ps = 0; ps < 4; ++ps) wq4[ps] = *(const u32x4*)(T + ps * 512 + lane * 8);
#pragma unroll
            for (int ps = 0; ps < 4; ++ps) {
                const u32x4 w = wq4[ps];
                float v[8] = {bflo(w.x), bfhi(w.x), bflo(w.y), bfhi(w.y), bflo(w.z), bfhi(w.z), bflo(w.w), bfhi(w.w)};
                float ss = 0.f;
#pragma unroll
                for (int j = 0; j < 8; ++j) ss += v[j] * v[j];
                ss += __shfl_xor(ss, 1); ss += __shfl_xor(ss, 2); ss += __shfl_xor(ss, 4); ss += __shfl_xor(ss, 8);
                const float rstd = rsqrtf(ss * (1.0f / 128.0f) + EPSF);
#pragma unroll
                for (int j = 0; j < 8; ++j) v[j] = v[j] * rstd * (tsel ? gkv[j] : gqv[j]);
                u32x4 o; o.x = pk2(v[0], v[1]); o.y = pk2(v[2], v[3]); o.z = pk2(v[4], v[5]); o.w = pk2(v[6], v[7]);
                *(u32x4*)(T + ps * 512 + lane * 8) = o;
            }
        }
        }
        {
            int pos0, len; if (row_first < NLAT) { pos0 = row_first & 8191; len = SEQ; } else { pos0 = (row_first - NLAT) & 255; len = CTXL; }
#pragma unroll 1
            for (int ps = 0; ps < 4; ++ps) {
                const int c = ps * 512 + lane * 8;
                float w0[8], w1[8], w2[8];
#pragma unroll
                for (int hq = 0; hq < 2; ++hq) { const f32x4 a = *(const f32x4*)(cw + c + hq * 4), bq = *(const f32x4*)(cw + 2048 + c + hq * 4), cq = *(const f32x4*)(cw + 4096 + c + hq * 4);
#pragma unroll
                    for (int j = 0; j < 4; ++j) { w0[hq * 4 + j] = a[j]; w1[hq * 4 + j] = bq[j]; w2[hq * 4 + j] = cq[j]; } }
                u32x4 cvr[10], xvr[10], bbr[8];
                const u32x4 zero4 = {0u, 0u, 0u, 0u};
#pragma unroll
                for (int k = 0; k < 10; ++k) { const int rel = k - 1; const bool ok = (rel <= nrun) && (pos0 + rel >= 0) && (pos0 + rel < len) && (rel < nrun || pos0 + rel < len);
                    if (ok && rel <= nrun) { const size_t o = (size_t)(row_first + rel) * 2048 + c; cvr[k] = *(const u32x4*)(BC + o); xvr[k] = *(const u32x4*)(BX + o); } else { cvr[k] = zero4; xvr[k] = zero4; } }
#pragma unroll
                for (int rr = 0; rr < 8; ++rr) bbr[rr] = (rr < nrun) ? *(const u32x4*)(BB + (size_t)(row_first + rr) * 2048 + c) : zero4;
                float up[8], uc[8], un[8];
                auto mk_u = [&](const u32x4 cv, const u32x4 xv, float (&u)[8]) {
                    u[0] = bflo(cv.x) * bflo(xv.x); u[1] = bfhi(cv.x) * bfhi(xv.x); u[2] = bflo(cv.y) * bflo(xv.y); u[3] = bfhi(cv.y) * bfhi(xv.y);
                    u[4] = bflo(cv.z) * bflo(xv.z); u[5] = bfhi(cv.z) * bfhi(xv.z); u[6] = bflo(cv.w) * bflo(xv.w); u[7] = bfhi(cv.w) * bfhi(xv.w); };
                mk_u(cvr[0], xvr[0], up); mk_u(cvr[1], xvr[1], uc);
#pragma unroll
                for (int rr = 0; rr < 8; ++rr) {
                    if (rr < nrun) {
                        mk_u(cvr[rr + 2], xvr[rr + 2], un);
                        const size_t o = (size_t)(row_first + rr) * 2048 + c; const u32x4 bb = bbr[rr];
                        const float bv[8] = {bflo(bb.x), bfhi(bb.x), bflo(bb.y), bfhi(bb.y), bflo(bb.z), bfhi(bb.z), bflo(bb.w), bfhi(bb.w)};
                        float y[8];
#pragma unroll
                        for (int j = 0; j < 8; ++j) y[j] = bv[j] * (up[j] * w0[j] + uc[j] * w1[j] + un[j] * w2[j]);
                        u32x4 ov; ov.x = pk2(y[0], y[1]); ov.y = pk2(y[2], y[3]); ov.z = pk2(y[4], y[5]); ov.w = pk2(y[6], y[7]);
                        *(u32x4*)(BB + o) = ov;
#pragma unroll
                        for (int j = 0; j < 8; ++j) { up[j] = uc[j]; uc[j] = un[j]; }
                    }
                }
            }
        }
    }
}

constexpr int ML_QS = 0, ML_KS = 17408, ML_VT = 53248, ML_CT = 69376, ML_CTSZ = 13056, ML_PRE_TOT = 3 * 8448 * 4;
__device__ __forceinline__ int ml_row(int pp, int b, int dir) {
    if (pp < 256) { const int j = dir ? 255 - pp : pp; return NLAT + b * 256 + j; }
    int s = pp - 256; if (dir) s = 8191 - s; return b * 8192 + s;
}
__device__ __forceinline__ void phase_mlstm(KP p, int l, LAS unsigned char* lds, int wid0) {
    const int tid = tid_fresh(wid0), lane = tid & 63, w = __builtin_amdgcn_readfirstlane(tid >> 6), q4 = lane >> 4, c16 = lane & 15;
    unsigned char* ws = launder(p->ws);
    const bf16_t* PQ = (const bf16_t*)(ws + WS_PQ); const bf16_t* PK = (const bf16_t*)(ws + WS_PK); const bf16_t* PV = (const bf16_t*)(ws + WS_PV);
    const float* GA = (const float*)(ws + WS_GATES);
    for (int task = blockIdx.x; task < 256; task += gridDim.x) {
        const int xq = task & 7, yq = task >> 3; const int bh = 2 * xq + (yq >> 4), dir = (yq >> 3) & 1, sl = yq & 7; const int b = bh >> 3, h = bh & 7;
        bf16_t* H = (bf16_t*)(ws + (dir ? WS_BX : WS_BC));
        float* SCN = (float*)(ws + WS_SCAN) + (size_t)task * 5 * 8448;
        __syncthreads();
        {
            LAS float* PB = (LAS float*)lds; LAS float* TOT = (LAS float*)(lds + ML_PRE_TOT);
            float li_n = 0.f, lf_n = 0.f;
            if (w < 132) { const int r = ml_row(w * 64 + lane, b, dir); li_n = GA[(size_t)r * 32 + (2 * dir) * 8 + h]; lf_n = GA[(size_t)r * 32 + (2 * dir + 1) * 8 + h]; }
            for (int cc = w; cc < 132; cc += 8) {
                const float li = li_n, lf = lf_n;
                if (cc + 8 < 132) { const int r = ml_row((cc + 8) * 64 + lane, b, dir); li_n = GA[(size_t)r * 32 + (2 * dir) * 8 + h]; lf_n = GA[(size_t)r * 32 + (2 * dir + 1) * 8 + h]; }
                float bc = lf;
#pragma unroll
                for (int o = 1; o < 64; o <<= 1) { const float t = __shfl_up(bc, o); if (lane >= o) bc += t; }
                const float a = li - bc;
                float pm = a;
#pragma unroll
                for (int o = 1; o < 64; o <<= 1) { const float t = __shfl_up(pm, o); if (lane >= o) pm = fmaxf(pm, t); }
                PB[cc * 64 + lane] = bc; PB[8448 + cc * 64 + lane] = a; PB[2 * 8448 + cc * 64 + lane] = pm;
                if (lane == 63) { TOT[cc] = bc; TOT[256 + cc] = pm; }
            }
            __syncthreads();
            const float t0 = TOT[lane], p0 = TOT[256 + lane], t1 = TOT[64 + lane], p1 = TOT[256 + 64 + lane], t2 = TOT[128 + (lane & 3)], p2 = TOT[256 + 128 + (lane & 3)];
            float m = 0.f, mk0 = 0.f, mk1 = 0.f, mk2 = 0.f;
#pragma unroll 4
            for (int c = 0; c < 64; ++c) { if (lane == c) mk0 = m; m = rlane(t0, c) + fmaxf(m, rlane(p0, c)); }
#pragma unroll 4
            for (int c = 0; c < 64; ++c) { if (lane == c) mk1 = m; m = rlane(t1, c) + fmaxf(m, rlane(p1, c)); }
#pragma unroll
            for (int c = 0; c < 4; ++c) { if (lane == c) mk2 = m; m = rlane(t2, c) + fmaxf(m, rlane(p2, c)); }
            for (int cc = w; cc < 132; cc += 8) {
                const float mkk = (cc < 64) ? mk0 : (cc < 128 ? mk1 : mk2);
                const float mc = rlane(mkk, cc & 63);
                const float bc = PB[cc * 64 + lane], a = PB[8448 + cc * 64 + lane], pm = PB[2 * 8448 + cc * 64 + lane];
                const float pmall = rlane(pm, 63);
                const float mx = fmaxf(mc, pm), mref = fmaxf(mc, pmall);
                SCN[cc * 64 + lane] = __expf(mc - mx);
                SCN[8448 + cc * 64 + lane] = __expf(fminf(mref - mx, 80.0f));
                SCN[2 * 8448 + cc * 64 + lane] = __expf(-(bc + mx));
                SCN[3 * 8448 + cc * 64 + lane] = __expf(a - mref);
                if (lane == 0) SCN[4 * 8448 + cc] = __expf(mc - mref);
            }
        }
        __syncthreads();
        for (int i = tid; i < 16 * 32; i += NTHREADS) { const int r = 32 + (i >> 5), cdw = i & 31; *(LAS unsigned*)(lds + ML_VT + r * 144 + cdw * 4) = 0x3f803f80u; }
        for (int i = tid; i < 2 * ML_CTSZ / 4; i += NTHREADS) *(LAS unsigned*)(lds + ML_CT + i * 4) = 0u;
        __syncthreads();
        f32x4 Cst[3];
#pragma unroll
        for (int i = 0; i < 3; ++i) Cst[i] = (f32x4){0.f, 0.f, 0.f, 0.f};
        u32x4 qreg[2], kreg[2], vreg; float eak[2], decay; f32x4 wi4, em4, emr4;
        const int qrow_l = lane >> 4, qpc = lane & 15, vrow_l = lane >> 2, vpc = lane & 3;
        const int tr = w >> 1, part = w & 1;
        const int sgn = dir ? -1 : 1;
        const unsigned char* PQb = (const unsigned char*)PQ; const unsigned char* PKb = (const unsigned char*)PK; const unsigned char* PVb = (const unsigned char*)PV;
        const unsigned char* SCb = (const unsigned char*)SCN; unsigned char* Hb = (unsigned char*)H;
        const int lq0 = (sgn * (8 * w + qrow_l) * 1024 + h * 128 + qpc * 8) * 2, lq1 = lq0 + sgn * 4 * 2048;
        const int lv = (sgn * (16 * w + vrow_l) * 2048 + h * 256 + sl * 32 + vpc * 8) * 2;
        const int lh = (sgn * (16 * tr + 4 * q4) * 2048 + h * 256 + sl * 32 + 16 * part + c16) * 2;
        const int lea = (3 * 8448 + 8 * w + qrow_l) * 4, lwi = (16 * tr + 4 * q4) * 4;
#define ML_PREFETCH(cn) do { const int _r0 = ml_row((cn) * 64, b, dir); const unsigned _q = (unsigned)_r0 * 2048u, _v = (unsigned)_r0 * 4096u, _s = (unsigned)(cn) * 256u; \
            qreg[0] = *(const u32x4*)(PQb + (_q + (unsigned)lq0)); kreg[0] = *(const u32x4*)(PKb + (_q + (unsigned)lq0)); qreg[1] = *(const u32x4*)(PQb + (_q + (unsigned)lq1)); kreg[1] = *(const u32x4*)(PKb + (_q + (unsigned)lq1)); \
            eak[0] = *(const float*)(SCb + (_s + (unsigned)lea)); eak[1] = *(const float*)(SCb + (_s + (unsigned)lea + 16u)); \
            if (w < 4) vreg = *(const u32x4*)(PVb + (_v + (unsigned)lv)); \
            } while (0)
#define ML_PREFETCH_OUT(cn) do { const unsigned _s = (unsigned)(cn) * 256u; \
            wi4 = *(const f32x4*)(SCb + (_s + (unsigned)lwi)); em4 = *(const f32x4*)(SCb + (_s + (unsigned)lwi + 8448u * 4u)); emr4 = *(const f32x4*)(SCb + (_s + (unsigned)lwi + 2u * 8448u * 4u)); \
            decay = *(const float*)(SCb + (4u * 8448u * 4u + (unsigned)(cn) * 4u)); } while (0)
        ML_PREFETCH(0); ML_PREFETCH_OUT(0);
        for (int c = 0; c < 132; ++c) {
#pragma unroll
            for (int i = 0; i < 2; ++i) { const int sr = 8 * w + 4 * i + qrow_l;
                *(LAS u32x4*)(lds + ML_QS + sr * 272 + qpc * 16) = qreg[i];
                const float e = eak[i]; const u32x4 kk4 = kreg[i]; u32x4 ks;
                ks.x = pk2(bflo(kk4.x) * e, bfhi(kk4.x) * e); ks.y = pk2(bflo(kk4.y) * e, bfhi(kk4.y) * e); ks.z = pk2(bflo(kk4.z) * e, bfhi(kk4.z) * e); ks.w = pk2(bflo(kk4.w) * e, bfhi(kk4.w) * e);
                *(LAS u32x4*)(lds + ML_KS + sr * 272 + qpc * 16) = ks; }
            if (w < 4) { const unsigned vw[4] = {vreg.x, vreg.y, vreg.z, vreg.w}; const int sv = 16 * w + vrow_l;
#pragma unroll
                for (int j = 0; j < 4; ++j) { const int e = vpc * 8 + 2 * j;
                    *(LAS bf16_t*)(lds + ML_VT + e * 144 + sv * 2) = (bf16_t)(vw[j] & 0xffffu);
                    *(LAS bf16_t*)(lds + ML_VT + (e + 1) * 144 + sv * 2) = (bf16_t)(vw[j] >> 16); } }
            if (c + 1 < 132) ML_PREFETCH(c + 1);
            LDS_BARRIER();
            const LAS unsigned char* CTc = lds + ML_CT + (c & 1) * ML_CTSZ;
            const LAS unsigned char* kbase = lds + ML_KS + c16 * 272 + 8 * q4 * 2;
            const LAS unsigned char* vbase1 = lds + ML_VT + (16 * part + c16) * 144 + 4 * q4 * 2, * vbase2 = lds + ML_VT + (32 + c16) * 144 + 4 * q4 * 2;
            bf16x8 aq[4], ka[2][4], cb1[4], cb2[4]; u32x2 vf[4];
#pragma unroll
            for (int ks = 0; ks < 4; ++ks) aq[ks] = *(const LAS bf16x8*)(lds + ML_QS + (16 * tr + c16) * 272 + (ks * 32 + 8 * q4) * 2);
#pragma unroll
            for (int ks = 0; ks < 4; ++ks) { ka[0][ks] = *(const LAS bf16x8*)(kbase + ks * 64); ka[1][ks] = *(const LAS bf16x8*)(kbase + 16 * 272 + ks * 64); }
#pragma unroll
            for (int ks = 0; ks < 4; ++ks) { cb1[ks] = *(const LAS bf16x8*)(CTc + (16 * part + c16) * 272 + (ks * 32 + 8 * q4) * 2); cb2[ks] = *(const LAS bf16x8*)(CTc + (32 + c16) * 272 + (ks * 32 + 8 * q4) * 2); }
            vf[0] = *(const LAS u32x2*)(vbase1); vf[1] = *(const LAS u32x2*)(vbase1 + 32); vf[2] = *(const LAS u32x2*)(vbase2); vf[3] = *(const LAS u32x2*)(vbase2 + 32);
            __builtin_amdgcn_sched_barrier(0);
            f32x4 accA = {0.f, 0.f, 0.f, 0.f}, accD = {0.f, 0.f, 0.f, 0.f}, s0 = {0.f, 0.f, 0.f, 0.f}, s1 = {0.f, 0.f, 0.f, 0.f};
#pragma unroll
            for (int ks = 0; ks < 4; ++ks) { s0 = mfma16(ka[0][ks], aq[ks], s0); s1 = mfma16(ka[1][ks], aq[ks], s1); accA = mfma16(aq[ks], cb1[ks], accA); accD = mfma16(aq[ks], cb2[ks], accD); }
            __builtin_amdgcn_sched_barrier(0);
            bf16x8 kb[2][4]; u32x2 vg[4];
#pragma unroll
            for (int ks = 0; ks < 4; ++ks) { kb[0][ks] = *(const LAS bf16x8*)(kbase + 32 * 272 + ks * 64); kb[1][ks] = *(const LAS bf16x8*)(kbase + 48 * 272 + ks * 64); }
            vg[0] = *(const LAS u32x2*)(vbase1 + 64); vg[1] = *(const LAS u32x2*)(vbase1 + 96); vg[2] = *(const LAS u32x2*)(vbase2 + 64); vg[3] = *(const LAS u32x2*)(vbase2 + 96);
            __builtin_amdgcn_sched_barrier(0);
            const int dq = 4 * q4 - 16 * tr - c16;
            f32x4 accIA, accID;
            {
                float pe[8];
#pragma unroll
                for (int r = 0; r < 4; ++r) { pe[r] = (r + dq <= 0) ? s0[r] : 0.f; pe[4 + r] = (16 + r + dq <= 0) ? s1[r] : 0.f; }
                u32x4 pw; pw.x = pk2(pe[0], pe[1]); pw.y = pk2(pe[2], pe[3]); pw.z = pk2(pe[4], pe[5]); pw.w = pk2(pe[6], pe[7]);
                const bf16x8 pf = __builtin_bit_cast(bf16x8, pw);
                u32x4 bw1, bw2; bw1.x = vf[0].x; bw1.y = vf[0].y; bw1.z = vf[1].x; bw1.w = vf[1].y; bw2.x = vf[2].x; bw2.y = vf[2].y; bw2.z = vf[3].x; bw2.w = vf[3].y;
                accIA = mfma16(pf, __builtin_bit_cast(bf16x8, bw1), (f32x4){0.f, 0.f, 0.f, 0.f}); accID = mfma16(pf, __builtin_bit_cast(bf16x8, bw2), (f32x4){0.f, 0.f, 0.f, 0.f});
            }
            if (tr >= 2) {
                f32x4 s2 = {0.f, 0.f, 0.f, 0.f}, s3 = {0.f, 0.f, 0.f, 0.f};
#pragma unroll
                for (int ks = 0; ks < 4; ++ks) { s2 = mfma16(kb[0][ks], aq[ks], s2); s3 = mfma16(kb[1][ks], aq[ks], s3); }
                float pe[8];
#pragma unroll
                for (int r = 0; r < 4; ++r) { pe[r] = (32 + r + dq <= 0) ? s2[r] : 0.f; pe[4 + r] = (48 + r + dq <= 0) ? s3[r] : 0.f; }
                u32x4 pw; pw.x = pk2(pe[0], pe[1]); pw.y = pk2(pe[2], pe[3]); pw.z = pk2(pe[4], pe[5]); pw.w = pk2(pe[6], pe[7]);
                const bf16x8 pf = __builtin_bit_cast(bf16x8, pw);
                u32x4 bw1, bw2; bw1.x = vg[0].x; bw1.y = vg[0].y; bw1.z = vg[1].x; bw1.w = vg[1].y; bw2.x = vg[2].x; bw2.y = vg[2].y; bw2.z = vg[3].x; bw2.w = vg[3].y;
                accIA = mfma16(pf, __builtin_bit_cast(bf16x8, bw1), accIA); accID = mfma16(pf, __builtin_bit_cast(bf16x8, bw2), accID);
            }
            bf16x8 ak[2], bv[3][2];
#pragma unroll
            for (int k2 = 0; k2 < 2; ++k2) {
                const s16x4 t0 = __builtin_amdgcn_ds_read_tr16_b64_v4i16((LAS s16x4*)(lds + ML_KS + (k2 * 32 + 8 * q4 + (c16 >> 2)) * 272 + (16 * w + 4 * (c16 & 3)) * 2));
                const s16x4 t1 = __builtin_amdgcn_ds_read_tr16_b64_v4i16((LAS s16x4*)(lds + ML_KS + (k2 * 32 + 8 * q4 + 4 + (c16 >> 2)) * 272 + (16 * w + 4 * (c16 & 3)) * 2));
                ak[k2] = __builtin_shufflevector(t0, t1, 0, 1, 2, 3, 4, 5, 6, 7);
            }
#pragma unroll
            for (int ct = 0; ct < 3; ++ct)
#pragma unroll
                for (int k2 = 0; k2 < 2; ++k2) bv[ct][k2] = *(const LAS bf16x8*)(lds + ML_VT + (16 * ct + c16) * 144 + (k2 * 32 + 8 * q4) * 2);
            __builtin_amdgcn_sched_barrier(0);
            if (l == 0 || c >= 4) {
                const unsigned hb = (unsigned)ml_row(c * 64, b, dir) * 4096u + (unsigned)lh;
#pragma unroll
                for (int r = 0; r < 4; ++r) {
                    const float num = wi4[r] * accA[r] + em4[r] * accIA[r], den = wi4[r] * accD[r] + em4[r] * accID[r];
                    const float hv = num * __builtin_amdgcn_rcpf(fmaxf(fabsf(den), emr4[r]));
                    *(bf16_t*)(Hb + (hb + (unsigned)(r * sgn * 4096))) = f2bf(hv);
                }
            }
            {
                LAS unsigned char* CTn = lds + ML_CT + ((c + 1) & 1) * ML_CTSZ;
#pragma unroll
                for (int ct = 0; ct < 3; ++ct) {
                    Cst[ct] = Cst[ct] * decay;
#pragma unroll
                    for (int k2 = 0; k2 < 2; ++k2) Cst[ct] = mfma16(ak[k2], bv[ct][k2], Cst[ct]);
                }
                if (c + 1 < 132) ML_PREFETCH_OUT(c + 1);
#pragma unroll
                for (int ct = 0; ct < 3; ++ct) { u32x2 o; o.x = pk2(Cst[ct][0], Cst[ct][1]); o.y = pk2(Cst[ct][2], Cst[ct][3]);
                    *(LAS u32x2*)(CTn + (16 * ct + c16) * 272 + (16 * w + 4 * q4) * 2) = o; }
            }
            LDS_BARRIER();
        }
#undef ML_PREFETCH
#undef ML_PREFETCH_OUT
    }
}

constexpr int AT_KS = 0, AT_VS = 17408, AT_RPB = 35840;
__device__ __forceinline__ void phase_attn(KP p, int l, LAS unsigned char* lds, int wid0) {
    const int tid = tid_fresh(wid0), lane = tid & 63, w = __builtin_amdgcn_readfirstlane(tid >> 6), q4 = lane >> 4, c16 = lane & 15;
    unsigned char* ws = launder(p->ws);
    bf16_t* CQ = (bf16_t*)(ws + WS_CQ); const bf16_t* CK = (const bf16_t*)(ws + WS_CK); const bf16_t* CV = (const bf16_t*)(ws + WS_CV);
    const int nunits = 2048 + (l == 0 ? 64 : 0);
    for (int u = blockIdx.x; u < nunits; u += gridDim.x) {
        int b, h, qrow = 0, g = 0, ntl = 0, r0a = 0, qbase;  bool is_ctx = u >= 2048;
        if (!is_ctx) { b = u >> 10; h = (u >> 6) & 15; const int rp = u & 63; qrow = 2 * rp + (w >> 2); g = w & 3;
            r0a = min(max(2 * rp - 4, 0), 120); const int r0b = min(max(2 * rp + 1 - 4, 0), 120); ntl = r0b + 8 - r0a;
            qbase = b * 8192 + qrow * 64 + 16 * g; }
        else { const int uu = u - 2048; b = uu >> 5; h = (uu >> 1) & 15; qbase = NLAT + b * 256 + (uu & 1) * 128 + 16 * w; }
        const int r0q = min(max(qrow - 4, 0), 120);
        const int a_g = (g == 0) ? 0 : (g == 1 ? 8 : (g == 2 ? 24 : 32));
        __syncthreads();
        if (!is_ctx) for (int i = tid; i < 465; i += NTHREADS) *(LAS float*)(lds + AT_RPB + i * 4) = p->c_rpb[((size_t)l * 16 + h) * 465 + i] * 1.4426950408889634f;
        bf16x8 qf[4];
#pragma unroll
        for (int ks = 0; ks < 4; ++ks) qf[ks] = *(const bf16x8*)(CQ + (size_t)(qbase + c16) * 2048 + h * 128 + ks * 32 + 8 * q4);
        f32x4 O[8];
#pragma unroll
        for (int i = 0; i < 8; ++i) O[i] = (f32x4){0.f, 0.f, 0.f, 0.f};
        float m_run = -1e30f, l_run = 0.f;
        const int ntiles = ntl + 4;
        u32x4 kreg[2], vreg[2];
        auto tile_row = [&](int t, int key) -> int { return (t < ntl) ? (b * 8192 + (r0a + t) * 64 + key) : (NLAT + b * 256 + (t - ntl) * 64 + key); };
        const int krow_l = lane >> 4, kpc = lane & 15;
        {
#pragma unroll
          for (int i = 0; i < 2; ++i) { const int r = tile_row(0, 8 * w + 4 * i + krow_l); kreg[i] = *(const u32x4*)(CK + (size_t)r * 2048 + h * 128 + kpc * 8); vreg[i] = *(const u32x4*)(CV + (size_t)r * 2048 + h * 128 + kpc * 8); } }
        for (int t = 0; t < ntiles; ++t) {
            LDS_BARRIER();
#pragma unroll
            for (int i = 0; i < 2; ++i) { const int key = 8 * w + 4 * i + krow_l;
                *(LAS u32x4*)(lds + AT_KS + key * 272 + kpc * 16) = kreg[i];
                *(LAS u32x4*)(lds + AT_VS + key * 288 + kpc * 16) = vreg[i]; }
            if (t + 1 < ntiles) {
#pragma unroll
                for (int i = 0; i < 2; ++i) { const int r = tile_row(t + 1, 8 * w + 4 * i + krow_l); kreg[i] = *(const u32x4*)(CK + (size_t)r * 2048 + h * 128 + kpc * 8); vreg[i] = *(const u32x4*)(CV + (size_t)r * 2048 + h * 128 + kpc * 8); } }
            LDS_BARRIER();
            const bool local = t < ntl; const int kr = r0a + t;
            if (local && !(kr >= r0q && kr < r0q + 8)) continue;
            const int npass = local ? 1 : 2;
            for (int ps = 0; ps < npass; ++ps) {
                const int a0 = local ? a_g : ps * 32;
                const LAS unsigned char* kp0 = lds + AT_KS + (a0 + c16) * 272 + 8 * q4 * 2;
                bf16x8 kf[2][4];
#pragma unroll
                for (int ct = 0; ct < 2; ++ct)
#pragma unroll
                    for (int ks = 0; ks < 4; ++ks) kf[ct][ks] = *(const LAS bf16x8*)(kp0 + ct * 16 * 272 + ks * 64);
                float bs[8];
                if (local) {
                    const int qc = 16 * g + c16;
                    const LAS float* bp = (const LAS float*)(lds + AT_RPB) + ((kr - qrow + 7) * 31 + a0 + 4 * q4 - qc + 15);
#pragma unroll
                    for (int i = 0; i < 8; ++i) bs[i] = bp[16 * (i >> 2) + (i & 3)];
                    asm volatile("" : "+v"(bs[0]), "+v"(bs[1]), "+v"(bs[2]), "+v"(bs[3]), "+v"(bs[4]), "+v"(bs[5]), "+v"(bs[6]), "+v"(bs[7]));
                }
                __builtin_amdgcn_sched_barrier(0);
                f32x4 sc[2] = {{0.f, 0.f, 0.f, 0.f}, {0.f, 0.f, 0.f, 0.f}};
#pragma unroll
                for (int ks = 0; ks < 4; ++ks) { sc[0] = mfma16(kf[0][ks], qf[ks], sc[0]); sc[1] = mfma16(kf[1][ks], qf[ks], sc[1]); }
                __builtin_amdgcn_sched_barrier(0);
                s16x4 vlo[8], vhi[8];
                { const LAS unsigned char* vp0 = lds + AT_VS + (a0 + 4 * q4 + (c16 >> 2)) * 288 + 4 * (c16 & 3) * 2;
#pragma unroll
                  for (int dt = 0; dt < 8; ++dt) { vlo[dt] = __builtin_amdgcn_ds_read_tr16_b64_v4i16((LAS s16x4*)(vp0 + dt * 32)); vhi[dt] = __builtin_amdgcn_ds_read_tr16_b64_v4i16((LAS s16x4*)(vp0 + 16 * 288 + dt * 32)); } }
                __builtin_amdgcn_sched_barrier(0);
                if (local) {
                    const int qc = 16 * g + c16, col0 = min(max(qc - 8, 0), 48);
                    const int kb = a0 + 4 * q4 - col0;
#pragma unroll
                    for (int ct = 0; ct < 2; ++ct)
#pragma unroll
                        for (int r = 0; r < 4; ++r) sc[ct][r] = ((unsigned)(kb + 16 * ct + r) < 16u) ? sc[ct][r] + bs[ct * 4 + r] : -1e30f;
                }
                float mx = fmaxf(fmaxf(fmaxf(sc[0][0], sc[0][1]), fmaxf(sc[0][2], sc[0][3])), fmaxf(fmaxf(sc[1][0], sc[1][1]), fmaxf(sc[1][2], sc[1][3])));
                { const u32x2 t = __builtin_amdgcn_permlane16_swap(__float_as_uint(mx), __float_as_uint(mx), false, false); mx = fmaxf(__uint_as_float(t.x), __uint_as_float(t.y)); }
                { const u32x2 t = __builtin_amdgcn_permlane32_swap(__float_as_uint(mx), __float_as_uint(mx), false, false); mx = fmaxf(__uint_as_float(t.x), __uint_as_float(t.y)); }
                const float m_new = fmaxf(m_run, mx);
                const float alpha = __builtin_amdgcn_exp2f(m_run - m_new);
                float pe[8]; float psum = 0.f;
#pragma unroll
                for (int ct = 0; ct < 2; ++ct)
#pragma unroll
                    for (int r = 0; r < 4; ++r) { const float e = __builtin_amdgcn_exp2f(sc[ct][r] - m_new); pe[ct * 4 + r] = e; psum += e; }
                { const u32x2 t = __builtin_amdgcn_permlane16_swap(__float_as_uint(psum), __float_as_uint(psum), false, false); psum = __uint_as_float(t.x) + __uint_as_float(t.y); }
                { const u32x2 t = __builtin_amdgcn_permlane32_swap(__float_as_uint(psum), __float_as_uint(psum), false, false); psum = __uint_as_float(t.x) + __uint_as_float(t.y); }
                l_run = l_run * alpha + psum; m_run = m_new;
                bf16x8 pf; { u32x4 pw; pw.x = pk2(pe[0], pe[1]); pw.y = pk2(pe[2], pe[3]); pw.z = pk2(pe[4], pe[5]); pw.w = pk2(pe[6], pe[7]); pf = __builtin_bit_cast(bf16x8, pw); }
                if (__ballot(alpha != 1.0f) != 0ull) {
                    float al[4];
#pragma unroll
                    for (int r = 0; r < 4; ++r) al[r] = __shfl(alpha, 4 * q4 + r);
#pragma unroll
                    for (int dt = 0; dt < 8; ++dt)
#pragma unroll
                        for (int r = 0; r < 4; ++r) O[dt][r] *= al[r];
                }
#pragma unroll
                for (int dt = 0; dt < 8; ++dt) O[dt] = mfma16(pf, __builtin_shufflevector(vlo[dt], vhi[dt], 0, 1, 2, 3, 4, 5, 6, 7), O[dt]);
            }
        }
        float linv[4];
#pragma unroll
        for (int r = 0; r < 4; ++r) linv[r] = 1.0f / __shfl(l_run, 4 * q4 + r);
#pragma unroll
        for (int dt = 0; dt < 8; ++dt)
#pragma unroll
            for (int r = 0; r < 4; ++r) CQ[(size_t)(qbase + 4 * q4 + r) * 2048 + h * 128 + 16 * dt + c16] = f2bf(O[dt][r] * linv[r]);
    }
}

__device__ __forceinline__ void phase_e2(KP p, int l, int nrows, int wid0) {
    const int tid = tid_fresh(wid0); const int lane = tid & 63, gw = blockIdx.x * 8 + (tid >> 6), nw = gridDim.x * 8;
    unsigned char* ws = launder(p->ws);
    const bf16_t* HF = (const bf16_t*)(ws + WS_BC); const bf16_t* HB = (const bf16_t*)(ws + WS_BX); bf16_t* PO = (bf16_t*)(ws + WS_PO);
    const float* hg = p->a_hnorm_g + (size_t)l * 2048;
    for (int row = gw; row < nrows; row += nw) {
        u32x2 fv[8], bv[8], ovv[8];
#pragma unroll
        for (int h = 0; h < 8; ++h) { const size_t o = (size_t)row * 2048 + h * 256 + lane * 4; fv[h] = *(const u32x2*)(HF + o); bv[h] = *(const u32x2*)(HB + o); ovv[h] = *(const u32x2*)(PO + o); }
#pragma unroll
        for (int h = 0; h < 8; ++h) {
            const size_t o = (size_t)row * 2048 + h * 256 + lane * 4;
            const u32x2 f = fv[h], bb = bv[h], ov = ovv[h];
            float v[4] = {bflo(f.x) + bflo(bb.x), bfhi(f.x) + bfhi(bb.x), bflo(f.y) + bflo(bb.y), bfhi(f.y) + bfhi(bb.y)};
            float ss = v[0] * v[0] + v[1] * v[1] + v[2] * v[2] + v[3] * v[3];
            ss = wave_sum(ss);
            const float rstd = rsqrtf(ss * (1.0f / 256.0f) + EPSF);
            const f32x4 gg = *(const f32x4*)(hg + h * 256 + lane * 4);
            const float og[4] = {bflo(ov.x), bfhi(ov.x), bflo(ov.y), bfhi(ov.y)};
            float y[4];
#pragma unroll
            for (int j = 0; j < 4; ++j) y[j] = sigmoidf_(og[j]) * v[j] * rstd * gg[j];
            u32x2 wv; wv.x = pk2(y[0], y[1]); wv.y = pk2(y[2], y[3]); *(u32x2*)(PO + o) = wv;
        }
    }
}

template <int MODE>
__device__ __forceinline__ void ctx_gemm(KP p, int l, LAS unsigned char* lds, int wid0) {
    const int tid = tid_fresh(wid0); const int lane = tid & 63, w = __builtin_amdgcn_readfirstlane(tid >> 6), q4 = lane >> 4, c16 = lane & 15;
    unsigned char* ws = launder(p->ws);
    for (int task = blockIdx.x; task < (NCTX / 64) * 32; task += gridDim.x) {
        const int rg = task >> 5, cb = task & 31; const int row0 = NLAT + rg * 64, col0 = cb * 64;
        const int orow = row0 + (tid >> 3), ocol = col0 + (tid & 7) * 8;
        float yv[8];
#pragma unroll
        for (int i = 0; i < 8; ++i) yv[i] = 0.f;
#pragma unroll 1
        for (int br = 0; br < (MODE == 0 ? 3 : 1); ++br) {
            const bf16_t* A; const bf16_t* Bt;
            if (MODE == 0) { const int ti = 1 + 4 * (br == 1) + (br == 2); A = (const bf16_t*)(ws + WS_T8 + (size_t)ti * SZ_A); Bt = (const bf16_t*)(ws + WS_WA + (size_t)br * SZ_W); }
            else if (MODE == 1) { A = (const bf16_t*)(ws + WS_Y); Bt = (const bf16_t*)(ws + WS_WO); }
            else { A = (const bf16_t*)(ws + WS_XN); Bt = (const bf16_t*)(ws + WS_WQ); }
            const bf16_t* ap = A + (size_t)(row0 + c16) * 2048 + w * 256 + 8 * q4; const bf16_t* bp = Bt + (size_t)(col0 + c16) * 2048 + w * 256 + 8 * q4;
            f32x4 acc[4][4];
#pragma unroll
            for (int mi = 0; mi < 4; ++mi)
#pragma unroll
                for (int j = 0; j < 4; ++j) acc[mi][j] = (f32x4){0.f, 0.f, 0.f, 0.f};
#pragma unroll 2
            for (int ks = 0; ks < 8; ++ks) {
                bf16x8 a[4], bb[4];
#pragma unroll
                for (int mi = 0; mi < 4; ++mi) a[mi] = *(const bf16x8*)(ap + (size_t)mi * 16 * 2048 + ks * 32);
#pragma unroll
                for (int j = 0; j < 4; ++j) bb[j] = *(const bf16x8*)(bp + (size_t)j * 16 * 2048 + ks * 32);
#pragma unroll
                for (int mi = 0; mi < 4; ++mi)
#pragma unroll
                    for (int j = 0; j < 4; ++j) acc[mi][j] = mfma16(a[mi], bb[j], acc[mi][j]);
            }
            __syncthreads();
#pragma unroll
            for (int mi = 0; mi < 4; ++mi)
#pragma unroll
                for (int j = 0; j < 4; ++j)
#pragma unroll
                    for (int r = 0; r < 4; ++r) *(LAS float*)(lds + ((w * 64 + 16 * mi + 4 * q4 + r) * 64 + 16 * j + c16) * 4) = acc[mi][j][r];
            __syncthreads();
            float sv[8];
#pragma unroll
            for (int i = 0; i < 8; ++i) sv[i] = 0.f;
#pragma unroll
            for (int ww = 0; ww < 8; ++ww) { const f32x4 p0 = *(const LAS f32x4*)(lds + ((ww * 64 + (tid >> 3)) * 64 + (tid & 7) * 8) * 4), p1 = *(const LAS f32x4*)(lds + ((ww * 64 + (tid >> 3)) * 64 + (tid & 7) * 8 + 4) * 4);
                sv[0] += p0[0]; sv[1] += p0[1]; sv[2] += p0[2]; sv[3] += p0[3]; sv[4] += p1[0]; sv[5] += p1[1]; sv[6] += p1[2]; sv[7] += p1[3]; }
            if (MODE == 0) { const u32x2 g = *(const u32x2*)(ws + WS_GT + (size_t)orow * 6144 + (size_t)br * 2048 + ocol);
#pragma unroll
                for (int i = 0; i < 8; ++i) yv[i] += pg8::gq8(i < 4 ? g.x : g.y, i & 3) * (1.0f / 255.0f) * sv[i]; }
            else {
#pragma unroll
                for (int i = 0; i < 8; ++i) yv[i] = sv[i]; }
        }
        if (MODE == 1) { bf16_t* xp = (bf16_t*)(ws + WS_X) + (size_t)orow * 2048 + ocol; const float* xi = p->ctx + (size_t)(orow - NLAT) * 2048 + ocol; const float* mg = (const float*)(ws + WS_MOD) + (size_t)l * 3 * 12288 + 2 * 12288 + 2 * 2048 + ocol;
            const f32x4 x0 = *(const f32x4*)xi, x1 = *(const f32x4*)(xi + 4), g0 = *(const f32x4*)mg, g1 = *(const f32x4*)(mg + 4);
            f32x4 o0, o1; o0[0] = x0[0] + g0[0] * yv[0]; o0[1] = x0[1] + g0[1] * yv[1]; o0[2] = x0[2] + g0[2] * yv[2]; o0[3] = x0[3] + g0[3] * yv[3];
            o1[0] = x1[0] + g1[0] * yv[4]; o1[1] = x1[1] + g1[1] * yv[5]; o1[2] = x1[2] + g1[2] * yv[6]; o1[3] = x1[3] + g1[3] * yv[7];
            u32x4 ow; ow.x = pk2(o0[0], o0[1]); ow.y = pk2(o0[2], o0[3]); ow.z = pk2(o1[0], o1[1]); ow.w = pk2(o1[2], o1[3]); *(u32x4*)xp = ow; }
        else { u32x4 ov; ov.x = pk2(yv[0], yv[1]); ov.y = pk2(yv[2], yv[3]); ov.z = pk2(yv[4], yv[5]); ov.w = pk2(yv[6], yv[7]);
            *(u32x4*)((bf16_t*)(ws + (MODE == 0 ? WS_Y : WS_PV)) + (size_t)orow * 2048 + ocol) = ov; }
    }
}

constexpr int PE_MAXT = 80;
constexpr int PE_IDX = 0, PE_W = PE_MAXT * 128 * 4, PE_SCR = 2 * PE_MAXT * 128 * 4, PE_SCRSZ = 16 * 132 * 4 + 4096 + 256;
#define PE_DPPU(v, ctrl) ((unsigned)__builtin_amdgcn_update_dpp(0, (int)(v), ctrl, 0xf, 0xf, true))
__device__ __forceinline__ unsigned ordkey(float v) { const unsigned u = __float_as_uint(v); return (u & 0x80000000u) ? ~u : (u | 0x80000000u); }
__device__ __forceinline__ void phase_peer(KP p, int l, LAS unsigned char* lds, int wid0) {
    const int tid = tid_fresh(wid0), lane = tid & 63, w = __builtin_amdgcn_readfirstlane(tid >> 6), q4 = lane >> 4, c16 = lane & 15;
    unsigned char* ws = launder(p->ws);
    const bf16_t* QP = (const bf16_t*)(ws + WS_PV); const bf16_t* KEYS = (const bf16_t*)(ws + WS_KEYS);
    const bf16_t* XN = (const bf16_t*)(ws + WS_XN);
    bf16_t* X = (bf16_t*)(ws + WS_X); const float* mod = (const float*)(ws + WS_MOD) + (size_t)l * 3 * 12288;
    const int ntok = (l == 0) ? MR : NLAT, G = gridDim.x;
    const int per = (ntok + G - 1) / G; const int t_begin = blockIdx.x * per, t_end = min(ntok, t_begin + per);
    for (int tb = t_begin; tb < t_end; tb += PE_MAXT) {
        const int nt = min(PE_MAXT, t_end - tb);
        __syncthreads();
        const int ntask = (nt + 15) >> 4;
        if (w < ntask) {
            int lane_pe1 = lane; asm volatile("" : "+v"(lane_pe1));
            const int lane = lane_pe1, q4 = lane >> 4, c16 = lane & 15;
            LAS unsigned char* scr = lds + PE_SCR + w * PE_SCRSZ;
            LAS float* SC = (LAS float*)scr;
            LAS float* LS = (LAS float*)(scr + 16 * 132 * 4);
            LAS int* LI = (LAS int*)(scr + 16 * 132 * 4 + 2048);
            LAS unsigned char* PT = scr + 16 * 132 * 4 + 4096;
            if (lane < 52) {
                const int L = lane;
                const int ge16 = L >= 16, ge24 = L >= 24, ge29 = L >= 29, ge33 = L >= 33, ge36 = L >= 36, ge38 = L >= 38, ge40 = L >= 40, ge42 = L >= 42;
                int pa = ge16 + ge24 + ge29 + ge33 + ge36 + ge38 + ge40 + ge42; if (ge42) pa = 8 + (L - 42);
                int pb = L - (16 * ge16 + 8 * ge24 + 5 * ge29 + 4 * ge33 + 3 * ge36 + 2 * ge38 + 2 * ge40 + 2 * ge42); if (ge42) pb = 0;
                if (L >= 50) { pa = 15; pb = 15; }
                PT[lane * 2] = (unsigned char)pa; PT[lane * 2 + 1] = (unsigned char)pb;
            }
            const int tok_a = min(tb + 16 * w + c16, t_end - 1);
            const int tkl = lane >> 2, qq = lane & 3;
            for (int h = 0; h < 8; ++h) {
                for (int pp = 0; pp < 2; ++pp) {
                    const int hp = 2 * h + pp;
                    bf16x8 af[4];
#pragma unroll
                    for (int ks = 0; ks < 4; ++ks) af[ks] = *(const bf16x8*)(QP + (size_t)tok_a * 2048 + h * 256 + pp * 128 + ks * 32 + 8 * q4);
#pragma unroll 4
                    for (int ct = 0; ct < 8; ++ct) {
                        f32x4 acc = {0.f, 0.f, 0.f, 0.f};
#pragma unroll
                        for (int ks = 0; ks < 4; ++ks) { const bf16x8 bfr = *(const bf16x8*)(KEYS + ((size_t)hp * 128 + 16 * ct + c16) * 128 + ks * 32 + 8 * q4); acc = mfma16(af[ks], bfr, acc); }
#pragma unroll
                        for (int r = 0; r < 4; ++r) SC[(4 * q4 + r) * 132 + 16 * ct + c16] = acc[r];
                    }
                    asm volatile("s_waitcnt lgkmcnt(0)" ::: "memory");
                    unsigned key[32];
#pragma unroll
                    for (int i = 0; i < 8; ++i) { const f32x4 v = *(const LAS f32x4*)(SC + tkl * 132 + 32 * qq + 4 * i);
#pragma unroll
                        for (int j = 0; j < 4; ++j) key[4 * i + j] = ((ordkey(v[j]) >> 1) & ~127u) | (unsigned)(32 * qq + 4 * i + j); }
                    unsigned prev = 0x80000000u;
#pragma unroll 1
                    for (int r = 0; r < 16; ++r) {
                        unsigned mxd = 0u;
#pragma unroll
                        for (int i = 0; i < 32; ++i) { const unsigned d = key[i] - prev; mxd = mxd > d ? mxd : d; }
                        { const unsigned o1 = PE_DPPU(mxd, 0xB1); mxd = mxd > o1 ? mxd : o1; const unsigned o2 = PE_DPPU(mxd, 0x4E); mxd = mxd > o2 ? mxd : o2; }
                        const unsigned mxk = mxd + prev;
                        prev = mxk;
                        if (qq == (r & 3)) { const int idx = (int)(mxk & 127u); LS[(pp * 16 + tkl) * 16 + r] = SC[tkl * 132 + idx]; LI[(pp * 16 + tkl) * 16 + r] = idx; }
                    }
                    asm volatile("s_waitcnt lgkmcnt(0)" ::: "memory");
                }
                unsigned ck[13];
#pragma unroll
                for (int i = 0; i < 13; ++i) { const int cidx = qq + 4 * i;
                    if (cidx < 50) { const int a = PT[cidx * 2], bq = PT[cidx * 2 + 1]; const float sv = LS[(0 * 16 + tkl) * 16 + a] + LS[(1 * 16 + tkl) * 16 + bq]; ck[i] = ((ordkey(sv) >> 1) & ~63u) | (unsigned)cidx; }
                    else ck[i] = 0u; }
                unsigned prev = 0x80000000u; float best0 = 0.f, esum = 0.f; float myexp[4] = {0.f, 0.f, 0.f, 0.f}; int myidx[4] = {0, 0, 0, 0};
#pragma unroll
                for (int r = 0; r < 16; ++r) {
                    unsigned mxd = 0u;
#pragma unroll
                    for (int i = 0; i < 13; ++i) { const unsigned d = ck[i] - prev; mxd = mxd > d ? mxd : d; }
                    { const unsigned o1 = PE_DPPU(mxd, 0xB1); mxd = mxd > o1 ? mxd : o1; const unsigned o2 = PE_DPPU(mxd, 0x4E); mxd = mxd > o2 ? mxd : o2; }
                    const unsigned mxk = mxd + prev;
                    prev = mxk;
                    const int cidx = (int)(mxk & 63u); const int a = PT[cidx * 2], bq = PT[cidx * 2 + 1];
                    const float best = LS[(0 * 16 + tkl) * 16 + a] + LS[(1 * 16 + tkl) * 16 + bq];
                    const int eidx = LI[(0 * 16 + tkl) * 16 + a] * 128 + LI[(1 * 16 + tkl) * 16 + bq];
                    if (r == 0) best0 = best;
                    const float e = __expf(best - best0); esum += e;
                    if (qq == (r & 3)) { myexp[r >> 2] = e; myidx[r >> 2] = eidx; }
                }
                const float inv = 1.0f / esum; const int tl = 16 * w + tkl;
                if (tl < nt) {
#pragma unroll
                    for (int i = 0; i < 4; ++i) { const int r = 4 * i + qq;
                        *(LAS int*)(lds + PE_IDX + (tl * 128 + h * 16 + r) * 4) = myidx[i];
                        *(LAS float*)(lds + PE_W + (tl * 128 + h * 16 + r) * 4) = myexp[i] * inv; }
                }
                asm volatile("s_waitcnt lgkmcnt(0)" ::: "memory");
            }
        }
        __syncthreads();
        int lane_pe2 = lane; asm volatile("" : "+v"(lane_pe2));
        const int nfull = nt & ~7, nleft = nt - nfull;
        const int S = (nleft == 1 || nleft == 2 || nleft == 4) ? 8 / nleft : 1;
        const int nrounds = (nfull >> 3) + (nleft ? 1 : 0);
        for (int rd = 0; rd < nrounds; ++rd) {
            const int lane = lane_pe2;
            const bool split = (rd == (nfull >> 3)) && S > 1;
            const int tl = split ? nfull + w / S : rd * 8 + w;
            const int NB = split ? 64 / S : 64, B0 = split ? (w % S) * NB : 0;
            const bool active = tl < nt;
            if (active) {
            const int row = tb + tl;
            u32x16 xq;
#pragma unroll
            for (int i = 0; i < 4; ++i) { const u32x4 xw = *(const u32x4*)(XN + (size_t)row * 2048 + lane * 32 + i * 8); xq[4 * i] = xw.x; xq[4 * i + 1] = xw.y; xq[4 * i + 2] = xw.z; xq[4 * i + 3] = xw.w; }
            const LAS int* idxp = (const LAS int*)(lds + PE_IDX + tl * 512);
            LAS float* wp = (LAS float*)(lds + PE_W + tl * 512);
            u32x4 bufA[2], bufB[2], bufC[2], bufD[2];
#define PE_ISSUE(buf, TAB, b) do { const u32x2 _ee = *(const LAS u32x2*)(idxp + 2 * (b)); \
                buf[0] = *(const u32x4*)((TAB) + ((_ee.x << 10) + (unsigned)lane * 16u)); buf[1] = *(const u32x4*)((TAB) + ((_ee.y << 10) + (unsigned)lane * 16u)); } while (0)
#define PE_DPPF(v, ctrl) __uint_as_float((unsigned)__builtin_amdgcn_update_dpp(0, (int)__float_as_uint(v), ctrl, 0xf, 0xf, true))
#define PE_CONS_U(buf, b) do { float _p[2]; \
                _Pragma("unroll") for (int _j = 0; _j < 2; ++_j) { float _d = 0.f; \
                    _Pragma("unroll") for (int _q = 0; _q < 4; ++_q) { const unsigned _dw = buf[_j][_q]; \
                        _d = dot2bf(__builtin_bit_cast(unsigned, __builtin_amdgcn_cvt_scalef32_pk_bf16_fp4(_dw, 1.0f, 0)), xq[4 * _q + 0], _d); _d = dot2bf(__builtin_bit_cast(unsigned, __builtin_amdgcn_cvt_scalef32_pk_bf16_fp4(_dw, 1.0f, 1)), xq[4 * _q + 1], _d); \
                        _d = dot2bf(__builtin_bit_cast(unsigned, __builtin_amdgcn_cvt_scalef32_pk_bf16_fp4(_dw, 1.0f, 2)), xq[4 * _q + 2], _d); _d = dot2bf(__builtin_bit_cast(unsigned, __builtin_amdgcn_cvt_scalef32_pk_bf16_fp4(_dw, 1.0f, 3)), xq[4 * _q + 3], _d); } \
                    _p[_j] = _d; } \
                float _c; { const u32x2 _t = __builtin_amdgcn_permlane32_swap(__float_as_uint(_p[0]), __float_as_uint(_p[1]), false, false); _c = __uint_as_float(_t.x) + __uint_as_float(_t.y); }     \
                { const u32x2 _t = __builtin_amdgcn_permlane16_swap(__float_as_uint(_c), __float_as_uint(_c), false, false); _c = __uint_as_float(_t.x) + __uint_as_float(_t.y); } \
                _c += PE_DPPF(_c, 0x140); _c += PE_DPPF(_c, 0x141); _c += PE_DPPF(_c, 0x4E); _c += PE_DPPF(_c, 0xB1);        \
                if ((lane & 31) == ((((b) - B0)) & 31)) cacc = _c; } while (0)
#define PE_FLUSH(jb, cnt) do { if ((lane & 31) < (cnt)) { const int _e = 2 * (B0 + (jb) + (lane & 31)) + (lane >> 5); const float _g = wp[_e]; \
                const float _a = cacc * (1.0f / 64.0f); wp[_e] = _g * 0.5f * _a * (1.0f + erff(_a * 0.70710678118654752f)); } } while (0)
#define PE_CONS_V(buf, b) do { const f32x2 _w2 = *(const LAS f32x2*)(wp + 2 * (b)); \
                _Pragma("unroll") for (int _j = 0; _j < 2; ++_j) { const f32x2 _wv = {_w2[_j], _w2[_j]}; \
                    _Pragma("unroll") for (int _q = 0; _q < 4; ++_q) { const unsigned _dw = buf[_j][_q]; \
                        out2[4 * _q + 0] += _wv * __builtin_amdgcn_cvt_scalef32_pk_f32_fp4(_dw, 1.0f, 0); out2[4 * _q + 1] += _wv * __builtin_amdgcn_cvt_scalef32_pk_f32_fp4(_dw, 1.0f, 1); \
                        out2[4 * _q + 2] += _wv * __builtin_amdgcn_cvt_scalef32_pk_f32_fp4(_dw, 1.0f, 2); out2[4 * _q + 3] += _wv * __builtin_amdgcn_cvt_scalef32_pk_f32_fp4(_dw, 1.0f, 3); } } } while (0)
            const unsigned char* TU = ws + WS_PU; const unsigned char* TV = ws + WS_PVW;
            const int NT = 2 * NB;
            asm volatile("" : "+v"(xq));
#define PE_ISS(s_, bi) do { const int _jn = min(max(j0 + (s_) + 3, 0), NT - 1); const bool _isv = _jn >= NB; \
                const unsigned char* _tab = _isv ? TV : TU; const int _bb = B0 + (_isv ? _jn - NB : _jn); PE_ISSUE(bi, _tab, _bb); } while (0)
            float cacc = 0.f;
#pragma unroll 1
            for (int t = -1; 4 * t < NB; ++t) { const int j0 = 4 * t;
                PE_ISS(0, bufD); if (t >= 0) PE_CONS_U(bufA, B0 + j0);
                PE_ISS(1, bufA); if (t >= 0) PE_CONS_U(bufB, B0 + j0 + 1);
                PE_ISS(2, bufB); if (t >= 0) PE_CONS_U(bufC, B0 + j0 + 2);
                PE_ISS(3, bufC); if (t >= 0) PE_CONS_U(bufD, B0 + j0 + 3);
                if (t >= 0 && ((t & 7) == 7 || 4 * (t + 1) >= NB)) PE_FLUSH(32 * (t >> 3), min(32, NB - 32 * (t >> 3)));
            }
            asm volatile("s_waitcnt lgkmcnt(0)" ::: "memory");
            f32x2 out2[16];
#pragma unroll
            for (int i = 0; i < 16; ++i) out2[i] = (f32x2){0.f, 0.f};
#pragma unroll 1
            for (int t = 0; 4 * t < NB; ++t) { const int j0 = NB + 4 * t;
                PE_ISS(0, bufD); PE_CONS_V(bufA, B0 + 4 * t);
                PE_ISS(1, bufA); PE_CONS_V(bufB, B0 + 4 * t + 1);
                PE_ISS(2, bufB); PE_CONS_V(bufC, B0 + 4 * t + 2);
                PE_ISS(3, bufC); PE_CONS_V(bufD, B0 + 4 * t + 3);
            }
#undef PE_ISS
#undef PE_ISSUE
#undef PE_CONS_U
#undef PE_FLUSH
#undef PE_DPPF
#undef PE_CONS_V
            f32x32 outv;
#pragma unroll
            for (int i = 0; i < 16; ++i) { outv[2 * i] = out2[i][0]; outv[2 * i + 1] = out2[i][1]; }
            if (split) {
                LAS float* pp = (LAS float*)(lds + PE_SCR) + ((size_t)((tl - nfull) * S + (w % S)) * 64 + lane) * 32;
#pragma unroll
                for (int i = 0; i < 8; ++i) { f32x4 t4; t4[0] = outv[4 * i]; t4[1] = outv[4 * i + 1]; t4[2] = outv[4 * i + 2]; t4[3] = outv[4 * i + 3]; *(LAS f32x4*)(pp + 4 * i) = t4; }
            }
            if (!split) {
            const int which = row < NLAT ? (row >> 13) : 2;
            const float* mg = mod + (size_t)which * 12288 + 5 * 2048;
            const bf16_t* xrow = X + (size_t)row * 2048;
            u32x4 xbv[4]; f32x4 gvv[8];
#pragma unroll
            for (int i = 0; i < 4; ++i) xbv[i] = *(const u32x4*)(xrow + lane * 32 + i * 8);
#pragma unroll
            for (int hh = 0; hh < 8; ++hh) gvv[hh] = *(const f32x4*)(mg + lane * 32 + hh * 4);
#pragma unroll
            for (int i = 0; i < 4; ++i) { const u32x4 xw = xbv[i]; const f32x4 g0 = gvv[2 * i], g1 = gvv[2 * i + 1];
                f32x4 o0, o1;
                o0[0] = bflo(xw.x) + g0[0] * outv[i * 8 + 0] * 0.25f; o0[1] = bfhi(xw.x) + g0[1] * outv[i * 8 + 1] * 0.25f; o0[2] = bflo(xw.y) + g0[2] * outv[i * 8 + 2] * 0.25f; o0[3] = bfhi(xw.y) + g0[3] * outv[i * 8 + 3] * 0.25f;
                o1[0] = bflo(xw.z) + g1[0] * outv[i * 8 + 4] * 0.25f; o1[1] = bfhi(xw.z) + g1[1] * outv[i * 8 + 5] * 0.25f; o1[2] = bflo(xw.w) + g1[2] * outv[i * 8 + 6] * 0.25f; o1[3] = bfhi(xw.w) + g1[3] * outv[i * 8 + 7] * 0.25f;
                if (l == 1) { float* orow = p->out + (size_t)row * 2048 + lane * 32 + i * 8; *(f32x4*)orow = o0; *(f32x4*)(orow + 4) = o1; }
                else { u32x4 ow; ow.x = pk2(o0[0], o0[1]); ow.y = pk2(o0[2], o0[3]); ow.z = pk2(o1[0], o1[1]); ow.w = pk2(o1[2], o1[3]); *(u32x4*)(X + (size_t)row * 2048 + lane * 32 + i * 8) = ow; } }
            }
            }
            if (split) {
                __syncthreads();
                if ((w % S) == 0 && tl < nt) {
                    const int row = tb + tl;
                    const int which = row < NLAT ? (row >> 13) : 2;
                    const float* mg = mod + (size_t)which * 12288 + 5 * 2048;
                    const bf16_t* xrow = X + (size_t)row * 2048;
                    const LAS float* pp = (const LAS float*)(lds + PE_SCR) + ((size_t)((tl - nfull) * S) * 64 + lane) * 32;
                    u32x4 xbv[4];
#pragma unroll
                    for (int i = 0; i < 4; ++i) xbv[i] = *(const u32x4*)(xrow + lane * 32 + i * 8);
#pragma unroll
                    for (int i = 0; i < 4; ++i) {
                        f32x4 a0 = *(const LAS f32x4*)(pp + i * 8), a1 = *(const LAS f32x4*)(pp + i * 8 + 4);
                        for (int q = 1; q < S; ++q) { a0 += *(const LAS f32x4*)(pp + (size_t)q * 64 * 32 + i * 8); a1 += *(const LAS f32x4*)(pp + (size_t)q * 64 * 32 + i * 8 + 4); }
                        const f32x4 g0 = *(const f32x4*)(mg + lane * 32 + i * 8), g1 = *(const f32x4*)(mg + lane * 32 + i * 8 + 4);
                        const u32x4 xw = xbv[i];
                        f32x4 o0, o1;
                        o0[0] = bflo(xw.x) + g0[0] * a0[0] * 0.25f; o0[1] = bfhi(xw.x) + g0[1] * a0[1] * 0.25f; o0[2] = bflo(xw.y) + g0[2] * a0[2] * 0.25f; o0[3] = bfhi(xw.y) + g0[3] * a0[3] * 0.25f;
                        o1[0] = bflo(xw.z) + g1[0] * a1[0] * 0.25f; o1[1] = bfhi(xw.z) + g1[1] * a1[1] * 0.25f; o1[2] = bflo(xw.w) + g1[2] * a1[2] * 0.25f; o1[3] = bfhi(xw.w) + g1[3] * a1[3] * 0.25f;
                        if (l == 1) { float* orow = p->out + (size_t)row * 2048 + lane * 32 + i * 8; *(f32x4*)orow = o0; *(f32x4*)(orow + 4) = o1; }
                        else { u32x4 ow; ow.x = pk2(o0[0], o0[1]); ow.y = pk2(o0[2], o0[3]); ow.z = pk2(o1[0], o1[1]); ow.w = pk2(o1[2], o1[3]); *(u32x4*)(X + (size_t)row * 2048 + lane * 32 + i * 8) = ow; }
                    }
                }
            }
        }
    }
}

#if !MK_SINGLE
#define LOHI_ARGS , const int lo, const int hi
#define LOHI_PASS , lo, hi
#else
#define LOHI_ARGS
#define LOHI_PASS
#endif
#ifndef PHM
#define PHM 0x7ff
#endif
#if MK_SINGLE
#define IN(k) (((PHM >> (((k) % NPH))) & 1) != 0)
#define SEAM(k) do { if ((k) + 1 < 2 * NPH) xcd_barrier(bar); } while (0)
#else
#define IN(k) (((PHM >> (((k) % NPH))) & 1) && lo <= (k) && (k) < hi)
#define SEAM(k) do { if (IN(k) && IN((k) + 1)) xcd_barrier(bar); } while (0)
#endif
template <int l>
__device__ __forceinline__ void layer_program(KP kp, unsigned char* ws0, LAS unsigned char* lds, const XcdBarrier& bar, const int G, const int wid0 LOHI_ARGS) {
        const int pb = l * NPH;
        const int M2 = (l == 0) ? MR : NLAT;
        constexpr int MG = NLAT;
        if (IN(pb + 0)) { phase_w(launder_p(kp), l, lds, wid0); } SEAM(pb + 0);
        if (IN(pb + 1)) { phase_norm(launder_p(kp), l, 0, MR, wid0); } SEAM(pb + 1);
        if (IN(pb + 2)) { unsigned char* ws = launder(ws0);
            { pg8::PlainOrder S; S.init(ws + WS_XN8, ws + WS_WIN, MR, (72 - (BF_HI - BF_LO)) * 256, 1024, G, (int)blockIdx.x); S.skip_from = BF_LO; S.skip_cnt = BF_HI - BF_LO; S.skip2_from = 48; S.skip2_cnt = 24;
              if (G == 256 && BF_HI - BF_LO == 8) { S.short_rounds = 15; S.n_long = 192; }
              pg8::EpiProj E{ws};
              pg8::gemm_phase<pg8::EpiProj, pg8::PlainOrder, true>(lds, 1024, S, E, wid0); }
            { pg8::PlainOrder S; S.init(ws + WS_XN, ws + WS_WINB, MR, (24 + BF_HI - BF_LO) * 256, 2048, G, G - 1 - (int)blockIdx.x); S.pn_base = BF_LO; S.skip_from = BF_HI; S.skip_cnt = 48 - BF_HI; S.b_compact = 1;
              pg8::EpiProj E{ws};
              pg8::gemm_phase<pg8::EpiProj, pg8::PlainOrder, false>(lds, 2048, S, E, wid0); }
        } SEAM(pb + 2);
        if (IN(pb + 3)) { phase_gates_gemm(launder_p(kp), l, wid0); phase_e1(launder_p(kp), l, wid0); } SEAM(pb + 3);
        if (IN(pb + 4)) { phase_mlstm(launder_p(kp), l, lds, wid0); phase_attn(launder_p(kp), l, lds, wid0); } SEAM(pb + 4);
        if (IN(pb + 5)) { phase_e2(launder_p(kp), l, M2, wid0); } SEAM(pb + 5);
        if (IN(pb + 6)) { unsigned char* ws = launder(ws0);
            pg8::BranchOrder S; S.T8 = (const char*)(ws + WS_T8); S.WA = (const char*)(ws + WS_WA);
            S.nM = MG / 256; S.nN = 8; S.G = G; S.c = (int)blockIdx.x; S.tstep = (size_t)256 * 2048 * 2;
            pg8::EpiMerge E{(bf16_t*)(ws + WS_Y), (const unsigned char*)(ws + WS_GT)};
            pg8::gemm_phase<pg8::EpiMerge, pg8::BranchOrder>(lds, 2048, S, E, wid0);
            if (l == 0) ctx_gemm<0>(launder_p(kp), l, lds, wid0);
        } SEAM(pb + 6);
        if (IN(pb + 7)) { unsigned char* ws = launder(ws0);
            pg8::PlainOrder S; S.init(ws + WS_Y, ws + WS_WO, MG, 2048, 2048, G, (int)blockIdx.x);
            if constexpr (l == 0) { pg8::EpiRes<true> E{(bf16_t*)(ws + WS_X), kp->x, (const float*)(ws + WS_MOD) + (size_t)l * 3 * 12288};
                pg8::gemm_phase<pg8::EpiRes<true>, pg8::PlainOrder>(lds, 2048, S, E, wid0); }
            else { pg8::EpiRes<false> E{(bf16_t*)(ws + WS_X), nullptr, (const float*)(ws + WS_MOD) + (size_t)l * 3 * 12288};
                pg8::gemm_phase<pg8::EpiRes<false>, pg8::PlainOrder>(lds, 2048, S, E, wid0); }
            if (l == 0) ctx_gemm<1>(launder_p(kp), l, lds, wid0);
        } SEAM(pb + 7);
        if (IN(pb + 8)) { phase_norm(launder_p(kp), l, 1, M2, wid0); } SEAM(pb + 8);
        if (IN(pb + 9)) { unsigned char* ws = launder(ws0);
            pg8::PlainOrder S; S.init(ws + WS_XN, ws + WS_WQ, MG, 2048, 2048, G, (int)blockIdx.x);
            pg8::EpiBf E{(bf16_t*)(ws + WS_PV), 2048};
            pg8::gemm_phase<pg8::EpiBf, pg8::PlainOrder>(lds, 2048, S, E, wid0);
            if (l == 0) ctx_gemm<2>(launder_p(kp), l, lds, wid0);
        } SEAM(pb + 9);
        if (IN(pb + 10)) { phase_peer(launder_p(kp), l, lds, wid0); } SEAM(pb + 10);
    }
#undef IN
#undef SEAM

__global__ void __launch_bounds__(NTHREADS, 2) fwd_kernel(Params p) {
    extern __shared__ __attribute__((aligned(16))) unsigned char lds_raw[];
    LAS unsigned char* lds = (LAS unsigned char*)lds_raw;
    const int tid = threadIdx.x, G = gridDim.x;
    const int wid0 = __builtin_amdgcn_readfirstlane(tid >> 6);
    KP kp = (KP)__builtin_amdgcn_kernarg_segment_ptr();
    unsigned char* ws0 = kp->ws;
    volatile LAS unsigned* bst = (volatile LAS unsigned*)(lds + LDS_BYTES - 16);
    if (tid == 0) { bst[0] = 0u; bst[1] = 0u; bst[2] = 0u; bst[3] = 0u; }
    __syncthreads();
    XcdBarrier bar; bar.bar = (unsigned*)(ws0 + WS_BAR); bar.x = 0; bar.st = bst;
    if (MK_SINGLE) bar = xcd_barrier_post((unsigned*)(ws0 + WS_BAR), bst);
#if !MK_SINGLE
    const int lo = kp->ph_lo, hi = kp->ph_hi;
#endif
    layer_program<0>(kp, ws0, lds, bar, G, wid0 LOHI_PASS);
    layer_program<1>(kp, ws0, lds, bar, G, wid0 LOHI_PASS);
}

extern "C" void kernel_launch(void* const* d_in, const int* in_sizes, int n_in, void* d_out, int out_size, void* d_ws, size_t ws_size, hipStream_t stream) {
    static int grid = 0;
    if (grid == 0) {
        if (n_in != 21 || in_sizes[0] != NLAT * DM || out_size != NLAT * DM || ws_size < WS_END) {
            fprintf(stderr, "kernel_launch: unexpected shapes (n_in %d, in0 %d, out %d, ws %zu need %zu); nothing launched\n", n_in, n_in > 0 ? in_sizes[0] : -1, out_size, ws_size, (size_t)WS_END); grid = -1; return; }
        int dev = 0, cus = 0, per_cu = 0;
        if (hipGetDevice(&dev) != hipSuccess || hipDeviceGetAttribute(&cus, hipDeviceAttributeMultiprocessorCount, dev) != hipSuccess) { grid = -1; return; }
        if (hipFuncSetAttribute((const void*)fwd_kernel, hipFuncAttributeMaxDynamicSharedMemorySize, LDS_BYTES) != hipSuccess) { fprintf(stderr, "kernel_launch: hipFuncSetAttribute failed\n"); grid = -1; return; }
        if (hipOccupancyMaxActiveBlocksPerMultiprocessor(&per_cu, (const void*)fwd_kernel, NTHREADS, LDS_BYTES) != hipSuccess || per_cu < 1) { fprintf(stderr, "kernel_launch: occupancy query says %d\n", per_cu); }
        (void)hipGetLastError();
        grid = cus;
    }
    if (grid < 0) return;
    (void)hipMemsetAsync((char*)d_ws, 0, 16384, stream);
    Params p{};
    const float** pp = (const float**)&p;
    for (int i = 0; i < 21; ++i) pp[i] = (const float*)d_in[i];
    p.out = (float*)d_out; p.ws = (unsigned char*)d_ws;
#if MK_SINGLE
    p.ph_lo = 0; p.ph_hi = 2 * NPH;
    hipLaunchKernelGGL(fwd_kernel, dim3(grid), dim3(NTHREADS), LDS_BYTES, stream, p);
#else
    for (int k = 0; k < 2 * NPH; ++k) { p.ph_lo = k; p.ph_hi = k + 1; hipLaunchKernelGGL(fwd_kernel, dim3(grid), dim3(NTHREADS), LDS_BYTES, stream, p); }
#endif
}
```

```cpp
#include <hip/hip_runtime.h>
#include <stdint.h>
#include <stdio.h>
#include <type_traits>

#ifndef BF_LO
#define BF_LO 0
#define BF_HI 8
#endif
#ifndef MK_SINGLE
#define MK_SINGLE 1
#endif

#define LAS __attribute__((address_space(3)))
typedef unsigned short bf16_t;
typedef short bf16x8 __attribute__((ext_vector_type(8)));
typedef float f32x4 __attribute__((ext_vector_type(4)));
typedef float f32x2 __attribute__((ext_vector_type(2)));
typedef unsigned u32x4 __attribute__((ext_vector_type(4)));
typedef unsigned u32x2 __attribute__((ext_vector_type(2)));
typedef __bf16 bf2_t __attribute__((ext_vector_type(2)));
typedef int i32x4 __attribute__((ext_vector_type(4)));
typedef int i32x8 __attribute__((ext_vector_type(8)));
typedef float f32x16 __attribute__((ext_vector_type(16)));
typedef float f32x32 __attribute__((ext_vector_type(32)));
typedef unsigned u32x6 __attribute__((ext_vector_type(6)));
typedef __bf16 bf16x32_t __attribute__((ext_vector_type(32)));
typedef unsigned u32x16 __attribute__((ext_vector_type(16)));
typedef short s16x4 __attribute__((ext_vector_type(4)));
#ifndef FP6_INTERLEAVED
#define FP6_INTERLEAVED 1
#endif

constexpr int DM = 2048, NBATCH = 2, SEQ = 8192, CTXL = 256;
constexpr int NLAT = NBATCH * SEQ;
constexpr int NCTX = NBATCH * CTXL;
constexpr int MR = NLAT + NCTX;
constexpr int PROJ_W = 24608;
constexpr int NPROJ = 24576;
constexpr int NTHREADS = 512;
constexpr int LDS_BYTES = 163840;
constexpr int NPH = 11;
constexpr float EPSF = 1e-6f;

constexpr size_t SZ_A = (size_t)MR * 2048 * 2;
constexpr size_t WS_BAR = 0;
constexpr size_t WS_MOD = 16384;
constexpr size_t CTL_BYTES = 16384 + 2 * 3 * 12288 * 4;
constexpr size_t WS_TAB = 311296;
constexpr size_t WS_X = WS_TAB + 32768;
constexpr size_t WS_XN = WS_X + (size_t)MR * 2048 * 4;
constexpr size_t WS_Y = WS_XN + SZ_A;
constexpr size_t WS_XN8 = WS_Y;
constexpr size_t WS_PQ = WS_Y + SZ_A;
constexpr size_t WS_PK = WS_PQ + SZ_A / 2;
constexpr size_t WS_T8 = WS_PK + SZ_A / 2;
constexpr size_t WS_PV = WS_T8 + 0 * SZ_A;
constexpr size_t WS_PO = WS_T8 + 1 * SZ_A;
constexpr size_t WS_CQ = WS_T8 + 2 * SZ_A;
constexpr size_t WS_CK = WS_T8 + 3 * SZ_A;
constexpr size_t WS_CV = WS_T8 + 4 * SZ_A;
constexpr size_t WS_BB = WS_T8 + 5 * SZ_A;
constexpr size_t WS_BC = WS_T8 + 6 * SZ_A;
constexpr size_t WS_BX = WS_T8 + 7 * SZ_A;
constexpr size_t WS_GT = WS_T8 + 8 * SZ_A;
constexpr size_t WS_GATES = WS_GT + 3 * SZ_A;
constexpr size_t WS_WIN = WS_GATES + (size_t)MR * 32 * 4;
constexpr size_t WS_WINB = WS_WIN + (size_t)NPROJ * 2048;
constexpr size_t WS_WG = WS_WIN + (size_t)NPROJ * 2048 * 2;
constexpr size_t SZ_W = (size_t)2048 * 2048 * 2;
constexpr size_t WS_WA = WS_WG + 32 * 2048 * 2;
constexpr size_t WS_WB = WS_WA + SZ_W;
constexpr size_t WS_WC = WS_WB + SZ_W;
constexpr size_t WS_WO = WS_WC + SZ_W;
constexpr size_t WS_WQ = WS_WO + SZ_W;
constexpr size_t WS_KEYS = WS_WQ + SZ_W;
constexpr size_t WS_PU = WS_KEYS + 16 * 128 * 128 * 2;
constexpr size_t WS_PVW = WS_PU + (size_t)16384 * 2048 * 2;
constexpr size_t WS_SCAN = WS_PU + (size_t)16384 * 1024;
constexpr size_t WS_END = WS_PVW + (size_t)16384 * 2048 * 2;

struct Params {
    const float *x, *c, *ctx, *c_ctx, *w_ada, *b_ada, *norm_g, *w_in, *a_gate_b, *a_hnorm_g, *b_conv, *c_qk_g, *c_rpb,
        *w_a_out, *w_b_out, *w_c_out, *w_out, *peer_wq, *peer_keys, *peer_u, *peer_v;
    float* out; unsigned char* ws; int ph_lo, ph_hi;
};
#define CAS __attribute__((address_space(4)))
typedef const CAS Params* KP;
__device__ __forceinline__ KP launder_p(KP q) { asm volatile("" : "+s"(q)); return q; }

__device__ __forceinline__ unsigned char* launder(unsigned char* q) { size_t z = 0; asm volatile("" : "+s"(z)); return q + z; }
__device__ __forceinline__ int tid_fresh(int wid0) { int t = wid0 * 64 + (int)__builtin_amdgcn_mbcnt_hi(~0u, __builtin_amdgcn_mbcnt_lo(~0u, 0u)); asm volatile("" : "+v"(t)); return t; }

__device__ __forceinline__ float bf2f(unsigned b) { return __uint_as_float(b << 16); }
__device__ __forceinline__ float bflo(unsigned w) { return __uint_as_float(w << 16); }
__device__ __forceinline__ float bfhi(unsigned w) { return __uint_as_float(w & 0xffff0000u); }
__device__ __forceinline__ unsigned pk2(float lo, float hi) { f32x2 v = {lo, hi}; bf2_t b = __builtin_convertvector(v, bf2_t); return __builtin_bit_cast(unsigned, b); }
__device__ __forceinline__ bf16_t f2bf(float f) { return (bf16_t)(pk2(f, 0.f) & 0xffffu); }
__device__ __forceinline__ f32x4 mfma16(bf16x8 a, bf16x8 b, f32x4 c) { return __builtin_amdgcn_mfma_f32_16x16x32_bf16(a, b, c, 0, 0, 0); }
__device__ __forceinline__ float dot2bf(unsigned a, unsigned b, float c) { return __builtin_amdgcn_fdot2_f32_bf16(__builtin_bit_cast(bf2_t, a), __builtin_bit_cast(bf2_t, b), c, false); }
#define LDS_BARRIER() do { asm volatile("s_waitcnt lgkmcnt(0)" ::: "memory"); __builtin_amdgcn_s_barrier(); asm volatile("" ::: "memory"); } while (0)
__device__ __forceinline__ float rlane(float v, int l) { return __uint_as_float((unsigned)__builtin_amdgcn_readlane((int)__float_as_uint(v), l)); }
__device__ __forceinline__ float wave_sum(float v) {
#pragma unroll
    for (int o = 32; o >= 1; o >>= 1) v += __shfl_xor(v, o);
    return v;
}
__device__ __forceinline__ float sigmoidf_(float v) { return __builtin_amdgcn_rcpf(1.0f + __expf(-v)); }
__device__ __forceinline__ float logsigmoidf_(float v) { return fminf(v, 0.f) - log1pf(__expf(-fabsf(v))); }

#define XB_TMO      128
#define XB_XCNT(j)  (256  + 64 * (j))
#define XB_XSUB(j)  (1280 + 64 * (j))
#define XB_XGEN(j)  (2304 + 64 * (j))
#define XB_TOP      3328
#define XB_TOPGEN   3392
#define XCD_BAR_WORDS 3456
#define XB_SPIN_CAP (1u << 22)
__device__ __forceinline__ unsigned xb_ld(unsigned* p)              { return __hip_atomic_load(p, __ATOMIC_RELAXED, __HIP_MEMORY_SCOPE_AGENT); }
__device__ __forceinline__ unsigned xb_add(unsigned* p, unsigned v) { return __hip_atomic_fetch_add(p, v, __ATOMIC_RELAXED, __HIP_MEMORY_SCOPE_AGENT); }
__device__ __forceinline__ unsigned xb_xcc_id() { return (unsigned)__builtin_amdgcn_s_getreg((3 << 11) | 20) & 0xFu; }
#define XB_SPIN(cond, bar) do { unsigned _sp = 0; while (cond) { __builtin_amdgcn_s_sleep(1); \
    if ((++_sp & 255u) == 0u) { if (xb_ld(&(bar)[XB_TMO])) break; if (_sp > XB_SPIN_CAP) { atomicAdd(&(bar)[XB_TMO], 1u); break; } } } } while (0)
struct XcdBarrier { unsigned* bar; unsigned x; volatile LAS unsigned* st; };
__device__ __forceinline__ XcdBarrier xcd_barrier_post(unsigned* bar, volatile LAS unsigned* st) {
    XcdBarrier b; b.bar = bar; b.x = xb_xcc_id(); b.st = st;
    if (threadIdx.x == 0) (void)xb_add(&bar[XB_XCNT(b.x)], 1u);
    return b;
}
__device__ __forceinline__ void xcd_barrier_complete(unsigned* bar, unsigned x, unsigned& nloc, unsigned& nx) {
    const unsigned G = gridDim.x * gridDim.y * gridDim.z;
    unsigned sum, cnt, mine, sp = 0u;
    for (;;) {
        sum = 0u; cnt = 0u; mine = 0u;
#pragma unroll
        for (unsigned j = 0; j < 16; ++j) { const unsigned c = xb_ld(&bar[XB_XCNT(j)]); sum += c; cnt += (c > 0u) ? 1u : 0u; mine = (j == x) ? c : mine; }
        if (sum == G) break;
        __builtin_amdgcn_s_sleep(1);
        if ((++sp & 255u) == 0u) { if (xb_ld(&bar[XB_TMO])) break; if (sp > XB_SPIN_CAP) { atomicAdd(&bar[XB_TMO], 1u); break; } }
    }
    nloc = mine > 0u ? mine : 1u; nx = cnt > 0u ? cnt : 1u;
}
__device__ __forceinline__ void xcd_barrier(const XcdBarrier& b) {
    asm volatile("s_waitcnt vmcnt(0)" ::: "memory");
    __syncthreads();
    if (threadIdx.x == 0) {
        unsigned* bar = b.bar;
        __builtin_amdgcn_s_waitcnt(0);
        unsigned nloc = b.st[0], nx = b.st[1];
        if (nloc == 0u) { xcd_barrier_complete(bar, b.x, nloc, nx); b.st[0] = nloc; b.st[1] = nx; }
        const unsigned old = xb_add(&bar[XB_XSUB(b.x)], 1u);
        const unsigned gen = old / nloc;
        if (old + 1u == (gen + 1u) * nloc) {
            __builtin_amdgcn_fence(__ATOMIC_RELEASE, "agent");
            asm volatile("s_waitcnt vmcnt(0)" ::: "memory");
            const unsigned og = xb_add(&bar[XB_TOP], 1u);
            const unsigned tg = og / nx;
            if (og + 1u == (tg + 1u) * nx) xb_add(&bar[XB_TOPGEN], 1u);
            else XB_SPIN(xb_ld(&bar[XB_TOPGEN]) == tg, bar);
            __builtin_amdgcn_fence(__ATOMIC_ACQUIRE, "agent");
            xb_add(&bar[XB_XGEN(b.x)], 1u);
            asm volatile("s_waitcnt vmcnt(0)" ::: "memory");
        } else {
            XB_SPIN(xb_ld(&bar[XB_XGEN(b.x)]) == gen, bar);
            __builtin_amdgcn_fence(__ATOMIC_ACQUIRE, "agent");
            asm volatile("s_waitcnt vmcnt(0)" ::: "memory");
        }
    }
    __syncthreads();
}

namespace pg8 {
constexpr int BM = 256, BK = 64, HALF = 128, HTB = HALF * BK * 2, STAGE_BYTES = 8 * HTB, NXCD = 8, WGM = 8;
__host__ __device__ __forceinline__ int lds_byte(int r, int c) { const int st = (r >> 4) * 2 + (c >> 5), rr = r & 15, cc = c & 31, ob = rr * 64 + cc * 2; return st * 1024 + (ob ^ (((ob >> 9) & 1) << 5)); }
__host__ __device__ __forceinline__ void stage_rc(int b, int& R, int& C) { const int st = b / 1024, sb = b % 1024, swz = sb ^ (((sb >> 9) & 1) << 5); R = (st >> 1) * 16 + swz / 64; C = (st & 1) * 32 + (swz % 64) / 2; }
__host__ __device__ __forceinline__ int perm32(int rho) { const int n = rho >> 4, i = rho & 15; return 8 * (i >> 2) + 4 * n + (i & 3); }

struct Unit { int pm, pn, br; const char* A; const char* B; };

__device__ __forceinline__ bool tile_of(int L, int nM, int nN, int& pm, int& pn) {
    const int nwg = nM * nN; if (L >= nwg) return false;
    int wgid = L; { const int q = nwg / NXCD, r = nwg % NXCD, xcd = wgid % NXCD, off = wgid / NXCD; wgid = (xcd < r ? xcd * (q + 1) : r * (q + 1) + (xcd - r) * q) + off; }
    const int nig = WGM * nN, gid = wgid / nig, fm = gid * WGM, gsz = (nM - fm) < WGM ? (nM - fm) : WGM;
    pm = fm + ((wgid % nig) % gsz); pn = (wgid % nig) / gsz; return true;
}
struct PlainOrder {
    const char* A; const char* Bt; int nM, nN, G, c; size_t tstep; int pn_base, skip_from, skip_cnt, skip2_from, skip2_cnt, b_row0, b_compact, short_rounds, n_long;
    __device__ __forceinline__ void init(const void* A_, const void* Bt_, int M, int N, int K, int G_, int c_) { A = (const char*)A_; Bt = (const char*)Bt_; nM = M / BM; nN = N / BM; G = G_; c = c_; tstep = (size_t)BM * K * 2;
        pn_base = 0; skip_from = 1 << 30; skip_cnt = 0; skip2_from = 1 << 30; skip2_cnt = 0; b_row0 = 0; b_compact = 0; short_rounds = 1 << 30; n_long = 0; }
    __device__ __forceinline__ bool next(int i, Unit& u) const {
        int L = i * G + c;
        if (i >= short_rounds) { if (c >= n_long) return false; const int per = (nM * nN - short_rounds * G) / n_long, j = i - short_rounds; if (j >= per) return false; L = short_rounds * G + per * c + j; }
        int pm, pn; if (!tile_of(L, nM, nN, pm, pn)) return false;
        const int pnc = pn;
        pn += pn_base; if (pn >= skip_from) pn += skip_cnt; if (pn >= skip2_from) pn += skip2_cnt;
        u.pm = pm; u.pn = pn; u.br = 0; u.A = A + (size_t)pm * tstep; u.B = Bt + (size_t)(b_compact ? pnc : pn - b_row0) * tstep; return true;
    }
};
struct BranchOrder {
    const char* T8; const char* WA; int nM, nN, G, c; size_t tstep;
    __device__ __forceinline__ bool next(int i, Unit& u) const {
        const int tl = i / 3, br = i - 3 * tl; int pm, pn; if (!tile_of(tl * G + c, nM, nN, pm, pn)) return false;
        u.pm = pm; u.pn = pn; u.br = br;
        const int ti = 1 + 4 * (br == 1) + (br == 2);
        u.A = T8 + (size_t)ti * SZ_A + (size_t)pm * tstep; u.B = WA + (size_t)br * SZ_W + (size_t)pn * tstep; return true;
    }
};

template <class Epi, class Sched, bool FP8 = false>
__device__ __forceinline__ void gemm_phase(LAS unsigned char* lds, const int K, const Sched& S, const Epi& E, int wid0) {
    const int tid = tid_fresh(wid0), wid = __builtin_amdgcn_readfirstlane(tid >> 6), lane = tid & 63, wr = wid >> 2, wc = wid & 3, fr = lane & 15, fq = lane >> 4;
    const int nt = K / BK;
    unsigned voffA[2], voffB[2];
#pragma unroll
    for (int i = 0; i < 2; ++i) { int R, C; stage_rc(tid * 16 + i * 8192, R, C); const int Rb = Epi::PERM ? ((R & ~31) + perm32(R & 31)) : R;
        voffA[i] = (unsigned)(R * K + C) * 2u; voffB[i] = (unsigned)(Rb * K + C) * 2u; }
    const size_t kstep = (size_t)(BK * 2);
    const size_t hstep = (size_t)HALF * K * 2;
    const unsigned ldsw = (unsigned)wid * 1024u;
    const int aoff = lds_byte(wr * 64 + fr, fq * 8), boff = lds_byte(wc * 32 + fr, fq * 8);
#define PG8_SA(b, h) (((b) * 2 + (h)) * HTB)
#define PG8_SB(b, h) ((4 + (b) * 2 + (h)) * HTB)
#define PG8_STAGE(bufoff, gbase, voff) do { _Pragma("unroll") for (int _i = 0; _i < 2; ++_i) \
        __builtin_amdgcn_global_load_lds((const unsigned*)((const char*)(gbase) + (voff)[_i]), (LAS unsigned*)(lds + (bufoff) + ldsw + _i * 8192), 16, 0, 0); } while (0)
#define PG8_LD1(dstv, addr) do { if constexpr (FP8) { const i32x4 _lo = *(const LAS i32x4*)(lds + (addr)), _hi = *(const LAS i32x4*)(lds + (addr) + 1024); dstv[0] = __builtin_shufflevector(_lo, _hi, 0, 1, 2, 3, 4, 5, 6, 7); } \
        else { _Pragma("unroll") for (int k = 0; k < 2; ++k) dstv[k] = *(const LAS bf16x8*)(lds + (addr) + k * 1024); } } while (0)
#define PG8_LDA(dst, b, h) do { _Pragma("unroll") for (int m = 0; m < 4; ++m) PG8_LD1(dst[m], PG8_SA(b, h) + aoff + m * 2048); } while (0)
#define PG8_LDB(dst, b, h) do { _Pragma("unroll") for (int n = 0; n < 2; ++n) PG8_LD1(dst[n], PG8_SB(b, h) + boff + n * 2048); } while (0)
#define PG8_MMA(ai, bj, At, Bt) do { __builtin_amdgcn_s_setprio(1); _Pragma("unroll") for (int m = 0; m < 4; ++m) _Pragma("unroll") for (int n = 0; n < 2; ++n) { \
        if constexpr (FP8) asm volatile("v_mfma_scale_f32_16x16x128_f8f6f4 %0, %1, %2, %0, %3, %4 op_sel_hi:[0,0,0]" : "+v"(acc[ai][bj][m][n]) : "v"(Bt[n][0]), "v"(At[m][0]), "v"(sclW), "v"(sclX)); \
        else { _Pragma("unroll") for (int k = 0; k < 2; ++k) acc[ai][bj][m][n] = __builtin_amdgcn_mfma_f32_16x16x32_bf16(Bt[n][k], At[m][k], acc[ai][bj][m][n], 0, 0, 0); } } \
        __builtin_amdgcn_s_setprio(0); } while (0)
#define PG8_WAIT_V(n) asm volatile("s_waitcnt vmcnt(" #n ")" ::: "memory")
#define PG8_WAIT_L(n) asm volatile("s_waitcnt lgkmcnt(" #n ")" ::: "memory")
#define PG8_BAR __builtin_amdgcn_s_barrier()
#define PG8_SCHED __builtin_amdgcn_sched_barrier(0)
    Unit cur, nxt; int ui = 0;
    if (!S.next(0, cur)) return;
    const int sclW = 0x75757575, sclX = 0x7F7F7F7F;
    f32x4 acc[2][2][4][2];
#pragma unroll
    for (int a = 0; a < 2; ++a)
#pragma unroll
        for (int b = 0; b < 2; ++b)
#pragma unroll
            for (int m = 0; m < 4; ++m)
#pragma unroll
                for (int n = 0; n < 2; ++n) acc[a][b][m][n] = (f32x4){0.f, 0.f, 0.f, 0.f};
    typedef typename std::conditional<FP8, i32x8, bf16x8>::type frag_t;
    frag_t At[4][FP8 ? 1 : 2], B0[2][FP8 ? 1 : 2], B1[2][FP8 ? 1 : 2];
    const char* cA = cur.A; const char* cB = cur.B;
    PG8_STAGE(PG8_SB(0, 0), cB, voffB); PG8_STAGE(PG8_SA(0, 0), cA, voffA); PG8_STAGE(PG8_SB(0, 1), cB + hstep, voffB); PG8_STAGE(PG8_SA(0, 1), cA + hstep, voffA);
    if (wr == 1) PG8_BAR;
    PG8_WAIT_V(4); PG8_BAR;
    PG8_STAGE(PG8_SB(1, 0), cB + kstep, voffB); PG8_STAGE(PG8_SA(1, 0), cA + kstep, voffA); PG8_STAGE(PG8_SB(1, 1), cB + hstep + kstep, voffB);
    PG8_WAIT_V(6); PG8_BAR;
    for (;;) {
        const bool has_next = S.next(ui + 1, nxt);
        const char* nA = has_next ? nxt.A : cA; const char* nB = has_next ? nxt.B : cB;
        for (int t = 0; t < nt; t += 2) {
            const bool last = (t == nt - 2);
            const char* a1 = cA + (size_t)(t + 1) * kstep;
            const char* a2 = last ? nA : cA + (size_t)(t + 2) * kstep; const char* b2 = last ? nB : cB + (size_t)(t + 2) * kstep;
            const char* a3 = a2 + kstep; const char* b3 = b2 + kstep;
            PG8_LDB(B0, 0, 0); PG8_SCHED; PG8_LDA(At, 0, 0); PG8_STAGE(PG8_SA(1, 1), a1 + hstep, voffA);
            PG8_WAIT_L(8); PG8_BAR; PG8_WAIT_L(0); PG8_MMA(0, 0, At, B0); PG8_BAR; PG8_SCHED;
            PG8_LDB(B1, 0, 1); PG8_STAGE(PG8_SB(0, 0), b2, voffB);
            PG8_BAR; PG8_WAIT_L(0); PG8_MMA(0, 1, At, B1); PG8_BAR;
            PG8_LDA(At, 0, 1); PG8_STAGE(PG8_SA(0, 0), a2, voffA);
            PG8_BAR; PG8_WAIT_L(0); PG8_MMA(1, 0, At, B0); PG8_BAR; PG8_SCHED;
            PG8_STAGE(PG8_SB(0, 1), b2 + hstep, voffB);
            PG8_WAIT_V(6); PG8_BAR; PG8_MMA(1, 1, At, B1); PG8_BAR;
            PG8_LDB(B0, 1, 0); PG8_SCHED; PG8_LDA(At, 1, 0); PG8_STAGE(PG8_SA(0, 1), a2 + hstep, voffA);
            PG8_WAIT_L(8); PG8_BAR; PG8_WAIT_L(0); PG8_MMA(0, 0, At, B0); PG8_BAR; PG8_SCHED;
            PG8_LDB(B1, 1, 1); PG8_STAGE(PG8_SB(1, 0), b3, voffB);
            PG8_BAR; PG8_WAIT_L(0); PG8_MMA(0, 1, At, B1); PG8_BAR;
            PG8_LDA(At, 1, 1); PG8_STAGE(PG8_SA(1, 0), a3, voffA);
            PG8_BAR; PG8_WAIT_L(0); PG8_MMA(1, 0, At, B0); PG8_BAR; PG8_SCHED;
            PG8_STAGE(PG8_SB(1, 1), b3 + hstep, voffB);
            PG8_WAIT_V(6); PG8_BAR; PG8_MMA(1, 1, At, B1); PG8_BAR;
        }
        if constexpr (FP8) { asm volatile("s_nop 15\n\ts_nop 15\n\ts_nop 15" ::: "memory"); }
        E(acc, cur, wr, wc, fr, fq);
        if (!has_next) break;
#pragma unroll
        for (int a = 0; a < 2; ++a)
#pragma unroll
            for (int b = 0; b < 2; ++b)
#pragma unroll
                for (int m = 0; m < 4; ++m)
#pragma unroll
                    for (int n = 0; n < 2; ++n) acc[a][b][m][n] = (f32x4){0.f, 0.f, 0.f, 0.f};
        cur = nxt; cA = nA; cB = nB; ++ui;
    }
    PG8_WAIT_V(0);
    if (wr == 0) PG8_BAR;
    PG8_BAR;
#undef PG8_SA
#undef PG8_SB
#undef PG8_STAGE
#undef PG8_LD1
#undef PG8_LDA
#undef PG8_LDB
#undef PG8_MMA
#undef PG8_WAIT_V
#undef PG8_WAIT_L
#undef PG8_BAR
#undef PG8_SCHED
}

struct EpiProj {
    static constexpr bool PERM = true;
    unsigned char* ws;
    __device__ __forceinline__ void operator()(const f32x4 (&acc)[2][2][4][2], const Unit& u, int wr, int wc, int fr, int fq) const {
        const int pn = u.pn; size_t off; int ld, c0;
        if (pn < 4) { off = WS_PQ; ld = 1024; c0 = pn * 256; }
        else if (pn < 8) { off = WS_PK; ld = 1024; c0 = (pn - 4) * 256; }
        else if (pn < 72) { const int t = (pn - 8) >> 3; off = WS_T8 + (size_t)t * SZ_A; ld = 2048; c0 = ((pn - 8) & 7) * 256; }
        else {
            unsigned char* gp = ws + WS_GT + (size_t)(u.pm * BM + wr * 64 + fr) * 6144 + (pn - 72) * 256 + wc * 32 + 8 * fq;
#pragma unroll
            for (int ai = 0; ai < 2; ++ai) {
#pragma unroll
                for (int m = 0; m < 4; ++m) {
                    asm volatile("" : "+v"(gp));
#pragma unroll
                    for (int bj = 0; bj < 2; ++bj) { const f32x4 v0 = acc[ai][bj][m][0], v1 = acc[ai][bj][m][1];
                        unsigned q[8];
#pragma unroll
                        for (int j = 0; j < 4; ++j) { q[j] = (unsigned)(sigmoidf_(v0[j]) * 255.0f + 0.5f); q[4 + j] = (unsigned)(sigmoidf_(v1[j]) * 255.0f + 0.5f); }
                        u32x2 w; w.x = q[0] | (q[1] << 8) | (q[2] << 16) | (q[3] << 24); w.y = q[4] | (q[5] << 8) | (q[6] << 16) | (q[7] << 24);
                        *(u32x2*)(gp + bj * HALF) = w; }
                    gp += (size_t)16 * 6144;
                }
                gp += (size_t)64 * 6144;
            }
            return;
        }
        bf16_t* rp = (bf16_t*)(ws + off) + (size_t)(u.pm * BM + wr * 64 + fr) * ld + c0 + wc * 32 + 8 * fq;
        const size_t step = (size_t)16 * ld;
#pragma unroll
        for (int ai = 0; ai < 2; ++ai) {
#pragma unroll
            for (int m = 0; m < 4; ++m) {
                asm volatile("" : "+v"(rp));
#pragma unroll
                for (int bj = 0; bj < 2; ++bj) { const f32x4 v0 = acc[ai][bj][m][0], v1 = acc[ai][bj][m][1];
                    u32x4 w; w.x = pk2(v0[0], v0[1]); w.y = pk2(v0[2], v0[3]); w.z = pk2(v1[0], v1[1]); w.w = pk2(v1[2], v1[3]);
                    *(u32x4*)(rp + bj * HALF) = w; }
                rp += step;
            }
            rp += 4 * step;
        }
    }
};
struct EpiBf {
    static constexpr bool PERM = true;
    bf16_t* O; int ld;
    __device__ __forceinline__ void operator()(const f32x4 (&acc)[2][2][4][2], const Unit& u, int wr, int wc, int fr, int fq) const {
        const int row0 = u.pm * BM + wr * 64 + fr, col0 = u.pn * BM + wc * 32 + 8 * fq;
#pragma unroll
        for (int ai = 0; ai < 2; ++ai)
#pragma unroll
            for (int m = 0; m < 4; ++m) { bf16_t* rowp = O + (size_t)(row0 + ai * HALF + m * 16) * ld + col0;
#pragma unroll
                for (int bj = 0; bj < 2; ++bj) { const f32x4 v0 = acc[ai][bj][m][0], v1 = acc[ai][bj][m][1];
                    u32x4 w; w.x = pk2(v0[0], v0[1]); w.y = pk2(v0[2], v0[3]); w.z = pk2(v1[0], v1[1]); w.w = pk2(v1[2], v1[3]);
                    *(u32x4*)(rowp + bj * HALF) = w; } }
    }
};
__device__ __forceinline__ float gq8(unsigned w, int i) { return (float)((w >> (8 * i)) & 0xffu); }
struct EpiMerge {
    static constexpr bool PERM = true;
    bf16_t* Y; const unsigned char* GT;
    __device__ __forceinline__ void operator()(const f32x4 (&acc)[2][2][4][2], const Unit& u, int wr, int wc, int fr, int fq) const {
        const int row0 = u.pm * BM + wr * 64 + fr, col0 = u.pn * BM + wc * 32 + 8 * fq;
        const bool addy = u.br != 0;
#pragma unroll
        for (int ai = 0; ai < 2; ++ai) {
            u32x2 g[4][2]; u32x4 y[4][2];
#pragma unroll
            for (int m = 0; m < 4; ++m)
#pragma unroll
                for (int bj = 0; bj < 2; ++bj) { const size_t r = (size_t)(row0 + ai * HALF + m * 16);
                    g[m][bj] = *(const u32x2*)(GT + r * 6144 + (size_t)u.br * 2048 + col0 + bj * HALF); }
            if (addy) {
#pragma unroll
                for (int m = 0; m < 4; ++m)
#pragma unroll
                    for (int bj = 0; bj < 2; ++bj) { const size_t r = (size_t)(row0 + ai * HALF + m * 16); y[m][bj] = *(const u32x4*)(Y + r * 2048 + col0 + bj * HALF); }
            } else {
#pragma unroll
                for (int m = 0; m < 4; ++m)
#pragma unroll
                    for (int bj = 0; bj < 2; ++bj) y[m][bj] = (u32x4){0u, 0u, 0u, 0u};
            }
#pragma unroll
            for (int m = 0; m < 4; ++m)
#pragma unroll
                for (int bj = 0; bj < 2; ++bj) { const size_t r = (size_t)(row0 + ai * HALF + m * 16);
                    const f32x4 v0 = acc[ai][bj][m][0] * (1.0f / 255.0f), v1 = acc[ai][bj][m][1] * (1.0f / 255.0f); const u32x2 gg = g[m][bj]; const u32x4 yy = y[m][bj];
                    float o[8];
                    o[0] = gq8(gg.x, 0) * v0[0] + bflo(yy.x); o[1] = gq8(gg.x, 1) * v0[1] + bfhi(yy.x); o[2] = gq8(gg.x, 2) * v0[2] + bflo(yy.y); o[3] = gq8(gg.x, 3) * v0[3] + bfhi(yy.y);
                    o[4] = gq8(gg.y, 0) * v1[0] + bflo(yy.z); o[5] = gq8(gg.y, 1) * v1[1] + bfhi(yy.z); o[6] = gq8(gg.y, 2) * v1[2] + bflo(yy.w); o[7] = gq8(gg.y, 3) * v1[3] + bfhi(yy.w);
                    u32x4 w; w.x = pk2(o[0], o[1]); w.y = pk2(o[2], o[3]); w.z = pk2(o[4], o[5]); w.w = pk2(o[6], o[7]);
                    *(u32x4*)(Y + r * 2048 + col0 + bj * HALF) = w; }
        }
    }
};
template <bool XF32> struct EpiRes {
    static constexpr bool PERM = true;
    bf16_t* X; const float* Xf; const float* mod;
    __device__ __forceinline__ void operator()(const f32x4 (&acc)[2][2][4][2], const Unit& u, int wr, int wc, int fr, int fq) const {
        const int row0 = u.pm * BM + wr * 64 + fr, col0 = u.pn * BM + wc * 32 + 8 * fq;
        const int which = (u.pm < 32) ? 0 : (u.pm < 64 ? 1 : 2);
        const float* mg = mod + (size_t)which * 12288 + 2 * 2048 + col0;
        f32x4 gv[2][2];
#pragma unroll
        for (int bj = 0; bj < 2; ++bj)
#pragma unroll
            for (int n = 0; n < 2; ++n) gv[bj][n] = *(const f32x4*)(mg + bj * HALF + n * 4);
#pragma unroll
        for (int ai = 0; ai < 2; ++ai) {
            if constexpr (XF32) {
#pragma unroll
              for (int mh = 0; mh < 2; ++mh) {
                f32x4 xin[2][2][2];
#pragma unroll
                for (int m = 0; m < 2; ++m)
#pragma unroll
                    for (int bj = 0; bj < 2; ++bj)
#pragma unroll
                        for (int n = 0; n < 2; ++n) xin[m][bj][n] = *(const f32x4*)(Xf + (size_t)(row0 + ai * HALF + (2 * mh + m) * 16) * 2048 + col0 + bj * HALF + n * 4);
#pragma unroll
                for (int m = 0; m < 2; ++m)
#pragma unroll
                    for (int bj = 0; bj < 2; ++bj) {
                        const f32x4 o0 = xin[m][bj][0] + gv[bj][0] * acc[ai][bj][2 * mh + m][0], o1 = xin[m][bj][1] + gv[bj][1] * acc[ai][bj][2 * mh + m][1];
                        u32x4 ow; ow.x = pk2(o0[0], o0[1]); ow.y = pk2(o0[2], o0[3]); ow.z = pk2(o1[0], o1[1]); ow.w = pk2(o1[2], o1[3]);
                        *(u32x4*)(X + (size_t)(row0 + ai * HALF + (2 * mh + m) * 16) * 2048 + col0 + bj * HALF) = ow; }
              }
            } else {
                u32x4 xb[4][2];
#pragma unroll
                for (int m = 0; m < 4; ++m)
#pragma unroll
                    for (int bj = 0; bj < 2; ++bj) xb[m][bj] = *(const u32x4*)(X + (size_t)(row0 + ai * HALF + m * 16) * 2048 + col0 + bj * HALF);
#pragma unroll
                for (int m = 0; m < 4; ++m)
#pragma unroll
                    for (int bj = 0; bj < 2; ++bj) { const u32x4 xw = xb[m][bj]; const f32x4 a0 = acc[ai][bj][m][0], a1 = acc[ai][bj][m][1], g0 = gv[bj][0], g1 = gv[bj][1];
                        u32x4 ow; ow.x = pk2(bflo(xw.x) + g0[0] * a0[0], bfhi(xw.x) + g0[1] * a0[1]); ow.y = pk2(bflo(xw.y) + g0[2] * a0[2], bfhi(xw.y) + g0[3] * a0[3]);
                        ow.z = pk2(bflo(xw.z) + g1[0] * a1[0], bfhi(xw.z) + g1[1] * a1[1]); ow.w = pk2(bflo(xw.w) + g1[2] * a1[2], bfhi(xw.w) + g1[3] * a1[3]);
                        *(u32x4*)(X + (size_t)(row0 + ai * HALF + m * 16) * 2048 + col0 + bj * HALF) = ow; }
            }
        }
    }
};
}

__device__ __forceinline__ int proj_src_col(int n) {
    if (n < 1024) return 7200 + n;
    if (n < 2048) return n - 1024;
    if (n < 4096) return 1024 + (n - 2048);
    if (n < 6144) return 8224 + (n - 4096);
    if (n < 8192) return 16416 + (n - 6144);
    if (n < 10240) return 3104 + (n - 8192);
    if (n < 12288) return 5152 + (n - 10240);
    if (n < 14336) return 10272 + (n - 12288);
    if (n < 16384) return 12320 + (n - 14336);
    if (n < 18432) return 14368 + (n - 16384);
    return 18464 + (n - 18432);
}
__device__ __forceinline__ void phase_w(KP p, int l, LAS unsigned char* lds, int wid0) {
    const int tid = tid_fresh(wid0), G = gridDim.x, bid = blockIdx.x;
    unsigned char* ws = launder(p->ws);
    {
        LAS float* tile = (LAS float*)lds;
        const int NT_IN = NPROJ / 64;
        const int total = (NT_IN + 5 * 32) * 8;
        for (int t = bid; t < total; t += G) {
            const int ntile = t >> 3, kt = t & 7, k0 = kt * 256;
            const float* src; int ld; bf16_t* dst; float scale = 1.0f; int n0;
            bool to8 = false;
            if (ntile < NT_IN) { n0 = ntile * 64; src = p->w_in + (size_t)l * 2048 * PROJ_W + proj_src_col(n0); ld = PROJ_W;
                const int pnl = n0 >> 8; const bool isb = (pnl >= BF_LO && pnl < BF_HI) || (pnl >= 48 && pnl < 72);
                if (isb) { const int cpn = pnl < 48 ? pnl - BF_LO : pnl - 48 + (BF_HI - BF_LO); dst = (bf16_t*)(ws + WS_WINB) + (size_t)(cpn * 256 + (n0 & 255)) * 2048; if (n0 < 1024) scale = 0.08838834764831845f; }
                else { to8 = true; dst = (bf16_t*)(ws + WS_WIN); scale = (n0 < 1024) ? 1024.0f * 0.08838834764831845f : 1024.0f; } }
            else { const int mi = (ntile - NT_IN) >> 5; n0 = ((ntile - NT_IN) & 31) * 64;
                const float* m5 = mi == 0 ? p->w_a_out : mi == 1 ? p->w_b_out : mi == 2 ? p->w_c_out : mi == 3 ? p->w_out : p->peer_wq;
                src = m5 + (size_t)l * 2048 * 2048 + n0; ld = 2048;
                dst = (bf16_t*)(ws + WS_WA + (size_t)mi * SZ_W) + (size_t)n0 * 2048; }
            { const int kk = tid >> 4, n4 = (tid & 15) * 4;
              f32x4 v[8];
#pragma unroll
              for (int h = 0; h < 8; ++h) v[h] = *(const f32x4*)(src + (size_t)(k0 + kk + 32 * h) * ld + n4);
#pragma unroll
              for (int h = 0; h < 8; ++h) { LAS float* tp = tile + (kk + 32 * h) * 65 + n4; tp[0] = v[h][0]; tp[1] = v[h][1]; tp[2] = v[h][2]; tp[3] = v[h][3]; } }
            __syncthreads();
            { const int n = tid >> 3, kq = (tid & 7) * 8;
#pragma unroll
              for (int sub = 0; sub < 4; ++sub) { const int k8 = sub * 64 + kq; float v[8];
#pragma unroll
                  for (int j = 0; j < 8; ++j) v[j] = tile[(k8 + j) * 65 + n] * scale;
                  if (to8) {
#pragma unroll
                      for (int j = 0; j < 8; ++j) v[j] = fminf(fmaxf(v[j], -448.f), 448.f);
                      int d0 = 0, d1 = 0; d0 = __builtin_amdgcn_cvt_pk_fp8_f32(v[0], v[1], d0, false); d0 = __builtin_amdgcn_cvt_pk_fp8_f32(v[2], v[3], d0, true);
                      d1 = __builtin_amdgcn_cvt_pk_fp8_f32(v[4], v[5], d1, false); d1 = __builtin_amdgcn_cvt_pk_fp8_f32(v[6], v[7], d1, true);
                      u32x2 w8; w8.x = (unsigned)d0; w8.y = (unsigned)d1; *(u32x2*)((unsigned char*)dst + (size_t)(n0 + n) * 2048 + k0 + k8) = w8; }
                  else { u32x4 w; w.x = pk2(v[0], v[1]); w.y = pk2(v[2], v[3]); w.z = pk2(v[4], v[5]); w.w = pk2(v[6], v[7]);
                      *(u32x4*)(dst + (size_t)n * 2048 + k0 + k8) = w; } } }
            __syncthreads();
        }
    }
    const size_t gtid = (size_t)bid * NTHREADS + tid, gthreads = (size_t)G * NTHREADS;
    for (size_t i = gtid; i < 32 * 2048; i += gthreads) { const int n = (int)(i >> 11), k = (int)(i & 2047);
        ((bf16_t*)(ws + WS_WG))[i] = f2bf(p->w_in[(size_t)l * 2048 * PROJ_W + (size_t)k * PROJ_W + 3072 + n]); }
    {
        const float* su = p->peer_u + (size_t)l * 16384 * 2048; const float* sv = p->peer_v + (size_t)l * 16384 * 2048;
        unsigned char* du = ws + WS_PU; unsigned char* dv = ws + WS_PVW;
        const size_t n32 = (size_t)16384 * 2048 / 32;
        for (size_t i = gtid; i < n32; i += gthreads) {
#pragma unroll
            for (int t = 0; t < 2; ++t) {
                const float* sp = (t ? sv : su) + i * 32; const float sc = t ? 4.0f : 64.0f;
                u32x4 wv;
#pragma unroll
                for (int q = 0; q < 4; ++q) { const f32x4 a = *(const f32x4*)(sp + q * 8), b = *(const f32x4*)(sp + q * 8 + 4);
                    unsigned d = 0;
                    d = __builtin_amdgcn_cvt_scalef32_pk_fp4_f32(d, a[0] * sc, a[1] * sc, 1.0f, 0); d = __builtin_amdgcn_cvt_scalef32_pk_fp4_f32(d, a[2] * sc, a[3] * sc, 1.0f, 1);
                    d = __builtin_amdgcn_cvt_scalef32_pk_fp4_f32(d, b[0] * sc, b[1] * sc, 1.0f, 2); d = __builtin_amdgcn_cvt_scalef32_pk_fp4_f32(d, b[2] * sc, b[3] * sc, 1.0f, 3);
                    wv[q] = d; }
                *(u32x4*)((t ? dv : du) + i * 16) = wv;
            }
        }
        const float* sk = p->peer_keys + (size_t)l * 16 * 128 * 128; bf16_t* dk = (bf16_t*)(ws + WS_KEYS);
        for (size_t i = gtid; i < (size_t)16 * 128 * 128; i += gthreads) dk[i] = f2bf(sk[i]);
    }
    {
        float* mod = (float*)(ws + WS_MOD) + (size_t)l * 3 * 12288;
        const float* wa = p->w_ada + (size_t)l * 2048 * 12288; const float* ba = p->b_ada + (size_t)l * 12288;
        LAS float* part = (LAS float*)(lds + 69632);
        const int col = tid & 63, ks = tid >> 6;
        for (int t = bid; t < 256; t += G) {
            const int n = t * 48 + col;
            float a0 = 0.f, a1 = 0.f, a2 = 0.f;
            if (col < 48) {
#pragma unroll 8
                for (int k = ks * 256; k < ks * 256 + 256; ++k) {
                    const float w = wa[(size_t)k * 12288 + n];
                    const float c0 = p->c[k], c1 = p->c[2048 + k], c2 = p->c_ctx[k];
                    a0 += c0 * sigmoidf_(c0) * w; a1 += c1 * sigmoidf_(c1) * w; a2 += c2 * sigmoidf_(c2) * w;
                }
                part[(ks * 3 + 0) * 48 + col] = a0; part[(ks * 3 + 1) * 48 + col] = a1; part[(ks * 3 + 2) * 48 + col] = a2;
            }
            __syncthreads();
            if (tid < 144) { const int which = tid / 48, cc = tid - which * 48; float sacc = ba[t * 48 + cc];
#pragma unroll
                for (int q = 0; q < 8; ++q) sacc += part[(q * 3 + which) * 48 + cc];
                mod[(size_t)which * 12288 + t * 48 + cc] = sacc; }
            __syncthreads();
        }
    }
    if (l == 0) {
        float* tab = (float*)(ws + WS_TAB);
        for (size_t i = gtid; i < 4096; i += gthreads) { const int pos = (int)(i >> 5), j = (int)(i & 31);
            const float inv = powf(10000.0f, -(float)j / 32.0f); const float ang = (float)pos * inv;
            tab[i] = cosf(ang); tab[4096 + i] = sinf(ang); }
    }
}

__device__ __forceinline__ void phase_norm(KP p, int l, int which_norm, int nrows, int wid0) {
    const int tid = tid_fresh(wid0); const int lane = tid & 63, gw = blockIdx.x * 8 + (tid >> 6), nw = gridDim.x * 8;
    unsigned char* ws = launder(p->ws);
    const bf16_t* X = (const bf16_t*)(ws + WS_X); bf16_t* XN = (bf16_t*)(ws + WS_XN);
    const float* mod = (const float*)(ws + WS_MOD) + (size_t)l * 3 * 12288;
    const float* g = p->norm_g + (size_t)(l * 2 + which_norm) * 2048;
    const int shift_c = which_norm ? 3 : 0, scale_c = which_norm ? 4 : 1;
    for (int row = gw; row < nrows; row += nw) {
        const int which = row < NLAT ? (row >> 13) : 2;
        const float* mb = mod + (size_t)which * 12288;
        f32x4 v[8]; float ss = 0.f;
        if (l == 0 && which_norm == 0) {
            const float* xr = row < NLAT ? p->x + (size_t)row * 2048 : p->ctx + (size_t)(row - NLAT) * 2048;
#pragma unroll
            for (int i = 0; i < 8; ++i) v[i] = *(const f32x4*)(xr + i * 256 + lane * 4);
        } else {
            const bf16_t* xr = X + (size_t)row * 2048;
            u32x2 xb[8];
#pragma unroll
            for (int i = 0; i < 8; ++i) xb[i] = *(const u32x2*)(xr + i * 256 + lane * 4);
#pragma unroll
            for (int i = 0; i < 8; ++i) { v[i][0] = bflo(xb[i].x); v[i][1] = bfhi(xb[i].x); v[i][2] = bflo(xb[i].y); v[i][3] = bfhi(xb[i].y); }
        }
#pragma unroll
        for (int i = 0; i < 8; ++i) ss += v[i][0] * v[i][0] + v[i][1] * v[i][1] + v[i][2] * v[i][2] + v[i][3] * v[i][3];
        ss = wave_sum(ss);
        const float rstd = rsqrtf(ss * (1.0f / 2048.0f) + EPSF);
        f32x4 ggv[8], shv[8], scv[8];
#pragma unroll
        for (int i = 0; i < 8; ++i) { const int c = i * 256 + lane * 4; ggv[i] = *(const f32x4*)(g + c); shv[i] = *(const f32x4*)(mb + shift_c * 2048 + c); scv[i] = *(const f32x4*)(mb + scale_c * 2048 + c); }
#pragma unroll
        for (int i = 0; i < 8; ++i) { const int c = i * 256 + lane * 4;
            const f32x4 gg = ggv[i], sh = shv[i], sc = scv[i];
            float o[4];
#pragma unroll
            for (int j = 0; j < 4; ++j) o[j] = v[i][j] * rstd * gg[j] * (1.0f + sc[j]) + sh[j];
            u32x2 w; w.x = pk2(o[0], o[1]); w.y = pk2(o[2], o[3]); *(u32x2*)(XN + (size_t)row * 2048 + c) = w;
            if (which_norm == 0) { int d = 0; d = __builtin_amdgcn_cvt_pk_fp8_f32(fminf(fmaxf(o[0], -448.f), 448.f), fminf(fmaxf(o[1], -448.f), 448.f), d, false);
                d = __builtin_amdgcn_cvt_pk_fp8_f32(fminf(fmaxf(o[2], -448.f), 448.f), fminf(fmaxf(o[3], -448.f), 448.f), d, true); *(unsigned*)(ws + WS_XN8 + (size_t)row * 2048 + c) = (unsigned)d; } }
    }
}

__device__ __forceinline__ void phase_gates_gemm(KP p, int l, int wid0) {
    const int tid = tid_fresh(wid0); const int lane = tid & 63, gw = blockIdx.x * 8 + (tid >> 6), nw = gridDim.x * 8;
    unsigned char* ws = launder(p->ws);
    const bf16_t* XN = (const bf16_t*)(ws + WS_XN); const bf16_t* WG = (const bf16_t*)(ws + WS_WG); float* GA = (float*)(ws + WS_GATES);
    const int q4 = lane >> 4, c = lane & 15;
    const float gb0 = p->a_gate_b[l * 32 + c], gb1 = p->a_gate_b[l * 32 + 16 + c];
    for (int task = gw; task < MR / 16; task += nw) {
        const int r0 = task * 16;
        f32x4 acc0 = {0.f, 0.f, 0.f, 0.f}, acc1 = {0.f, 0.f, 0.f, 0.f};
        const bf16_t* ap = XN + (size_t)(r0 + c) * 2048 + 8 * q4; const bf16_t* b0 = WG + (size_t)c * 2048 + 8 * q4; const bf16_t* b1 = b0 + 16 * 2048;
#pragma unroll 4
        for (int ks = 0; ks < 64; ++ks) { const bf16x8 a = *(const bf16x8*)(ap + ks * 32), x0 = *(const bf16x8*)(b0 + ks * 32), x1 = *(const bf16x8*)(b1 + ks * 32);
            acc0 = mfma16(a, x0, acc0); acc1 = mfma16(a, x1, acc1); }
#pragma unroll
        for (int r = 0; r < 4; ++r) {
            const float v0 = acc0[r] + gb0, v1 = acc1[r] + gb1;
            GA[(size_t)(r0 + 4 * q4 + r) * 32 + c] = (c >= 8) ? logsigmoidf_(v0) : v0; GA[(size_t)(r0 + 4 * q4 + r) * 32 + 16 + c] = (c >= 8) ? logsigmoidf_(v1) : v1; }
    }
}

__device__ __forceinline__ void phase_e1(KP p, int l, int wid0) {
    const int tid = tid_fresh(wid0); const int lane = tid & 63, gw = blockIdx.x * 8 + (tid >> 6), nw = gridDim.x * 8;
    unsigned char* ws = launder(p->ws);
    bf16_t* PQ = (bf16_t*)(ws + WS_PQ); bf16_t* PK = (bf16_t*)(ws + WS_PK); bf16_t* CQ = (bf16_t*)(ws + WS_CQ); bf16_t* CK = (bf16_t*)(ws + WS_CK);
    bf16_t* BB = (bf16_t*)(ws + WS_BB); const bf16_t* BC = (const bf16_t*)(ws + WS_BC); const bf16_t* BX = (const bf16_t*)(ws + WS_BX);
    float* GA = (float*)(ws + WS_GATES); const float* tab = (const float*)(ws + WS_TAB);
    const float* gq = p->c_qk_g + (size_t)(l * 2 + 0) * 128; const float* gk = p->c_qk_g + (size_t)(l * 2 + 1) * 128;
    const float* cw = p->b_conv + (size_t)l * 3 * 2048;
    float gqv[8], gkv[8];
#pragma unroll
    for (int j = 0; j < 8; ++j) { gqv[j] = gq[(lane & 15) * 8 + j] * 0.12751743082459868f;        gkv[j] = gk[(lane & 15) * 8 + j]; }
    const int nitems = NLAT / 8 + NCTX;
    for (int item = gw; item < nitems; item += nw) {
        const int row_first = item < NLAT / 8 ? item * 8 : NLAT + (item - NLAT / 8), nrun = item < NLAT / 8 ? 8 : 1;
        for (int rr = 0; rr < nrun; ++rr) { const int row = row_first + rr;
        if (row < NLAT) {
            const int s = row & 8191, gr = s >> 6, gc = s & 63;
#pragma unroll
            for (int it = 0; it < 2; ++it) {
                const int unit = it * 64 + lane, h = unit >> 4, hf = (unit >> 3) & 1, j4 = unit & 7;
                const int off = h * 128 + hf * 64 + j4 * 4, pos = hf ? gc : gr;
                const f32x4 cs = *(const f32x4*)(tab + pos * 32 + j4 * 4), sn = *(const f32x4*)(tab + 4096 + pos * 32 + j4 * 4);
#pragma unroll
                for (int tsel = 0; tsel < 2; ++tsel) { bf16_t* T = (tsel ? PK : PQ) + (size_t)row * 1024 + off;
                    const u32x2 u1 = *(const u32x2*)T, u2 = *(const u32x2*)(T + 32);
                    const float a0 = bflo(u1.x), a1 = bfhi(u1.x), a2 = bflo(u1.y), a3 = bfhi(u1.y), b0 = bflo(u2.x), b1 = bfhi(u2.x), b2 = bflo(u2.y), b3 = bfhi(u2.y);
                    u32x2 o1, o2;
                    o1.x = pk2(a0 * cs[0] - b0 * sn[0], a1 * cs[1] - b1 * sn[1]); o1.y = pk2(a2 * cs[2] - b2 * sn[2], a3 * cs[3] - b3 * sn[3]);
                    o2.x = pk2(b0 * cs[0] + a0 * sn[0], b1 * cs[1] + a1 * sn[1]); o2.y = pk2(b2 * cs[2] + a2 * sn[2], b3 * cs[3] + a3 * sn[3]);
                    *(u32x2*)T = o1; *(u32x2*)(T + 32) = o2; }
            }
        }
#pragma unroll
        for (int tsel = 0; tsel < 2; ++tsel) {
            bf16_t* T = (tsel ? CK : CQ) + (size_t)row * 2048;
            u32x4 wq4[4];
#pragma unroll
            for (int ps = 0; ps < 4; ++ps) wq4[ps] = *(const u32x4*)(T + ps * 512 + lane * 8);
#pragma unroll
            for (int ps = 0; ps < 4; ++ps) {
                const u32x4 w = wq4[ps];
                float v[8] = {bflo(w.x), bfhi(w.x), bflo(w.y), bfhi(w.y), bflo(w.z), bfhi(w.z), bflo(w.w), bfhi(w.w)};
                float ss = 0.f;
#pragma unroll
                for (int j = 0; j < 8; ++j) ss += v[j] * v[j];
                ss += __shfl_xor(ss, 1); ss += __shfl_xor(ss, 2); ss += __shfl_xor(ss, 4); ss += __shfl_xor(ss, 8);
                const float rstd = rsqrtf(ss * (1.0f / 128.0f) + EPSF);
#pragma unroll
                for (int j = 0; j < 8; ++j) v[j] = v[j] * rstd * (tsel ? gkv[j] : gqv[j]);
                u32x4 o; o.x = pk2(v[0], v[1]); o.y = pk2(v[2], v[3]); o.z = pk2(v[4], v[5]); o.w = pk2(v[6], v[7]);
                *(u32x4*)(T + ps * 512 + lane * 8) = o;
            }
        }
        }
        {
            int pos0, len; if (row_first < NLAT) { pos0 = row_first & 8191; len = SEQ; } else { pos0 = (row_first - NLAT) & 255; len = CTXL; }
#pragma unroll 1
            for (int ps = 0; ps < 4; ++ps) {
                const int c = ps * 512 + lane * 8;
                float w0[8], w1[8], w2[8];
#pragma unroll
                for (int hq = 0; hq < 2; ++hq) { const f32x4 a = *(const f32x4*)(cw + c + hq * 4), bq = *(const f32x4*)(cw + 2048 + c + hq * 4), cq = *(const f32x4*)(cw + 4096 + c + hq * 4);
#pragma unroll
                    for (int j = 0; j < 4; ++j) { w0[hq * 4 + j] = a[j]; w1[hq * 4 + j] = bq[j]; w2[hq * 4 + j] = cq[j]; } }
                u32x4 cvr[10], xvr[10], bbr[8];
                const u32x4 zero4 = {0u, 0u, 0u, 0u};
#pragma unroll
                for (int k = 0; k < 10; ++k) { const int rel = k - 1; const bool ok = (rel <= nrun) && (pos0 + rel >= 0) && (pos0 + rel < len) && (rel < nrun || pos0 + rel < len);
                    if (ok && rel <= nrun) { const size_t o = (size_t)(row_first + rel) * 2048 + c; cvr[k] = *(const u32x4*)(BC + o); xvr[k] = *(const u32x4*)(BX + o); } else { cvr[k] = zero4; xvr[k] = zero4; } }
#pragma unroll
                for (int rr = 0; rr < 8; ++rr) bbr[rr] = (rr < nrun) ? *(const u32x4*)(BB + (size_t)(row_first + rr) * 2048 + c) : zero4;
                float up[8], uc[8], un[8];
                auto mk_u = [&](const u32x4 cv, const u32x4 xv, float (&u)[8]) {
                    u[0] = bflo(cv.x) * bflo(xv.x); u[1] = bfhi(cv.x) * bfhi(xv.x); u[2] = bflo(cv.y) * bflo(xv.y); u[3] = bfhi(cv.y) * bfhi(xv.y);
                    u[4] = bflo(cv.z) * bflo(xv.z); u[5] = bfhi(cv.z) * bfhi(xv.z); u[6] = bflo(cv.w) * bflo(xv.w); u[7] = bfhi(cv.w) * bfhi(xv.w); };
                mk_u(cvr[0], xvr[0], up); mk_u(cvr[1], xvr[1], uc);
#pragma unroll
                for (int rr = 0; rr < 8; ++rr) {
                    if (rr < nrun) {
                        mk_u(cvr[rr + 2], xvr[rr + 2], un);
                        const size_t o = (size_t)(row_first + rr) * 2048 + c; const u32x4 bb = bbr[rr];
                        const float bv[8] = {bflo(bb.x), bfhi(bb.x), bflo(bb.y), bfhi(bb.y), bflo(bb.z), bfhi(bb.z), bflo(bb.w), bfhi(bb.w)};
                        float y[8];
#pragma unroll
                        for (int j = 0; j < 8; ++j) y[j] = bv[j] * (up[j] * w0[j] + uc[j] * w1[j] + un[j] * w2[j]);
                        u32x4 ov; ov.x = pk2(y[0], y[1]); ov.y = pk2(y[2], y[3]); ov.z = pk2(y[4], y[5]); ov.w = pk2(y[6], y[7]);
                        *(u32x4*)(BB + o) = ov;
#pragma unroll
                        for (int j = 0; j < 8; ++j) { up[j] = uc[j]; uc[j] = un[j]; }
                    }
                }
            }
        }
    }
}

constexpr int ML_QS = 0, ML_KS = 17408, ML_VT = 53248, ML_CT = 69376, ML_CTSZ = 13056, ML_PRE_TOT = 3 * 8448 * 4;
__device__ __forceinline__ int ml_row(int pp, int b, int dir) {
    if (pp < 256) { const int j = dir ? 255 - pp : pp; return NLAT + b * 256 + j; }
    int s = pp - 256; if (dir) s = 8191 - s; return b * 8192 + s;
}
__device__ __forceinline__ void phase_mlstm(KP p, int l, LAS unsigned char* lds, int wid0) {
    const int tid = tid_fresh(wid0), lane = tid & 63, w = __builtin_amdgcn_readfirstlane(tid >> 6), q4 = lane >> 4, c16 = lane & 15;
    unsigned char* ws = launder(p->ws);
    const bf16_t* PQ = (const bf16_t*)(ws + WS_PQ); const bf16_t* PK = (const bf16_t*)(ws + WS_PK); const bf16_t* PV = (const bf16_t*)(ws + WS_PV);
    const float* GA = (const float*)(ws + WS_GATES);
    for (int task = blockIdx.x; task < 256; task += gridDim.x) {
        const int xq = task & 7, yq = task >> 3; const int bh = 2 * xq + (yq >> 4), dir = (yq >> 3) & 1, sl = yq & 7; const int b = bh >> 3, h = bh & 7;
        bf16_t* H = (bf16_t*)(ws + (dir ? WS_BX : WS_BC));
        float* SCN = (float*)(ws + WS_SCAN) + (size_t)task * 5 * 8448;
        __syncthreads();
        {
            LAS float* PB = (LAS float*)lds; LAS float* TOT = (LAS float*)(lds + ML_PRE_TOT);
            float li_n = 0.f, lf_n = 0.f;
            if (w < 132) { const int r = ml_row(w * 64 + lane, b, dir); li_n = GA[(size_t)r * 32 + (2 * dir) * 8 + h]; lf_n = GA[(size_t)r * 32 + (2 * dir + 1) * 8 + h]; }
            for (int cc = w; cc < 132; cc += 8) {
                const float li = li_n, lf = lf_n;
                if (cc + 8 < 132) { const int r = ml_row((cc + 8) * 64 + lane, b, dir); li_n = GA[(size_t)r * 32 + (2 * dir) * 8 + h]; lf_n = GA[(size_t)r * 32 + (2 * dir + 1) * 8 + h]; }
                float bc = lf;
#pragma unroll
                for (int o = 1; o < 64; o <<= 1) { const float t = __shfl_up(bc, o); if (lane >= o) bc += t; }
                const float a = li - bc;
                float pm = a;
#pragma unroll
                for (int o = 1; o < 64; o <<= 1) { const float t = __shfl_up(pm, o); if (lane >= o) pm = fmaxf(pm, t); }
                PB[cc * 64 + lane] = bc; PB[8448 + cc * 64 + lane] = a; PB[2 * 8448 + cc * 64 + lane] = pm;
                if (lane == 63) { TOT[cc] = bc; TOT[256 + cc] = pm; }
            }
            __syncthreads();
            const float t0 = TOT[lane], p0 = TOT[256 + lane], t1 = TOT[64 + lane], p1 = TOT[256 + 64 + lane], t2 = TOT[128 + (lane & 3)], p2 = TOT[256 + 128 + (lane & 3)];
            float m = 0.f, mk0 = 0.f, mk1 = 0.f, mk2 = 0.f;
#pragma unroll 4
            for (int c = 0; c < 64; ++c) { if (lane == c) mk0 = m; m = rlane(t0, c) + fmaxf(m, rlane(p0, c)); }
#pragma unroll 4
            for (int c = 0; c < 64; ++c) { if (lane == c) mk1 = m; m = rlane(t1, c) + fmaxf(m, rlane(p1, c)); }
#pragma unroll
            for (int c = 0; c < 4; ++c) { if (lane == c) mk2 = m; m = rlane(t2, c) + fmaxf(m, rlane(p2, c)); }
            for (int cc = w; cc < 132; cc += 8) {
                const float mkk = (cc < 64) ? mk0 : (cc < 128 ? mk1 : mk2);
                const float mc = rlane(mkk, cc & 63);
                const float bc = PB[cc * 64 + lane], a = PB[8448 + cc * 64 + lane], pm = PB[2 * 8448 + cc * 64 + lane];
                const float pmall = rlane(pm, 63);
                const float mx = fmaxf(mc, pm), mref = fmaxf(mc, pmall);
                SCN[cc * 64 + lane] = __expf(mc - mx);
                SCN[8448 + cc * 64 + lane] = __expf(fminf(mref - mx, 80.0f));
                SCN[2 * 8448 + cc * 64 + lane] = __expf(-(bc + mx));
                SCN[3 * 8448 + cc * 64 + lane] = __expf(a - mref);
                if (lane == 0) SCN[4 * 8448 + cc] = __expf(mc - mref);
            }
        }
        __syncthreads();
        for (int i = tid; i < 16 * 32; i += NTHREADS) { const int r = 32 + (i >> 5), cdw = i & 31; *(LAS unsigned*)(lds + ML_VT + r * 144 + cdw * 4) = 0x3f803f80u; }
        for (int i = tid; i < 2 * ML_CTSZ / 4; i += NTHREADS) *(LAS unsigned*)(lds + ML_CT + i * 4) = 0u;
        __syncthreads();
        f32x4 Cst[3];
#pragma unroll
        for (int i = 0; i < 3; ++i) Cst[i] = (f32x4){0.f, 0.f, 0.f, 0.f};
        u32x4 qreg[2], kreg[2], vreg; float eak[2], decay; float wi1, em1, emr1;
        const int qrow_l = lane >> 4, qpc = lane & 15, vrow_l = lane >> 2, vpc = lane & 3;
        const int tr = w >> 1, part = w & 1;
        const int sgn = dir ? -1 : 1;
        const unsigned char* PQb = (const unsigned char*)PQ; const unsigned char* PKb = (const unsigned char*)PK; const unsigned char* PVb = (const unsigned char*)PV;
        const unsigned char* SCb = (const unsigned char*)SCN; unsigned char* Hb = (unsigned char*)H;
        const int lq0 = (sgn * (8 * w + qrow_l) * 1024 + h * 128 + qpc * 8) * 2, lq1 = lq0 + sgn * 4 * 2048;
        const int lv = (sgn * (16 * w + vrow_l) * 2048 + h * 256 + sl * 32 + vpc * 8) * 2;
        const int lh = (sgn * (16 * tr + c16) * 2048 + h * 256 + sl * 32 + 16 * part + 4 * q4) * 2;
        const int lea = (3 * 8448 + 8 * w + qrow_l) * 4, lwi = (16 * tr + c16) * 4;
#define ML_PREFETCH(cn) do { const int _r0 = ml_row((cn) * 64, b, dir); const unsigned _q = (unsigned)_r0 * 2048u, _v = (unsigned)_r0 * 4096u, _s = (unsigned)(cn) * 256u; \
            qreg[0] = *(const u32x4*)(PQb + (_q + (unsigned)lq0)); kreg[0] = *(const u32x4*)(PKb + (_q + (unsigned)lq0)); qreg[1] = *(const u32x4*)(PQb + (_q + (unsigned)lq1)); kreg[1] = *(const u32x4*)(PKb + (_q + (unsigned)lq1)); \
            eak[0] = *(const float*)(SCb + (_s + (unsigned)lea)); eak[1] = *(const float*)(SCb + (_s + (unsigned)lea + 16u)); \
            if (w < 4) vreg = *(const u32x4*)(PVb + (_v + (unsigned)lv)); \
            } while (0)
#define ML_PREFETCH_OUT(cn) do { const unsigned _s = (unsigned)(cn) * 256u; \
            wi1 = *(const float*)(SCb + (_s + (unsigned)lwi)); em1 = *(const float*)(SCb + (_s + (unsigned)lwi + 8448u * 4u)); emr1 = *(const float*)(SCb + (_s + (unsigned)lwi + 2u * 8448u * 4u)); \
            decay = *(const float*)(SCb + (4u * 8448u * 4u + (unsigned)(cn) * 4u)); } while (0)
        ML_PREFETCH(0); ML_PREFETCH_OUT(0);
        for (int c = 0; c < 132; ++c) {
#pragma unroll
            for (int i = 0; i < 2; ++i) { const int sr = 8 * w + 4 * i + qrow_l;
                *(LAS u32x4*)(lds + ML_QS + sr * 272 + qpc * 16) = qreg[i];
                const float e = eak[i]; const u32x4 kk4 = kreg[i]; u32x4 ks;
                ks.x = pk2(bflo(kk4.x) * e, bfhi(kk4.x) * e); ks.y = pk2(bflo(kk4.y) * e, bfhi(kk4.y) * e); ks.z = pk2(bflo(kk4.z) * e, bfhi(kk4.z) * e); ks.w = pk2(bflo(kk4.w) * e, bfhi(kk4.w) * e);
                *(LAS u32x4*)(lds + ML_KS + sr * 272 + qpc * 16) = ks; }
            if (w < 4) { const unsigned vw[4] = {vreg.x, vreg.y, vreg.z, vreg.w}; const int sv = 16 * w + vrow_l;
#pragma unroll
                for (int j = 0; j < 4; ++j) { const int e = vpc * 8 + 2 * j;
                    *(LAS bf16_t*)(lds + ML_VT + e * 144 + sv * 2) = (bf16_t)(vw[j] & 0xffffu);
                    *(LAS bf16_t*)(lds + ML_VT + (e + 1) * 144 + sv * 2) = (bf16_t)(vw[j] >> 16); } }
            if (c + 1 < 132) ML_PREFETCH(c + 1);
            LDS_BARRIER();
            const LAS unsigned char* CTc = lds + ML_CT + (c & 1) * ML_CTSZ;
            const LAS unsigned char* kbase = lds + ML_KS + c16 * 272 + 8 * q4 * 2;
            const LAS unsigned char* vbase1 = lds + ML_VT + (16 * part + c16) * 144 + 4 * q4 * 2, * vbase2 = lds + ML_VT + (32 + c16) * 144 + 4 * q4 * 2;
            bf16x8 aq[4], ka[2][4], cb1[4], cb2[4]; u32x2 vf[4];
#pragma unroll
            for (int ks = 0; ks < 4; ++ks) aq[ks] = *(const LAS bf16x8*)(lds + ML_QS + (16 * tr + c16) * 272 + (ks * 32 + 8 * q4) * 2);
#pragma unroll
            for (int ks = 0; ks < 4; ++ks) { ka[0][ks] = *(const LAS bf16x8*)(kbase + ks * 64); ka[1][ks] = *(const LAS bf16x8*)(kbase + 16 * 272 + ks * 64); }
#pragma unroll
            for (int ks = 0; ks < 4; ++ks) { cb1[ks] = *(const LAS bf16x8*)(CTc + (16 * part + c16) * 272 + (ks * 32 + 8 * q4) * 2); cb2[ks] = *(const LAS bf16x8*)(CTc + (32 + c16) * 272 + (ks * 32 + 8 * q4) * 2); }
            vf[0] = *(const LAS u32x2*)(vbase1); vf[1] = *(const LAS u32x2*)(vbase1 + 32); vf[2] = *(const LAS u32x2*)(vbase2); vf[3] = *(const LAS u32x2*)(vbase2 + 32);
            __builtin_amdgcn_sched_barrier(0);
            f32x4 accA = {0.f, 0.f, 0.f, 0.f}, accD = {0.f, 0.f, 0.f, 0.f}, s0 = {0.f, 0.f, 0.f, 0.f}, s1 = {0.f, 0.f, 0.f, 0.f};
#pragma unroll
            for (int ks = 0; ks < 4; ++ks) { s0 = mfma16(ka[0][ks], aq[ks], s0); s1 = mfma16(ka[1][ks], aq[ks], s1); accA = mfma16(cb1[ks], aq[ks], accA); accD = mfma16(cb2[ks], aq[ks], accD); }
            __builtin_amdgcn_sched_barrier(0);
            bf16x8 kb[2][4]; u32x2 vg[4];
#pragma unroll
            for (int ks = 0; ks < 4; ++ks) { kb[0][ks] = *(const LAS bf16x8*)(kbase + 32 * 272 + ks * 64); kb[1][ks] = *(const LAS bf16x8*)(kbase + 48 * 272 + ks * 64); }
            vg[0] = *(const LAS u32x2*)(vbase1 + 64); vg[1] = *(const LAS u32x2*)(vbase1 + 96); vg[2] = *(const LAS u32x2*)(vbase2 + 64); vg[3] = *(const LAS u32x2*)(vbase2 + 96);
            __builtin_amdgcn_sched_barrier(0);
            const int dq = 4 * q4 - 16 * tr - c16;
            f32x4 accIA, accID;
            {
                float pe[8];
#pragma unroll
                for (int r = 0; r < 4; ++r) { pe[r] = (r + dq <= 0) ? s0[r] : 0.f; pe[4 + r] = (16 + r + dq <= 0) ? s1[r] : 0.f; }
                u32x4 pw; pw.x = pk2(pe[0], pe[1]); pw.y = pk2(pe[2], pe[3]); pw.z = pk2(pe[4], pe[5]); pw.w = pk2(pe[6], pe[7]);
                const bf16x8 pf = __builtin_bit_cast(bf16x8, pw);
                u32x4 bw1, bw2; bw1.x = vf[0].x; bw1.y = vf[0].y; bw1.z = vf[1].x; bw1.w = vf[1].y; bw2.x = vf[2].x; bw2.y = vf[2].y; bw2.z = vf[3].x; bw2.w = vf[3].y;
                accIA = mfma16(__builtin_bit_cast(bf16x8, bw1), pf, (f32x4){0.f, 0.f, 0.f, 0.f}); accID = mfma16(__builtin_bit_cast(bf16x8, bw2), pf, (f32x4){0.f, 0.f, 0.f, 0.f});
            }
            if (tr >= 2) {
                f32x4 s2 = {0.f, 0.f, 0.f, 0.f}, s3 = {0.f, 0.f, 0.f, 0.f};
#pragma unroll
                for (int ks = 0; ks < 4; ++ks) { s2 = mfma16(kb[0][ks], aq[ks], s2); s3 = mfma16(kb[1][ks], aq[ks], s3); }
                float pe[8];
#pragma unroll
                for (int r = 0; r < 4; ++r) { pe[r] = (32 + r + dq <= 0) ? s2[r] : 0.f; pe[4 + r] = (48 + r + dq <= 0) ? s3[r] : 0.f; }
                u32x4 pw; pw.x = pk2(pe[0], pe[1]); pw.y = pk2(pe[2], pe[3]); pw.z = pk2(pe[4], pe[5]); pw.w = pk2(pe[6], pe[7]);
                const bf16x8 pf = __builtin_bit_cast(bf16x8, pw);
                u32x4 bw1, bw2; bw1.x = vg[0].x; bw1.y = vg[0].y; bw1.z = vg[1].x; bw1.w = vg[1].y; bw2.x = vg[2].x; bw2.y = vg[2].y; bw2.z = vg[3].x; bw2.w = vg[3].y;
                accIA = mfma16(__builtin_bit_cast(bf16x8, bw1), pf, accIA); accID = mfma16(__builtin_bit_cast(bf16x8, bw2), pf, accID);
            }
            bf16x8 ak[2], bv[3][2];
#pragma unroll
            for (int k2 = 0; k2 < 2; ++k2) {
                const s16x4 t0 = __builtin_amdgcn_ds_read_tr16_b64_v4i16((LAS s16x4*)(lds + ML_KS + (k2 * 32 + 8 * q4 + (c16 >> 2)) * 272 + (16 * w + 4 * (c16 & 3)) * 2));
                const s16x4 t1 = __builtin_amdgcn_ds_read_tr16_b64_v4i16((LAS s16x4*)(lds + ML_KS + (k2 * 32 + 8 * q4 + 4 + (c16 >> 2)) * 272 + (16 * w + 4 * (c16 & 3)) * 2));
                ak[k2] = __builtin_shufflevector(t0, t1, 0, 1, 2, 3, 4, 5, 6, 7);
            }
#pragma unroll
            for (int ct = 0; ct < 3; ++ct)
#pragma unroll
                for (int k2 = 0; k2 < 2; ++k2) bv[ct][k2] = *(const LAS bf16x8*)(lds + ML_VT + (16 * ct + c16) * 144 + (k2 * 32 + 8 * q4) * 2);
            __builtin_amdgcn_sched_barrier(0);
            if (l == 0 || c >= 4) {
                const unsigned hb = (unsigned)ml_row(c * 64, b, dir) * 4096u + (unsigned)lh;
                const float den = wi1 * accD[0] + em1 * accID[0];
                const float inv = __builtin_amdgcn_rcpf(fmaxf(fabsf(den), emr1));
                const f32x4 num = accA * wi1 + accIA * em1;
                u32x2 ow; ow.x = pk2(num[0] * inv, num[1] * inv); ow.y = pk2(num[2] * inv, num[3] * inv);
                *(u32x2*)(Hb + hb) = ow;
            }
            {
                LAS unsigned char* CTn = lds + ML_CT + ((c + 1) & 1) * ML_CTSZ;
#pragma unroll
                for (int ct = 0; ct < 3; ++ct) {
                    Cst[ct] = Cst[ct] * decay;
#pragma unroll
                    for (int k2 = 0; k2 < 2; ++k2) Cst[ct] = mfma16(ak[k2], bv[ct][k2], Cst[ct]);
                }
                if (c + 1 < 132) ML_PREFETCH_OUT(c + 1);
#pragma unroll
                for (int ct = 0; ct < 3; ++ct) { u32x2 o; o.x = pk2(Cst[ct][0], Cst[ct][1]); o.y = pk2(Cst[ct][2], Cst[ct][3]);
                    *(LAS u32x2*)(CTn + (16 * ct + c16) * 272 + (16 * w + 4 * q4) * 2) = o; }
            }
            LDS_BARRIER();
        }
#undef ML_PREFETCH
#undef ML_PREFETCH_OUT
    }
}

constexpr int AT_KS = 0, AT_VS = 17408, AT_RPB = 35840;
__device__ __forceinline__ void phase_attn(KP p, int l, LAS unsigned char* lds, int wid0) {
    const int tid = tid_fresh(wid0), lane = tid & 63, w = __builtin_amdgcn_readfirstlane(tid >> 6), q4 = lane >> 4, c16 = lane & 15;
    unsigned char* ws = launder(p->ws);
    bf16_t* CQ = (bf16_t*)(ws + WS_CQ); const bf16_t* CK = (const bf16_t*)(ws + WS_CK); const bf16_t* CV = (const bf16_t*)(ws + WS_CV);
    const int nunits = 2048 + (l == 0 ? 64 : 0);
    for (int u = blockIdx.x; u < nunits; u += gridDim.x) {
        int b, h, qrow = 0, g = 0, ntl = 0, r0a = 0, qbase;  bool is_ctx = u >= 2048;
        if (!is_ctx) { b = u >> 10; h = (u >> 6) & 15; const int rp = u & 63; qrow = 2 * rp + (w >> 2); g = w & 3;
            r0a = min(max(2 * rp - 4, 0), 120); const int r0b = min(max(2 * rp + 1 - 4, 0), 120); ntl = r0b + 8 - r0a;
            qbase = b * 8192 + qrow * 64 + 16 * g; }
        else { const int uu = u - 2048; b = uu >> 5; h = (uu >> 1) & 15; qbase = NLAT + b * 256 + (uu & 1) * 128 + 16 * w; }
        const int r0q = min(max(qrow - 4, 0), 120);
        const int a_g = (g == 0) ? 0 : (g == 1 ? 8 : (g == 2 ? 24 : 32));
        __syncthreads();
        if (!is_ctx) for (int i = tid; i < 465; i += NTHREADS) *(LAS float*)(lds + AT_RPB + i * 4) = p->c_rpb[((size_t)l * 16 + h) * 465 + i] * 1.4426950408889634f;
        bf16x8 qf[4];
#pragma unroll
        for (int ks = 0; ks < 4; ++ks) qf[ks] = *(const bf16x8*)(CQ + (size_t)(qbase + c16) * 2048 + h * 128 + ks * 32 + 8 * q4);
        f32x4 O[8];
#pragma unroll
        for (int i = 0; i < 8; ++i) O[i] = (f32x4){0.f, 0.f, 0.f, 0.f};
        float m_run = -1e30f, l_run = 0.f;
        const int ntiles = ntl + 4;
        u32x4 kreg[2], vreg[2];
        auto tile_row = [&](int t, int key) -> int { return (t < ntl) ? (b * 8192 + (r0a + t) * 64 + key) : (NLAT + b * 256 + (t - ntl) * 64 + key); };
        const int krow_l = lane >> 4, kpc = lane & 15;
        {
#pragma unroll
          for (int i = 0; i < 2; ++i) { const int r = tile_row(0, 8 * w + 4 * i + krow_l); kreg[i] = *(const u32x4*)(CK + (size_t)r * 2048 + h * 128 + kpc * 8); vreg[i] = *(const u32x4*)(CV + (size_t)r * 2048 + h * 128 + kpc * 8); } }
        for (int t = 0; t < ntiles; ++t) {
            LDS_BARRIER();
#pragma unroll
            for (int i = 0; i < 2; ++i) { const int key = 8 * w + 4 * i + krow_l;
                *(LAS u32x4*)(lds + AT_KS + key * 272 + kpc * 16) = kreg[i];
                *(LAS u32x4*)(lds + AT_VS + key * 288 + kpc * 16) = vreg[i]; }
            if (t + 1 < ntiles) {
#pragma unroll
                for (int i = 0; i < 2; ++i) { const int r = tile_row(t + 1, 8 * w + 4 * i + krow_l); kreg[i] = *(const u32x4*)(CK + (size_t)r * 2048 + h * 128 + kpc * 8); vreg[i] = *(const u32x4*)(CV + (size_t)r * 2048 + h * 128 + kpc * 8); } }
            LDS_BARRIER();
            const bool local = t < ntl; const int kr = r0a + t;
            if (local && !(kr >= r0q && kr < r0q + 8)) continue;
            const int npass = local ? 1 : 2;
            for (int ps = 0; ps < npass; ++ps) {
                const int a0 = local ? a_g : ps * 32;
                const LAS unsigned char* kp0 = lds + AT_KS + (a0 + c16) * 272 + 8 * q4 * 2;
                bf16x8 kf[2][4];
#pragma unroll
                for (int ct = 0; ct < 2; ++ct)
#pragma unroll
                    for (int ks = 0; ks < 4; ++ks) kf[ct][ks] = *(const LAS bf16x8*)(kp0 + ct * 16 * 272 + ks * 64);
                float bs[8];
                if (local) {
                    const int qc = 16 * g + c16;
                    const LAS float* bp = (const LAS float*)(lds + AT_RPB) + ((kr - qrow + 7) * 31 + a0 + 4 * q4 - qc + 15);
#pragma unroll
                    for (int i = 0; i < 8; ++i) bs[i] = bp[16 * (i >> 2) + (i & 3)];
                    asm volatile("" : "+v"(bs[0]), "+v"(bs[1]), "+v"(bs[2]), "+v"(bs[3]), "+v"(bs[4]), "+v"(bs[5]), "+v"(bs[6]), "+v"(bs[7]));
                }
                __builtin_amdgcn_sched_barrier(0);
                f32x4 sc[2] = {{0.f, 0.f, 0.f, 0.f}, {0.f, 0.f, 0.f, 0.f}};
#pragma unroll
                for (int ks = 0; ks < 4; ++ks) { sc[0] = mfma16(kf[0][ks], qf[ks], sc[0]); sc[1] = mfma16(kf[1][ks], qf[ks], sc[1]); }
                __builtin_amdgcn_sched_barrier(0);
                s16x4 vlo[8], vhi[8];
                { const LAS unsigned char* vp0 = lds + AT_VS + (a0 + 4 * q4 + (c16 >> 2)) * 288 + 4 * (c16 & 3) * 2;
#pragma unroll
                  for (int dt = 0; dt < 8; ++dt) { vlo[dt] = __builtin_amdgcn_ds_read_tr16_b64_v4i16((LAS s16x4*)(vp0 + dt * 32)); vhi[dt] = __builtin_amdgcn_ds_read_tr16_b64_v4i16((LAS s16x4*)(vp0 + 16 * 288 + dt * 32)); } }
                __builtin_amdgcn_sched_barrier(0);
                if (local) {
                    const int qc = 16 * g + c16, col0 = min(max(qc - 8, 0), 48);
                    const int kb = a0 + 4 * q4 - col0;
#pragma unroll
                    for (int ct = 0; ct < 2; ++ct)
#pragma unroll
                        for (int r = 0; r < 4; ++r) sc[ct][r] = ((unsigned)(kb + 16 * ct + r) < 16u) ? sc[ct][r] + bs[ct * 4 + r] : -1e30f;
                }
                float mx = fmaxf(fmaxf(fmaxf(sc[0][0], sc[0][1]), fmaxf(sc[0][2], sc[0][3])), fmaxf(fmaxf(sc[1][0], sc[1][1]), fmaxf(sc[1][2], sc[1][3])));
                { const u32x2 t = __builtin_amdgcn_permlane16_swap(__float_as_uint(mx), __float_as_uint(mx), false, false); mx = fmaxf(__uint_as_float(t.x), __uint_as_float(t.y)); }
                { const u32x2 t = __builtin_amdgcn_permlane32_swap(__float_as_uint(mx), __float_as_uint(mx), false, false); mx = fmaxf(__uint_as_float(t.x), __uint_as_float(t.y)); }
                const float m_new = fmaxf(m_run, mx);
                const float alpha = __builtin_amdgcn_exp2f(m_run - m_new);
                float pe[8]; float psum = 0.f;
#pragma unroll
                for (int ct = 0; ct < 2; ++ct)
#pragma unroll
                    for (int r = 0; r < 4; ++r) { const float e = __builtin_amdgcn_exp2f(sc[ct][r] - m_new); pe[ct * 4 + r] = e; psum += e; }
                { const u32x2 t = __builtin_amdgcn_permlane16_swap(__float_as_uint(psum), __float_as_uint(psum), false, false); psum = __uint_as_float(t.x) + __uint_as_float(t.y); }
                { const u32x2 t = __builtin_amdgcn_permlane32_swap(__float_as_uint(psum), __float_as_uint(psum), false, false); psum = __uint_as_float(t.x) + __uint_as_float(t.y); }
                l_run = l_run * alpha + psum; m_run = m_new;
                bf16x8 pf; { u32x4 pw; pw.x = pk2(pe[0], pe[1]); pw.y = pk2(pe[2], pe[3]); pw.z = pk2(pe[4], pe[5]); pw.w = pk2(pe[6], pe[7]); pf = __builtin_bit_cast(bf16x8, pw); }
                if (__ballot(alpha != 1.0f) != 0ull) {
#pragma unroll
                    for (int dt = 0; dt < 8; ++dt) O[dt] = O[dt] * alpha;
                }
#pragma unroll
                for (int dt = 0; dt < 8; ++dt) O[dt] = mfma16(__builtin_shufflevector(vlo[dt], vhi[dt], 0, 1, 2, 3, 4, 5, 6, 7), pf, O[dt]);
            }
        }
        const float linv = 1.0f / l_run;
#pragma unroll
        for (int dt = 0; dt < 8; ++dt) { u32x2 ow; ow.x = pk2(O[dt][0] * linv, O[dt][1] * linv); ow.y = pk2(O[dt][2] * linv, O[dt][3] * linv);
            *(u32x2*)(CQ + (size_t)(qbase + c16) * 2048 + h * 128 + 16 * dt + 4 * q4) = ow; }
    }
}

__device__ __forceinline__ void phase_e2(KP p, int l, int nrows, int wid0) {
    const int tid = tid_fresh(wid0); const int lane = tid & 63, gw = blockIdx.x * 8 + (tid >> 6), nw = gridDim.x * 8;
    unsigned char* ws = launder(p->ws);
    const bf16_t* HF = (const bf16_t*)(ws + WS_BC); const bf16_t* HB = (const bf16_t*)(ws + WS_BX); bf16_t* PO = (bf16_t*)(ws + WS_PO);
    const float* hg = p->a_hnorm_g + (size_t)l * 2048;
    for (int row = gw; row < nrows; row += nw) {
        u32x2 fv[8], bv[8], ovv[8];
#pragma unroll
        for (int h = 0; h < 8; ++h) { const size_t o = (size_t)row * 2048 + h * 256 + lane * 4; fv[h] = *(const u32x2*)(HF + o); bv[h] = *(const u32x2*)(HB + o); ovv[h] = *(const u32x2*)(PO + o); }
#pragma unroll
        for (int h = 0; h < 8; ++h) {
            const size_t o = (size_t)row * 2048 + h * 256 + lane * 4;
            const u32x2 f = fv[h], bb = bv[h], ov = ovv[h];
            float v[4] = {bflo(f.x) + bflo(bb.x), bfhi(f.x) + bfhi(bb.x), bflo(f.y) + bflo(bb.y), bfhi(f.y) + bfhi(bb.y)};
            float ss = v[0] * v[0] + v[1] * v[1] + v[2] * v[2] + v[3] * v[3];
            ss = wave_sum(ss);
            const float rstd = rsqrtf(ss * (1.0f / 256.0f) + EPSF);
            const f32x4 gg = *(const f32x4*)(hg + h * 256 + lane * 4);
            const float og[4] = {bflo(ov.x), bfhi(ov.x), bflo(ov.y), bfhi(ov.y)};
            float y[4];
#pragma unroll
            for (int j = 0; j < 4; ++j) y[j] = sigmoidf_(og[j]) * v[j] * rstd * gg[j];
            u32x2 wv; wv.x = pk2(y[0], y[1]); wv.y = pk2(y[2], y[3]); *(u32x2*)(PO + o) = wv;
        }
    }
}

template <int MODE>
__device__ __forceinline__ void ctx_gemm(KP p, int l, LAS unsigned char* lds, int wid0) {
    const int tid = tid_fresh(wid0); const int lane = tid & 63, w = __builtin_amdgcn_readfirstlane(tid >> 6), q4 = lane >> 4, c16 = lane & 15;
    unsigned char* ws = launder(p->ws);
    for (int task = blockIdx.x; task < (NCTX / 64) * 32; task += gridDim.x) {
        const int rg = task >> 5, cb = task & 31; const int row0 = NLAT + rg * 64, col0 = cb * 64;
        const int orow = row0 + (tid >> 3), ocol = col0 + (tid & 7) * 8;
        float yv[8];
#pragma unroll
        for (int i = 0; i < 8; ++i) yv[i] = 0.f;
#pragma unroll 1
        for (int br = 0; br < (MODE == 0 ? 3 : 1); ++br) {
            const bf16_t* A; const bf16_t* Bt;
            if (MODE == 0) { const int ti = 1 + 4 * (br == 1) + (br == 2); A = (const bf16_t*)(ws + WS_T8 + (size_t)ti * SZ_A); Bt = (const bf16_t*)(ws + WS_WA + (size_t)br * SZ_W); }
            else if (MODE == 1) { A = (const bf16_t*)(ws + WS_Y); Bt = (const bf16_t*)(ws + WS_WO); }
            else { A = (const bf16_t*)(ws + WS_XN); Bt = (const bf16_t*)(ws + WS_WQ); }
            const bf16_t* ap = A + (size_t)(row0 + c16) * 2048 + w * 256 + 8 * q4; const bf16_t* bp = Bt + (size_t)(col0 + c16) * 2048 + w * 256 + 8 * q4;
            f32x4 acc[4][4];
#pragma unroll
            for (int mi = 0; mi < 4; ++mi)
#pragma unroll
                for (int j = 0; j < 4; ++j) acc[mi][j] = (f32x4){0.f, 0.f, 0.f, 0.f};
#pragma unroll 2
            for (int ks = 0; ks < 8; ++ks) {
                bf16x8 a[4], bb[4];
#pragma unroll
                for (int mi = 0; mi < 4; ++mi) a[mi] = *(const bf16x8*)(ap + (size_t)mi * 16 * 2048 + ks * 32);
#pragma unroll
                for (int j = 0; j < 4; ++j) bb[j] = *(const bf16x8*)(bp + (size_t)j * 16 * 2048 + ks * 32);
#pragma unroll
                for (int mi = 0; mi < 4; ++mi)
#pragma unroll
                    for (int j = 0; j < 4; ++j) acc[mi][j] = mfma16(a[mi], bb[j], acc[mi][j]);
            }
            __syncthreads();
#pragma unroll
            for (int mi = 0; mi < 4; ++mi)
#pragma unroll
                for (int j = 0; j < 4; ++j)
#pragma unroll
                    for (int r = 0; r < 4; ++r) *(LAS float*)(lds + ((w * 64 + 16 * mi + 4 * q4 + r) * 64 + 16 * j + c16) * 4) = acc[mi][j][r];
            __syncthreads();
            float sv[8];
#pragma unroll
            for (int i = 0; i < 8; ++i) sv[i] = 0.f;
#pragma unroll
            for (int ww = 0; ww < 8; ++ww) { const f32x4 p0 = *(const LAS f32x4*)(lds + ((ww * 64 + (tid >> 3)) * 64 + (tid & 7) * 8) * 4), p1 = *(const LAS f32x4*)(lds + ((ww * 64 + (tid >> 3)) * 64 + (tid & 7) * 8 + 4) * 4);
                sv[0] += p0[0]; sv[1] += p0[1]; sv[2] += p0[2]; sv[3] += p0[3]; sv[4] += p1[0]; sv[5] += p1[1]; sv[6] += p1[2]; sv[7] += p1[3]; }
            if (MODE == 0) { const u32x2 g = *(const u32x2*)(ws + WS_GT + (size_t)orow * 6144 + (size_t)br * 2048 + ocol);
#pragma unroll
                for (int i = 0; i < 8; ++i) yv[i] += pg8::gq8(i < 4 ? g.x : g.y, i & 3) * (1.0f / 255.0f) * sv[i]; }
            else {
#pragma unroll
                for (int i = 0; i < 8; ++i) yv[i] = sv[i]; }
        }
        if (MODE == 1) { bf16_t* xp = (bf16_t*)(ws + WS_X) + (size_t)orow * 2048 + ocol; const float* xi = p->ctx + (size_t)(orow - NLAT) * 2048 + ocol; const float* mg = (const float*)(ws + WS_MOD) + (size_t)l * 3 * 12288 + 2 * 12288 + 2 * 2048 + ocol;
            const f32x4 x0 = *(const f32x4*)xi, x1 = *(const f32x4*)(xi + 4), g0 = *(const f32x4*)mg, g1 = *(const f32x4*)(mg + 4);
            f32x4 o0, o1; o0[0] = x0[0] + g0[0] * yv[0]; o0[1] = x0[1] + g0[1] * yv[1]; o0[2] = x0[2] + g0[2] * yv[2]; o0[3] = x0[3] + g0[3] * yv[3];
            o1[0] = x1[0] + g1[0] * yv[4]; o1[1] = x1[1] + g1[1] * yv[5]; o1[2] = x1[2] + g1[2] * yv[6]; o1[3] = x1[3] + g1[3] * yv[7];
            u32x4 ow; ow.x = pk2(o0[0], o0[1]); ow.y = pk2(o0[2], o0[3]); ow.z = pk2(o1[0], o1[1]); ow.w = pk2(o1[2], o1[3]); *(u32x4*)xp = ow; }
        else { u32x4 ov; ov.x = pk2(yv[0], yv[1]); ov.y = pk2(yv[2], yv[3]); ov.z = pk2(yv[4], yv[5]); ov.w = pk2(yv[6], yv[7]);
            *(u32x4*)((bf16_t*)(ws + (MODE == 0 ? WS_Y : WS_PV)) + (size_t)orow * 2048 + ocol) = ov; }
    }
}

constexpr int PE_MAXT = 80;
constexpr int PE_IDX = 0, PE_W = PE_MAXT * 128 * 4, PE_SCR = 2 * PE_MAXT * 128 * 4, PE_SCRSZ = 16 * 132 * 4 + 4096 + 256;
#define PE_DPPU(v, ctrl) ((unsigned)__builtin_amdgcn_update_dpp(0, (int)(v), ctrl, 0xf, 0xf, true))
__device__ __forceinline__ unsigned ordkey(float v) { const unsigned u = __float_as_uint(v); return (u & 0x80000000u) ? ~u : (u | 0x80000000u); }
__device__ __forceinline__ void phase_peer(KP p, int l, LAS unsigned char* lds, int wid0) {
    const int tid = tid_fresh(wid0), lane = tid & 63, w = __builtin_amdgcn_readfirstlane(tid >> 6), q4 = lane >> 4, c16 = lane & 15;
    unsigned char* ws = launder(p->ws);
    const bf16_t* QP = (const bf16_t*)(ws + WS_PV); const bf16_t* KEYS = (const bf16_t*)(ws + WS_KEYS);
    const bf16_t* XN = (const bf16_t*)(ws + WS_XN);
    bf16_t* X = (bf16_t*)(ws + WS_X); const float* mod = (const float*)(ws + WS_MOD) + (size_t)l * 3 * 12288;
    const int ntok = (l == 0) ? MR : NLAT, G = gridDim.x;
    const int per = (ntok + G - 1) / G; const int t_begin = blockIdx.x * per, t_end = min(ntok, t_begin + per);
    for (int tb = t_begin; tb < t_end; tb += PE_MAXT) {
        const int nt = min(PE_MAXT, t_end - tb);
        __syncthreads();
        const int ntask = (nt + 15) >> 4;
        if (w < ntask) {
            int lane_pe1 = lane; asm volatile("" : "+v"(lane_pe1));
            const int lane = lane_pe1, q4 = lane >> 4, c16 = lane & 15;
            LAS unsigned char* scr = lds + PE_SCR + w * PE_SCRSZ;
            LAS float* SC = (LAS float*)scr;
            LAS float* LS = (LAS float*)(scr + 16 * 132 * 4);
            LAS int* LI = (LAS int*)(scr + 16 * 132 * 4 + 2048);
            LAS unsigned char* PT = scr + 16 * 132 * 4 + 4096;
            if (lane < 52) {
                const int L = lane;
                const int ge16 = L >= 16, ge24 = L >= 24, ge29 = L >= 29, ge33 = L >= 33, ge36 = L >= 36, ge38 = L >= 38, ge40 = L >= 40, ge42 = L >= 42;
                int pa = ge16 + ge24 + ge29 + ge33 + ge36 + ge38 + ge40 + ge42; if (ge42) pa = 8 + (L - 42);
                int pb = L - (16 * ge16 + 8 * ge24 + 5 * ge29 + 4 * ge33 + 3 * ge36 + 2 * ge38 + 2 * ge40 + 2 * ge42); if (ge42) pb = 0;
                if (L >= 50) { pa = 15; pb = 15; }
                PT[lane * 2] = (unsigned char)pa; PT[lane * 2 + 1] = (unsigned char)pb;
            }
            const int tok_a = min(tb + 16 * w + c16, t_end - 1);
            const int tkl = lane >> 2, qq = lane & 3;
            for (int h = 0; h < 8; ++h) {
                for (int pp = 0; pp < 2; ++pp) {
                    const int hp = 2 * h + pp;
                    bf16x8 af[4];
#pragma unroll
                    for (int ks = 0; ks < 4; ++ks) af[ks] = *(const bf16x8*)(QP + (size_t)tok_a * 2048 + h * 256 + pp * 128 + ks * 32 + 8 * q4);
#pragma unroll 4
                    for (int ct = 0; ct < 8; ++ct) {
                        f32x4 acc = {0.f, 0.f, 0.f, 0.f};
#pragma unroll
                        for (int ks = 0; ks < 4; ++ks) { const bf16x8 bfr = *(const bf16x8*)(KEYS + ((size_t)hp * 128 + 16 * ct + c16) * 128 + ks * 32 + 8 * q4); acc = mfma16(af[ks], bfr, acc); }
#pragma unroll
                        for (int r = 0; r < 4; ++r) SC[(4 * q4 + r) * 132 + 16 * ct + c16] = acc[r];
                    }
                    asm volatile("s_waitcnt lgkmcnt(0)" ::: "memory");
                    unsigned key[32];
#pragma unroll
                    for (int i = 0; i < 8; ++i) { const f32x4 v = *(const LAS f32x4*)(SC + tkl * 132 + 32 * qq + 4 * i);
#pragma unroll
                        for (int j = 0; j < 4; ++j) key[4 * i + j] = ((ordkey(v[j]) >> 1) & ~127u) | (unsigned)(32 * qq + 4 * i + j); }
                    unsigned prev = 0x80000000u;
#pragma unroll 1
                    for (int r = 0; r < 16; ++r) {
                        unsigned mxd = 0u;
#pragma unroll
                        for (int i = 0; i < 32; ++i) { const unsigned d = key[i] - prev; mxd = mxd > d ? mxd : d; }
                        { const unsigned o1 = PE_DPPU(mxd, 0xB1); mxd = mxd > o1 ? mxd : o1; const unsigned o2 = PE_DPPU(mxd, 0x4E); mxd = mxd > o2 ? mxd : o2; }
                        const unsigned mxk = mxd + prev;
                        prev = mxk;
                        if (qq == (r & 3)) { const int idx = (int)(mxk & 127u); LS[(pp * 16 + tkl) * 16 + r] = SC[tkl * 132 + idx]; LI[(pp * 16 + tkl) * 16 + r] = idx; }
                    }
                    asm volatile("s_waitcnt lgkmcnt(0)" ::: "memory");
                }
                unsigned ck[13];
#pragma unroll
                for (int i = 0; i < 13; ++i) { const int cidx = qq + 4 * i;
                    if (cidx < 50) { const int a = PT[cidx * 2], bq = PT[cidx * 2 + 1]; const float sv = LS[(0 * 16 + tkl) * 16 + a] + LS[(1 * 16 + tkl) * 16 + bq]; ck[i] = ((ordkey(sv) >> 1) & ~63u) | (unsigned)cidx; }
                    else ck[i] = 0u; }
                unsigned prev = 0x80000000u; float best0 = 0.f, esum = 0.f; float myexp[4] = {0.f, 0.f, 0.f, 0.f}; int myidx[4] = {0, 0, 0, 0};
#pragma unroll
                for (int r = 0; r < 16; ++r) {
                    unsigned mxd = 0u;
#pragma unroll
                    for (int i = 0; i < 13; ++i) { const unsigned d = ck[i] - prev; mxd = mxd > d ? mxd : d; }
                    { const unsigned o1 = PE_DPPU(mxd, 0xB1); mxd = mxd > o1 ? mxd : o1; const unsigned o2 = PE_DPPU(mxd, 0x4E); mxd = mxd > o2 ? mxd : o2; }
                    const unsigned mxk = mxd + prev;
                    prev = mxk;
                    const int cidx = (int)(mxk & 63u); const int a = PT[cidx * 2], bq = PT[cidx * 2 + 1];
                    const float best = LS[(0 * 16 + tkl) * 16 + a] + LS[(1 * 16 + tkl) * 16 + bq];
                    const int eidx = LI[(0 * 16 + tkl) * 16 + a] * 128 + LI[(1 * 16 + tkl) * 16 + bq];
                    if (r == 0) best0 = best;
                    const float e = __expf(best - best0); esum += e;
                    if (qq == (r & 3)) { myexp[r >> 2] = e; myidx[r >> 2] = eidx; }
                }
                const float inv = 1.0f / esum; const int tl = 16 * w + tkl;
                if (tl < nt) {
#pragma unroll
                    for (int i = 0; i < 4; ++i) { const int r = 4 * i + qq;
                        *(LAS int*)(lds + PE_IDX + (tl * 128 + h * 16 + r) * 4) = myidx[i];
                        *(LAS float*)(lds + PE_W + (tl * 128 + h * 16 + r) * 4) = myexp[i] * inv; }
                }
                asm volatile("s_waitcnt lgkmcnt(0)" ::: "memory");
            }
        }
        __syncthreads();
        int lane_pe2 = lane; asm volatile("" : "+v"(lane_pe2));
        const int nfull = nt & ~7, nleft = nt - nfull;
        const int S = (nleft == 1 || nleft == 2 || nleft == 4) ? 8 / nleft : 1;
        const int nrounds = (nfull >> 3) + (nleft ? 1 : 0);
        for (int rd = 0; rd < nrounds; ++rd) {
            const int lane = lane_pe2;
            const bool split = (rd == (nfull >> 3)) && S > 1;
            const int tl = split ? nfull + w / S : rd * 8 + w;
            const int NB = split ? 64 / S : 64, B0 = split ? (w % S) * NB : 0;
            const bool active = tl < nt;
            if (active) {
            const int row = tb + tl;
            u32x16 xq;
#pragma unroll
            for (int i = 0; i < 4; ++i) { const u32x4 xw = *(const u32x4*)(XN + (size_t)row * 2048 + lane * 32 + i * 8); xq[4 * i] = xw.x; xq[4 * i + 1] = xw.y; xq[4 * i + 2] = xw.z; xq[4 * i + 3] = xw.w; }
            const LAS int* idxp = (const LAS int*)(lds + PE_IDX + tl * 512);
            LAS float* wp = (LAS float*)(lds + PE_W + tl * 512);
            u32x4 bufA[2], bufB[2], bufC[2], bufD[2];
#define PE_ISSUE(buf, TAB, b) do { const u32x2 _ee = *(const LAS u32x2*)(idxp + 2 * (b)); \
                buf[0] = *(const u32x4*)((TAB) + ((_ee.x << 10) + (unsigned)lane * 16u)); buf[1] = *(const u32x4*)((TAB) + ((_ee.y << 10) + (unsigned)lane * 16u)); } while (0)
#define PE_DPPF(v, ctrl) __uint_as_float((unsigned)__builtin_amdgcn_update_dpp(0, (int)__float_as_uint(v), ctrl, 0xf, 0xf, true))
#define PE_CONS_U(buf, b) do { float _p[2]; \
                _Pragma("unroll") for (int _j = 0; _j < 2; ++_j) { float _d = 0.f; \
                    _Pragma("unroll") for (int _q = 0; _q < 4; ++_q) { const unsigned _dw = buf[_j][_q]; \
                        _d = dot2bf(__builtin_bit_cast(unsigned, __builtin_amdgcn_cvt_scalef32_pk_bf16_fp4(_dw, 1.0f, 0)), xq[4 * _q + 0], _d); _d = dot2bf(__builtin_bit_cast(unsigned, __builtin_amdgcn_cvt_scalef32_pk_bf16_fp4(_dw, 1.0f, 1)), xq[4 * _q + 1], _d); \
                        _d = dot2bf(__builtin_bit_cast(unsigned, __builtin_amdgcn_cvt_scalef32_pk_bf16_fp4(_dw, 1.0f, 2)), xq[4 * _q + 2], _d); _d = dot2bf(__builtin_bit_cast(unsigned, __builtin_amdgcn_cvt_scalef32_pk_bf16_fp4(_dw, 1.0f, 3)), xq[4 * _q + 3], _d); } \
                    _p[_j] = _d; } \
                float _c; { const u32x2 _t = __builtin_amdgcn_permlane32_swap(__float_as_uint(_p[0]), __float_as_uint(_p[1]), false, false); _c = __uint_as_float(_t.x) + __uint_as_float(_t.y); }     \
                { const u32x2 _t = __builtin_amdgcn_permlane16_swap(__float_as_uint(_c), __float_as_uint(_c), false, false); _c = __uint_as_float(_t.x) + __uint_as_float(_t.y); } \
                _c += PE_DPPF(_c, 0x140); _c += PE_DPPF(_c, 0x141); _c += PE_DPPF(_c, 0x4E); _c += PE_DPPF(_c, 0xB1);        \
                if ((lane & 31) == ((((b) - B0)) & 31)) cacc = _c; } while (0)
#define PE_FLUSH(jb, cnt) do { if ((lane & 31) < (cnt)) { const int _e = 2 * (B0 + (jb) + (lane & 31)) + (lane >> 5); const float _g = wp[_e]; \
                const float _a = cacc * (1.0f / 64.0f); wp[_e] = _g * 0.5f * _a * (1.0f + erff(_a * 0.70710678118654752f)); } } while (0)
#define PE_CONS_V(buf, b) do { const f32x2 _w2 = *(const LAS f32x2*)(wp + 2 * (b)); \
                _Pragma("unroll") for (int _j = 0; _j < 2; ++_j) { const f32x2 _wv = {_w2[_j], _w2[_j]}; \
                    _Pragma("unroll") for (int _q = 0; _q < 4; ++_q) { const unsigned _dw = buf[_j][_q]; \
                        out2[4 * _q + 0] += _wv * __builtin_amdgcn_cvt_scalef32_pk_f32_fp4(_dw, 1.0f, 0); out2[4 * _q + 1] += _wv * __builtin_amdgcn_cvt_scalef32_pk_f32_fp4(_dw, 1.0f, 1); \
                        out2[4 * _q + 2] += _wv * __builtin_amdgcn_cvt_scalef32_pk_f32_fp4(_dw, 1.0f, 2); out2[4 * _q + 3] += _wv * __builtin_amdgcn_cvt_scalef32_pk_f32_fp4(_dw, 1.0f, 3); } } } while (0)
            const unsigned char* TU = ws + WS_PU; const unsigned char* TV = ws + WS_PVW;
            const int NT = 2 * NB;
            asm volatile("" : "+v"(xq));
#define PE_ISS(s_, bi) do { const int _jn = min(max(j0 + (s_) + 3, 0), NT - 1); const bool _isv = _jn >= NB; \
                const unsigned char* _tab = _isv ? TV : TU; const int _bb = B0 + (_isv ? _jn - NB : _jn); PE_ISSUE(bi, _tab, _bb); } while (0)
            float cacc = 0.f;
#pragma unroll 1
            for (int t = -1; 4 * t < NB; ++t) { const int j0 = 4 * t;
                PE_ISS(0, bufD); if (t >= 0) PE_CONS_U(bufA, B0 + j0);
                PE_ISS(1, bufA); if (t >= 0) PE_CONS_U(bufB, B0 + j0 + 1);
                PE_ISS(2, bufB); if (t >= 0) PE_CONS_U(bufC, B0 + j0 + 2);
                PE_ISS(3, bufC); if (t >= 0) PE_CONS_U(bufD, B0 + j0 + 3);
                if (t >= 0 && ((t & 7) == 7 || 4 * (t + 1) >= NB)) PE_FLUSH(32 * (t >> 3), min(32, NB - 32 * (t >> 3)));
            }
            asm volatile("s_waitcnt lgkmcnt(0)" ::: "memory");
            f32x2 out2[16];
#pragma unroll
            for (int i = 0; i < 16; ++i) out2[i] = (f32x2){0.f, 0.f};
#pragma unroll 1
            for (int t = 0; 4 * t < NB; ++t) { const int j0 = NB + 4 * t;
                PE_ISS(0, bufD); PE_CONS_V(bufA, B0 + 4 * t);
                PE_ISS(1, bufA); PE_CONS_V(bufB, B0 + 4 * t + 1);
                PE_ISS(2, bufB); PE_CONS_V(bufC, B0 + 4 * t + 2);
                PE_ISS(3, bufC); PE_CONS_V(bufD, B0 + 4 * t + 3);
            }
#undef PE_ISS
#undef PE_ISSUE
#undef PE_CONS_U
#undef PE_FLUSH
#undef PE_DPPF
#undef PE_CONS_V
            f32x32 outv;
#pragma unroll
            for (int i = 0; i < 16; ++i) { outv[2 * i] = out2[i][0]; outv[2 * i + 1] = out2[i][1]; }
            if (split) {
                LAS float* pp = (LAS float*)(lds + PE_SCR) + ((size_t)((tl - nfull) * S + (w % S)) * 64 + lane) * 32;
#pragma unroll
                for (int i = 0; i < 8; ++i) { f32x4 t4; t4[0] = outv[4 * i]; t4[1] = outv[4 * i + 1]; t4[2] = outv[4 * i + 2]; t4[3] = outv[4 * i + 3]; *(LAS f32x4*)(pp + 4 * i) = t4; }
            }
            if (!split) {
            const int which = row < NLAT ? (row >> 13) : 2;
            const float* mg = mod + (size_t)which * 12288 + 5 * 2048;
            const bf16_t* xrow = X + (size_t)row * 2048;
            u32x4 xbv[4]; f32x4 gvv[8];
#pragma unroll
            for (int i = 0; i < 4; ++i) xbv[i] = *(const u32x4*)(xrow + lane * 32 + i * 8);
#pragma unroll
            for (int hh = 0; hh < 8; ++hh) gvv[hh] = *(const f32x4*)(mg + lane * 32 + hh * 4);
#pragma unroll
            for (int i = 0; i < 4; ++i) { const u32x4 xw = xbv[i]; const f32x4 g0 = gvv[2 * i], g1 = gvv[2 * i + 1];
                f32x4 o0, o1;
                o0[0] = bflo(xw.x) + g0[0] * outv[i * 8 + 0] * 0.25f; o0[1] = bfhi(xw.x) + g0[1] * outv[i * 8 + 1] * 0.25f; o0[2] = bflo(xw.y) + g0[2] * outv[i * 8 + 2] * 0.25f; o0[3] = bfhi(xw.y) + g0[3] * outv[i * 8 + 3] * 0.25f;
                o1[0] = bflo(xw.z) + g1[0] * outv[i * 8 + 4] * 0.25f; o1[1] = bfhi(xw.z) + g1[1] * outv[i * 8 + 5] * 0.25f; o1[2] = bflo(xw.w) + g1[2] * outv[i * 8 + 6] * 0.25f; o1[3] = bfhi(xw.w) + g1[3] * outv[i * 8 + 7] * 0.25f;
                if (l == 1) { float* orow = p->out + (size_t)row * 2048 + lane * 32 + i * 8; *(f32x4*)orow = o0; *(f32x4*)(orow + 4) = o1; }
                else { u32x4 ow; ow.x = pk2(o0[0], o0[1]); ow.y = pk2(o0[2], o0[3]); ow.z = pk2(o1[0], o1[1]); ow.w = pk2(o1[2], o1[3]); *(u32x4*)(X + (size_t)row * 2048 + lane * 32 + i * 8) = ow; } }
            }
            }
            if (split) {
                __syncthreads();
                if ((w % S) == 0 && tl < nt) {
                    const int row = tb + tl;
                    const int which = row < NLAT ? (row >> 13) : 2;
                    const float* mg = mod + (size_t)which * 12288 + 5 * 2048;
                    const bf16_t* xrow = X + (size_t)row * 2048;
                    const LAS float* pp = (const LAS float*)(lds + PE_SCR) + ((size_t)((tl - nfull) * S) * 64 + lane) * 32;
                    u32x4 xbv[4];
#pragma unroll
                    for (int i = 0; i < 4; ++i) xbv[i] = *(const u32x4*)(xrow + lane * 32 + i * 8);
#pragma unroll
                    for (int i = 0; i < 4; ++i) {
                        f32x4 a0 = *(const LAS f32x4*)(pp + i * 8), a1 = *(const LAS f32x4*)(pp + i * 8 + 4);
                        for (int q = 1; q < S; ++q) { a0 += *(const LAS f32x4*)(pp + (size_t)q * 64 * 32 + i * 8); a1 += *(const LAS f32x4*)(pp + (size_t)q * 64 * 32 + i * 8 + 4); }
                        const f32x4 g0 = *(const f32x4*)(mg + lane * 32 + i * 8), g1 = *(const f32x4*)(mg + lane * 32 + i * 8 + 4);
                        const u32x4 xw = xbv[i];
                        f32x4 o0, o1;
                        o0[0] = bflo(xw.x) + g0[0] * a0[0] * 0.25f; o0[1] = bfhi(xw.x) + g0[1] * a0[1] * 0.25f; o0[2] = bflo(xw.y) + g0[2] * a0[2] * 0.25f; o0[3] = bfhi(xw.y) + g0[3] * a0[3] * 0.25f;
                        o1[0] = bflo(xw.z) + g1[0] * a1[0] * 0.25f; o1[1] = bfhi(xw.z) + g1[1] * a1[1] * 0.25f; o1[2] = bflo(xw.w) + g1[2] * a1[2] * 0.25f; o1[3] = bfhi(xw.w) + g1[3] * a1[3] * 0.25f;
                        if (l == 1) { float* orow = p->out + (size_t)row * 2048 + lane * 32 + i * 8; *(f32x4*)orow = o0; *(f32x4*)(orow + 4) = o1; }
                        else { u32x4 ow; ow.x = pk2(o0[0], o0[1]); ow.y = pk2(o0[2], o0[3]); ow.z = pk2(o1[0], o1[1]); ow.w = pk2(o1[2], o1[3]); *(u32x4*)(X + (size_t)row * 2048 + lane * 32 + i * 8) = ow; }
                    }
                }
            }
        }
    }
}

#if !MK_SINGLE
#define LOHI_ARGS , const int lo, const int hi
#define LOHI_PASS , lo, hi
#else
#define LOHI_ARGS
#define LOHI_PASS
#endif
#ifndef PHM
#define PHM 0x7ff
#endif
#if MK_SINGLE
#define IN(k) (((PHM >> (((k) % NPH))) & 1) != 0)
#define SEAM(k) do { if ((k) + 1 < 2 * NPH) xcd_barrier(bar); } while (0)
#else
#define IN(k) (((PHM >> (((k) % NPH))) & 1) && lo <= (k) && (k) < hi)
#define SEAM(k) do { if (IN(k) && IN((k) + 1)) xcd_barrier(bar); } while (0)
#endif
template <int l>
__device__ __forceinline__ void layer_program(KP kp, unsigned char* ws0, LAS unsigned char* lds, const XcdBarrier& bar, const int G, const int wid0 LOHI_ARGS) {
        const int pb = l * NPH;
        const int M2 = (l == 0) ? MR : NLAT;
        constexpr int MG = NLAT;
        if (IN(pb + 0)) { phase_w(launder_p(kp), l, lds, wid0); } SEAM(pb + 0);
        if (IN(pb + 1)) { phase_norm(launder_p(kp), l, 0, MR, wid0); } SEAM(pb + 1);
        if (IN(pb + 2)) { unsigned char* ws = launder(ws0);
            { pg8::PlainOrder S; S.init(ws + WS_XN8, ws + WS_WIN, MR, (72 - (BF_HI - BF_LO)) * 256, 1024, G, (int)blockIdx.x); S.skip_from = BF_LO; S.skip_cnt = BF_HI - BF_LO; S.skip2_from = 48; S.skip2_cnt = 24;
              if (G == 256 && BF_HI - BF_LO == 8) { S.short_rounds = 15; S.n_long = 192; }
              pg8::EpiProj E{ws};
              pg8::gemm_phase<pg8::EpiProj, pg8::PlainOrder, true>(lds, 1024, S, E, wid0); }
            { pg8::PlainOrder S; S.init(ws + WS_XN, ws + WS_WINB, MR, (24 + BF_HI - BF_LO) * 256, 2048, G, G - 1 - (int)blockIdx.x); S.pn_base = BF_LO; S.skip_from = BF_HI; S.skip_cnt = 48 - BF_HI; S.b_compact = 1;
              pg8::EpiProj E{ws};
              pg8::gemm_phase<pg8::EpiProj, pg8::PlainOrder, false>(lds, 2048, S, E, wid0); }
        } SEAM(pb + 2);
        if (IN(pb + 3)) { phase_gates_gemm(launder_p(kp), l, wid0); phase_e1(launder_p(kp), l, wid0); } SEAM(pb + 3);
        if (IN(pb + 4)) { phase_mlstm(launder_p(kp), l, lds, wid0); phase_attn(launder_p(kp), l, lds, wid0); } SEAM(pb + 4);
        if (IN(pb + 5)) { phase_e2(launder_p(kp), l, M2, wid0); } SEAM(pb + 5);
        if (IN(pb + 6)) { unsigned char* ws = launder(ws0);
            pg8::BranchOrder S; S.T8 = (const char*)(ws + WS_T8); S.WA = (const char*)(ws + WS_WA);
            S.nM = MG / 256; S.nN = 8; S.G = G; S.c = (int)blockIdx.x; S.tstep = (size_t)256 * 2048 * 2;
            pg8::EpiMerge E{(bf16_t*)(ws + WS_Y), (const unsigned char*)(ws + WS_GT)};
            pg8::gemm_phase<pg8::EpiMerge, pg8::BranchOrder>(lds, 2048, S, E, wid0);
            if (l == 0) ctx_gemm<0>(launder_p(kp), l, lds, wid0);
        } SEAM(pb + 6);
        if (IN(pb + 7)) { unsigned char* ws = launder(ws0);
            pg8::PlainOrder S; S.init(ws + WS_Y, ws + WS_WO, MG, 2048, 2048, G, (int)blockIdx.x);
            if constexpr (l == 0) { pg8::EpiRes<true> E{(bf16_t*)(ws + WS_X), kp->x, (const float*)(ws + WS_MOD) + (size_t)l * 3 * 12288};
                pg8::gemm_phase<pg8::EpiRes<true>, pg8::PlainOrder>(lds, 2048, S, E, wid0); }
            else { pg8::EpiRes<false> E{(bf16_t*)(ws + WS_X), nullptr, (const float*)(ws + WS_MOD) + (size_t)l * 3 * 12288};
                pg8::gemm_phase<pg8::EpiRes<false>, pg8::PlainOrder>(lds, 2048, S, E, wid0); }
            if (l == 0) ctx_gemm<1>(launder_p(kp), l, lds, wid0);
        } SEAM(pb + 7);
        if (IN(pb + 8)) { phase_norm(launder_p(kp), l, 1, M2, wid0); } SEAM(pb + 8);
        if (IN(pb + 9)) { unsigned char* ws = launder(ws0);
            pg8::PlainOrder S; S.init(ws + WS_XN, ws + WS_WQ, MG, 2048, 2048, G, (int)blockIdx.x);
            pg8::EpiBf E{(bf16_t*)(ws + WS_PV), 2048};
            pg8::gemm_phase<pg8::EpiBf, pg8::PlainOrder>(lds, 2048, S, E, wid0);
            if (l == 0) ctx_gemm<2>(launder_p(kp), l, lds, wid0);
        } SEAM(pb + 9);
        if (IN(pb + 10)) { phase_peer(launder_p(kp), l, lds, wid0); } SEAM(pb + 10);
    }
#undef IN
#undef SEAM

__global__ void __launch_bounds__(NTHREADS, 2) fwd_kernel(Params p) {
    extern __shared__ __attribute__((aligned(16))) unsigned char lds_raw[];
    LAS unsigned char* lds = (LAS unsigned char*)lds_raw;
    const int tid = threadIdx.x, G = gridDim.x;
    const int wid0 = __builtin_amdgcn_readfirstlane(tid >> 6);
    KP kp = (KP)__builtin_amdgcn_kernarg_segment_ptr();
    unsigned char* ws0 = kp->ws;
    volatile LAS unsigned* bst = (volatile LAS unsigned*)(lds + LDS_BYTES - 16);
    if (tid == 0) { bst[0] = 0u; bst[1] = 0u; bst[2] = 0u; bst[3] = 0u; }
    __syncthreads();
    XcdBarrier bar; bar.bar = (unsigned*)(ws0 + WS_BAR); bar.x = 0; bar.st = bst;
    if (MK_SINGLE) bar = xcd_barrier_post((unsigned*)(ws0 + WS_BAR), bst);
#if !MK_SINGLE
    const int lo = kp->ph_lo, hi = kp->ph_hi;
#endif
    layer_program<0>(kp, ws0, lds, bar, G, wid0 LOHI_PASS);
    layer_program<1>(kp, ws0, lds, bar, G, wid0 LOHI_PASS);
}

extern "C" void kernel_launch(void* const* d_in, const int* in_sizes, int n_in, void* d_out, int out_size, void* d_ws, size_t ws_size, hipStream_t stream) {
    static int grid = 0;
    if (grid == 0) {
        if (n_in != 21 || in_sizes[0] != NLAT * DM || out_size != NLAT * DM || ws_size < WS_END) {
            fprintf(stderr, "kernel_launch: unexpected shapes (n_in %d, in0 %d, out %d, ws %zu need %zu); nothing launched\n", n_in, n_in > 0 ? in_sizes[0] : -1, out_size, ws_size, (size_t)WS_END); grid = -1; return; }
        int dev = 0, cus = 0, per_cu = 0;
        if (hipGetDevice(&dev) != hipSuccess || hipDeviceGetAttribute(&cus, hipDeviceAttributeMultiprocessorCount, dev) != hipSuccess) { grid = -1; return; }
        if (hipFuncSetAttribute((const void*)fwd_kernel, hipFuncAttributeMaxDynamicSharedMemorySize, LDS_BYTES) != hipSuccess) { fprintf(stderr, "kernel_launch: hipFuncSetAttribute failed\n"); grid = -1; return; }
        if (hipOccupancyMaxActiveBlocksPerMultiprocessor(&per_cu, (const void*)fwd_kernel, NTHREADS, LDS_BYTES) != hipSuccess || per_cu < 1) { fprintf(stderr, "kernel_launch: occupancy query says %d\n", per_cu); }
        (void)hipGetLastError();
        grid = cus;
    }
    if (grid < 0) return;
    (void)hipMemsetAsync((char*)d_ws, 0, 16384, stream);
    Params p{};
    const float** pp = (const float**)&p;
    for (int i = 0; i < 21; ++i) pp[i] = (const float*)d_in[i];
    p.out = (float*)d_out; p.ws = (unsigned char*)d_ws;
#if MK_SINGLE
    p.ph_lo = 0; p.ph_hi = 2 * NPH;
    hipLaunchKernelGGL(fwd_kernel, dim3(grid), dim3(NTHREADS), LDS_BYTES, stream, p);
#else
    for (int k = 0; k < 2 * NPH; ++k) { p.ph_lo = k; p.ph_hi = k + 1; hipLaunchKernelGGL(fwd_kernel, dim3(grid), dim3(NTHREADS), LDS_BYTES, stream, p); }
#endif
}
```

```cpp
#include <hip/hip_runtime.h>
#include <stdint.h>
#include <stdio.h>
#include <type_traits>

#ifndef BF_LO
#define BF_LO 0
#define BF_HI 8
#endif
#ifndef MK_SINGLE
#define MK_SINGLE 1
#endif

#define LAS __attribute__((address_space(3)))
typedef unsigned short bf16_t;
typedef short bf16x8 __attribute__((ext_vector_type(8)));
typedef float f32x4 __attribute__((ext_vector_type(4)));
typedef float f32x2 __attribute__((ext_vector_type(2)));
typedef unsigned u32x4 __attribute__((ext_vector_type(4)));
typedef unsigned u32x2 __attribute__((ext_vector_type(2)));
typedef __bf16 bf2_t __attribute__((ext_vector_type(2)));
typedef int i32x4 __attribute__((ext_vector_type(4)));
typedef int i32x8 __attribute__((ext_vector_type(8)));
typedef float f32x16 __attribute__((ext_vector_type(16)));
typedef float f32x32 __attribute__((ext_vector_type(32)));
typedef unsigned u32x6 __attribute__((ext_vector_type(6)));
typedef __bf16 bf16x32_t __attribute__((ext_vector_type(32)));
typedef unsigned u32x16 __attribute__((ext_vector_type(16)));
typedef short s16x4 __attribute__((ext_vector_type(4)));
#ifndef FP6_INTERLEAVED
#define FP6_INTERLEAVED 1
#endif

constexpr int DM = 2048, NBATCH = 2, SEQ = 8192, CTXL = 256;
constexpr int NLAT = NBATCH * SEQ;
constexpr int NCTX = NBATCH * CTXL;
constexpr int MR = NLAT + NCTX;
constexpr int PROJ_W = 24608;
constexpr int NPROJ = 24576;
constexpr int NTHREADS = 512;
constexpr int LDS_BYTES = 163840;
constexpr int NPH = 11;
constexpr float EPSF = 1e-6f;

constexpr size_t SZ_A = (size_t)MR * 2048 * 2;
constexpr size_t WS_BAR = 0;
constexpr size_t WS_MOD = 16384;
constexpr size_t CTL_BYTES = 16384 + 2 * 3 * 12288 * 4;
constexpr size_t WS_TAB = 311296;
constexpr size_t WS_X = WS_TAB + 32768;
constexpr size_t WS_XN = WS_X + (size_t)MR * 2048 * 4;
constexpr size_t WS_Y = WS_XN + SZ_A;
constexpr size_t WS_XN8 = WS_Y;
constexpr size_t WS_PQ = WS_Y + SZ_A;
constexpr size_t WS_PK = WS_PQ + SZ_A / 2;
constexpr size_t WS_T8 = WS_PK + SZ_A / 2;
constexpr size_t WS_PV = WS_T8 + 0 * SZ_A;
constexpr size_t WS_PO = WS_T8 + 1 * SZ_A;
constexpr size_t WS_CQ = WS_T8 + 2 * SZ_A;
constexpr size_t WS_CK = WS_T8 + 3 * SZ_A;
constexpr size_t WS_CV = WS_T8 + 4 * SZ_A;
constexpr size_t WS_BB = WS_T8 + 5 * SZ_A;
constexpr size_t WS_BC = WS_T8 + 6 * SZ_A;
constexpr size_t WS_BX = WS_T8 + 7 * SZ_A;
constexpr size_t WS_GT = WS_T8 + 8 * SZ_A;
constexpr size_t WS_GATES = WS_GT + 3 * SZ_A;
constexpr size_t WS_WIN = WS_GATES + (size_t)MR * 32 * 4;
constexpr size_t WS_WINB = WS_WIN + (size_t)NPROJ * 2048;
constexpr size_t WS_WG = WS_WIN + (size_t)NPROJ * 2048 * 2;
constexpr size_t SZ_W = (size_t)2048 * 2048 * 2;
constexpr size_t WS_WA = WS_WG + 32 * 2048 * 2;
constexpr size_t WS_WB = WS_WA + SZ_W;
constexpr size_t WS_WC = WS_WB + SZ_W;
constexpr size_t WS_WO = WS_WC + SZ_W;
constexpr size_t WS_WQ = WS_WO + SZ_W;
constexpr size_t WS_KEYS = WS_WQ + SZ_W;
constexpr size_t WS_PU = WS_KEYS + 16 * 128 * 128 * 2;
constexpr size_t WS_PVW = WS_PU + (size_t)16384 * 2048 * 2;
constexpr size_t WS_SCAN = WS_PU + (size_t)16384 * 1024;
constexpr size_t WS_END = WS_PVW + (size_t)16384 * 2048 * 2;

struct Params {
    const float *x, *c, *ctx, *c_ctx, *w_ada, *b_ada, *norm_g, *w_in, *a_gate_b, *a_hnorm_g, *b_conv, *c_qk_g, *c_rpb,
        *w_a_out, *w_b_out, *w_c_out, *w_out, *peer_wq, *peer_keys, *peer_u, *peer_v;
    float* out; unsigned char* ws; int ph_lo, ph_hi;
};
#define CAS __attribute__((address_space(4)))
#define GAS __attribute__((address_space(1)))
typedef const CAS Params* KP;
__device__ __forceinline__ KP launder_p(KP q) { asm volatile("" : "+s"(q)); return q; }

__device__ __forceinline__ unsigned char* launder(unsigned char* q) { size_t z = 0; asm volatile("" : "+s"(z)); return q + z; }
__device__ __forceinline__ int tid_fresh(int wid0) { int t = wid0 * 64 + (int)__builtin_amdgcn_mbcnt_hi(~0u, __builtin_amdgcn_mbcnt_lo(~0u, 0u)); asm volatile("" : "+v"(t)); return t; }

__device__ __forceinline__ float bf2f(unsigned b) { return __uint_as_float(b << 16); }
__device__ __forceinline__ float bflo(unsigned w) { return __uint_as_float(w << 16); }
__device__ __forceinline__ float bfhi(unsigned w) { return __uint_as_float(w & 0xffff0000u); }
__device__ __forceinline__ unsigned pk2(float lo, float hi) { f32x2 v = {lo, hi}; bf2_t b = __builtin_convertvector(v, bf2_t); return __builtin_bit_cast(unsigned, b); }
__device__ __forceinline__ bf16_t f2bf(float f) { return (bf16_t)(pk2(f, 0.f) & 0xffffu); }
__device__ __forceinline__ f32x4 mfma16(bf16x8 a, bf16x8 b, f32x4 c) { return __builtin_amdgcn_mfma_f32_16x16x32_bf16(a, b, c, 0, 0, 0); }
__device__ __forceinline__ float dot2bf(unsigned a, unsigned b, float c) { return __builtin_amdgcn_fdot2_f32_bf16(__builtin_bit_cast(bf2_t, a), __builtin_bit_cast(bf2_t, b), c, false); }
#define LDS_BARRIER() do { asm volatile("s_waitcnt lgkmcnt(0)" ::: "memory"); __builtin_amdgcn_s_barrier(); asm volatile("" ::: "memory"); } while (0)
__device__ __forceinline__ float rlane(float v, int l) { return __uint_as_float((unsigned)__builtin_amdgcn_readlane((int)__float_as_uint(v), l)); }
__device__ __forceinline__ float wave_sum(float v) {
#pragma unroll
    for (int o = 32; o >= 1; o >>= 1) v += __shfl_xor(v, o);
    return v;
}
__device__ __forceinline__ float sigmoidf_(float v) { return __builtin_amdgcn_rcpf(1.0f + __expf(-v)); }
__device__ __forceinline__ float logsigmoidf_(float v) { return fminf(v, 0.f) - log1pf(__expf(-fabsf(v))); }

#define XB_TMO      128
#define XB_XCNT(j)  (256  + 64 * (j))
#define XB_XSUB(j)  (1280 + 64 * (j))
#define XB_XGEN(j)  (2304 + 64 * (j))
#define XB_TOP      3328
#define XB_TOPGEN   3392
#define XCD_BAR_WORDS 3456
#define XB_SPIN_CAP (1u << 22)
__device__ __forceinline__ unsigned xb_ld(unsigned* p)              { return __hip_atomic_load(p, __ATOMIC_RELAXED, __HIP_MEMORY_SCOPE_AGENT); }
__device__ __forceinline__ unsigned xb_add(unsigned* p, unsigned v) { return __hip_atomic_fetch_add(p, v, __ATOMIC_RELAXED, __HIP_MEMORY_SCOPE_AGENT); }
__device__ __forceinline__ unsigned xb_xcc_id() { return (unsigned)__builtin_amdgcn_s_getreg((3 << 11) | 20) & 0xFu; }
#define XB_SPIN(cond, bar) do { unsigned _sp = 0; while (cond) { __builtin_amdgcn_s_sleep(1); \
    if ((++_sp & 255u) == 0u) { if (xb_ld(&(bar)[XB_TMO])) break; if (_sp > XB_SPIN_CAP) { atomicAdd(&(bar)[XB_TMO], 1u); break; } } } } while (0)
struct XcdBarrier { unsigned* bar; unsigned x; volatile LAS unsigned* st; };
__device__ __forceinline__ XcdBarrier xcd_barrier_post(unsigned* bar, volatile LAS unsigned* st) {
    XcdBarrier b; b.bar = bar; b.x = xb_xcc_id(); b.st = st;
    if (threadIdx.x == 0) (void)xb_add(&bar[XB_XCNT(b.x)], 1u);
    return b;
}
__device__ __forceinline__ void xcd_barrier_complete(unsigned* bar, unsigned x, unsigned& nloc, unsigned& nx) {
    const unsigned G = gridDim.x * gridDim.y * gridDim.z;
    unsigned sum, cnt, mine, sp = 0u;
    for (;;) {
        sum = 0u; cnt = 0u; mine = 0u;
#pragma unroll
        for (unsigned j = 0; j < 16; ++j) { const unsigned c = xb_ld(&bar[XB_XCNT(j)]); sum += c; cnt += (c > 0u) ? 1u : 0u; mine = (j == x) ? c : mine; }
        if (sum == G) break;
        __builtin_amdgcn_s_sleep(1);
        if ((++sp & 255u) == 0u) { if (xb_ld(&bar[XB_TMO])) break; if (sp > XB_SPIN_CAP) { atomicAdd(&bar[XB_TMO], 1u); break; } }
    }
    nloc = mine > 0u ? mine : 1u; nx = cnt > 0u ? cnt : 1u;
}
__device__ __forceinline__ void xcd_barrier(const XcdBarrier& b) {
    asm volatile("s_waitcnt vmcnt(0)" ::: "memory");
    __syncthreads();
    if (threadIdx.x == 0) {
        unsigned* bar = b.bar;
        __builtin_amdgcn_s_waitcnt(0);
        unsigned nloc = b.st[0], nx = b.st[1];
        if (nloc == 0u) { xcd_barrier_complete(bar, b.x, nloc, nx); b.st[0] = nloc; b.st[1] = nx; }
        const unsigned old = xb_add(&bar[XB_XSUB(b.x)], 1u);
        const unsigned gen = old / nloc;
        if (old + 1u == (gen + 1u) * nloc) {
            __builtin_amdgcn_fence(__ATOMIC_RELEASE, "agent");
            asm volatile("s_waitcnt vmcnt(0)" ::: "memory");
            const unsigned og = xb_add(&bar[XB_TOP], 1u);
            const unsigned tg = og / nx;
            if (og + 1u == (tg + 1u) * nx) xb_add(&bar[XB_TOPGEN], 1u);
            else XB_SPIN(xb_ld(&bar[XB_TOPGEN]) == tg, bar);
            __builtin_amdgcn_fence(__ATOMIC_ACQUIRE, "agent");
            xb_add(&bar[XB_XGEN(b.x)], 1u);
            asm volatile("s_waitcnt vmcnt(0)" ::: "memory");
        } else {
            XB_SPIN(xb_ld(&bar[XB_XGEN(b.x)]) == gen, bar);
            __builtin_amdgcn_fence(__ATOMIC_ACQUIRE, "agent");
            asm volatile("s_waitcnt vmcnt(0)" ::: "memory");
        }
    }
    __syncthreads();
}

namespace pg8 {
constexpr int BM = 256, BK = 64, HALF = 128, HTB = HALF * BK * 2, STAGE_BYTES = 8 * HTB, NXCD = 8, WGM = 8;
__host__ __device__ __forceinline__ int lds_byte(int r, int c) { const int st = (r >> 4) * 2 + (c >> 5), rr = r & 15, cc = c & 31, ob = rr * 64 + cc * 2; return st * 1024 + (ob ^ (((ob >> 9) & 1) << 5)); }
__host__ __device__ __forceinline__ void stage_rc(int b, int& R, int& C) { const int st = b / 1024, sb = b % 1024, swz = sb ^ (((sb >> 9) & 1) << 5); R = (st >> 1) * 16 + swz / 64; C = (st & 1) * 32 + (swz % 64) / 2; }
__host__ __device__ __forceinline__ int perm32(int rho) { const int n = rho >> 4, i = rho & 15; return 8 * (i >> 2) + 4 * n + (i & 3); }

struct Unit { int pm, pn, br; const char* A; const char* B; };

__device__ __forceinline__ bool tile_of(int L, int nM, int nN, int& pm, int& pn) {
    const int nwg = nM * nN; if (L >= nwg) return false;
    int wgid = L; { const int q = nwg / NXCD, r = nwg % NXCD, xcd = wgid % NXCD, off = wgid / NXCD; wgid = (xcd < r ? xcd * (q + 1) : r * (q + 1) + (xcd - r) * q) + off; }
    const int nig = WGM * nN, gid = wgid / nig, fm = gid * WGM, gsz = (nM - fm) < WGM ? (nM - fm) : WGM;
    pm = fm + ((wgid % nig) % gsz); pn = (wgid % nig) / gsz; return true;
}
struct PlainOrder {
    const char* A; const char* Bt; int nM, nN, G, c; size_t tstep; int pn_base, skip_from, skip_cnt, skip2_from, skip2_cnt, b_row0, b_compact, short_rounds, n_long;
    __device__ __forceinline__ void init(const void* A_, const void* Bt_, int M, int N, int K, int G_, int c_) { A = (const char*)A_; Bt = (const char*)Bt_; nM = M / BM; nN = N / BM; G = G_; c = c_; tstep = (size_t)BM * K * 2;
        pn_base = 0; skip_from = 1 << 30; skip_cnt = 0; skip2_from = 1 << 30; skip2_cnt = 0; b_row0 = 0; b_compact = 0; short_rounds = 1 << 30; n_long = 0; }
    __device__ __forceinline__ bool next(int i, Unit& u) const {
        int L = i * G + c;
        if (i >= short_rounds) { if (c >= n_long) return false; const int per = (nM * nN - short_rounds * G) / n_long, j = i - short_rounds; if (j >= per) return false; L = short_rounds * G + per * c + j; }
        int pm, pn; if (!tile_of(L, nM, nN, pm, pn)) return false;
        const int pnc = pn;
        pn += pn_base; if (pn >= skip_from) pn += skip_cnt; if (pn >= skip2_from) pn += skip2_cnt;
        u.pm = pm; u.pn = pn; u.br = 0; u.A = A + (size_t)pm * tstep; u.B = Bt + (size_t)(b_compact ? pnc : pn - b_row0) * tstep; return true;
    }
};
struct BranchOrder {
    const char* T8; const char* WA; int nM, nN, G, c; size_t tstep;
    __device__ __forceinline__ bool next(int i, Unit& u) const {
        const int tl = i / 3, br = i - 3 * tl; int pm, pn; if (!tile_of(tl * G + c, nM, nN, pm, pn)) return false;
        u.pm = pm; u.pn = pn; u.br = br;
        const int ti = 1 + 4 * (br == 1) + (br == 2);
        u.A = T8 + (size_t)ti * SZ_A + (size_t)pm * tstep; u.B = WA + (size_t)br * SZ_W + (size_t)pn * tstep; return true;
    }
};

template <class Epi, class Sched, bool FP8 = false>
__device__ __forceinline__ void gemm_phase(LAS unsigned char* lds, const int K, const Sched& S, const Epi& E, int wid0) {
    const int tid = tid_fresh(wid0), wid = __builtin_amdgcn_readfirstlane(tid >> 6), lane = tid & 63, wr = wid >> 2, wc = wid & 3, fr = lane & 15, fq = lane >> 4;
    const int nt = K / BK;
    unsigned voffA[2], voffB[2];
#pragma unroll
    for (int i = 0; i < 2; ++i) { int R, C; stage_rc(tid * 16 + i * 8192, R, C); const int Rb = Epi::PERM ? ((R & ~31) + perm32(R & 31)) : R;
        voffA[i] = (unsigned)(R * K + C) * 2u; voffB[i] = (unsigned)(Rb * K + C) * 2u; }
    const size_t kstep = (size_t)(BK * 2);
    const size_t hstep = (size_t)HALF * K * 2;
    const unsigned ldsw = (unsigned)wid * 1024u;
    const int aoff = lds_byte(wr * 64 + fr, fq * 8), boff = lds_byte(wc * 32 + fr, fq * 8);
#define PG8_SA(b, h) (((b) * 2 + (h)) * HTB)
#define PG8_SB(b, h) ((4 + (b) * 2 + (h)) * HTB)
#define PG8_STAGE(bufoff, gbase, voff) do { _Pragma("unroll") for (int _i = 0; _i < 2; ++_i) \
        __builtin_amdgcn_global_load_lds((const unsigned*)((const char*)(gbase) + (voff)[_i]), (LAS unsigned*)(lds + (bufoff) + ldsw + _i * 8192), 16, 0, 0); } while (0)
#define PG8_LD1(dstv, addr) do { if constexpr (FP8) { const i32x4 _lo = *(const LAS i32x4*)(lds + (addr)), _hi = *(const LAS i32x4*)(lds + (addr) + 1024); dstv[0] = __builtin_shufflevector(_lo, _hi, 0, 1, 2, 3, 4, 5, 6, 7); } \
        else { _Pragma("unroll") for (int k = 0; k < 2; ++k) dstv[k] = *(const LAS bf16x8*)(lds + (addr) + k * 1024); } } while (0)
#define PG8_LDA(dst, b, h) do { _Pragma("unroll") for (int m = 0; m < 4; ++m) PG8_LD1(dst[m], PG8_SA(b, h) + aoff + m * 2048); } while (0)
#define PG8_LDB(dst, b, h) do { _Pragma("unroll") for (int n = 0; n < 2; ++n) PG8_LD1(dst[n], PG8_SB(b, h) + boff + n * 2048); } while (0)
#define PG8_MMA(ai, bj, At, Bt) do { __builtin_amdgcn_s_setprio(1); _Pragma("unroll") for (int m = 0; m < 4; ++m) _Pragma("unroll") for (int n = 0; n < 2; ++n) { \
        if constexpr (FP8) asm volatile("v_mfma_scale_f32_16x16x128_f8f6f4 %0, %1, %2, %0, %3, %4 op_sel_hi:[0,0,0]" : "+v"(acc[ai][bj][m][n]) : "v"(Bt[n][0]), "v"(At[m][0]), "v"(sclW), "v"(sclX)); \
        else { _Pragma("unroll") for (int k = 0; k < 2; ++k) acc[ai][bj][m][n] = __builtin_amdgcn_mfma_f32_16x16x32_bf16(Bt[n][k], At[m][k], acc[ai][bj][m][n], 0, 0, 0); } } \
        __builtin_amdgcn_s_setprio(0); } while (0)
#define PG8_WAIT_V(n) asm volatile("s_waitcnt vmcnt(" #n ")" ::: "memory")
#define PG8_WAIT_L(n) asm volatile("s_waitcnt lgkmcnt(" #n ")" ::: "memory")
#define PG8_BAR __builtin_amdgcn_s_barrier()
#define PG8_SCHED __builtin_amdgcn_sched_barrier(0)
    Unit cur, nxt; int ui = 0;
    if (!S.next(0, cur)) return;
    const int sclW = 0x75757575, sclX = 0x7F7F7F7F;
    f32x4 acc[2][2][4][2];
#pragma unroll
    for (int a = 0; a < 2; ++a)
#pragma unroll
        for (int b = 0; b < 2; ++b)
#pragma unroll
            for (int m = 0; m < 4; ++m)
#pragma unroll
                for (int n = 0; n < 2; ++n) acc[a][b][m][n] = (f32x4){0.f, 0.f, 0.f, 0.f};
    typedef typename std::conditional<FP8, i32x8, bf16x8>::type frag_t;
    frag_t At[4][FP8 ? 1 : 2], B0[2][FP8 ? 1 : 2], B1[2][FP8 ? 1 : 2];
    const char* cA = cur.A; const char* cB = cur.B;
    PG8_STAGE(PG8_SB(0, 0), cB, voffB); PG8_STAGE(PG8_SA(0, 0), cA, voffA); PG8_STAGE(PG8_SB(0, 1), cB + hstep, voffB); PG8_STAGE(PG8_SA(0, 1), cA + hstep, voffA);
    if (wr == 1) PG8_BAR;
    PG8_WAIT_V(4); PG8_BAR;
    PG8_STAGE(PG8_SB(1, 0), cB + kstep, voffB); PG8_STAGE(PG8_SA(1, 0), cA + kstep, voffA); PG8_STAGE(PG8_SB(1, 1), cB + hstep + kstep, voffB);
    PG8_WAIT_V(6); PG8_BAR;
    for (;;) {
        const bool has_next = S.next(ui + 1, nxt);
        const char* nA = has_next ? nxt.A : cA; const char* nB = has_next ? nxt.B : cB;
        for (int t = 0; t < nt; t += 2) {
            const bool last = (t == nt - 2);
            const char* a1 = cA + (size_t)(t + 1) * kstep;
            const char* a2 = last ? nA : cA + (size_t)(t + 2) * kstep; const char* b2 = last ? nB : cB + (size_t)(t + 2) * kstep;
            const char* a3 = a2 + kstep; const char* b3 = b2 + kstep;
            PG8_LDB(B0, 0, 0); PG8_SCHED; PG8_LDA(At, 0, 0); PG8_STAGE(PG8_SA(1, 1), a1 + hstep, voffA);
            PG8_WAIT_L(8); PG8_BAR; PG8_WAIT_L(0); PG8_MMA(0, 0, At, B0); PG8_BAR; PG8_SCHED;
            PG8_LDB(B1, 0, 1); PG8_STAGE(PG8_SB(0, 0), b2, voffB);
            PG8_BAR; PG8_WAIT_L(0); PG8_MMA(0, 1, At, B1); PG8_BAR;
            PG8_LDA(At, 0, 1); PG8_STAGE(PG8_SA(0, 0), a2, voffA);
            PG8_BAR; PG8_WAIT_L(0); PG8_MMA(1, 0, At, B0); PG8_BAR; PG8_SCHED;
            PG8_STAGE(PG8_SB(0, 1), b2 + hstep, voffB);
            PG8_WAIT_V(6); PG8_BAR; PG8_MMA(1, 1, At, B1); PG8_BAR;
            PG8_LDB(B0, 1, 0); PG8_SCHED; PG8_LDA(At, 1, 0); PG8_STAGE(PG8_SA(0, 1), a2 + hstep, voffA);
            PG8_WAIT_L(8); PG8_BAR; PG8_WAIT_L(0); PG8_MMA(0, 0, At, B0); PG8_BAR; PG8_SCHED;
            PG8_LDB(B1, 1, 1); PG8_STAGE(PG8_SB(1, 0), b3, voffB);
            PG8_BAR; PG8_WAIT_L(0); PG8_MMA(0, 1, At, B1); PG8_BAR;
            PG8_LDA(At, 1, 1); PG8_STAGE(PG8_SA(1, 0), a3, voffA);
            PG8_BAR; PG8_WAIT_L(0); PG8_MMA(1, 0, At, B0); PG8_BAR; PG8_SCHED;
            PG8_STAGE(PG8_SB(1, 1), b3 + hstep, voffB);
            PG8_WAIT_V(6); PG8_BAR; PG8_MMA(1, 1, At, B1); PG8_BAR;
        }
        if constexpr (FP8) { asm volatile("s_nop 15\n\ts_nop 15\n\ts_nop 15" ::: "memory"); }
        E(acc, cur, wr, wc, fr, fq);
        if (!has_next) break;
#pragma unroll
        for (int a = 0; a < 2; ++a)
#pragma unroll
            for (int b = 0; b < 2; ++b)
#pragma unroll
                for (int m = 0; m < 4; ++m)
#pragma unroll
                    for (int n = 0; n < 2; ++n) acc[a][b][m][n] = (f32x4){0.f, 0.f, 0.f, 0.f};
        cur = nxt; cA = nA; cB = nB; ++ui;
    }
    PG8_WAIT_V(0);
    if (wr == 0) PG8_BAR;
    PG8_BAR;
#undef PG8_SA
#undef PG8_SB
#undef PG8_STAGE
#undef PG8_LD1
#undef PG8_LDA
#undef PG8_LDB
#undef PG8_MMA
#undef PG8_WAIT_V
#undef PG8_WAIT_L
#undef PG8_BAR
#undef PG8_SCHED
}

struct EpiProj {
    static constexpr bool PERM = true;
    unsigned char* ws;
    __device__ __forceinline__ void operator()(const f32x4 (&acc)[2][2][4][2], const Unit& u, int wr, int wc, int fr, int fq) const {
        const int pn = u.pn; size_t off; int ld, c0;
        if (pn < 4) { off = WS_PQ; ld = 1024; c0 = pn * 256; }
        else if (pn < 8) { off = WS_PK; ld = 1024; c0 = (pn - 4) * 256; }
        else if (pn < 72) { const int t = (pn - 8) >> 3; off = WS_T8 + (size_t)t * SZ_A; ld = 2048; c0 = ((pn - 8) & 7) * 256; }
        else {
            GAS unsigned char* gp = (GAS unsigned char*)ws + WS_GT + (size_t)(u.pm * BM + wr * 64 + fr) * 6144 + (pn - 72) * 256 + wc * 32 + 8 * fq;
#pragma unroll
            for (int ai = 0; ai < 2; ++ai) {
#pragma unroll
                for (int m = 0; m < 4; ++m) {
                    asm volatile("" : "+v"(gp));
#pragma unroll
                    for (int bj = 0; bj < 2; ++bj) { const f32x4 v0 = acc[ai][bj][m][0], v1 = acc[ai][bj][m][1];
                        unsigned q[8];
#pragma unroll
                        for (int j = 0; j < 4; ++j) { q[j] = (unsigned)(sigmoidf_(v0[j]) * 255.0f + 0.5f); q[4 + j] = (unsigned)(sigmoidf_(v1[j]) * 255.0f + 0.5f); }
                        u32x2 w; w.x = q[0] | (q[1] << 8) | (q[2] << 16) | (q[3] << 24); w.y = q[4] | (q[5] << 8) | (q[6] << 16) | (q[7] << 24);
                        *(GAS u32x2*)(gp + bj * HALF) = w; }
                    gp += (size_t)16 * 6144;
                }
                gp += (size_t)64 * 6144;
            }
            return;
        }
        GAS bf16_t* rp = (GAS bf16_t*)(ws + off) + (size_t)(u.pm * BM + wr * 64 + fr) * ld + c0 + wc * 32 + 8 * fq;
        const size_t step = (size_t)16 * ld;
#pragma unroll
        for (int ai = 0; ai < 2; ++ai) {
#pragma unroll
            for (int m = 0; m < 4; ++m) {
                asm volatile("" : "+v"(rp));
#pragma unroll
                for (int bj = 0; bj < 2; ++bj) { const f32x4 v0 = acc[ai][bj][m][0], v1 = acc[ai][bj][m][1];
                    u32x4 w; w.x = pk2(v0[0], v0[1]); w.y = pk2(v0[2], v0[3]); w.z = pk2(v1[0], v1[1]); w.w = pk2(v1[2], v1[3]);
                    *(GAS u32x4*)(rp + bj * HALF) = w; }
                rp += step;
            }
            rp += 4 * step;
        }
    }
};
struct EpiBf {
    static constexpr bool PERM = true;
    bf16_t* O; int ld;
    __device__ __forceinline__ void operator()(const f32x4 (&acc)[2][2][4][2], const Unit& u, int wr, int wc, int fr, int fq) const {
        const int row0 = u.pm * BM + wr * 64 + fr, col0 = u.pn * BM + wc * 32 + 8 * fq;
#pragma unroll
        for (int ai = 0; ai < 2; ++ai)
#pragma unroll
            for (int m = 0; m < 4; ++m) { bf16_t* rowp = O + (size_t)(row0 + ai * HALF + m * 16) * ld + col0;
#pragma unroll
                for (int bj = 0; bj < 2; ++bj) { const f32x4 v0 = acc[ai][bj][m][0], v1 = acc[ai][bj][m][1];
                    u32x4 w; w.x = pk2(v0[0], v0[1]); w.y = pk2(v0[2], v0[3]); w.z = pk2(v1[0], v1[1]); w.w = pk2(v1[2], v1[3]);
                    *(u32x4*)(rowp + bj * HALF) = w; } }
    }
};
__device__ __forceinline__ float gq8(unsigned w, int i) { return (float)((w >> (8 * i)) & 0xffu); }
struct EpiMerge {
    static constexpr bool PERM = true;
    bf16_t* Y; const unsigned char* GT;
    __device__ __forceinline__ void operator()(const f32x4 (&acc)[2][2][4][2], const Unit& u, int wr, int wc, int fr, int fq) const {
        const int row0 = u.pm * BM + wr * 64 + fr, col0 = u.pn * BM + wc * 32 + 8 * fq;
        const bool addy = u.br != 0;
#pragma unroll
        for (int ai = 0; ai < 2; ++ai) {
            u32x2 g[4][2]; u32x4 y[4][2];
#pragma unroll
            for (int m = 0; m < 4; ++m)
#pragma unroll
                for (int bj = 0; bj < 2; ++bj) { const size_t r = (size_t)(row0 + ai * HALF + m * 16);
                    g[m][bj] = *(const u32x2*)(GT + r * 6144 + (size_t)u.br * 2048 + col0 + bj * HALF); }
            if (addy) {
#pragma unroll
                for (int m = 0; m < 4; ++m)
#pragma unroll
                    for (int bj = 0; bj < 2; ++bj) { const size_t r = (size_t)(row0 + ai * HALF + m * 16); y[m][bj] = *(const u32x4*)(Y + r * 2048 + col0 + bj * HALF); }
            } else {
#pragma unroll
                for (int m = 0; m < 4; ++m)
#pragma unroll
                    for (int bj = 0; bj < 2; ++bj) y[m][bj] = (u32x4){0u, 0u, 0u, 0u};
            }
#pragma unroll
            for (int m = 0; m < 4; ++m)
#pragma unroll
                for (int bj = 0; bj < 2; ++bj) { const size_t r = (size_t)(row0 + ai * HALF + m * 16);
                    const f32x4 v0 = acc[ai][bj][m][0] * (1.0f / 255.0f), v1 = acc[ai][bj][m][1] * (1.0f / 255.0f); const u32x2 gg = g[m][bj]; const u32x4 yy = y[m][bj];
                    float o[8];
                    o[0] = gq8(gg.x, 0) * v0[0] + bflo(yy.x); o[1] = gq8(gg.x, 1) * v0[1] + bfhi(yy.x); o[2] = gq8(gg.x, 2) * v0[2] + bflo(yy.y); o[3] = gq8(gg.x, 3) * v0[3] + bfhi(yy.y);
                    o[4] = gq8(gg.y, 0) * v1[0] + bflo(yy.z); o[5] = gq8(gg.y, 1) * v1[1] + bfhi(yy.z); o[6] = gq8(gg.y, 2) * v1[2] + bflo(yy.w); o[7] = gq8(gg.y, 3) * v1[3] + bfhi(yy.w);
                    u32x4 w; w.x = pk2(o[0], o[1]); w.y = pk2(o[2], o[3]); w.z = pk2(o[4], o[5]); w.w = pk2(o[6], o[7]);
                    *(u32x4*)(Y + r * 2048 + col0 + bj * HALF) = w; }
        }
    }
};
template <bool XF32> struct EpiRes {
    static constexpr bool PERM = true;
    bf16_t* X; const float* Xf; const float* mod;
    __device__ __forceinline__ void operator()(const f32x4 (&acc)[2][2][4][2], const Unit& u, int wr, int wc, int fr, int fq) const {
        const int row0 = u.pm * BM + wr * 64 + fr, col0 = u.pn * BM + wc * 32 + 8 * fq;
        const int which = (u.pm < 32) ? 0 : (u.pm < 64 ? 1 : 2);
        const float* mg = mod + (size_t)which * 12288 + 2 * 2048 + col0;
        f32x4 gv[2][2];
#pragma unroll
        for (int bj = 0; bj < 2; ++bj)
#pragma unroll
            for (int n = 0; n < 2; ++n) gv[bj][n] = *(const f32x4*)(mg + bj * HALF + n * 4);
#pragma unroll
        for (int ai = 0; ai < 2; ++ai) {
            if constexpr (XF32) {
#pragma unroll
              for (int mh = 0; mh < 2; ++mh) {
                f32x4 xin[2][2][2];
#pragma unroll
                for (int m = 0; m < 2; ++m)
#pragma unroll
                    for (int bj = 0; bj < 2; ++bj)
#pragma unroll
                        for (int n = 0; n < 2; ++n) xin[m][bj][n] = *(const f32x4*)(Xf + (size_t)(row0 + ai * HALF + (2 * mh + m) * 16) * 2048 + col0 + bj * HALF + n * 4);
#pragma unroll
                for (int m = 0; m < 2; ++m)
#pragma unroll
                    for (int bj = 0; bj < 2; ++bj) {
                        const f32x4 o0 = xin[m][bj][0] + gv[bj][0] * acc[ai][bj][2 * mh + m][0], o1 = xin[m][bj][1] + gv[bj][1] * acc[ai][bj][2 * mh + m][1];
                        u32x4 ow; ow.x = pk2(o0[0], o0[1]); ow.y = pk2(o0[2], o0[3]); ow.z = pk2(o1[0], o1[1]); ow.w = pk2(o1[2], o1[3]);
                        *(u32x4*)(X + (size_t)(row0 + ai * HALF + (2 * mh + m) * 16) * 2048 + col0 + bj * HALF) = ow; }
              }
            } else {
                u32x4 xb[4][2];
#pragma unroll
                for (int m = 0; m < 4; ++m)
#pragma unroll
                    for (int bj = 0; bj < 2; ++bj) xb[m][bj] = *(const u32x4*)(X + (size_t)(row0 + ai * HALF + m * 16) * 2048 + col0 + bj * HALF);
#pragma unroll
                for (int m = 0; m < 4; ++m)
#pragma unroll
                    for (int bj = 0; bj < 2; ++bj) { const u32x4 xw = xb[m][bj]; const f32x4 a0 = acc[ai][bj][m][0], a1 = acc[ai][bj][m][1], g0 = gv[bj][0], g1 = gv[bj][1];
                        u32x4 ow; ow.x = pk2(bflo(xw.x) + g0[0] * a0[0], bfhi(xw.x) + g0[1] * a0[1]); ow.y = pk2(bflo(xw.y) + g0[2] * a0[2], bfhi(xw.y) + g0[3] * a0[3]);
                        ow.z = pk2(bflo(xw.z) + g1[0] * a1[0], bfhi(xw.z) + g1[1] * a1[1]); ow.w = pk2(bflo(xw.w) + g1[2] * a1[2], bfhi(xw.w) + g1[3] * a1[3]);
                        *(u32x4*)(X + (size_t)(row0 + ai * HALF + m * 16) * 2048 + col0 + bj * HALF) = ow; }
            }
        }
    }
};
}

__device__ __forceinline__ int proj_src_col(int n) {
    if (n < 1024) return 7200 + n;
    if (n < 2048) return n - 1024;
    if (n < 4096) return 1024 + (n - 2048);
    if (n < 6144) return 8224 + (n - 4096);
    if (n < 8192) return 16416 + (n - 6144);
    if (n < 10240) return 3104 + (n - 8192);
    if (n < 12288) return 5152 + (n - 10240);
    if (n < 14336) return 10272 + (n - 12288);
    if (n < 16384) return 12320 + (n - 14336);
    if (n < 18432) return 14368 + (n - 16384);
    return 18464 + (n - 18432);
}
__device__ __forceinline__ void phase_w(KP p, int l, LAS unsigned char* lds, int wid0) {
    const int tid = tid_fresh(wid0), G = gridDim.x, bid = blockIdx.x;
    unsigned char* ws = launder(p->ws);
    {
        LAS float* tile = (LAS float*)lds;
        const int NT_IN = NPROJ / 64;
        const int total = (NT_IN + 5 * 32) * 8;
        for (int t = bid; t < total; t += G) {
            const int ntile = t >> 3, kt = t & 7, k0 = kt * 256;
            const float* src; int ld; bf16_t* dst; float scale = 1.0f; int n0;
            bool to8 = false;
            if (ntile < NT_IN) { n0 = ntile * 64; src = p->w_in + (size_t)l * 2048 * PROJ_W + proj_src_col(n0); ld = PROJ_W;
                const int pnl = n0 >> 8; const bool isb = (pnl >= BF_LO && pnl < BF_HI) || (pnl >= 48 && pnl < 72);
                if (isb) { const int cpn = pnl < 48 ? pnl - BF_LO : pnl - 48 + (BF_HI - BF_LO); dst = (bf16_t*)(ws + WS_WINB) + (size_t)(cpn * 256 + (n0 & 255)) * 2048; if (n0 < 1024) scale = 0.08838834764831845f; }
                else { to8 = true; dst = (bf16_t*)(ws + WS_WIN); scale = (n0 < 1024) ? 1024.0f * 0.08838834764831845f : 1024.0f; } }
            else { const int mi = (ntile - NT_IN) >> 5; n0 = ((ntile - NT_IN) & 31) * 64;
                const float* m5 = mi == 0 ? p->w_a_out : mi == 1 ? p->w_b_out : mi == 2 ? p->w_c_out : mi == 3 ? p->w_out : p->peer_wq;
                src = m5 + (size_t)l * 2048 * 2048 + n0; ld = 2048;
                dst = (bf16_t*)(ws + WS_WA + (size_t)mi * SZ_W) + (size_t)n0 * 2048; }
            { const int kk = tid >> 4, n4 = (tid & 15) * 4;
              f32x4 v[8];
#pragma unroll
              for (int h = 0; h < 8; ++h) v[h] = *(const f32x4*)(src + (size_t)(k0 + kk + 32 * h) * ld + n4);
#pragma unroll
              for (int h = 0; h < 8; ++h) { LAS float* tp = tile + (kk + 32 * h) * 65 + n4; tp[0] = v[h][0]; tp[1] = v[h][1]; tp[2] = v[h][2]; tp[3] = v[h][3]; } }
            __syncthreads();
            { const int n = tid >> 3, kq = (tid & 7) * 8;
#pragma unroll
              for (int sub = 0; sub < 4; ++sub) { const int k8 = sub * 64 + kq; float v[8];
#pragma unroll
                  for (int j = 0; j < 8; ++j) v[j] = tile[(k8 + j) * 65 + n] * scale;
                  if (to8) {
#pragma unroll
                      for (int j = 0; j < 8; ++j) v[j] = fminf(fmaxf(v[j], -448.f), 448.f);
                      int d0 = 0, d1 = 0; d0 = __builtin_amdgcn_cvt_pk_fp8_f32(v[0], v[1], d0, false); d0 = __builtin_amdgcn_cvt_pk_fp8_f32(v[2], v[3], d0, true);
                      d1 = __builtin_amdgcn_cvt_pk_fp8_f32(v[4], v[5], d1, false); d1 = __builtin_amdgcn_cvt_pk_fp8_f32(v[6], v[7], d1, true);
                      u32x2 w8; w8.x = (unsigned)d0; w8.y = (unsigned)d1; *(u32x2*)((unsigned char*)dst + (size_t)(n0 + n) * 2048 + k0 + k8) = w8; }
                  else { u32x4 w; w.x = pk2(v[0], v[1]); w.y = pk2(v[2], v[3]); w.z = pk2(v[4], v[5]); w.w = pk2(v[6], v[7]);
                      *(u32x4*)(dst + (size_t)n * 2048 + k0 + k8) = w; } } }
            __syncthreads();
        }
    }
    const size_t gtid = (size_t)bid * NTHREADS + tid, gthreads = (size_t)G * NTHREADS;
    for (size_t i = gtid; i < 32 * 2048; i += gthreads) { const int n = (int)(i >> 11), k = (int)(i & 2047);
        ((bf16_t*)(ws + WS_WG))[i] = f2bf(p->w_in[(size_t)l * 2048 * PROJ_W + (size_t)k * PROJ_W + 3072 + n]); }
    {
        const float* su = p->peer_u + (size_t)l * 16384 * 2048; const float* sv = p->peer_v + (size_t)l * 16384 * 2048;
        unsigned char* du = ws + WS_PU; unsigned char* dv = ws + WS_PVW;
        const size_t n32 = (size_t)16384 * 2048 / 32;
        for (size_t i = gtid; i < n32; i += gthreads) {
#pragma unroll
            for (int t = 0; t < 2; ++t) {
                const float* sp = (t ? sv : su) + i * 32; const float sc = t ? 4.0f : 64.0f;
                u32x4 wv;
#pragma unroll
                for (int q = 0; q < 4; ++q) { const f32x4 a = *(const f32x4*)(sp + q * 8), b = *(const f32x4*)(sp + q * 8 + 4);
                    unsigned d = 0;
                    d = __builtin_amdgcn_cvt_scalef32_pk_fp4_f32(d, a[0] * sc, a[1] * sc, 1.0f, 0); d = __builtin_amdgcn_cvt_scalef32_pk_fp4_f32(d, a[2] * sc, a[3] * sc, 1.0f, 1);
                    d = __builtin_amdgcn_cvt_scalef32_pk_fp4_f32(d, b[0] * sc, b[1] * sc, 1.0f, 2); d = __builtin_amdgcn_cvt_scalef32_pk_fp4_f32(d, b[2] * sc, b[3] * sc, 1.0f, 3);
                    wv[q] = d; }
                *(u32x4*)((t ? dv : du) + i * 16) = wv;
            }
        }
        const float* sk = p->peer_keys + (size_t)l * 16 * 128 * 128; bf16_t* dk = (bf16_t*)(ws + WS_KEYS);
        for (size_t i = gtid; i < (size_t)16 * 128 * 128; i += gthreads) dk[i] = f2bf(sk[i]);
    }
    {
        float* mod = (float*)(ws + WS_MOD) + (size_t)l * 3 * 12288;
        const float* wa = p->w_ada + (size_t)l * 2048 * 12288; const float* ba = p->b_ada + (size_t)l * 12288;
        LAS float* part = (LAS float*)(lds + 69632);
        const int col = tid & 63, ks = tid >> 6;
        for (int t = bid; t < 256; t += G) {
            const int n = t * 48 + col;
            float a0 = 0.f, a1 = 0.f, a2 = 0.f;
            if (col < 48) {
#pragma unroll 8
                for (int k = ks * 256; k < ks * 256 + 256; ++k) {
                    const float w = wa[(size_t)k * 12288 + n];
                    const float c0 = p->c[k], c1 = p->c[2048 + k], c2 = p->c_ctx[k];
                    a0 += c0 * sigmoidf_(c0) * w; a1 += c1 * sigmoidf_(c1) * w; a2 += c2 * sigmoidf_(c2) * w;
                }
                part[(ks * 3 + 0) * 48 + col] = a0; part[(ks * 3 + 1) * 48 + col] = a1; part[(ks * 3 + 2) * 48 + col] = a2;
            }
            __syncthreads();
            if (tid < 144) { const int which = tid / 48, cc = tid - which * 48; float sacc = ba[t * 48 + cc];
#pragma unroll
                for (int q = 0; q < 8; ++q) sacc += part[(q * 3 + which) * 48 + cc];
                mod[(size_t)which * 12288 + t * 48 + cc] = sacc; }
            __syncthreads();
        }
    }
    if (l == 0) {
        float* tab = (float*)(ws + WS_TAB);
        for (size_t i = gtid; i < 4096; i += gthreads) { const int pos = (int)(i >> 5), j = (int)(i & 31);
            const float inv = powf(10000.0f, -(float)j / 32.0f); const float ang = (float)pos * inv;
            tab[i] = cosf(ang); tab[4096 + i] = sinf(ang); }
    }
}

__device__ __forceinline__ void phase_norm(KP p, int l, int which_norm, int nrows, int wid0) {
    const int tid = tid_fresh(wid0); const int lane = tid & 63, gw = blockIdx.x * 8 + (tid >> 6), nw = gridDim.x * 8;
    unsigned char* ws = launder(p->ws);
    const bf16_t* X = (const bf16_t*)(ws + WS_X); bf16_t* XN = (bf16_t*)(ws + WS_XN);
    const float* mod = (const float*)(ws + WS_MOD) + (size_t)l * 3 * 12288;
    const float* g = p->norm_g + (size_t)(l * 2 + which_norm) * 2048;
    const int shift_c = which_norm ? 3 : 0, scale_c = which_norm ? 4 : 1;
    for (int row = gw; row < nrows; row += nw) {
        const int which = row < NLAT ? (row >> 13) : 2;
        const float* mb = mod + (size_t)which * 12288;
        f32x4 v[8]; float ss = 0.f;
        if (l == 0 && which_norm == 0) {
            const float* xr = row < NLAT ? p->x + (size_t)row * 2048 : p->ctx + (size_t)(row - NLAT) * 2048;
#pragma unroll
            for (int i = 0; i < 8; ++i) v[i] = *(const f32x4*)(xr + i * 256 + lane * 4);
        } else {
            const bf16_t* xr = X + (size_t)row * 2048;
            u32x2 xb[8];
#pragma unroll
            for (int i = 0; i < 8; ++i) xb[i] = *(const u32x2*)(xr + i * 256 + lane * 4);
#pragma unroll
            for (int i = 0; i < 8; ++i) { v[i][0] = bflo(xb[i].x); v[i][1] = bfhi(xb[i].x); v[i][2] = bflo(xb[i].y); v[i][3] = bfhi(xb[i].y); }
        }
#pragma unroll
        for (int i = 0; i < 8; ++i) ss += v[i][0] * v[i][0] + v[i][1] * v[i][1] + v[i][2] * v[i][2] + v[i][3] * v[i][3];
        ss = wave_sum(ss);
        const float rstd = rsqrtf(ss * (1.0f / 2048.0f) + EPSF);
        f32x4 ggv[8], shv[8], scv[8];
#pragma unroll
        for (int i = 0; i < 8; ++i) { const int c = i * 256 + lane * 4; ggv[i] = *(const f32x4*)(g + c); shv[i] = *(const f32x4*)(mb + shift_c * 2048 + c); scv[i] = *(const f32x4*)(mb + scale_c * 2048 + c); }
#pragma unroll
        for (int i = 0; i < 8; ++i) { const int c = i * 256 + lane * 4;
            const f32x4 gg = ggv[i], sh = shv[i], sc = scv[i];
            float o[4];
#pragma unroll
            for (int j = 0; j < 4; ++j) o[j] = v[i][j] * rstd * gg[j] * (1.0f + sc[j]) + sh[j];
            u32x2 w; w.x = pk2(o[0], o[1]); w.y = pk2(o[2], o[3]); *(u32x2*)(XN + (size_t)row * 2048 + c) = w;
            if (which_norm == 0) { int d = 0; d = __builtin_amdgcn_cvt_pk_fp8_f32(fminf(fmaxf(o[0], -448.f), 448.f), fminf(fmaxf(o[1], -448.f), 448.f), d, false);
                d = __builtin_amdgcn_cvt_pk_fp8_f32(fminf(fmaxf(o[2], -448.f), 448.f), fminf(fmaxf(o[3], -448.f), 448.f), d, true); *(unsigned*)(ws + WS_XN8 + (size_t)row * 2048 + c) = (unsigned)d; } }
    }
}

__device__ __forceinline__ void phase_gates_gemm(KP p, int l, int wid0) {
    const int tid = tid_fresh(wid0); const int lane = tid & 63, gw = blockIdx.x * 8 + (tid >> 6), nw = gridDim.x * 8;
    unsigned char* ws = launder(p->ws);
    const bf16_t* XN = (const bf16_t*)(ws + WS_XN); const bf16_t* WG = (const bf16_t*)(ws + WS_WG); float* GA = (float*)(ws + WS_GATES);
    const int q4 = lane >> 4, c = lane & 15;
    const float gb0 = p->a_gate_b[l * 32 + c], gb1 = p->a_gate_b[l * 32 + 16 + c];
    for (int task = gw; task < MR / 16; task += nw) {
        const int r0 = task * 16;
        f32x4 acc0 = {0.f, 0.f, 0.f, 0.f}, acc1 = {0.f, 0.f, 0.f, 0.f};
        const bf16_t* ap = XN + (size_t)(r0 + c) * 2048 + 8 * q4; const bf16_t* b0 = WG + (size_t)c * 2048 + 8 * q4; const bf16_t* b1 = b0 + 16 * 2048;
#pragma unroll 4
        for (int ks = 0; ks < 64; ++ks) { const bf16x8 a = *(const bf16x8*)(ap + ks * 32), x0 = *(const bf16x8*)(b0 + ks * 32), x1 = *(const bf16x8*)(b1 + ks * 32);
            acc0 = mfma16(a, x0, acc0); acc1 = mfma16(a, x1, acc1); }
#pragma unroll
        for (int r = 0; r < 4; ++r) {
            const float v0 = acc0[r] + gb0, v1 = acc1[r] + gb1;
            GA[(size_t)(r0 + 4 * q4 + r) * 32 + c] = (c >= 8) ? logsigmoidf_(v0) : v0; GA[(size_t)(r0 + 4 * q4 + r) * 32 + 16 + c] = (c >= 8) ? logsigmoidf_(v1) : v1; }
    }
}

__device__ __forceinline__ void phase_e1(KP p, int l, int wid0) {
    const int tid = tid_fresh(wid0); const int lane = tid & 63, gw = blockIdx.x * 8 + (tid >> 6), nw = gridDim.x * 8;
    unsigned char* ws = launder(p->ws);
    bf16_t* PQ = (bf16_t*)(ws + WS_PQ); bf16_t* PK = (bf16_t*)(ws + WS_PK); bf16_t* CQ = (bf16_t*)(ws + WS_CQ); bf16_t* CK = (bf16_t*)(ws + WS_CK);
    bf16_t* BB = (bf16_t*)(ws + WS_BB); const bf16_t* BC = (const bf16_t*)(ws + WS_BC); const bf16_t* BX = (const bf16_t*)(ws + WS_BX);
    float* GA = (float*)(ws + WS_GATES); const float* tab = (const float*)(ws + WS_TAB);
    const float* gq = p->c_qk_g + (size_t)(l * 2 + 0) * 128; const float* gk = p->c_qk_g + (size_t)(l * 2 + 1) * 128;
    const float* cw = p->b_conv + (size_t)l * 3 * 2048;
    float gqv[8], gkv[8];
#pragma unroll
    for (int j = 0; j < 8; ++j) { gqv[j] = gq[(lane & 15) * 8 + j] * 0.12751743082459868f;        gkv[j] = gk[(lane & 15) * 8 + j]; }
    const int nitems = NLAT / 8 + NCTX;
    for (int item = gw; item < nitems; item += nw) {
        const int row_first = item < NLAT / 8 ? item * 8 : NLAT + (item - NLAT / 8), nrun = item < NLAT / 8 ? 8 : 1;
        for (int rr = 0; rr < nrun; ++rr) { const int row = row_first + rr;
        if (row < NLAT) {
            const int s = row & 8191, gr = s >> 6, gc = s & 63;
#pragma unroll
            for (int it = 0; it < 2; ++it) {
                const int unit = it * 64 + lane, h = unit >> 4, hf = (unit >> 3) & 1, j4 = unit & 7;
                const int off = h * 128 + hf * 64 + j4 * 4, pos = hf ? gc : gr;
                const f32x4 cs = *(const f32x4*)(tab + pos * 32 + j4 * 4), sn = *(const f32x4*)(tab + 4096 + pos * 32 + j4 * 4);
#pragma unroll
                for (int tsel = 0; tsel < 2; ++tsel) { bf16_t* T = (tsel ? PK : PQ) + (size_t)row * 1024 + off;
                    const u32x2 u1 = *(const u32x2*)T, u2 = *(const u32x2*)(T + 32);
                    const float a0 = bflo(u1.x), a1 = bfhi(u1.x), a2 = bflo(u1.y), a3 = bfhi(u1.y), b0 = bflo(u2.x), b1 = bfhi(u2.x), b2 = bflo(u2.y), b3 = bfhi(u2.y);
                    u32x2 o1, o2;
                    o1.x = pk2(a0 * cs[0] - b0 * sn[0], a1 * cs[1] - b1 * sn[1]); o1.y = pk2(a2 * cs[2] - b2 * sn[2], a3 * cs[3] - b3 * sn[3]);
                    o2.x = pk2(b0 * cs[0] + a0 * sn[0], b1 * cs[1] + a1 * sn[1]); o2.y = pk2(b2 * cs[2] + a2 * sn[2], b3 * cs[3] + a3 * sn[3]);
                    *(u32x2*)T = o1; *(u32x2*)(T + 32) = o2; }
            }
        }
#pragma unroll
        for (int tsel = 0; tsel < 2; ++tsel) {
            bf16_t* T = (tsel ? CK : CQ) + (size_t)row * 2048;
            u32x4 wq4[4];
#pragma unroll
            for (int ps = 0; ps < 4; ++ps) wq4[ps] = *(const u32x4*)(T + ps * 512 + lane * 8);
#pragma unroll
            for (int ps = 0; ps < 4; ++ps) {
                const u32x4 w = wq4[ps];
                float v[8] = {bflo(w.x), bfhi(w.x), bflo(w.y), bfhi(w.y), bflo(w.z), bfhi(w.z), bflo(w.w), bfhi(w.w)};
                float ss = 0.f;
#pragma unroll
                for (int j = 0; j < 8; ++j) ss += v[j] * v[j];
                ss += __shfl_xor(ss, 1); ss += __shfl_xor(ss, 2); ss += __shfl_xor(ss, 4); ss += __shfl_xor(ss, 8);
                const float rstd = rsqrtf(ss * (1.0f / 128.0f) + EPSF);
#pragma unroll
                for (int j = 0; j < 8; ++j) v[j] = v[j] * rstd * (tsel ? gkv[j] : gqv[j]);
                u32x4 o; o.x = pk2(v[0], v[1]); o.y = pk2(v[2], v[3]); o.z = pk2(v[4], v[5]); o.w = pk2(v[6], v[7]);
                *(u32x4*)(T + ps * 512 + lane * 8) = o;
            }
        }
        }
        {
            int pos0, len; if (row_first < NLAT) { pos0 = row_first & 8191; len = SEQ; } else { pos0 = (row_first - NLAT) & 255; len = CTXL; }
#pragma unroll 1
            for (int ps = 0; ps < 4; ++ps) {
                const int c = ps * 512 + lane * 8;
                float w0[8], w1[8], w2[8];
#pragma unroll
                for (int hq = 0; hq < 2; ++hq) { const f32x4 a = *(const f32x4*)(cw + c + hq * 4), bq = *(const f32x4*)(cw + 2048 + c + hq * 4), cq = *(const f32x4*)(cw + 4096 + c + hq * 4);
#pragma unroll
                    for (int j = 0; j < 4; ++j) { w0[hq * 4 + j] = a[j]; w1[hq * 4 + j] = bq[j]; w2[hq * 4 + j] = cq[j]; } }
                u32x4 cvr[10], xvr[10], bbr[8];
                const u32x4 zero4 = {0u, 0u, 0u, 0u};
#pragma unroll
                for (int k = 0; k < 10; ++k) { const int rel = k - 1; const bool ok = (rel <= nrun) && (pos0 + rel >= 0) && (pos0 + rel < len) && (rel < nrun || pos0 + rel < len);
                    if (ok && rel <= nrun) { const size_t o = (size_t)(row_first + rel) * 2048 + c; cvr[k] = *(const u32x4*)(BC + o); xvr[k] = *(const u32x4*)(BX + o); } else { cvr[k] = zero4; xvr[k] = zero4; } }
#pragma unroll
                for (int rr = 0; rr < 8; ++rr) bbr[rr] = (rr < nrun) ? *(const u32x4*)(BB + (size_t)(row_first + rr) * 2048 + c) : zero4;
                float up[8], uc[8], un[8];
                auto mk_u = [&](const u32x4 cv, const u32x4 xv, float (&u)[8]) {
                    u[0] = bflo(cv.x) * bflo(xv.x); u[1] = bfhi(cv.x) * bfhi(xv.x); u[2] = bflo(cv.y) * bflo(xv.y); u[3] = bfhi(cv.y) * bfhi(xv.y);
                    u[4] = bflo(cv.z) * bflo(xv.z); u[5] = bfhi(cv.z) * bfhi(xv.z); u[6] = bflo(cv.w) * bflo(xv.w); u[7] = bfhi(cv.w) * bfhi(xv.w); };
                mk_u(cvr[0], xvr[0], up); mk_u(cvr[1], xvr[1], uc);
#pragma unroll
                for (int rr = 0; rr < 8; ++rr) {
                    if (rr < nrun) {
                        mk_u(cvr[rr + 2], xvr[rr + 2], un);
                        const size_t o = (size_t)(row_first + rr) * 2048 + c; const u32x4 bb = bbr[rr];
                        const float bv[8] = {bflo(bb.x), bfhi(bb.x), bflo(bb.y), bfhi(bb.y), bflo(bb.z), bfhi(bb.z), bflo(bb.w), bfhi(bb.w)};
                        float y[8];
#pragma unroll
                        for (int j = 0; j < 8; ++j) y[j] = bv[j] * (up[j] * w0[j] + uc[j] * w1[j] + un[j] * w2[j]);
                        u32x4 ov; ov.x = pk2(y[0], y[1]); ov.y = pk2(y[2], y[3]); ov.z = pk2(y[4], y[5]); ov.w = pk2(y[6], y[7]);
                        *(u32x4*)(BB + o) = ov;
#pragma unroll
                        for (int j = 0; j < 8; ++j) { up[j] = uc[j]; uc[j] = un[j]; }
                    }
                }
            }
        }
    }
}

constexpr int ML_QS = 0, ML_KS = 17408, ML_VT = 53248, ML_CT = 69376, ML_CTSZ = 13056, ML_PRE_TOT = 3 * 8448 * 4;
__device__ __forceinline__ int ml_row(int pp, int b, int dir) {
    if (pp < 256) { const int j = dir ? 255 - pp : pp; return NLAT + b * 256 + j; }
    int s = pp - 256; if (dir) s = 8191 - s; return b * 8192 + s;
}
__device__ __forceinline__ void phase_mlstm(KP p, int l, LAS unsigned char* lds, int wid0) {
    const int tid = tid_fresh(wid0), lane = tid & 63, w = __builtin_amdgcn_readfirstlane(tid >> 6), q4 = lane >> 4, c16 = lane & 15;
    unsigned char* ws = launder(p->ws);
    const bf16_t* PQ = (const bf16_t*)(ws + WS_PQ); const bf16_t* PK = (const bf16_t*)(ws + WS_PK); const bf16_t* PV = (const bf16_t*)(ws + WS_PV);
    const float* GA = (const float*)(ws + WS_GATES);
    for (int task = blockIdx.x; task < 256; task += gridDim.x) {
        const int xq = task & 7, yq = task >> 3; const int bh = 2 * xq + (yq >> 4), dir = (yq >> 3) & 1, sl = yq & 7; const int b = bh >> 3, h = bh & 7;
        bf16_t* H = (bf16_t*)(ws + (dir ? WS_BX : WS_BC));
        float* SCN = (float*)(ws + WS_SCAN) + (size_t)task * 5 * 8448;
        __syncthreads();
        {
            LAS float* PB = (LAS float*)lds; LAS float* TOT = (LAS float*)(lds + ML_PRE_TOT);
            float li_n = 0.f, lf_n = 0.f;
            if (w < 132) { const int r = ml_row(w * 64 + lane, b, dir); li_n = GA[(size_t)r * 32 + (2 * dir) * 8 + h]; lf_n = GA[(size_t)r * 32 + (2 * dir + 1) * 8 + h]; }
            for (int cc = w; cc < 132; cc += 8) {
                const float li = li_n, lf = lf_n;
                if (cc + 8 < 132) { const int r = ml_row((cc + 8) * 64 + lane, b, dir); li_n = GA[(size_t)r * 32 + (2 * dir) * 8 + h]; lf_n = GA[(size_t)r * 32 + (2 * dir + 1) * 8 + h]; }
                float bc = lf;
#pragma unroll
                for (int o = 1; o < 64; o <<= 1) { const float t = __shfl_up(bc, o); if (lane >= o) bc += t; }
                const float a = li - bc;
                float pm = a;
#pragma unroll
                for (int o = 1; o < 64; o <<= 1) { const float t = __shfl_up(pm, o); if (lane >= o) pm = fmaxf(pm, t); }
                PB[cc * 64 + lane] = bc; PB[8448 + cc * 64 + lane] = a; PB[2 * 8448 + cc * 64 + lane] = pm;
                if (lane == 63) { TOT[cc] = bc; TOT[256 + cc] = pm; }
            }
            __syncthreads();
            const float t0 = TOT[lane], p0 = TOT[256 + lane], t1 = TOT[64 + lane], p1 = TOT[256 + 64 + lane], t2 = TOT[128 + (lane & 3)], p2 = TOT[256 + 128 + (lane & 3)];
            float m = 0.f, mk0 = 0.f, mk1 = 0.f, mk2 = 0.f;
#pragma unroll 4
            for (int c = 0; c < 64; ++c) { if (lane == c) mk0 = m; m = rlane(t0, c) + fmaxf(m, rlane(p0, c)); }
#pragma unroll 4
            for (int c = 0; c < 64; ++c) { if (lane == c) mk1 = m; m = rlane(t1, c) + fmaxf(m, rlane(p1, c)); }
#pragma unroll
            for (int c = 0; c < 4; ++c) { if (lane == c) mk2 = m; m = rlane(t2, c) + fmaxf(m, rlane(p2, c)); }
            for (int cc = w; cc < 132; cc += 8) {
                const float mkk = (cc < 64) ? mk0 : (cc < 128 ? mk1 : mk2);
                const float mc = rlane(mkk, cc & 63);
                const float bc = PB[cc * 64 + lane], a = PB[8448 + cc * 64 + lane], pm = PB[2 * 8448 + cc * 64 + lane];
                const float pmall = rlane(pm, 63);
                const float mx = fmaxf(mc, pm), mref = fmaxf(mc, pmall);
                SCN[cc * 64 + lane] = __expf(mc - mx);
                SCN[8448 + cc * 64 + lane] = __expf(fminf(mref - mx, 80.0f));
                SCN[2 * 8448 + cc * 64 + lane] = __expf(-(bc + mx));
                SCN[3 * 8448 + cc * 64 + lane] = __expf(a - mref);
                if (lane == 0) SCN[4 * 8448 + cc] = __expf(mc - mref);
            }
        }
        __syncthreads();
        for (int i = tid; i < 16 * 32; i += NTHREADS) { const int r = 32 + (i >> 5), cdw = i & 31; *(LAS unsigned*)(lds + ML_VT + r * 144 + cdw * 4) = 0x3f803f80u; }
        for (int i = tid; i < 2 * ML_CTSZ / 4; i += NTHREADS) *(LAS unsigned*)(lds + ML_CT + i * 4) = 0u;
        __syncthreads();
        f32x4 Cst[3];
#pragma unroll
        for (int i = 0; i < 3; ++i) Cst[i] = (f32x4){0.f, 0.f, 0.f, 0.f};
        u32x4 qreg[2], kreg[2], vreg; float eak[2], decay; float wi1, em1, emr1;
        const int qrow_l = lane >> 4, qpc = lane & 15, vrow_l = lane >> 2, vpc = lane & 3;
        const int tr = w >> 1, part = w & 1;
        const int sgn = dir ? -1 : 1;
        const unsigned char* PQb = (const unsigned char*)PQ; const unsigned char* PKb = (const unsigned char*)PK; const unsigned char* PVb = (const unsigned char*)PV;
        const unsigned char* SCb = (const unsigned char*)SCN; unsigned char* Hb = (unsigned char*)H;
        const int lq0 = (sgn * (8 * w + qrow_l) * 1024 + h * 128 + qpc * 8) * 2, lq1 = lq0 + sgn * 4 * 2048;
        const int lv = (sgn * (16 * w + vrow_l) * 2048 + h * 256 + sl * 32 + vpc * 8) * 2;
        const int lh = (sgn * (16 * tr + c16) * 2048 + h * 256 + sl * 32 + 16 * part + 4 * q4) * 2;
        const int lea = (3 * 8448 + 8 * w + qrow_l) * 4, lwi = (16 * tr + c16) * 4;
#define ML_PREFETCH(cn) do { const int _r0 = ml_row((cn) * 64, b, dir); const unsigned _q = (unsigned)_r0 * 2048u, _v = (unsigned)_r0 * 4096u, _s = (unsigned)(cn) * 256u; \
            qreg[0] = *(const u32x4*)(PQb + (_q + (unsigned)lq0)); kreg[0] = *(const u32x4*)(PKb + (_q + (unsigned)lq0)); qreg[1] = *(const u32x4*)(PQb + (_q + (unsigned)lq1)); kreg[1] = *(const u32x4*)(PKb + (_q + (unsigned)lq1)); \
            eak[0] = *(const float*)(SCb + (_s + (unsigned)lea)); eak[1] = *(const float*)(SCb + (_s + (unsigned)lea + 16u)); \
            if (w < 4) vreg = *(const u32x4*)(PVb + (_v + (unsigned)lv)); \
            } while (0)
#define ML_PREFETCH_OUT(cn) do { const unsigned _s = (unsigned)(cn) * 256u; \
            wi1 = *(const float*)(SCb + (_s + (unsigned)lwi)); em1 = *(const float*)(SCb + (_s + (unsigned)lwi + 8448u * 4u)); emr1 = *(const float*)(SCb + (_s + (unsigned)lwi + 2u * 8448u * 4u)); \
            decay = *(const float*)(SCb + (4u * 8448u * 4u + (unsigned)(cn) * 4u)); } while (0)
        ML_PREFETCH(0); ML_PREFETCH_OUT(0);
        for (int c = 0; c < 132; ++c) {
#pragma unroll
            for (int i = 0; i < 2; ++i) { const int sr = 8 * w + 4 * i + qrow_l;
                *(LAS u32x4*)(lds + ML_QS + sr * 272 + qpc * 16) = qreg[i];
                const float e = eak[i]; const u32x4 kk4 = kreg[i]; u32x4 ks;
                ks.x = pk2(bflo(kk4.x) * e, bfhi(kk4.x) * e); ks.y = pk2(bflo(kk4.y) * e, bfhi(kk4.y) * e); ks.z = pk2(bflo(kk4.z) * e, bfhi(kk4.z) * e); ks.w = pk2(bflo(kk4.w) * e, bfhi(kk4.w) * e);
                *(LAS u32x4*)(lds + ML_KS + sr * 272 + qpc * 16) = ks; }
            if (w < 4) { const unsigned vw[4] = {vreg.x, vreg.y, vreg.z, vreg.w}; const int sv = 16 * w + vrow_l;
#pragma unroll
                for (int j = 0; j < 4; ++j) { const int e = vpc * 8 + 2 * j;
                    *(LAS bf16_t*)(lds + ML_VT + e * 144 + sv * 2) = (bf16_t)(vw[j] & 0xffffu);
                    *(LAS bf16_t*)(lds + ML_VT + (e + 1) * 144 + sv * 2) = (bf16_t)(vw[j] >> 16); } }
            if (c + 1 < 132) ML_PREFETCH(c + 1);
            LDS_BARRIER();
            const LAS unsigned char* CTc = lds + ML_CT + (c & 1) * ML_CTSZ;
            const LAS unsigned char* kbase = lds + ML_KS + c16 * 272 + 8 * q4 * 2;
            const LAS unsigned char* vbase1 = lds + ML_VT + (16 * part + c16) * 144 + 4 * q4 * 2, * vbase2 = lds + ML_VT + (32 + c16) * 144 + 4 * q4 * 2;
            bf16x8 aq[4], ka[2][4], cb1[4], cb2[4]; u32x2 vf[4];
#pragma unroll
            for (int ks = 0; ks < 4; ++ks) aq[ks] = *(const LAS bf16x8*)(lds + ML_QS + (16 * tr + c16) * 272 + (ks * 32 + 8 * q4) * 2);
#pragma unroll
            for (int ks = 0; ks < 4; ++ks) { ka[0][ks] = *(const LAS bf16x8*)(kbase + ks * 64); ka[1][ks] = *(const LAS bf16x8*)(kbase + 16 * 272 + ks * 64); }
#pragma unroll
            for (int ks = 0; ks < 4; ++ks) { cb1[ks] = *(const LAS bf16x8*)(CTc + (16 * part + c16) * 272 + (ks * 32 + 8 * q4) * 2); cb2[ks] = *(const LAS bf16x8*)(CTc + (32 + c16) * 272 + (ks * 32 + 8 * q4) * 2); }
            vf[0] = *(const LAS u32x2*)(vbase1); vf[1] = *(const LAS u32x2*)(vbase1 + 32); vf[2] = *(const LAS u32x2*)(vbase2); vf[3] = *(const LAS u32x2*)(vbase2 + 32);
            __builtin_amdgcn_sched_barrier(0);
            f32x4 accA = {0.f, 0.f, 0.f, 0.f}, accD = {0.f, 0.f, 0.f, 0.f}, s0 = {0.f, 0.f, 0.f, 0.f}, s1 = {0.f, 0.f, 0.f, 0.f};
#pragma unroll
            for (int ks = 0; ks < 4; ++ks) { s0 = mfma16(ka[0][ks], aq[ks], s0); s1 = mfma16(ka[1][ks], aq[ks], s1); accA = mfma16(cb1[ks], aq[ks], accA); accD = mfma16(cb2[ks], aq[ks], accD); }
            __builtin_amdgcn_sched_barrier(0);
            bf16x8 kb[2][4]; u32x2 vg[4];
#pragma unroll
            for (int ks = 0; ks < 4; ++ks) { kb[0][ks] = *(const LAS bf16x8*)(kbase + 32 * 272 + ks * 64); kb[1][ks] = *(const LAS bf16x8*)(kbase + 48 * 272 + ks * 64); }
            vg[0] = *(const LAS u32x2*)(vbase1 + 64); vg[1] = *(const LAS u32x2*)(vbase1 + 96); vg[2] = *(const LAS u32x2*)(vbase2 + 64); vg[3] = *(const LAS u32x2*)(vbase2 + 96);
            __builtin_amdgcn_sched_barrier(0);
            const int dq = 4 * q4 - 16 * tr - c16;
            f32x4 accIA, accID;
            {
                float pe[8];
#pragma unroll
                for (int r = 0; r < 4; ++r) { pe[r] = (r + dq <= 0) ? s0[r] : 0.f; pe[4 + r] = (16 + r + dq <= 0) ? s1[r] : 0.f; }
                u32x4 pw; pw.x = pk2(pe[0], pe[1]); pw.y = pk2(pe[2], pe[3]); pw.z = pk2(pe[4], pe[5]); pw.w = pk2(pe[6], pe[7]);
                const bf16x8 pf = __builtin_bit_cast(bf16x8, pw);
                u32x4 bw1, bw2; bw1.x = vf[0].x; bw1.y = vf[0].y; bw1.z = vf[1].x; bw1.w = vf[1].y; bw2.x = vf[2].x; bw2.y = vf[2].y; bw2.z = vf[3].x; bw2.w = vf[3].y;
                accIA = mfma16(__builtin_bit_cast(bf16x8, bw1), pf, (f32x4){0.f, 0.f, 0.f, 0.f}); accID = mfma16(__builtin_bit_cast(bf16x8, bw2), pf, (f32x4){0.f, 0.f, 0.f, 0.f});
            }
            if (tr >= 2) {
                f32x4 s2 = {0.f, 0.f, 0.f, 0.f}, s3 = {0.f, 0.f, 0.f, 0.f};
#pragma unroll
                for (int ks = 0; ks < 4; ++ks) { s2 = mfma16(kb[0][ks], aq[ks], s2); s3 = mfma16(kb[1][ks], aq[ks], s3); }
                float pe[8];
#pragma unroll
                for (int r = 0; r < 4; ++r) { pe[r] = (32 + r + dq <= 0) ? s2[r] : 0.f; pe[4 + r] = (48 + r + dq <= 0) ? s3[r] : 0.f; }
                u32x4 pw; pw.x = pk2(pe[0], pe[1]); pw.y = pk2(pe[2], pe[3]); pw.z = pk2(pe[4], pe[5]); pw.w = pk2(pe[6], pe[7]);
                const bf16x8 pf = __builtin_bit_cast(bf16x8, pw);
                u32x4 bw1, bw2; bw1.x = vg[0].x; bw1.y = vg[0].y; bw1.z = vg[1].x; bw1.w = vg[1].y; bw2.x = vg[2].x; bw2.y = vg[2].y; bw2.z = vg[3].x; bw2.w = vg[3].y;
                accIA = mfma16(__builtin_bit_cast(bf16x8, bw1), pf, accIA); accID = mfma16(__builtin_bit_cast(bf16x8, bw2), pf, accID);
            }
            bf16x8 ak[2], bv[3][2];
#pragma unroll
            for (int k2 = 0; k2 < 2; ++k2) {
                const s16x4 t0 = __builtin_amdgcn_ds_read_tr16_b64_v4i16((LAS s16x4*)(lds + ML_KS + (k2 * 32 + 8 * q4 + (c16 >> 2)) * 272 + (16 * w + 4 * (c16 & 3)) * 2));
                const s16x4 t1 = __builtin_amdgcn_ds_read_tr16_b64_v4i16((LAS s16x4*)(lds + ML_KS + (k2 * 32 + 8 * q4 + 4 + (c16 >> 2)) * 272 + (16 * w + 4 * (c16 & 3)) * 2));
                ak[k2] = __builtin_shufflevector(t0, t1, 0, 1, 2, 3, 4, 5, 6, 7);
            }
#pragma unroll
            for (int ct = 0; ct < 3; ++ct)
#pragma unroll
                for (int k2 = 0; k2 < 2; ++k2) bv[ct][k2] = *(const LAS bf16x8*)(lds + ML_VT + (16 * ct + c16) * 144 + (k2 * 32 + 8 * q4) * 2);
            __builtin_amdgcn_sched_barrier(0);
            if (l == 0 || c >= 4) {
                const unsigned hb = (unsigned)ml_row(c * 64, b, dir) * 4096u + (unsigned)lh;
                const float den = wi1 * accD[0] + em1 * accID[0];
                const float inv = __builtin_amdgcn_rcpf(fmaxf(fabsf(den), emr1));
                const f32x4 num = accA * wi1 + accIA * em1;
                u32x2 ow; ow.x = pk2(num[0] * inv, num[1] * inv); ow.y = pk2(num[2] * inv, num[3] * inv);
                *(u32x2*)(Hb + hb) = ow;
            }
            {
                LAS unsigned char* CTn = lds + ML_CT + ((c + 1) & 1) * ML_CTSZ;
#pragma unroll
                for (int ct = 0; ct < 3; ++ct) {
                    Cst[ct] = Cst[ct] * decay;
#pragma unroll
                    for (int k2 = 0; k2 < 2; ++k2) Cst[ct] = mfma16(ak[k2], bv[ct][k2], Cst[ct]);
                }
                if (c + 1 < 132) ML_PREFETCH_OUT(c + 1);
#pragma unroll
                for (int ct = 0; ct < 3; ++ct) { u32x2 o; o.x = pk2(Cst[ct][0], Cst[ct][1]); o.y = pk2(Cst[ct][2], Cst[ct][3]);
                    *(LAS u32x2*)(CTn + (16 * ct + c16) * 272 + (16 * w + 4 * q4) * 2) = o; }
            }
            LDS_BARRIER();
        }
#undef ML_PREFETCH
#undef ML_PREFETCH_OUT
    }
}

constexpr int AT_KS = 0, AT_VS = 17408, AT_RPB = 35840;
__device__ __forceinline__ void phase_attn(KP p, int l, LAS unsigned char* lds, int wid0) {
    const int tid = tid_fresh(wid0), lane = tid & 63, w = __builtin_amdgcn_readfirstlane(tid >> 6), q4 = lane >> 4, c16 = lane & 15;
    unsigned char* ws = launder(p->ws);
    bf16_t* CQ = (bf16_t*)(ws + WS_CQ); const bf16_t* CK = (const bf16_t*)(ws + WS_CK); const bf16_t* CV = (const bf16_t*)(ws + WS_CV);
    const int nunits = 2048 + (l == 0 ? 64 : 0);
    for (int u = blockIdx.x; u < nunits; u += gridDim.x) {
        int b, h, qrow = 0, g = 0, ntl = 0, r0a = 0, qbase;  bool is_ctx = u >= 2048;
        if (!is_ctx) { b = u >> 10; h = (u >> 6) & 15; const int rp = u & 63; qrow = 2 * rp + (w >> 2); g = w & 3;
            r0a = min(max(2 * rp - 4, 0), 120); const int r0b = min(max(2 * rp + 1 - 4, 0), 120); ntl = r0b + 8 - r0a;
            qbase = b * 8192 + qrow * 64 + 16 * g; }
        else { const int uu = u - 2048; b = uu >> 5; h = (uu >> 1) & 15; qbase = NLAT + b * 256 + (uu & 1) * 128 + 16 * w; }
        const int r0q = min(max(qrow - 4, 0), 120);
        const int a_g = (g == 0) ? 0 : (g == 1 ? 8 : (g == 2 ? 24 : 32));
        __syncthreads();
        if (!is_ctx) for (int i = tid; i < 465; i += NTHREADS) *(LAS float*)(lds + AT_RPB + i * 4) = p->c_rpb[((size_t)l * 16 + h) * 465 + i] * 1.4426950408889634f;
        bf16x8 qf[4];
#pragma unroll
        for (int ks = 0; ks < 4; ++ks) qf[ks] = *(const bf16x8*)(CQ + (size_t)(qbase + c16) * 2048 + h * 128 + ks * 32 + 8 * q4);
        f32x4 O[8];
#pragma unroll
        for (int i = 0; i < 8; ++i) O[i] = (f32x4){0.f, 0.f, 0.f, 0.f};
        float m_run = -1e30f, l_run = 0.f;
        const int ntiles = ntl + 4;
        u32x4 kreg[2], vreg[2];
        auto tile_row = [&](int t, int key) -> int { return (t < ntl) ? (b * 8192 + (r0a + t) * 64 + key) : (NLAT + b * 256 + (t - ntl) * 64 + key); };
        const int krow_l = lane >> 4, kpc = lane & 15;
        {
#pragma unroll
          for (int i = 0; i < 2; ++i) { const int r = tile_row(0, 8 * w + 4 * i + krow_l); kreg[i] = *(const u32x4*)(CK + (size_t)r * 2048 + h * 128 + kpc * 8); vreg[i] = *(const u32x4*)(CV + (size_t)r * 2048 + h * 128 + kpc * 8); } }
        for (int t = 0; t < ntiles; ++t) {
            LDS_BARRIER();
#pragma unroll
            for (int i = 0; i < 2; ++i) { const int key = 8 * w + 4 * i + krow_l;
                *(LAS u32x4*)(lds + AT_KS + key * 272 + kpc * 16) = kreg[i];
                *(LAS u32x4*)(lds + AT_VS + key * 288 + kpc * 16) = vreg[i]; }
            if (t + 1 < ntiles) {
#pragma unroll
                for (int i = 0; i < 2; ++i) { const int r = tile_row(t + 1, 8 * w + 4 * i + krow_l); kreg[i] = *(const u32x4*)(CK + (size_t)r * 2048 + h * 128 + kpc * 8); vreg[i] = *(const u32x4*)(CV + (size_t)r * 2048 + h * 128 + kpc * 8); } }
            LDS_BARRIER();
            const bool local = t < ntl; const int kr = r0a + t;
            if (local && !(kr >= r0q && kr < r0q + 8)) continue;
            const int npass = local ? 1 : 2;
            for (int ps = 0; ps < npass; ++ps) {
                const int a0 = local ? a_g : ps * 32;
                const LAS unsigned char* kp0 = lds + AT_KS + (a0 + c16) * 272 + 8 * q4 * 2;
                bf16x8 kf[2][4];
#pragma unroll
                for (int ct = 0; ct < 2; ++ct)
#pragma unroll
                    for (int ks = 0; ks < 4; ++ks) kf[ct][ks] = *(const LAS bf16x8*)(kp0 + ct * 16 * 272 + ks * 64);
                float bs[8];
                if (local) {
                    const int qc = 16 * g + c16;
                    const LAS float* bp = (const LAS float*)(lds + AT_RPB) + ((kr - qrow + 7) * 31 + a0 + 4 * q4 - qc + 15);
#pragma unroll
                    for (int i = 0; i < 8; ++i) bs[i] = bp[16 * (i >> 2) + (i & 3)];
                    asm volatile("" : "+v"(bs[0]), "+v"(bs[1]), "+v"(bs[2]), "+v"(bs[3]), "+v"(bs[4]), "+v"(bs[5]), "+v"(bs[6]), "+v"(bs[7]));
                }
                __builtin_amdgcn_sched_barrier(0);
                f32x4 sc[2] = {{0.f, 0.f, 0.f, 0.f}, {0.f, 0.f, 0.f, 0.f}};
#pragma unroll
                for (int ks = 0; ks < 4; ++ks) { sc[0] = mfma16(kf[0][ks], qf[ks], sc[0]); sc[1] = mfma16(kf[1][ks], qf[ks], sc[1]); }
                __builtin_amdgcn_sched_barrier(0);
                s16x4 vlo[8], vhi[8];
                { const LAS unsigned char* vp0 = lds + AT_VS + (a0 + 4 * q4 + (c16 >> 2)) * 288 + 4 * (c16 & 3) * 2;
#pragma unroll
                  for (int dt = 0; dt < 8; ++dt) { vlo[dt] = __builtin_amdgcn_ds_read_tr16_b64_v4i16((LAS s16x4*)(vp0 + dt * 32)); vhi[dt] = __builtin_amdgcn_ds_read_tr16_b64_v4i16((LAS s16x4*)(vp0 + 16 * 288 + dt * 32)); } }
                __builtin_amdgcn_sched_barrier(0);
                if (local) {
                    const int qc = 16 * g + c16, col0 = min(max(qc - 8, 0), 48);
                    const int kb = a0 + 4 * q4 - col0;
#pragma unroll
                    for (int ct = 0; ct < 2; ++ct)
#pragma unroll
                        for (int r = 0; r < 4; ++r) sc[ct][r] = ((unsigned)(kb + 16 * ct + r) < 16u) ? sc[ct][r] + bs[ct * 4 + r] : -1e30f;
                }
                float mx = fmaxf(fmaxf(fmaxf(sc[0][0], sc[0][1]), fmaxf(sc[0][2], sc[0][3])), fmaxf(fmaxf(sc[1][0], sc[1][1]), fmaxf(sc[1][2], sc[1][3])));
                { const u32x2 t = __builtin_amdgcn_permlane16_swap(__float_as_uint(mx), __float_as_uint(mx), false, false); mx = fmaxf(__uint_as_float(t.x), __uint_as_float(t.y)); }
                { const u32x2 t = __builtin_amdgcn_permlane32_swap(__float_as_uint(mx), __float_as_uint(mx), false, false); mx = fmaxf(__uint_as_float(t.x), __uint_as_float(t.y)); }
                const float m_new = fmaxf(m_run, mx);
                const float alpha = __builtin_amdgcn_exp2f(m_run - m_new);
                float pe[8]; float psum = 0.f;
#pragma unroll
                for (int ct = 0; ct < 2; ++ct)
#pragma unroll
                    for (int r = 0; r < 4; ++r) { const float e = __builtin_amdgcn_exp2f(sc[ct][r] - m_new); pe[ct * 4 + r] = e; psum += e; }
                { const u32x2 t = __builtin_amdgcn_permlane16_swap(__float_as_uint(psum), __float_as_uint(psum), false, false); psum = __uint_as_float(t.x) + __uint_as_float(t.y); }
                { const u32x2 t = __builtin_amdgcn_permlane32_swap(__float_as_uint(psum), __float_as_uint(psum), false, false); psum = __uint_as_float(t.x) + __uint_as_float(t.y); }
                l_run = l_run * alpha + psum; m_run = m_new;
                bf16x8 pf; { u32x4 pw; pw.x = pk2(pe[0], pe[1]); pw.y = pk2(pe[2], pe[3]); pw.z = pk2(pe[4], pe[5]); pw.w = pk2(pe[6], pe[7]); pf = __builtin_bit_cast(bf16x8, pw); }
                if (__ballot(alpha != 1.0f) != 0ull) {
#pragma unroll
                    for (int dt = 0; dt < 8; ++dt) O[dt] = O[dt] * alpha;
                }
#pragma unroll
                for (int dt = 0; dt < 8; ++dt) O[dt] = mfma16(__builtin_shufflevector(vlo[dt], vhi[dt], 0, 1, 2, 3, 4, 5, 6, 7), pf, O[dt]);
            }
        }
        const float linv = 1.0f / l_run;
#pragma unroll
        for (int dt = 0; dt < 8; ++dt) { u32x2 ow; ow.x = pk2(O[dt][0] * linv, O[dt][1] * linv); ow.y = pk2(O[dt][2] * linv, O[dt][3] * linv);
            *(u32x2*)(CQ + (size_t)(qbase + c16) * 2048 + h * 128 + 16 * dt + 4 * q4) = ow; }
    }
}

__device__ __forceinline__ void phase_e2(KP p, int l, int nrows, int wid0) {
    const int tid = tid_fresh(wid0); const int lane = tid & 63, gw = blockIdx.x * 8 + (tid >> 6), nw = gridDim.x * 8;
    unsigned char* ws = launder(p->ws);
    const bf16_t* HF = (const bf16_t*)(ws + WS_BC); const bf16_t* HB = (const bf16_t*)(ws + WS_BX); bf16_t* PO = (bf16_t*)(ws + WS_PO);
    const float* hg = p->a_hnorm_g + (size_t)l * 2048;
    for (int row = gw; row < nrows; row += nw) {
        u32x2 fv[8], bv[8], ovv[8];
#pragma unroll
        for (int h = 0; h < 8; ++h) { const size_t o = (size_t)row * 2048 + h * 256 + lane * 4; fv[h] = *(const u32x2*)(HF + o); bv[h] = *(const u32x2*)(HB + o); ovv[h] = *(const u32x2*)(PO + o); }
#pragma unroll
        for (int h = 0; h < 8; ++h) {
            const size_t o = (size_t)row * 2048 + h * 256 + lane * 4;
            const u32x2 f = fv[h], bb = bv[h], ov = ovv[h];
            float v[4] = {bflo(f.x) + bflo(bb.x), bfhi(f.x) + bfhi(bb.x), bflo(f.y) + bflo(bb.y), bfhi(f.y) + bfhi(bb.y)};
            float ss = v[0] * v[0] + v[1] * v[1] + v[2] * v[2] + v[3] * v[3];
            ss = wave_sum(ss);
            const float rstd = rsqrtf(ss * (1.0f / 256.0f) + EPSF);
            const f32x4 gg = *(const f32x4*)(hg + h * 256 + lane * 4);
            const float og[4] = {bflo(ov.x), bfhi(ov.x), bflo(ov.y), bfhi(ov.y)};
            float y[4];
#pragma unroll
            for (int j = 0; j < 4; ++j) y[j] = sigmoidf_(og[j]) * v[j] * rstd * gg[j];
            u32x2 wv; wv.x = pk2(y[0], y[1]); wv.y = pk2(y[2], y[3]); *(u32x2*)(PO + o) = wv;
        }
    }
}

template <int MODE>
__device__ __forceinline__ void ctx_gemm(KP p, int l, LAS unsigned char* lds, int wid0) {
    const int tid = tid_fresh(wid0); const int lane = tid & 63, w = __builtin_amdgcn_readfirstlane(tid >> 6), q4 = lane >> 4, c16 = lane & 15;
    unsigned char* ws = launder(p->ws);
    for (int task = blockIdx.x; task < (NCTX / 64) * 32; task += gridDim.x) {
        const int rg = task >> 5, cb = task & 31; const int row0 = NLAT + rg * 64, col0 = cb * 64;
        const int orow = row0 + (tid >> 3), ocol = col0 + (tid & 7) * 8;
        float yv[8];
#pragma unroll
        for (int i = 0; i < 8; ++i) yv[i] = 0.f;
#pragma unroll 1
        for (int br = 0; br < (MODE == 0 ? 3 : 1); ++br) {
            const bf16_t* A; const bf16_t* Bt;
            if (MODE == 0) { const int ti = 1 + 4 * (br == 1) + (br == 2); A = (const bf16_t*)(ws + WS_T8 + (size_t)ti * SZ_A); Bt = (const bf16_t*)(ws + WS_WA + (size_t)br * SZ_W); }
            else if (MODE == 1) { A = (const bf16_t*)(ws + WS_Y); Bt = (const bf16_t*)(ws + WS_WO); }
            else { A = (const bf16_t*)(ws + WS_XN); Bt = (const bf16_t*)(ws + WS_WQ); }
            const bf16_t* ap = A + (size_t)(row0 + c16) * 2048 + w * 256 + 8 * q4; const bf16_t* bp = Bt + (size_t)(col0 + c16) * 2048 + w * 256 + 8 * q4;
            f32x4 acc[4][4];
#pragma unroll
            for (int mi = 0; mi < 4; ++mi)
#pragma unroll
                for (int j = 0; j < 4; ++j) acc[mi][j] = (f32x4){0.f, 0.f, 0.f, 0.f};
#pragma unroll 2
            for (int ks = 0; ks < 8; ++ks) {
                bf16x8 a[4], bb[4];
#pragma unroll
                for (int mi = 0; mi < 4; ++mi) a[mi] = *(const bf16x8*)(ap + (size_t)mi * 16 * 2048 + ks * 32);
#pragma unroll
                for (int j = 0; j < 4; ++j) bb[j] = *(const bf16x8*)(bp + (size_t)j * 16 * 2048 + ks * 32);
#pragma unroll
                for (int mi = 0; mi < 4; ++mi)
#pragma unroll
                    for (int j = 0; j < 4; ++j) acc[mi][j] = mfma16(a[mi], bb[j], acc[mi][j]);
            }
            __syncthreads();
#pragma unroll
            for (int mi = 0; mi < 4; ++mi)
#pragma unroll
                for (int j = 0; j < 4; ++j)
#pragma unroll
                    for (int r = 0; r < 4; ++r) *(LAS float*)(lds + ((w * 64 + 16 * mi + 4 * q4 + r) * 64 + 16 * j + c16) * 4) = acc[mi][j][r];
            __syncthreads();
            float sv[8];
#pragma unroll
            for (int i = 0; i < 8; ++i) sv[i] = 0.f;
#pragma unroll
            for (int ww = 0; ww < 8; ++ww) { const f32x4 p0 = *(const LAS f32x4*)(lds + ((ww * 64 + (tid >> 3)) * 64 + (tid & 7) * 8) * 4), p1 = *(const LAS f32x4*)(lds + ((ww * 64 + (tid >> 3)) * 64 + (tid & 7) * 8 + 4) * 4);
                sv[0] += p0[0]; sv[1] += p0[1]; sv[2] += p0[2]; sv[3] += p0[3]; sv[4] += p1[0]; sv[5] += p1[1]; sv[6] += p1[2]; sv[7] += p1[3]; }
            if (MODE == 0) { const u32x2 g = *(const u32x2*)(ws + WS_GT + (size_t)orow * 6144 + (size_t)br * 2048 + ocol);
#pragma unroll
                for (int i = 0; i < 8; ++i) yv[i] += pg8::gq8(i < 4 ? g.x : g.y, i & 3) * (1.0f / 255.0f) * sv[i]; }
            else {
#pragma unroll
                for (int i = 0; i < 8; ++i) yv[i] = sv[i]; }
        }
        if (MODE == 1) { bf16_t* xp = (bf16_t*)(ws + WS_X) + (size_t)orow * 2048 + ocol; const float* xi = p->ctx + (size_t)(orow - NLAT) * 2048 + ocol; const float* mg = (const float*)(ws + WS_MOD) + (size_t)l * 3 * 12288 + 2 * 12288 + 2 * 2048 + ocol;
            const f32x4 x0 = *(const f32x4*)xi, x1 = *(const f32x4*)(xi + 4), g0 = *(const f32x4*)mg, g1 = *(const f32x4*)(mg + 4);
            f32x4 o0, o1; o0[0] = x0[0] + g0[0] * yv[0]; o0[1] = x0[1] + g0[1] * yv[1]; o0[2] = x0[2] + g0[2] * yv[2]; o0[3] = x0[3] + g0[3] * yv[3];
            o1[0] = x1[0] + g1[0] * yv[4]; o1[1] = x1[1] + g1[1] * yv[5]; o1[2] = x1[2] + g1[2] * yv[6]; o1[3] = x1[3] + g1[3] * yv[7];
            u32x4 ow; ow.x = pk2(o0[0], o0[1]); ow.y = pk2(o0[2], o0[3]); ow.z = pk2(o1[0], o1[1]); ow.w = pk2(o1[2], o1[3]); *(u32x4*)xp = ow; }
        else { u32x4 ov; ov.x = pk2(yv[0], yv[1]); ov.y = pk2(yv[2], yv[3]); ov.z = pk2(yv[4], yv[5]); ov.w = pk2(yv[6], yv[7]);
            *(u32x4*)((bf16_t*)(ws + (MODE == 0 ? WS_Y : WS_PV)) + (size_t)orow * 2048 + ocol) = ov; }
    }
}

constexpr int PE_MAXT = 80;
constexpr int PE_IDX = 0, PE_W = PE_MAXT * 128 * 4, PE_SCR = 2 * PE_MAXT * 128 * 4, PE_SCRSZ = 16 * 132 * 4 + 4096 + 256;
#define PE_DPPU(v, ctrl) ((unsigned)__builtin_amdgcn_update_dpp(0, (int)(v), ctrl, 0xf, 0xf, true))
__device__ __forceinline__ unsigned ordkey(float v) { const unsigned u = __float_as_uint(v); return (u & 0x80000000u) ? ~u : (u | 0x80000000u); }
__device__ __forceinline__ void phase_peer(KP p, int l, LAS unsigned char* lds, int wid0) {
    const int tid = tid_fresh(wid0), lane = tid & 63, w = __builtin_amdgcn_readfirstlane(tid >> 6), q4 = lane >> 4, c16 = lane & 15;
    unsigned char* ws = launder(p->ws);
    const bf16_t* QP = (const bf16_t*)(ws + WS_PV); const bf16_t* KEYS = (const bf16_t*)(ws + WS_KEYS);
    const bf16_t* XN = (const bf16_t*)(ws + WS_XN);
    bf16_t* X = (bf16_t*)(ws + WS_X); const float* mod = (const float*)(ws + WS_MOD) + (size_t)l * 3 * 12288;
    const int ntok = (l == 0) ? MR : NLAT, G = gridDim.x;
    const int per = (ntok + G - 1) / G; const int t_begin = blockIdx.x * per, t_end = min(ntok, t_begin + per);
    for (int tb = t_begin; tb < t_end; tb += PE_MAXT) {
        const int nt = min(PE_MAXT, t_end - tb);
        __syncthreads();
        const int ntask = (nt + 15) >> 4;
        if (w < ntask) {
            int lane_pe1 = lane; asm volatile("" : "+v"(lane_pe1));
            const int lane = lane_pe1, q4 = lane >> 4, c16 = lane & 15;
            LAS unsigned char* scr = lds + PE_SCR + w * PE_SCRSZ;
            LAS float* SC = (LAS float*)scr;
            LAS float* LS = (LAS float*)(scr + 16 * 132 * 4);
            LAS int* LI = (LAS int*)(scr + 16 * 132 * 4 + 2048);
            LAS unsigned char* PT = scr + 16 * 132 * 4 + 4096;
            if (lane < 52) {
                const int L = lane;
                const int ge16 = L >= 16, ge24 = L >= 24, ge29 = L >= 29, ge33 = L >= 33, ge36 = L >= 36, ge38 = L >= 38, ge40 = L >= 40, ge42 = L >= 42;
                int pa = ge16 + ge24 + ge29 + ge33 + ge36 + ge38 + ge40 + ge42; if (ge42) pa = 8 + (L - 42);
                int pb = L - (16 * ge16 + 8 * ge24 + 5 * ge29 + 4 * ge33 + 3 * ge36 + 2 * ge38 + 2 * ge40 + 2 * ge42); if (ge42) pb = 0;
                if (L >= 50) { pa = 15; pb = 15; }
                PT[lane * 2] = (unsigned char)pa; PT[lane * 2 + 1] = (unsigned char)pb;
            }
            const int tok_a = min(tb + 16 * w + c16, t_end - 1);
            const int tkl = lane >> 2, qq = lane & 3;
            for (int h = 0; h < 8; ++h) {
                for (int pp = 0; pp < 2; ++pp) {
                    const int hp = 2 * h + pp;
                    bf16x8 af[4];
#pragma unroll
                    for (int ks = 0; ks < 4; ++ks) af[ks] = *(const bf16x8*)(QP + (size_t)tok_a * 2048 + h * 256 + pp * 128 + ks * 32 + 8 * q4);
#pragma unroll 4
                    for (int ct = 0; ct < 8; ++ct) {
                        f32x4 acc = {0.f, 0.f, 0.f, 0.f};
#pragma unroll
                        for (int ks = 0; ks < 4; ++ks) { const bf16x8 bfr = *(const bf16x8*)(KEYS + ((size_t)hp * 128 + 16 * ct + c16) * 128 + ks * 32 + 8 * q4); acc = mfma16(af[ks], bfr, acc); }
#pragma unroll
                        for (int r = 0; r < 4; ++r) SC[(4 * q4 + r) * 132 + 16 * ct + c16] = acc[r];
                    }
                    asm volatile("s_waitcnt lgkmcnt(0)" ::: "memory");
                    unsigned key[32];
#pragma unroll
                    for (int i = 0; i < 8; ++i) { const f32x4 v = *(const LAS f32x4*)(SC + tkl * 132 + 32 * qq + 4 * i);
#pragma unroll
                        for (int j = 0; j < 4; ++j) key[4 * i + j] = ((ordkey(v[j]) >> 1) & ~127u) | (unsigned)(32 * qq + 4 * i + j); }
                    unsigned prev = 0x80000000u;
#pragma unroll 1
                    for (int r = 0; r < 16; ++r) {
                        unsigned mxd = 0u;
#pragma unroll
                        for (int i = 0; i < 32; ++i) { const unsigned d = key[i] - prev; mxd = mxd > d ? mxd : d; }
                        { const unsigned o1 = PE_DPPU(mxd, 0xB1); mxd = mxd > o1 ? mxd : o1; const unsigned o2 = PE_DPPU(mxd, 0x4E); mxd = mxd > o2 ? mxd : o2; }
                        const unsigned mxk = mxd + prev;
                        prev = mxk;
                        if (qq == (r & 3)) { const int idx = (int)(mxk & 127u); LS[(pp * 16 + tkl) * 16 + r] = SC[tkl * 132 + idx]; LI[(pp * 16 + tkl) * 16 + r] = idx; }
                    }
                    asm volatile("s_waitcnt lgkmcnt(0)" ::: "memory");
                }
                unsigned ck[13];
#pragma unroll
                for (int i = 0; i < 13; ++i) { const int cidx = qq + 4 * i;
                    if (cidx < 50) { const int a = PT[cidx * 2], bq = PT[cidx * 2 + 1]; const float sv = LS[(0 * 16 + tkl) * 16 + a] + LS[(1 * 16 + tkl) * 16 + bq]; ck[i] = ((ordkey(sv) >> 1) & ~63u) | (unsigned)cidx; }
                    else ck[i] = 0u; }
                unsigned prev = 0x80000000u; float best0 = 0.f, esum = 0.f; float myexp[4] = {0.f, 0.f, 0.f, 0.f}; int myidx[4] = {0, 0, 0, 0};
#pragma unroll
                for (int r = 0; r < 16; ++r) {
                    unsigned mxd = 0u;
#pragma unroll
                    for (int i = 0; i < 13; ++i) { const unsigned d = ck[i] - prev; mxd = mxd > d ? mxd : d; }
                    { const unsigned o1 = PE_DPPU(mxd, 0xB1); mxd = mxd > o1 ? mxd : o1; const unsigned o2 = PE_DPPU(mxd, 0x4E); mxd = mxd > o2 ? mxd : o2; }
                    const unsigned mxk = mxd + prev;
                    prev = mxk;
                    const int cidx = (int)(mxk & 63u); const int a = PT[cidx * 2], bq = PT[cidx * 2 + 1];
                    const float best = LS[(0 * 16 + tkl) * 16 + a] + LS[(1 * 16 + tkl) * 16 + bq];
                    const int eidx = LI[(0 * 16 + tkl) * 16 + a] * 128 + LI[(1 * 16 + tkl) * 16 + bq];
                    if (r == 0) best0 = best;
                    const float e = __expf(best - best0); esum += e;
                    if (qq == (r & 3)) { myexp[r >> 2] = e; myidx[r >> 2] = eidx; }
                }
                const float inv = 1.0f / esum; const int tl = 16 * w + tkl;
                if (tl < nt) {
#pragma unroll
                    for (int i = 0; i < 4; ++i) { const int r = 4 * i + qq;
                        *(LAS int*)(lds + PE_IDX + (tl * 128 + h * 16 + r) * 4) = myidx[i];
                        *(LAS float*)(lds + PE_W + (tl * 128 + h * 16 + r) * 4) = myexp[i] * inv; }
                }
                asm volatile("s_waitcnt lgkmcnt(0)" ::: "memory");
            }
        }
        __syncthreads();
        int lane_pe2 = lane; asm volatile("" : "+v"(lane_pe2));
        const int nfull = nt & ~7, nleft = nt - nfull;
        const int S = (nleft == 1 || nleft == 2 || nleft == 4) ? 8 / nleft : 1;
        const int nrounds = (nfull >> 3) + (nleft ? 1 : 0);
        for (int rd = 0; rd < nrounds; ++rd) {
            const int lane = lane_pe2;
            const bool split = (rd == (nfull >> 3)) && S > 1;
            const int tl = split ? nfull + w / S : rd * 8 + w;
            const int NB = split ? 64 / S : 64, B0 = split ? (w % S) * NB : 0;
            const bool active = tl < nt;
            if (active) {
            const int row = tb + tl;
            u32x16 xq;
#pragma unroll
            for (int i = 0; i < 4; ++i) { const u32x4 xw = *(const u32x4*)(XN + (size_t)row * 2048 + lane * 32 + i * 8); xq[4 * i] = xw.x; xq[4 * i + 1] = xw.y; xq[4 * i + 2] = xw.z; xq[4 * i + 3] = xw.w; }
            const LAS int* idxp = (const LAS int*)(lds + PE_IDX + tl * 512);
            LAS float* wp = (LAS float*)(lds + PE_W + tl * 512);
            u32x4 bufA[2], bufB[2], bufC[2], bufD[2];
#define PE_ISSUE(buf, TAB, b) do { const u32x2 _ee = *(const LAS u32x2*)(idxp + 2 * (b)); \
                buf[0] = *(const u32x4*)((TAB) + ((_ee.x << 10) + (unsigned)lane * 16u)); buf[1] = *(const u32x4*)((TAB) + ((_ee.y << 10) + (unsigned)lane * 16u)); } while (0)
#define PE_DPPF(v, ctrl) __uint_as_float((unsigned)__builtin_amdgcn_update_dpp(0, (int)__float_as_uint(v), ctrl, 0xf, 0xf, true))
#define PE_CONS_U(buf, b) do { float _p[2]; \
                _Pragma("unroll") for (int _j = 0; _j < 2; ++_j) { float _d = 0.f; \
                    _Pragma("unroll") for (int _q = 0; _q < 4; ++_q) { const unsigned _dw = buf[_j][_q]; \
                        _d = dot2bf(__builtin_bit_cast(unsigned, __builtin_amdgcn_cvt_scalef32_pk_bf16_fp4(_dw, 1.0f, 0)), xq[4 * _q + 0], _d); _d = dot2bf(__builtin_bit_cast(unsigned, __builtin_amdgcn_cvt_scalef32_pk_bf16_fp4(_dw, 1.0f, 1)), xq[4 * _q + 1], _d); \
                        _d = dot2bf(__builtin_bit_cast(unsigned, __builtin_amdgcn_cvt_scalef32_pk_bf16_fp4(_dw, 1.0f, 2)), xq[4 * _q + 2], _d); _d = dot2bf(__builtin_bit_cast(unsigned, __builtin_amdgcn_cvt_scalef32_pk_bf16_fp4(_dw, 1.0f, 3)), xq[4 * _q + 3], _d); } \
                    _p[_j] = _d; } \
                float _c; { const u32x2 _t = __builtin_amdgcn_permlane32_swap(__float_as_uint(_p[0]), __float_as_uint(_p[1]), false, false); _c = __uint_as_float(_t.x) + __uint_as_float(_t.y); }     \
                { const u32x2 _t = __builtin_amdgcn_permlane16_swap(__float_as_uint(_c), __float_as_uint(_c), false, false); _c = __uint_as_float(_t.x) + __uint_as_float(_t.y); } \
                _c += PE_DPPF(_c, 0x140); _c += PE_DPPF(_c, 0x141); _c += PE_DPPF(_c, 0x4E); _c += PE_DPPF(_c, 0xB1);        \
                if ((lane & 31) == ((((b) - B0)) & 31)) cacc = _c; } while (0)
#define PE_FLUSH(jb, cnt) do { if ((lane & 31) < (cnt)) { const int _e = 2 * (B0 + (jb) + (lane & 31)) + (lane >> 5); const float _g = wp[_e]; \
                const float _a = cacc * (1.0f / 64.0f); wp[_e] = _g * 0.5f * _a * (1.0f + erff(_a * 0.70710678118654752f)); } } while (0)
#define PE_CONS_V(buf, b) do { const f32x2 _w2 = *(const LAS f32x2*)(wp + 2 * (b)); \
                _Pragma("unroll") for (int _j = 0; _j < 2; ++_j) { const f32x2 _wv = {_w2[_j], _w2[_j]}; \
                    _Pragma("unroll") for (int _q = 0; _q < 4; ++_q) { const unsigned _dw = buf[_j][_q]; \
                        out2[4 * _q + 0] += _wv * __builtin_amdgcn_cvt_scalef32_pk_f32_fp4(_dw, 1.0f, 0); out2[4 * _q + 1] += _wv * __builtin_amdgcn_cvt_scalef32_pk_f32_fp4(_dw, 1.0f, 1); \
                        out2[4 * _q + 2] += _wv * __builtin_amdgcn_cvt_scalef32_pk_f32_fp4(_dw, 1.0f, 2); out2[4 * _q + 3] += _wv * __builtin_amdgcn_cvt_scalef32_pk_f32_fp4(_dw, 1.0f, 3); } } } while (0)
            const unsigned char* TU = ws + WS_PU; const unsigned char* TV = ws + WS_PVW;
            const int NT = 2 * NB;
            asm volatile("" : "+v"(xq));
#define PE_ISS(s_, bi) do { const int _jn = min(max(j0 + (s_) + 3, 0), NT - 1); const bool _isv = _jn >= NB; \
                const unsigned char* _tab = _isv ? TV : TU; const int _bb = B0 + (_isv ? _jn - NB : _jn); PE_ISSUE(bi, _tab, _bb); } while (0)
            float cacc = 0.f;
#pragma unroll 1
            for (int t = -1; 4 * t < NB; ++t) { const int j0 = 4 * t;
                PE_ISS(0, bufD); if (t >= 0) PE_CONS_U(bufA, B0 + j0);
                PE_ISS(1, bufA); if (t >= 0) PE_CONS_U(bufB, B0 + j0 + 1);
                PE_ISS(2, bufB); if (t >= 0) PE_CONS_U(bufC, B0 + j0 + 2);
                PE_ISS(3, bufC); if (t >= 0) PE_CONS_U(bufD, B0 + j0 + 3);
                if (t >= 0 && ((t & 7) == 7 || 4 * (t + 1) >= NB)) PE_FLUSH(32 * (t >> 3), min(32, NB - 32 * (t >> 3)));
            }
            asm volatile("s_waitcnt lgkmcnt(0)" ::: "memory");
            f32x2 out2[16];
#pragma unroll
            for (int i = 0; i < 16; ++i) out2[i] = (f32x2){0.f, 0.f};
#pragma unroll 1
            for (int t = 0; 4 * t < NB; ++t) { const int j0 = NB + 4 * t;
                PE_ISS(0, bufD); PE_CONS_V(bufA, B0 + 4 * t);
                PE_ISS(1, bufA); PE_CONS_V(bufB, B0 + 4 * t + 1);
                PE_ISS(2, bufB); PE_CONS_V(bufC, B0 + 4 * t + 2);
                PE_ISS(3, bufC); PE_CONS_V(bufD, B0 + 4 * t + 3);
            }
#undef PE_ISS
#undef PE_ISSUE
#undef PE_CONS_U
#undef PE_FLUSH
#undef PE_DPPF
#undef PE_CONS_V
            f32x32 outv;
#pragma unroll
            for (int i = 0; i < 16; ++i) { outv[2 * i] = out2[i][0]; outv[2 * i + 1] = out2[i][1]; }
            if (split) {
                LAS float* pp = (LAS float*)(lds + PE_SCR) + ((size_t)((tl - nfull) * S + (w % S)) * 64 + lane) * 32;
#pragma unroll
                for (int i = 0; i < 8; ++i) { f32x4 t4; t4[0] = outv[4 * i]; t4[1] = outv[4 * i + 1]; t4[2] = outv[4 * i + 2]; t4[3] = outv[4 * i + 3]; *(LAS f32x4*)(pp + 4 * i) = t4; }
            }
            if (!split) {
            const int which = row < NLAT ? (row >> 13) : 2;
            const float* mg = mod + (size_t)which * 12288 + 5 * 2048;
            const bf16_t* xrow = X + (size_t)row * 2048;
            u32x4 xbv[4]; f32x4 gvv[8];
#pragma unroll
            for (int i = 0; i < 4; ++i) xbv[i] = *(const u32x4*)(xrow + lane * 32 + i * 8);
#pragma unroll
            for (int hh = 0; hh < 8; ++hh) gvv[hh] = *(const f32x4*)(mg + lane * 32 + hh * 4);
#pragma unroll
            for (int i = 0; i < 4; ++i) { const u32x4 xw = xbv[i]; const f32x4 g0 = gvv[2 * i], g1 = gvv[2 * i + 1];
                f32x4 o0, o1;
                o0[0] = bflo(xw.x) + g0[0] * outv[i * 8 + 0] * 0.25f; o0[1] = bfhi(xw.x) + g0[1] * outv[i * 8 + 1] * 0.25f; o0[2] = bflo(xw.y) + g0[2] * outv[i * 8 + 2] * 0.25f; o0[3] = bfhi(xw.y) + g0[3] * outv[i * 8 + 3] * 0.25f;
                o1[0] = bflo(xw.z) + g1[0] * outv[i * 8 + 4] * 0.25f; o1[1] = bfhi(xw.z) + g1[1] * outv[i * 8 + 5] * 0.25f; o1[2] = bflo(xw.w) + g1[2] * outv[i * 8 + 6] * 0.25f; o1[3] = bfhi(xw.w) + g1[3] * outv[i * 8 + 7] * 0.25f;
                if (l == 1) { float* orow = p->out + (size_t)row * 2048 + lane * 32 + i * 8; *(f32x4*)orow = o0; *(f32x4*)(orow + 4) = o1; }
                else { u32x4 ow; ow.x = pk2(o0[0], o0[1]); ow.y = pk2(o0[2], o0[3]); ow.z = pk2(o1[0], o1[1]); ow.w = pk2(o1[2], o1[3]); *(u32x4*)(X + (size_t)row * 2048 + lane * 32 + i * 8) = ow; } }
            }
            }
            if (split) {
                __syncthreads();
                if ((w % S) == 0 && tl < nt) {
                    const int row = tb + tl;
                    const int which = row < NLAT ? (row >> 13) : 2;
                    const float* mg = mod + (size_t)which * 12288 + 5 * 2048;
                    const bf16_t* xrow = X + (size_t)row * 2048;
                    const LAS float* pp = (const LAS float*)(lds + PE_SCR) + ((size_t)((tl - nfull) * S) * 64 + lane) * 32;
                    u32x4 xbv[4];
#pragma unroll
                    for (int i = 0; i < 4; ++i) xbv[i] = *(const u32x4*)(xrow + lane * 32 + i * 8);
#pragma unroll
                    for (int i = 0; i < 4; ++i) {
                        f32x4 a0 = *(const LAS f32x4*)(pp + i * 8), a1 = *(const LAS f32x4*)(pp + i * 8 + 4);
                        for (int q = 1; q < S; ++q) { a0 += *(const LAS f32x4*)(pp + (size_t)q * 64 * 32 + i * 8); a1 += *(const LAS f32x4*)(pp + (size_t)q * 64 * 32 + i * 8 + 4); }
                        const f32x4 g0 = *(const f32x4*)(mg + lane * 32 + i * 8), g1 = *(const f32x4*)(mg + lane * 32 + i * 8 + 4);
                        const u32x4 xw = xbv[i];
                        f32x4 o0, o1;
                        o0[0] = bflo(xw.x) + g0[0] * a0[0] * 0.25f; o0[1] = bfhi(xw.x) + g0[1] * a0[1] * 0.25f; o0[2] = bflo(xw.y) + g0[2] * a0[2] * 0.25f; o0[3] = bfhi(xw.y) + g0[3] * a0[3] * 0.25f;
                        o1[0] = bflo(xw.z) + g1[0] * a1[0] * 0.25f; o1[1] = bfhi(xw.z) + g1[1] * a1[1] * 0.25f; o1[2] = bflo(xw.w) + g1[2] * a1[2] * 0.25f; o1[3] = bfhi(xw.w) + g1[3] * a1[3] * 0.25f;
                        if (l == 1) { float* orow = p->out + (size_t)row * 2048 + lane * 32 + i * 8; *(f32x4*)orow = o0; *(f32x4*)(orow + 4) = o1; }
                        else { u32x4 ow; ow.x = pk2(o0[0], o0[1]); ow.y = pk2(o0[2], o0[3]); ow.z = pk2(o1[0], o1[1]); ow.w = pk2(o1[2], o1[3]); *(u32x4*)(X + (size_t)row * 2048 + lane * 32 + i * 8) = ow; }
                    }
                }
            }
        }
    }
}

#if !MK_SINGLE
#define LOHI_ARGS , const int lo, const int hi
#define LOHI_PASS , lo, hi
#else
#define LOHI_ARGS
#define LOHI_PASS
#endif
#ifndef PHM
#define PHM 0x7ff
#endif
#if MK_SINGLE
#define IN(k) (((PHM >> (((k) % NPH))) & 1) != 0)
#define SEAM(k) do { if ((k) + 1 < 2 * NPH) xcd_barrier(bar); } while (0)
#else
#define IN(k) (((PHM >> (((k) % NPH))) & 1) && lo <= (k) && (k) < hi)
#define SEAM(k) do { if (IN(k) && IN((k) + 1)) xcd_barrier(bar); } while (0)
#endif
template <int l>
__device__ __forceinline__ void layer_program(KP kp, unsigned char* ws0, LAS unsigned char* lds, const XcdBarrier& bar, const int G, const int wid0 LOHI_ARGS) {
        const int pb = l * NPH;
        const int M2 = (l == 0) ? MR : NLAT;
        constexpr int MG = NLAT;
        if (IN(pb + 0)) { phase_w(launder_p(kp), l, lds, wid0); } SEAM(pb + 0);
        if (IN(pb + 1)) { phase_norm(launder_p(kp), l, 0, MR, wid0); } SEAM(pb + 1);
        if (IN(pb + 2)) { unsigned char* ws = launder(ws0);
            { pg8::PlainOrder S; S.init(ws + WS_XN8, ws + WS_WIN, MR, (72 - (BF_HI - BF_LO)) * 256, 1024, G, (int)blockIdx.x); S.skip_from = BF_LO; S.skip_cnt = BF_HI - BF_LO; S.skip2_from = 48; S.skip2_cnt = 24;
              if (G == 256 && BF_HI - BF_LO == 8) { S.short_rounds = 15; S.n_long = 192; }
              pg8::EpiProj E{ws};
              pg8::gemm_phase<pg8::EpiProj, pg8::PlainOrder, true>(lds, 1024, S, E, wid0); }
            { pg8::PlainOrder S; S.init(ws + WS_XN, ws + WS_WINB, MR, (24 + BF_HI - BF_LO) * 256, 2048, G, G - 1 - (int)blockIdx.x); S.pn_base = BF_LO; S.skip_from = BF_HI; S.skip_cnt = 48 - BF_HI; S.b_compact = 1;
              pg8::EpiProj E{ws};
              pg8::gemm_phase<pg8::EpiProj, pg8::PlainOrder, false>(lds, 2048, S, E, wid0); }
        } SEAM(pb + 2);
        if (IN(pb + 3)) { phase_gates_gemm(launder_p(kp), l, wid0); phase_e1(launder_p(kp), l, wid0); } SEAM(pb + 3);
        if (IN(pb + 4)) { phase_mlstm(launder_p(kp), l, lds, wid0); phase_attn(launder_p(kp), l, lds, wid0); } SEAM(pb + 4);
        if (IN(pb + 5)) { phase_e2(launder_p(kp), l, M2, wid0); } SEAM(pb + 5);
        if (IN(pb + 6)) { unsigned char* ws = launder(ws0);
            pg8::BranchOrder S; S.T8 = (const char*)(ws + WS_T8); S.WA = (const char*)(ws + WS_WA);
            S.nM = MG / 256; S.nN = 8; S.G = G; S.c = (int)blockIdx.x; S.tstep = (size_t)256 * 2048 * 2;
            pg8::EpiMerge E{(bf16_t*)(ws + WS_Y), (const unsigned char*)(ws + WS_GT)};
            pg8::gemm_phase<pg8::EpiMerge, pg8::BranchOrder>(lds, 2048, S, E, wid0);
            if (l == 0) ctx_gemm<0>(launder_p(kp), l, lds, wid0);
        } SEAM(pb + 6);
        if (IN(pb + 7)) { unsigned char* ws = launder(ws0);
            pg8::PlainOrder S; S.init(ws + WS_Y, ws + WS_WO, MG, 2048, 2048, G, (int)blockIdx.x);
            if constexpr (l == 0) { pg8::EpiRes<true> E{(bf16_t*)(ws + WS_X), kp->x, (const float*)(ws + WS_MOD) + (size_t)l * 3 * 12288};
                pg8::gemm_phase<pg8::EpiRes<true>, pg8::PlainOrder>(lds, 2048, S, E, wid0); }
            else { pg8::EpiRes<false> E{(bf16_t*)(ws + WS_X), nullptr, (const float*)(ws + WS_MOD) + (size_t)l * 3 * 12288};
                pg8::gemm_phase<pg8::EpiRes<false>, pg8::PlainOrder>(lds, 2048, S, E, wid0); }
            if (l == 0) ctx_gemm<1>(launder_p(kp), l, lds, wid0);
        } SEAM(pb + 7);
        if (IN(pb + 8)) { phase_norm(launder_p(kp), l, 1, M2, wid0); } SEAM(pb + 8);
        if (IN(pb + 9)) { unsigned char* ws = launder(ws0);
            pg8::PlainOrder S; S.init(ws + WS_XN, ws + WS_WQ, MG, 2048, 2048, G, (int)blockIdx.x);
            pg8::EpiBf E{(bf16_t*)(ws + WS_PV), 2048};
            pg8::gemm_phase<pg8::EpiBf, pg8::PlainOrder>(lds, 2048, S, E, wid0);
            if (l == 0) ctx_gemm<2>(launder_p(kp), l, lds, wid0);
        } SEAM(pb + 9);
        if (IN(pb + 10)) { phase_peer(launder_p(kp), l, lds, wid0); } SEAM(pb + 10);
    }
#undef IN
#undef SEAM

__global__ void __launch_bounds__(NTHREADS, 2) fwd_kernel(Params p) {
    extern __shared__ __attribute__((aligned(16))) unsigned char lds_raw[];
    LAS unsigned char* lds = (LAS unsigned char*)lds_raw;
    const int tid = threadIdx.x, G = gridDim.x;
    const int wid0 = __builtin_amdgcn_readfirstlane(tid >> 6);
    KP kp = (KP)__builtin_amdgcn_kernarg_segment_ptr();
    unsigned char* ws0 = kp->ws;
    volatile LAS unsigned* bst = (volatile LAS unsigned*)(lds + LDS_BYTES - 16);
    if (tid == 0) { bst[0] = 0u; bst[1] = 0u; bst[2] = 0u; bst[3] = 0u; }
    __syncthreads();
    XcdBarrier bar; bar.bar = (unsigned*)(ws0 + WS_BAR); bar.x = 0; bar.st = bst;
    if (MK_SINGLE) bar = xcd_barrier_post((unsigned*)(ws0 + WS_BAR), bst);
#if !MK_SINGLE
    const int lo = kp->ph_lo, hi = kp->ph_hi;
#endif
    layer_program<0>(kp, ws0, lds, bar, G, wid0 LOHI_PASS);
    layer_program<1>(kp, ws0, lds, bar, G, wid0 LOHI_PASS);
}

extern "C" void kernel_launch(void* const* d_in, const int* in_sizes, int n_in, void* d_out, int out_size, void* d_ws, size_t ws_size, hipStream_t stream) {
    static int grid = 0;
    if (grid == 0) {
        if (n_in != 21 || in_sizes[0] != NLAT * DM || out_size != NLAT * DM || ws_size < WS_END) {
            fprintf(stderr, "kernel_launch: unexpected shapes (n_in %d, in0 %d, out %d, ws %zu need %zu); nothing launched\n", n_in, n_in > 0 ? in_sizes[0] : -1, out_size, ws_size, (size_t)WS_END); grid = -1; return; }
        int dev = 0, cus = 0, per_cu = 0;
        if (hipGetDevice(&dev) != hipSuccess || hipDeviceGetAttribute(&cus, hipDeviceAttributeMultiprocessorCount, dev) != hipSuccess) { grid = -1; return; }
        if (hipFuncSetAttribute((const void*)fwd_kernel, hipFuncAttributeMaxDynamicSharedMemorySize, LDS_BYTES) != hipSuccess) { fprintf(stderr, "kernel_launch: hipFuncSetAttribute failed\n"); grid = -1; return; }
        if (hipOccupancyMaxActiveBlocksPerMultiprocessor(&per_cu, (const void*)fwd_kernel, NTHREADS, LDS_BYTES) != hipSuccess || per_cu < 1) { fprintf(stderr, "kernel_launch: occupancy query says %d\n", per_cu); }
        (void)hipGetLastError();
        grid = cus;
    }
    if (grid < 0) return;
    (void)hipMemsetAsync((char*)d_ws, 0, 16384, stream);
    Params p{};
    const float** pp = (const float**)&p;
    for (int i = 0; i < 21; ++i) pp[i] = (const float*)d_in[i];
    p.out = (float*)d_out; p.ws = (unsigned char*)d_ws;
#if MK_SINGLE
    p.ph_lo = 0; p.ph_hi = 2 * NPH;
    hipLaunchKernelGGL(fwd_kernel, dim3(grid), dim3(NTHREADS), LDS_BYTES, stream, p);
#else
    for (int k = 0; k < 2 * NPH; ++k) { p.ph_lo = k; p.ph_hi = k + 1; hipLaunchKernelGGL(fwd_kernel, dim3(grid), dim3(NTHREADS), LDS_BYTES, stream, p); }
#endif
}
```

```cpp
#include <hip/hip_runtime.h>
#include <stdint.h>
#include <stdio.h>
#include <type_traits>

#ifndef BF_LO
#define BF_LO 0
#define BF_HI 8
#endif
#ifndef MK_SINGLE
#define MK_SINGLE 1
#endif

#define LAS __attribute__((address_space(3)))
typedef unsigned short bf16_t;
typedef short bf16x8 __attribute__((ext_vector_type(8)));
typedef float f32x4 __attribute__((ext_vector_type(4)));
typedef float f32x2 __attribute__((ext_vector_type(2)));
typedef unsigned u32x4 __attribute__((ext_vector_type(4)));
typedef unsigned u32x2 __attribute__((ext_vector_type(2)));
typedef __bf16 bf2_t __attribute__((ext_vector_type(2)));
typedef int i32x4 __attribute__((ext_vector_type(4)));
typedef int i32x8 __attribute__((ext_vector_type(8)));
typedef float f32x16 __attribute__((ext_vector_type(16)));
typedef float f32x32 __attribute__((ext_vector_type(32)));
typedef unsigned u32x6 __attribute__((ext_vector_type(6)));
typedef __bf16 bf16x32_t __attribute__((ext_vector_type(32)));
typedef unsigned u32x16 __attribute__((ext_vector_type(16)));
typedef short s16x4 __attribute__((ext_vector_type(4)));
#ifndef FP6_INTERLEAVED
#define FP6_INTERLEAVED 1
#endif

constexpr int DM = 2048, NBATCH = 2, SEQ = 8192, CTXL = 256;
constexpr int NLAT = NBATCH * SEQ;
constexpr int NCTX = NBATCH * CTXL;
constexpr int MR = NLAT + NCTX;
constexpr int PROJ_W = 24608;
constexpr int NPROJ = 24576;
constexpr int NTHREADS = 512;
constexpr int LDS_BYTES = 163840;
constexpr int NPH = 11;
constexpr float EPSF = 1e-6f;

constexpr size_t SZ_A = (size_t)MR * 2048 * 2;
constexpr size_t WS_BAR = 0;
constexpr size_t WS_MOD = 16384;
constexpr size_t CTL_BYTES = 16384 + 2 * 3 * 12288 * 4;
constexpr size_t WS_TAB = 311296;
constexpr size_t WS_X = WS_TAB + 32768;
constexpr size_t WS_XN = WS_X + (size_t)MR * 2048 * 4;
constexpr size_t WS_Y = WS_XN + SZ_A;
constexpr size_t WS_XN8 = WS_Y;
constexpr size_t WS_PQ = WS_Y + SZ_A;
constexpr size_t WS_PK = WS_PQ + SZ_A / 2;
constexpr size_t WS_T8 = WS_PK + SZ_A / 2;
constexpr size_t WS_PV = WS_T8 + 0 * SZ_A;
constexpr size_t WS_PO = WS_T8 + 1 * SZ_A;
constexpr size_t WS_CQ = WS_T8 + 2 * SZ_A;
constexpr size_t WS_CK = WS_T8 + 3 * SZ_A;
constexpr size_t WS_CV = WS_T8 + 4 * SZ_A;
constexpr size_t WS_BB = WS_T8 + 5 * SZ_A;
constexpr size_t WS_BC = WS_T8 + 6 * SZ_A;
constexpr size_t WS_BX = WS_T8 + 7 * SZ_A;
constexpr size_t WS_GT = WS_T8 + 8 * SZ_A;
constexpr size_t WS_GATES = WS_GT + 3 * SZ_A;
constexpr size_t WS_WIN = WS_GATES + (size_t)MR * 32 * 4;
constexpr size_t WS_WINB = WS_WIN + (size_t)NPROJ * 2048;
constexpr size_t WS_WG = WS_WIN + (size_t)NPROJ * 2048 * 2;
constexpr size_t SZ_W = (size_t)2048 * 2048 * 2;
constexpr size_t WS_WA = WS_WG + 32 * 2048 * 2;
constexpr size_t WS_WB = WS_WA + SZ_W;
constexpr size_t WS_WC = WS_WB + SZ_W;
constexpr size_t WS_WO = WS_WC + SZ_W;
constexpr size_t WS_WQ = WS_WO + SZ_W;
constexpr size_t WS_KEYS = WS_WQ + SZ_W;
constexpr size_t WS_PU = WS_KEYS + 16 * 128 * 128 * 2;
constexpr size_t WS_PVW = WS_PU + (size_t)16384 * 2048 * 2;
constexpr size_t WS_SCAN = WS_PU + (size_t)16384 * 1024;
constexpr size_t WS_END = WS_PVW + (size_t)16384 * 2048 * 2;

struct Params {
    const float *x, *c, *ctx, *c_ctx, *w_ada, *b_ada, *norm_g, *w_in, *a_gate_b, *a_hnorm_g, *b_conv, *c_qk_g, *c_rpb,
        *w_a_out, *w_b_out, *w_c_out, *w_out, *peer_wq, *peer_keys, *peer_u, *peer_v;
    float* out; unsigned char* ws; int ph_lo, ph_hi;
};
#define CAS __attribute__((address_space(4)))
#define GAS __attribute__((address_space(1)))
typedef const CAS Params* KP;
__device__ __forceinline__ KP launder_p(KP q) { asm volatile("" : "+s"(q)); return q; }

__device__ __forceinline__ unsigned char* launder(unsigned char* q) { size_t z = 0; asm volatile("" : "+s"(z)); return q + z; }
__device__ __forceinline__ int tid_fresh(int wid0) { int t = wid0 * 64 + (int)__builtin_amdgcn_mbcnt_hi(~0u, __builtin_amdgcn_mbcnt_lo(~0u, 0u)); asm volatile("" : "+v"(t)); return t; }

__device__ __forceinline__ float bf2f(unsigned b) { return __uint_as_float(b << 16); }
__device__ __forceinline__ float bflo(unsigned w) { return __uint_as_float(w << 16); }
__device__ __forceinline__ float bfhi(unsigned w) { return __uint_as_float(w & 0xffff0000u); }
__device__ __forceinline__ unsigned pk2(float lo, float hi) { f32x2 v = {lo, hi}; bf2_t b = __builtin_convertvector(v, bf2_t); return __builtin_bit_cast(unsigned, b); }
__device__ __forceinline__ bf16_t f2bf(float f) { return (bf16_t)(pk2(f, 0.f) & 0xffffu); }
__device__ __forceinline__ f32x4 mfma16(bf16x8 a, bf16x8 b, f32x4 c) { return __builtin_amdgcn_mfma_f32_16x16x32_bf16(a, b, c, 0, 0, 0); }
__device__ __forceinline__ float dot2bf(unsigned a, unsigned b, float c) { return __builtin_amdgcn_fdot2_f32_bf16(__builtin_bit_cast(bf2_t, a), __builtin_bit_cast(bf2_t, b), c, false); }
#define LDS_BARRIER() do { asm volatile("s_waitcnt lgkmcnt(0)" ::: "memory"); __builtin_amdgcn_s_barrier(); asm volatile("" ::: "memory"); } while (0)
__device__ __forceinline__ float rlane(float v, int l) { return __uint_as_float((unsigned)__builtin_amdgcn_readlane((int)__float_as_uint(v), l)); }
__device__ __forceinline__ float wave_sum(float v) {
#pragma unroll
    for (int o = 32; o >= 1; o >>= 1) v += __shfl_xor(v, o);
    return v;
}
__device__ __forceinline__ float sigmoidf_(float v) { return __builtin_amdgcn_rcpf(1.0f + __expf(-v)); }
__device__ __forceinline__ float logsigmoidf_(float v) { return fminf(v, 0.f) - log1pf(__expf(-fabsf(v))); }

#define XB_TMO      128
#define XB_XCNT(j)  (256  + 64 * (j))
#define XB_XSUB(j)  (1280 + 64 * (j))
#define XB_XGEN(j)  (2304 + 64 * (j))
#define XB_TOP      3328
#define XB_TOPGEN   3392
#define XCD_BAR_WORDS 3456
#define XB_SPIN_CAP (1u << 22)
__device__ __forceinline__ unsigned xb_ld(unsigned* p)              { return __hip_atomic_load(p, __ATOMIC_RELAXED, __HIP_MEMORY_SCOPE_AGENT); }
__device__ __forceinline__ unsigned xb_add(unsigned* p, unsigned v) { return __hip_atomic_fetch_add(p, v, __ATOMIC_RELAXED, __HIP_MEMORY_SCOPE_AGENT); }
__device__ __forceinline__ unsigned xb_xcc_id() { return (unsigned)__builtin_amdgcn_s_getreg((3 << 11) | 20) & 0xFu; }
#define XB_SPIN(cond, bar) do { unsigned _sp = 0; while (cond) { __builtin_amdgcn_s_sleep(1); \
    if ((++_sp & 255u) == 0u) { if (xb_ld(&(bar)[XB_TMO])) break; if (_sp > XB_SPIN_CAP) { atomicAdd(&(bar)[XB_TMO], 1u); break; } } } } while (0)
struct XcdBarrier { unsigned* bar; unsigned x; volatile LAS unsigned* st; };
__device__ __forceinline__ XcdBarrier xcd_barrier_post(unsigned* bar, volatile LAS unsigned* st) {
    XcdBarrier b; b.bar = bar; b.x = xb_xcc_id(); b.st = st;
    if (threadIdx.x == 0) (void)xb_add(&bar[XB_XCNT(b.x)], 1u);
    return b;
}
__device__ __forceinline__ void xcd_barrier_complete(unsigned* bar, unsigned x, unsigned& nloc, unsigned& nx) {
    const unsigned G = gridDim.x * gridDim.y * gridDim.z;
    unsigned sum, cnt, mine, sp = 0u;
    for (;;) {
        sum = 0u; cnt = 0u; mine = 0u;
#pragma unroll
        for (unsigned j = 0; j < 16; ++j) { const unsigned c = xb_ld(&bar[XB_XCNT(j)]); sum += c; cnt += (c > 0u) ? 1u : 0u; mine = (j == x) ? c : mine; }
        if (sum == G) break;
        __builtin_amdgcn_s_sleep(1);
        if ((++sp & 255u) == 0u) { if (xb_ld(&bar[XB_TMO])) break; if (sp > XB_SPIN_CAP) { atomicAdd(&bar[XB_TMO], 1u); break; } }
    }
    nloc = mine > 0u ? mine : 1u; nx = cnt > 0u ? cnt : 1u;
}
__device__ __forceinline__ void xcd_barrier(const XcdBarrier& b) {
    asm volatile("s_waitcnt vmcnt(0)" ::: "memory");
    __syncthreads();
    if (threadIdx.x == 0) {
        unsigned* bar = b.bar;
        __builtin_amdgcn_s_waitcnt(0);
        unsigned nloc = b.st[0], nx = b.st[1];
        if (nloc == 0u) { xcd_barrier_complete(bar, b.x, nloc, nx); b.st[0] = nloc; b.st[1] = nx; }
        const unsigned old = xb_add(&bar[XB_XSUB(b.x)], 1u);
        const unsigned gen = old / nloc;
        if (old + 1u == (gen + 1u) * nloc) {
            __builtin_amdgcn_fence(__ATOMIC_RELEASE, "agent");
            asm volatile("s_waitcnt vmcnt(0)" ::: "memory");
            const unsigned og = xb_add(&bar[XB_TOP], 1u);
            const unsigned tg = og / nx;
            if (og + 1u == (tg + 1u) * nx) xb_add(&bar[XB_TOPGEN], 1u);
            else XB_SPIN(xb_ld(&bar[XB_TOPGEN]) == tg, bar);
            __builtin_amdgcn_fence(__ATOMIC_ACQUIRE, "agent");
            xb_add(&bar[XB_XGEN(b.x)], 1u);
            asm volatile("s_waitcnt vmcnt(0)" ::: "memory");
        } else {
            XB_SPIN(xb_ld(&bar[XB_XGEN(b.x)]) == gen, bar);
            __builtin_amdgcn_fence(__ATOMIC_ACQUIRE, "agent");
            asm volatile("s_waitcnt vmcnt(0)" ::: "memory");
        }
    }
    __syncthreads();
}

namespace pg8 {
constexpr int BM = 256, BK = 64, HALF = 128, HTB = HALF * BK * 2, STAGE_BYTES = 8 * HTB, NXCD = 8, WGM = 8;
__host__ __device__ __forceinline__ int lds_byte(int r, int c) { const int st = (r >> 4) * 2 + (c >> 5), rr = r & 15, cc = c & 31, ob = rr * 64 + cc * 2; return st * 1024 + (ob ^ (((ob >> 9) & 1) << 5)); }
__host__ __device__ __forceinline__ void stage_rc(int b, int& R, int& C) { const int st = b / 1024, sb = b % 1024, swz = sb ^ (((sb >> 9) & 1) << 5); R = (st >> 1) * 16 + swz / 64; C = (st & 1) * 32 + (swz % 64) / 2; }
__host__ __device__ __forceinline__ int perm32(int rho) { const int n = rho >> 4, i = rho & 15; return 8 * (i >> 2) + 4 * n + (i & 3); }

struct Unit { int pm, pn, br; const char* A; const char* B; };

__device__ __forceinline__ bool tile_of(int L, int nM, int nN, int& pm, int& pn) {
    const int nwg = nM * nN; if (L >= nwg) return false;
    int wgid = L; { const int q = nwg / NXCD, r = nwg % NXCD, xcd = wgid % NXCD, off = wgid / NXCD; wgid = (xcd < r ? xcd * (q + 1) : r * (q + 1) + (xcd - r) * q) + off; }
    const int nig = WGM * nN, gid = wgid / nig, fm = gid * WGM, gsz = (nM - fm) < WGM ? (nM - fm) : WGM;
    pm = fm + ((wgid % nig) % gsz); pn = (wgid % nig) / gsz; return true;
}
struct PlainOrder {
    const char* A; const char* Bt; int nM, nN, G, c; size_t tstep; int pn_base, skip_from, skip_cnt, skip2_from, skip2_cnt, b_row0, b_compact, short_rounds, n_long;
    __device__ __forceinline__ void init(const void* A_, const void* Bt_, int M, int N, int K, int G_, int c_) { A = (const char*)A_; Bt = (const char*)Bt_; nM = M / BM; nN = N / BM; G = G_; c = c_; tstep = (size_t)BM * K * 2;
        pn_base = 0; skip_from = 1 << 30; skip_cnt = 0; skip2_from = 1 << 30; skip2_cnt = 0; b_row0 = 0; b_compact = 0; short_rounds = 1 << 30; n_long = 0; }
    __device__ __forceinline__ bool next(int i, Unit& u) const {
        int L = i * G + c;
        if (i >= short_rounds) { if (c >= n_long) return false; const int per = (nM * nN - short_rounds * G) / n_long, j = i - short_rounds; if (j >= per) return false; L = short_rounds * G + per * c + j; }
        int pm, pn; if (!tile_of(L, nM, nN, pm, pn)) return false;
        const int pnc = pn;
        pn += pn_base; if (pn >= skip_from) pn += skip_cnt; if (pn >= skip2_from) pn += skip2_cnt;
        u.pm = pm; u.pn = pn; u.br = 0; u.A = A + (size_t)pm * tstep; u.B = Bt + (size_t)(b_compact ? pnc : pn - b_row0) * tstep; return true;
    }
};
struct BranchOrder {
    const char* T8; const char* WA; int nM, nN, G, c; size_t tstep;
    __device__ __forceinline__ bool next(int i, Unit& u) const {
        const int tl = i / 3, br = i - 3 * tl; int pm, pn; if (!tile_of(tl * G + c, nM, nN, pm, pn)) return false;
        u.pm = pm; u.pn = pn; u.br = br;
        const int ti = 1 + 4 * (br == 1) + (br == 2);
        u.A = T8 + (size_t)ti * SZ_A + (size_t)pm * tstep; u.B = WA + (size_t)br * SZ_W + (size_t)pn * tstep; return true;
    }
};

template <class Epi, class Sched, bool FP8 = false>
__device__ __forceinline__ void gemm_phase(LAS unsigned char* lds, const int K, const Sched& S, const Epi& E, int wid0) {
    const int tid = tid_fresh(wid0), wid = __builtin_amdgcn_readfirstlane(tid >> 6), lane = tid & 63, wr = wid >> 2, wc = wid & 3, fr = lane & 15, fq = lane >> 4;
    const int nt = K / BK;
    unsigned voffA[2], voffB[2];
#pragma unroll
    for (int i = 0; i < 2; ++i) { int R, C; stage_rc(tid * 16 + i * 8192, R, C); const int Rb = Epi::PERM ? ((R & ~31) + perm32(R & 31)) : R;
        voffA[i] = (unsigned)(R * K + C) * 2u; voffB[i] = (unsigned)(Rb * K + C) * 2u; }
    const size_t kstep = (size_t)(BK * 2);
    const size_t hstep = (size_t)HALF * K * 2;
    const unsigned ldsw = (unsigned)wid * 1024u;
    const int aoff = lds_byte(wr * 64 + fr, fq * 8), boff = lds_byte(wc * 32 + fr, fq * 8);
#define PG8_SA(b, h) (((b) * 2 + (h)) * HTB)
#define PG8_SB(b, h) ((4 + (b) * 2 + (h)) * HTB)
#define PG8_STAGE(bufoff, gbase, voff) do { _Pragma("unroll") for (int _i = 0; _i < 2; ++_i) \
        __builtin_amdgcn_global_load_lds((const unsigned*)((const char*)(gbase) + (voff)[_i]), (LAS unsigned*)(lds + (bufoff) + ldsw + _i * 8192), 16, 0, 0); } while (0)
#define PG8_LD1(dstv, addr) do { if constexpr (FP8) { const i32x4 _lo = *(const LAS i32x4*)(lds + (addr)), _hi = *(const LAS i32x4*)(lds + (addr) + 1024); dstv[0] = __builtin_shufflevector(_lo, _hi, 0, 1, 2, 3, 4, 5, 6, 7); } \
        else { _Pragma("unroll") for (int k = 0; k < 2; ++k) dstv[k] = *(const LAS bf16x8*)(lds + (addr) + k * 1024); } } while (0)
#define PG8_LDA(dst, b, h) do { _Pragma("unroll") for (int m = 0; m < 4; ++m) PG8_LD1(dst[m], PG8_SA(b, h) + aoff + m * 2048); } while (0)
#define PG8_LDB(dst, b, h) do { _Pragma("unroll") for (int n = 0; n < 2; ++n) PG8_LD1(dst[n], PG8_SB(b, h) + boff + n * 2048); } while (0)
#define PG8_MMA(ai, bj, At, Bt) do { __builtin_amdgcn_s_setprio(1); _Pragma("unroll") for (int m = 0; m < 4; ++m) _Pragma("unroll") for (int n = 0; n < 2; ++n) { \
        if constexpr (FP8) asm volatile("v_mfma_scale_f32_16x16x128_f8f6f4 %0, %1, %2, %0, %3, %4 op_sel_hi:[0,0,0]" : "+v"(acc[ai][bj][m][n]) : "v"(Bt[n][0]), "v"(At[m][0]), "v"(sclW), "v"(sclX)); \
        else { _Pragma("unroll") for (int k = 0; k < 2; ++k) acc[ai][bj][m][n] = __builtin_amdgcn_mfma_f32_16x16x32_bf16(Bt[n][k], At[m][k], acc[ai][bj][m][n], 0, 0, 0); } } \
        __builtin_amdgcn_s_setprio(0); } while (0)
#define PG8_WAIT_V(n) asm volatile("s_waitcnt vmcnt(" #n ")" ::: "memory")
#define PG8_WAIT_L(n) asm volatile("s_waitcnt lgkmcnt(" #n ")" ::: "memory")
#define PG8_BAR __builtin_amdgcn_s_barrier()
#define PG8_SCHED __builtin_amdgcn_sched_barrier(0)
    Unit cur, nxt; int ui = 0;
    if (!S.next(0, cur)) return;
    const int sclW = 0x75757575, sclX = 0x7F7F7F7F;
    f32x4 acc[2][2][4][2];
#pragma unroll
    for (int a = 0; a < 2; ++a)
#pragma unroll
        for (int b = 0; b < 2; ++b)
#pragma unroll
            for (int m = 0; m < 4; ++m)
#pragma unroll
                for (int n = 0; n < 2; ++n) acc[a][b][m][n] = (f32x4){0.f, 0.f, 0.f, 0.f};
    typedef typename std::conditional<FP8, i32x8, bf16x8>::type frag_t;
    frag_t At[4][FP8 ? 1 : 2], B0[2][FP8 ? 1 : 2], B1[2][FP8 ? 1 : 2];
    const char* cA = cur.A; const char* cB = cur.B;
    PG8_STAGE(PG8_SB(0, 0), cB, voffB); PG8_STAGE(PG8_SA(0, 0), cA, voffA); PG8_STAGE(PG8_SB(0, 1), cB + hstep, voffB); PG8_STAGE(PG8_SA(0, 1), cA + hstep, voffA);
    if (wr == 1) PG8_BAR;
    PG8_WAIT_V(4); PG8_BAR;
    PG8_STAGE(PG8_SB(1, 0), cB + kstep, voffB); PG8_STAGE(PG8_SA(1, 0), cA + kstep, voffA); PG8_STAGE(PG8_SB(1, 1), cB + hstep + kstep, voffB);
    PG8_WAIT_V(6); PG8_BAR;
    for (;;) {
        const bool has_next = S.next(ui + 1, nxt);
        const char* nA = has_next ? nxt.A : cA; const char* nB = has_next ? nxt.B : cB;
        for (int t = 0; t < nt; t += 2) {
            const bool last = (t == nt - 2);
            const char* a1 = cA + (size_t)(t + 1) * kstep;
            const char* a2 = last ? nA : cA + (size_t)(t + 2) * kstep; const char* b2 = last ? nB : cB + (size_t)(t + 2) * kstep;
            const char* a3 = a2 + kstep; const char* b3 = b2 + kstep;
            PG8_LDB(B0, 0, 0); PG8_SCHED; PG8_LDA(At, 0, 0); PG8_STAGE(PG8_SA(1, 1), a1 + hstep, voffA);
            PG8_WAIT_L(8); PG8_BAR; PG8_WAIT_L(0); PG8_MMA(0, 0, At, B0); PG8_BAR; PG8_SCHED;
            PG8_LDB(B1, 0, 1); PG8_STAGE(PG8_SB(0, 0), b2, voffB);
            PG8_BAR; PG8_WAIT_L(0); PG8_MMA(0, 1, At, B1); PG8_BAR;
            PG8_LDA(At, 0, 1); PG8_STAGE(PG8_SA(0, 0), a2, voffA);
            PG8_BAR; PG8_WAIT_L(0); PG8_MMA(1, 0, At, B0); PG8_BAR; PG8_SCHED;
            PG8_STAGE(PG8_SB(0, 1), b2 + hstep, voffB);
            PG8_WAIT_V(6); PG8_BAR; PG8_MMA(1, 1, At, B1); PG8_BAR;
            PG8_LDB(B0, 1, 0); PG8_SCHED; PG8_LDA(At, 1, 0); PG8_STAGE(PG8_SA(0, 1), a2 + hstep, voffA);
            PG8_WAIT_L(8); PG8_BAR; PG8_WAIT_L(0); PG8_MMA(0, 0, At, B0); PG8_BAR; PG8_SCHED;
            PG8_LDB(B1, 1, 1); PG8_STAGE(PG8_SB(1, 0), b3, voffB);
            PG8_BAR; PG8_WAIT_L(0); PG8_MMA(0, 1, At, B1); PG8_BAR;
            PG8_LDA(At, 1, 1); PG8_STAGE(PG8_SA(1, 0), a3, voffA);
            PG8_BAR; PG8_WAIT_L(0); PG8_MMA(1, 0, At, B0); PG8_BAR; PG8_SCHED;
            PG8_STAGE(PG8_SB(1, 1), b3 + hstep, voffB);
            PG8_WAIT_V(6); PG8_BAR; PG8_MMA(1, 1, At, B1); PG8_BAR;
        }
        if constexpr (FP8) { asm volatile("s_nop 15\n\ts_nop 15\n\ts_nop 15" ::: "memory"); }
        E(acc, cur, wr, wc, fr, fq);
        if (!has_next) break;
#pragma unroll
        for (int a = 0; a < 2; ++a)
#pragma unroll
            for (int b = 0; b < 2; ++b)
#pragma unroll
                for (int m = 0; m < 4; ++m)
#pragma unroll
                    for (int n = 0; n < 2; ++n) acc[a][b][m][n] = (f32x4){0.f, 0.f, 0.f, 0.f};
        cur = nxt; cA = nA; cB = nB; ++ui;
    }
    PG8_WAIT_V(0);
    if (wr == 0) PG8_BAR;
    PG8_BAR;
#undef PG8_SA
#undef PG8_SB
#undef PG8_STAGE
#undef PG8_LD1
#undef PG8_LDA
#undef PG8_LDB
#undef PG8_MMA
#undef PG8_WAIT_V
#undef PG8_WAIT_L
#undef PG8_BAR
#undef PG8_SCHED
}

struct EpiProj {
    static constexpr bool PERM = true;
    unsigned char* ws;
    __device__ __forceinline__ void operator()(const f32x4 (&acc)[2][2][4][2], const Unit& u, int wr, int wc, int fr, int fq) const {
        const int pn = u.pn; size_t off; int ld, c0;
        if (pn < 4) { off = WS_PQ; ld = 1024; c0 = pn * 256; }
        else if (pn < 8) { off = WS_PK; ld = 1024; c0 = (pn - 4) * 256; }
        else if (pn < 72) { const int t = (pn - 8) >> 3; off = WS_T8 + (size_t)t * SZ_A; ld = 2048; c0 = ((pn - 8) & 7) * 256; }
        else {
            GAS unsigned char* gp = (GAS unsigned char*)ws + WS_GT + (size_t)(u.pm * BM + wr * 64 + fr) * 6144 + (pn - 72) * 256 + wc * 32 + 8 * fq;
#pragma unroll
            for (int ai = 0; ai < 2; ++ai) {
#pragma unroll
                for (int m = 0; m < 4; ++m) {
                    asm volatile("" : "+v"(gp));
#pragma unroll
                    for (int bj = 0; bj < 2; ++bj) { const f32x4 v0 = acc[ai][bj][m][0], v1 = acc[ai][bj][m][1];
                        unsigned q[8];
#pragma unroll
                        for (int j = 0; j < 4; ++j) { q[j] = (unsigned)(sigmoidf_(v0[j]) * 255.0f + 0.5f); q[4 + j] = (unsigned)(sigmoidf_(v1[j]) * 255.0f + 0.5f); }
                        u32x2 w; w.x = q[0] | (q[1] << 8) | (q[2] << 16) | (q[3] << 24); w.y = q[4] | (q[5] << 8) | (q[6] << 16) | (q[7] << 24);
                        *(GAS u32x2*)(gp + bj * HALF) = w; }
                    gp += (size_t)16 * 6144;
                }
                gp += (size_t)64 * 6144;
            }
            return;
        }
        GAS bf16_t* rp = (GAS bf16_t*)(ws + off) + (size_t)(u.pm * BM + wr * 64 + fr) * ld + c0 + wc * 32 + 8 * fq;
        const size_t step = (size_t)16 * ld;
#pragma unroll
        for (int ai = 0; ai < 2; ++ai) {
#pragma unroll
            for (int m = 0; m < 4; ++m) {
                asm volatile("" : "+v"(rp));
#pragma unroll
                for (int bj = 0; bj < 2; ++bj) { const f32x4 v0 = acc[ai][bj][m][0], v1 = acc[ai][bj][m][1];
                    u32x4 w; w.x = pk2(v0[0], v0[1]); w.y = pk2(v0[2], v0[3]); w.z = pk2(v1[0], v1[1]); w.w = pk2(v1[2], v1[3]);
                    *(GAS u32x4*)(rp + bj * HALF) = w; }
                rp += step;
            }
            rp += 4 * step;
        }
    }
};
struct EpiBf {
    static constexpr bool PERM = true;
    bf16_t* O; int ld;
    __device__ __forceinline__ void operator()(const f32x4 (&acc)[2][2][4][2], const Unit& u, int wr, int wc, int fr, int fq) const {
        const int row0 = u.pm * BM + wr * 64 + fr, col0 = u.pn * BM + wc * 32 + 8 * fq;
#pragma unroll
        for (int ai = 0; ai < 2; ++ai)
#pragma unroll
            for (int m = 0; m < 4; ++m) { bf16_t* rowp = O + (size_t)(row0 + ai * HALF + m * 16) * ld + col0;
#pragma unroll
                for (int bj = 0; bj < 2; ++bj) { const f32x4 v0 = acc[ai][bj][m][0], v1 = acc[ai][bj][m][1];
                    u32x4 w; w.x = pk2(v0[0], v0[1]); w.y = pk2(v0[2], v0[3]); w.z = pk2(v1[0], v1[1]); w.w = pk2(v1[2], v1[3]);
                    *(u32x4*)(rowp + bj * HALF) = w; } }
    }
};
__device__ __forceinline__ float gq8(unsigned w, int i) { return (float)((w >> (8 * i)) & 0xffu); }
struct EpiMerge {
    static constexpr bool PERM = true;
    bf16_t* Y; const unsigned char* GT;
    __device__ __forceinline__ void operator()(const f32x4 (&acc)[2][2][4][2], const Unit& u, int wr, int wc, int fr, int fq) const {
        const int row0 = u.pm * BM + wr * 64 + fr, col0 = u.pn * BM + wc * 32 + 8 * fq;
        const bool addy = u.br != 0;
#pragma unroll
        for (int ai = 0; ai < 2; ++ai) {
            u32x2 g[4][2]; u32x4 y[4][2];
#pragma unroll
            for (int m = 0; m < 4; ++m)
#pragma unroll
                for (int bj = 0; bj < 2; ++bj) { const size_t r = (size_t)(row0 + ai * HALF + m * 16);
                    g[m][bj] = *(const u32x2*)(GT + r * 6144 + (size_t)u.br * 2048 + col0 + bj * HALF); }
            if (addy) {
#pragma unroll
                for (int m = 0; m < 4; ++m)
#pragma unroll
                    for (int bj = 0; bj < 2; ++bj) { const size_t r = (size_t)(row0 + ai * HALF + m * 16); y[m][bj] = *(const u32x4*)(Y + r * 2048 + col0 + bj * HALF); }
            } else {
#pragma unroll
                for (int m = 0; m < 4; ++m)
#pragma unroll
                    for (int bj = 0; bj < 2; ++bj) y[m][bj] = (u32x4){0u, 0u, 0u, 0u};
            }
#pragma unroll
            for (int m = 0; m < 4; ++m)
#pragma unroll
                for (int bj = 0; bj < 2; ++bj) { const size_t r = (size_t)(row0 + ai * HALF + m * 16);
                    const f32x4 v0 = acc[ai][bj][m][0] * (1.0f / 255.0f), v1 = acc[ai][bj][m][1] * (1.0f / 255.0f); const u32x2 gg = g[m][bj]; const u32x4 yy = y[m][bj];
                    float o[8];
                    o[0] = gq8(gg.x, 0) * v0[0] + bflo(yy.x); o[1] = gq8(gg.x, 1) * v0[1] + bfhi(yy.x); o[2] = gq8(gg.x, 2) * v0[2] + bflo(yy.y); o[3] = gq8(gg.x, 3) * v0[3] + bfhi(yy.y);
                    o[4] = gq8(gg.y, 0) * v1[0] + bflo(yy.z); o[5] = gq8(gg.y, 1) * v1[1] + bfhi(yy.z); o[6] = gq8(gg.y, 2) * v1[2] + bflo(yy.w); o[7] = gq8(gg.y, 3) * v1[3] + bfhi(yy.w);
                    u32x4 w; w.x = pk2(o[0], o[1]); w.y = pk2(o[2], o[3]); w.z = pk2(o[4], o[5]); w.w = pk2(o[6], o[7]);
                    *(u32x4*)(Y + r * 2048 + col0 + bj * HALF) = w; }
        }
    }
};
template <bool XF32> struct EpiRes {
    static constexpr bool PERM = true;
    bf16_t* X; const float* Xf; const float* mod;
    __device__ __forceinline__ void operator()(const f32x4 (&acc)[2][2][4][2], const Unit& u, int wr, int wc, int fr, int fq) const {
        const int row0 = u.pm * BM + wr * 64 + fr, col0 = u.pn * BM + wc * 32 + 8 * fq;
        const int which = (u.pm < 32) ? 0 : (u.pm < 64 ? 1 : 2);
        const float* mg = mod + (size_t)which * 12288 + 2 * 2048 + col0;
        f32x4 gv[2][2];
#pragma unroll
        for (int bj = 0; bj < 2; ++bj)
#pragma unroll
            for (int n = 0; n < 2; ++n) gv[bj][n] = *(const f32x4*)(mg + bj * HALF + n * 4);
#pragma unroll
        for (int ai = 0; ai < 2; ++ai) {
            if constexpr (XF32) {
#pragma unroll
              for (int mh = 0; mh < 2; ++mh) {
                f32x4 xin[2][2][2];
#pragma unroll
                for (int m = 0; m < 2; ++m)
#pragma unroll
                    for (int bj = 0; bj < 2; ++bj)
#pragma unroll
                        for (int n = 0; n < 2; ++n) xin[m][bj][n] = *(const f32x4*)(Xf + (size_t)(row0 + ai * HALF + (2 * mh + m) * 16) * 2048 + col0 + bj * HALF + n * 4);
#pragma unroll
                for (int m = 0; m < 2; ++m)
#pragma unroll
                    for (int bj = 0; bj < 2; ++bj) {
                        const f32x4 o0 = xin[m][bj][0] + gv[bj][0] * acc[ai][bj][2 * mh + m][0], o1 = xin[m][bj][1] + gv[bj][1] * acc[ai][bj][2 * mh + m][1];
                        u32x4 ow; ow.x = pk2(o0[0], o0[1]); ow.y = pk2(o0[2], o0[3]); ow.z = pk2(o1[0], o1[1]); ow.w = pk2(o1[2], o1[3]);
                        *(u32x4*)(X + (size_t)(row0 + ai * HALF + (2 * mh + m) * 16) * 2048 + col0 + bj * HALF) = ow; }
              }
            } else {
                u32x4 xb[4][2];
#pragma unroll
                for (int m = 0; m < 4; ++m)
#pragma unroll
                    for (int bj = 0; bj < 2; ++bj) xb[m][bj] = *(const u32x4*)(X + (size_t)(row0 + ai * HALF + m * 16) * 2048 + col0 + bj * HALF);
#pragma unroll
                for (int m = 0; m < 4; ++m)
#pragma unroll
                    for (int bj = 0; bj < 2; ++bj) { const u32x4 xw = xb[m][bj]; const f32x4 a0 = acc[ai][bj][m][0], a1 = acc[ai][bj][m][1], g0 = gv[bj][0], g1 = gv[bj][1];
                        u32x4 ow; ow.x = pk2(bflo(xw.x) + g0[0] * a0[0], bfhi(xw.x) + g0[1] * a0[1]); ow.y = pk2(bflo(xw.y) + g0[2] * a0[2], bfhi(xw.y) + g0[3] * a0[3]);
                        ow.z = pk2(bflo(xw.z) + g1[0] * a1[0], bfhi(xw.z) + g1[1] * a1[1]); ow.w = pk2(bflo(xw.w) + g1[2] * a1[2], bfhi(xw.w) + g1[3] * a1[3]);
                        *(u32x4*)(X + (size_t)(row0 + ai * HALF + m * 16) * 2048 + col0 + bj * HALF) = ow; }
            }
        }
    }
};
}

__device__ __forceinline__ int proj_src_col(int n) {
    if (n < 1024) return 7200 + n;
    if (n < 2048) return n - 1024;
    if (n < 4096) return 1024 + (n - 2048);
    if (n < 6144) return 8224 + (n - 4096);
    if (n < 8192) return 16416 + (n - 6144);
    if (n < 10240) return 3104 + (n - 8192);
    if (n < 12288) return 5152 + (n - 10240);
    if (n < 14336) return 10272 + (n - 12288);
    if (n < 16384) return 12320 + (n - 14336);
    if (n < 18432) return 14368 + (n - 16384);
    return 18464 + (n - 18432);
}
__device__ __forceinline__ void phase_w(KP p, int l, LAS unsigned char* lds, int wid0) {
    const int tid = tid_fresh(wid0), G = gridDim.x, bid = blockIdx.x;
    unsigned char* ws = launder(p->ws);
    {
        LAS float* tile = (LAS float*)lds;
        const int NT_IN = NPROJ / 64;
        const int total = (NT_IN + 5 * 32) * 8;
        for (int t = bid; t < total; t += G) {
            const int ntile = t >> 3, kt = t & 7, k0 = kt * 256;
            const float* src; int ld; bf16_t* dst; float scale = 1.0f; int n0;
            bool to8 = false;
            if (ntile < NT_IN) { n0 = ntile * 64; src = p->w_in + (size_t)l * 2048 * PROJ_W + proj_src_col(n0); ld = PROJ_W;
                const int pnl = n0 >> 8; const bool isb = (pnl >= BF_LO && pnl < BF_HI) || (pnl >= 48 && pnl < 72);
                if (isb) { const int cpn = pnl < 48 ? pnl - BF_LO : pnl - 48 + (BF_HI - BF_LO); dst = (bf16_t*)(ws + WS_WINB) + (size_t)(cpn * 256 + (n0 & 255)) * 2048; if (n0 < 1024) scale = 0.08838834764831845f; }
                else { to8 = true; dst = (bf16_t*)(ws + WS_WIN); scale = (n0 < 1024) ? 1024.0f * 0.08838834764831845f : 1024.0f; } }
            else { const int mi = (ntile - NT_IN) >> 5; n0 = ((ntile - NT_IN) & 31) * 64;
                const float* m5 = mi == 0 ? p->w_a_out : mi == 1 ? p->w_b_out : mi == 2 ? p->w_c_out : mi == 3 ? p->w_out : p->peer_wq;
                src = m5 + (size_t)l * 2048 * 2048 + n0; ld = 2048;
                dst = (bf16_t*)(ws + WS_WA + (size_t)mi * SZ_W) + (size_t)n0 * 2048; }
            { const int kk = tid >> 4, n4 = (tid & 15) * 4;
              f32x4 v[8];
#pragma unroll
              for (int h = 0; h < 8; ++h) v[h] = *(const f32x4*)(src + (size_t)(k0 + kk + 32 * h) * ld + n4);
#pragma unroll
              for (int h = 0; h < 8; ++h) { LAS float* tp = tile + (kk + 32 * h) * 65 + n4; tp[0] = v[h][0]; tp[1] = v[h][1]; tp[2] = v[h][2]; tp[3] = v[h][3]; } }
            __syncthreads();
            { const int n = tid >> 3, kq = (tid & 7) * 8;
#pragma unroll
              for (int sub = 0; sub < 4; ++sub) { const int k8 = sub * 64 + kq; float v[8];
#pragma unroll
                  for (int j = 0; j < 8; ++j) v[j] = tile[(k8 + j) * 65 + n] * scale;
                  if (to8) {
#pragma unroll
                      for (int j = 0; j < 8; ++j) v[j] = fminf(fmaxf(v[j], -448.f), 448.f);
                      int d0 = 0, d1 = 0; d0 = __builtin_amdgcn_cvt_pk_fp8_f32(v[0], v[1], d0, false); d0 = __builtin_amdgcn_cvt_pk_fp8_f32(v[2], v[3], d0, true);
                      d1 = __builtin_amdgcn_cvt_pk_fp8_f32(v[4], v[5], d1, false); d1 = __builtin_amdgcn_cvt_pk_fp8_f32(v[6], v[7], d1, true);
                      u32x2 w8; w8.x = (unsigned)d0; w8.y = (unsigned)d1; *(u32x2*)((unsigned char*)dst + (size_t)(n0 + n) * 2048 + k0 + k8) = w8; }
                  else { u32x4 w; w.x = pk2(v[0], v[1]); w.y = pk2(v[2], v[3]); w.z = pk2(v[4], v[5]); w.w = pk2(v[6], v[7]);
                      *(u32x4*)(dst + (size_t)n * 2048 + k0 + k8) = w; } } }
            __syncthreads();
        }
    }
    const size_t gtid = (size_t)bid * NTHREADS + tid, gthreads = (size_t)G * NTHREADS;
    for (size_t i = gtid; i < 32 * 2048; i += gthreads) { const int n = (int)(i >> 11), k = (int)(i & 2047);
        ((bf16_t*)(ws + WS_WG))[i] = f2bf(p->w_in[(size_t)l * 2048 * PROJ_W + (size_t)k * PROJ_W + 3072 + n]); }
    {
        const float* su = p->peer_u + (size_t)l * 16384 * 2048; const float* sv = p->peer_v + (size_t)l * 16384 * 2048;
        unsigned char* du = ws + WS_PU; unsigned char* dv = ws + WS_PVW;
        const size_t n32 = (size_t)16384 * 2048 / 32;
        for (size_t i = gtid; i < n32; i += gthreads) {
#pragma unroll
            for (int t = 0; t < 2; ++t) {
                const float* sp = (t ? sv : su) + i * 32; const float sc = t ? 4.0f : 64.0f;
                u32x4 wv;
#pragma unroll
                for (int q = 0; q < 4; ++q) { const f32x4 a = *(const f32x4*)(sp + q * 8), b = *(const f32x4*)(sp + q * 8 + 4);
                    unsigned d = 0;
                    d = __builtin_amdgcn_cvt_scalef32_pk_fp4_f32(d, a[0] * sc, a[1] * sc, 1.0f, 0); d = __builtin_amdgcn_cvt_scalef32_pk_fp4_f32(d, a[2] * sc, a[3] * sc, 1.0f, 1);
                    d = __builtin_amdgcn_cvt_scalef32_pk_fp4_f32(d, b[0] * sc, b[1] * sc, 1.0f, 2); d = __builtin_amdgcn_cvt_scalef32_pk_fp4_f32(d, b[2] * sc, b[3] * sc, 1.0f, 3);
                    wv[q] = d; }
                *(u32x4*)((t ? dv : du) + i * 16) = wv;
            }
        }
        const float* sk = p->peer_keys + (size_t)l * 16 * 128 * 128; bf16_t* dk = (bf16_t*)(ws + WS_KEYS);
        for (size_t i = gtid; i < (size_t)16 * 128 * 128; i += gthreads) dk[i] = f2bf(sk[i]);
    }
    {
        float* mod = (float*)(ws + WS_MOD) + (size_t)l * 3 * 12288;
        const float* wa = p->w_ada + (size_t)l * 2048 * 12288; const float* ba = p->b_ada + (size_t)l * 12288;
        LAS float* part = (LAS float*)(lds + 69632);
        const int col = tid & 63, ks = tid >> 6;
        for (int t = bid; t < 256; t += G) {
            const int n = t * 48 + col;
            float a0 = 0.f, a1 = 0.f, a2 = 0.f;
            if (col < 48) {
#pragma unroll 8
                for (int k = ks * 256; k < ks * 256 + 256; ++k) {
                    const float w = wa[(size_t)k * 12288 + n];
                    const float c0 = p->c[k], c1 = p->c[2048 + k], c2 = p->c_ctx[k];
                    a0 += c0 * sigmoidf_(c0) * w; a1 += c1 * sigmoidf_(c1) * w; a2 += c2 * sigmoidf_(c2) * w;
                }
                part[(ks * 3 + 0) * 48 + col] = a0; part[(ks * 3 + 1) * 48 + col] = a1; part[(ks * 3 + 2) * 48 + col] = a2;
            }
            __syncthreads();
            if (tid < 144) { const int which = tid / 48, cc = tid - which * 48; float sacc = ba[t * 48 + cc];
#pragma unroll
                for (int q = 0; q < 8; ++q) sacc += part[(q * 3 + which) * 48 + cc];
                mod[(size_t)which * 12288 + t * 48 + cc] = sacc; }
            __syncthreads();
        }
    }
    if (l == 0) {
        float* tab = (float*)(ws + WS_TAB);
        for (size_t i = gtid; i < 4096; i += gthreads) { const int pos = (int)(i >> 5), j = (int)(i & 31);
            const float inv = powf(10000.0f, -(float)j / 32.0f); const float ang = (float)pos * inv;
            tab[i] = cosf(ang); tab[4096 + i] = sinf(ang); }
    }
}

__device__ __forceinline__ void phase_norm(KP p, int l, int which_norm, int nrows, int wid0) {
    const int tid = tid_fresh(wid0); const int lane = tid & 63, gw = blockIdx.x * 8 + (tid >> 6), nw = gridDim.x * 8;
    unsigned char* ws = launder(p->ws);
    const bf16_t* X = (const bf16_t*)(ws + WS_X); bf16_t* XN = (bf16_t*)(ws + WS_XN);
    const float* mod = (const float*)(ws + WS_MOD) + (size_t)l * 3 * 12288;
    const float* g = p->norm_g + (size_t)(l * 2 + which_norm) * 2048;
    const int shift_c = which_norm ? 3 : 0, scale_c = which_norm ? 4 : 1;
    for (int row = gw; row < nrows; row += nw) {
        const int which = row < NLAT ? (row >> 13) : 2;
        const float* mb = mod + (size_t)which * 12288;
        f32x4 v[8]; float ss = 0.f;
        if (l == 0 && which_norm == 0) {
            const float* xr = row < NLAT ? p->x + (size_t)row * 2048 : p->ctx + (size_t)(row - NLAT) * 2048;
#pragma unroll
            for (int i = 0; i < 8; ++i) v[i] = *(const f32x4*)(xr + i * 256 + lane * 4);
        } else {
            const bf16_t* xr = X + (size_t)row * 2048;
            u32x2 xb[8];
#pragma unroll
            for (int i = 0; i < 8; ++i) xb[i] = *(const u32x2*)(xr + i * 256 + lane * 4);
#pragma unroll
            for (int i = 0; i < 8; ++i) { v[i][0] = bflo(xb[i].x); v[i][1] = bfhi(xb[i].x); v[i][2] = bflo(xb[i].y); v[i][3] = bfhi(xb[i].y); }
        }
#pragma unroll
        for (int i = 0; i < 8; ++i) ss += v[i][0] * v[i][0] + v[i][1] * v[i][1] + v[i][2] * v[i][2] + v[i][3] * v[i][3];
        ss = wave_sum(ss);
        const float rstd = rsqrtf(ss * (1.0f / 2048.0f) + EPSF);
        f32x4 ggv[8], shv[8], scv[8];
#pragma unroll
        for (int i = 0; i < 8; ++i) { const int c = i * 256 + lane * 4; ggv[i] = *(const f32x4*)(g + c); shv[i] = *(const f32x4*)(mb + shift_c * 2048 + c); scv[i] = *(const f32x4*)(mb + scale_c * 2048 + c); }
#pragma unroll
        for (int i = 0; i < 8; ++i) { const int c = i * 256 + lane * 4;
            const f32x4 gg = ggv[i], sh = shv[i], sc = scv[i];
            float o[4];
#pragma unroll
            for (int j = 0; j < 4; ++j) o[j] = v[i][j] * rstd * gg[j] * (1.0f + sc[j]) + sh[j];
            u32x2 w; w.x = pk2(o[0], o[1]); w.y = pk2(o[2], o[3]); *(u32x2*)(XN + (size_t)row * 2048 + c) = w;
            if (which_norm == 0) { int d = 0; d = __builtin_amdgcn_cvt_pk_fp8_f32(fminf(fmaxf(o[0], -448.f), 448.f), fminf(fmaxf(o[1], -448.f), 448.f), d, false);
                d = __builtin_amdgcn_cvt_pk_fp8_f32(fminf(fmaxf(o[2], -448.f), 448.f), fminf(fmaxf(o[3], -448.f), 448.f), d, true); *(unsigned*)(ws + WS_XN8 + (size_t)row * 2048 + c) = (unsigned)d; } }
    }
}

__device__ __forceinline__ void phase_gates_gemm(KP p, int l, int wid0) {
    const int tid = tid_fresh(wid0); const int lane = tid & 63, gw = blockIdx.x * 8 + (tid >> 6), nw = gridDim.x * 8;
    unsigned char* ws = launder(p->ws);
    const bf16_t* XN = (const bf16_t*)(ws + WS_XN); const bf16_t* WG = (const bf16_t*)(ws + WS_WG); float* GA = (float*)(ws + WS_GATES);
    const int q4 = lane >> 4, c = lane & 15;
    const float gb0 = p->a_gate_b[l * 32 + c], gb1 = p->a_gate_b[l * 32 + 16 + c];
    for (int task = gw; task < MR / 16; task += nw) {
        const int r0 = task * 16;
        f32x4 acc0 = {0.f, 0.f, 0.f, 0.f}, acc1 = {0.f, 0.f, 0.f, 0.f};
        const bf16_t* ap = XN + (size_t)(r0 + c) * 2048 + 8 * q4; const bf16_t* b0 = WG + (size_t)c * 2048 + 8 * q4; const bf16_t* b1 = b0 + 16 * 2048;
#pragma unroll 4
        for (int ks = 0; ks < 64; ++ks) { const bf16x8 a = *(const bf16x8*)(ap + ks * 32), x0 = *(const bf16x8*)(b0 + ks * 32), x1 = *(const bf16x8*)(b1 + ks * 32);
            acc0 = mfma16(a, x0, acc0); acc1 = mfma16(a, x1, acc1); }
#pragma unroll
        for (int r = 0; r < 4; ++r) {
            const float v0 = acc0[r] + gb0, v1 = acc1[r] + gb1;
            GA[(size_t)(r0 + 4 * q4 + r) * 32 + c] = (c >= 8) ? logsigmoidf_(v0) : v0; GA[(size_t)(r0 + 4 * q4 + r) * 32 + 16 + c] = (c >= 8) ? logsigmoidf_(v1) : v1; }
    }
}

__device__ __forceinline__ void phase_e1(KP p, int l, int wid0) {
    const int tid = tid_fresh(wid0); const int lane = tid & 63, gw = blockIdx.x * 8 + (tid >> 6), nw = gridDim.x * 8;
    unsigned char* ws = launder(p->ws);
    bf16_t* PQ = (bf16_t*)(ws + WS_PQ); bf16_t* PK = (bf16_t*)(ws + WS_PK); bf16_t* CQ = (bf16_t*)(ws + WS_CQ); bf16_t* CK = (bf16_t*)(ws + WS_CK);
    bf16_t* BB = (bf16_t*)(ws + WS_BB); const bf16_t* BC = (const bf16_t*)(ws + WS_BC); const bf16_t* BX = (const bf16_t*)(ws + WS_BX);
    float* GA = (float*)(ws + WS_GATES); const float* tab = (const float*)(ws + WS_TAB);
    const float* gq = p->c_qk_g + (size_t)(l * 2 + 0) * 128; const float* gk = p->c_qk_g + (size_t)(l * 2 + 1) * 128;
    const float* cw = p->b_conv + (size_t)l * 3 * 2048;
    float gqv[8], gkv[8];
#pragma unroll
    for (int j = 0; j < 8; ++j) { gqv[j] = gq[(lane & 15) * 8 + j] * 0.12751743082459868f;        gkv[j] = gk[(lane & 15) * 8 + j]; }
    const int nitems = NLAT / 8 + NCTX;
    for (int item = gw; item < nitems; item += nw) {
        const int row_first = item < NLAT / 8 ? item * 8 : NLAT + (item - NLAT / 8), nrun = item < NLAT / 8 ? 8 : 1;
        for (int rr = 0; rr < nrun; ++rr) { const int row = row_first + rr;
        if (row < NLAT) {
            const int s = row & 8191, gr = s >> 6, gc = s & 63;
#pragma unroll
            for (int it = 0; it < 2; ++it) {
                const int unit = it * 64 + lane, h = unit >> 4, hf = (unit >> 3) & 1, j4 = unit & 7;
                const int off = h * 128 + hf * 64 + j4 * 4, pos = hf ? gc : gr;
                const f32x4 cs = *(const f32x4*)(tab + pos * 32 + j4 * 4), sn = *(const f32x4*)(tab + 4096 + pos * 32 + j4 * 4);
#pragma unroll
                for (int tsel = 0; tsel < 2; ++tsel) { bf16_t* T = (tsel ? PK : PQ) + (size_t)row * 1024 + off;
                    const u32x2 u1 = *(const u32x2*)T, u2 = *(const u32x2*)(T + 32);
                    const float a0 = bflo(u1.x), a1 = bfhi(u1.x), a2 = bflo(u1.y), a3 = bfhi(u1.y), b0 = bflo(u2.x), b1 = bfhi(u2.x), b2 = bflo(u2.y), b3 = bfhi(u2.y);
                    u32x2 o1, o2;
                    o1.x = pk2(a0 * cs[0] - b0 * sn[0], a1 * cs[1] - b1 * sn[1]); o1.y = pk2(a2 * cs[2] - b2 * sn[2], a3 * cs[3] - b3 * sn[3]);
                    o2.x = pk2(b0 * cs[0] + a0 * sn[0], b1 * cs[1] + a1 * sn[1]); o2.y = pk2(b2 * cs[2] + a2 * sn[2], b3 * cs[3] + a3 * sn[3]);
                    *(u32x2*)T = o1; *(u32x2*)(T + 32) = o2; }
            }
        }
#pragma unroll
        for (int tsel = 0; tsel < 2; ++tsel) {
            bf16_t* T = (tsel ? CK : CQ) + (size_t)row * 2048;
            u32x4 wq4[4];
#pragma unroll
            for (int ps = 0; ps < 4; ++ps) wq4[ps] = *(const u32x4*)(T + ps * 512 + lane * 8);
#pragma unroll
            for (int ps = 0; ps < 4; ++ps) {
                const u32x4 w = wq4[ps];
                float v[8] = {bflo(w.x), bfhi(w.x), bflo(w.y), bfhi(w.y), bflo(w.z), bfhi(w.z), bflo(w.w), bfhi(w.w)};
                float ss = 0.f;
#pragma unroll
                for (int j = 0; j < 8; ++j) ss += v[j] * v[j];
                ss += __shfl_xor(ss, 1); ss += __shfl_xor(ss, 2); ss += __shfl_xor(ss, 4); ss += __shfl_xor(ss, 8);
                const float rstd = rsqrtf(ss * (1.0f / 128.0f) + EPSF);
#pragma unroll
                for (int j = 0; j < 8; ++j) v[j] = v[j] * rstd * (tsel ? gkv[j] : gqv[j]);
                u32x4 o; o.x = pk2(v[0], v[1]); o.y = pk2(v[2], v[3]); o.z = pk2(v[4], v[5]); o.w = pk2(v[6], v[7]);
                *(u32x4*)(T + ps * 512 + lane * 8) = o;
            }
        }
        }
        {
            int pos0, len; if (row_first < NLAT) { pos0 = row_first & 8191; len = SEQ; } else { pos0 = (row_first - NLAT) & 255; len = CTXL; }
#pragma unroll 1
            for (int ps = 0; ps < 4; ++ps) {
                const int c = ps * 512 + lane * 8;
                float w0[8], w1[8], w2[8];
#pragma unroll
                for (int hq = 0; hq < 2; ++hq) { const f32x4 a = *(const f32x4*)(cw + c + hq * 4), bq = *(const f32x4*)(cw + 2048 + c + hq * 4), cq = *(const f32x4*)(cw + 4096 + c + hq * 4);
#pragma unroll
                    for (int j = 0; j < 4; ++j) { w0[hq * 4 + j] = a[j]; w1[hq * 4 + j] = bq[j]; w2[hq * 4 + j] = cq[j]; } }
                u32x4 cvr[10], xvr[10], bbr[8];
                const u32x4 zero4 = {0u, 0u, 0u, 0u};
#pragma unroll
                for (int k = 0; k < 10; ++k) { const int rel = k - 1; const bool ok = (rel <= nrun) && (pos0 + rel >= 0) && (pos0 + rel < len) && (rel < nrun || pos0 + rel < len);
                    if (ok && rel <= nrun) { const size_t o = (size_t)(row_first + rel) * 2048 + c; cvr[k] = *(const u32x4*)(BC + o); xvr[k] = *(const u32x4*)(BX + o); } else { cvr[k] = zero4; xvr[k] = zero4; } }
#pragma unroll
                for (int rr = 0; rr < 8; ++rr) bbr[rr] = (rr < nrun) ? *(const u32x4*)(BB + (size_t)(row_first + rr) * 2048 + c) : zero4;
                float up[8], uc[8], un[8];
                auto mk_u = [&](const u32x4 cv, const u32x4 xv, float (&u)[8]) {
                    u[0] = bflo(cv.x) * bflo(xv.x); u[1] = bfhi(cv.x) * bfhi(xv.x); u[2] = bflo(cv.y) * bflo(xv.y); u[3] = bfhi(cv.y) * bfhi(xv.y);
                    u[4] = bflo(cv.z) * bflo(xv.z); u[5] = bfhi(cv.z) * bfhi(xv.z); u[6] = bflo(cv.w) * bflo(xv.w); u[7] = bfhi(cv.w) * bfhi(xv.w); };
                mk_u(cvr[0], xvr[0], up); mk_u(cvr[1], xvr[1], uc);
#pragma unroll
                for (int rr = 0; rr < 8; ++rr) {
                    if (rr < nrun) {
                        mk_u(cvr[rr + 2], xvr[rr + 2], un);
                        const size_t o = (size_t)(row_first + rr) * 2048 + c; const u32x4 bb = bbr[rr];
                        const float bv[8] = {bflo(bb.x), bfhi(bb.x), bflo(bb.y), bfhi(bb.y), bflo(bb.z), bfhi(bb.z), bflo(bb.w), bfhi(bb.w)};
                        float y[8];
#pragma unroll
                        for (int j = 0; j < 8; ++j) y[j] = bv[j] * (up[j] * w0[j] + uc[j] * w1[j] + un[j] * w2[j]);
                        u32x4 ov; ov.x = pk2(y[0], y[1]); ov.y = pk2(y[2], y[3]); ov.z = pk2(y[4], y[5]); ov.w = pk2(y[6], y[7]);
                        *(u32x4*)(BB + o) = ov;
#pragma unroll
                        for (int j = 0; j < 8; ++j) { up[j] = uc[j]; uc[j] = un[j]; }
                    }
                }
            }
        }
    }
}

constexpr int ML_QS = 0, ML_KS = 17408, ML_VT = 53248, ML_CT = 69376, ML_CTSZ = 13056, ML_PRE_TOT = 3 * 8448 * 4;
__device__ __forceinline__ int ml_row(int pp, int b, int dir) {
    if (pp < 256) { const int j = dir ? 255 - pp : pp; return NLAT + b * 256 + j; }
    int s = pp - 256; if (dir) s = 8191 - s; return b * 8192 + s;
}
__device__ __forceinline__ void phase_mlstm(KP p, int l, LAS unsigned char* lds, int wid0) {
    const int tid = tid_fresh(wid0), lane = tid & 63, w = __builtin_amdgcn_readfirstlane(tid >> 6), q4 = lane >> 4, c16 = lane & 15;
    unsigned char* ws = launder(p->ws);
    const bf16_t* PQ = (const bf16_t*)(ws + WS_PQ); const bf16_t* PK = (const bf16_t*)(ws + WS_PK); const bf16_t* PV = (const bf16_t*)(ws + WS_PV);
    const float* GA = (const float*)(ws + WS_GATES);
    if (w >= 4) __builtin_amdgcn_s_setprio(1);
    for (int task = blockIdx.x; task < 256; task += gridDim.x) {
        const int xq = task & 7, yq = task >> 3; const int bh = 2 * xq + (yq >> 4), dir = (yq >> 3) & 1, sl = yq & 7; const int b = bh >> 3, h = bh & 7;
        bf16_t* H = (bf16_t*)(ws + (dir ? WS_BX : WS_BC));
        float* SCN = (float*)(ws + WS_SCAN) + (size_t)task * 5 * 8448;
        __syncthreads();
        {
            LAS float* PB = (LAS float*)lds; LAS float* TOT = (LAS float*)(lds + ML_PRE_TOT);
            float li_n = 0.f, lf_n = 0.f;
            if (w < 132) { const int r = ml_row(w * 64 + lane, b, dir); li_n = GA[(size_t)r * 32 + (2 * dir) * 8 + h]; lf_n = GA[(size_t)r * 32 + (2 * dir + 1) * 8 + h]; }
            for (int cc = w; cc < 132; cc += 8) {
                const float li = li_n, lf = lf_n;
                if (cc + 8 < 132) { const int r = ml_row((cc + 8) * 64 + lane, b, dir); li_n = GA[(size_t)r * 32 + (2 * dir) * 8 + h]; lf_n = GA[(size_t)r * 32 + (2 * dir + 1) * 8 + h]; }
                float bc = lf;
#pragma unroll
                for (int o = 1; o < 64; o <<= 1) { const float t = __shfl_up(bc, o); if (lane >= o) bc += t; }
                const float a = li - bc;
                float pm = a;
#pragma unroll
                for (int o = 1; o < 64; o <<= 1) { const float t = __shfl_up(pm, o); if (lane >= o) pm = fmaxf(pm, t); }
                PB[cc * 64 + lane] = bc; PB[8448 + cc * 64 + lane] = a; PB[2 * 8448 + cc * 64 + lane] = pm;
                if (lane == 63) { TOT[cc] = bc; TOT[256 + cc] = pm; }
            }
            __syncthreads();
            const float t0 = TOT[lane], p0 = TOT[256 + lane], t1 = TOT[64 + lane], p1 = TOT[256 + 64 + lane], t2 = TOT[128 + (lane & 3)], p2 = TOT[256 + 128 + (lane & 3)];
            float m = 0.f, mk0 = 0.f, mk1 = 0.f, mk2 = 0.f;
#pragma unroll 4
            for (int c = 0; c < 64; ++c) { if (lane == c) mk0 = m; m = rlane(t0, c) + fmaxf(m, rlane(p0, c)); }
#pragma unroll 4
            for (int c = 0; c < 64; ++c) { if (lane == c) mk1 = m; m = rlane(t1, c) + fmaxf(m, rlane(p1, c)); }
#pragma unroll
            for (int c = 0; c < 4; ++c) { if (lane == c) mk2 = m; m = rlane(t2, c) + fmaxf(m, rlane(p2, c)); }
            for (int cc = w; cc < 132; cc += 8) {
                const float mkk = (cc < 64) ? mk0 : (cc < 128 ? mk1 : mk2);
                const float mc = rlane(mkk, cc & 63);
                const float bc = PB[cc * 64 + lane], a = PB[8448 + cc * 64 + lane], pm = PB[2 * 8448 + cc * 64 + lane];
                const float pmall = rlane(pm, 63);
                const float mx = fmaxf(mc, pm), mref = fmaxf(mc, pmall);
                SCN[cc * 64 + lane] = __expf(mc - mx);
                SCN[8448 + cc * 64 + lane] = __expf(fminf(mref - mx, 80.0f));
                SCN[2 * 8448 + cc * 64 + lane] = __expf(-(bc + mx));
                SCN[3 * 8448 + cc * 64 + lane] = __expf(a - mref);
                if (lane == 0) SCN[4 * 8448 + cc] = __expf(mc - mref);
            }
        }
        __syncthreads();
        for (int i = tid; i < 16 * 32; i += NTHREADS) { const int r = 32 + (i >> 5), cdw = i & 31; *(LAS unsigned*)(lds + ML_VT + r * 144 + cdw * 4) = 0x3f803f80u; }
        for (int i = tid; i < 2 * ML_CTSZ / 4; i += NTHREADS) *(LAS unsigned*)(lds + ML_CT + i * 4) = 0u;
        __syncthreads();
        f32x4 Cst[3];
#pragma unroll
        for (int i = 0; i < 3; ++i) Cst[i] = (f32x4){0.f, 0.f, 0.f, 0.f};
        u32x4 qreg[2], kreg[2], vreg; float eak[2], decay; float wi1, em1, emr1;
        const int qrow_l = lane >> 4, qpc = lane & 15, vrow_l = lane >> 2, vpc = lane & 3;
        const int tr = w >> 1, part = w & 1;
        const int sgn = dir ? -1 : 1;
        const unsigned char* PQb = (const unsigned char*)PQ; const unsigned char* PKb = (const unsigned char*)PK; const unsigned char* PVb = (const unsigned char*)PV;
        const unsigned char* SCb = (const unsigned char*)SCN; unsigned char* Hb = (unsigned char*)H;
        const int lq0 = (sgn * (8 * w + qrow_l) * 1024 + h * 128 + qpc * 8) * 2, lq1 = lq0 + sgn * 4 * 2048;
        const int lv = (sgn * (16 * w + vrow_l) * 2048 + h * 256 + sl * 32 + vpc * 8) * 2;
        const int lh = (sgn * (16 * tr + c16) * 2048 + h * 256 + sl * 32 + 16 * part + 4 * q4) * 2;
        const int lea = (3 * 8448 + 8 * w + qrow_l) * 4, lwi = (16 * tr + c16) * 4;
#define ML_PREFETCH(cn) do { const int _r0 = ml_row((cn) * 64, b, dir); const unsigned _q = (unsigned)_r0 * 2048u, _v = (unsigned)_r0 * 4096u, _s = (unsigned)(cn) * 256u; \
            qreg[0] = *(const u32x4*)(PQb + (_q + (unsigned)lq0)); kreg[0] = *(const u32x4*)(PKb + (_q + (unsigned)lq0)); qreg[1] = *(const u32x4*)(PQb + (_q + (unsigned)lq1)); kreg[1] = *(const u32x4*)(PKb + (_q + (unsigned)lq1)); \
            eak[0] = *(const float*)(SCb + (_s + (unsigned)lea)); eak[1] = *(const float*)(SCb + (_s + (unsigned)lea + 16u)); \
            if (w < 4) vreg = *(const u32x4*)(PVb + (_v + (unsigned)lv)); \
            } while (0)
#define ML_PREFETCH_OUT(cn) do { const unsigned _s = (unsigned)(cn) * 256u; \
            wi1 = *(const float*)(SCb + (_s + (unsigned)lwi)); em1 = *(const float*)(SCb + (_s + (unsigned)lwi + 8448u * 4u)); emr1 = *(const float*)(SCb + (_s + (unsigned)lwi + 2u * 8448u * 4u)); \
            decay = *(const float*)(SCb + (4u * 8448u * 4u + (unsigned)(cn) * 4u)); } while (0)
        ML_PREFETCH(0); ML_PREFETCH_OUT(0);
        for (int c = 0; c < 132; ++c) {
#pragma unroll
            for (int i = 0; i < 2; ++i) { const int sr = 8 * w + 4 * i + qrow_l;
                *(LAS u32x4*)(lds + ML_QS + sr * 272 + qpc * 16) = qreg[i];
                const float e = eak[i]; const u32x4 kk4 = kreg[i]; u32x4 ks;
                ks.x = pk2(bflo(kk4.x) * e, bfhi(kk4.x) * e); ks.y = pk2(bflo(kk4.y) * e, bfhi(kk4.y) * e); ks.z = pk2(bflo(kk4.z) * e, bfhi(kk4.z) * e); ks.w = pk2(bflo(kk4.w) * e, bfhi(kk4.w) * e);
                *(LAS u32x4*)(lds + ML_KS + sr * 272 + qpc * 16) = ks; }
            if (w < 4) { const unsigned vw[4] = {vreg.x, vreg.y, vreg.z, vreg.w}; const int sv = 16 * w + vrow_l;
#pragma unroll
                for (int j = 0; j < 4; ++j) { const int e = vpc * 8 + 2 * j;
                    *(LAS bf16_t*)(lds + ML_VT + e * 144 + sv * 2) = (bf16_t)(vw[j] & 0xffffu);
                    *(LAS bf16_t*)(lds + ML_VT + (e + 1) * 144 + sv * 2) = (bf16_t)(vw[j] >> 16); } }
            if (c + 1 < 132) ML_PREFETCH(c + 1);
            LDS_BARRIER();
            const LAS unsigned char* CTc = lds + ML_CT + (c & 1) * ML_CTSZ;
            const LAS unsigned char* kbase = lds + ML_KS + c16 * 272 + 8 * q4 * 2;
            const LAS unsigned char* vbase1 = lds + ML_VT + (16 * part + c16) * 144 + 4 * q4 * 2, * vbase2 = lds + ML_VT + (32 + c16) * 144 + 4 * q4 * 2;
            bf16x8 aq[4], ka[2][4], cb1[4], cb2[4]; u32x2 vf[4];
#pragma unroll
            for (int ks = 0; ks < 4; ++ks) aq[ks] = *(const LAS bf16x8*)(lds + ML_QS + (16 * tr + c16) * 272 + (ks * 32 + 8 * q4) * 2);
#pragma unroll
            for (int ks = 0; ks < 4; ++ks) { ka[0][ks] = *(const LAS bf16x8*)(kbase + ks * 64); ka[1][ks] = *(const LAS bf16x8*)(kbase + 16 * 272 + ks * 64); }
#pragma unroll
            for (int ks = 0; ks < 4; ++ks) { cb1[ks] = *(const LAS bf16x8*)(CTc + (16 * part + c16) * 272 + (ks * 32 + 8 * q4) * 2); cb2[ks] = *(const LAS bf16x8*)(CTc + (32 + c16) * 272 + (ks * 32 + 8 * q4) * 2); }
            vf[0] = *(const LAS u32x2*)(vbase1); vf[1] = *(const LAS u32x2*)(vbase1 + 32); vf[2] = *(const LAS u32x2*)(vbase2); vf[3] = *(const LAS u32x2*)(vbase2 + 32);
            __builtin_amdgcn_sched_barrier(0);
            f32x4 accA = {0.f, 0.f, 0.f, 0.f}, accD = {0.f, 0.f, 0.f, 0.f}, s0 = {0.f, 0.f, 0.f, 0.f}, s1 = {0.f, 0.f, 0.f, 0.f};
#pragma unroll
            for (int ks = 0; ks < 4; ++ks) { s0 = mfma16(ka[0][ks], aq[ks], s0); s1 = mfma16(ka[1][ks], aq[ks], s1); accA = mfma16(cb1[ks], aq[ks], accA); accD = mfma16(cb2[ks], aq[ks], accD); }
            __builtin_amdgcn_sched_barrier(0);
            bf16x8 kb[2][4]; u32x2 vg[4];
#pragma unroll
            for (int ks = 0; ks < 4; ++ks) { kb[0][ks] = *(const LAS bf16x8*)(kbase + 32 * 272 + ks * 64); kb[1][ks] = *(const LAS bf16x8*)(kbase + 48 * 272 + ks * 64); }
            vg[0] = *(const LAS u32x2*)(vbase1 + 64); vg[1] = *(const LAS u32x2*)(vbase1 + 96); vg[2] = *(const LAS u32x2*)(vbase2 + 64); vg[3] = *(const LAS u32x2*)(vbase2 + 96);
            __builtin_amdgcn_sched_barrier(0);
            const int dq = 4 * q4 - 16 * tr - c16;
            f32x4 accIA, accID;
            {
                float pe[8];
#pragma unroll
                for (int r = 0; r < 4; ++r) { pe[r] = (r + dq <= 0) ? s0[r] : 0.f; pe[4 + r] = (16 + r + dq <= 0) ? s1[r] : 0.f; }
                u32x4 pw; pw.x = pk2(pe[0], pe[1]); pw.y = pk2(pe[2], pe[3]); pw.z = pk2(pe[4], pe[5]); pw.w = pk2(pe[6], pe[7]);
                const bf16x8 pf = __builtin_bit_cast(bf16x8, pw);
                u32x4 bw1, bw2; bw1.x = vf[0].x; bw1.y = vf[0].y; bw1.z = vf[1].x; bw1.w = vf[1].y; bw2.x = vf[2].x; bw2.y = vf[2].y; bw2.z = vf[3].x; bw2.w = vf[3].y;
                accIA = mfma16(__builtin_bit_cast(bf16x8, bw1), pf, (f32x4){0.f, 0.f, 0.f, 0.f}); accID = mfma16(__builtin_bit_cast(bf16x8, bw2), pf, (f32x4){0.f, 0.f, 0.f, 0.f});
            }
            if (tr >= 2) {
                f32x4 s2 = {0.f, 0.f, 0.f, 0.f}, s3 = {0.f, 0.f, 0.f, 0.f};
#pragma unroll
                for (int ks = 0; ks < 4; ++ks) { s2 = mfma16(kb[0][ks], aq[ks], s2); s3 = mfma16(kb[1][ks], aq[ks], s3); }
                float pe[8];
#pragma unroll
                for (int r = 0; r < 4; ++r) { pe[r] = (32 + r + dq <= 0) ? s2[r] : 0.f; pe[4 + r] = (48 + r + dq <= 0) ? s3[r] : 0.f; }
                u32x4 pw; pw.x = pk2(pe[0], pe[1]); pw.y = pk2(pe[2], pe[3]); pw.z = pk2(pe[4], pe[5]); pw.w = pk2(pe[6], pe[7]);
                const bf16x8 pf = __builtin_bit_cast(bf16x8, pw);
                u32x4 bw1, bw2; bw1.x = vg[0].x; bw1.y = vg[0].y; bw1.z = vg[1].x; bw1.w = vg[1].y; bw2.x = vg[2].x; bw2.y = vg[2].y; bw2.z = vg[3].x; bw2.w = vg[3].y;
                accIA = mfma16(__builtin_bit_cast(bf16x8, bw1), pf, accIA); accID = mfma16(__builtin_bit_cast(bf16x8, bw2), pf, accID);
            }
            bf16x8 ak[2], bv[3][2];
#pragma unroll
            for (int k2 = 0; k2 < 2; ++k2) {
                const s16x4 t0 = __builtin_amdgcn_ds_read_tr16_b64_v4i16((LAS s16x4*)(lds + ML_KS + (k2 * 32 + 8 * q4 + (c16 >> 2)) * 272 + (16 * w + 4 * (c16 & 3)) * 2));
                const s16x4 t1 = __builtin_amdgcn_ds_read_tr16_b64_v4i16((LAS s16x4*)(lds + ML_KS + (k2 * 32 + 8 * q4 + 4 + (c16 >> 2)) * 272 + (16 * w + 4 * (c16 & 3)) * 2));
                ak[k2] = __builtin_shufflevector(t0, t1, 0, 1, 2, 3, 4, 5, 6, 7);
            }
#pragma unroll
            for (int ct = 0; ct < 3; ++ct)
#pragma unroll
                for (int k2 = 0; k2 < 2; ++k2) bv[ct][k2] = *(const LAS bf16x8*)(lds + ML_VT + (16 * ct + c16) * 144 + (k2 * 32 + 8 * q4) * 2);
            __builtin_amdgcn_sched_barrier(0);
            if (l == 0 || c >= 4) {
                const unsigned hb = (unsigned)ml_row(c * 64, b, dir) * 4096u + (unsigned)lh;
                const float den = wi1 * accD[0] + em1 * accID[0];
                const float inv = __builtin_amdgcn_rcpf(fmaxf(fabsf(den), emr1));
                const f32x4 num = accA * wi1 + accIA * em1;
                u32x2 ow; ow.x = pk2(num[0] * inv, num[1] * inv); ow.y = pk2(num[2] * inv, num[3] * inv);
                *(u32x2*)(Hb + hb) = ow;
            }
            {
                LAS unsigned char* CTn = lds + ML_CT + ((c + 1) & 1) * ML_CTSZ;
#pragma unroll
                for (int ct = 0; ct < 3; ++ct) {
                    Cst[ct] = Cst[ct] * decay;
#pragma unroll
                    for (int k2 = 0; k2 < 2; ++k2) Cst[ct] = mfma16(ak[k2], bv[ct][k2], Cst[ct]);
                }
                if (c + 1 < 132) ML_PREFETCH_OUT(c + 1);
#pragma unroll
                for (int ct = 0; ct < 3; ++ct) { u32x2 o; o.x = pk2(Cst[ct][0], Cst[ct][1]); o.y = pk2(Cst[ct][2], Cst[ct][3]);
                    *(LAS u32x2*)(CTn + (16 * ct + c16) * 272 + (16 * w + 4 * q4) * 2) = o; }
            }
            LDS_BARRIER();
        }
#undef ML_PREFETCH
#undef ML_PREFETCH_OUT
    }
}

constexpr int AT_KS = 0, AT_VS = 17408, AT_RPB = 35840;
__device__ __forceinline__ void phase_attn(KP p, int l, LAS unsigned char* lds, int wid0) {
    const int tid = tid_fresh(wid0), lane = tid & 63, w = __builtin_amdgcn_readfirstlane(tid >> 6), q4 = lane >> 4, c16 = lane & 15;
    unsigned char* ws = launder(p->ws);
    bf16_t* CQ = (bf16_t*)(ws + WS_CQ); const bf16_t* CK = (const bf16_t*)(ws + WS_CK); const bf16_t* CV = (const bf16_t*)(ws + WS_CV);
    const int nunits = 2048 + (l == 0 ? 64 : 0);
    if (w >= 4) __builtin_amdgcn_s_setprio(1);
    for (int u = blockIdx.x; u < nunits; u += gridDim.x) {
        int b, h, qrow = 0, g = 0, ntl = 0, r0a = 0, qbase;  bool is_ctx = u >= 2048;
        if (!is_ctx) { b = u >> 10; h = (u >> 6) & 15; const int rp = u & 63; qrow = 2 * rp + (w >> 2); g = w & 3;
            r0a = min(max(2 * rp - 4, 0), 120); const int r0b = min(max(2 * rp + 1 - 4, 0), 120); ntl = r0b + 8 - r0a;
            qbase = b * 8192 + qrow * 64 + 16 * g; }
        else { const int uu = u - 2048; b = uu >> 5; h = (uu >> 1) & 15; qbase = NLAT + b * 256 + (uu & 1) * 128 + 16 * w; }
        const int r0q = min(max(qrow - 4, 0), 120);
        const int a_g = (g == 0) ? 0 : (g == 1 ? 8 : (g == 2 ? 24 : 32));
        __syncthreads();
        if (!is_ctx) for (int i = tid; i < 465; i += NTHREADS) *(LAS float*)(lds + AT_RPB + i * 4) = p->c_rpb[((size_t)l * 16 + h) * 465 + i] * 1.4426950408889634f;
        bf16x8 qf[4];
#pragma unroll
        for (int ks = 0; ks < 4; ++ks) qf[ks] = *(const bf16x8*)(CQ + (size_t)(qbase + c16) * 2048 + h * 128 + ks * 32 + 8 * q4);
        f32x4 O[8];
#pragma unroll
        for (int i = 0; i < 8; ++i) O[i] = (f32x4){0.f, 0.f, 0.f, 0.f};
        float m_run = -1e30f, l_run = 0.f;
        const int ntiles = ntl + 4;
        u32x4 kreg[2], vreg[2];
        auto tile_row = [&](int t, int key) -> int { return (t < ntl) ? (b * 8192 + (r0a + t) * 64 + key) : (NLAT + b * 256 + (t - ntl) * 64 + key); };
        const int krow_l = lane >> 4, kpc = lane & 15;
        {
#pragma unroll
          for (int i = 0; i < 2; ++i) { const int r = tile_row(0, 8 * w + 4 * i + krow_l); kreg[i] = *(const u32x4*)(CK + (size_t)r * 2048 + h * 128 + kpc * 8); vreg[i] = *(const u32x4*)(CV + (size_t)r * 2048 + h * 128 + kpc * 8); } }
        for (int t = 0; t < ntiles; ++t) {
            LDS_BARRIER();
#pragma unroll
            for (int i = 0; i < 2; ++i) { const int key = 8 * w + 4 * i + krow_l;
                *(LAS u32x4*)(lds + AT_KS + key * 272 + kpc * 16) = kreg[i];
                *(LAS u32x4*)(lds + AT_VS + key * 288 + kpc * 16) = vreg[i]; }
            if (t + 1 < ntiles) {
#pragma unroll
                for (int i = 0; i < 2; ++i) { const int r = tile_row(t + 1, 8 * w + 4 * i + krow_l); kreg[i] = *(const u32x4*)(CK + (size_t)r * 2048 + h * 128 + kpc * 8); vreg[i] = *(const u32x4*)(CV + (size_t)r * 2048 + h * 128 + kpc * 8); } }
            LDS_BARRIER();
            const bool local = t < ntl; const int kr = r0a + t;
            if (local && !(kr >= r0q && kr < r0q + 8)) continue;
            const int npass = local ? 1 : 2;
            for (int ps = 0; ps < npass; ++ps) {
                const int a0 = local ? a_g : ps * 32;
                const LAS unsigned char* kp0 = lds + AT_KS + (a0 + c16) * 272 + 8 * q4 * 2;
                bf16x8 kf[2][4];
#pragma unroll
                for (int ct = 0; ct < 2; ++ct)
#pragma unroll
                    for (int ks = 0; ks < 4; ++ks) kf[ct][ks] = *(const LAS bf16x8*)(kp0 + ct * 16 * 272 + ks * 64);
                float bs[8];
                if (local) {
                    const int qc = 16 * g + c16;
                    const LAS float* bp = (const LAS float*)(lds + AT_RPB) + ((kr - qrow + 7) * 31 + a0 + 4 * q4 - qc + 15);
#pragma unroll
                    for (int i = 0; i < 8; ++i) bs[i] = bp[16 * (i >> 2) + (i & 3)];
                    asm volatile("" : "+v"(bs[0]), "+v"(bs[1]), "+v"(bs[2]), "+v"(bs[3]), "+v"(bs[4]), "+v"(bs[5]), "+v"(bs[6]), "+v"(bs[7]));
                }
                __builtin_amdgcn_sched_barrier(0);
                f32x4 sc[2] = {{0.f, 0.f, 0.f, 0.f}, {0.f, 0.f, 0.f, 0.f}};
#pragma unroll
                for (int ks = 0; ks < 4; ++ks) { sc[0] = mfma16(kf[0][ks], qf[ks], sc[0]); sc[1] = mfma16(kf[1][ks], qf[ks], sc[1]); }
                __builtin_amdgcn_sched_barrier(0);
                s16x4 vlo[8], vhi[8];
                { const LAS unsigned char* vp0 = lds + AT_VS + (a0 + 4 * q4 + (c16 >> 2)) * 288 + 4 * (c16 & 3) * 2;
#pragma unroll
                  for (int dt = 0; dt < 8; ++dt) { vlo[dt] = __builtin_amdgcn_ds_read_tr16_b64_v4i16((LAS s16x4*)(vp0 + dt * 32)); vhi[dt] = __builtin_amdgcn_ds_read_tr16_b64_v4i16((LAS s16x4*)(vp0 + 16 * 288 + dt * 32)); } }
                __builtin_amdgcn_sched_barrier(0);
                if (local) {
                    const int qc = 16 * g + c16, col0 = min(max(qc - 8, 0), 48);
                    const int kb = a0 + 4 * q4 - col0;
#pragma unroll
                    for (int ct = 0; ct < 2; ++ct)
#pragma unroll
                        for (int r = 0; r < 4; ++r) sc[ct][r] = ((unsigned)(kb + 16 * ct + r) < 16u) ? sc[ct][r] + bs[ct * 4 + r] : -1e30f;
                }
                float mx = fmaxf(fmaxf(fmaxf(sc[0][0], sc[0][1]), fmaxf(sc[0][2], sc[0][3])), fmaxf(fmaxf(sc[1][0], sc[1][1]), fmaxf(sc[1][2], sc[1][3])));
                { const u32x2 t = __builtin_amdgcn_permlane16_swap(__float_as_uint(mx), __float_as_uint(mx), false, false); mx = fmaxf(__uint_as_float(t.x), __uint_as_float(t.y)); }
                { const u32x2 t = __builtin_amdgcn_permlane32_swap(__float_as_uint(mx), __float_as_uint(mx), false, false); mx = fmaxf(__uint_as_float(t.x), __uint_as_float(t.y)); }
                const float m_new = fmaxf(m_run, mx);
                const float alpha = __builtin_amdgcn_exp2f(m_run - m_new);
                float pe[8]; float psum = 0.f;
#pragma unroll
                for (int ct = 0; ct < 2; ++ct)
#pragma unroll
                    for (int r = 0; r < 4; ++r) { const float e = __builtin_amdgcn_exp2f(sc[ct][r] - m_new); pe[ct * 4 + r] = e; psum += e; }
                { const u32x2 t = __builtin_amdgcn_permlane16_swap(__float_as_uint(psum), __float_as_uint(psum), false, false); psum = __uint_as_float(t.x) + __uint_as_float(t.y); }
                { const u32x2 t = __builtin_amdgcn_permlane32_swap(__float_as_uint(psum), __float_as_uint(psum), false, false); psum = __uint_as_float(t.x) + __uint_as_float(t.y); }
                l_run = l_run * alpha + psum; m_run = m_new;
                bf16x8 pf; { u32x4 pw; pw.x = pk2(pe[0], pe[1]); pw.y = pk2(pe[2], pe[3]); pw.z = pk2(pe[4], pe[5]); pw.w = pk2(pe[6], pe[7]); pf = __builtin_bit_cast(bf16x8, pw); }
                if (__ballot(alpha != 1.0f) != 0ull) {
#pragma unroll
                    for (int dt = 0; dt < 8; ++dt) O[dt] = O[dt] * alpha;
                }
#pragma unroll
                for (int dt = 0; dt < 8; ++dt) O[dt] = mfma16(__builtin_shufflevector(vlo[dt], vhi[dt], 0, 1, 2, 3, 4, 5, 6, 7), pf, O[dt]);
            }
        }
        const float linv = 1.0f / l_run;
#pragma unroll
        for (int dt = 0; dt < 8; ++dt) { u32x2 ow; ow.x = pk2(O[dt][0] * linv, O[dt][1] * linv); ow.y = pk2(O[dt][2] * linv, O[dt][3] * linv);
            *(u32x2*)(CQ + (size_t)(qbase + c16) * 2048 + h * 128 + 16 * dt + 4 * q4) = ow; }
    }
    __builtin_amdgcn_s_setprio(0);
}

__device__ __forceinline__ void phase_e2(KP p, int l, int nrows, int wid0) {
    const int tid = tid_fresh(wid0); const int lane = tid & 63, gw = blockIdx.x * 8 + (tid >> 6), nw = gridDim.x * 8;
    unsigned char* ws = launder(p->ws);
    const bf16_t* HF = (const bf16_t*)(ws + WS_BC); const bf16_t* HB = (const bf16_t*)(ws + WS_BX); bf16_t* PO = (bf16_t*)(ws + WS_PO);
    const float* hg = p->a_hnorm_g + (size_t)l * 2048;
    for (int row = gw; row < nrows; row += nw) {
        u32x2 fv[8], bv[8], ovv[8];
#pragma unroll
        for (int h = 0; h < 8; ++h) { const size_t o = (size_t)row * 2048 + h * 256 + lane * 4; fv[h] = *(const u32x2*)(HF + o); bv[h] = *(const u32x2*)(HB + o); ovv[h] = *(const u32x2*)(PO + o); }
#pragma unroll
        for (int h = 0; h < 8; ++h) {
            const size_t o = (size_t)row * 2048 + h * 256 + lane * 4;
            const u32x2 f = fv[h], bb = bv[h], ov = ovv[h];
            float v[4] = {bflo(f.x) + bflo(bb.x), bfhi(f.x) + bfhi(bb.x), bflo(f.y) + bflo(bb.y), bfhi(f.y) + bfhi(bb.y)};
            float ss = v[0] * v[0] + v[1] * v[1] + v[2] * v[2] + v[3] * v[3];
            ss = wave_sum(ss);
            const float rstd = rsqrtf(ss * (1.0f / 256.0f) + EPSF);
            const f32x4 gg = *(const f32x4*)(hg + h * 256 + lane * 4);
            const float og[4] = {bflo(ov.x), bfhi(ov.x), bflo(ov.y), bfhi(ov.y)};
            float y[4];
#pragma unroll
            for (int j = 0; j < 4; ++j) y[j] = sigmoidf_(og[j]) * v[j] * rstd * gg[j];
            u32x2 wv; wv.x = pk2(y[0], y[1]); wv.y = pk2(y[2], y[3]); *(u32x2*)(PO + o) = wv;
        }
    }
}

template <int MODE>
__device__ __forceinline__ void ctx_gemm(KP p, int l, LAS unsigned char* lds, int wid0) {
    const int tid = tid_fresh(wid0); const int lane = tid & 63, w = __builtin_amdgcn_readfirstlane(tid >> 6), q4 = lane >> 4, c16 = lane & 15;
    unsigned char* ws = launder(p->ws);
    for (int task = blockIdx.x; task < (NCTX / 64) * 32; task += gridDim.x) {
        const int rg = task >> 5, cb = task & 31; const int row0 = NLAT + rg * 64, col0 = cb * 64;
        const int orow = row0 + (tid >> 3), ocol = col0 + (tid & 7) * 8;
        float yv[8];
#pragma unroll
        for (int i = 0; i < 8; ++i) yv[i] = 0.f;
#pragma unroll 1
        for (int br = 0; br < (MODE == 0 ? 3 : 1); ++br) {
            const bf16_t* A; const bf16_t* Bt;
            if (MODE == 0) { const int ti = 1 + 4 * (br == 1) + (br == 2); A = (const bf16_t*)(ws + WS_T8 + (size_t)ti * SZ_A); Bt = (const bf16_t*)(ws + WS_WA + (size_t)br * SZ_W); }
            else if (MODE == 1) { A = (const bf16_t*)(ws + WS_Y); Bt = (const bf16_t*)(ws + WS_WO); }
            else { A = (const bf16_t*)(ws + WS_XN); Bt = (const bf16_t*)(ws + WS_WQ); }
            const bf16_t* ap = A + (size_t)(row0 + c16) * 2048 + w * 256 + 8 * q4; const bf16_t* bp = Bt + (size_t)(col0 + c16) * 2048 + w * 256 + 8 * q4;
            f32x4 acc[4][4];
#pragma unroll
            for (int mi = 0; mi < 4; ++mi)
#pragma unroll
                for (int j = 0; j < 4; ++j) acc[mi][j] = (f32x4){0.f, 0.f, 0.f, 0.f};
#pragma unroll 2
            for (int ks = 0; ks < 8; ++ks) {
                bf16x8 a[4], bb[4];
#pragma unroll
                for (int mi = 0; mi < 4; ++mi) a[mi] = *(const bf16x8*)(ap + (size_t)mi * 16 * 2048 + ks * 32);
#pragma unroll
                for (int j = 0; j < 4; ++j) bb[j] = *(const bf16x8*)(bp + (size_t)j * 16 * 2048 + ks * 32);
#pragma unroll
                for (int mi = 0; mi < 4; ++mi)
#pragma unroll
                    for (int j = 0; j < 4; ++j) acc[mi][j] = mfma16(a[mi], bb[j], acc[mi][j]);
            }
            __syncthreads();
#pragma unroll
            for (int mi = 0; mi < 4; ++mi)
#pragma unroll
                for (int j = 0; j < 4; ++j)
#pragma unroll
                    for (int r = 0; r < 4; ++r) *(LAS float*)(lds + ((w * 64 + 16 * mi + 4 * q4 + r) * 64 + 16 * j + c16) * 4) = acc[mi][j][r];
            __syncthreads();
            float sv[8];
#pragma unroll
            for (int i = 0; i < 8; ++i) sv[i] = 0.f;
#pragma unroll
            for (int ww = 0; ww < 8; ++ww) { const f32x4 p0 = *(const LAS f32x4*)(lds + ((ww * 64 + (tid >> 3)) * 64 + (tid & 7) * 8) * 4), p1 = *(const LAS f32x4*)(lds + ((ww * 64 + (tid >> 3)) * 64 + (tid & 7) * 8 + 4) * 4);
                sv[0] += p0[0]; sv[1] += p0[1]; sv[2] += p0[2]; sv[3] += p0[3]; sv[4] += p1[0]; sv[5] += p1[1]; sv[6] += p1[2]; sv[7] += p1[3]; }
            if (MODE == 0) { const u32x2 g = *(const u32x2*)(ws + WS_GT + (size_t)orow * 6144 + (size_t)br * 2048 + ocol);
#pragma unroll
                for (int i = 0; i < 8; ++i) yv[i] += pg8::gq8(i < 4 ? g.x : g.y, i & 3) * (1.0f / 255.0f) * sv[i]; }
            else {
#pragma unroll
                for (int i = 0; i < 8; ++i) yv[i] = sv[i]; }
        }
        if (MODE == 1) { bf16_t* xp = (bf16_t*)(ws + WS_X) + (size_t)orow * 2048 + ocol; const float* xi = p->ctx + (size_t)(orow - NLAT) * 2048 + ocol; const float* mg = (const float*)(ws + WS_MOD) + (size_t)l * 3 * 12288 + 2 * 12288 + 2 * 2048 + ocol;
            const f32x4 x0 = *(const f32x4*)xi, x1 = *(const f32x4*)(xi + 4), g0 = *(const f32x4*)mg, g1 = *(const f32x4*)(mg + 4);
            f32x4 o0, o1; o0[0] = x0[0] + g0[0] * yv[0]; o0[1] = x0[1] + g0[1] * yv[1]; o0[2] = x0[2] + g0[2] * yv[2]; o0[3] = x0[3] + g0[3] * yv[3];
            o1[0] = x1[0] + g1[0] * yv[4]; o1[1] = x1[1] + g1[1] * yv[5]; o1[2] = x1[2] + g1[2] * yv[6]; o1[3] = x1[3] + g1[3] * yv[7];
            u32x4 ow; ow.x = pk2(o0[0], o0[1]); ow.y = pk2(o0[2], o0[3]); ow.z = pk2(o1[0], o1[1]); ow.w = pk2(o1[2], o1[3]); *(u32x4*)xp = ow; }
        else { u32x4 ov; ov.x = pk2(yv[0], yv[1]); ov.y = pk2(yv[2], yv[3]); ov.z = pk2(yv[4], yv[5]); ov.w = pk2(yv[6], yv[7]);
            *(u32x4*)((bf16_t*)(ws + (MODE == 0 ? WS_Y : WS_PV)) + (size_t)orow * 2048 + ocol) = ov; }
    }
}

constexpr int PE_MAXT = 80;
constexpr int PE_IDX = 0, PE_W = PE_MAXT * 128 * 4, PE_SCR = 2 * PE_MAXT * 128 * 4, PE_SCRSZ = 16 * 132 * 4 + 4096 + 256;
#define PE_DPPU(v, ctrl) ((unsigned)__builtin_amdgcn_update_dpp(0, (int)(v), ctrl, 0xf, 0xf, true))
__device__ __forceinline__ unsigned ordkey(float v) { const unsigned u = __float_as_uint(v); return (u & 0x80000000u) ? ~u : (u | 0x80000000u); }
__device__ __forceinline__ void phase_peer(KP p, int l, LAS unsigned char* lds, int wid0) {
    const int tid = tid_fresh(wid0), lane = tid & 63, w = __builtin_amdgcn_readfirstlane(tid >> 6), q4 = lane >> 4, c16 = lane & 15;
    unsigned char* ws = launder(p->ws);
    const bf16_t* QP = (const bf16_t*)(ws + WS_PV); const bf16_t* KEYS = (const bf16_t*)(ws + WS_KEYS);
    const bf16_t* XN = (const bf16_t*)(ws + WS_XN);
    bf16_t* X = (bf16_t*)(ws + WS_X); const float* mod = (const float*)(ws + WS_MOD) + (size_t)l * 3 * 12288;
    const int ntok = (l == 0) ? MR : NLAT, G = gridDim.x;
    const int per = (ntok + G - 1) / G; const int t_begin = blockIdx.x * per, t_end = min(ntok, t_begin + per);
    for (int tb = t_begin; tb < t_end; tb += PE_MAXT) {
        const int nt = min(PE_MAXT, t_end - tb);
        __syncthreads();
        const int ntask = (nt + 15) >> 4;
        if (w < ntask) {
            int lane_pe1 = lane; asm volatile("" : "+v"(lane_pe1));
            const int lane = lane_pe1, q4 = lane >> 4, c16 = lane & 15;
            LAS unsigned char* scr = lds + PE_SCR + w * PE_SCRSZ;
            LAS float* SC = (LAS float*)scr;
            LAS float* LS = (LAS float*)(scr + 16 * 132 * 4);
            LAS int* LI = (LAS int*)(scr + 16 * 132 * 4 + 2048);
            LAS unsigned char* PT = scr + 16 * 132 * 4 + 4096;
            if (lane < 52) {
                const int L = lane;
                const int ge16 = L >= 16, ge24 = L >= 24, ge29 = L >= 29, ge33 = L >= 33, ge36 = L >= 36, ge38 = L >= 38, ge40 = L >= 40, ge42 = L >= 42;
                int pa = ge16 + ge24 + ge29 + ge33 + ge36 + ge38 + ge40 + ge42; if (ge42) pa = 8 + (L - 42);
                int pb = L - (16 * ge16 + 8 * ge24 + 5 * ge29 + 4 * ge33 + 3 * ge36 + 2 * ge38 + 2 * ge40 + 2 * ge42); if (ge42) pb = 0;
                if (L >= 50) { pa = 15; pb = 15; }
                PT[lane * 2] = (unsigned char)pa; PT[lane * 2 + 1] = (unsigned char)pb;
            }
            const int tok_a = min(tb + 16 * w + c16, t_end - 1);
            const int tkl = lane >> 2, qq = lane & 3;
            for (int h = 0; h < 8; ++h) {
                for (int pp = 0; pp < 2; ++pp) {
                    const int hp = 2 * h + pp;
                    bf16x8 af[4];
#pragma unroll
                    for (int ks = 0; ks < 4; ++ks) af[ks] = *(const bf16x8*)(QP + (size_t)tok_a * 2048 + h * 256 + pp * 128 + ks * 32 + 8 * q4);
#pragma unroll 4
                    for (int ct = 0; ct < 8; ++ct) {
                        f32x4 acc = {0.f, 0.f, 0.f, 0.f};
#pragma unroll
                        for (int ks = 0; ks < 4; ++ks) { const bf16x8 bfr = *(const bf16x8*)(KEYS + ((size_t)hp * 128 + 16 * ct + c16) * 128 + ks * 32 + 8 * q4); acc = mfma16(af[ks], bfr, acc); }
#pragma unroll
                        for (int r = 0; r < 4; ++r) SC[(4 * q4 + r) * 132 + 16 * ct + c16] = acc[r];
                    }
                    asm volatile("s_waitcnt lgkmcnt(0)" ::: "memory");
                    unsigned key[32];
#pragma unroll
                    for (int i = 0; i < 8; ++i) { const f32x4 v = *(const LAS f32x4*)(SC + tkl * 132 + 32 * qq + 4 * i);
#pragma unroll
                        for (int j = 0; j < 4; ++j) key[4 * i + j] = ((ordkey(v[j]) >> 1) & ~127u) | (unsigned)(32 * qq + 4 * i + j); }
                    unsigned prev = 0x80000000u;
#pragma unroll 1
                    for (int r = 0; r < 16; ++r) {
                        unsigned mxd = 0u;
#pragma unroll
                        for (int i = 0; i < 32; ++i) { const unsigned d = key[i] - prev; mxd = mxd > d ? mxd : d; }
                        { const unsigned o1 = PE_DPPU(mxd, 0xB1); mxd = mxd > o1 ? mxd : o1; const unsigned o2 = PE_DPPU(mxd, 0x4E); mxd = mxd > o2 ? mxd : o2; }
                        const unsigned mxk = mxd + prev;
                        prev = mxk;
                        if (qq == (r & 3)) { const int idx = (int)(mxk & 127u); LS[(pp * 16 + tkl) * 16 + r] = SC[tkl * 132 + idx]; LI[(pp * 16 + tkl) * 16 + r] = idx; }
                    }
                    asm volatile("s_waitcnt lgkmcnt(0)" ::: "memory");
                }
                unsigned ck[13];
#pragma unroll
                for (int i = 0; i < 13; ++i) { const int cidx = qq + 4 * i;
                    if (cidx < 50) { const int a = PT[cidx * 2], bq = PT[cidx * 2 + 1]; const float sv = LS[(0 * 16 + tkl) * 16 + a] + LS[(1 * 16 + tkl) * 16 + bq]; ck[i] = ((ordkey(sv) >> 1) & ~63u) | (unsigned)cidx; }
                    else ck[i] = 0u; }
                unsigned prev = 0x80000000u; float best0 = 0.f, esum = 0.f; float myexp[4] = {0.f, 0.f, 0.f, 0.f}; int myidx[4] = {0, 0, 0, 0};
#pragma unroll
                for (int r = 0; r < 16; ++r) {
                    unsigned mxd = 0u;
#pragma unroll
                    for (int i = 0; i < 13; ++i) { const unsigned d = ck[i] - prev; mxd = mxd > d ? mxd : d; }
                    { const unsigned o1 = PE_DPPU(mxd, 0xB1); mxd = mxd > o1 ? mxd : o1; const unsigned o2 = PE_DPPU(mxd, 0x4E); mxd = mxd > o2 ? mxd : o2; }
                    const unsigned mxk = mxd + prev;
                    prev = mxk;
                    const int cidx = (int)(mxk & 63u); const int a = PT[cidx * 2], bq = PT[cidx * 2 + 1];
                    const float best = LS[(0 * 16 + tkl) * 16 + a] + LS[(1 * 16 + tkl) * 16 + bq];
                    const int eidx = LI[(0 * 16 + tkl) * 16 + a] * 128 + LI[(1 * 16 + tkl) * 16 + bq];
                    if (r == 0) best0 = best;
                    const float e = __expf(best - best0); esum += e;
                    if (qq == (r & 3)) { myexp[r >> 2] = e; myidx[r >> 2] = eidx; }
                }
                const float inv = 1.0f / esum; const int tl = 16 * w + tkl;
                if (tl < nt) {
#pragma unroll
                    for (int i = 0; i < 4; ++i) { const int r = 4 * i + qq;
                        *(LAS int*)(lds + PE_IDX + (tl * 128 + h * 16 + r) * 4) = myidx[i];
                        *(LAS float*)(lds + PE_W + (tl * 128 + h * 16 + r) * 4) = myexp[i] * inv; }
                }
                asm volatile("s_waitcnt lgkmcnt(0)" ::: "memory");
            }
        }
        __syncthreads();
        int lane_pe2 = lane; asm volatile("" : "+v"(lane_pe2));
        const int nfull = nt & ~7, nleft = nt - nfull;
        const int S = (nleft == 1 || nleft == 2 || nleft == 4) ? 8 / nleft : 1;
        const int nrounds = (nfull >> 3) + (nleft ? 1 : 0);
        for (int rd = 0; rd < nrounds; ++rd) {
            const int lane = lane_pe2;
            const bool split = (rd == (nfull >> 3)) && S > 1;
            const int tl = split ? nfull + w / S : rd * 8 + w;
            const int NB = split ? 64 / S : 64, B0 = split ? (w % S) * NB : 0;
            const bool active = tl < nt;
            if (active) {
            const int row = tb + tl;
            u32x16 xq;
#pragma unroll
            for (int i = 0; i < 4; ++i) { const u32x4 xw = *(const u32x4*)(XN + (size_t)row * 2048 + lane * 32 + i * 8); xq[4 * i] = xw.x; xq[4 * i + 1] = xw.y; xq[4 * i + 2] = xw.z; xq[4 * i + 3] = xw.w; }
            const LAS int* idxp = (const LAS int*)(lds + PE_IDX + tl * 512);
            LAS float* wp = (LAS float*)(lds + PE_W + tl * 512);
            u32x4 bufA[2], bufB[2], bufC[2], bufD[2];
#define PE_ISSUE(buf, TAB, b) do { const u32x2 _ee = *(const LAS u32x2*)(idxp + 2 * (b)); \
                buf[0] = *(const u32x4*)((TAB) + ((_ee.x << 10) + (unsigned)lane * 16u)); buf[1] = *(const u32x4*)((TAB) + ((_ee.y << 10) + (unsigned)lane * 16u)); } while (0)
#define PE_DPPF(v, ctrl) __uint_as_float((unsigned)__builtin_amdgcn_update_dpp(0, (int)__float_as_uint(v), ctrl, 0xf, 0xf, true))
#define PE_CONS_U(buf, b) do { float _p[2]; \
                _Pragma("unroll") for (int _j = 0; _j < 2; ++_j) { float _d = 0.f; \
                    _Pragma("unroll") for (int _q = 0; _q < 4; ++_q) { const unsigned _dw = buf[_j][_q]; \
                        _d = dot2bf(__builtin_bit_cast(unsigned, __builtin_amdgcn_cvt_scalef32_pk_bf16_fp4(_dw, 1.0f, 0)), xq[4 * _q + 0], _d); _d = dot2bf(__builtin_bit_cast(unsigned, __builtin_amdgcn_cvt_scalef32_pk_bf16_fp4(_dw, 1.0f, 1)), xq[4 * _q + 1], _d); \
                        _d = dot2bf(__builtin_bit_cast(unsigned, __builtin_amdgcn_cvt_scalef32_pk_bf16_fp4(_dw, 1.0f, 2)), xq[4 * _q + 2], _d); _d = dot2bf(__builtin_bit_cast(unsigned, __builtin_amdgcn_cvt_scalef32_pk_bf16_fp4(_dw, 1.0f, 3)), xq[4 * _q + 3], _d); } \
                    _p[_j] = _d; } \
                float _c; { const u32x2 _t = __builtin_amdgcn_permlane32_swap(__float_as_uint(_p[0]), __float_as_uint(_p[1]), false, false); _c = __uint_as_float(_t.x) + __uint_as_float(_t.y); }     \
                { const u32x2 _t = __builtin_amdgcn_permlane16_swap(__float_as_uint(_c), __float_as_uint(_c), false, false); _c = __uint_as_float(_t.x) + __uint_as_float(_t.y); } \
                _c += PE_DPPF(_c, 0x140); _c += PE_DPPF(_c, 0x141); _c += PE_DPPF(_c, 0x4E); _c += PE_DPPF(_c, 0xB1);        \
                if ((lane & 31) == ((((b) - B0)) & 31)) cacc = _c; } while (0)
#define PE_FLUSH(jb, cnt) do { if ((lane & 31) < (cnt)) { const int _e = 2 * (B0 + (jb) + (lane & 31)) + (lane >> 5); const float _g = wp[_e]; \
                const float _a = cacc * (1.0f / 64.0f); wp[_e] = _g * 0.5f * _a * (1.0f + erff(_a * 0.70710678118654752f)); } } while (0)
#define PE_CONS_V(buf, b) do { const f32x2 _w2 = *(const LAS f32x2*)(wp + 2 * (b)); \
                _Pragma("unroll") for (int _j = 0; _j < 2; ++_j) { const f32x2 _wv = {_w2[_j], _w2[_j]}; \
                    _Pragma("unroll") for (int _q = 0; _q < 4; ++_q) { const unsigned _dw = buf[_j][_q]; \
                        out2[4 * _q + 0] += _wv * __builtin_amdgcn_cvt_scalef32_pk_f32_fp4(_dw, 1.0f, 0); out2[4 * _q + 1] += _wv * __builtin_amdgcn_cvt_scalef32_pk_f32_fp4(_dw, 1.0f, 1); \
                        out2[4 * _q + 2] += _wv * __builtin_amdgcn_cvt_scalef32_pk_f32_fp4(_dw, 1.0f, 2); out2[4 * _q + 3] += _wv * __builtin_amdgcn_cvt_scalef32_pk_f32_fp4(_dw, 1.0f, 3); } } } while (0)
            const unsigned char* TU = ws + WS_PU; const unsigned char* TV = ws + WS_PVW;
            const int NT = 2 * NB;
            asm volatile("" : "+v"(xq));
#define PE_ISS(s_, bi) do { const int _jn = min(max(j0 + (s_) + 3, 0), NT - 1); const bool _isv = _jn >= NB; \
                const unsigned char* _tab = _isv ? TV : TU; const int _bb = B0 + (_isv ? _jn - NB : _jn); PE_ISSUE(bi, _tab, _bb); } while (0)
            float cacc = 0.f;
#pragma unroll 1
            for (int t = -1; 4 * t < NB; ++t) { const int j0 = 4 * t;
                PE_ISS(0, bufD); if (t >= 0) PE_CONS_U(bufA, B0 + j0);
                PE_ISS(1, bufA); if (t >= 0) PE_CONS_U(bufB, B0 + j0 + 1);
                PE_ISS(2, bufB); if (t >= 0) PE_CONS_U(bufC, B0 + j0 + 2);
                PE_ISS(3, bufC); if (t >= 0) PE_CONS_U(bufD, B0 + j0 + 3);
                if (t >= 0 && ((t & 7) == 7 || 4 * (t + 1) >= NB)) PE_FLUSH(32 * (t >> 3), min(32, NB - 32 * (t >> 3)));
            }
            asm volatile("s_waitcnt lgkmcnt(0)" ::: "memory");
            f32x2 out2[16];
#pragma unroll
            for (int i = 0; i < 16; ++i) out2[i] = (f32x2){0.f, 0.f};
#pragma unroll 1
            for (int t = 0; 4 * t < NB; ++t) { const int j0 = NB + 4 * t;
                PE_ISS(0, bufD); PE_CONS_V(bufA, B0 + 4 * t);
                PE_ISS(1, bufA); PE_CONS_V(bufB, B0 + 4 * t + 1);
                PE_ISS(2, bufB); PE_CONS_V(bufC, B0 + 4 * t + 2);
                PE_ISS(3, bufC); PE_CONS_V(bufD, B0 + 4 * t + 3);
            }
#undef PE_ISS
#undef PE_ISSUE
#undef PE_CONS_U
#undef PE_FLUSH
#undef PE_DPPF
#undef PE_CONS_V
            f32x32 outv;
#pragma unroll
            for (int i = 0; i < 16; ++i) { outv[2 * i] = out2[i][0]; outv[2 * i + 1] = out2[i][1]; }
            if (split) {
                LAS float* pp = (LAS float*)(lds + PE_SCR) + ((size_t)((tl - nfull) * S + (w % S)) * 64 + lane) * 32;
#pragma unroll
                for (int i = 0; i < 8; ++i) { f32x4 t4; t4[0] = outv[4 * i]; t4[1] = outv[4 * i + 1]; t4[2] = outv[4 * i + 2]; t4[3] = outv[4 * i + 3]; *(LAS f32x4*)(pp + 4 * i) = t4; }
            }
            if (!split) {
            const int which = row < NLAT ? (row >> 13) : 2;
            const float* mg = mod + (size_t)which * 12288 + 5 * 2048;
            const bf16_t* xrow = X + (size_t)row * 2048;
            u32x4 xbv[4]; f32x4 gvv[8];
#pragma unroll
            for (int i = 0; i < 4; ++i) xbv[i] = *(const u32x4*)(xrow + lane * 32 + i * 8);
#pragma unroll
            for (int hh = 0; hh < 8; ++hh) gvv[hh] = *(const f32x4*)(mg + lane * 32 + hh * 4);
#pragma unroll
            for (int i = 0; i < 4; ++i) { const u32x4 xw = xbv[i]; const f32x4 g0 = gvv[2 * i], g1 = gvv[2 * i + 1];
                f32x4 o0, o1;
                o0[0] = bflo(xw.x) + g0[0] * outv[i * 8 + 0] * 0.25f; o0[1] = bfhi(xw.x) + g0[1] * outv[i * 8 + 1] * 0.25f; o0[2] = bflo(xw.y) + g0[2] * outv[i * 8 + 2] * 0.25f; o0[3] = bfhi(xw.y) + g0[3] * outv[i * 8 + 3] * 0.25f;
                o1[0] = bflo(xw.z) + g1[0] * outv[i * 8 + 4] * 0.25f; o1[1] = bfhi(xw.z) + g1[1] * outv[i * 8 + 5] * 0.25f; o1[2] = bflo(xw.w) + g1[2] * outv[i * 8 + 6] * 0.25f; o1[3] = bfhi(xw.w) + g1[3] * outv[i * 8 + 7] * 0.25f;
                if (l == 1) { float* orow = p->out + (size_t)row * 2048 + lane * 32 + i * 8; *(f32x4*)orow = o0; *(f32x4*)(orow + 4) = o1; }
                else { u32x4 ow; ow.x = pk2(o0[0], o0[1]); ow.y = pk2(o0[2], o0[3]); ow.z = pk2(o1[0], o1[1]); ow.w = pk2(o1[2], o1[3]); *(u32x4*)(X + (size_t)row * 2048 + lane * 32 + i * 8) = ow; } }
            }
            }
            if (split) {
                __syncthreads();
                if ((w % S) == 0 && tl < nt) {
                    const int row = tb + tl;
                    const int which = row < NLAT ? (row >> 13) : 2;
                    const float* mg = mod + (size_t)which * 12288 + 5 * 2048;
                    const bf16_t* xrow = X + (size_t)row * 2048;
                    const LAS float* pp = (const LAS float*)(lds + PE_SCR) + ((size_t)((tl - nfull) * S) * 64 + lane) * 32;
                    u32x4 xbv[4];
#pragma unroll
                    for (int i = 0; i < 4; ++i) xbv[i] = *(const u32x4*)(xrow + lane * 32 + i * 8);
#pragma unroll
                    for (int i = 0; i < 4; ++i) {
                        f32x4 a0 = *(const LAS f32x4*)(pp + i * 8), a1 = *(const LAS f32x4*)(pp + i * 8 + 4);
                        for (int q = 1; q < S; ++q) { a0 += *(const LAS f32x4*)(pp + (size_t)q * 64 * 32 + i * 8); a1 += *(const LAS f32x4*)(pp + (size_t)q * 64 * 32 + i * 8 + 4); }
                        const f32x4 g0 = *(const f32x4*)(mg + lane * 32 + i * 8), g1 = *(const f32x4*)(mg + lane * 32 + i * 8 + 4);
                        const u32x4 xw = xbv[i];
                        f32x4 o0, o1;
                        o0[0] = bflo(xw.x) + g0[0] * a0[0] * 0.25f; o0[1] = bfhi(xw.x) + g0[1] * a0[1] * 0.25f; o0[2] = bflo(xw.y) + g0[2] * a0[2] * 0.25f; o0[3] = bfhi(xw.y) + g0[3] * a0[3] * 0.25f;
                        o1[0] = bflo(xw.z) + g1[0] * a1[0] * 0.25f; o1[1] = bfhi(xw.z) + g1[1] * a1[1] * 0.25f; o1[2] = bflo(xw.w) + g1[2] * a1[2] * 0.25f; o1[3] = bfhi(xw.w) + g1[3] * a1[3] * 0.25f;
                        if (l == 1) { float* orow = p->out + (size_t)row * 2048 + lane * 32 + i * 8; *(f32x4*)orow = o0; *(f32x4*)(orow + 4) = o1; }
                        else { u32x4 ow; ow.x = pk2(o0[0], o0[1]); ow.y = pk2(o0[2], o0[3]); ow.z = pk2(o1[0], o1[1]); ow.w = pk2(o1[2], o1[3]); *(u32x4*)(X + (size_t)row * 2048 + lane * 32 + i * 8) = ow; }
                    }
                }
            }
        }
    }
}

#if !MK_SINGLE
#define LOHI_ARGS , const int lo, const int hi
#define LOHI_PASS , lo, hi
#else
#define LOHI_ARGS
#define LOHI_PASS
#endif
#ifndef PHM
#define PHM 0x7ff
#endif
#if MK_SINGLE
#define IN(k) (((PHM >> (((k) % NPH))) & 1) != 0)
#define SEAM(k) do { if ((k) + 1 < 2 * NPH) xcd_barrier(bar); } while (0)
#else
#define IN(k) (((PHM >> (((k) % NPH))) & 1) && lo <= (k) && (k) < hi)
#define SEAM(k) do { if (IN(k) && IN((k) + 1)) xcd_barrier(bar); } while (0)
#endif
template <int l>
__device__ __forceinline__ void layer_program(KP kp, unsigned char* ws0, LAS unsigned char* lds, const XcdBarrier& bar, const int G, const int wid0 LOHI_ARGS) {
        const int pb = l * NPH;
        const int M2 = (l == 0) ? MR : NLAT;
        constexpr int MG = NLAT;
        if (IN(pb + 0)) { phase_w(launder_p(kp), l, lds, wid0); } SEAM(pb + 0);
        if (IN(pb + 1)) { phase_norm(launder_p(kp), l, 0, MR, wid0); } SEAM(pb + 1);
        if (IN(pb + 2)) { unsigned char* ws = launder(ws0);
            { pg8::PlainOrder S; S.init(ws + WS_XN8, ws + WS_WIN, MR, (72 - (BF_HI - BF_LO)) * 256, 1024, G, (int)blockIdx.x); S.skip_from = BF_LO; S.skip_cnt = BF_HI - BF_LO; S.skip2_from = 48; S.skip2_cnt = 24;
              if (G == 256 && BF_HI - BF_LO == 8) { S.short_rounds = 15; S.n_long = 192; }
              pg8::EpiProj E{ws};
              pg8::gemm_phase<pg8::EpiProj, pg8::PlainOrder, true>(lds, 1024, S, E, wid0); }
            { pg8::PlainOrder S; S.init(ws + WS_XN, ws + WS_WINB, MR, (24 + BF_HI - BF_LO) * 256, 2048, G, G - 1 - (int)blockIdx.x); S.pn_base = BF_LO; S.skip_from = BF_HI; S.skip_cnt = 48 - BF_HI; S.b_compact = 1;
              pg8::EpiProj E{ws};
              pg8::gemm_phase<pg8::EpiProj, pg8::PlainOrder, false>(lds, 2048, S, E, wid0); }
        } SEAM(pb + 2);
        if (IN(pb + 3)) { phase_gates_gemm(launder_p(kp), l, wid0); phase_e1(launder_p(kp), l, wid0); } SEAM(pb + 3);
        if (IN(pb + 4)) { phase_mlstm(launder_p(kp), l, lds, wid0); phase_attn(launder_p(kp), l, lds, wid0); } SEAM(pb + 4);
        if (IN(pb + 5)) { phase_e2(launder_p(kp), l, M2, wid0); } SEAM(pb + 5);
        if (IN(pb + 6)) { unsigned char* ws = launder(ws0);
            pg8::BranchOrder S; S.T8 = (const char*)(ws + WS_T8); S.WA = (const char*)(ws + WS_WA);
            S.nM = MG / 256; S.nN = 8; S.G = G; S.c = (int)blockIdx.x; S.tstep = (size_t)256 * 2048 * 2;
            pg8::EpiMerge E{(bf16_t*)(ws + WS_Y), (const unsigned char*)(ws + WS_GT)};
            pg8::gemm_phase<pg8::EpiMerge, pg8::BranchOrder>(lds, 2048, S, E, wid0);
            if (l == 0) ctx_gemm<0>(launder_p(kp), l, lds, wid0);
        } SEAM(pb + 6);
        if (IN(pb + 7)) { unsigned char* ws = launder(ws0);
            pg8::PlainOrder S; S.init(ws + WS_Y, ws + WS_WO, MG, 2048, 2048, G, (int)blockIdx.x);
            if constexpr (l == 0) { pg8::EpiRes<true> E{(bf16_t*)(ws + WS_X), kp->x, (const float*)(ws + WS_MOD) + (size_t)l * 3 * 12288};
                pg8::gemm_phase<pg8::EpiRes<true>, pg8::PlainOrder>(lds, 2048, S, E, wid0); }
            else { pg8::EpiRes<false> E{(bf16_t*)(ws + WS_X), nullptr, (const float*)(ws + WS_MOD) + (size_t)l * 3 * 12288};
                pg8::gemm_phase<pg8::EpiRes<false>, pg8::PlainOrder>(lds, 2048, S, E, wid0); }
            if (l == 0) ctx_gemm<1>(launder_p(kp), l, lds, wid0);
        } SEAM(pb + 7);
        if (IN(pb + 8)) { phase_norm(launder_p(kp), l, 1, M2, wid0); } SEAM(pb + 8);
        if (IN(pb + 9)) { unsigned char* ws = launder(ws0);
            pg8::PlainOrder S; S.init(ws + WS_XN, ws + WS_WQ, MG, 2048, 2048, G, (int)blockIdx.x);
            pg8::EpiBf E{(bf16_t*)(ws + WS_PV), 2048};
            pg8::gemm_phase<pg8::EpiBf, pg8::PlainOrder>(lds, 2048, S, E, wid0);
            if (l == 0) ctx_gemm<2>(launder_p(kp), l, lds, wid0);
        } SEAM(pb + 9);
        if (IN(pb + 10)) { phase_peer(launder_p(kp), l, lds, wid0); } SEAM(pb + 10);
    }
#undef IN
#undef SEAM

__global__ void __launch_bounds__(NTHREADS, 2) fwd_kernel(Params p) {
    extern __shared__ __attribute__((aligned(16))) unsigned char lds_raw[];
    LAS unsigned char* lds = (LAS unsigned char*)lds_raw;
    const int tid = threadIdx.x, G = gridDim.x;
    const int wid0 = __builtin_amdgcn_readfirstlane(tid >> 6);
    KP kp = (KP)__builtin_amdgcn_kernarg_segment_ptr();
    unsigned char* ws0 = kp->ws;
    volatile LAS unsigned* bst = (volatile LAS unsigned*)(lds + LDS_BYTES - 16);
    if (tid == 0) { bst[0] = 0u; bst[1] = 0u; bst[2] = 0u; bst[3] = 0u; }
    __syncthreads();
    XcdBarrier bar; bar.bar = (unsigned*)(ws0 + WS_BAR); bar.x = 0; bar.st = bst;
    if (MK_SINGLE) bar = xcd_barrier_post((unsigned*)(ws0 + WS_BAR), bst);
#if !MK_SINGLE
    const int lo = kp->ph_lo, hi = kp->ph_hi;
#endif
    layer_program<0>(kp, ws0, lds, bar, G, wid0 LOHI_PASS);
    layer_program<1>(kp, ws0, lds, bar, G, wid0 LOHI_PASS);
}

extern "C" void kernel_launch(void* const* d_in, const int* in_sizes, int n_in, void* d_out, int out_size, void* d_ws, size_t ws_size, hipStream_t stream) {
    static int grid = 0;
    if (grid == 0) {
        if (n_in != 21 || in_sizes[0] != NLAT * DM || out_size != NLAT * DM || ws_size < WS_END) {
            fprintf(stderr, "kernel_launch: unexpected shapes (n_in %d, in0 %d, out %d, ws %zu need %zu); nothing launched\n", n_in, n_in > 0 ? in_sizes[0] : -1, out_size, ws_size, (size_t)WS_END); grid = -1; return; }
        int dev = 0, cus = 0, per_cu = 0;
        if (hipGetDevice(&dev) != hipSuccess || hipDeviceGetAttribute(&cus, hipDeviceAttributeMultiprocessorCount, dev) != hipSuccess) { grid = -1; return; }
        if (hipFuncSetAttribute((const void*)fwd_kernel, hipFuncAttributeMaxDynamicSharedMemorySize, LDS_BYTES) != hipSuccess) { fprintf(stderr, "kernel_launch: hipFuncSetAttribute failed\n"); grid = -1; return; }
        if (hipOccupancyMaxActiveBlocksPerMultiprocessor(&per_cu, (const void*)fwd_kernel, NTHREADS, LDS_BYTES) != hipSuccess || per_cu < 1) { fprintf(stderr, "kernel_launch: occupancy query says %d\n", per_cu); }
        (void)hipGetLastError();
        grid = cus;
    }
    if (grid < 0) return;
    (void)hipMemsetAsync((char*)d_ws, 0, 16384, stream);
    Params p{};
    const float** pp = (const float**)&p;
    for (int i = 0; i < 21; ++i) pp[i] = (const float*)d_in[i];
    p.out = (float*)d_out; p.ws = (unsigned char*)d_ws;
#if MK_SINGLE
    p.ph_lo = 0; p.ph_hi = 2 * NPH;
    hipLaunchKernelGGL(fwd_kernel, dim3(grid), dim3(NTHREADS), LDS_BYTES, stream, p);
#else
    for (int k = 0; k < 2 * NPH; ++k) { p.ph_lo = k; p.ph_hi = k + 1; hipLaunchKernelGGL(fwd_kernel, dim3(grid), dim3(NTHREADS), LDS_BYTES, stream, p); }
#endif
}
```

```cpp
#include <hip/hip_runtime.h>
#include <stdint.h>
#include <stdio.h>
#include <type_traits>

#ifndef BF_LO
#define BF_LO 0
#define BF_HI 8
#endif
#ifndef MK_SINGLE
#define MK_SINGLE 1
#endif

#define LAS __attribute__((address_space(3)))
typedef unsigned short bf16_t;
typedef short bf16x8 __attribute__((ext_vector_type(8)));
typedef float f32x4 __attribute__((ext_vector_type(4)));
typedef float f32x2 __attribute__((ext_vector_type(2)));
typedef unsigned u32x4 __attribute__((ext_vector_type(4)));
typedef unsigned u32x2 __attribute__((ext_vector_type(2)));
typedef __bf16 bf2_t __attribute__((ext_vector_type(2)));
typedef int i32x4 __attribute__((ext_vector_type(4)));
typedef int i32x8 __attribute__((ext_vector_type(8)));
typedef float f32x16 __attribute__((ext_vector_type(16)));
typedef float f32x32 __attribute__((ext_vector_type(32)));
typedef unsigned u32x6 __attribute__((ext_vector_type(6)));
typedef __bf16 bf16x32_t __attribute__((ext_vector_type(32)));
typedef unsigned u32x16 __attribute__((ext_vector_type(16)));
typedef short s16x4 __attribute__((ext_vector_type(4)));
#ifndef FP6_INTERLEAVED
#define FP6_INTERLEAVED 1
#endif

constexpr int DM = 2048, NBATCH = 2, SEQ = 8192, CTXL = 256;
constexpr int NLAT = NBATCH * SEQ;
constexpr int NCTX = NBATCH * CTXL;
constexpr int MR = NLAT + NCTX;
constexpr int PROJ_W = 24608;
constexpr int NPROJ = 24576;
constexpr int NTHREADS = 512;
constexpr int LDS_BYTES = 163840;
constexpr int NPH = 11;
constexpr float EPSF = 1e-6f;

constexpr size_t SZ_A = (size_t)MR * 2048 * 2;
constexpr size_t WS_BAR = 0;
constexpr size_t WS_MOD = 16384;
constexpr size_t CTL_BYTES = 16384 + 2 * 3 * 12288 * 4;
constexpr size_t WS_TAB = 311296;
constexpr size_t WS_X = WS_TAB + 32768;
constexpr size_t WS_XN = WS_X + (size_t)MR * 2048 * 4;
constexpr size_t WS_Y = WS_XN + SZ_A;
constexpr size_t WS_XN8 = WS_Y;
constexpr size_t WS_PQ = WS_Y + SZ_A;
constexpr size_t WS_PK = WS_PQ + SZ_A / 2;
constexpr size_t WS_T8 = WS_PK + SZ_A / 2;
constexpr size_t WS_PV = WS_T8 + 0 * SZ_A;
constexpr size_t WS_PO = WS_T8 + 1 * SZ_A;
constexpr size_t WS_CQ = WS_T8 + 2 * SZ_A;
constexpr size_t WS_CK = WS_T8 + 3 * SZ_A;
constexpr size_t WS_CV = WS_T8 + 4 * SZ_A;
constexpr size_t WS_BB = WS_T8 + 5 * SZ_A;
constexpr size_t WS_BC = WS_T8 + 6 * SZ_A;
constexpr size_t WS_BX = WS_T8 + 7 * SZ_A;
constexpr size_t WS_GT = WS_T8 + 8 * SZ_A;
constexpr size_t WS_AO8 = WS_GT + (size_t)MR * 6144;
constexpr size_t WS_GATES = WS_GT + 3 * SZ_A;
constexpr size_t WS_WIN = WS_GATES + (size_t)MR * 32 * 4;
constexpr size_t WS_WINB = WS_WIN + (size_t)NPROJ * 2048;
constexpr size_t WS_WG = WS_WIN + (size_t)NPROJ * 2048 * 2;
constexpr size_t SZ_W = (size_t)2048 * 2048 * 2;
constexpr size_t WS_WA = WS_WG + 32 * 2048 * 2;
constexpr size_t WS_WB = WS_WA + SZ_W;
constexpr size_t WS_WC = WS_WB + SZ_W;
constexpr size_t WS_WO = WS_WC + SZ_W;
constexpr size_t WS_WQ = WS_WO + SZ_W;
constexpr size_t WS_KEYS = WS_WQ + SZ_W;
constexpr size_t WS_PU = WS_KEYS + 16 * 128 * 128 * 2;
constexpr size_t WS_PVW = WS_PU + (size_t)16384 * 2048 * 2;
constexpr size_t WS_SCAN = WS_PU + (size_t)16384 * 1024;
constexpr size_t WS_END = WS_PVW + (size_t)16384 * 2048 * 2;

struct Params {
    const float *x, *c, *ctx, *c_ctx, *w_ada, *b_ada, *norm_g, *w_in, *a_gate_b, *a_hnorm_g, *b_conv, *c_qk_g, *c_rpb,
        *w_a_out, *w_b_out, *w_c_out, *w_out, *peer_wq, *peer_keys, *peer_u, *peer_v;
    float* out; unsigned char* ws; int ph_lo, ph_hi;
};
#define CAS __attribute__((address_space(4)))
#define GAS __attribute__((address_space(1)))
typedef const CAS Params* KP;
__device__ __forceinline__ KP launder_p(KP q) { asm volatile("" : "+s"(q)); return q; }

__device__ __forceinline__ unsigned char* launder(unsigned char* q) { size_t z = 0; asm volatile("" : "+s"(z)); return q + z; }
__device__ __forceinline__ int tid_fresh(int wid0) { int t = wid0 * 64 + (int)__builtin_amdgcn_mbcnt_hi(~0u, __builtin_amdgcn_mbcnt_lo(~0u, 0u)); asm volatile("" : "+v"(t)); return t; }

__device__ __forceinline__ float bf2f(unsigned b) { return __uint_as_float(b << 16); }
__device__ __forceinline__ float bflo(unsigned w) { return __uint_as_float(w << 16); }
__device__ __forceinline__ float bfhi(unsigned w) { return __uint_as_float(w & 0xffff0000u); }
__device__ __forceinline__ unsigned pk2(float lo, float hi) { f32x2 v = {lo, hi}; bf2_t b = __builtin_convertvector(v, bf2_t); return __builtin_bit_cast(unsigned, b); }
__device__ __forceinline__ bf16_t f2bf(float f) { return (bf16_t)(pk2(f, 0.f) & 0xffffu); }
__device__ __forceinline__ f32x4 mfma16(bf16x8 a, bf16x8 b, f32x4 c) { return __builtin_amdgcn_mfma_f32_16x16x32_bf16(a, b, c, 0, 0, 0); }
__device__ __forceinline__ float dot2bf(unsigned a, unsigned b, float c) { return __builtin_amdgcn_fdot2_f32_bf16(__builtin_bit_cast(bf2_t, a), __builtin_bit_cast(bf2_t, b), c, false); }
#define LDS_BARRIER() do { asm volatile("s_waitcnt lgkmcnt(0)" ::: "memory"); __builtin_amdgcn_s_barrier(); asm volatile("" ::: "memory"); } while (0)
__device__ __forceinline__ float rlane(float v, int l) { return __uint_as_float((unsigned)__builtin_amdgcn_readlane((int)__float_as_uint(v), l)); }
#define WS_DPPF(v, ctrl) __uint_as_float((unsigned)__builtin_amdgcn_update_dpp(0, (int)__float_as_uint(v), ctrl, 0xf, 0xf, true))
__device__ __forceinline__ float wave_sum(float v) {
    { const u32x2 t = __builtin_amdgcn_permlane32_swap(__float_as_uint(v), __float_as_uint(v), false, false); v = __uint_as_float(t.x) + __uint_as_float(t.y); }
    { const u32x2 t = __builtin_amdgcn_permlane16_swap(__float_as_uint(v), __float_as_uint(v), false, false); v = __uint_as_float(t.x) + __uint_as_float(t.y); }
    v += WS_DPPF(v, 0x140); v += WS_DPPF(v, 0x141); v += WS_DPPF(v, 0x4E); v += WS_DPPF(v, 0xB1);
    return v;
}
__device__ __forceinline__ float sigmoidf_(float v) { return __builtin_amdgcn_rcpf(1.0f + __expf(-v)); }
__device__ __forceinline__ float logsigmoidf_(float v) { return fminf(v, 0.f) - log1pf(__expf(-fabsf(v))); }

#define XB_TMO      128
#define XB_XCNT(j)  (256  + 64 * (j))
#define XB_XSUB(j)  (1280 + 64 * (j))
#define XB_XGEN(j)  (2304 + 64 * (j))
#define XB_TOP      3328
#define XB_TOPGEN   3392
#define XCD_BAR_WORDS 3456
#define XB_SPIN_CAP (1u << 22)
__device__ __forceinline__ unsigned xb_ld(unsigned* p)              { return __hip_atomic_load(p, __ATOMIC_RELAXED, __HIP_MEMORY_SCOPE_AGENT); }
__device__ __forceinline__ unsigned xb_add(unsigned* p, unsigned v) { return __hip_atomic_fetch_add(p, v, __ATOMIC_RELAXED, __HIP_MEMORY_SCOPE_AGENT); }
__device__ __forceinline__ unsigned xb_xcc_id() { return (unsigned)__builtin_amdgcn_s_getreg((3 << 11) | 20) & 0xFu; }
#define XB_SPIN(cond, bar) do { unsigned _sp = 0; while (cond) { __builtin_amdgcn_s_sleep(1); \
    if ((++_sp & 255u) == 0u) { if (xb_ld(&(bar)[XB_TMO])) break; if (_sp > XB_SPIN_CAP) { atomicAdd(&(bar)[XB_TMO], 1u); break; } } } } while (0)
struct XcdBarrier { unsigned* bar; unsigned x; volatile LAS unsigned* st; };
__device__ __forceinline__ XcdBarrier xcd_barrier_post(unsigned* bar, volatile LAS unsigned* st) {
    XcdBarrier b; b.bar = bar; b.x = xb_xcc_id(); b.st = st;
    if (threadIdx.x == 0) (void)xb_add(&bar[XB_XCNT(b.x)], 1u);
    return b;
}
__device__ __forceinline__ void xcd_barrier_complete(unsigned* bar, unsigned x, unsigned& nloc, unsigned& nx) {
    const unsigned G = gridDim.x * gridDim.y * gridDim.z;
    unsigned sum, cnt, mine, sp = 0u;
    for (;;) {
        sum = 0u; cnt = 0u; mine = 0u;
#pragma unroll
        for (unsigned j = 0; j < 16; ++j) { const unsigned c = xb_ld(&bar[XB_XCNT(j)]); sum += c; cnt += (c > 0u) ? 1u : 0u; mine = (j == x) ? c : mine; }
        if (sum == G) break;
        __builtin_amdgcn_s_sleep(1);
        if ((++sp & 255u) == 0u) { if (xb_ld(&bar[XB_TMO])) break; if (sp > XB_SPIN_CAP) { atomicAdd(&bar[XB_TMO], 1u); break; } }
    }
    nloc = mine > 0u ? mine : 1u; nx = cnt > 0u ? cnt : 1u;
}
__device__ __forceinline__ void xcd_barrier(const XcdBarrier& b) {
    asm volatile("s_waitcnt vmcnt(0)" ::: "memory");
    __syncthreads();
    if (threadIdx.x == 0) {
        unsigned* bar = b.bar;
        __builtin_amdgcn_s_waitcnt(0);
        unsigned nloc = b.st[0], nx = b.st[1];
        if (nloc == 0u) { xcd_barrier_complete(bar, b.x, nloc, nx); b.st[0] = nloc; b.st[1] = nx; }
        const unsigned old = xb_add(&bar[XB_XSUB(b.x)], 1u);
        const unsigned gen = old / nloc;
        if (old + 1u == (gen + 1u) * nloc) {
            __builtin_amdgcn_fence(__ATOMIC_RELEASE, "agent");
            asm volatile("s_waitcnt vmcnt(0)" ::: "memory");
            const unsigned og = xb_add(&bar[XB_TOP], 1u);
            const unsigned tg = og / nx;
            if (og + 1u == (tg + 1u) * nx) xb_add(&bar[XB_TOPGEN], 1u);
            else XB_SPIN(xb_ld(&bar[XB_TOPGEN]) == tg, bar);
            __builtin_amdgcn_fence(__ATOMIC_ACQUIRE, "agent");
            xb_add(&bar[XB_XGEN(b.x)], 1u);
            asm volatile("s_waitcnt vmcnt(0)" ::: "memory");
        } else {
            XB_SPIN(xb_ld(&bar[XB_XGEN(b.x)]) == gen, bar);
            __builtin_amdgcn_fence(__ATOMIC_ACQUIRE, "agent");
            asm volatile("s_waitcnt vmcnt(0)" ::: "memory");
        }
    }
    __syncthreads();
}

namespace pg8 {
constexpr int BM = 256, BK = 64, HALF = 128, HTB = HALF * BK * 2, STAGE_BYTES = 8 * HTB, NXCD = 8, WGM = 8;
__host__ __device__ __forceinline__ int lds_byte(int r, int c) { const int st = (r >> 4) * 2 + (c >> 5), rr = r & 15, cc = c & 31, ob = rr * 64 + cc * 2; return st * 1024 + (ob ^ (((ob >> 9) & 1) << 5)); }
__host__ __device__ __forceinline__ void stage_rc(int b, int& R, int& C) { const int st = b / 1024, sb = b % 1024, swz = sb ^ (((sb >> 9) & 1) << 5); R = (st >> 1) * 16 + swz / 64; C = (st & 1) * 32 + (swz % 64) / 2; }
__host__ __device__ __forceinline__ int perm32(int rho) { const int n = rho >> 4, i = rho & 15; return 8 * (i >> 2) + 4 * n + (i & 3); }

struct Unit { int pm, pn, br; const char* A; const char* B; };

__device__ __forceinline__ bool tile_of(int L, int nM, int nN, int& pm, int& pn) {
    const int nwg = nM * nN; if (L >= nwg) return false;
    int wgid = L; { const int q = nwg / NXCD, r = nwg % NXCD, xcd = wgid % NXCD, off = wgid / NXCD; wgid = (xcd < r ? xcd * (q + 1) : r * (q + 1) + (xcd - r) * q) + off; }
    const int nig = WGM * nN, gid = wgid / nig, fm = gid * WGM, gsz = (nM - fm) < WGM ? (nM - fm) : WGM;
    pm = fm + ((wgid % nig) % gsz); pn = (wgid % nig) / gsz; return true;
}
struct PlainOrder {
    const char* A; const char* Bt; int nM, nN, G, c; size_t tstep; int pn_base, skip_from, skip_cnt, skip2_from, skip2_cnt, b_row0, b_compact, short_rounds, n_long;
    __device__ __forceinline__ void init(const void* A_, const void* Bt_, int M, int N, int K, int G_, int c_) { A = (const char*)A_; Bt = (const char*)Bt_; nM = M / BM; nN = N / BM; G = G_; c = c_; tstep = (size_t)BM * K * 2;
        pn_base = 0; skip_from = 1 << 30; skip_cnt = 0; skip2_from = 1 << 30; skip2_cnt = 0; b_row0 = 0; b_compact = 0; short_rounds = 1 << 30; n_long = 0; }
    __device__ __forceinline__ bool next(int i, Unit& u) const {
        int L = i * G + c;
        if (i >= short_rounds) { if (c >= n_long) return false; const int per = (nM * nN - short_rounds * G) / n_long, j = i - short_rounds; if (j >= per) return false; L = short_rounds * G + per * c + j; }
        int pm, pn; if (!tile_of(L, nM, nN, pm, pn)) return false;
        const int pnc = pn;
        pn += pn_base; if (pn >= skip_from) pn += skip_cnt; if (pn >= skip2_from) pn += skip2_cnt;
        u.pm = pm; u.pn = pn; u.br = 0; u.A = A + (size_t)pm * tstep; u.B = Bt + (size_t)(b_compact ? pnc : pn - b_row0) * tstep; return true;
    }
};
struct BranchOrder {
    const char* T8; const char* WA; int nM, nN, G, c; size_t tstep;
    __device__ __forceinline__ bool next(int i, Unit& u) const {
        const int tl = i / 3, br = i - 3 * tl; int pm, pn; if (!tile_of(tl * G + c, nM, nN, pm, pn)) return false;
        u.pm = pm; u.pn = pn; u.br = br;
        const int ti = 1 + 4 * (br == 1) + (br == 2);
        u.A = T8 + (size_t)ti * SZ_A + (size_t)pm * tstep; u.B = WA + (size_t)br * SZ_W + (size_t)pn * tstep; return true;
    }
};

template <class Epi, class Sched, bool FP8 = false>
__device__ __forceinline__ void gemm_phase(LAS unsigned char* lds, const int K, const Sched& S, const Epi& E, int wid0) {
    const int tid = tid_fresh(wid0), wid = __builtin_amdgcn_readfirstlane(tid >> 6), lane = tid & 63, wr = wid >> 2, wc = wid & 3, fr = lane & 15, fq = lane >> 4;
    const int nt = K / BK;
    unsigned voffA[2], voffB[2];
#pragma unroll
    for (int i = 0; i < 2; ++i) { int R, C; stage_rc(tid * 16 + i * 8192, R, C); const int Rb = Epi::PERM ? ((R & ~31) + perm32(R & 31)) : R;
        voffA[i] = (unsigned)(R * K + C) * 2u; voffB[i] = (unsigned)(Rb * K + C) * 2u; }
    const size_t kstep = (size_t)(BK * 2);
    const size_t hstep = (size_t)HALF * K * 2;
    const unsigned ldsw = (unsigned)wid * 1024u;
    const int aoff = lds_byte(wr * 64 + fr, fq * 8), boff = lds_byte(wc * 32 + fr, fq * 8);
#define PG8_SA(b, h) (((b) * 2 + (h)) * HTB)
#define PG8_SB(b, h) ((4 + (b) * 2 + (h)) * HTB)
#define PG8_STAGE(bufoff, gbase, voff) do { _Pragma("unroll") for (int _i = 0; _i < 2; ++_i) \
        __builtin_amdgcn_global_load_lds((const unsigned*)((const char*)(gbase) + (voff)[_i]), (LAS unsigned*)(lds + (bufoff) + ldsw + _i * 8192), 16, 0, 0); } while (0)
#define PG8_LD1(dstv, addr) do { if constexpr (FP8) { const i32x4 _lo = *(const LAS i32x4*)(lds + (addr)), _hi = *(const LAS i32x4*)(lds + (addr) + 1024); dstv[0] = __builtin_shufflevector(_lo, _hi, 0, 1, 2, 3, 4, 5, 6, 7); } \
        else { _Pragma("unroll") for (int k = 0; k < 2; ++k) dstv[k] = *(const LAS bf16x8*)(lds + (addr) + k * 1024); } } while (0)
#define PG8_LDA(dst, b, h) do { _Pragma("unroll") for (int m = 0; m < 4; ++m) PG8_LD1(dst[m], PG8_SA(b, h) + aoff + m * 2048); } while (0)
#define PG8_LDB(dst, b, h) do { _Pragma("unroll") for (int n = 0; n < 2; ++n) PG8_LD1(dst[n], PG8_SB(b, h) + boff + n * 2048); } while (0)
#define PG8_MMA(ai, bj, At, Bt) do { __builtin_amdgcn_s_setprio(1); _Pragma("unroll") for (int m = 0; m < 4; ++m) _Pragma("unroll") for (int n = 0; n < 2; ++n) { \
        if constexpr (FP8) asm volatile("v_mfma_scale_f32_16x16x128_f8f6f4 %0, %1, %2, %0, %3, %4 op_sel_hi:[0,0,0]" : "+v"(acc[ai][bj][m][n]) : "v"(Bt[n][0]), "v"(At[m][0]), "v"(sclW), "v"(sclX)); \
        else { _Pragma("unroll") for (int k = 0; k < 2; ++k) acc[ai][bj][m][n] = __builtin_amdgcn_mfma_f32_16x16x32_bf16(Bt[n][k], At[m][k], acc[ai][bj][m][n], 0, 0, 0); } } \
        __builtin_amdgcn_s_setprio(0); } while (0)
#define PG8_WAIT_V(n) asm volatile("s_waitcnt vmcnt(" #n ")" ::: "memory")
#define PG8_WAIT_L(n) asm volatile("s_waitcnt lgkmcnt(" #n ")" ::: "memory")
#define PG8_BAR __builtin_amdgcn_s_barrier()
#define PG8_SCHED __builtin_amdgcn_sched_barrier(0)
    Unit cur, nxt; int ui = 0;
    if (!S.next(0, cur)) return;
    const int sclW = 0x75757575, sclX = 0x7F7F7F7F;
    f32x4 acc[2][2][4][2];
#pragma unroll
    for (int a = 0; a < 2; ++a)
#pragma unroll
        for (int b = 0; b < 2; ++b)
#pragma unroll
            for (int m = 0; m < 4; ++m)
#pragma unroll
                for (int n = 0; n < 2; ++n) acc[a][b][m][n] = (f32x4){0.f, 0.f, 0.f, 0.f};
    typedef typename std::conditional<FP8, i32x8, bf16x8>::type frag_t;
    frag_t At[4][FP8 ? 1 : 2], B0[2][FP8 ? 1 : 2], B1[2][FP8 ? 1 : 2];
    const char* cA = cur.A; const char* cB = cur.B;
    PG8_STAGE(PG8_SB(0, 0), cB, voffB); PG8_STAGE(PG8_SA(0, 0), cA, voffA); PG8_STAGE(PG8_SB(0, 1), cB + hstep, voffB); PG8_STAGE(PG8_SA(0, 1), cA + hstep, voffA);
    if (wr == 1) PG8_BAR;
    PG8_WAIT_V(4); PG8_BAR;
    PG8_STAGE(PG8_SB(1, 0), cB + kstep, voffB); PG8_STAGE(PG8_SA(1, 0), cA + kstep, voffA); PG8_STAGE(PG8_SB(1, 1), cB + hstep + kstep, voffB);
    PG8_WAIT_V(6); PG8_BAR;
    for (;;) {
        const bool has_next = S.next(ui + 1, nxt);
        const char* nA = has_next ? nxt.A : cA; const char* nB = has_next ? nxt.B : cB;
        for (int t = 0; t < nt; t += 2) {
            const bool last = (t == nt - 2);
            const char* a1 = cA + (size_t)(t + 1) * kstep;
            const char* a2 = last ? nA : cA + (size_t)(t + 2) * kstep; const char* b2 = last ? nB : cB + (size_t)(t + 2) * kstep;
            const char* a3 = a2 + kstep; const char* b3 = b2 + kstep;
            PG8_LDB(B0, 0, 0); PG8_SCHED; PG8_LDA(At, 0, 0); PG8_STAGE(PG8_SA(1, 1), a1 + hstep, voffA);
            PG8_WAIT_L(8); PG8_BAR; PG8_WAIT_L(0); PG8_MMA(0, 0, At, B0); PG8_BAR; PG8_SCHED;
            PG8_LDB(B1, 0, 1); PG8_STAGE(PG8_SB(0, 0), b2, voffB);
            PG8_BAR; PG8_WAIT_L(0); PG8_MMA(0, 1, At, B1); PG8_BAR;
            PG8_LDA(At, 0, 1); PG8_STAGE(PG8_SA(0, 0), a2, voffA);
            PG8_BAR; PG8_WAIT_L(0); PG8_MMA(1, 0, At, B0); PG8_BAR; PG8_SCHED;
            PG8_STAGE(PG8_SB(0, 1), b2 + hstep, voffB);
            PG8_WAIT_V(6); PG8_BAR; PG8_MMA(1, 1, At, B1); PG8_BAR;
            PG8_LDB(B0, 1, 0); PG8_SCHED; PG8_LDA(At, 1, 0); PG8_STAGE(PG8_SA(0, 1), a2 + hstep, voffA);
            PG8_WAIT_L(8); PG8_BAR; PG8_WAIT_L(0); PG8_MMA(0, 0, At, B0); PG8_BAR; PG8_SCHED;
            PG8_LDB(B1, 1, 1); PG8_STAGE(PG8_SB(1, 0), b3, voffB);
            PG8_BAR; PG8_WAIT_L(0); PG8_MMA(0, 1, At, B1); PG8_BAR;
            PG8_LDA(At, 1, 1); PG8_STAGE(PG8_SA(1, 0), a3, voffA);
            PG8_BAR; PG8_WAIT_L(0); PG8_MMA(1, 0, At, B0); PG8_BAR; PG8_SCHED;
            PG8_STAGE(PG8_SB(1, 1), b3 + hstep, voffB);
            PG8_WAIT_V(6); PG8_BAR; PG8_MMA(1, 1, At, B1); PG8_BAR;
        }
        if constexpr (FP8) { asm volatile("s_nop 15\n\ts_nop 15\n\ts_nop 15" ::: "memory"); }
        E(acc, cur, wr, wc, fr, fq);
        if (!has_next) break;
#pragma unroll
        for (int a = 0; a < 2; ++a)
#pragma unroll
            for (int b = 0; b < 2; ++b)
#pragma unroll
                for (int m = 0; m < 4; ++m)
#pragma unroll
                    for (int n = 0; n < 2; ++n) acc[a][b][m][n] = (f32x4){0.f, 0.f, 0.f, 0.f};
        cur = nxt; cA = nA; cB = nB; ++ui;
    }
    PG8_WAIT_V(0);
    if (wr == 0) PG8_BAR;
    PG8_BAR;
#undef PG8_SA
#undef PG8_SB
#undef PG8_STAGE
#undef PG8_LD1
#undef PG8_LDA
#undef PG8_LDB
#undef PG8_MMA
#undef PG8_WAIT_V
#undef PG8_WAIT_L
#undef PG8_BAR
#undef PG8_SCHED
}

struct EpiProj {
    static constexpr bool PERM = true;
    unsigned char* ws;
    __device__ __forceinline__ void operator()(const f32x4 (&acc)[2][2][4][2], const Unit& u, int wr, int wc, int fr, int fq) const {
        const int pn = u.pn; size_t off; int ld, c0;
        if (pn < 4) { off = WS_PQ; ld = 1024; c0 = pn * 256; }
        else if (pn < 8) { off = WS_PK; ld = 1024; c0 = (pn - 4) * 256; }
        else if (pn < 72) { const int t = (pn - 8) >> 3; off = WS_T8 + (size_t)t * SZ_A; ld = 2048; c0 = ((pn - 8) & 7) * 256; }
        else { off = 0; ld = 0; c0 = 0; }
        if (pn >= 72 || (pn >= 16 && pn < 24)) {
            const size_t gld = pn >= 72 ? 6144 : 2048;
            GAS unsigned char* gp = (GAS unsigned char*)ws + (pn >= 72 ? WS_GT + (size_t)(pn - 72) * 256 : WS_AO8 + (size_t)(pn - 16) * 256) + (size_t)(u.pm * BM + wr * 64 + fr) * gld + wc * 32 + 8 * fq;
#pragma unroll
            for (int ai = 0; ai < 2; ++ai) {
#pragma unroll
                for (int m = 0; m < 4; ++m) {
                    asm volatile("" : "+v"(gp));
#pragma unroll
                    for (int bj = 0; bj < 2; ++bj) { const f32x4 v0 = acc[ai][bj][m][0], v1 = acc[ai][bj][m][1];
                        unsigned q[8];
#pragma unroll
                        for (int j = 0; j < 4; ++j) { q[j] = (unsigned)(sigmoidf_(v0[j]) * 255.0f + 0.5f); q[4 + j] = (unsigned)(sigmoidf_(v1[j]) * 255.0f + 0.5f); }
                        u32x2 w; w.x = q[0] | (q[1] << 8) | (q[2] << 16) | (q[3] << 24); w.y = q[4] | (q[5] << 8) | (q[6] << 16) | (q[7] << 24);
                        *(GAS u32x2*)(gp + bj * HALF) = w; }
                    gp += (size_t)16 * gld;
                }
                gp += (size_t)64 * gld;
            }
            return;
        }
        GAS bf16_t* rp = (GAS bf16_t*)(ws + off) + (size_t)(u.pm * BM + wr * 64 + fr) * ld + c0 + wc * 32 + 8 * fq;
        const size_t step = (size_t)16 * ld;
#pragma unroll
        for (int ai = 0; ai < 2; ++ai) {
#pragma unroll
            for (int m = 0; m < 4; ++m) {
                asm volatile("" : "+v"(rp));
#pragma unroll
                for (int bj = 0; bj < 2; ++bj) { const f32x4 v0 = acc[ai][bj][m][0], v1 = acc[ai][bj][m][1];
                    u32x4 w; w.x = pk2(v0[0], v0[1]); w.y = pk2(v0[2], v0[3]); w.z = pk2(v1[0], v1[1]); w.w = pk2(v1[2], v1[3]);
                    *(GAS u32x4*)(rp + bj * HALF) = w; }
                rp += step;
            }
            rp += 4 * step;
        }
    }
};
struct EpiBf {
    static constexpr bool PERM = true;
    bf16_t* O; int ld;
    __device__ __forceinline__ void operator()(const f32x4 (&acc)[2][2][4][2], const Unit& u, int wr, int wc, int fr, int fq) const {
        const int row0 = u.pm * BM + wr * 64 + fr, col0 = u.pn * BM + wc * 32 + 8 * fq;
#pragma unroll
        for (int ai = 0; ai < 2; ++ai)
#pragma unroll
            for (int m = 0; m < 4; ++m) { bf16_t* rowp = O + (size_t)(row0 + ai * HALF + m * 16) * ld + col0;
#pragma unroll
                for (int bj = 0; bj < 2; ++bj) { const f32x4 v0 = acc[ai][bj][m][0], v1 = acc[ai][bj][m][1];
                    u32x4 w; w.x = pk2(v0[0], v0[1]); w.y = pk2(v0[2], v0[3]); w.z = pk2(v1[0], v1[1]); w.w = pk2(v1[2], v1[3]);
                    *(u32x4*)(rowp + bj * HALF) = w; } }
    }
};
__device__ __forceinline__ float gq8(unsigned w, int i) { return (float)((w >> (8 * i)) & 0xffu); }
struct EpiMerge {
    static constexpr bool PERM = true;
    bf16_t* Y; const unsigned char* GT;
    __device__ __forceinline__ void operator()(const f32x4 (&acc)[2][2][4][2], const Unit& u, int wr, int wc, int fr, int fq) const {
        const int row0 = u.pm * BM + wr * 64 + fr, col0 = u.pn * BM + wc * 32 + 8 * fq;
        const bool addy = u.br != 0;
#pragma unroll
        for (int ai = 0; ai < 2; ++ai) {
            u32x2 g[4][2]; u32x4 y[4][2];
#pragma unroll
            for (int m = 0; m < 4; ++m)
#pragma unroll
                for (int bj = 0; bj < 2; ++bj) { const size_t r = (size_t)(row0 + ai * HALF + m * 16);
                    g[m][bj] = *(const u32x2*)(GT + r * 6144 + (size_t)u.br * 2048 + col0 + bj * HALF); }
            if (addy) {
#pragma unroll
                for (int m = 0; m < 4; ++m)
#pragma unroll
                    for (int bj = 0; bj < 2; ++bj) { const size_t r = (size_t)(row0 + ai * HALF + m * 16); y[m][bj] = *(const u32x4*)(Y + r * 2048 + col0 + bj * HALF); }
            } else {
#pragma unroll
                for (int m = 0; m < 4; ++m)
#pragma unroll
                    for (int bj = 0; bj < 2; ++bj) y[m][bj] = (u32x4){0u, 0u, 0u, 0u};
            }
#pragma unroll
            for (int m = 0; m < 4; ++m)
#pragma unroll
                for (int bj = 0; bj < 2; ++bj) { const size_t r = (size_t)(row0 + ai * HALF + m * 16);
                    const f32x4 v0 = acc[ai][bj][m][0] * (1.0f / 255.0f), v1 = acc[ai][bj][m][1] * (1.0f / 255.0f); const u32x2 gg = g[m][bj]; const u32x4 yy = y[m][bj];
                    float o[8];
                    o[0] = gq8(gg.x, 0) * v0[0] + bflo(yy.x); o[1] = gq8(gg.x, 1) * v0[1] + bfhi(yy.x); o[2] = gq8(gg.x, 2) * v0[2] + bflo(yy.y); o[3] = gq8(gg.x, 3) * v0[3] + bfhi(yy.y);
                    o[4] = gq8(gg.y, 0) * v1[0] + bflo(yy.z); o[5] = gq8(gg.y, 1) * v1[1] + bfhi(yy.z); o[6] = gq8(gg.y, 2) * v1[2] + bflo(yy.w); o[7] = gq8(gg.y, 3) * v1[3] + bfhi(yy.w);
                    u32x4 w; w.x = pk2(o[0], o[1]); w.y = pk2(o[2], o[3]); w.z = pk2(o[4], o[5]); w.w = pk2(o[6], o[7]);
                    *(u32x4*)(Y + r * 2048 + col0 + bj * HALF) = w; }
        }
    }
};
template <bool XF32> struct EpiRes {
    static constexpr bool PERM = true;
    bf16_t* X; const float* Xf; const float* mod;
    __device__ __forceinline__ void operator()(const f32x4 (&acc)[2][2][4][2], const Unit& u, int wr, int wc, int fr, int fq) const {
        const int row0 = u.pm * BM + wr * 64 + fr, col0 = u.pn * BM + wc * 32 + 8 * fq;
        const int which = (u.pm < 32) ? 0 : (u.pm < 64 ? 1 : 2);
        const float* mg = mod + (size_t)which * 12288 + 2 * 2048 + col0;
        f32x4 gv[2][2];
#pragma unroll
        for (int bj = 0; bj < 2; ++bj)
#pragma unroll
            for (int n = 0; n < 2; ++n) gv[bj][n] = *(const f32x4*)(mg + bj * HALF + n * 4);
#pragma unroll
        for (int ai = 0; ai < 2; ++ai) {
            if constexpr (XF32) {
#pragma unroll
              for (int mh = 0; mh < 2; ++mh) {
                f32x4 xin[2][2][2];
#pragma unroll
                for (int m = 0; m < 2; ++m)
#pragma unroll
                    for (int bj = 0; bj < 2; ++bj)
#pragma unroll
                        for (int n = 0; n < 2; ++n) xin[m][bj][n] = *(const f32x4*)(Xf + (size_t)(row0 + ai * HALF + (2 * mh + m) * 16) * 2048 + col0 + bj * HALF + n * 4);
#pragma unroll
                for (int m = 0; m < 2; ++m)
#pragma unroll
                    for (int bj = 0; bj < 2; ++bj) {
                        const f32x4 o0 = xin[m][bj][0] + gv[bj][0] * acc[ai][bj][2 * mh + m][0], o1 = xin[m][bj][1] + gv[bj][1] * acc[ai][bj][2 * mh + m][1];
                        u32x4 ow; ow.x = pk2(o0[0], o0[1]); ow.y = pk2(o0[2], o0[3]); ow.z = pk2(o1[0], o1[1]); ow.w = pk2(o1[2], o1[3]);
                        *(u32x4*)(X + (size_t)(row0 + ai * HALF + (2 * mh + m) * 16) * 2048 + col0 + bj * HALF) = ow; }
              }
            } else {
                u32x4 xb[4][2];
#pragma unroll
                for (int m = 0; m < 4; ++m)
#pragma unroll
                    for (int bj = 0; bj < 2; ++bj) xb[m][bj] = *(const u32x4*)(X + (size_t)(row0 + ai * HALF + m * 16) * 2048 + col0 + bj * HALF);
#pragma unroll
                for (int m = 0; m < 4; ++m)
#pragma unroll
                    for (int bj = 0; bj < 2; ++bj) { const u32x4 xw = xb[m][bj]; const f32x4 a0 = acc[ai][bj][m][0], a1 = acc[ai][bj][m][1], g0 = gv[bj][0], g1 = gv[bj][1];
                        u32x4 ow; ow.x = pk2(bflo(xw.x) + g0[0] * a0[0], bfhi(xw.x) + g0[1] * a0[1]); ow.y = pk2(bflo(xw.y) + g0[2] * a0[2], bfhi(xw.y) + g0[3] * a0[3]);
                        ow.z = pk2(bflo(xw.z) + g1[0] * a1[0], bfhi(xw.z) + g1[1] * a1[1]); ow.w = pk2(bflo(xw.w) + g1[2] * a1[2], bfhi(xw.w) + g1[3] * a1[3]);
                        *(u32x4*)(X + (size_t)(row0 + ai * HALF + m * 16) * 2048 + col0 + bj * HALF) = ow; }
            }
        }
    }
};
}

__device__ __forceinline__ int proj_src_col(int n) {
    if (n < 1024) return 7200 + n;
    if (n < 2048) return n - 1024;
    if (n < 4096) return 1024 + (n - 2048);
    if (n < 6144) return 8224 + (n - 4096);
    if (n < 8192) return 16416 + (n - 6144);
    if (n < 10240) return 3104 + (n - 8192);
    if (n < 12288) return 5152 + (n - 10240);
    if (n < 14336) return 10272 + (n - 12288);
    if (n < 16384) return 12320 + (n - 14336);
    if (n < 18432) return 14368 + (n - 16384);
    return 18464 + (n - 18432);
}
__device__ __forceinline__ void phase_w(KP p, int l, LAS unsigned char* lds, int wid0) {
    const int tid = tid_fresh(wid0), G = gridDim.x, bid = blockIdx.x;
    unsigned char* ws = launder(p->ws);
    {
        LAS float* tile = (LAS float*)lds;
        const int NT_IN = NPROJ / 64;
        const int total = (NT_IN + 5 * 32) * 8;
        for (int t = bid; t < total; t += G) {
            const int ntile = t >> 3, kt = t & 7, k0 = kt * 256;
            const float* src; int ld; bf16_t* dst; float scale = 1.0f; int n0;
            bool to8 = false;
            if (ntile < NT_IN) { n0 = ntile * 64; src = p->w_in + (size_t)l * 2048 * PROJ_W + proj_src_col(n0); ld = PROJ_W;
                const int pnl = n0 >> 8; const bool isb = (pnl >= BF_LO && pnl < BF_HI) || (pnl >= 48 && pnl < 72);
                if (isb) { const int cpn = pnl < 48 ? pnl - BF_LO : pnl - 48 + (BF_HI - BF_LO); dst = (bf16_t*)(ws + WS_WINB) + (size_t)(cpn * 256 + (n0 & 255)) * 2048; if (n0 < 1024) scale = 0.08838834764831845f; }
                else { to8 = true; dst = (bf16_t*)(ws + WS_WIN); scale = (n0 < 1024) ? 1024.0f * 0.08838834764831845f : 1024.0f; } }
            else { const int mi = (ntile - NT_IN) >> 5; n0 = ((ntile - NT_IN) & 31) * 64;
                const float* m5 = mi == 0 ? p->w_a_out : mi == 1 ? p->w_b_out : mi == 2 ? p->w_c_out : mi == 3 ? p->w_out : p->peer_wq;
                src = m5 + (size_t)l * 2048 * 2048 + n0; ld = 2048;
                dst = (bf16_t*)(ws + WS_WA + (size_t)mi * SZ_W) + (size_t)n0 * 2048; }
            { const int kk = tid >> 4, n4 = (tid & 15) * 4;
              f32x4 v[8];
#pragma unroll
              for (int h = 0; h < 8; ++h) v[h] = *(const f32x4*)(src + (size_t)(k0 + kk + 32 * h) * ld + n4);
#pragma unroll
              for (int h = 0; h < 8; ++h) { LAS float* tp = tile + (kk + 32 * h) * 65 + n4; tp[0] = v[h][0]; tp[1] = v[h][1]; tp[2] = v[h][2]; tp[3] = v[h][3]; } }
            __syncthreads();
            { const int n = tid >> 3, kq = (tid & 7) * 8;
#pragma unroll
              for (int sub = 0; sub < 4; ++sub) { const int k8 = sub * 64 + kq; float v[8];
#pragma unroll
                  for (int j = 0; j < 8; ++j) v[j] = tile[(k8 + j) * 65 + n] * scale;
                  if (to8) {
#pragma unroll
                      for (int j = 0; j < 8; ++j) v[j] = fminf(fmaxf(v[j], -448.f), 448.f);
                      int d0 = 0, d1 = 0; d0 = __builtin_amdgcn_cvt_pk_fp8_f32(v[0], v[1], d0, false); d0 = __builtin_amdgcn_cvt_pk_fp8_f32(v[2], v[3], d0, true);
                      d1 = __builtin_amdgcn_cvt_pk_fp8_f32(v[4], v[5], d1, false); d1 = __builtin_amdgcn_cvt_pk_fp8_f32(v[6], v[7], d1, true);
                      u32x2 w8; w8.x = (unsigned)d0; w8.y = (unsigned)d1; *(u32x2*)((unsigned char*)dst + (size_t)(n0 + n) * 2048 + k0 + k8) = w8; }
                  else { u32x4 w; w.x = pk2(v[0], v[1]); w.y = pk2(v[2], v[3]); w.z = pk2(v[4], v[5]); w.w = pk2(v[6], v[7]);
                      *(u32x4*)(dst + (size_t)n * 2048 + k0 + k8) = w; } } }
            __syncthreads();
        }
    }
    const size_t gtid = (size_t)bid * NTHREADS + tid, gthreads = (size_t)G * NTHREADS;
    for (size_t i = gtid; i < 32 * 2048; i += gthreads) { const int n = (int)(i >> 11), k = (int)(i & 2047);
        ((bf16_t*)(ws + WS_WG))[i] = f2bf(p->w_in[(size_t)l * 2048 * PROJ_W + (size_t)k * PROJ_W + 3072 + n]); }
    {
        const float* su = p->peer_u + (size_t)l * 16384 * 2048; const float* sv = p->peer_v + (size_t)l * 16384 * 2048;
        unsigned char* du = ws + WS_PU; unsigned char* dv = ws + WS_PVW;
        const size_t n32 = (size_t)16384 * 2048 / 32;
        for (size_t i = gtid; i < n32; i += gthreads) {
#pragma unroll
            for (int t = 0; t < 2; ++t) {
                const float* sp = (t ? sv : su) + i * 32; const float sc = t ? 4.0f : 64.0f;
                u32x4 wv;
#pragma unroll
                for (int q = 0; q < 4; ++q) { const f32x4 a = *(const f32x4*)(sp + q * 8), b = *(const f32x4*)(sp + q * 8 + 4);
                    unsigned d = 0;
                    d = __builtin_amdgcn_cvt_scalef32_pk_fp4_f32(d, a[0] * sc, a[1] * sc, 1.0f, 0); d = __builtin_amdgcn_cvt_scalef32_pk_fp4_f32(d, a[2] * sc, a[3] * sc, 1.0f, 1);
                    d = __builtin_amdgcn_cvt_scalef32_pk_fp4_f32(d, b[0] * sc, b[1] * sc, 1.0f, 2); d = __builtin_amdgcn_cvt_scalef32_pk_fp4_f32(d, b[2] * sc, b[3] * sc, 1.0f, 3);
                    wv[q] = d; }
                *(u32x4*)((t ? dv : du) + i * 16) = wv;
            }
        }
        const float* sk = p->peer_keys + (size_t)l * 16 * 128 * 128; bf16_t* dk = (bf16_t*)(ws + WS_KEYS);
        for (size_t i = gtid; i < (size_t)16 * 128 * 128; i += gthreads) dk[i] = f2bf(sk[i]);
    }
    {
        float* mod = (float*)(ws + WS_MOD) + (size_t)l * 3 * 12288;
        const float* wa = p->w_ada + (size_t)l * 2048 * 12288; const float* ba = p->b_ada + (size_t)l * 12288;
        LAS float* part = (LAS float*)(lds + 69632);
        const int col = tid & 63, ks = tid >> 6;
        for (int t = bid; t < 256; t += G) {
            const int n = t * 48 + col;
            float a0 = 0.f, a1 = 0.f, a2 = 0.f;
            if (col < 48) {
#pragma unroll 8
                for (int k = ks * 256; k < ks * 256 + 256; ++k) {
                    const float w = wa[(size_t)k * 12288 + n];
                    const float c0 = p->c[k], c1 = p->c[2048 + k], c2 = p->c_ctx[k];
                    a0 += c0 * sigmoidf_(c0) * w; a1 += c1 * sigmoidf_(c1) * w; a2 += c2 * sigmoidf_(c2) * w;
                }
                part[(ks * 3 + 0) * 48 + col] = a0; part[(ks * 3 + 1) * 48 + col] = a1; part[(ks * 3 + 2) * 48 + col] = a2;
            }
            __syncthreads();
            if (tid < 144) { const int which = tid / 48, cc = tid - which * 48; float sacc = ba[t * 48 + cc];
#pragma unroll
                for (int q = 0; q < 8; ++q) sacc += part[(q * 3 + which) * 48 + cc];
                mod[(size_t)which * 12288 + t * 48 + cc] = sacc; }
            __syncthreads();
        }
    }
    if (l == 0) {
        float* tab = (float*)(ws + WS_TAB);
        for (size_t i = gtid; i < 4096; i += gthreads) { const int pos = (int)(i >> 5), j = (int)(i & 31);
            const float inv = powf(10000.0f, -(float)j / 32.0f); const float ang = (float)pos * inv;
            tab[i] = cosf(ang); tab[4096 + i] = sinf(ang); }
    }
}

__device__ __forceinline__ void phase_norm(KP p, int l, int which_norm, int nrows, int wid0) {
    const int tid = tid_fresh(wid0); const int lane = tid & 63, gw = blockIdx.x * 8 + (tid >> 6), nw = gridDim.x * 8;
    unsigned char* ws = launder(p->ws);
    const bf16_t* X = (const bf16_t*)(ws + WS_X); bf16_t* XN = (bf16_t*)(ws + WS_XN);
    const float* mod = (const float*)(ws + WS_MOD) + (size_t)l * 3 * 12288;
    const float* g = p->norm_g + (size_t)(l * 2 + which_norm) * 2048;
    const int shift_c = which_norm ? 3 : 0, scale_c = which_norm ? 4 : 1;
    for (int row = gw; row < nrows; row += nw) {
        const int which = row < NLAT ? (row >> 13) : 2;
        const float* mb = mod + (size_t)which * 12288;
        f32x4 v[8]; float ss = 0.f;
        if (l == 0 && which_norm == 0) {
            const float* xr = row < NLAT ? p->x + (size_t)row * 2048 : p->ctx + (size_t)(row - NLAT) * 2048;
#pragma unroll
            for (int i = 0; i < 8; ++i) v[i] = *(const f32x4*)(xr + i * 256 + lane * 4);
        } else {
            const bf16_t* xr = X + (size_t)row * 2048;
            u32x2 xb[8];
#pragma unroll
            for (int i = 0; i < 8; ++i) xb[i] = *(const u32x2*)(xr + i * 256 + lane * 4);
#pragma unroll
            for (int i = 0; i < 8; ++i) { v[i][0] = bflo(xb[i].x); v[i][1] = bfhi(xb[i].x); v[i][2] = bflo(xb[i].y); v[i][3] = bfhi(xb[i].y); }
        }
#pragma unroll
        for (int i = 0; i < 8; ++i) ss += v[i][0] * v[i][0] + v[i][1] * v[i][1] + v[i][2] * v[i][2] + v[i][3] * v[i][3];
        ss = wave_sum(ss);
        const float rstd = rsqrtf(ss * (1.0f / 2048.0f) + EPSF);
        f32x4 ggv[8], shv[8], scv[8];
#pragma unroll
        for (int i = 0; i < 8; ++i) { const int c = i * 256 + lane * 4; ggv[i] = *(const f32x4*)(g + c); shv[i] = *(const f32x4*)(mb + shift_c * 2048 + c); scv[i] = *(const f32x4*)(mb + scale_c * 2048 + c); }
#pragma unroll
        for (int i = 0; i < 8; ++i) { const int c = i * 256 + lane * 4;
            const f32x4 gg = ggv[i], sh = shv[i], sc = scv[i];
            float o[4];
#pragma unroll
            for (int j = 0; j < 4; ++j) o[j] = v[i][j] * rstd * gg[j] * (1.0f + sc[j]) + sh[j];
            u32x2 w; w.x = pk2(o[0], o[1]); w.y = pk2(o[2], o[3]); *(u32x2*)(XN + (size_t)row * 2048 + c) = w;
            if (which_norm == 0) { int d = 0; d = __builtin_amdgcn_cvt_pk_fp8_f32(fminf(fmaxf(o[0], -448.f), 448.f), fminf(fmaxf(o[1], -448.f), 448.f), d, false);
                d = __builtin_amdgcn_cvt_pk_fp8_f32(fminf(fmaxf(o[2], -448.f), 448.f), fminf(fmaxf(o[3], -448.f), 448.f), d, true); *(unsigned*)(ws + WS_XN8 + (size_t)row * 2048 + c) = (unsigned)d; } }
    }
}

__device__ __forceinline__ void phase_gates_gemm(KP p, int l, int wid0) {
    const int tid = tid_fresh(wid0); const int lane = tid & 63, gw = blockIdx.x * 8 + (tid >> 6), nw = gridDim.x * 8;
    unsigned char* ws = launder(p->ws);
    const bf16_t* XN = (const bf16_t*)(ws + WS_XN); const bf16_t* WG = (const bf16_t*)(ws + WS_WG); float* GA = (float*)(ws + WS_GATES);
    const int q4 = lane >> 4, c = lane & 15;
    const float gb0 = p->a_gate_b[l * 32 + c], gb1 = p->a_gate_b[l * 32 + 16 + c];
    for (int task = gw; task < MR / 16; task += nw) {
        const int r0 = task * 16;
        f32x4 acc0 = {0.f, 0.f, 0.f, 0.f}, acc1 = {0.f, 0.f, 0.f, 0.f};
        const bf16_t* ap = XN + (size_t)(r0 + c) * 2048 + 8 * q4; const bf16_t* b0 = WG + (size_t)c * 2048 + 8 * q4; const bf16_t* b1 = b0 + 16 * 2048;
#pragma unroll 4
        for (int ks = 0; ks < 64; ++ks) { const bf16x8 a = *(const bf16x8*)(ap + ks * 32), x0 = *(const bf16x8*)(b0 + ks * 32), x1 = *(const bf16x8*)(b1 + ks * 32);
            acc0 = mfma16(a, x0, acc0); acc1 = mfma16(a, x1, acc1); }
#pragma unroll
        for (int r = 0; r < 4; ++r) {
            const float v0 = acc0[r] + gb0, v1 = acc1[r] + gb1;
            GA[(size_t)(r0 + 4 * q4 + r) * 32 + c] = (c >= 8) ? logsigmoidf_(v0) : v0; GA[(size_t)(r0 + 4 * q4 + r) * 32 + 16 + c] = (c >= 8) ? logsigmoidf_(v1) : v1; }
    }
}

__device__ __forceinline__ void phase_e1(KP p, int l, int wid0) {
    const int tid = tid_fresh(wid0); const int lane = tid & 63, gw = blockIdx.x * 8 + (tid >> 6), nw = gridDim.x * 8;
    unsigned char* ws = launder(p->ws);
    bf16_t* PQ = (bf16_t*)(ws + WS_PQ); bf16_t* PK = (bf16_t*)(ws + WS_PK); bf16_t* CQ = (bf16_t*)(ws + WS_CQ); bf16_t* CK = (bf16_t*)(ws + WS_CK);
    bf16_t* BB = (bf16_t*)(ws + WS_BB); const bf16_t* BC = (const bf16_t*)(ws + WS_BC); const bf16_t* BX = (const bf16_t*)(ws + WS_BX);
    float* GA = (float*)(ws + WS_GATES); const float* tab = (const float*)(ws + WS_TAB);
    const float* gq = p->c_qk_g + (size_t)(l * 2 + 0) * 128; const float* gk = p->c_qk_g + (size_t)(l * 2 + 1) * 128;
    const float* cw = p->b_conv + (size_t)l * 3 * 2048;
    float gqv[8], gkv[8];
#pragma unroll
    for (int j = 0; j < 8; ++j) { gqv[j] = gq[(lane & 15) * 8 + j] * 0.12751743082459868f;        gkv[j] = gk[(lane & 15) * 8 + j]; }
    const int nitems = NLAT / 8 + NCTX;
    for (int item = gw; item < nitems; item += nw) {
        const int row_first = item < NLAT / 8 ? item * 8 : NLAT + (item - NLAT / 8), nrun = item < NLAT / 8 ? 8 : 1;
        for (int rr = 0; rr < nrun; ++rr) { const int row = row_first + rr;
        if (row < NLAT) {
            const int s = row & 8191, gr = s >> 6, gc = s & 63;
#pragma unroll
            for (int it = 0; it < 2; ++it) {
                const int unit = it * 64 + lane, h = unit >> 4, hf = (unit >> 3) & 1, j4 = unit & 7;
                const int off = h * 128 + hf * 64 + j4 * 4, pos = hf ? gc : gr;
                const f32x4 cs = *(const f32x4*)(tab + pos * 32 + j4 * 4), sn = *(const f32x4*)(tab + 4096 + pos * 32 + j4 * 4);
#pragma unroll
                for (int tsel = 0; tsel < 2; ++tsel) { bf16_t* T = (tsel ? PK : PQ) + (size_t)row * 1024 + off;
                    const u32x2 u1 = *(const u32x2*)T, u2 = *(const u32x2*)(T + 32);
                    const float a0 = bflo(u1.x), a1 = bfhi(u1.x), a2 = bflo(u1.y), a3 = bfhi(u1.y), b0 = bflo(u2.x), b1 = bfhi(u2.x), b2 = bflo(u2.y), b3 = bfhi(u2.y);
                    u32x2 o1, o2;
                    o1.x = pk2(a0 * cs[0] - b0 * sn[0], a1 * cs[1] - b1 * sn[1]); o1.y = pk2(a2 * cs[2] - b2 * sn[2], a3 * cs[3] - b3 * sn[3]);
                    o2.x = pk2(b0 * cs[0] + a0 * sn[0], b1 * cs[1] + a1 * sn[1]); o2.y = pk2(b2 * cs[2] + a2 * sn[2], b3 * cs[3] + a3 * sn[3]);
                    *(u32x2*)T = o1; *(u32x2*)(T + 32) = o2; }
            }
        }
#pragma unroll
        for (int tsel = 0; tsel < 2; ++tsel) {
            bf16_t* T = (tsel ? CK : CQ) + (size_t)row * 2048;
            u32x4 wq4[4];
#pragma unroll
            for (int ps = 0; ps < 4; ++ps) wq4[ps] = *(const u32x4*)(T + ps * 512 + lane * 8);
#pragma unroll
            for (int ps = 0; ps < 4; ++ps) {
                const u32x4 w = wq4[ps];
                float v[8] = {bflo(w.x), bfhi(w.x), bflo(w.y), bfhi(w.y), bflo(w.z), bfhi(w.z), bflo(w.w), bfhi(w.w)};
                float ss = 0.f;
#pragma unroll
                for (int j = 0; j < 8; ++j) ss += v[j] * v[j];
                ss += __shfl_xor(ss, 1); ss += __shfl_xor(ss, 2); ss += __shfl_xor(ss, 4); ss += __shfl_xor(ss, 8);
                const float rstd = rsqrtf(ss * (1.0f / 128.0f) + EPSF);
#pragma unroll
                for (int j = 0; j < 8; ++j) v[j] = v[j] * rstd * (tsel ? gkv[j] : gqv[j]);
                u32x4 o; o.x = pk2(v[0], v[1]); o.y = pk2(v[2], v[3]); o.z = pk2(v[4], v[5]); o.w = pk2(v[6], v[7]);
                *(u32x4*)(T + ps * 512 + lane * 8) = o;
            }
        }
        }
        {
            int pos0, len; if (row_first < NLAT) { pos0 = row_first & 8191; len = SEQ; } else { pos0 = (row_first - NLAT) & 255; len = CTXL; }
#pragma unroll 1
            for (int ps = 0; ps < 4; ++ps) {
                const int c = ps * 512 + lane * 8;
                float w0[8], w1[8], w2[8];
#pragma unroll
                for (int hq = 0; hq < 2; ++hq) { const f32x4 a = *(const f32x4*)(cw + c + hq * 4), bq = *(const f32x4*)(cw + 2048 + c + hq * 4), cq = *(const f32x4*)(cw + 4096 + c + hq * 4);
#pragma unroll
                    for (int j = 0; j < 4; ++j) { w0[hq * 4 + j] = a[j]; w1[hq * 4 + j] = bq[j]; w2[hq * 4 + j] = cq[j]; } }
                u32x4 cvr[10], xvr[10], bbr[8];
                const u32x4 zero4 = {0u, 0u, 0u, 0u};
#pragma unroll
                for (int k = 0; k < 10; ++k) { const int rel = k - 1; const bool ok = (rel <= nrun) && (pos0 + rel >= 0) && (pos0 + rel < len) && (rel < nrun || pos0 + rel < len);
                    if (ok && rel <= nrun) { const size_t o = (size_t)(row_first + rel) * 2048 + c; cvr[k] = *(const u32x4*)(BC + o); xvr[k] = *(const u32x4*)(BX + o); } else { cvr[k] = zero4; xvr[k] = zero4; } }
#pragma unroll
                for (int rr = 0; rr < 8; ++rr) bbr[rr] = (rr < nrun) ? *(const u32x4*)(BB + (size_t)(row_first + rr) * 2048 + c) : zero4;
                float up[8], uc[8], un[8];
                auto mk_u = [&](const u32x4 cv, const u32x4 xv, float (&u)[8]) {
                    u[0] = bflo(cv.x) * bflo(xv.x); u[1] = bfhi(cv.x) * bfhi(xv.x); u[2] = bflo(cv.y) * bflo(xv.y); u[3] = bfhi(cv.y) * bfhi(xv.y);
                    u[4] = bflo(cv.z) * bflo(xv.z); u[5] = bfhi(cv.z) * bfhi(xv.z); u[6] = bflo(cv.w) * bflo(xv.w); u[7] = bfhi(cv.w) * bfhi(xv.w); };
                mk_u(cvr[0], xvr[0], up); mk_u(cvr[1], xvr[1], uc);
#pragma unroll
                for (int rr = 0; rr < 8; ++rr) {
                    if (rr < nrun) {
                        mk_u(cvr[rr + 2], xvr[rr + 2], un);
                        const size_t o = (size_t)(row_first + rr) * 2048 + c; const u32x4 bb = bbr[rr];
                        const float bv[8] = {bflo(bb.x), bfhi(bb.x), bflo(bb.y), bfhi(bb.y), bflo(bb.z), bfhi(bb.z), bflo(bb.w), bfhi(bb.w)};
                        float y[8];
#pragma unroll
                        for (int j = 0; j < 8; ++j) y[j] = bv[j] * (up[j] * w0[j] + uc[j] * w1[j] + un[j] * w2[j]);
                        u32x4 ov; ov.x = pk2(y[0], y[1]); ov.y = pk2(y[2], y[3]); ov.z = pk2(y[4], y[5]); ov.w = pk2(y[6], y[7]);
                        *(u32x4*)(BB + o) = ov;
#pragma unroll
                        for (int j = 0; j < 8; ++j) { up[j] = uc[j]; uc[j] = un[j]; }
                    }
                }
            }
        }
    }
}

constexpr int ML_QS = 0, ML_KS = 17408, ML_VT = 53248, ML_CT = 69376, ML_CTSZ = 13056, ML_PRE_TOT = 3 * 8448 * 4;
__device__ __forceinline__ int ml_row(int pp, int b, int dir) {
    if (pp < 256) { const int j = dir ? 255 - pp : pp; return NLAT + b * 256 + j; }
    int s = pp - 256; if (dir) s = 8191 - s; return b * 8192 + s;
}
__device__ __forceinline__ void phase_mlstm(KP p, int l, LAS unsigned char* lds, int wid0) {
    const int tid = tid_fresh(wid0), lane = tid & 63, w = __builtin_amdgcn_readfirstlane(tid >> 6), q4 = lane >> 4, c16 = lane & 15;
    unsigned char* ws = launder(p->ws);
    const bf16_t* PQ = (const bf16_t*)(ws + WS_PQ); const bf16_t* PK = (const bf16_t*)(ws + WS_PK); const bf16_t* PV = (const bf16_t*)(ws + WS_PV);
    const float* GA = (const float*)(ws + WS_GATES);
    if (w >= 4) __builtin_amdgcn_s_setprio(1);
    for (int task = blockIdx.x; task < 256; task += gridDim.x) {
        const int xq = task & 7, yq = task >> 3; const int bh = 2 * xq + (yq >> 4), dir = (yq >> 3) & 1, sl = yq & 7; const int b = bh >> 3, h = bh & 7;
        bf16_t* H = (bf16_t*)(ws + (dir ? WS_BX : WS_BC));
        float* SCN = (float*)(ws + WS_SCAN) + (size_t)task * 5 * 8448;
        __syncthreads();
        {
            LAS float* PB = (LAS float*)lds; LAS float* TOT = (LAS float*)(lds + ML_PRE_TOT);
            float li_n = 0.f, lf_n = 0.f;
            if (w < 132) { const int r = ml_row(w * 64 + lane, b, dir); li_n = GA[(size_t)r * 32 + (2 * dir) * 8 + h]; lf_n = GA[(size_t)r * 32 + (2 * dir + 1) * 8 + h]; }
            for (int cc = w; cc < 132; cc += 8) {
                const float li = li_n, lf = lf_n;
                if (cc + 8 < 132) { const int r = ml_row((cc + 8) * 64 + lane, b, dir); li_n = GA[(size_t)r * 32 + (2 * dir) * 8 + h]; lf_n = GA[(size_t)r * 32 + (2 * dir + 1) * 8 + h]; }
                float bc = lf;
#pragma unroll
                for (int o = 1; o < 64; o <<= 1) { const float t = __shfl_up(bc, o); if (lane >= o) bc += t; }
                const float a = li - bc;
                float pm = a;
#pragma unroll
                for (int o = 1; o < 64; o <<= 1) { const float t = __shfl_up(pm, o); if (lane >= o) pm = fmaxf(pm, t); }
                PB[cc * 64 + lane] = bc; PB[8448 + cc * 64 + lane] = a; PB[2 * 8448 + cc * 64 + lane] = pm;
                if (lane == 63) { TOT[cc] = bc; TOT[256 + cc] = pm; }
            }
            __syncthreads();
            const float t0 = TOT[lane], p0 = TOT[256 + lane], t1 = TOT[64 + lane], p1 = TOT[256 + 64 + lane], t2 = TOT[128 + (lane & 3)], p2 = TOT[256 + 128 + (lane & 3)];
            float m = 0.f, mk0 = 0.f, mk1 = 0.f, mk2 = 0.f;
#pragma unroll 4
            for (int c = 0; c < 64; ++c) { if (lane == c) mk0 = m; m = rlane(t0, c) + fmaxf(m, rlane(p0, c)); }
#pragma unroll 4
            for (int c = 0; c < 64; ++c) { if (lane == c) mk1 = m; m = rlane(t1, c) + fmaxf(m, rlane(p1, c)); }
#pragma unroll
            for (int c = 0; c < 4; ++c) { if (lane == c) mk2 = m; m = rlane(t2, c) + fmaxf(m, rlane(p2, c)); }
            for (int cc = w; cc < 132; cc += 8) {
                const float mkk = (cc < 64) ? mk0 : (cc < 128 ? mk1 : mk2);
                const float mc = rlane(mkk, cc & 63);
                const float bc = PB[cc * 64 + lane], a = PB[8448 + cc * 64 + lane], pm = PB[2 * 8448 + cc * 64 + lane];
                const float pmall = rlane(pm, 63);
                const float mx = fmaxf(mc, pm), mref = fmaxf(mc, pmall);
                SCN[cc * 64 + lane] = __expf(mc - mx);
                SCN[8448 + cc * 64 + lane] = __expf(fminf(mref - mx, 80.0f));
                SCN[2 * 8448 + cc * 64 + lane] = __expf(-(bc + mx));
                SCN[3 * 8448 + cc * 64 + lane] = __expf(a - mref);
                if (lane == 0) SCN[4 * 8448 + cc] = __expf(mc - mref);
            }
        }
        __syncthreads();
        for (int i = tid; i < 16 * 32; i += NTHREADS) { const int r = 32 + (i >> 5), cdw = i & 31; *(LAS unsigned*)(lds + ML_VT + r * 144 + cdw * 4) = 0x3f803f80u; }
        for (int i = tid; i < 2 * ML_CTSZ / 4; i += NTHREADS) *(LAS unsigned*)(lds + ML_CT + i * 4) = 0u;
        __syncthreads();
        f32x4 Cst[3];
#pragma unroll
        for (int i = 0; i < 3; ++i) Cst[i] = (f32x4){0.f, 0.f, 0.f, 0.f};
        u32x4 qreg[2], kreg[2], vreg; float eak[2], decay; float wi1, em1, emr1;
        const int qrow_l = lane >> 4, qpc = lane & 15, vrow_l = lane >> 2, vpc = lane & 3;
        const int tr = w >> 1, part = w & 1;
        const int sgn = dir ? -1 : 1;
        const unsigned char* PQb = (const unsigned char*)PQ; const unsigned char* PKb = (const unsigned char*)PK; const unsigned char* PVb = (const unsigned char*)PV;
        const unsigned char* SCb = (const unsigned char*)SCN; unsigned char* Hb = (unsigned char*)H;
        const int lq0 = (sgn * (8 * w + qrow_l) * 1024 + h * 128 + qpc * 8) * 2, lq1 = lq0 + sgn * 4 * 2048;
        const int lv = (sgn * (16 * w + vrow_l) * 2048 + h * 256 + sl * 32 + vpc * 8) * 2;
        const int lh = (sgn * (16 * tr + c16) * 2048 + h * 256 + sl * 32 + 16 * part + 4 * q4) * 2;
        const int lea = (3 * 8448 + 8 * w + qrow_l) * 4, lwi = (16 * tr + c16) * 4;
#define ML_PREFETCH(cn) do { const int _r0 = ml_row((cn) * 64, b, dir); const unsigned _q = (unsigned)_r0 * 2048u, _v = (unsigned)_r0 * 4096u, _s = (unsigned)(cn) * 256u; \
            qreg[0] = *(const u32x4*)(PQb + (_q + (unsigned)lq0)); kreg[0] = *(const u32x4*)(PKb + (_q + (unsigned)lq0)); qreg[1] = *(const u32x4*)(PQb + (_q + (unsigned)lq1)); kreg[1] = *(const u32x4*)(PKb + (_q + (unsigned)lq1)); \
            eak[0] = *(const float*)(SCb + (_s + (unsigned)lea)); eak[1] = *(const float*)(SCb + (_s + (unsigned)lea + 16u)); \
            if (w < 4) vreg = *(const u32x4*)(PVb + (_v + (unsigned)lv)); \
            } while (0)
#define ML_PREFETCH_OUT(cn) do { const unsigned _s = (unsigned)(cn) * 256u; \
            wi1 = *(const float*)(SCb + (_s + (unsigned)lwi)); em1 = *(const float*)(SCb + (_s + (unsigned)lwi + 8448u * 4u)); emr1 = *(const float*)(SCb + (_s + (unsigned)lwi + 2u * 8448u * 4u)); \
            decay = *(const float*)(SCb + (4u * 8448u * 4u + (unsigned)(cn) * 4u)); } while (0)
        ML_PREFETCH(0); ML_PREFETCH_OUT(0);
        for (int c = 0; c < 132; ++c) {
#pragma unroll
            for (int i = 0; i < 2; ++i) { const int sr = 8 * w + 4 * i + qrow_l;
                *(LAS u32x4*)(lds + ML_QS + sr * 272 + qpc * 16) = qreg[i];
                const float e = eak[i]; const u32x4 kk4 = kreg[i]; u32x4 ks;
                ks.x = pk2(bflo(kk4.x) * e, bfhi(kk4.x) * e); ks.y = pk2(bflo(kk4.y) * e, bfhi(kk4.y) * e); ks.z = pk2(bflo(kk4.z) * e, bfhi(kk4.z) * e); ks.w = pk2(bflo(kk4.w) * e, bfhi(kk4.w) * e);
                *(LAS u32x4*)(lds + ML_KS + sr * 272 + qpc * 16) = ks; }
            if (w < 4) { const unsigned vw[4] = {vreg.x, vreg.y, vreg.z, vreg.w}; const int sv = 16 * w + vrow_l;
#pragma unroll
                for (int j = 0; j < 4; ++j) { const int e = vpc * 8 + 2 * j;
                    *(LAS bf16_t*)(lds + ML_VT + e * 144 + sv * 2) = (bf16_t)(vw[j] & 0xffffu);
                    *(LAS bf16_t*)(lds + ML_VT + (e + 1) * 144 + sv * 2) = (bf16_t)(vw[j] >> 16); } }
            if (c + 1 < 132) ML_PREFETCH(c + 1);
            LDS_BARRIER();
            const LAS unsigned char* CTc = lds + ML_CT + (c & 1) * ML_CTSZ;
            const LAS unsigned char* kbase = lds + ML_KS + c16 * 272 + 8 * q4 * 2;
            const LAS unsigned char* vbase1 = lds + ML_VT + (16 * part + c16) * 144 + 4 * q4 * 2, * vbase2 = lds + ML_VT + (32 + c16) * 144 + 4 * q4 * 2;
            bf16x8 aq[4], ka[2][4], cb1[4], cb2[4]; u32x2 vf[4];
#pragma unroll
            for (int ks = 0; ks < 4; ++ks) aq[ks] = *(const LAS bf16x8*)(lds + ML_QS + (16 * tr + c16) * 272 + (ks * 32 + 8 * q4) * 2);
#pragma unroll
            for (int ks = 0; ks < 4; ++ks) { ka[0][ks] = *(const LAS bf16x8*)(kbase + ks * 64); ka[1][ks] = *(const LAS bf16x8*)(kbase + 16 * 272 + ks * 64); }
#pragma unroll
            for (int ks = 0; ks < 4; ++ks) { cb1[ks] = *(const LAS bf16x8*)(CTc + (16 * part + c16) * 272 + (ks * 32 + 8 * q4) * 2); cb2[ks] = *(const LAS bf16x8*)(CTc + (32 + c16) * 272 + (ks * 32 + 8 * q4) * 2); }
            vf[0] = *(const LAS u32x2*)(vbase1); vf[1] = *(const LAS u32x2*)(vbase1 + 32); vf[2] = *(const LAS u32x2*)(vbase2); vf[3] = *(const LAS u32x2*)(vbase2 + 32);
            __builtin_amdgcn_sched_barrier(0);
            f32x4 accA = {0.f, 0.f, 0.f, 0.f}, accD = {0.f, 0.f, 0.f, 0.f}, s0 = {0.f, 0.f, 0.f, 0.f}, s1 = {0.f, 0.f, 0.f, 0.f};
#pragma unroll
            for (int ks = 0; ks < 4; ++ks) { s0 = mfma16(ka[0][ks], aq[ks], s0); s1 = mfma16(ka[1][ks], aq[ks], s1); accA = mfma16(cb1[ks], aq[ks], accA); accD = mfma16(cb2[ks], aq[ks], accD); }
            __builtin_amdgcn_sched_barrier(0);
            bf16x8 kb[2][4]; u32x2 vg[4];
#pragma unroll
            for (int ks = 0; ks < 4; ++ks) { kb[0][ks] = *(const LAS bf16x8*)(kbase + 32 * 272 + ks * 64); kb[1][ks] = *(const LAS bf16x8*)(kbase + 48 * 272 + ks * 64); }
            vg[0] = *(const LAS u32x2*)(vbase1 + 64); vg[1] = *(const LAS u32x2*)(vbase1 + 96); vg[2] = *(const LAS u32x2*)(vbase2 + 64); vg[3] = *(const LAS u32x2*)(vbase2 + 96);
            __builtin_amdgcn_sched_barrier(0);
            const int dq = 4 * q4 - 16 * tr - c16;
            f32x4 accIA, accID;
            {
                float pe[8];
#pragma unroll
                for (int r = 0; r < 4; ++r) { pe[r] = (r + dq <= 0) ? s0[r] : 0.f; pe[4 + r] = (16 + r + dq <= 0) ? s1[r] : 0.f; }
                u32x4 pw; pw.x = pk2(pe[0], pe[1]); pw.y = pk2(pe[2], pe[3]); pw.z = pk2(pe[4], pe[5]); pw.w = pk2(pe[6], pe[7]);
                const bf16x8 pf = __builtin_bit_cast(bf16x8, pw);
                u32x4 bw1, bw2; bw1.x = vf[0].x; bw1.y = vf[0].y; bw1.z = vf[1].x; bw1.w = vf[1].y; bw2.x = vf[2].x; bw2.y = vf[2].y; bw2.z = vf[3].x; bw2.w = vf[3].y;
                accIA = mfma16(__builtin_bit_cast(bf16x8, bw1), pf, (f32x4){0.f, 0.f, 0.f, 0.f}); accID = mfma16(__builtin_bit_cast(bf16x8, bw2), pf, (f32x4){0.f, 0.f, 0.f, 0.f});
            }
            if (tr >= 2) {
                f32x4 s2 = {0.f, 0.f, 0.f, 0.f}, s3 = {0.f, 0.f, 0.f, 0.f};
#pragma unroll
                for (int ks = 0; ks < 4; ++ks) { s2 = mfma16(kb[0][ks], aq[ks], s2); s3 = mfma16(kb[1][ks], aq[ks], s3); }
                float pe[8];
#pragma unroll
                for (int r = 0; r < 4; ++r) { pe[r] = (32 + r + dq <= 0) ? s2[r] : 0.f; pe[4 + r] = (48 + r + dq <= 0) ? s3[r] : 0.f; }
                u32x4 pw; pw.x = pk2(pe[0], pe[1]); pw.y = pk2(pe[2], pe[3]); pw.z = pk2(pe[4], pe[5]); pw.w = pk2(pe[6], pe[7]);
                const bf16x8 pf = __builtin_bit_cast(bf16x8, pw);
                u32x4 bw1, bw2; bw1.x = vg[0].x; bw1.y = vg[0].y; bw1.z = vg[1].x; bw1.w = vg[1].y; bw2.x = vg[2].x; bw2.y = vg[2].y; bw2.z = vg[3].x; bw2.w = vg[3].y;
                accIA = mfma16(__builtin_bit_cast(bf16x8, bw1), pf, accIA); accID = mfma16(__builtin_bit_cast(bf16x8, bw2), pf, accID);
            }
            bf16x8 ak[2], bv[3][2];
#pragma unroll
            for (int k2 = 0; k2 < 2; ++k2) {
                const s16x4 t0 = __builtin_amdgcn_ds_read_tr16_b64_v4i16((LAS s16x4*)(lds + ML_KS + (k2 * 32 + 8 * q4 + (c16 >> 2)) * 272 + (16 * w + 4 * (c16 & 3)) * 2));
                const s16x4 t1 = __builtin_amdgcn_ds_read_tr16_b64_v4i16((LAS s16x4*)(lds + ML_KS + (k2 * 32 + 8 * q4 + 4 + (c16 >> 2)) * 272 + (16 * w + 4 * (c16 & 3)) * 2));
                ak[k2] = __builtin_shufflevector(t0, t1, 0, 1, 2, 3, 4, 5, 6, 7);
            }
#pragma unroll
            for (int ct = 0; ct < 3; ++ct)
#pragma unroll
                for (int k2 = 0; k2 < 2; ++k2) bv[ct][k2] = *(const LAS bf16x8*)(lds + ML_VT + (16 * ct + c16) * 144 + (k2 * 32 + 8 * q4) * 2);
            __builtin_amdgcn_sched_barrier(0);
            if (l == 0 || c >= 4) {
                const unsigned hb = (unsigned)ml_row(c * 64, b, dir) * 4096u + (unsigned)lh;
                const float den = wi1 * accD[0] + em1 * accID[0];
                const float inv = __builtin_amdgcn_rcpf(fmaxf(fabsf(den), emr1));
                const f32x4 num = accA * wi1 + accIA * em1;
                u32x2 ow; ow.x = pk2(num[0] * inv, num[1] * inv); ow.y = pk2(num[2] * inv, num[3] * inv);
                *(u32x2*)(Hb + hb) = ow;
            }
            {
                LAS unsigned char* CTn = lds + ML_CT + ((c + 1) & 1) * ML_CTSZ;
#pragma unroll
                for (int ct = 0; ct < 3; ++ct) {
                    Cst[ct] = Cst[ct] * decay;
#pragma unroll
                    for (int k2 = 0; k2 < 2; ++k2) Cst[ct] = mfma16(ak[k2], bv[ct][k2], Cst[ct]);
                }
                if (c + 1 < 132) ML_PREFETCH_OUT(c + 1);
#pragma unroll
                for (int ct = 0; ct < 3; ++ct) { u32x2 o; o.x = pk2(Cst[ct][0], Cst[ct][1]); o.y = pk2(Cst[ct][2], Cst[ct][3]);
                    *(LAS u32x2*)(CTn + (16 * ct + c16) * 272 + (16 * w + 4 * q4) * 2) = o; }
            }
            LDS_BARRIER();
        }
#undef ML_PREFETCH
#undef ML_PREFETCH_OUT
    }
}

constexpr int AT_KS = 0, AT_VS = 17408, AT_RPB = 35840;
__device__ __forceinline__ void phase_attn(KP p, int l, LAS unsigned char* lds, int wid0) {
    const int tid = tid_fresh(wid0), lane = tid & 63, w = __builtin_amdgcn_readfirstlane(tid >> 6), q4 = lane >> 4, c16 = lane & 15;
    unsigned char* ws = launder(p->ws);
    bf16_t* CQ = (bf16_t*)(ws + WS_CQ); const bf16_t* CK = (const bf16_t*)(ws + WS_CK); const bf16_t* CV = (const bf16_t*)(ws + WS_CV);
    const int nunits = 2048 + (l == 0 ? 64 : 0);
    if (w >= 4) __builtin_amdgcn_s_setprio(1);
    for (int u = blockIdx.x; u < nunits; u += gridDim.x) {
        int b, h, qrow = 0, g = 0, ntl = 0, r0a = 0, qbase;  bool is_ctx = u >= 2048;
        if (!is_ctx) { b = u >> 10; h = (u >> 6) & 15; const int rp = u & 63; qrow = 2 * rp + (w >> 2); g = w & 3;
            r0a = min(max(2 * rp - 4, 0), 120); const int r0b = min(max(2 * rp + 1 - 4, 0), 120); ntl = r0b + 8 - r0a;
            qbase = b * 8192 + qrow * 64 + 16 * g; }
        else { const int uu = u - 2048; b = uu >> 5; h = (uu >> 1) & 15; qbase = NLAT + b * 256 + (uu & 1) * 128 + 16 * w; }
        const int r0q = min(max(qrow - 4, 0), 120);
        const int a_g = (g == 0) ? 0 : (g == 1 ? 8 : (g == 2 ? 24 : 32));
        __syncthreads();
        if (!is_ctx) for (int i = tid; i < 465; i += NTHREADS) *(LAS float*)(lds + AT_RPB + i * 4) = p->c_rpb[((size_t)l * 16 + h) * 465 + i] * 1.4426950408889634f;
        bf16x8 qf[4];
#pragma unroll
        for (int ks = 0; ks < 4; ++ks) qf[ks] = *(const bf16x8*)(CQ + (size_t)(qbase + c16) * 2048 + h * 128 + ks * 32 + 8 * q4);
        f32x4 O[8];
#pragma unroll
        for (int i = 0; i < 8; ++i) O[i] = (f32x4){0.f, 0.f, 0.f, 0.f};
        float m_run = -1e30f, l_run = 0.f;
        const int ntiles = ntl + 4;
        u32x4 kreg[2], vreg[2];
        auto tile_row = [&](int t, int key) -> int { return (t < ntl) ? (b * 8192 + (r0a + t) * 64 + key) : (NLAT + b * 256 + (t - ntl) * 64 + key); };
        const int krow_l = lane >> 4, kpc = lane & 15;
        {
#pragma unroll
          for (int i = 0; i < 2; ++i) { const int r = tile_row(0, 8 * w + 4 * i + krow_l); kreg[i] = *(const u32x4*)(CK + (size_t)r * 2048 + h * 128 + kpc * 8); vreg[i] = *(const u32x4*)(CV + (size_t)r * 2048 + h * 128 + kpc * 8); } }
        for (int t = 0; t < ntiles; ++t) {
            LDS_BARRIER();
#pragma unroll
            for (int i = 0; i < 2; ++i) { const int key = 8 * w + 4 * i + krow_l;
                *(LAS u32x4*)(lds + AT_KS + key * 272 + kpc * 16) = kreg[i];
                *(LAS u32x4*)(lds + AT_VS + key * 288 + kpc * 16) = vreg[i]; }
            if (t + 1 < ntiles) {
#pragma unroll
                for (int i = 0; i < 2; ++i) { const int r = tile_row(t + 1, 8 * w + 4 * i + krow_l); kreg[i] = *(const u32x4*)(CK + (size_t)r * 2048 + h * 128 + kpc * 8); vreg[i] = *(const u32x4*)(CV + (size_t)r * 2048 + h * 128 + kpc * 8); } }
            LDS_BARRIER();
            const bool local = t < ntl; const int kr = r0a + t;
            if (local && !(kr >= r0q && kr < r0q + 8)) continue;
            const int npass = local ? 1 : 2;
            for (int ps = 0; ps < npass; ++ps) {
                const int a0 = local ? a_g : ps * 32;
                const LAS unsigned char* kp0 = lds + AT_KS + (a0 + c16) * 272 + 8 * q4 * 2;
                bf16x8 kf[2][4];
#pragma unroll
                for (int ct = 0; ct < 2; ++ct)
#pragma unroll
                    for (int ks = 0; ks < 4; ++ks) kf[ct][ks] = *(const LAS bf16x8*)(kp0 + ct * 16 * 272 + ks * 64);
                float bs[8];
                if (local) {
                    const int qc = 16 * g + c16;
                    const LAS float* bp = (const LAS float*)(lds + AT_RPB) + ((kr - qrow + 7) * 31 + a0 + 4 * q4 - qc + 15);
#pragma unroll
                    for (int i = 0; i < 8; ++i) bs[i] = bp[16 * (i >> 2) + (i & 3)];
                    asm volatile("" : "+v"(bs[0]), "+v"(bs[1]), "+v"(bs[2]), "+v"(bs[3]), "+v"(bs[4]), "+v"(bs[5]), "+v"(bs[6]), "+v"(bs[7]));
                }
                __builtin_amdgcn_sched_barrier(0);
                f32x4 sc[2] = {{0.f, 0.f, 0.f, 0.f}, {0.f, 0.f, 0.f, 0.f}};
#pragma unroll
                for (int ks = 0; ks < 4; ++ks) { sc[0] = mfma16(kf[0][ks], qf[ks], sc[0]); sc[1] = mfma16(kf[1][ks], qf[ks], sc[1]); }
                __builtin_amdgcn_sched_barrier(0);
                s16x4 vlo[8], vhi[8];
                { const LAS unsigned char* vp0 = lds + AT_VS + (a0 + 4 * q4 + (c16 >> 2)) * 288 + 4 * (c16 & 3) * 2;
#pragma unroll
                  for (int dt = 0; dt < 8; ++dt) { vlo[dt] = __builtin_amdgcn_ds_read_tr16_b64_v4i16((LAS s16x4*)(vp0 + dt * 32)); vhi[dt] = __builtin_amdgcn_ds_read_tr16_b64_v4i16((LAS s16x4*)(vp0 + 16 * 288 + dt * 32)); } }
                __builtin_amdgcn_sched_barrier(0);
                if (local) {
                    const int qc = 16 * g + c16, col0 = min(max(qc - 8, 0), 48);
                    const int kb = a0 + 4 * q4 - col0;
#pragma unroll
                    for (int ct = 0; ct < 2; ++ct)
#pragma unroll
                        for (int r = 0; r < 4; ++r) sc[ct][r] = ((unsigned)(kb + 16 * ct + r) < 16u) ? sc[ct][r] + bs[ct * 4 + r] : -1e30f;
                }
                float mx = fmaxf(fmaxf(fmaxf(sc[0][0], sc[0][1]), fmaxf(sc[0][2], sc[0][3])), fmaxf(fmaxf(sc[1][0], sc[1][1]), fmaxf(sc[1][2], sc[1][3])));
                { const u32x2 t = __builtin_amdgcn_permlane16_swap(__float_as_uint(mx), __float_as_uint(mx), false, false); mx = fmaxf(__uint_as_float(t.x), __uint_as_float(t.y)); }
                { const u32x2 t = __builtin_amdgcn_permlane32_swap(__float_as_uint(mx), __float_as_uint(mx), false, false); mx = fmaxf(__uint_as_float(t.x), __uint_as_float(t.y)); }
                const float m_new = fmaxf(m_run, mx);
                const float alpha = __builtin_amdgcn_exp2f(m_run - m_new);
                float pe[8]; float psum = 0.f;
#pragma unroll
                for (int ct = 0; ct < 2; ++ct)
#pragma unroll
                    for (int r = 0; r < 4; ++r) { const float e = __builtin_amdgcn_exp2f(sc[ct][r] - m_new); pe[ct * 4 + r] = e; psum += e; }
                { const u32x2 t = __builtin_amdgcn_permlane16_swap(__float_as_uint(psum), __float_as_uint(psum), false, false); psum = __uint_as_float(t.x) + __uint_as_float(t.y); }
                { const u32x2 t = __builtin_amdgcn_permlane32_swap(__float_as_uint(psum), __float_as_uint(psum), false, false); psum = __uint_as_float(t.x) + __uint_as_float(t.y); }
                l_run = l_run * alpha + psum; m_run = m_new;
                bf16x8 pf; { u32x4 pw; pw.x = pk2(pe[0], pe[1]); pw.y = pk2(pe[2], pe[3]); pw.z = pk2(pe[4], pe[5]); pw.w = pk2(pe[6], pe[7]); pf = __builtin_bit_cast(bf16x8, pw); }
                if (__ballot(alpha != 1.0f) != 0ull) {
#pragma unroll
                    for (int dt = 0; dt < 8; ++dt) O[dt] = O[dt] * alpha;
                }
#pragma unroll
                for (int dt = 0; dt < 8; ++dt) O[dt] = mfma16(__builtin_shufflevector(vlo[dt], vhi[dt], 0, 1, 2, 3, 4, 5, 6, 7), pf, O[dt]);
            }
        }
        const float linv = 1.0f / l_run;
#pragma unroll
        for (int dt = 0; dt < 8; ++dt) { u32x2 ow; ow.x = pk2(O[dt][0] * linv, O[dt][1] * linv); ow.y = pk2(O[dt][2] * linv, O[dt][3] * linv);
            *(u32x2*)(CQ + (size_t)(qbase + c16) * 2048 + h * 128 + 16 * dt + 4 * q4) = ow; }
    }
    __builtin_amdgcn_s_setprio(0);
}

__device__ __forceinline__ void phase_e2(KP p, int l, int nrows, int wid0) {
    const int tid = tid_fresh(wid0); const int lane = tid & 63, gw = blockIdx.x * 8 + (tid >> 6), nw = gridDim.x * 8;
    unsigned char* ws = launder(p->ws);
    const bf16_t* HF = (const bf16_t*)(ws + WS_BC); const bf16_t* HB = (const bf16_t*)(ws + WS_BX); bf16_t* PO = (bf16_t*)(ws + WS_PO);
    const float* hg = p->a_hnorm_g + (size_t)l * 2048;
    for (int row = gw; row < nrows; row += nw) {
        u32x2 fv[8], bv[8]; unsigned ovv[8];
#pragma unroll
        for (int h = 0; h < 8; ++h) { const size_t o = (size_t)row * 2048 + h * 256 + lane * 4; fv[h] = *(const u32x2*)(HF + o); bv[h] = *(const u32x2*)(HB + o); ovv[h] = *(const unsigned*)(ws + WS_AO8 + o); }
#pragma unroll
        for (int h = 0; h < 8; ++h) {
            const size_t o = (size_t)row * 2048 + h * 256 + lane * 4;
            const u32x2 f = fv[h], bb = bv[h]; const unsigned ov = ovv[h];
            float v[4] = {bflo(f.x) + bflo(bb.x), bfhi(f.x) + bfhi(bb.x), bflo(f.y) + bflo(bb.y), bfhi(f.y) + bfhi(bb.y)};
            float ss = v[0] * v[0] + v[1] * v[1] + v[2] * v[2] + v[3] * v[3];
            ss = wave_sum(ss);
            const float rstd = rsqrtf(ss * (1.0f / 256.0f) + EPSF);
            const f32x4 gg = *(const f32x4*)(hg + h * 256 + lane * 4);
            const float og[4] = {pg8::gq8(ov, 0), pg8::gq8(ov, 1), pg8::gq8(ov, 2), pg8::gq8(ov, 3)};
            float y[4];
#pragma unroll
            for (int j = 0; j < 4; ++j) y[j] = og[j] * (1.0f / 255.0f) * v[j] * rstd * gg[j];
            u32x2 wv; wv.x = pk2(y[0], y[1]); wv.y = pk2(y[2], y[3]); *(u32x2*)(PO + o) = wv;
        }
    }
}

template <int MODE>
__device__ __forceinline__ void ctx_gemm(KP p, int l, LAS unsigned char* lds, int wid0) {
    const int tid = tid_fresh(wid0); const int lane = tid & 63, w = __builtin_amdgcn_readfirstlane(tid >> 6), q4 = lane >> 4, c16 = lane & 15;
    unsigned char* ws = launder(p->ws);
    for (int task = blockIdx.x; task < (NCTX / 64) * 32; task += gridDim.x) {
        const int rg = task >> 5, cb = task & 31; const int row0 = NLAT + rg * 64, col0 = cb * 64;
        const int orow = row0 + (tid >> 3), ocol = col0 + (tid & 7) * 8;
        float yv[8];
#pragma unroll
        for (int i = 0; i < 8; ++i) yv[i] = 0.f;
#pragma unroll 1
        for (int br = 0; br < (MODE == 0 ? 3 : 1); ++br) {
            const bf16_t* A; const bf16_t* Bt;
            if (MODE == 0) { const int ti = 1 + 4 * (br == 1) + (br == 2); A = (const bf16_t*)(ws + WS_T8 + (size_t)ti * SZ_A); Bt = (const bf16_t*)(ws + WS_WA + (size_t)br * SZ_W); }
            else if (MODE == 1) { A = (const bf16_t*)(ws + WS_Y); Bt = (const bf16_t*)(ws + WS_WO); }
            else { A = (const bf16_t*)(ws + WS_XN); Bt = (const bf16_t*)(ws + WS_WQ); }
            const bf16_t* ap = A + (size_t)(row0 + c16) * 2048 + w * 256 + 8 * q4; const bf16_t* bp = Bt + (size_t)(col0 + c16) * 2048 + w * 256 + 8 * q4;
            f32x4 acc[4][4];
#pragma unroll
            for (int mi = 0; mi < 4; ++mi)
#pragma unroll
                for (int j = 0; j < 4; ++j) acc[mi][j] = (f32x4){0.f, 0.f, 0.f, 0.f};
#pragma unroll 2
            for (int ks = 0; ks < 8; ++ks) {
                bf16x8 a[4], bb[4];
#pragma unroll
                for (int mi = 0; mi < 4; ++mi) a[mi] = *(const bf16x8*)(ap + (size_t)mi * 16 * 2048 + ks * 32);
#pragma unroll
                for (int j = 0; j < 4; ++j) bb[j] = *(const bf16x8*)(bp + (size_t)j * 16 * 2048 + ks * 32);
#pragma unroll
                for (int mi = 0; mi < 4; ++mi)
#pragma unroll
                    for (int j = 0; j < 4; ++j) acc[mi][j] = mfma16(a[mi], bb[j], acc[mi][j]);
            }
            __syncthreads();
#pragma unroll
            for (int mi = 0; mi < 4; ++mi)
#pragma unroll
                for (int j = 0; j < 4; ++j)
#pragma unroll
                    for (int r = 0; r < 4; ++r) *(LAS float*)(lds + ((w * 64 + 16 * mi + 4 * q4 + r) * 64 + 16 * j + c16) * 4) = acc[mi][j][r];
            __syncthreads();
            float sv[8];
#pragma unroll
            for (int i = 0; i < 8; ++i) sv[i] = 0.f;
#pragma unroll
            for (int ww = 0; ww < 8; ++ww) { const f32x4 p0 = *(const LAS f32x4*)(lds + ((ww * 64 + (tid >> 3)) * 64 + (tid & 7) * 8) * 4), p1 = *(const LAS f32x4*)(lds + ((ww * 64 + (tid >> 3)) * 64 + (tid & 7) * 8 + 4) * 4);
                sv[0] += p0[0]; sv[1] += p0[1]; sv[2] += p0[2]; sv[3] += p0[3]; sv[4] += p1[0]; sv[5] += p1[1]; sv[6] += p1[2]; sv[7] += p1[3]; }
            if (MODE == 0) { const u32x2 g = *(const u32x2*)(ws + WS_GT + (size_t)orow * 6144 + (size_t)br * 2048 + ocol);
#pragma unroll
                for (int i = 0; i < 8; ++i) yv[i] += pg8::gq8(i < 4 ? g.x : g.y, i & 3) * (1.0f / 255.0f) * sv[i]; }
            else {
#pragma unroll
                for (int i = 0; i < 8; ++i) yv[i] = sv[i]; }
        }
        if (MODE == 1) { bf16_t* xp = (bf16_t*)(ws + WS_X) + (size_t)orow * 2048 + ocol; const float* xi = p->ctx + (size_t)(orow - NLAT) * 2048 + ocol; const float* mg = (const float*)(ws + WS_MOD) + (size_t)l * 3 * 12288 + 2 * 12288 + 2 * 2048 + ocol;
            const f32x4 x0 = *(const f32x4*)xi, x1 = *(const f32x4*)(xi + 4), g0 = *(const f32x4*)mg, g1 = *(const f32x4*)(mg + 4);
            f32x4 o0, o1; o0[0] = x0[0] + g0[0] * yv[0]; o0[1] = x0[1] + g0[1] * yv[1]; o0[2] = x0[2] + g0[2] * yv[2]; o0[3] = x0[3] + g0[3] * yv[3];
            o1[0] = x1[0] + g1[0] * yv[4]; o1[1] = x1[1] + g1[1] * yv[5]; o1[2] = x1[2] + g1[2] * yv[6]; o1[3] = x1[3] + g1[3] * yv[7];
            u32x4 ow; ow.x = pk2(o0[0], o0[1]); ow.y = pk2(o0[2], o0[3]); ow.z = pk2(o1[0], o1[1]); ow.w = pk2(o1[2], o1[3]); *(u32x4*)xp = ow; }
        else { u32x4 ov; ov.x = pk2(yv[0], yv[1]); ov.y = pk2(yv[2], yv[3]); ov.z = pk2(yv[4], yv[5]); ov.w = pk2(yv[6], yv[7]);
            *(u32x4*)((bf16_t*)(ws + (MODE == 0 ? WS_Y : WS_PV)) + (size_t)orow * 2048 + ocol) = ov; }
    }
}

constexpr int PE_MAXT = 80;
constexpr int PE_IDX = 0, PE_W = PE_MAXT * 128 * 4, PE_SCR = 2 * PE_MAXT * 128 * 4, PE_SCRSZ = 16 * 132 * 4 + 4096 + 256;
#define PE_DPPU(v, ctrl) ((unsigned)__builtin_amdgcn_update_dpp(0, (int)(v), ctrl, 0xf, 0xf, true))
__device__ __forceinline__ unsigned ordkey(float v) { const unsigned u = __float_as_uint(v); return (u & 0x80000000u) ? ~u : (u | 0x80000000u); }
__device__ __forceinline__ void phase_peer(KP p, int l, LAS unsigned char* lds, int wid0) {
    const int tid = tid_fresh(wid0), lane = tid & 63, w = __builtin_amdgcn_readfirstlane(tid >> 6), q4 = lane >> 4, c16 = lane & 15;
    unsigned char* ws = launder(p->ws);
    const bf16_t* QP = (const bf16_t*)(ws + WS_PV); const bf16_t* KEYS = (const bf16_t*)(ws + WS_KEYS);
    const bf16_t* XN = (const bf16_t*)(ws + WS_XN);
    bf16_t* X = (bf16_t*)(ws + WS_X); const float* mod = (const float*)(ws + WS_MOD) + (size_t)l * 3 * 12288;
    const int ntok = (l == 0) ? MR : NLAT, G = gridDim.x;
    const int per = (ntok + G - 1) / G; const int t_begin = blockIdx.x * per, t_end = min(ntok, t_begin + per);
    for (int tb = t_begin; tb < t_end; tb += PE_MAXT) {
        const int nt = min(PE_MAXT, t_end - tb);
        __syncthreads();
        const int ntask = (nt + 15) >> 4;
        if (w < ntask) {
            int lane_pe1 = lane; asm volatile("" : "+v"(lane_pe1));
            const int lane = lane_pe1, q4 = lane >> 4, c16 = lane & 15;
            LAS unsigned char* scr = lds + PE_SCR + w * PE_SCRSZ;
            LAS float* SC = (LAS float*)scr;
            LAS float* LS = (LAS float*)(scr + 16 * 132 * 4);
            LAS int* LI = (LAS int*)(scr + 16 * 132 * 4 + 2048);
            LAS unsigned char* PT = scr + 16 * 132 * 4 + 4096;
            if (lane < 52) {
                const int L = lane;
                const int ge16 = L >= 16, ge24 = L >= 24, ge29 = L >= 29, ge33 = L >= 33, ge36 = L >= 36, ge38 = L >= 38, ge40 = L >= 40, ge42 = L >= 42;
                int pa = ge16 + ge24 + ge29 + ge33 + ge36 + ge38 + ge40 + ge42; if (ge42) pa = 8 + (L - 42);
                int pb = L - (16 * ge16 + 8 * ge24 + 5 * ge29 + 4 * ge33 + 3 * ge36 + 2 * ge38 + 2 * ge40 + 2 * ge42); if (ge42) pb = 0;
                if (L >= 50) { pa = 15; pb = 15; }
                PT[lane * 2] = (unsigned char)pa; PT[lane * 2 + 1] = (unsigned char)pb;
            }
            const int tok_a = min(tb + 16 * w + c16, t_end - 1);
            const int tkl = lane >> 2, qq = lane & 3;
            for (int h = 0; h < 8; ++h) {
                for (int pp = 0; pp < 2; ++pp) {
                    const int hp = 2 * h + pp;
                    bf16x8 af[4];
#pragma unroll
                    for (int ks = 0; ks < 4; ++ks) af[ks] = *(const bf16x8*)(QP + (size_t)tok_a * 2048 + h * 256 + pp * 128 + ks * 32 + 8 * q4);
#pragma unroll 4
                    for (int ct = 0; ct < 8; ++ct) {
                        f32x4 acc = {0.f, 0.f, 0.f, 0.f};
#pragma unroll
                        for (int ks = 0; ks < 4; ++ks) { const bf16x8 bfr = *(const bf16x8*)(KEYS + ((size_t)hp * 128 + 16 * ct + c16) * 128 + ks * 32 + 8 * q4); acc = mfma16(af[ks], bfr, acc); }
#pragma unroll
                        for (int r = 0; r < 4; ++r) SC[(4 * q4 + r) * 132 + 16 * ct + c16] = acc[r];
                    }
                    asm volatile("s_waitcnt lgkmcnt(0)" ::: "memory");
                    unsigned key[32];
#pragma unroll
                    for (int i = 0; i < 8; ++i) { const f32x4 v = *(const LAS f32x4*)(SC + tkl * 132 + 32 * qq + 4 * i);
#pragma unroll
                        for (int j = 0; j < 4; ++j) key[4 * i + j] = ((ordkey(v[j]) >> 1) & ~127u) | (unsigned)(32 * qq + 4 * i + j); }
                    unsigned prev = 0x80000000u;
#pragma unroll 1
                    for (int r = 0; r < 16; ++r) {
                        unsigned mxd = 0u;
#pragma unroll
                        for (int i = 0; i < 32; ++i) { const unsigned d = key[i] - prev; mxd = mxd > d ? mxd : d; }
                        { const unsigned o1 = PE_DPPU(mxd, 0xB1); mxd = mxd > o1 ? mxd : o1; const unsigned o2 = PE_DPPU(mxd, 0x4E); mxd = mxd > o2 ? mxd : o2; }
                        const unsigned mxk = mxd + prev;
                        prev = mxk;
                        if (qq == (r & 3)) { const int idx = (int)(mxk & 127u); LS[(pp * 16 + tkl) * 16 + r] = SC[tkl * 132 + idx]; LI[(pp * 16 + tkl) * 16 + r] = idx; }
                    }
                    asm volatile("s_waitcnt lgkmcnt(0)" ::: "memory");
                }
                unsigned ck[13];
#pragma unroll
                for (int i = 0; i < 13; ++i) { const int cidx = qq + 4 * i;
                    if (cidx < 50) { const int a = PT[cidx * 2], bq = PT[cidx * 2 + 1]; const float sv = LS[(0 * 16 + tkl) * 16 + a] + LS[(1 * 16 + tkl) * 16 + bq]; ck[i] = ((ordkey(sv) >> 1) & ~63u) | (unsigned)cidx; }
                    else ck[i] = 0u; }
                unsigned prev = 0x80000000u; float best0 = 0.f, esum = 0.f; float myexp[4] = {0.f, 0.f, 0.f, 0.f}; int myidx[4] = {0, 0, 0, 0};
#pragma unroll
                for (int r = 0; r < 16; ++r) {
                    unsigned mxd = 0u;
#pragma unroll
                    for (int i = 0; i < 13; ++i) { const unsigned d = ck[i] - prev; mxd = mxd > d ? mxd : d; }
                    { const unsigned o1 = PE_DPPU(mxd, 0xB1); mxd = mxd > o1 ? mxd : o1; const unsigned o2 = PE_DPPU(mxd, 0x4E); mxd = mxd > o2 ? mxd : o2; }
                    const unsigned mxk = mxd + prev;
                    prev = mxk;
                    const int cidx = (int)(mxk & 63u); const int a = PT[cidx * 2], bq = PT[cidx * 2 + 1];
                    const float best = LS[(0 * 16 + tkl) * 16 + a] + LS[(1 * 16 + tkl) * 16 + bq];
                    const int eidx = LI[(0 * 16 + tkl) * 16 + a] * 128 + LI[(1 * 16 + tkl) * 16 + bq];
                    if (r == 0) best0 = best;
                    const float e = __expf(best - best0); esum += e;
                    if (qq == (r & 3)) { myexp[r >> 2] = e; myidx[r >> 2] = eidx; }
                }
                const float inv = 1.0f / esum; const int tl = 16 * w + tkl;
                if (tl < nt) {
#pragma unroll
                    for (int i = 0; i < 4; ++i) { const int r = 4 * i + qq;
                        *(LAS int*)(lds + PE_IDX + (tl * 128 + h * 16 + r) * 4) = myidx[i];
                        *(LAS float*)(lds + PE_W + (tl * 128 + h * 16 + r) * 4) = myexp[i] * inv; }
                }
                asm volatile("s_waitcnt lgkmcnt(0)" ::: "memory");
            }
        }
        __syncthreads();
        int lane_pe2 = lane; asm volatile("" : "+v"(lane_pe2));
        const int nfull = nt & ~7, nleft = nt - nfull;
        const int S = (nleft == 1 || nleft == 2 || nleft == 4) ? 8 / nleft : 1;
        const int nrounds = (nfull >> 3) + (nleft ? 1 : 0);
        for (int rd = 0; rd < nrounds; ++rd) {
            const int lane = lane_pe2;
            const bool split = (rd == (nfull >> 3)) && S > 1;
            const int tl = split ? nfull + w / S : rd * 8 + w;
            const int NB = split ? 64 / S : 64, B0 = split ? (w % S) * NB : 0;
            const bool active = tl < nt;
            if (active) {
            const int row = tb + tl;
            u32x16 xq;
#pragma unroll
            for (int i = 0; i < 4; ++i) { const u32x4 xw = *(const u32x4*)(XN + (size_t)row * 2048 + lane * 32 + i * 8); xq[4 * i] = xw.x; xq[4 * i + 1] = xw.y; xq[4 * i + 2] = xw.z; xq[4 * i + 3] = xw.w; }
            const LAS int* idxp = (const LAS int*)(lds + PE_IDX + tl * 512);
            LAS float* wp = (LAS float*)(lds + PE_W + tl * 512);
            u32x4 bufA[2], bufB[2], bufC[2], bufD[2];
#define PE_ISSUE(buf, TAB, b) do { const u32x2 _ee = *(const LAS u32x2*)(idxp + 2 * (b)); \
                buf[0] = *(const u32x4*)((TAB) + ((_ee.x << 10) + (unsigned)lane * 16u)); buf[1] = *(const u32x4*)((TAB) + ((_ee.y << 10) + (unsigned)lane * 16u)); } while (0)
#define PE_DPPF(v, ctrl) __uint_as_float((unsigned)__builtin_amdgcn_update_dpp(0, (int)__float_as_uint(v), ctrl, 0xf, 0xf, true))
#define PE_CONS_U(buf, b) do { float _p[2]; \
                _Pragma("unroll") for (int _j = 0; _j < 2; ++_j) { float _d = 0.f; \
                    _Pragma("unroll") for (int _q = 0; _q < 4; ++_q) { const unsigned _dw = buf[_j][_q]; \
                        _d = dot2bf(__builtin_bit_cast(unsigned, __builtin_amdgcn_cvt_scalef32_pk_bf16_fp4(_dw, 1.0f, 0)), xq[4 * _q + 0], _d); _d = dot2bf(__builtin_bit_cast(unsigned, __builtin_amdgcn_cvt_scalef32_pk_bf16_fp4(_dw, 1.0f, 1)), xq[4 * _q + 1], _d); \
                        _d = dot2bf(__builtin_bit_cast(unsigned, __builtin_amdgcn_cvt_scalef32_pk_bf16_fp4(_dw, 1.0f, 2)), xq[4 * _q + 2], _d); _d = dot2bf(__builtin_bit_cast(unsigned, __builtin_amdgcn_cvt_scalef32_pk_bf16_fp4(_dw, 1.0f, 3)), xq[4 * _q + 3], _d); } \
                    _p[_j] = _d; } \
                float _c; { const u32x2 _t = __builtin_amdgcn_permlane32_swap(__float_as_uint(_p[0]), __float_as_uint(_p[1]), false, false); _c = __uint_as_float(_t.x) + __uint_as_float(_t.y); }     \
                { const u32x2 _t = __builtin_amdgcn_permlane16_swap(__float_as_uint(_c), __float_as_uint(_c), false, false); _c = __uint_as_float(_t.x) + __uint_as_float(_t.y); } \
                _c += PE_DPPF(_c, 0x140); _c += PE_DPPF(_c, 0x141); _c += PE_DPPF(_c, 0x4E); _c += PE_DPPF(_c, 0xB1);        \
                if ((lane & 31) == ((((b) - B0)) & 31)) cacc = _c; } while (0)
#define PE_FLUSH(jb, cnt) do { if ((lane & 31) < (cnt)) { const int _e = 2 * (B0 + (jb) + (lane & 31)) + (lane >> 5); const float _g = wp[_e]; \
                const float _a = cacc * (1.0f / 64.0f); wp[_e] = _g * 0.5f * _a * (1.0f + erff(_a * 0.70710678118654752f)); } } while (0)
#define PE_CONS_V(buf, b) do { const f32x2 _w2 = *(const LAS f32x2*)(wp + 2 * (b)); \
                _Pragma("unroll") for (int _j = 0; _j < 2; ++_j) { const f32x2 _wv = {_w2[_j], _w2[_j]}; \
                    _Pragma("unroll") for (int _q = 0; _q < 4; ++_q) { const unsigned _dw = buf[_j][_q]; \
                        out2[4 * _q + 0] += _wv * __builtin_amdgcn_cvt_scalef32_pk_f32_fp4(_dw, 1.0f, 0); out2[4 * _q + 1] += _wv * __builtin_amdgcn_cvt_scalef32_pk_f32_fp4(_dw, 1.0f, 1); \
                        out2[4 * _q + 2] += _wv * __builtin_amdgcn_cvt_scalef32_pk_f32_fp4(_dw, 1.0f, 2); out2[4 * _q + 3] += _wv * __builtin_amdgcn_cvt_scalef32_pk_f32_fp4(_dw, 1.0f, 3); } } } while (0)
            const unsigned char* TU = ws + WS_PU; const unsigned char* TV = ws + WS_PVW;
            const int NT = 2 * NB;
            asm volatile("" : "+v"(xq));
#define PE_ISS(s_, bi) do { const int _jn = min(max(j0 + (s_) + 3, 0), NT - 1); const bool _isv = _jn >= NB; \
                const unsigned char* _tab = _isv ? TV : TU; const int _bb = B0 + (_isv ? _jn - NB : _jn); PE_ISSUE(bi, _tab, _bb); } while (0)
            float cacc = 0.f;
#pragma unroll 1
            for (int t = -1; 4 * t < NB; ++t) { const int j0 = 4 * t;
                PE_ISS(0, bufD); if (t >= 0) PE_CONS_U(bufA, B0 + j0);
                PE_ISS(1, bufA); if (t >= 0) PE_CONS_U(bufB, B0 + j0 + 1);
                PE_ISS(2, bufB); if (t >= 0) PE_CONS_U(bufC, B0 + j0 + 2);
                PE_ISS(3, bufC); if (t >= 0) PE_CONS_U(bufD, B0 + j0 + 3);
                if (t >= 0 && ((t & 7) == 7 || 4 * (t + 1) >= NB)) PE_FLUSH(32 * (t >> 3), min(32, NB - 32 * (t >> 3)));
            }
            asm volatile("s_waitcnt lgkmcnt(0)" ::: "memory");
            f32x2 out2[16];
#pragma unroll
            for (int i = 0; i < 16; ++i) out2[i] = (f32x2){0.f, 0.f};
#pragma unroll 1
            for (int t = 0; 4 * t < NB; ++t) { const int j0 = NB + 4 * t;
                PE_ISS(0, bufD); PE_CONS_V(bufA, B0 + 4 * t);
                PE_ISS(1, bufA); PE_CONS_V(bufB, B0 + 4 * t + 1);
                PE_ISS(2, bufB); PE_CONS_V(bufC, B0 + 4 * t + 2);
                PE_ISS(3, bufC); PE_CONS_V(bufD, B0 + 4 * t + 3);
            }
#undef PE_ISS
#undef PE_ISSUE
#undef PE_CONS_U
#undef PE_FLUSH
#undef PE_DPPF
#undef PE_CONS_V
            f32x32 outv;
#pragma unroll
            for (int i = 0; i < 16; ++i) { outv[2 * i] = out2[i][0]; outv[2 * i + 1] = out2[i][1]; }
            if (split) {
                LAS float* pp = (LAS float*)(lds + PE_SCR) + ((size_t)((tl - nfull) * S + (w % S)) * 64 + lane) * 32;
#pragma unroll
                for (int i = 0; i < 8; ++i) { f32x4 t4; t4[0] = outv[4 * i]; t4[1] = outv[4 * i + 1]; t4[2] = outv[4 * i + 2]; t4[3] = outv[4 * i + 3]; *(LAS f32x4*)(pp + 4 * i) = t4; }
            }
            if (!split) {
            const int which = row < NLAT ? (row >> 13) : 2;
            const float* mg = mod + (size_t)which * 12288 + 5 * 2048;
            const bf16_t* xrow = X + (size_t)row * 2048;
            u32x4 xbv[4]; f32x4 gvv[8];
#pragma unroll
            for (int i = 0; i < 4; ++i) xbv[i] = *(const u32x4*)(xrow + lane * 32 + i * 8);
#pragma unroll
            for (int hh = 0; hh < 8; ++hh) gvv[hh] = *(const f32x4*)(mg + lane * 32 + hh * 4);
#pragma unroll
            for (int i = 0; i < 4; ++i) { const u32x4 xw = xbv[i]; const f32x4 g0 = gvv[2 * i], g1 = gvv[2 * i + 1];
                f32x4 o0, o1;
                o0[0] = bflo(xw.x) + g0[0] * outv[i * 8 + 0] * 0.25f; o0[1] = bfhi(xw.x) + g0[1] * outv[i * 8 + 1] * 0.25f; o0[2] = bflo(xw.y) + g0[2] * outv[i * 8 + 2] * 0.25f; o0[3] = bfhi(xw.y) + g0[3] * outv[i * 8 + 3] * 0.25f;
                o1[0] = bflo(xw.z) + g1[0] * outv[i * 8 + 4] * 0.25f; o1[1] = bfhi(xw.z) + g1[1] * outv[i * 8 + 5] * 0.25f; o1[2] = bflo(xw.w) + g1[2] * outv[i * 8 + 6] * 0.25f; o1[3] = bfhi(xw.w) + g1[3] * outv[i * 8 + 7] * 0.25f;
                if (l == 1) { float* orow = p->out + (size_t)row * 2048 + lane * 32 + i * 8; *(f32x4*)orow = o0; *(f32x4*)(orow + 4) = o1; }
                else { u32x4 ow; ow.x = pk2(o0[0], o0[1]); ow.y = pk2(o0[2], o0[3]); ow.z = pk2(o1[0], o1[1]); ow.w = pk2(o1[2], o1[3]); *(u32x4*)(X + (size_t)row * 2048 + lane * 32 + i * 8) = ow; } }
            }
            }
            if (split) {
                __syncthreads();
                if ((w % S) == 0 && tl < nt) {
                    const int row = tb + tl;
                    const int which = row < NLAT ? (row >> 13) : 2;
                    const float* mg = mod + (size_t)which * 12288 + 5 * 2048;
                    const bf16_t* xrow = X + (size_t)row * 2048;
                    const LAS float* pp = (const LAS float*)(lds + PE_SCR) + ((size_t)((tl - nfull) * S) * 64 + lane) * 32;
                    u32x4 xbv[4];
#pragma unroll
                    for (int i = 0; i < 4; ++i) xbv[i] = *(const u32x4*)(xrow + lane * 32 + i * 8);
#pragma unroll
                    for (int i = 0; i < 4; ++i) {
                        f32x4 a0 = *(const LAS f32x4*)(pp + i * 8), a1 = *(const LAS f32x4*)(pp + i * 8 + 4);
                        for (int q = 1; q < S; ++q) { a0 += *(const LAS f32x4*)(pp + (size_t)q * 64 * 32 + i * 8); a1 += *(const LAS f32x4*)(pp + (size_t)q * 64 * 32 + i * 8 + 4); }
                        const f32x4 g0 = *(const f32x4*)(mg + lane * 32 + i * 8), g1 = *(const f32x4*)(mg + lane * 32 + i * 8 + 4);
                        const u32x4 xw = xbv[i];
                        f32x4 o0, o1;
                        o0[0] = bflo(xw.x) + g0[0] * a0[0] * 0.25f; o0[1] = bfhi(xw.x) + g0[1] * a0[1] * 0.25f; o0[2] = bflo(xw.y) + g0[2] * a0[2] * 0.25f; o0[3] = bfhi(xw.y) + g0[3] * a0[3] * 0.25f;
                        o1[0] = bflo(xw.z) + g1[0] * a1[0] * 0.25f; o1[1] = bfhi(xw.z) + g1[1] * a1[1] * 0.25f; o1[2] = bflo(xw.w) + g1[2] * a1[2] * 0.25f; o1[3] = bfhi(xw.w) + g1[3] * a1[3] * 0.25f;
                        if (l == 1) { float* orow = p->out + (size_t)row * 2048 + lane * 32 + i * 8; *(f32x4*)orow = o0; *(f32x4*)(orow + 4) = o1; }
                        else { u32x4 ow; ow.x = pk2(o0[0], o0[1]); ow.y = pk2(o0[2], o0[3]); ow.z = pk2(o1[0], o1[1]); ow.w = pk2(o1[2], o1[3]); *(u32x4*)(X + (size_t)row * 2048 + lane * 32 + i * 8) = ow; }
                    }
                }
            }
        }
    }
}

#if !MK_SINGLE
#define LOHI_ARGS , const int lo, const int hi
#define LOHI_PASS , lo, hi
#else
#define LOHI_ARGS
#define LOHI_PASS
#endif
#ifndef PHM
#define PHM 0x7ff
#endif
#if MK_SINGLE
#define IN(k) (((PHM >> (((k) % NPH))) & 1) != 0)
#define SEAM(k) do { if ((k) + 1 < 2 * NPH) xcd_barrier(bar); } while (0)
#else
#define IN(k) (((PHM >> (((k) % NPH))) & 1) && lo <= (k) && (k) < hi)
#define SEAM(k) do { if (IN(k) && IN((k) + 1)) xcd_barrier(bar); } while (0)
#endif
template <int l>
__device__ __forceinline__ void layer_program(KP kp, unsigned char* ws0, LAS unsigned char* lds, const XcdBarrier& bar, const int G, const int wid0 LOHI_ARGS) {
        const int pb = l * NPH;
        const int M2 = (l == 0) ? MR : NLAT;
        constexpr int MG = NLAT;
        if (IN(pb + 0)) { phase_w(launder_p(kp), l, lds, wid0); } SEAM(pb + 0);
        if (IN(pb + 1)) { phase_norm(launder_p(kp), l, 0, MR, wid0); } SEAM(pb + 1);
        if (IN(pb + 2)) { unsigned char* ws = launder(ws0);
            { pg8::PlainOrder S; S.init(ws + WS_XN8, ws + WS_WIN, MR, (72 - (BF_HI - BF_LO)) * 256, 1024, G, (int)blockIdx.x); S.skip_from = BF_LO; S.skip_cnt = BF_HI - BF_LO; S.skip2_from = 48; S.skip2_cnt = 24;
              if (G == 256 && BF_HI - BF_LO == 8) { S.short_rounds = 15; S.n_long = 192; }
              pg8::EpiProj E{ws};
              pg8::gemm_phase<pg8::EpiProj, pg8::PlainOrder, true>(lds, 1024, S, E, wid0); }
            { pg8::PlainOrder S; S.init(ws + WS_XN, ws + WS_WINB, MR, (24 + BF_HI - BF_LO) * 256, 2048, G, G - 1 - (int)blockIdx.x); S.pn_base = BF_LO; S.skip_from = BF_HI; S.skip_cnt = 48 - BF_HI; S.b_compact = 1;
              pg8::EpiProj E{ws};
              pg8::gemm_phase<pg8::EpiProj, pg8::PlainOrder, false>(lds, 2048, S, E, wid0); }
        } SEAM(pb + 2);
        if (IN(pb + 3)) { phase_gates_gemm(launder_p(kp), l, wid0); phase_e1(launder_p(kp), l, wid0); } SEAM(pb + 3);
        if (IN(pb + 4)) { phase_mlstm(launder_p(kp), l, lds, wid0); phase_attn(launder_p(kp), l, lds, wid0); } SEAM(pb + 4);
        if (IN(pb + 5)) { phase_e2(launder_p(kp), l, M2, wid0); } SEAM(pb + 5);
        if (IN(pb + 6)) { unsigned char* ws = launder(ws0);
            pg8::BranchOrder S; S.T8 = (const char*)(ws + WS_T8); S.WA = (const char*)(ws + WS_WA);
            S.nM = MG / 256; S.nN = 8; S.G = G; S.c = (int)blockIdx.x; S.tstep = (size_t)256 * 2048 * 2;
            pg8::EpiMerge E{(bf16_t*)(ws + WS_Y), (const unsigned char*)(ws + WS_GT)};
            pg8::gemm_phase<pg8::EpiMerge, pg8::BranchOrder>(lds, 2048, S, E, wid0);
            if (l == 0) ctx_gemm<0>(launder_p(kp), l, lds, wid0);
        } SEAM(pb + 6);
        if (IN(pb + 7)) { unsigned char* ws = launder(ws0);
            pg8::PlainOrder S; S.init(ws + WS_Y, ws + WS_WO, MG, 2048, 2048, G, (int)blockIdx.x);
            if constexpr (l == 0) { pg8::EpiRes<true> E{(bf16_t*)(ws + WS_X), kp->x, (const float*)(ws + WS_MOD) + (size_t)l * 3 * 12288};
                pg8::gemm_phase<pg8::EpiRes<true>, pg8::PlainOrder>(lds, 2048, S, E, wid0); }
            else { pg8::EpiRes<false> E{(bf16_t*)(ws + WS_X), nullptr, (const float*)(ws + WS_MOD) + (size_t)l * 3 * 12288};
                pg8::gemm_phase<pg8::EpiRes<false>, pg8::PlainOrder>(lds, 2048, S, E, wid0); }
            if (l == 0) ctx_gemm<1>(launder_p(kp), l, lds, wid0);
        } SEAM(pb + 7);
        if (IN(pb + 8)) { phase_norm(launder_p(kp), l, 1, M2, wid0); } SEAM(pb + 8);
        if (IN(pb + 9)) { unsigned char* ws = launder(ws0);
            pg8::PlainOrder S; S.init(ws + WS_XN, ws + WS_WQ, MG, 2048, 2048, G, (int)blockIdx.x);
            pg8::EpiBf E{(bf16_t*)(ws + WS_PV), 2048};
            pg8::gemm_phase<pg8::EpiBf, pg8::PlainOrder>(lds, 2048, S, E, wid0);
            if (l == 0) ctx_gemm<2>(launder_p(kp), l, lds, wid0);
        } SEAM(pb + 9);
        if (IN(pb + 10)) { phase_peer(launder_p(kp), l, lds, wid0); } SEAM(pb + 10);
    }
#undef IN
#undef SEAM

__global__ void __launch_bounds__(NTHREADS, 2) fwd_kernel(Params p) {
    extern __shared__ __attribute__((aligned(16))) unsigned char lds_raw[];
    LAS unsigned char* lds = (LAS unsigned char*)lds_raw;
    const int tid = threadIdx.x, G = gridDim.x;
    const int wid0 = __builtin_amdgcn_readfirstlane(tid >> 6);
    KP kp = (KP)__builtin_amdgcn_kernarg_segment_ptr();
    unsigned char* ws0 = kp->ws;
    volatile LAS unsigned* bst = (volatile LAS unsigned*)(lds + LDS_BYTES - 16);
    if (tid == 0) { bst[0] = 0u; bst[1] = 0u; bst[2] = 0u; bst[3] = 0u; }
    __syncthreads();
    XcdBarrier bar; bar.bar = (unsigned*)(ws0 + WS_BAR); bar.x = 0; bar.st = bst;
    if (MK_SINGLE) bar = xcd_barrier_post((unsigned*)(ws0 + WS_BAR), bst);
#if !MK_SINGLE
    const int lo = kp->ph_lo, hi = kp->ph_hi;
#endif
    layer_program<0>(kp, ws0, lds, bar, G, wid0 LOHI_PASS);
    layer_program<1>(kp, ws0, lds, bar, G, wid0 LOHI_PASS);
}

extern "C" void kernel_launch(void* const* d_in, const int* in_sizes, int n_in, void* d_out, int out_size, void* d_ws, size_t ws_size, hipStream_t stream) {
    static int grid = 0;
    if (grid == 0) {
        if (n_in != 21 || in_sizes[0] != NLAT * DM || out_size != NLAT * DM || ws_size < WS_END) {
            fprintf(stderr, "kernel_launch: unexpected shapes (n_in %d, in0 %d, out %d, ws %zu need %zu); nothing launched\n", n_in, n_in > 0 ? in_sizes[0] : -1, out_size, ws_size, (size_t)WS_END); grid = -1; return; }
        int dev = 0, cus = 0, per_cu = 0;
        if (hipGetDevice(&dev) != hipSuccess || hipDeviceGetAttribute(&cus, hipDeviceAttributeMultiprocessorCount, dev) != hipSuccess) { grid = -1; return; }
        if (hipFuncSetAttribute((const void*)fwd_kernel, hipFuncAttributeMaxDynamicSharedMemorySize, LDS_BYTES) != hipSuccess) { fprintf(stderr, "kernel_launch: hipFuncSetAttribute failed\n"); grid = -1; return; }
        if (hipOccupancyMaxActiveBlocksPerMultiprocessor(&per_cu, (const void*)fwd_kernel, NTHREADS, LDS_BYTES) != hipSuccess || per_cu < 1) { fprintf(stderr, "kernel_launch: occupancy query says %d\n", per_cu); }
        (void)hipGetLastError();
        grid = cus;
    }
    if (grid < 0) return;
    (void)hipMemsetAsync((char*)d_ws, 0, 16384, stream);
    Params p{};
    const float** pp = (const float**)&p;
    for (int i = 0; i < 21; ++i) pp[i] = (const float*)d_in[i];
    p.out = (float*)d_out; p.ws = (unsigned char*)d_ws;
#if MK_SINGLE
    p.ph_lo = 0; p.ph_hi = 2 * NPH;
    hipLaunchKernelGGL(fwd_kernel, dim3(grid), dim3(NTHREADS), LDS_BYTES, stream, p);
#else
    for (int k = 0; k < 2 * NPH; ++k) { p.ph_lo = k; p.ph_hi = k + 1; hipLaunchKernelGGL(fwd_kernel, dim3(grid), dim3(NTHREADS), LDS_BYTES, stream, p); }
#endif
}
```
